# Optimizing an MI355X kernel written in HIP

```python
import jax, jax.numpy as jnp
from jax import lax
import numpy as np

D_MODEL = 1024
BATCH = 2
SEQ = 16384
DEPTH = 1

R_HEADS = 8
R_HEAD_DIM = 64
R_WIDTH = R_HEADS * R_HEAD_DIM
DECAY_LORA = 64
ICLR_LORA = 64
GATE_LORA = 160
LNX_EPS = 64e-5
R_COLS = 3 * R_WIDTH + DECAY_LORA + ICLR_LORA + GATE_LORA
N_Q_HEADS = 8
N_KV_HEADS = 2
GQA = N_Q_HEADS // N_KV_HEADS
HEAD_DIM = 64
N_WIDTH = N_Q_HEADS * HEAD_DIM
KV_WIDTH = N_KV_HEADS * HEAD_DIM
N_COLS = N_WIDTH + 6 * KV_WIDTH + 3 * N_Q_HEADS
CMP_BLOCK = 32
CMP_STRIDE = 16
CMP_HIDDEN = 256
SEL_BLOCK = 64
SEL_TOPK = 16
WINDOW = 512
Q_BLOCK = 128
ROPE_THETA = 500000.0
ROT_DIM = HEAD_DIM // 4
IN_COLS = R_COLS + N_COLS
MIX_WIDTH = R_WIDTH + N_WIDTH
D_FF = ((8 * D_MODEL + 3 * 256 - 1) // (3 * 256)) * 256
NORM_EPS = 1e-6
MASK = -1e30
FORCE = 1e6

kernel_name = "hymba_rwkv7_nsa_hybrid_layer"


def rms_norm(x, g):
    xf = x.astype(jnp.float32)
    y = xf * lax.rsqrt(jnp.mean(xf * xf, axis=-1, keepdims=True) + NORM_EPS)
    return (y * g.astype(jnp.float32)).astype(x.dtype)


def partial_rope(x, pos):
    half = ROT_DIM // 2
    inv_freq = jnp.power(jnp.float32(ROPE_THETA), -jnp.arange(half, dtype=jnp.float32) * 2.0 / ROT_DIM)
    ang = pos.astype(jnp.float32)[..., None] * inv_freq
    cos = jnp.cos(ang)[:, :, None, :]
    sin = jnp.sin(ang)[:, :, None, :]
    xf = x.astype(jnp.float32)
    x1 = xf[..., :half]
    x2 = xf[..., half:ROT_DIM]
    out = jnp.concatenate([x1 * cos - x2 * sin, x2 * cos + x1 * sin, xf[..., ROT_DIM:]], axis=-1)
    return out.astype(x.dtype)


def rwkv7_group(cols, mu_shift, w0, w2, a0, a2, g2, k_k, k_a, r_k, lnx_w, lnx_b):
    B, S, _ = cols.shape
    f32 = jnp.float32
    prev = jnp.pad(cols, ((0, 0), (1, 0), (0, 0)))[:, :-1]
    cols = cols + (prev - cols) * mu_shift
    o = 0
    r = cols[..., o:o + R_WIDTH]; o += R_WIDTH
    k = cols[..., o:o + R_WIDTH]; o += R_WIDTH
    v = cols[..., o:o + R_WIDTH]; o += R_WIDTH
    w_lat = cols[..., o:o + DECAY_LORA]; o += DECAY_LORA
    a_lat = cols[..., o:o + ICLR_LORA]; o += ICLR_LORA
    g_lat = cols[..., o:o + GATE_LORA]

    w = -jax.nn.softplus(-(w0 + jnp.tanh(w_lat) @ w2).astype(f32)) - 0.5
    decay = jnp.exp(-jnp.exp(w))
    a = jax.nn.sigmoid((a0 + a_lat @ a2).astype(f32))
    g = jax.nn.sigmoid(g_lat) @ g2
    kk = (k * k_k).astype(f32)
    k_mod = k.astype(f32) * (1.0 + (a - 1.0) * k_a.astype(f32))

    heads = lambda t: t.astype(f32).reshape(B, S, R_HEADS, R_HEAD_DIM)
    kk = heads(kk)
    kk = kk / jnp.maximum(jnp.sqrt(jnp.sum(kk * kk, axis=-1, keepdims=True)), 1e-12)
    rh, kh, vh, ah, wh = heads(r), heads(k_mod), heads(v), heads(a), heads(decay)

    def step(state, inp):
        r_t, w_t, k_t, v_t, an_t, b_t = inp
        sa = jnp.einsum('bhvk,bhk->bhv', state, an_t)
        state = state * w_t[:, :, None, :] + sa[..., None] * b_t[:, :, None, :] + v_t[..., None] * k_t[:, :, None, :]
        return state, jnp.einsum('bhvk,bhk->bhv', state, r_t)

    seq_first = lambda t: jnp.moveaxis(t, 1, 0)
    state0 = jnp.zeros((B, R_HEADS, R_HEAD_DIM, R_HEAD_DIM), f32)
    xs = (seq_first(rh), seq_first(wh), seq_first(kh), seq_first(vh), seq_first(-kk), seq_first(kk * ah))
    _, y = lax.scan(step, state0, xs)
    y = jnp.moveaxis(y, 0, 1)

    mean = jnp.mean(y, axis=-1, keepdims=True)
    var = jnp.mean(jnp.square(y - mean), axis=-1, keepdims=True)
    y = ((y - mean) * lax.rsqrt(var + LNX_EPS)).reshape(B, S, R_WIDTH) * lnx_w + lnx_b
    bonus = jnp.sum(rh * kh * r_k.astype(f32), axis=-1, keepdims=True) * vh
    y = (y + bonus.reshape(B, S, R_WIDTH)) * g
    return y.astype(cols.dtype)


def compress(t, pe, w1, b1, w2):
    B, Hk, S, D = t.shape
    n_blk = S // CMP_STRIDE
    n_sub = CMP_BLOCK // CMP_STRIDE
    n_cmp = n_blk - n_sub + 1
    blocks = t.reshape(B, Hk, n_blk, CMP_STRIDE, D)
    win = jnp.concatenate([blocks[:, :, i:i + n_cmp] for i in range(n_sub)], axis=3)
    win = (win + pe).reshape(B, Hk, n_cmp, CMP_BLOCK * D)
    return jax.nn.silu(win @ w1 + b1) @ w2


def nsa_group(cols, positions, pe_k, wk1, bk1, wk2, pe_v, wv1, bv1, wv2):
    B, S, _ = cols.shape
    f32 = jnp.float32
    scale = HEAD_DIM ** -0.5
    q = partial_rope(cols[..., :N_WIDTH].reshape(B, S, N_Q_HEADS, HEAD_DIM), positions)
    q = q.reshape(B, S, N_KV_HEADS, GQA, HEAD_DIM).transpose(0, 2, 3, 1, 4)

    def kv(i, rope):
        o = N_WIDTH + i * KV_WIDTH
        t = cols[..., o:o + KV_WIDTH].reshape(B, S, N_KV_HEADS, HEAD_DIM)
        if rope:
            t = partial_rope(t, positions)
        return t.transpose(0, 2, 1, 3)

    k_cmp, v_cmp = kv(0, False), kv(1, False)
    k_slc, v_slc = kv(2, True), kv(3, True)
    k_win, v_win = kv(4, True), kv(5, True)
    gates = jax.nn.sigmoid(cols[..., N_WIDTH + 6 * KV_WIDTH:].reshape(B, S, N_KV_HEADS, GQA, 3))
    gates = gates.transpose(0, 2, 3, 1, 4)

    kc = compress(k_cmp, pe_k, wk1, bk1, wk2)
    vc = compress(v_cmp, pe_v, wv1, bv1, wv2)
    n_cmp = kc.shape[2]
    pos_c = positions[:, CMP_BLOCK - 1::CMP_STRIDE][:, :n_cmp]
    kc = partial_rope(kc.transpose(0, 2, 1, 3), pos_c).transpose(0, 2, 1, 3)
    cmp_end = jnp.arange(n_cmp) * CMP_STRIDE + CMP_BLOCK - 1

    n_sel = S // SEL_BLOCK
    n_top = min(SEL_TOPK, n_sel)
    ks_blocks = k_slc.reshape(B, N_KV_HEADS, n_sel, SEL_BLOCK, HEAD_DIM)
    vs_blocks = v_slc.reshape(B, N_KV_HEADS, n_sel, SEL_BLOCK, HEAD_DIM)
    c_start = jnp.arange(n_cmp)[:, None] * CMP_STRIDE
    s_start = jnp.arange(n_sel)[None, :] * SEL_BLOCK
    cover = ((c_start < s_start + SEL_BLOCK) & (c_start + CMP_BLOCK > s_start)).astype(f32)
    sel_ids = jnp.arange(n_sel)
    bidx = jnp.arange(B)[:, None, None, None]
    hidx = jnp.arange(N_KV_HEADS)[None, :, None, None]

    kw_pad = jnp.pad(k_win, ((0, 0), (0, 0), (WINDOW, 0), (0, 0)))
    vw_pad = jnp.pad(v_win, ((0, 0), (0, 0), (WINDOW, 0), (0, 0)))

    def q_block(qb):
        start = qb * Q_BLOCK
        t = start + jnp.arange(Q_BLOCK)
        qq = lax.dynamic_slice_in_dim(q, start, Q_BLOCK, axis=3)
        gg = lax.dynamic_slice_in_dim(gates, start, Q_BLOCK, axis=3)

        s = jnp.einsum('bkgqd,bknd->bkgqn', qq, kc).astype(f32) * scale
        valid = cmp_end[None, :] <= t[:, None]
        p = jax.nn.softmax(jnp.where(valid, s, MASK), axis=-1)
        p = jnp.where(valid, p, 0.0)
        o_cmp = jnp.einsum('bkgqn,bknd->bkgqd', p.astype(vc.dtype), vc)

        imp = jnp.sum(p, axis=2) @ cover
        cur = t // SEL_BLOCK
        forced = (sel_ids[None] == 0) | (sel_ids[None] == cur[:, None]) | (sel_ids[None] == cur[:, None] - 1)
        score = jnp.where(forced, FORCE, jnp.where(sel_ids[None] <= cur[:, None], imp, MASK))
        _, idx = lax.top_k(score, n_top)
        k_sel = ks_blocks[bidx, hidx, idx]
        v_sel = vs_blocks[bidx, hidx, idx]
        tok = idx[..., None] * SEL_BLOCK + jnp.arange(SEL_BLOCK)
        valid = (tok <= t[:, None, None])[:, :, None]
        s = jnp.einsum('bkgqd,bkqjld->bkgqjl', qq, k_sel).astype(f32) * scale
        s = jnp.where(valid, s, MASK).reshape(B, N_KV_HEADS, GQA, Q_BLOCK, n_top * SEL_BLOCK)
        p = jax.nn.softmax(s, axis=-1).reshape(B, N_KV_HEADS, GQA, Q_BLOCK, n_top, SEL_BLOCK)
        o_sel = jnp.einsum('bkgqjl,bkqjld->bkgqd', p.astype(v_sel.dtype), v_sel)

        kw = lax.dynamic_slice_in_dim(kw_pad, start, WINDOW + Q_BLOCK, axis=2)
        vw = lax.dynamic_slice_in_dim(vw_pad, start, WINDOW + Q_BLOCK, axis=2)
        kpos = start - WINDOW + jnp.arange(WINDOW + Q_BLOCK)
        valid = (kpos[None] <= t[:, None]) & (kpos[None] > t[:, None] - WINDOW) & (kpos[None] >= 0)
        s = jnp.einsum('bkgqd,bksd->bkgqs', qq, kw).astype(f32) * scale
        p = jax.nn.softmax(jnp.where(valid, s, MASK), axis=-1)
        o_win = jnp.einsum('bkgqs,bksd->bkgqd', p.astype(vw.dtype), vw)

        o = gg[..., 0:1] * o_cmp + gg[..., 1:2] * o_sel + gg[..., 2:3] * o_win
        return o.astype(cols.dtype)

    out = lax.map(q_block, jnp.arange(S // Q_BLOCK))
    out = jnp.moveaxis(out, 0, 3).reshape(B, N_KV_HEADS, GQA, S, HEAD_DIM)
    return out.transpose(0, 3, 1, 2, 4).reshape(B, S, N_WIDTH)


def swiglu(x, w_gate, w_up, w_down):
    return (jax.nn.silu(x @ w_gate) * (x @ w_up)) @ w_down


def setup_inputs(seed: int = 0) -> dict:
    key = jax.random.key(seed)
    ks = iter(jax.random.split(key, 40))
    f32 = jnp.float32
    L = DEPTH
    nrm = lambda shape, s: jax.random.normal(next(ks), shape, f32) * s
    uni = lambda shape, lo, hi: jax.random.uniform(next(ks), shape, f32, lo, hi)
    x = nrm((BATCH, SEQ, D_MODEL), 1.0)
    positions = (jax.random.randint(next(ks), (BATCH, 1), 0, 4096, jnp.int32)
                 + jnp.arange(SEQ, dtype=jnp.int32)[None, :])
    return {
        "x": x,
        "positions": positions,
        "norm_mix": 1.0 + nrm((L, D_MODEL), 0.02),
        "w_in": nrm((L, D_MODEL, IN_COLS), D_MODEL ** -0.5),
        "mu_shift": uni((L, R_COLS), 0.0, 1.0),
        "w0": uni((L, R_WIDTH), -6.0, -1.0),
        "w2": nrm((L, DECAY_LORA, R_WIDTH), 0.1),
        "a0": nrm((L, R_WIDTH), 0.1),
        "a2": nrm((L, ICLR_LORA, R_WIDTH), 0.1),
        "g2": nrm((L, GATE_LORA, R_WIDTH), GATE_LORA ** -0.5),
        "k_k": 0.85 + nrm((L, R_WIDTH), 0.05),
        "k_a": 1.0 + nrm((L, R_WIDTH), 0.05),
        "r_k": nrm((L, R_HEADS, R_HEAD_DIM), 0.1),
        "lnx_w": 1.0 + nrm((L, R_WIDTH), 0.02),
        "lnx_b": nrm((L, R_WIDTH), 0.01),
        "pe_k": nrm((L, CMP_BLOCK, HEAD_DIM), 0.1),
        "wk1": nrm((L, CMP_BLOCK * HEAD_DIM, CMP_HIDDEN), (CMP_BLOCK * HEAD_DIM) ** -0.5),
        "bk1": nrm((L, CMP_HIDDEN), 0.01),
        "wk2": nrm((L, CMP_HIDDEN, HEAD_DIM), CMP_HIDDEN ** -0.5),
        "pe_v": nrm((L, CMP_BLOCK, HEAD_DIM), 0.1),
        "wv1": nrm((L, CMP_BLOCK * HEAD_DIM, CMP_HIDDEN), (CMP_BLOCK * HEAD_DIM) ** -0.5),
        "bv1": nrm((L, CMP_HIDDEN), 0.01),
        "wv2": nrm((L, CMP_HIDDEN, HEAD_DIM), CMP_HIDDEN ** -0.5),
        "w_out": nrm((L, MIX_WIDTH, D_MODEL), MIX_WIDTH ** -0.5),
        "norm_ffn": 1.0 + nrm((L, D_MODEL), 0.02),
        "w_gate": nrm((L, D_MODEL, D_FF), D_MODEL ** -0.5),
        "w_up": nrm((L, D_MODEL, D_FF), D_MODEL ** -0.5),
        "w_down": nrm((L, D_FF, D_MODEL), D_FF ** -0.5),
        "norm_final": 1.0 + nrm((D_MODEL,), 0.02),
    }


def reference(x, positions, norm_mix, w_in, mu_shift, w0, w2, a0, a2, g2, k_k, k_a, r_k, lnx_w, lnx_b,
              pe_k, wk1, bk1, wk2, pe_v, wv1, bv1, wv2, w_out, norm_ffn, w_gate, w_up, w_down, norm_final):
    h = x
    for l in range(DEPTH):
        xn = rms_norm(h, norm_mix[l])
        proj = xn @ w_in[l]
        y_r = rwkv7_group(proj[..., :R_COLS], mu_shift[l], w0[l], w2[l], a0[l], a2[l], g2[l],
                          k_k[l], k_a[l], r_k[l], lnx_w[l], lnx_b[l])
        y_n = nsa_group(proj[..., R_COLS:], positions, pe_k[l], wk1[l], bk1[l], wk2[l],
                        pe_v[l], wv1[l], bv1[l], wv2[l])
        h = h + jnp.concatenate([y_r, y_n], axis=-1) @ w_out[l]
        h = h + swiglu(rms_norm(h, norm_ffn[l]), w_gate[l], w_up[l], w_down[l])
    return rms_norm(h, norm_final)
```

```cpp
#include <hip/hip_runtime.h>
#include <hip/hip_cooperative_groups.h>
#include <cstdio>
namespace cg = cooperative_groups;

#ifndef MK_SINGLE
#define MK_SINGLE 1
#endif

#define DI __device__ __forceinline__
typedef unsigned short bf16_t;
typedef short bf16x8 __attribute__((ext_vector_type(8)));
typedef float f32x16 __attribute__((ext_vector_type(16)));
typedef __bf16 bf2_t __attribute__((ext_vector_type(2)));
typedef float f2_t __attribute__((ext_vector_type(2)));

constexpr int T_ = 32768, S_ = 16384;
constexpr int PLD = 3200;
constexpr int QC = 1856, KVC = 2368, GC = 3136;
constexpr int DFF = 2816;
constexpr int NTHR = 256;

#define MFMA32(a, b, c) __builtin_amdgcn_mfma_f32_32x32x16_bf16((a), (b), (c), 0, 0, 0)

DI unsigned pack2(float a, float b) { f2_t v = {a, b}; return __builtin_bit_cast(unsigned, __builtin_convertvector(v, bf2_t)); }
DI float bflo(unsigned u) { return __uint_as_float(u << 16); }
DI float bfhi(unsigned u) { return __uint_as_float(u & 0xffff0000u); }
DI bf16_t f2bf(float a) { return (bf16_t)(pack2(a, 0.f) & 0xffffu); }
DI void unpack8(const uint4& u, float (&f)[8]) {
    f[0] = bflo(u.x); f[1] = bfhi(u.x); f[2] = bflo(u.y); f[3] = bfhi(u.y);
    f[4] = bflo(u.z); f[5] = bfhi(u.z); f[6] = bflo(u.w); f[7] = bfhi(u.w);
}
DI uint4 pack8(const float (&f)[8]) { uint4 u; u.x = pack2(f[0], f[1]); u.y = pack2(f[2], f[3]); u.z = pack2(f[4], f[5]); u.w = pack2(f[6], f[7]); return u; }
DI float wave_sum(float v) {
#pragma unroll
    for (int o = 32; o; o >>= 1) v += __shfl_xor(v, o);
    return v;
}
DI float sigmoidf_(float x) { return 1.f / (1.f + __expf(-x)); }
DI int crow(int reg, int h) { return (reg & 3) + 8 * (reg >> 2) + 4 * h; }

struct P {
    const float* x; const int* pos; const float *norm_mix, *w_in, *mu, *w0, *w2, *a0, *a2, *g2, *k_k, *k_a, *r_k, *lnx_w, *lnx_b,
        *pe_k, *wk1, *bk1, *wk2, *pe_v, *wv1, *bv1, *wv2, *w_out, *norm_ffn, *w_gate, *w_up, *w_down, *norm_final;
    float* out;
    bf16_t *WinT, *WoutT, *WguT, *WdnT, *w2T, *a2T, *g2T, *w1T, *wc2T;
    float *b1p, *cosT, *sinT;
    unsigned* counter;
    bf16_t *A, *proj, *stream;
    bf16_t* gbuf; float* yraw; bf16_t *vT, *hid, *kc, *vcT;
};

DI float tr_val(const P& p, int job, int k, int n) {
    switch (job) {
    case 0: { int c = n < 1824 ? n : ((n >= 1856 && n < 3160) ? n - 32 : -1); return c >= 0 ? p.w_in[(size_t)k * 3128 + c] : 0.f; }
    case 1: return p.w_out[k * 1024 + n];
    case 2: { int q = n >> 6, r = n & 63; return r < 32 ? p.w_gate[(size_t)k * DFF + q * 32 + r] : p.w_up[(size_t)k * DFF + q * 32 + r - 32]; }
    case 3: return p.w_down[(size_t)k * 1024 + n];
    case 4: return p.w2[k * 512 + n];
    case 5: return p.a2[k * 512 + n];
    case 6: return p.g2[k * 512 + n];
    case 7: return p.wk1[k * 256 + n];
    case 8: return p.wv1[k * 256 + n];
    case 9: return n < 64 ? p.wk2[k * 64 + n] : 0.f;
    default: return n < 64 ? p.wv2[k * 64 + n] : 0.f;
    }
}
DI void tr_item(const P& p, int it, float* tile) {
    int job, K, N; bf16_t* dst;
    if (it < 800) { job = 0; K = 1024; N = 3200; dst = p.WinT; }
    else if (it < 1056) { job = 1; it -= 800; K = 1024; N = 1024; dst = p.WoutT; }
    else if (it < 2464) { job = 2; it -= 1056; K = 1024; N = 5632; dst = p.WguT; }
    else if (it < 3168) { job = 3; it -= 2464; K = 2816; N = 1024; dst = p.WdnT; }
    else if (it < 3176) { job = 4; it -= 3168; K = 64; N = 512; dst = p.w2T; }
    else if (it < 3184) { job = 5; it -= 3176; K = 64; N = 512; dst = p.a2T; }
    else if (it < 3208) { job = 6; it -= 3184; K = 160; N = 512; dst = p.g2T; }
    else if (it < 3336) { job = 7; it -= 3208; K = 2048; N = 256; dst = p.w1T; }
    else if (it < 3464) { job = 8; it -= 3336; K = 2048; N = 256; dst = p.w1T + 256 * 2048; }
    else if (it < 3472) { job = 9; it -= 3464; K = 256; N = 128; dst = p.wc2T; }
    else { job = 10; it -= 3472; K = 256; N = 128; dst = p.wc2T + 128 * 256; }
    const int nt = N >> 6;
    const int k0 = (it / nt) * 64, n0 = (it % nt) * 64;
    const int tid = threadIdx.x;
    __syncthreads();
#pragma unroll 4
    for (int i = 0; i < 16; ++i) {
        const int kk = i * 4 + (tid >> 6), nn = tid & 63;
        tile[kk * 65 + nn] = (k0 + kk < K) ? tr_val(p, job, k0 + kk, n0 + nn) : 0.f;
    }
    __syncthreads();
#pragma unroll 4
    for (int i = 0; i < 16; ++i) {
        const int nn = i * 4 + (tid >> 6), kk = tid & 63;
        if (k0 + kk < K) dst[(size_t)(n0 + nn) * K + k0 + kk] = f2bf(tile[kk * 65 + nn]);
    }
}
DI void b1_item(const P& p, int idx) {
    const int kv = idx >> 4, jc = idx & 15, tid = threadIdx.x;
    const float* pe = kv ? p.pe_v : p.pe_k; const float* w1 = kv ? p.wv1 : p.wk1; const float* b1 = kv ? p.bv1 : p.bk1;
    const int j = jc * 16 + (tid >> 4), kl = tid & 15;
    float s = 0.f;
    for (int i = 0; i < 128; ++i) { const int k = kl + 16 * i; s += pe[k] * w1[k * 256 + j]; }
    s += __shfl_xor(s, 1); s += __shfl_xor(s, 2); s += __shfl_xor(s, 4); s += __shfl_xor(s, 8);
    if (kl == 0) p.b1p[kv * 256 + j] = b1[j] + s;
}
DI void sincos_d(float ang, float& c, float& s) {
    double x = (double)ang;
    const double TWO_PI = 6.283185307179586476925286766559;
    double n = __builtin_rint(x * (1.0 / TWO_PI));
    double r = x - n * TWO_PI;
    double q = r * 0.25;
    double q2 = q * q;
    double sn = q * (1.0 + q2 * (-1.0 / 6 + q2 * (1.0 / 120 + q2 * (-1.0 / 5040 + q2 * (1.0 / 362880 + q2 * (-1.0 / 39916800 + q2 * (1.0 / 6227020800.0)))))));
    double cs = 1.0 + q2 * (-0.5 + q2 * (1.0 / 24 + q2 * (-1.0 / 720 + q2 * (1.0 / 40320 + q2 * (-1.0 / 3628800 + q2 * (1.0 / 479001600.0))))));
    double s2 = 2 * sn * cs, c2 = 1 - 2 * sn * sn;
    double s4 = 2 * s2 * c2, c4 = 1 - 2 * s2 * s2;
    c = (float)c4; s = (float)s4;
}
DI void cs_item(const P& p, int idx) {
    const int e = idx * 256 + threadIdx.x, tok = e >> 3, f = e & 7;
    const float invf[8] = {1.000000000e+00f, 1.939227432e-01f, 3.760603070e-02f, 7.292664610e-03f, 1.414213562e-03f, 2.742481884e-04f, 5.318295734e-05f, 1.031338525e-05f};
    float iv = invf[0];
#pragma unroll
    for (int i = 1; i < 8; ++i) iv = (f == i) ? invf[i] : iv;
    const float ang = (float)p.pos[tok] * iv;
    float c, s; sincos_d(ang, c, s);
    p.cosT[e] = c; p.sinT[e] = s;
}
DI void rms_item(const float* src, const float* g, bf16_t* dst, int idx) {
    const int row = idx * 4 + (threadIdx.x >> 6), lane = threadIdx.x & 63;
    const float4* sp = (const float4*)(src + (size_t)row * 1024);
    float4 v[4]; float ss = 0.f;
#pragma unroll
    for (int i = 0; i < 4; ++i) { v[i] = sp[lane + 64 * i]; ss += v[i].x * v[i].x + v[i].y * v[i].y + v[i].z * v[i].z + v[i].w * v[i].w; }
    ss = wave_sum(ss);
    const float rs = rsqrtf(ss * (1.f / 1024.f) + 1e-6f);
#pragma unroll
    for (int i = 0; i < 4; ++i) {
        const float4 gv = ((const float4*)g)[lane + 64 * i];
        uint2 o; o.x = pack2(v[i].x * rs * gv.x, v[i].y * rs * gv.y); o.y = pack2(v[i].z * rs * gv.z, v[i].w * rs * gv.w);
        *(uint2*)(dst + (size_t)row * 1024 + (lane + 64 * i) * 4) = o;
    }
}
DI void phase0(const P& p, char* smem) {
    if (blockIdx.x == 0 && threadIdx.x == 0) *p.counter = 0u;
    constexpr int NTR = 3480, NB1 = 32, NCS = 1024, NXN = 8192;
    for (int it = blockIdx.x; it < NTR + NB1 + NCS + NXN; it += gridDim.x) {
        if (it < NTR) tr_item(p, it, (float*)smem);
        else if (it < NTR + NB1) b1_item(p, it - NTR);
        else if (it < NTR + NB1 + NCS) cs_item(p, it - NTR - NB1);
        else rms_item(p.x, p.norm_mix, p.A, it - NTR - NB1 - NCS);
    }
}

struct AFPlain { const bf16_t* A; int lda; DI uint4 load(int row, int k) const { return *(const uint4*)(A + (size_t)row * lda + k); } };
struct AFCmp {
    const bf16_t* base;
    DI uint4 load(int r, int k) const { int tok = 16 * r + (k >> 6); tok = tok < S_ ? tok : S_ - 1; return *(const uint4*)(base + (size_t)tok * PLD + (k & 63)); }
};

template <class AF, class EPI>
DI void gemm_tile(const AF af, const bf16_t* __restrict__ Bt, const int K, const int m0, const int n0, const EPI epi, char* smem) {
    bf16_t* sA = (bf16_t*)smem; bf16_t* sB = sA + 128 * 72;
    const int tid = threadIdx.x, wave = tid >> 6, lane = tid & 63, wm = wave >> 1, wn = wave & 1, rr = lane & 31, hh = lane >> 5;
    f32x16 acc[2][2];
#pragma unroll
    for (int a = 0; a < 2; ++a)
#pragma unroll
        for (int b = 0; b < 2; ++b)
#pragma unroll
            for (int i = 0; i < 16; ++i) acc[a][b][i] = 0.f;
    const int lrow = tid >> 3, lk = (tid & 7) * 8;
#define GLOAD(KO) \
    ra0 = af.load(m0 + lrow, (KO) + lk); ra1 = af.load(m0 + lrow + 32, (KO) + lk); ra2 = af.load(m0 + lrow + 64, (KO) + lk); ra3 = af.load(m0 + lrow + 96, (KO) + lk); \
    rb0 = *(const uint4*)(Bt + (size_t)(lrow) * K + (KO) + lk); rb1 = *(const uint4*)(Bt + (size_t)(lrow + 32) * K + (KO) + lk); \
    rb2 = *(const uint4*)(Bt + (size_t)(lrow + 64) * K + (KO) + lk); rb3 = *(const uint4*)(Bt + (size_t)(lrow + 96) * K + (KO) + lk);
    uint4 ra0, ra1, ra2, ra3, rb0, rb1, rb2, rb3;
    GLOAD(0)
#pragma unroll 1
    for (int k0 = 0; k0 < K; k0 += 64) {
        __syncthreads();
        *(uint4*)&sA[(lrow) * 72 + lk] = ra0; *(uint4*)&sA[(lrow + 32) * 72 + lk] = ra1; *(uint4*)&sA[(lrow + 64) * 72 + lk] = ra2; *(uint4*)&sA[(lrow + 96) * 72 + lk] = ra3;
        *(uint4*)&sB[(lrow) * 72 + lk] = rb0; *(uint4*)&sB[(lrow + 32) * 72 + lk] = rb1; *(uint4*)&sB[(lrow + 64) * 72 + lk] = rb2; *(uint4*)&sB[(lrow + 96) * 72 + lk] = rb3;
        __syncthreads();
        if (k0 + 64 < K) { GLOAD(k0 + 64) }
#pragma unroll
        for (int ks = 0; ks < 4; ++ks) {
            bf16x8 tf[2], wf[2];
#pragma unroll
            for (int t = 0; t < 2; ++t) tf[t] = *(const bf16x8*)&sA[(wm * 64 + t * 32 + rr) * 72 + ks * 16 + hh * 8];
#pragma unroll
            for (int w = 0; w < 2; ++w) wf[w] = *(const bf16x8*)&sB[(wn * 64 + w * 32 + rr) * 72 + ks * 16 + hh * 8];
#pragma unroll
            for (int w = 0; w < 2; ++w)
#pragma unroll
                for (int t = 0; t < 2; ++t) acc[w][t] = MFMA32(wf[w], tf[t], acc[w][t]);
        }
    }
#undef GLOAD
    epi(acc, m0 + wm * 64, n0 + wn * 64, lane);
}

struct EpiProj {
    bf16_t* C;
    DI void operator()(const f32x16 (&acc)[2][2], int rowbase, int colbase, int lane) const {
        const int rr = lane & 31, hh = lane >> 5;
#pragma unroll
        for (int w = 0; w < 2; ++w)
#pragma unroll
            for (int t = 0; t < 2; ++t)
#pragma unroll
                for (int j = 0; j < 4; ++j) {
                    uint2 o; o.x = pack2(acc[w][t][4 * j], acc[w][t][4 * j + 1]); o.y = pack2(acc[w][t][4 * j + 2], acc[w][t][4 * j + 3]);
                    *(uint2*)(C + (size_t)(rowbase + t * 32 + rr) * PLD + colbase + w * 32 + j * 8 + hh * 4) = o;
                }
    }
};
struct EpiHid {
    bf16_t* H; const float* bias;
    DI void operator()(const f32x16 (&acc)[2][2], int rowbase, int colbase, int lane) const {
        const int rr = lane & 31, hh = lane >> 5;
#pragma unroll
        for (int w = 0; w < 2; ++w)
#pragma unroll
            for (int t = 0; t < 2; ++t)
#pragma unroll
                for (int j = 0; j < 4; ++j) {
                    const int col = colbase + w * 32 + j * 8 + hh * 4;
                    const float4 bv = *(const float4*)(bias + col);
                    float v0 = acc[w][t][4 * j] + bv.x, v1 = acc[w][t][4 * j + 1] + bv.y, v2 = acc[w][t][4 * j + 2] + bv.z, v3 = acc[w][t][4 * j + 3] + bv.w;
                    v0 *= sigmoidf_(v0); v1 *= sigmoidf_(v1); v2 *= sigmoidf_(v2); v3 *= sigmoidf_(v3);
                    uint2 o; o.x = pack2(v0, v1); o.y = pack2(v2, v3);
                    *(uint2*)(H + (size_t)(rowbase + t * 32 + rr) * 256 + col) = o;
                }
    }
};
struct EpiKc {
    bf16_t* kc; const float *cosT, *sinT; int tokbase;
    DI void operator()(const f32x16 (&acc)[2][2], int rowbase, int colbase, int lane) const {
        if (colbase != 0) return;
        const int rr = lane & 31, hh = lane >> 5;
#pragma unroll
        for (int t = 0; t < 2; ++t) {
            const int r = rowbase + t * 32 + rr;
            int tk = 31 + 16 * r; tk = tk < S_ ? tk : S_ - 1;
            const float4 c = *(const float4*)(cosT + (size_t)(tokbase + tk) * 8 + hh * 4), s = *(const float4*)(sinT + (size_t)(tokbase + tk) * 8 + hh * 4);
            bf16_t* kp = kc + (size_t)r * 64 + hh * 4;
            const float a0 = acc[0][t][0], a1 = acc[0][t][1], a2 = acc[0][t][2], a3 = acc[0][t][3];
            const float b0 = acc[0][t][4], b1 = acc[0][t][5], b2 = acc[0][t][6], b3 = acc[0][t][7];
            uint2 o;
            o.x = pack2(a0 * c.x - b0 * s.x, a1 * c.y - b1 * s.y); o.y = pack2(a2 * c.z - b2 * s.z, a3 * c.w - b3 * s.w);
            *(uint2*)(kp) = o;
            o.x = pack2(b0 * c.x + a0 * s.x, b1 * c.y + a1 * s.y); o.y = pack2(b2 * c.z + a2 * s.z, b3 * c.w + a3 * s.w);
            *(uint2*)(kp + 8) = o;
#pragma unroll
            for (int j = 2; j < 4; ++j) {
                o.x = pack2(acc[0][t][4 * j], acc[0][t][4 * j + 1]); o.y = pack2(acc[0][t][4 * j + 2], acc[0][t][4 * j + 3]);
                *(uint2*)(kp + j * 8) = o;
            }
#pragma unroll
            for (int j = 0; j < 4; ++j) {
                o.x = pack2(acc[1][t][4 * j], acc[1][t][4 * j + 1]); o.y = pack2(acc[1][t][4 * j + 2], acc[1][t][4 * j + 3]);
                *(uint2*)(kp + 32 + j * 8) = o;
            }
        }
    }
};
struct EpiVc {
    bf16_t* vcT; char* smem;
    DI void operator()(const f32x16 (&acc)[2][2], int rowbase, int colbase, int lane) const {
        const int rr = lane & 31, hh = lane >> 5;
        bf16_t* tl = (bf16_t*)smem;
        __syncthreads();
        if (colbase == 0) {
            const int rl = rowbase & 127;
#pragma unroll
            for (int w = 0; w < 2; ++w)
#pragma unroll
                for (int t = 0; t < 2; ++t)
#pragma unroll
                    for (int i = 0; i < 16; ++i) tl[(w * 32 + crow(i, hh)) * 136 + rl + t * 32 + rr] = f2bf(acc[w][t][i]);
        }
        __syncthreads();
        const int m0 = rowbase & ~127;
#pragma unroll
        for (int i = 0; i < 4; ++i) {
            const int c = threadIdx.x + i * 256, d = c >> 4, ch = c & 15;
            *(uint4*)(vcT + (size_t)d * 1024 + m0 + ch * 8) = *(const uint4*)&tl[d * 136 + ch * 8];
        }
    }
};
struct EpiOut {
    float* out; const float* x;
    DI void operator()(const f32x16 (&acc)[2][2], int rowbase, int colbase, int lane) const {
        const int rr = lane & 31, hh = lane >> 5;
#pragma unroll
        for (int w = 0; w < 2; ++w)
#pragma unroll
            for (int t = 0; t < 2; ++t)
#pragma unroll
                for (int j = 0; j < 4; ++j) {
                    const size_t o = (size_t)(rowbase + t * 32 + rr) * 1024 + colbase + w * 32 + j * 8 + hh * 4;
                    float4 xv = *(const float4*)(x + o);
                    xv.x += acc[w][t][4 * j]; xv.y += acc[w][t][4 * j + 1]; xv.z += acc[w][t][4 * j + 2]; xv.w += acc[w][t][4 * j + 3];
                    *(float4*)(out + o) = xv;
                }
    }
};
struct EpiFfn1 {
    bf16_t* act;
    DI void operator()(const f32x16 (&acc)[2][2], int rowbase, int colbase, int lane) const {
        const int rr = lane & 31, hh = lane >> 5;
        const int cb = (colbase >> 6) * 32;
#pragma unroll
        for (int t = 0; t < 2; ++t)
#pragma unroll
            for (int j = 0; j < 4; ++j) {
                float v[4];
#pragma unroll
                for (int i = 0; i < 4; ++i) { const float g = acc[0][t][4 * j + i], u = acc[1][t][4 * j + i]; v[i] = g * sigmoidf_(g) * u; }
                uint2 o; o.x = pack2(v[0], v[1]); o.y = pack2(v[2], v[3]);
                *(uint2*)(act + (size_t)(rowbase + t * 32 + rr) * DFF + cb + j * 8 + hh * 4) = o;
            }
    }
};

DI void rwkv_prep(const P& p, int idx, char* smem) {
    const int tile = idx >> 3, h = idx & 7, tt0 = tile * 32;
    const int tid = threadIdx.x, wave = tid >> 6, lane = tid & 63, rr = lane & 31, hh = lane >> 5;
    bf16_t* lat = (bf16_t*)smem;
    float* res = (float*)(smem + 32 * 296 * 2);
    __syncthreads();
    for (int c = tid; c < 32 * 36; c += NTHR) {
        const int tok = c / 36, ch = c - tok * 36, gi = tt0 + tok, col = 1536 + ch * 8;
        const uint4 cu = *(const uint4*)(p.proj + (size_t)gi * PLD + col);
        uint4 pv = make_uint4(0, 0, 0, 0);
        if ((gi & (S_ - 1)) != 0) pv = *(const uint4*)(p.proj + (size_t)(gi - 1) * PLD + col);
        float a[8], b[8]; unpack8(cu, a); unpack8(pv, b);
        const float4 m0 = *(const float4*)(p.mu + col), m1 = *(const float4*)(p.mu + col + 4);
        const float mu[8] = {m0.x, m0.y, m0.z, m0.w, m1.x, m1.y, m1.z, m1.w};
#pragma unroll
        for (int e = 0; e < 8; ++e) {
            float x = a[e] + (b[e] - a[e]) * mu[e];
            if (ch < 8) x = tanhf(x); else if (ch >= 16) x = sigmoidf_(x);
            a[e] = x;
        }
        *(uint4*)&lat[tok * 296 + ch * 8] = pack8(a);
    }
    __syncthreads();
    if (wave < 2) {
        const int mt = wave;
        f32x16 aw, aa;
#pragma unroll
        for (int i = 0; i < 16; ++i) { aw[i] = 0.f; aa[i] = 0.f; }
#pragma unroll
        for (int ks = 0; ks < 4; ++ks) {
            const bf16x8 wf = *(const bf16x8*)(p.w2T + (size_t)(h * 64 + mt * 32 + rr) * 64 + ks * 16 + hh * 8);
            const bf16x8 af = *(const bf16x8*)(p.a2T + (size_t)(h * 64 + mt * 32 + rr) * 64 + ks * 16 + hh * 8);
            const bf16x8 l0 = *(const bf16x8*)&lat[rr * 296 + ks * 16 + hh * 8];
            const bf16x8 l1 = *(const bf16x8*)&lat[rr * 296 + 64 + ks * 16 + hh * 8];
            aw = MFMA32(wf, l0, aw); aa = MFMA32(af, l1, aa);
        }
#pragma unroll
        for (int j = 0; j < 4; ++j) {
            *(float4*)&res[(0 * 32 + rr) * 64 + mt * 32 + j * 8 + hh * 4] = make_float4(aw[4 * j], aw[4 * j + 1], aw[4 * j + 2], aw[4 * j + 3]);
            *(float4*)&res[(1 * 32 + rr) * 64 + mt * 32 + j * 8 + hh * 4] = make_float4(aa[4 * j], aa[4 * j + 1], aa[4 * j + 2], aa[4 * j + 3]);
        }
    } else {
        const int mt = wave - 2;
        f32x16 ag;
#pragma unroll
        for (int i = 0; i < 16; ++i) ag[i] = 0.f;
#pragma unroll
        for (int ks = 0; ks < 10; ++ks) {
            const bf16x8 gf = *(const bf16x8*)(p.g2T + (size_t)(h * 64 + mt * 32 + rr) * 160 + ks * 16 + hh * 8);
            const bf16x8 l2 = *(const bf16x8*)&lat[rr * 296 + 128 + ks * 16 + hh * 8];
            ag = MFMA32(gf, l2, ag);
        }
#pragma unroll
        for (int j = 0; j < 4; ++j)
            *(float4*)&res[(2 * 32 + rr) * 64 + mt * 32 + j * 8 + hh * 4] = make_float4(ag[4 * j], ag[4 * j + 1], ag[4 * j + 2], ag[4 * j + 3]);
    }
    __syncthreads();
    {
        const int tok = tid >> 3, cgp = tid & 7, gi = tt0 + tok, b = gi >> 14, s = gi & (S_ - 1), cb = h * 64 + cgp * 8;
        const bool first = (s == 0);
        float r[8], k[8], v[8];
        {
            float a[8], pb[8];
            const bf16_t* pr = p.proj + (size_t)gi * PLD;
#pragma unroll
            for (int q = 0; q < 3; ++q) {
                const int col = q * 512 + cb;
                unpack8(*(const uint4*)(pr + col), a);
                if (first) {
#pragma unroll
                    for (int e = 0; e < 8; ++e) pb[e] = 0.f;
                } else unpack8(*(const uint4*)(pr - PLD + col), pb);
                const float4 m0 = *(const float4*)(p.mu + col), m1 = *(const float4*)(p.mu + col + 4);
                const float mu[8] = {m0.x, m0.y, m0.z, m0.w, m1.x, m1.y, m1.z, m1.w};
#pragma unroll
                for (int e = 0; e < 8; ++e) {
                    const float x = a[e] + (pb[e] - a[e]) * mu[e];
                    if (q == 0) r[e] = x; else if (q == 1) k[e] = x; else v[e] = x;
                }
            }
        }
        float om[8], av[8], gg[8], kk[8], km[8], bb[8];
        float ss = 0.f;
#pragma unroll
        for (int e = 0; e < 8; ++e) {
            const float wp = res[(0 * 32 + tok) * 64 + cgp * 8 + e] + p.w0[cb + e];
            const float z = -wp;
            const float sp = fmaxf(z, 0.f) + log1pf(__expf(-fabsf(z)));
            const float w = -sp - 0.5f;
            om[e] = -expm1f(-__expf(w));
            av[e] = sigmoidf_(res[(1 * 32 + tok) * 64 + cgp * 8 + e] + p.a0[cb + e]);
            gg[e] = res[(2 * 32 + tok) * 64 + cgp * 8 + e];
            kk[e] = k[e] * p.k_k[cb + e];
            ss += kk[e] * kk[e];
            km[e] = k[e] * (1.f + (av[e] - 1.f) * p.k_a[cb + e]);
        }
        ss += __shfl_xor(ss, 1); ss += __shfl_xor(ss, 2); ss += __shfl_xor(ss, 4);
        const float inv = 1.f / fmaxf(sqrtf(ss), 1e-12f);
#pragma unroll
        for (int e = 0; e < 8; ++e) { kk[e] *= inv; bb[e] = kk[e] * av[e]; }
        bf16_t* sp = p.stream + ((size_t)((b * 8 + h) * S_ + s) * 6) * 64 + cgp * 8;
        *(uint4*)(sp) = pack8(om); *(uint4*)(sp + 64) = pack8(km); *(uint4*)(sp + 128) = pack8(kk);
        *(uint4*)(sp + 192) = pack8(bb); *(uint4*)(sp + 256) = pack8(r); *(uint4*)(sp + 320) = pack8(v);
        *(uint4*)(p.gbuf + (size_t)gi * 512 + cb) = pack8(gg);
    }
}

DI void rope_item(const P& p, int idx, char* smem) {
    const int tt0 = idx * 64, tid = threadIdx.x;
    bf16_t* vtile = (bf16_t*)smem;
    __syncthreads();
#pragma unroll 1
    for (int it = 0; it < 2; ++it) {
        const int item = tid + it * 256, tok = item >> 3, head = item & 7, gi = tt0 + tok;
        bf16_t* ptr = p.proj + (size_t)gi * PLD + QC + head * 64;
        const float4 c0 = *(const float4*)(p.cosT + (size_t)gi * 8), c1 = *(const float4*)(p.cosT + (size_t)gi * 8 + 4);
        const float4 s0 = *(const float4*)(p.sinT + (size_t)gi * 8), s1 = *(const float4*)(p.sinT + (size_t)gi * 8 + 4);
        const float cc[8] = {c0.x, c0.y, c0.z, c0.w, c1.x, c1.y, c1.z, c1.w}, sn[8] = {s0.x, s0.y, s0.z, s0.w, s1.x, s1.y, s1.z, s1.w};
        float a[8], b[8];
        unpack8(*(const uint4*)ptr, a); unpack8(*(const uint4*)(ptr + 8), b);
#pragma unroll
        for (int e = 0; e < 8; ++e) { const float x1 = a[e], x2 = b[e]; a[e] = (x1 * cc[e] - x2 * sn[e]) * 0.125f; b[e] = (x2 * cc[e] + x1 * sn[e]) * 0.125f; }
        *(uint4*)ptr = pack8(a); *(uint4*)(ptr + 8) = pack8(b);
#pragma unroll
        for (int q = 2; q < 8; ++q) {
            unpack8(*(const uint4*)(ptr + q * 8), a);
#pragma unroll
            for (int e = 0; e < 8; ++e) a[e] *= 0.125f;
            *(uint4*)(ptr + q * 8) = pack8(a);
        }
    }
    {
        const int tok = tid >> 2, sel = (tid >> 1) & 1, hk = tid & 1, gi = tt0 + tok;
        const float4 c0 = *(const float4*)(p.cosT + (size_t)gi * 8), c1 = *(const float4*)(p.cosT + (size_t)gi * 8 + 4);
        const float4 s0 = *(const float4*)(p.sinT + (size_t)gi * 8), s1 = *(const float4*)(p.sinT + (size_t)gi * 8 + 4);
        const float cc[8] = {c0.x, c0.y, c0.z, c0.w, c1.x, c1.y, c1.z, c1.w}, sn[8] = {s0.x, s0.y, s0.z, s0.w, s1.x, s1.y, s1.z, s1.w};
        float a[8], b[8];
        {
            bf16_t* ptr = p.proj + (size_t)gi * PLD + KVC + (sel ? 4 : 2) * 128 + hk * 64;
            unpack8(*(const uint4*)ptr, a); unpack8(*(const uint4*)(ptr + 8), b);
#pragma unroll
            for (int e = 0; e < 8; ++e) { const float x1 = a[e], x2 = b[e]; a[e] = x1 * cc[e] - x2 * sn[e]; b[e] = x2 * cc[e] + x1 * sn[e]; }
            *(uint4*)ptr = pack8(a); *(uint4*)(ptr + 8) = pack8(b);
        }
        {
            const bf16_t* ptr = p.proj + (size_t)gi * PLD + KVC + (sel ? 5 : 3) * 128 + hk * 64;
            bf16_t* vt = vtile + (size_t)((sel * 2 + hk) * 64) * 72 + tok;
            unpack8(*(const uint4*)ptr, a); unpack8(*(const uint4*)(ptr + 8), b);
#pragma unroll
            for (int e = 0; e < 8; ++e) { const float x1 = a[e], x2 = b[e]; a[e] = x1 * cc[e] - x2 * sn[e]; b[e] = x2 * cc[e] + x1 * sn[e]; }
#pragma unroll
            for (int e = 0; e < 8; ++e) { vt[e * 72] = f2bf(a[e]); vt[(8 + e) * 72] = f2bf(b[e]); }
#pragma unroll
            for (int q = 2; q < 8; ++q) {
                const uint4 u = *(const uint4*)(ptr + q * 8);
                const unsigned w[4] = {u.x, u.y, u.z, u.w};
#pragma unroll
                for (int e = 0; e < 4; ++e) { vt[(q * 8 + 2 * e) * 72] = (bf16_t)(w[e] & 0xffffu); vt[(q * 8 + 2 * e + 1) * 72] = (bf16_t)(w[e] >> 16); }
            }
        }
    }
    __syncthreads();
    const int b = tt0 >> 14, s0 = tt0 & (S_ - 1);
#pragma unroll
    for (int i = 0; i < 8; ++i) {
        const int c = tid + i * 256, grp = c >> 9, d = (c >> 3) & 63, ch = c & 7, sel = grp >> 1, hk = grp & 1;
        const uint4 u = *(const uint4*)&vtile[(size_t)(grp * 64 + d) * 72 + ch * 8];
        *(uint4*)(p.vT + ((size_t)((sel * 4 + b * 2 + hk) * 64 + d)) * S_ + s0 + ch * 8) = u;
    }
}

DI void phase2(const P& p, char* smem) {
    for (int it = blockIdx.x; it < 128 + 512 + 8192; it += gridDim.x) {
        if (it < 128) {
            const int kv = it >> 6, bhk = (it >> 4) & 3, mt = (it >> 1) & 7, nt = it & 1, b = bhk >> 1, hk = bhk & 1;
            AFCmp af{p.proj + (size_t)(b * S_) * PLD + KVC + kv * 128 + hk * 64};
            EpiHid ep{p.hid + (size_t)((kv * 4 + bhk) * 1024) * 256, p.b1p + kv * 256};
            gemm_tile(af, p.w1T + (size_t)(kv * 256 + nt * 128) * 2048, 2048, mt * 128, nt * 128, ep, smem);
        } else if (it < 640) rope_item(p, it - 128, smem);
        else rwkv_prep(p, it - 640, smem);
    }
}
DI void phase3(const P& p, char* smem) {
    for (int it = blockIdx.x; it < 64; it += gridDim.x) {
        const int kv = it >> 5, bhk = (it >> 3) & 3, mt = it & 7, b = bhk >> 1;
        AFPlain af{p.hid + (size_t)((kv * 4 + bhk) * 1024) * 256, 256};
        if (kv == 0) { EpiKc ep{p.kc + (size_t)bhk * 1024 * 64, p.cosT, p.sinT, b * S_}; gemm_tile(af, p.wc2T, 256, mt * 128, 0, ep, smem); }
        else { EpiVc ep{p.vcT + (size_t)bhk * 64 * 1024, smem}; gemm_tile(af, p.wc2T + 128 * 256, 256, mt * 128, 0, ep, smem); }
    }
}

template <int CTRL> DI float dpp_add(float x) { return x + __int_as_float(__builtin_amdgcn_mov_dpp(__float_as_int(x), CTRL, 0xF, 0xF, true)); }
DI float red16(float x) { x = dpp_add<0xB1>(x); x = dpp_add<0x4E>(x); x = dpp_add<0x141>(x); x = dpp_add<0x140>(x); return x; }

DI void scan_unit(const P& p, int su, char* smem) {
    const int xcd = su & 7, kq = su >> 3, bh = xcd * 2 + (kq >> 3), oct = kq & 7, b = bh >> 3, h = bh & 7;
    const int tid = threadIdx.x, wave = tid >> 6, lane = tid & 63;
    float* buf = (float*)smem;
    const bf16_t* sbase = p.stream + (size_t)bh * S_ * 384;
    uint4 rg[3];
    __syncthreads();
#pragma unroll
    for (int i = 0; i < 3; ++i) rg[i] = *(const uint4*)(sbase + (size_t)(tid + i * 256) * 8);
#pragma unroll
    for (int i = 0; i < 3; ++i) {
        const int ci = tid + i * 256; float f[8]; unpack8(rg[i], f);
        if ((ci % 48) < 8) {
#pragma unroll
            for (int e = 0; e < 8; ++e) f[e] = 1.f - f[e];
        }
        float* d = buf + ci * 8;
        *(float4*)d = make_float4(f[0], f[1], f[2], f[3]); *(float4*)(d + 4) = make_float4(f[4], f[5], f[6], f[7]);
    }
    __syncthreads();
    const int rl = lane >> 4, ks = lane & 15, row = oct * 8 + wave * 4 + rl;
    float s0 = 0.f, s1 = 0.f, s2 = 0.f, s3 = 0.f;
    float* yout = p.yraw + (size_t)(b * S_) * 512 + h * 64 + row;
    for (int c = 0; c < 1024; ++c) {
        if (c + 1 < 1024) {
#pragma unroll
            for (int i = 0; i < 3; ++i) rg[i] = *(const uint4*)(sbase + (size_t)(c + 1) * 6144 + (size_t)(tid + i * 256) * 8);
        }
        if (wave < 2) {
            const float* cb = buf + (c & 1) * 6144;
#pragma unroll 4
            for (int st = 0; st < 16; ++st) {
                const float* rec = cb + st * 384;
                const float4 dec = *(const float4*)(rec + ks * 4), km = *(const float4*)(rec + 64 + ks * 4), kk = *(const float4*)(rec + 128 + ks * 4),
                             bb = *(const float4*)(rec + 192 + ks * 4), rv = *(const float4*)(rec + 256 + ks * 4);
                const float v = rec[320 + row];
                float sa = (s0 * kk.x + s1 * kk.y) + (s2 * kk.z + s3 * kk.w);
                sa = red16(sa);
                s0 = s0 * dec.x + v * km.x - sa * bb.x; s1 = s1 * dec.y + v * km.y - sa * bb.y;
                s2 = s2 * dec.z + v * km.z - sa * bb.z; s3 = s3 * dec.w + v * km.w - sa * bb.w;
                float y = (s0 * rv.x + s1 * rv.y) + (s2 * rv.z + s3 * rv.w);
                y = red16(y);
                if (ks == 0) yout[(size_t)(c * 16 + st) * 512] = y;
            }
        }
        if (c + 1 < 1024) {
            float* nb = buf + ((c + 1) & 1) * 6144;
#pragma unroll
            for (int i = 0; i < 3; ++i) {
                const int ci = tid + i * 256; float f[8]; unpack8(rg[i], f);
                if ((ci % 48) < 8) {
#pragma unroll
                    for (int e = 0; e < 8; ++e) f[e] = 1.f - f[e];
                }
                float* d = nb + ci * 8;
                *(float4*)d = make_float4(f[0], f[1], f[2], f[3]); *(float4*)(d + 4) = make_float4(f[4], f[5], f[6], f[7]);
            }
        }
        __syncthreads();
    }
}

struct AttnSmem {
    bf16_t k[64 * 72];
    bf16_t vt[64 * 68];
    float imp[32 * 256];
    unsigned selbits[32 * 8];
    unsigned wunion[4 * 8];
    unsigned bunion[8];
    int unit;
};

DI void attn_load(const bf16_t* kbase, int kstride, const bf16_t* vtbase, int vtstride, uint4 (&r)[4], int tid, bool needv) {
#pragma unroll
    for (int i = 0; i < 2; ++i) { const int c = tid + i * 256; r[i] = *(const uint4*)(kbase + (size_t)(c >> 3) * kstride + (c & 7) * 8); }
    if (needv) {
#pragma unroll
        for (int i = 0; i < 2; ++i) { const int c = tid + i * 256; r[2 + i] = *(const uint4*)(vtbase + (size_t)(c >> 3) * vtstride + (c & 7) * 8); }
    }
}
DI void attn_store(AttnSmem& sm, const uint4 (&r)[4], int tid, bool needv) {
#pragma unroll
    for (int i = 0; i < 2; ++i) { const int c = tid + i * 256; *(uint4*)&sm.k[(c >> 3) * 72 + (c & 7) * 8] = r[i]; }
    if (needv) {
#pragma unroll
        for (int i = 0; i < 2; ++i) {
            const int c = tid + i * 256; bf16_t* d = &sm.vt[(c >> 3) * 68 + (c & 7) * 8];
            *(uint2*)d = make_uint2(r[2 + i].x, r[2 + i].y); *(uint2*)(d + 4) = make_uint2(r[2 + i].z, r[2 + i].w);
        }
    }
}

template <int MODE>
DI void attn_tile(AttnSmem& sm, const bf16x8 (&qf)[4], f32x16 (&o)[2], float& m, float& l, const float inv_l, const int lo, const int hi,
                  const int lane, const int tokl, const int jbase) {
    const int rr = lane & 31, hh = lane >> 5;
    f32x16 s[2];
#pragma unroll
    for (int mt = 0; mt < 2; ++mt) {
#pragma unroll
        for (int i = 0; i < 16; ++i) s[mt][i] = 0.f;
#pragma unroll
        for (int ks = 0; ks < 4; ++ks) {
            const bf16x8 kf = *(const bf16x8*)&sm.k[(mt * 32 + rr) * 72 + ks * 16 + hh * 8];
            s[mt] = MFMA32(kf, qf[ks], s[mt]);
        }
        asm volatile("" ::: "memory");
    }
    const float L2E = 1.4426950408889634f;
    const int lo2 = lo - 4 * hh, hi2 = hi - 4 * hh;
    float mx = -1e30f;
#pragma unroll
    for (int mt = 0; mt < 2; ++mt)
#pragma unroll
        for (int i = 0; i < 16; ++i) {
            const int kc_ = mt * 32 + (i & 3) + 8 * (i >> 2);
            float v = s[mt][i] * L2E;
            v = (kc_ >= lo2 && kc_ <= hi2) ? v : -1e30f;
            s[mt][i] = v; mx = fmaxf(mx, v);
        }
    float mref = m;
    if (MODE != 2) {
        mx = fmaxf(mx, __shfl_xor(mx, 32));
        const float mnew = fmaxf(m, mx);
        const float alpha = __builtin_amdgcn_exp2f(m - mnew);
        m = mnew; mref = mnew;
        l *= alpha;
        if (MODE == 1) {
#pragma unroll
            for (int dt = 0; dt < 2; ++dt)
#pragma unroll
                for (int i = 0; i < 16; ++i) o[dt][i] *= alpha;
        }
    }
    float psum = 0.f;
#pragma unroll
    for (int mt = 0; mt < 2; ++mt)
#pragma unroll
        for (int i = 0; i < 16; ++i) {
            const float v = s[mt][i];
            float pv = (v > -1e29f) ? __builtin_amdgcn_exp2f(v - mref) : 0.f;
            if (MODE == 2) pv *= inv_l;
            s[mt][i] = pv; psum += pv;
        }
    if (MODE != 2) l += psum;
    if (MODE == 0) return;
    if (MODE == 2) {
#pragma unroll
        for (int mt = 0; mt < 2; ++mt)
#pragma unroll
            for (int jj = 0; jj < 4; ++jj) {
                float q4 = (s[mt][4 * jj] + s[mt][4 * jj + 1]) + (s[mt][4 * jj + 2] + s[mt][4 * jj + 3]);
                float e3 = s[mt][4 * jj + 3];
                q4 += __shfl_xor(q4, 1); q4 += __shfl_xor(q4, 2);
                e3 += __shfl_xor(e3, 1); e3 += __shfl_xor(e3, 2);
                if ((rr & 3) == 0) {
                    const int j = jbase + mt * 8 + 2 * jj + hh;
                    atomicAdd(&sm.imp[tokl * 256 + j], q4);
                    if (j + 1 < 256) atomicAdd(&sm.imp[tokl * 256 + j + 1], e3);
                }
            }
    }
#pragma unroll
    for (int mt = 0; mt < 2; ++mt)
#pragma unroll
        for (int s2 = 0; s2 < 2; ++s2) {
            uint4 pu;
            pu.x = pack2(s[mt][8 * s2 + 0], s[mt][8 * s2 + 1]); pu.y = pack2(s[mt][8 * s2 + 2], s[mt][8 * s2 + 3]);
            pu.z = pack2(s[mt][8 * s2 + 4], s[mt][8 * s2 + 5]); pu.w = pack2(s[mt][8 * s2 + 6], s[mt][8 * s2 + 7]);
            const bf16x8 pf = __builtin_bit_cast(bf16x8, pu);
            asm volatile("" ::: "memory");
#pragma unroll
            for (int dt = 0; dt < 2; ++dt) {
                const bf16_t* vp = &sm.vt[(dt * 32 + rr) * 68 + mt * 32 + s2 * 16 + hh * 4];
                const uint2 v0 = *(const uint2*)vp, v1 = *(const uint2*)(vp + 8);
                const bf16x8 vf = __builtin_bit_cast(bf16x8, make_uint4(v0.x, v0.y, v1.x, v1.y));
                o[dt] = MFMA32(vf, pf, o[dt]);
            }
        }
}

DI unsigned wave_umax(unsigned v) {
#pragma unroll
    for (int o = 32; o; o >>= 1) { const unsigned t = (unsigned)__shfl_xor((int)v, o); v = v > t ? v : t; }
    return v;
}

DI void attn_unit(const P& p, int u, char* smem) {
    AttnSmem& sm = *(AttnSmem*)smem;
    const int tid = threadIdx.x, wave = tid >> 6, lane = tid & 63, rr = lane & 31, hh = lane >> 5;
    const int tile = 511 - (u >> 2), bhk = u & 3, b = bhk >> 1, hk = bhk & 1, t0 = tile * 32;
    const int tokl = wave * 8 + (rr >> 2), t = t0 + tokl, g = rr & 3, head = hk * 4 + g;
    const size_t tokg = (size_t)b * S_ + t;
    bf16x8 qf[4];
#pragma unroll
    for (int ks = 0; ks < 4; ++ks) qf[ks] = *(const bf16x8*)(p.proj + tokg * PLD + QC + head * 64 + ks * 16 + hh * 8);
    float gate[3];
#pragma unroll
    for (int i = 0; i < 3; ++i) gate[i] = sigmoidf_(__uint_as_float((unsigned)p.proj[tokg * PLD + GC + head * 3 + i] << 16));
#pragma unroll
    for (int i = 0; i < 8; ++i) *(float4*)&sm.imp[(tid + i * 256) * 4] = make_float4(0.f, 0.f, 0.f, 0.f);
    sm.selbits[tid] = 0u;
    f32x16 o[2];
#pragma unroll
    for (int dt = 0; dt < 2; ++dt)
#pragma unroll
        for (int i = 0; i < 16; ++i) o[dt][i] = 0.f;
    float* park = &sm.imp[wave * 2048 + lane];
    uint4 rg[4];
    const int ntc = (t0 >> 10) + 1;
    const int vmaxi = (t >= 31) ? ((t - 31) >> 4) : -1;
    const bf16_t* kcb = p.kc + (size_t)bhk * 1024 * 64;
    const bf16_t* vcb = p.vcT + (size_t)bhk * 64 * 1024;
    float m = -1e30f, l = 0.f;
    attn_load(kcb, 64, vcb, 1024, rg, tid, false);
    for (int j = 0; j < ntc; ++j) {
        __syncthreads();
        attn_store(sm, rg, tid, false);
        __syncthreads();
        if (j + 1 < ntc) attn_load(kcb + (size_t)(j + 1) * 64 * 64, 64, vcb, 1024, rg, tid, false);
        attn_tile<0>(sm, qf, o, m, l, 0.f, 0, vmaxi - j * 64, lane, tokl, 0);
    }
    {
        const float lt = l + __shfl_xor(l, 32);
        const float inv_l = lt > 0.f ? 1.f / lt : 0.f;
        attn_load(kcb, 64, vcb, 1024, rg, tid, true);
        for (int j = 0; j < ntc; ++j) {
            __syncthreads();
            attn_store(sm, rg, tid, true);
            __syncthreads();
            if (j + 1 < ntc) attn_load(kcb + (size_t)(j + 1) * 64 * 64, 64, vcb + (j + 1) * 64, 1024, rg, tid, true);
            attn_tile<2>(sm, qf, o, m, l, inv_l, 0, vmaxi - j * 64, lane, tokl, j * 16);
        }
    }
    __syncthreads();
    const int cur = t0 >> 6;
    for (int tk = 0; tk < 8; ++tk) {
        const int tl = wave * 8 + tk;
        const float* ip = &sm.imp[tl * 256];
        unsigned nib = 0u;
        if (cur <= 15) {
#pragma unroll
            for (int e = 0; e < 4; ++e) if (lane * 4 + e <= cur) nib |= 1u << e;
        } else {
            unsigned k0, k1, k2, k3;
            {
                const float4 iv = *(const float4*)(ip + lane * 4);
                const int j0 = lane * 4;
                k0 = (j0 >= 1 && j0 <= cur - 2) ? ((__float_as_uint(iv.x) & 0xFFFFFF00u) | (unsigned)(255 - j0)) : 0u;
                k1 = (j0 + 1 <= cur - 2) ? ((__float_as_uint(iv.y) & 0xFFFFFF00u) | (unsigned)(254 - j0)) : 0u;
                k2 = (j0 + 2 <= cur - 2) ? ((__float_as_uint(iv.z) & 0xFFFFFF00u) | (unsigned)(253 - j0)) : 0u;
                k3 = (j0 + 3 <= cur - 2) ? ((__float_as_uint(iv.w) & 0xFFFFFF00u) | (unsigned)(252 - j0)) : 0u;
#pragma unroll
                for (int e = 0; e < 4; ++e) { const int j = j0 + e; if (j == 0 || j == cur || j == cur - 1) nib |= 1u << e; }
            }
            for (int r = 0; r < 13; ++r) {
                unsigned lm = k0 > k1 ? k0 : k1; const unsigned lm2 = k2 > k3 ? k2 : k3; lm = lm > lm2 ? lm : lm2;
                const unsigned wm = wave_umax(lm);
                if (k0 == wm) { k0 = 0u; nib |= 1u; }
                if (k1 == wm) { k1 = 0u; nib |= 2u; }
                if (k2 == wm) { k2 = 0u; nib |= 4u; }
                if (k3 == wm) { k3 = 0u; nib |= 8u; }
            }
        }
        atomicOr(&sm.selbits[tl * 8 + (lane >> 3)], nib << ((lane & 7) * 4));
    }
    __syncthreads();
    if (tid < 32) {
        const int w = tid >> 3, d = tid & 7; unsigned uu = 0u;
#pragma unroll
        for (int k = 0; k < 8; ++k) uu |= sm.selbits[(w * 8 + k) * 8 + d];
        sm.wunion[w * 8 + d] = uu;
    }
    __syncthreads();
    if (tid < 8) sm.bunion[tid] = sm.wunion[tid] | sm.wunion[8 + tid] | sm.wunion[16 + tid] | sm.wunion[24 + tid];
    __syncthreads();
#pragma unroll
    for (int dt = 0; dt < 2; ++dt)
#pragma unroll
        for (int i = 0; i < 16; ++i) { park[(dt * 16 + i) * 64] = gate[0] * o[dt][i]; o[dt][i] = 0.f; }
    {
        const bf16_t* kb = p.proj + (size_t)(b * S_) * PLD + KVC + 2 * 128 + hk * 64;
        const bf16_t* vb = p.vT + (size_t)((0 * 4 + bhk) * 64) * S_;
        m = -1e30f; l = 0.f;
        auto nextj = [&](int j) -> int {
            ++j;
            while (j <= cur) {
                const unsigned w = sm.bunion[j >> 5] >> (j & 31);
                if (w) { j += __ffs((int)w) - 1; return j <= cur ? j : -1; }
                j = (j | 31) + 1;
            }
            return -1;
        };
        int j = nextj(-1);
        if (j >= 0) attn_load(kb + (size_t)j * 64 * PLD, PLD, vb + j * 64, S_, rg, tid, true);
        while (j >= 0) {
            __syncthreads();
            attn_store(sm, rg, tid, true);
            __syncthreads();
            const int jn = nextj(j);
            if (jn >= 0) attn_load(kb + (size_t)jn * 64 * PLD, PLD, vb + jn * 64, S_, rg, tid, true);
            if ((sm.wunion[wave * 8 + (j >> 5)] >> (j & 31)) & 1u) {
                const bool selme = (sm.selbits[tokl * 8 + (j >> 5)] >> (j & 31)) & 1u;
                const int hi = selme ? (j < cur ? 63 : t - j * 64) : -1;
                attn_tile<1>(sm, qf, o, m, l, 0.f, 0, hi, lane, tokl, 0);
            }
            j = jn;
        }
        const float lt = l + __shfl_xor(l, 32);
        const float sc = lt > 0.f ? gate[1] / lt : 0.f;
#pragma unroll
        for (int dt = 0; dt < 2; ++dt)
#pragma unroll
            for (int i = 0; i < 16; ++i) { park[(dt * 16 + i) * 64] += sc * o[dt][i]; o[dt][i] = 0.f; }
    }
    {
        const bf16_t* kb = p.proj + (size_t)(b * S_) * PLD + KVC + 4 * 128 + hk * 64;
        const bf16_t* vb = p.vT + (size_t)((1 * 4 + bhk) * 64) * S_;
        m = -1e30f; l = 0.f;
        const int jlo = (t0 >= 511) ? ((t0 - 511) >> 6) : 0, jhi = t0 >> 6;
        attn_load(kb + (size_t)jlo * 64 * PLD, PLD, vb + jlo * 64, S_, rg, tid, true);
        for (int j = jlo; j <= jhi; ++j) {
            __syncthreads();
            attn_store(sm, rg, tid, true);
            __syncthreads();
            if (j + 1 <= jhi) attn_load(kb + (size_t)(j + 1) * 64 * PLD, PLD, vb + (j + 1) * 64, S_, rg, tid, true);
            attn_tile<1>(sm, qf, o, m, l, 0.f, t - 511 - j * 64, t - j * 64, lane, tokl, 0);
        }
        const float lt = l + __shfl_xor(l, 32);
        const float sc = lt > 0.f ? gate[2] / lt : 0.f;
#pragma unroll
        for (int dt = 0; dt < 2; ++dt)
#pragma unroll
            for (int i = 0; i < 16; ++i) o[dt][i] = park[(dt * 16 + i) * 64] + sc * o[dt][i];
    }
    bf16_t* mp = p.A + tokg * 1024 + 512 + head * 64;
#pragma unroll
    for (int dt = 0; dt < 2; ++dt)
#pragma unroll
        for (int jj = 0; jj < 4; ++jj) {
            uint2 ov; ov.x = pack2(o[dt][4 * jj], o[dt][4 * jj + 1]); ov.y = pack2(o[dt][4 * jj + 2], o[dt][4 * jj + 3]);
            *(uint2*)(mp + dt * 32 + jj * 8 + hh * 4) = ov;
        }
}

DI void phase4(const P& p, char* smem) {
    for (int su = blockIdx.x; su < 128; su += gridDim.x) scan_unit(p, su, smem);
    AttnSmem& sm = *(AttnSmem*)smem;
    while (true) {
        __syncthreads();
        if (threadIdx.x == 0) sm.unit = (int)atomicAdd(p.counter, 1u);
        __syncthreads();
        const int u = sm.unit;
        if (u >= 2048) break;
        attn_unit(p, u, smem);
    }
}

DI void phase4b(const P& p) {
    const int tid = threadIdx.x;
    for (int it = blockIdx.x; it < T_ / 4; it += gridDim.x) {
        const int gi = it * 4 + (tid >> 6), cgp = tid & 63, h = cgp >> 3, c8 = (cgp & 7) * 8, col = cgp * 8, b = gi >> 14, s = gi & (S_ - 1);
        const float4 y0 = *(const float4*)(p.yraw + (size_t)gi * 512 + col), y1 = *(const float4*)(p.yraw + (size_t)gi * 512 + col + 4);
        float y[8] = {y0.x, y0.y, y0.z, y0.w, y1.x, y1.y, y1.z, y1.w};
        const bf16_t* sp = p.stream + ((size_t)((b * 8 + h) * S_ + s) * 6) * 64 + c8;
        float km[8], r[8], v[8], gg[8];
        unpack8(*(const uint4*)(sp + 64), km); unpack8(*(const uint4*)(sp + 256), r); unpack8(*(const uint4*)(sp + 320), v);
        unpack8(*(const uint4*)(p.gbuf + (size_t)gi * 512 + col), gg);
        float sum = 0.f, bon = 0.f;
#pragma unroll
        for (int e = 0; e < 8; ++e) { sum += y[e]; bon += r[e] * km[e] * p.r_k[col + e]; }
        sum += __shfl_xor(sum, 1); sum += __shfl_xor(sum, 2); sum += __shfl_xor(sum, 4);
        bon += __shfl_xor(bon, 1); bon += __shfl_xor(bon, 2); bon += __shfl_xor(bon, 4);
        const float mean = sum * (1.f / 64.f);
        float var = 0.f;
#pragma unroll
        for (int e = 0; e < 8; ++e) { y[e] -= mean; var += y[e] * y[e]; }
        var += __shfl_xor(var, 1); var += __shfl_xor(var, 2); var += __shfl_xor(var, 4);
        const float rs = rsqrtf(var * (1.f / 64.f) + 64e-5f);
        float o[8];
#pragma unroll
        for (int e = 0; e < 8; ++e) o[e] = (y[e] * rs * p.lnx_w[col + e] + p.lnx_b[col + e] + bon * v[e]) * gg[e];
        *(uint4*)(p.A + (size_t)gi * 1024 + col) = pack8(o);
    }
}

struct EpiFfn2 {
    float* out;
    DI void operator()(const f32x16 (&acc)[2][2], int rowbase, int colbase, int lane) const {
        const int rr = lane & 31, hh = lane >> 5;
#pragma unroll
        for (int w = 0; w < 2; ++w)
#pragma unroll
            for (int t = 0; t < 2; ++t)
#pragma unroll
                for (int j = 0; j < 4; ++j) {
                    float4* o = (float4*)(out + (size_t)(rowbase + t * 32 + rr) * 1024 + colbase + w * 32 + j * 8 + hh * 4);
                    float4 xv = *o;
                    xv.x += acc[w][t][4 * j]; xv.y += acc[w][t][4 * j + 1]; xv.z += acc[w][t][4 * j + 2]; xv.w += acc[w][t][4 * j + 3];
                    *o = xv;
                }
    }
};

DI void final_item(float* io, const float* g, int idx) {
    const int row = idx * 4 + (threadIdx.x >> 6), lane = threadIdx.x & 63;
    float4* sp = (float4*)(io + (size_t)row * 1024);
    float4 v[4]; float ss = 0.f;
#pragma unroll
    for (int i = 0; i < 4; ++i) { v[i] = sp[lane + 64 * i]; ss += v[i].x * v[i].x + v[i].y * v[i].y + v[i].z * v[i].z + v[i].w * v[i].w; }
    ss = wave_sum(ss);
    const float rs = rsqrtf(ss * (1.f / 1024.f) + 1e-6f);
#pragma unroll
    for (int i = 0; i < 4; ++i) {
        const float4 gv = ((const float4*)g)[lane + 64 * i];
        sp[lane + 64 * i] = make_float4(v[i].x * rs * gv.x, v[i].y * rs * gv.y, v[i].z * rs * gv.z, v[i].w * rs * gv.w);
    }
}

DI void run_phase(const P& p, int ph, char* smem) {
    switch (ph) {
    case 0: phase0(p, smem); break;
    case 1:
        for (int it = blockIdx.x; it < 256 * 25; it += gridDim.x) {
            const int mt = it / 25, nt = it - mt * 25;
            gemm_tile(AFPlain{p.A, 1024}, p.WinT + (size_t)nt * 128 * 1024, 1024, mt * 128, nt * 128, EpiProj{p.proj}, smem);
        }
        break;
    case 2: phase2(p, smem); break;
    case 3: phase3(p, smem); break;
    case 4: phase4(p, smem); break;
    case 5: phase4b(p); break;
    case 6:
        for (int it = blockIdx.x; it < 256 * 8; it += gridDim.x) {
            const int mt = it >> 3, nt = it & 7;
            gemm_tile(AFPlain{p.A, 1024}, p.WoutT + (size_t)nt * 128 * 1024, 1024, mt * 128, nt * 128, EpiOut{p.out, p.x}, smem);
        }
        break;
    case 7:
        for (int it = blockIdx.x; it < T_ / 4; it += gridDim.x) rms_item(p.out, p.norm_ffn, p.A, it);
        break;
    case 8:
        for (int it = blockIdx.x; it < 256 * 44; it += gridDim.x) {
            const int mt = it / 44, nt = it - mt * 44;
            gemm_tile(AFPlain{p.A, 1024}, p.WguT + (size_t)nt * 128 * 1024, 1024, mt * 128, nt * 128, EpiFfn1{p.stream}, smem);
        }
        break;
    case 9:
        for (int it = blockIdx.x; it < 256 * 8; it += gridDim.x) {
            const int mt = it >> 3, nt = it & 7;
            gemm_tile(AFPlain{p.stream, DFF}, p.WdnT + (size_t)nt * 128 * DFF, DFF, mt * 128, nt * 128, EpiFfn2{p.out}, smem);
        }
        break;
    default:
        for (int it = blockIdx.x; it < T_ / 4; it += gridDim.x) final_item(p.out, p.norm_final, it);
        break;
    }
}
constexpr int NPHASE = 11;
constexpr int SMEM_BYTES = 57344;

__global__ void __launch_bounds__(NTHR, 2) mega_kernel(P p) {
    __shared__ __attribute__((aligned(16))) char smem[SMEM_BYTES];
    cg::grid_group grid = cg::this_grid();
    run_phase(p, 0, smem); grid.sync();
    run_phase(p, 1, smem); grid.sync();
    run_phase(p, 2, smem); grid.sync();
    run_phase(p, 3, smem); grid.sync();
    run_phase(p, 4, smem); grid.sync();
    run_phase(p, 5, smem); grid.sync();
    run_phase(p, 6, smem); grid.sync();
    run_phase(p, 7, smem); grid.sync();
    run_phase(p, 8, smem); grid.sync();
    run_phase(p, 9, smem); grid.sync();
    run_phase(p, 10, smem);
}
__global__ void __launch_bounds__(NTHR, 2) phase_kernel(P p, int ph) {
    __shared__ __attribute__((aligned(16))) char smem[SMEM_BYTES];
    run_phase(p, ph, smem);
}

extern "C" void kernel_launch(void* const* d_in, const int* in_sizes, int n_in, void* d_out, int out_size, void* d_ws, size_t ws_size,
                              hipStream_t stream) {
    P p{};
    p.x = (const float*)d_in[0]; p.pos = (const int*)d_in[1]; p.norm_mix = (const float*)d_in[2]; p.w_in = (const float*)d_in[3];
    p.mu = (const float*)d_in[4]; p.w0 = (const float*)d_in[5]; p.w2 = (const float*)d_in[6]; p.a0 = (const float*)d_in[7];
    p.a2 = (const float*)d_in[8]; p.g2 = (const float*)d_in[9]; p.k_k = (const float*)d_in[10]; p.k_a = (const float*)d_in[11];
    p.r_k = (const float*)d_in[12]; p.lnx_w = (const float*)d_in[13]; p.lnx_b = (const float*)d_in[14]; p.pe_k = (const float*)d_in[15];
    p.wk1 = (const float*)d_in[16]; p.bk1 = (const float*)d_in[17]; p.wk2 = (const float*)d_in[18]; p.pe_v = (const float*)d_in[19];
    p.wv1 = (const float*)d_in[20]; p.bv1 = (const float*)d_in[21]; p.wv2 = (const float*)d_in[22]; p.w_out = (const float*)d_in[23];
    p.norm_ffn = (const float*)d_in[24]; p.w_gate = (const float*)d_in[25]; p.w_up = (const float*)d_in[26]; p.w_down = (const float*)d_in[27];
    p.norm_final = (const float*)d_in[28];
    p.out = (float*)d_out;
    char* ws = (char*)d_ws;
    size_t off = 0;
    auto take = [&](size_t bytes) { char* r = ws + off; off += (bytes + 255) & ~(size_t)255; return r; };
    p.WinT = (bf16_t*)take((size_t)3200 * 1024 * 2);
    p.WoutT = (bf16_t*)take((size_t)1024 * 1024 * 2);
    p.WguT = (bf16_t*)take((size_t)5632 * 1024 * 2);
    p.WdnT = (bf16_t*)take((size_t)1024 * DFF * 2);
    p.w2T = (bf16_t*)take(512 * 64 * 2);
    p.a2T = (bf16_t*)take(512 * 64 * 2);
    p.g2T = (bf16_t*)take(512 * 160 * 2);
    p.w1T = (bf16_t*)take((size_t)2 * 256 * 2048 * 2);
    p.wc2T = (bf16_t*)take(2 * 128 * 256 * 2);
    p.b1p = (float*)take(512 * 4);
    p.cosT = (float*)take((size_t)T_ * 8 * 4);
    p.sinT = (float*)take((size_t)T_ * 8 * 4);
    p.counter = (unsigned*)take(256);
    off = (size_t)32 << 20;
    p.A = (bf16_t*)take((size_t)T_ * 1024 * 2);
    p.proj = (bf16_t*)take((size_t)T_ * PLD * 2);
    p.stream = (bf16_t*)take((size_t)T_ * 8 * 384 * 2);
    if (off > ws_size) fprintf(stderr, "workspace too small: need %zu have %zu\n", off, ws_size);
    char* ob = (char*)d_out;
    p.gbuf = (bf16_t*)ob;
    p.yraw = (float*)(ob + ((size_t)32 << 20));
    p.vT = (bf16_t*)(ob + ((size_t)96 << 20));
    p.hid = (bf16_t*)(ob + ((size_t)112 << 20));
    p.kc = (bf16_t*)(ob + ((size_t)116 << 20));
    p.vcT = (bf16_t*)(ob + ((size_t)116 << 20) + (512 << 10));
#if MK_SINGLE
    static int grid_blocks = 0;
    if (!grid_blocks) {
        int dev = 0, cus = 0, per_cu = 0;
        hipGetDevice(&dev);
        hipDeviceGetAttribute(&cus, hipDeviceAttributeMultiprocessorCount, dev);
        hipOccupancyMaxActiveBlocksPerMultiprocessor(&per_cu, mega_kernel, NTHR, 0);
        if (per_cu > 2) per_cu = 2;
        if (per_cu < 1) per_cu = 1;
        grid_blocks = cus * per_cu;
    }
    void* args[] = {&p};
    hipError_t e = hipLaunchCooperativeKernel((void*)mega_kernel, dim3(grid_blocks), dim3(NTHR), args, 0, stream);
    if (e != hipSuccess) fprintf(stderr, "cooperative launch failed: %s (grid %d)\n", hipGetErrorString(e), grid_blocks);
#else
    for (int ph = 0; ph < NPHASE; ++ph) phase_kernel<<<512, NTHR, 0, stream>>>(p, ph);
#endif
}
```

```cpp
#include <hip/hip_runtime.h>
#include <hip/hip_cooperative_groups.h>
#include <cstdio>
namespace cg = cooperative_groups;

#ifndef MK_SINGLE
#define MK_SINGLE 1
#endif

#define DI __device__ __forceinline__
typedef unsigned short bf16_t;
typedef short bf16x8 __attribute__((ext_vector_type(8)));
typedef float f32x16 __attribute__((ext_vector_type(16)));
typedef __bf16 bf2_t __attribute__((ext_vector_type(2)));
typedef float f2_t __attribute__((ext_vector_type(2)));

constexpr int T_ = 32768, S_ = 16384;
constexpr int PLD = 3200;
constexpr int QC = 1856, KVC = 2368, GC = 3136;
constexpr int DFF = 2816;
constexpr int NTHR = 256;

#define MFMA32(a, b, c) __builtin_amdgcn_mfma_f32_32x32x16_bf16((a), (b), (c), 0, 0, 0)

DI unsigned pack2(float a, float b) { f2_t v = {a, b}; return __builtin_bit_cast(unsigned, __builtin_convertvector(v, bf2_t)); }
DI float bflo(unsigned u) { return __uint_as_float(u << 16); }
DI float bfhi(unsigned u) { return __uint_as_float(u & 0xffff0000u); }
DI bf16_t f2bf(float a) { return (bf16_t)(pack2(a, 0.f) & 0xffffu); }
DI void unpack8(const uint4& u, float (&f)[8]) {
    f[0] = bflo(u.x); f[1] = bfhi(u.x); f[2] = bflo(u.y); f[3] = bfhi(u.y);
    f[4] = bflo(u.z); f[5] = bfhi(u.z); f[6] = bflo(u.w); f[7] = bfhi(u.w);
}
DI uint4 pack8(const float (&f)[8]) { uint4 u; u.x = pack2(f[0], f[1]); u.y = pack2(f[2], f[3]); u.z = pack2(f[4], f[5]); u.w = pack2(f[6], f[7]); return u; }
DI float wave_sum(float v) {
#pragma unroll
    for (int o = 32; o; o >>= 1) v += __shfl_xor(v, o);
    return v;
}
DI float sigmoidf_(float x) { return 1.f / (1.f + __expf(-x)); }
DI int crow(int reg, int h) { return (reg & 3) + 8 * (reg >> 2) + 4 * h; }

struct P {
    const float* x; const int* pos; const float *norm_mix, *w_in, *mu, *w0, *w2, *a0, *a2, *g2, *k_k, *k_a, *r_k, *lnx_w, *lnx_b,
        *pe_k, *wk1, *bk1, *wk2, *pe_v, *wv1, *bv1, *wv2, *w_out, *norm_ffn, *w_gate, *w_up, *w_down, *norm_final;
    float* out;
    bf16_t *WinT, *WoutT, *WguT, *WdnT, *w2T, *a2T, *g2T, *w1T, *wc2T;
    float *b1p, *cosT, *sinT;
    unsigned* counter;
    bf16_t *A, *proj, *stream;
    bf16_t* gbuf; float* yraw; bf16_t *vT, *hid, *kc, *vcT;
};

DI float tr_val(const P& p, int job, int k, int n) {
    switch (job) {
    case 0: { int c = n < 1824 ? n : ((n >= 1856 && n < 3160) ? n - 32 : -1); return c >= 0 ? p.w_in[(size_t)k * 3128 + c] : 0.f; }
    case 1: return p.w_out[k * 1024 + n];
    case 2: { int q = n >> 6, r = n & 63; return r < 32 ? p.w_gate[(size_t)k * DFF + q * 32 + r] : p.w_up[(size_t)k * DFF + q * 32 + r - 32]; }
    case 3: return p.w_down[(size_t)k * 1024 + n];
    case 4: return p.w2[k * 512 + n];
    case 5: return p.a2[k * 512 + n];
    case 6: return p.g2[k * 512 + n];
    case 7: return p.wk1[k * 256 + n];
    case 8: return p.wv1[k * 256 + n];
    case 9: return n < 64 ? p.wk2[k * 64 + n] : 0.f;
    default: return n < 64 ? p.wv2[k * 64 + n] : 0.f;
    }
}
DI void tr_item(const P& p, int it, float* tile) {
    int job, K, N; bf16_t* dst;
    if (it < 800) { job = 0; K = 1024; N = 3200; dst = p.WinT; }
    else if (it < 1056) { job = 1; it -= 800; K = 1024; N = 1024; dst = p.WoutT; }
    else if (it < 2464) { job = 2; it -= 1056; K = 1024; N = 5632; dst = p.WguT; }
    else if (it < 3168) { job = 3; it -= 2464; K = 2816; N = 1024; dst = p.WdnT; }
    else if (it < 3176) { job = 4; it -= 3168; K = 64; N = 512; dst = p.w2T; }
    else if (it < 3184) { job = 5; it -= 3176; K = 64; N = 512; dst = p.a2T; }
    else if (it < 3208) { job = 6; it -= 3184; K = 160; N = 512; dst = p.g2T; }
    else if (it < 3336) { job = 7; it -= 3208; K = 2048; N = 256; dst = p.w1T; }
    else if (it < 3464) { job = 8; it -= 3336; K = 2048; N = 256; dst = p.w1T + 256 * 2048; }
    else if (it < 3472) { job = 9; it -= 3464; K = 256; N = 128; dst = p.wc2T; }
    else { job = 10; it -= 3472; K = 256; N = 128; dst = p.wc2T + 128 * 256; }
    const int nt = N >> 6;
    const int k0 = (it / nt) * 64, n0 = (it % nt) * 64;
    const int tid = threadIdx.x;
    __syncthreads();
#pragma unroll 4
    for (int i = 0; i < 16; ++i) {
        const int kk = i * 4 + (tid >> 6), nn = tid & 63;
        tile[kk * 65 + nn] = (k0 + kk < K) ? tr_val(p, job, k0 + kk, n0 + nn) : 0.f;
    }
    __syncthreads();
#pragma unroll 4
    for (int i = 0; i < 16; ++i) {
        const int nn = i * 4 + (tid >> 6), kk = tid & 63;
        if (k0 + kk < K) dst[(size_t)(n0 + nn) * K + k0 + kk] = f2bf(tile[kk * 65 + nn]);
    }
}
DI void b1_item(const P& p, int idx) {
    const int kv = idx >> 4, jc = idx & 15, tid = threadIdx.x;
    const float* pe = kv ? p.pe_v : p.pe_k; const float* w1 = kv ? p.wv1 : p.wk1; const float* b1 = kv ? p.bv1 : p.bk1;
    const int j = jc * 16 + (tid >> 4), kl = tid & 15;
    float s = 0.f;
    for (int i = 0; i < 128; ++i) { const int k = kl + 16 * i; s += pe[k] * w1[k * 256 + j]; }
    s += __shfl_xor(s, 1); s += __shfl_xor(s, 2); s += __shfl_xor(s, 4); s += __shfl_xor(s, 8);
    if (kl == 0) p.b1p[kv * 256 + j] = b1[j] + s;
}
DI void sincos_d(float ang, float& c, float& s) {
    double x = (double)ang;
    const double TWO_PI = 6.283185307179586476925286766559;
    double n = __builtin_rint(x * (1.0 / TWO_PI));
    double r = x - n * TWO_PI;
    double q = r * 0.25;
    double q2 = q * q;
    double sn = q * (1.0 + q2 * (-1.0 / 6 + q2 * (1.0 / 120 + q2 * (-1.0 / 5040 + q2 * (1.0 / 362880 + q2 * (-1.0 / 39916800 + q2 * (1.0 / 6227020800.0)))))));
    double cs = 1.0 + q2 * (-0.5 + q2 * (1.0 / 24 + q2 * (-1.0 / 720 + q2 * (1.0 / 40320 + q2 * (-1.0 / 3628800 + q2 * (1.0 / 479001600.0))))));
    double s2 = 2 * sn * cs, c2 = 1 - 2 * sn * sn;
    double s4 = 2 * s2 * c2, c4 = 1 - 2 * s2 * s2;
    c = (float)c4; s = (float)s4;
}
DI void cs_item(const P& p, int idx) {
    const int e = idx * 256 + threadIdx.x, tok = e >> 3, f = e & 7;
    const float invf[8] = {1.000000000e+00f, 1.939227432e-01f, 3.760603070e-02f, 7.292664610e-03f, 1.414213562e-03f, 2.742481884e-04f, 5.318295734e-05f, 1.031338525e-05f};
    float iv = invf[0];
#pragma unroll
    for (int i = 1; i < 8; ++i) iv = (f == i) ? invf[i] : iv;
    const float ang = (float)p.pos[tok] * iv;
    float c, s; sincos_d(ang, c, s);
    p.cosT[e] = c; p.sinT[e] = s;
}
DI void rms_item(const float* src, const float* g, bf16_t* dst, int idx) {
    const int row = idx * 4 + (threadIdx.x >> 6), lane = threadIdx.x & 63;
    const float4* sp = (const float4*)(src + (size_t)row * 1024);
    float4 v[4]; float ss = 0.f;
#pragma unroll
    for (int i = 0; i < 4; ++i) { v[i] = sp[lane + 64 * i]; ss += v[i].x * v[i].x + v[i].y * v[i].y + v[i].z * v[i].z + v[i].w * v[i].w; }
    ss = wave_sum(ss);
    const float rs = rsqrtf(ss * (1.f / 1024.f) + 1e-6f);
#pragma unroll
    for (int i = 0; i < 4; ++i) {
        const float4 gv = ((const float4*)g)[lane + 64 * i];
        uint2 o; o.x = pack2(v[i].x * rs * gv.x, v[i].y * rs * gv.y); o.y = pack2(v[i].z * rs * gv.z, v[i].w * rs * gv.w);
        *(uint2*)(dst + (size_t)row * 1024 + (lane + 64 * i) * 4) = o;
    }
}
DI void phase0(const P& p, char* smem) {
    if (blockIdx.x == 0 && threadIdx.x == 0) *p.counter = 0u;
    constexpr int NTR = 3480, NB1 = 32, NCS = 1024, NXN = 8192;
    for (int it = blockIdx.x; it < NTR + NB1 + NCS + NXN; it += gridDim.x) {
        if (it < NTR) tr_item(p, it, (float*)smem);
        else if (it < NTR + NB1) b1_item(p, it - NTR);
        else if (it < NTR + NB1 + NCS) cs_item(p, it - NTR - NB1);
        else rms_item(p.x, p.norm_mix, p.A, it - NTR - NB1 - NCS);
    }
}

struct AFPlain { const bf16_t* A; int lda; DI uint4 load(int row, int k) const { return *(const uint4*)(A + (size_t)row * lda + k); } };
struct AFCmp {
    const bf16_t* base;
    DI uint4 load(int r, int k) const { int tok = 16 * r + (k >> 6); tok = tok < S_ ? tok : S_ - 1; return *(const uint4*)(base + (size_t)tok * PLD + (k & 63)); }
};

template <class AF, class EPI>
DI void gemm_tile(const AF af, const bf16_t* __restrict__ Bt, const int K, const int m0, const int n0, const EPI epi, char* smem) {
    bf16_t* sA = (bf16_t*)smem; bf16_t* sB = sA + 128 * 72;
    const int tid = threadIdx.x, wave = tid >> 6, lane = tid & 63, wm = wave >> 1, wn = wave & 1, rr = lane & 31, hh = lane >> 5;
    f32x16 acc[2][2];
#pragma unroll
    for (int a = 0; a < 2; ++a)
#pragma unroll
        for (int b = 0; b < 2; ++b)
#pragma unroll
            for (int i = 0; i < 16; ++i) acc[a][b][i] = 0.f;
    const int lrow = tid >> 3, lk = (tid & 7) * 8;
#define GLOAD(KO) \
    ra0 = af.load(m0 + lrow, (KO) + lk); ra1 = af.load(m0 + lrow + 32, (KO) + lk); ra2 = af.load(m0 + lrow + 64, (KO) + lk); ra3 = af.load(m0 + lrow + 96, (KO) + lk); \
    rb0 = *(const uint4*)(Bt + (size_t)(lrow) * K + (KO) + lk); rb1 = *(const uint4*)(Bt + (size_t)(lrow + 32) * K + (KO) + lk); \
    rb2 = *(const uint4*)(Bt + (size_t)(lrow + 64) * K + (KO) + lk); rb3 = *(const uint4*)(Bt + (size_t)(lrow + 96) * K + (KO) + lk);
    uint4 ra0, ra1, ra2, ra3, rb0, rb1, rb2, rb3;
    GLOAD(0)
#pragma unroll 1
    for (int k0 = 0; k0 < K; k0 += 64) {
        __syncthreads();
        *(uint4*)&sA[(lrow) * 72 + lk] = ra0; *(uint4*)&sA[(lrow + 32) * 72 + lk] = ra1; *(uint4*)&sA[(lrow + 64) * 72 + lk] = ra2; *(uint4*)&sA[(lrow + 96) * 72 + lk] = ra3;
        *(uint4*)&sB[(lrow) * 72 + lk] = rb0; *(uint4*)&sB[(lrow + 32) * 72 + lk] = rb1; *(uint4*)&sB[(lrow + 64) * 72 + lk] = rb2; *(uint4*)&sB[(lrow + 96) * 72 + lk] = rb3;
        __syncthreads();
        if (k0 + 64 < K) { GLOAD(k0 + 64) }
#pragma unroll
        for (int ks = 0; ks < 4; ++ks) {
            bf16x8 tf[2], wf[2];
#pragma unroll
            for (int t = 0; t < 2; ++t) tf[t] = *(const bf16x8*)&sA[(wm * 64 + t * 32 + rr) * 72 + ks * 16 + hh * 8];
#pragma unroll
            for (int w = 0; w < 2; ++w) wf[w] = *(const bf16x8*)&sB[(wn * 64 + w * 32 + rr) * 72 + ks * 16 + hh * 8];
#pragma unroll
            for (int w = 0; w < 2; ++w)
#pragma unroll
                for (int t = 0; t < 2; ++t) acc[w][t] = MFMA32(wf[w], tf[t], acc[w][t]);
        }
    }
#undef GLOAD
    epi(acc, m0 + wm * 64, n0 + wn * 64, lane);
}

struct EpiProj {
    bf16_t* C;
    DI void operator()(const f32x16 (&acc)[2][2], int rowbase, int colbase, int lane) const {
        const int rr = lane & 31, hh = lane >> 5;
#pragma unroll
        for (int w = 0; w < 2; ++w)
#pragma unroll
            for (int t = 0; t < 2; ++t)
#pragma unroll
                for (int j = 0; j < 4; ++j) {
                    uint2 o; o.x = pack2(acc[w][t][4 * j], acc[w][t][4 * j + 1]); o.y = pack2(acc[w][t][4 * j + 2], acc[w][t][4 * j + 3]);
                    *(uint2*)(C + (size_t)(rowbase + t * 32 + rr) * PLD + colbase + w * 32 + j * 8 + hh * 4) = o;
                }
    }
};
struct EpiHid {
    bf16_t* H; const float* bias;
    DI void operator()(const f32x16 (&acc)[2][2], int rowbase, int colbase, int lane) const {
        const int rr = lane & 31, hh = lane >> 5;
#pragma unroll
        for (int w = 0; w < 2; ++w)
#pragma unroll
            for (int t = 0; t < 2; ++t)
#pragma unroll
                for (int j = 0; j < 4; ++j) {
                    const int col = colbase + w * 32 + j * 8 + hh * 4;
                    const float4 bv = *(const float4*)(bias + col);
                    float v0 = acc[w][t][4 * j] + bv.x, v1 = acc[w][t][4 * j + 1] + bv.y, v2 = acc[w][t][4 * j + 2] + bv.z, v3 = acc[w][t][4 * j + 3] + bv.w;
                    v0 *= sigmoidf_(v0); v1 *= sigmoidf_(v1); v2 *= sigmoidf_(v2); v3 *= sigmoidf_(v3);
                    uint2 o; o.x = pack2(v0, v1); o.y = pack2(v2, v3);
                    *(uint2*)(H + (size_t)(rowbase + t * 32 + rr) * 256 + col) = o;
                }
    }
};
struct EpiKc {
    bf16_t* kc; const float *cosT, *sinT; int tokbase;
    DI void operator()(const f32x16 (&acc)[2][2], int rowbase, int colbase, int lane) const {
        if (colbase != 0) return;
        const int rr = lane & 31, hh = lane >> 5;
#pragma unroll
        for (int t = 0; t < 2; ++t) {
            const int r = rowbase + t * 32 + rr;
            int tk = 31 + 16 * r; tk = tk < S_ ? tk : S_ - 1;
            const float4 c = *(const float4*)(cosT + (size_t)(tokbase + tk) * 8 + hh * 4), s = *(const float4*)(sinT + (size_t)(tokbase + tk) * 8 + hh * 4);
            bf16_t* kp = kc + (size_t)r * 64 + hh * 4;
            const float a0 = acc[0][t][0], a1 = acc[0][t][1], a2 = acc[0][t][2], a3 = acc[0][t][3];
            const float b0 = acc[0][t][4], b1 = acc[0][t][5], b2 = acc[0][t][6], b3 = acc[0][t][7];
            uint2 o;
            o.x = pack2(a0 * c.x - b0 * s.x, a1 * c.y - b1 * s.y); o.y = pack2(a2 * c.z - b2 * s.z, a3 * c.w - b3 * s.w);
            *(uint2*)(kp) = o;
            o.x = pack2(b0 * c.x + a0 * s.x, b1 * c.y + a1 * s.y); o.y = pack2(b2 * c.z + a2 * s.z, b3 * c.w + a3 * s.w);
            *(uint2*)(kp + 8) = o;
#pragma unroll
            for (int j = 2; j < 4; ++j) {
                o.x = pack2(acc[0][t][4 * j], acc[0][t][4 * j + 1]); o.y = pack2(acc[0][t][4 * j + 2], acc[0][t][4 * j + 3]);
                *(uint2*)(kp + j * 8) = o;
            }
#pragma unroll
            for (int j = 0; j < 4; ++j) {
                o.x = pack2(acc[1][t][4 * j], acc[1][t][4 * j + 1]); o.y = pack2(acc[1][t][4 * j + 2], acc[1][t][4 * j + 3]);
                *(uint2*)(kp + 32 + j * 8) = o;
            }
        }
    }
};
struct EpiVc {
    bf16_t* vcT; char* smem;
    DI void operator()(const f32x16 (&acc)[2][2], int rowbase, int colbase, int lane) const {
        const int rr = lane & 31, hh = lane >> 5;
        bf16_t* tl = (bf16_t*)smem;
        __syncthreads();
        if (colbase == 0) {
            const int rl = rowbase & 127;
#pragma unroll
            for (int w = 0; w < 2; ++w)
#pragma unroll
                for (int t = 0; t < 2; ++t)
#pragma unroll
                    for (int i = 0; i < 16; ++i) tl[(w * 32 + crow(i, hh)) * 136 + rl + t * 32 + rr] = f2bf(acc[w][t][i]);
        }
        __syncthreads();
        const int m0 = rowbase & ~127;
#pragma unroll
        for (int i = 0; i < 4; ++i) {
            const int c = threadIdx.x + i * 256, d = c >> 4, ch = c & 15;
            *(uint4*)(vcT + (size_t)d * 1024 + m0 + ch * 8) = *(const uint4*)&tl[d * 136 + ch * 8];
        }
    }
};
struct EpiOut {
    float* out; const float* x;
    DI void operator()(const f32x16 (&acc)[2][2], int rowbase, int colbase, int lane) const {
        const int rr = lane & 31, hh = lane >> 5;
#pragma unroll
        for (int w = 0; w < 2; ++w)
#pragma unroll
            for (int t = 0; t < 2; ++t)
#pragma unroll
                for (int j = 0; j < 4; ++j) {
                    const size_t o = (size_t)(rowbase + t * 32 + rr) * 1024 + colbase + w * 32 + j * 8 + hh * 4;
                    float4 xv = *(const float4*)(x + o);
                    xv.x += acc[w][t][4 * j]; xv.y += acc[w][t][4 * j + 1]; xv.z += acc[w][t][4 * j + 2]; xv.w += acc[w][t][4 * j + 3];
                    *(float4*)(out + o) = xv;
                }
    }
};
struct EpiFfn1 {
    bf16_t* act;
    DI void operator()(const f32x16 (&acc)[2][2], int rowbase, int colbase, int lane) const {
        const int rr = lane & 31, hh = lane >> 5;
        const int cb = (colbase >> 6) * 32;
#pragma unroll
        for (int t = 0; t < 2; ++t)
#pragma unroll
            for (int j = 0; j < 4; ++j) {
                float v[4];
#pragma unroll
                for (int i = 0; i < 4; ++i) { const float g = acc[0][t][4 * j + i], u = acc[1][t][4 * j + i]; v[i] = g * sigmoidf_(g) * u; }
                uint2 o; o.x = pack2(v[0], v[1]); o.y = pack2(v[2], v[3]);
                *(uint2*)(act + (size_t)(rowbase + t * 32 + rr) * DFF + cb + j * 8 + hh * 4) = o;
            }
    }
};

DI void rwkv_prep(const P& p, int idx, char* smem) {
    const int tile = idx >> 3, h = idx & 7, tt0 = tile * 32;
    const int tid = threadIdx.x, wave = tid >> 6, lane = tid & 63, rr = lane & 31, hh = lane >> 5;
    bf16_t* lat = (bf16_t*)smem;
    float* res = (float*)(smem + 32 * 296 * 2);
    __syncthreads();
    for (int c = tid; c < 32 * 36; c += NTHR) {
        const int tok = c / 36, ch = c - tok * 36, gi = tt0 + tok, col = 1536 + ch * 8;
        const uint4 cu = *(const uint4*)(p.proj + (size_t)gi * PLD + col);
        uint4 pv = make_uint4(0, 0, 0, 0);
        if ((gi & (S_ - 1)) != 0) pv = *(const uint4*)(p.proj + (size_t)(gi - 1) * PLD + col);
        float a[8], b[8]; unpack8(cu, a); unpack8(pv, b);
        const float4 m0 = *(const float4*)(p.mu + col), m1 = *(const float4*)(p.mu + col + 4);
        const float mu[8] = {m0.x, m0.y, m0.z, m0.w, m1.x, m1.y, m1.z, m1.w};
#pragma unroll
        for (int e = 0; e < 8; ++e) {
            float x = a[e] + (b[e] - a[e]) * mu[e];
            if (ch < 8) x = tanhf(x); else if (ch >= 16) x = sigmoidf_(x);
            a[e] = x;
        }
        *(uint4*)&lat[tok * 296 + ch * 8] = pack8(a);
    }
    __syncthreads();
    if (wave < 2) {
        const int mt = wave;
        f32x16 aw, aa;
#pragma unroll
        for (int i = 0; i < 16; ++i) { aw[i] = 0.f; aa[i] = 0.f; }
#pragma unroll
        for (int ks = 0; ks < 4; ++ks) {
            const bf16x8 wf = *(const bf16x8*)(p.w2T + (size_t)(h * 64 + mt * 32 + rr) * 64 + ks * 16 + hh * 8);
            const bf16x8 af = *(const bf16x8*)(p.a2T + (size_t)(h * 64 + mt * 32 + rr) * 64 + ks * 16 + hh * 8);
            const bf16x8 l0 = *(const bf16x8*)&lat[rr * 296 + ks * 16 + hh * 8];
            const bf16x8 l1 = *(const bf16x8*)&lat[rr * 296 + 64 + ks * 16 + hh * 8];
            aw = MFMA32(wf, l0, aw); aa = MFMA32(af, l1, aa);
        }
#pragma unroll
        for (int j = 0; j < 4; ++j) {
            *(float4*)&res[(0 * 32 + rr) * 64 + mt * 32 + j * 8 + hh * 4] = make_float4(aw[4 * j], aw[4 * j + 1], aw[4 * j + 2], aw[4 * j + 3]);
            *(float4*)&res[(1 * 32 + rr) * 64 + mt * 32 + j * 8 + hh * 4] = make_float4(aa[4 * j], aa[4 * j + 1], aa[4 * j + 2], aa[4 * j + 3]);
        }
    } else {
        const int mt = wave - 2;
        f32x16 ag;
#pragma unroll
        for (int i = 0; i < 16; ++i) ag[i] = 0.f;
#pragma unroll
        for (int ks = 0; ks < 10; ++ks) {
            const bf16x8 gf = *(const bf16x8*)(p.g2T + (size_t)(h * 64 + mt * 32 + rr) * 160 + ks * 16 + hh * 8);
            const bf16x8 l2 = *(const bf16x8*)&lat[rr * 296 + 128 + ks * 16 + hh * 8];
            ag = MFMA32(gf, l2, ag);
        }
#pragma unroll
        for (int j = 0; j < 4; ++j)
            *(float4*)&res[(2 * 32 + rr) * 64 + mt * 32 + j * 8 + hh * 4] = make_float4(ag[4 * j], ag[4 * j + 1], ag[4 * j + 2], ag[4 * j + 3]);
    }
    __syncthreads();
    {
        const int tok = tid >> 3, cgp = tid & 7, gi = tt0 + tok, b = gi >> 14, s = gi & (S_ - 1), cb = h * 64 + cgp * 8;
        const bool first = (s == 0);
        float r[8], k[8], v[8];
        {
            float a[8], pb[8];
            const bf16_t* pr = p.proj + (size_t)gi * PLD;
#pragma unroll
            for (int q = 0; q < 3; ++q) {
                const int col = q * 512 + cb;
                unpack8(*(const uint4*)(pr + col), a);
                if (first) {
#pragma unroll
                    for (int e = 0; e < 8; ++e) pb[e] = 0.f;
                } else unpack8(*(const uint4*)(pr - PLD + col), pb);
                const float4 m0 = *(const float4*)(p.mu + col), m1 = *(const float4*)(p.mu + col + 4);
                const float mu[8] = {m0.x, m0.y, m0.z, m0.w, m1.x, m1.y, m1.z, m1.w};
#pragma unroll
                for (int e = 0; e < 8; ++e) {
                    const float x = a[e] + (pb[e] - a[e]) * mu[e];
                    if (q == 0) r[e] = x; else if (q == 1) k[e] = x; else v[e] = x;
                }
            }
        }
        float om[8], av[8], gg[8], kk[8], km[8], bb[8];
        float ss = 0.f;
#pragma unroll
        for (int e = 0; e < 8; ++e) {
            const float wp = res[(0 * 32 + tok) * 64 + cgp * 8 + e] + p.w0[cb + e];
            const float z = -wp;
            const float sp = fmaxf(z, 0.f) + log1pf(__expf(-fabsf(z)));
            const float w = -sp - 0.5f;
            om[e] = -expm1f(-__expf(w));
            av[e] = sigmoidf_(res[(1 * 32 + tok) * 64 + cgp * 8 + e] + p.a0[cb + e]);
            gg[e] = res[(2 * 32 + tok) * 64 + cgp * 8 + e];
            kk[e] = k[e] * p.k_k[cb + e];
            ss += kk[e] * kk[e];
            km[e] = k[e] * (1.f + (av[e] - 1.f) * p.k_a[cb + e]);
        }
        ss += __shfl_xor(ss, 1); ss += __shfl_xor(ss, 2); ss += __shfl_xor(ss, 4);
        const float inv = 1.f / fmaxf(sqrtf(ss), 1e-12f);
#pragma unroll
        for (int e = 0; e < 8; ++e) { kk[e] *= inv; bb[e] = kk[e] * av[e]; }
        bf16_t* sp = p.stream + ((size_t)((b * 8 + h) * S_ + s) * 6) * 64 + cgp * 8;
        *(uint4*)(sp) = pack8(om); *(uint4*)(sp + 64) = pack8(km); *(uint4*)(sp + 128) = pack8(kk);
        *(uint4*)(sp + 192) = pack8(bb); *(uint4*)(sp + 256) = pack8(r); *(uint4*)(sp + 320) = pack8(v);
        *(uint4*)(p.gbuf + (size_t)gi * 512 + cb) = pack8(gg);
    }
}

DI void rope_item(const P& p, int idx, char* smem) {
    const int tt0 = idx * 64, tid = threadIdx.x;
    bf16_t* vtile = (bf16_t*)smem;
    __syncthreads();
#pragma unroll 1
    for (int it = 0; it < 2; ++it) {
        const int item = tid + it * 256, tok = item >> 3, head = item & 7, gi = tt0 + tok;
        bf16_t* ptr = p.proj + (size_t)gi * PLD + QC + head * 64;
        const float4 c0 = *(const float4*)(p.cosT + (size_t)gi * 8), c1 = *(const float4*)(p.cosT + (size_t)gi * 8 + 4);
        const float4 s0 = *(const float4*)(p.sinT + (size_t)gi * 8), s1 = *(const float4*)(p.sinT + (size_t)gi * 8 + 4);
        const float cc[8] = {c0.x, c0.y, c0.z, c0.w, c1.x, c1.y, c1.z, c1.w}, sn[8] = {s0.x, s0.y, s0.z, s0.w, s1.x, s1.y, s1.z, s1.w};
        float a[8], b[8];
        unpack8(*(const uint4*)ptr, a); unpack8(*(const uint4*)(ptr + 8), b);
#pragma unroll
        for (int e = 0; e < 8; ++e) { const float x1 = a[e], x2 = b[e]; a[e] = (x1 * cc[e] - x2 * sn[e]) * 0.125f; b[e] = (x2 * cc[e] + x1 * sn[e]) * 0.125f; }
        *(uint4*)ptr = pack8(a); *(uint4*)(ptr + 8) = pack8(b);
#pragma unroll
        for (int q = 2; q < 8; ++q) {
            unpack8(*(const uint4*)(ptr + q * 8), a);
#pragma unroll
            for (int e = 0; e < 8; ++e) a[e] *= 0.125f;
            *(uint4*)(ptr + q * 8) = pack8(a);
        }
    }
    {
        const int tok = tid >> 2, sel = (tid >> 1) & 1, hk = tid & 1, gi = tt0 + tok;
        const float4 c0 = *(const float4*)(p.cosT + (size_t)gi * 8), c1 = *(const float4*)(p.cosT + (size_t)gi * 8 + 4);
        const float4 s0 = *(const float4*)(p.sinT + (size_t)gi * 8), s1 = *(const float4*)(p.sinT + (size_t)gi * 8 + 4);
        const float cc[8] = {c0.x, c0.y, c0.z, c0.w, c1.x, c1.y, c1.z, c1.w}, sn[8] = {s0.x, s0.y, s0.z, s0.w, s1.x, s1.y, s1.z, s1.w};
        float a[8], b[8];
        {
            bf16_t* ptr = p.proj + (size_t)gi * PLD + KVC + (sel ? 4 : 2) * 128 + hk * 64;
            unpack8(*(const uint4*)ptr, a); unpack8(*(const uint4*)(ptr + 8), b);
#pragma unroll
            for (int e = 0; e < 8; ++e) { const float x1 = a[e], x2 = b[e]; a[e] = x1 * cc[e] - x2 * sn[e]; b[e] = x2 * cc[e] + x1 * sn[e]; }
            *(uint4*)ptr = pack8(a); *(uint4*)(ptr + 8) = pack8(b);
        }
        {
            const bf16_t* ptr = p.proj + (size_t)gi * PLD + KVC + (sel ? 5 : 3) * 128 + hk * 64;
            bf16_t* vt = vtile + (size_t)((sel * 2 + hk) * 64) * 72 + tok;
            unpack8(*(const uint4*)ptr, a); unpack8(*(const uint4*)(ptr + 8), b);
#pragma unroll
            for (int e = 0; e < 8; ++e) { const float x1 = a[e], x2 = b[e]; a[e] = x1 * cc[e] - x2 * sn[e]; b[e] = x2 * cc[e] + x1 * sn[e]; }
#pragma unroll
            for (int e = 0; e < 8; ++e) { vt[e * 72] = f2bf(a[e]); vt[(8 + e) * 72] = f2bf(b[e]); }
#pragma unroll
            for (int q = 2; q < 8; ++q) {
                const uint4 u = *(const uint4*)(ptr + q * 8);
                const unsigned w[4] = {u.x, u.y, u.z, u.w};
#pragma unroll
                for (int e = 0; e < 4; ++e) { vt[(q * 8 + 2 * e) * 72] = (bf16_t)(w[e] & 0xffffu); vt[(q * 8 + 2 * e + 1) * 72] = (bf16_t)(w[e] >> 16); }
            }
        }
    }
    __syncthreads();
    const int b = tt0 >> 14, s0 = tt0 & (S_ - 1);
#pragma unroll
    for (int i = 0; i < 8; ++i) {
        const int c = tid + i * 256, grp = c >> 9, d = (c >> 3) & 63, ch = c & 7, sel = grp >> 1, hk = grp & 1;
        const uint4 u = *(const uint4*)&vtile[(size_t)(grp * 64 + d) * 72 + ch * 8];
        *(uint4*)(p.vT + ((size_t)((sel * 4 + b * 2 + hk) * 64 + d)) * S_ + s0 + ch * 8) = u;
    }
}

DI void phase2(const P& p, char* smem) {
    for (int it = blockIdx.x; it < 128 + 512 + 8192; it += gridDim.x) {
        if (it < 128) {
            const int kv = it >> 6, bhk = (it >> 4) & 3, mt = (it >> 1) & 7, nt = it & 1, b = bhk >> 1, hk = bhk & 1;
            AFCmp af{p.proj + (size_t)(b * S_) * PLD + KVC + kv * 128 + hk * 64};
            EpiHid ep{p.hid + (size_t)((kv * 4 + bhk) * 1024) * 256, p.b1p + kv * 256};
            gemm_tile(af, p.w1T + (size_t)(kv * 256 + nt * 128) * 2048, 2048, mt * 128, nt * 128, ep, smem);
        } else if (it < 640) rope_item(p, it - 128, smem);
        else rwkv_prep(p, it - 640, smem);
    }
}
DI void phase3(const P& p, char* smem) {
    for (int it = blockIdx.x; it < 64; it += gridDim.x) {
        const int kv = it >> 5, bhk = (it >> 3) & 3, mt = it & 7, b = bhk >> 1;
        AFPlain af{p.hid + (size_t)((kv * 4 + bhk) * 1024) * 256, 256};
        if (kv == 0) { EpiKc ep{p.kc + (size_t)bhk * 1024 * 64, p.cosT, p.sinT, b * S_}; gemm_tile(af, p.wc2T, 256, mt * 128, 0, ep, smem); }
        else { EpiVc ep{p.vcT + (size_t)bhk * 64 * 1024, smem}; gemm_tile(af, p.wc2T + 128 * 256, 256, mt * 128, 0, ep, smem); }
    }
}

template <int CTRL> DI float dpp_add(float x) { return x + __int_as_float(__builtin_amdgcn_mov_dpp(__float_as_int(x), CTRL, 0xF, 0xF, true)); }
DI float red16(float x) { x = dpp_add<0xB1>(x); x = dpp_add<0x4E>(x); x = dpp_add<0x141>(x); x = dpp_add<0x140>(x); return x; }

DI void scan_unit(const P& p, int su, char* smem) {
    const int xcd = su & 7, kq = su >> 3, bh = xcd * 2 + (kq >> 3), oct = kq & 7, b = bh >> 3, h = bh & 7;
    const int tid = threadIdx.x, wave = tid >> 6, lane = tid & 63;
    float* buf = (float*)smem;
    const bf16_t* sbase = p.stream + (size_t)bh * S_ * 384;
    uint4 rg[3];
    __syncthreads();
#pragma unroll
    for (int i = 0; i < 3; ++i) rg[i] = *(const uint4*)(sbase + (size_t)(tid + i * 256) * 8);
#pragma unroll
    for (int i = 0; i < 3; ++i) {
        const int ci = tid + i * 256; float f[8]; unpack8(rg[i], f);
        if ((ci % 48) < 8) {
#pragma unroll
            for (int e = 0; e < 8; ++e) f[e] = 1.f - f[e];
        }
        float* d = buf + ci * 8;
        *(float4*)d = make_float4(f[0], f[1], f[2], f[3]); *(float4*)(d + 4) = make_float4(f[4], f[5], f[6], f[7]);
    }
    __syncthreads();
    const int rl = lane >> 4, ks = lane & 15, row = oct * 8 + wave * 4 + rl;
    f2_t sA = {0.f, 0.f}, sB = {0.f, 0.f};
    float* yout = p.yraw + (size_t)(b * S_) * 512 + h * 64 + row;
    for (int c = 0; c < 1024; ++c) {
        if (c + 1 < 1024) {
#pragma unroll
            for (int i = 0; i < 3; ++i) rg[i] = *(const uint4*)(sbase + (size_t)(c + 1) * 6144 + (size_t)(tid + i * 256) * 8);
        }
        if (wave < 2) {
            const float* cb = buf + (c & 1) * 6144 + ks * 4;
            const float* vb = buf + (c & 1) * 6144 + 320 + row;
            float yp[16];
            float4 dec = *(const float4*)(cb), km = *(const float4*)(cb + 64), kk = *(const float4*)(cb + 128), bb = *(const float4*)(cb + 192), rv = *(const float4*)(cb + 256);
            float v = vb[0];
#pragma unroll
            for (int st = 0; st < 16; ++st) {
                float4 ndec = dec, nkm = km, nkk = kk, nbb = bb, nrv = rv; float nv = v;
                if (st < 15) {
                    const float* rec = cb + (st + 1) * 384;
                    ndec = *(const float4*)(rec); nkm = *(const float4*)(rec + 64); nkk = *(const float4*)(rec + 128); nbb = *(const float4*)(rec + 192); nrv = *(const float4*)(rec + 256);
                    nv = vb[(st + 1) * 384];
                }
                const f2_t vv = {v, v};
                const f2_t d01 = {dec.x, dec.y}, d23 = {dec.z, dec.w}, m01 = {km.x, km.y}, m23 = {km.z, km.w};
                const f2_t k01 = {kk.x, kk.y}, k23 = {kk.z, kk.w}, b01 = {bb.x, bb.y}, b23 = {bb.z, bb.w}, r01 = {rv.x, rv.y}, r23 = {rv.z, rv.w};
                const f2_t tA = sA * d01 + vv * m01, tB = sB * d23 + vv * m23;
                f2_t pa = sA * k01; pa = sB * k23 + pa;
                const float sa = red16(pa.x + pa.y);
                const f2_t sav = {sa, sa};
                sA = tA - sav * b01; sB = tB - sav * b23;
                f2_t ya = sA * r01; ya = sB * r23 + ya;
                yp[st] = ya.x + ya.y;
                dec = ndec; km = nkm; kk = nkk; bb = nbb; rv = nrv; v = nv;
            }
#pragma unroll
            for (int i = 0; i < 16; ++i) yp[i] = dpp_add<0xB1>(yp[i]);
#pragma unroll
            for (int i = 0; i < 16; ++i) yp[i] = dpp_add<0x4E>(yp[i]);
#pragma unroll
            for (int i = 0; i < 16; ++i) yp[i] = dpp_add<0x141>(yp[i]);
#pragma unroll
            for (int i = 0; i < 16; ++i) yp[i] = dpp_add<0x140>(yp[i]);
            if (ks == 0) {
#pragma unroll
                for (int i = 0; i < 16; ++i) yout[(size_t)(c * 16 + i) * 512] = yp[i];
            }
        }
        if (c + 1 < 1024) {
            float* nb = buf + ((c + 1) & 1) * 6144;
#pragma unroll
            for (int i = 0; i < 3; ++i) {
                const int ci = tid + i * 256; float f[8]; unpack8(rg[i], f);
                if ((ci % 48) < 8) {
#pragma unroll
                    for (int e = 0; e < 8; ++e) f[e] = 1.f - f[e];
                }
                float* d = nb + ci * 8;
                *(float4*)d = make_float4(f[0], f[1], f[2], f[3]); *(float4*)(d + 4) = make_float4(f[4], f[5], f[6], f[7]);
            }
        }
        __syncthreads();
    }
}

struct AttnSmem {
    bf16_t k[64 * 72];
    bf16_t vt[64 * 68];
    float imp[32 * 256];
    unsigned selbits[32 * 8];
    unsigned wunion[4 * 8];
    unsigned bunion[8];
    int unit;
};

DI void attn_load(const bf16_t* kbase, int kstride, const bf16_t* vtbase, int vtstride, uint4 (&r)[4], int tid, bool needv) {
#pragma unroll
    for (int i = 0; i < 2; ++i) { const int c = tid + i * 256; r[i] = *(const uint4*)(kbase + (size_t)(c >> 3) * kstride + (c & 7) * 8); }
    if (needv) {
#pragma unroll
        for (int i = 0; i < 2; ++i) { const int c = tid + i * 256; r[2 + i] = *(const uint4*)(vtbase + (size_t)(c >> 3) * vtstride + (c & 7) * 8); }
    }
}
DI void attn_store(AttnSmem& sm, const uint4 (&r)[4], int tid, bool needv) {
#pragma unroll
    for (int i = 0; i < 2; ++i) { const int c = tid + i * 256; *(uint4*)&sm.k[(c >> 3) * 72 + (c & 7) * 8] = r[i]; }
    if (needv) {
#pragma unroll
        for (int i = 0; i < 2; ++i) {
            const int c = tid + i * 256; bf16_t* d = &sm.vt[(c >> 3) * 68 + (c & 7) * 8];
            *(uint2*)d = make_uint2(r[2 + i].x, r[2 + i].y); *(uint2*)(d + 4) = make_uint2(r[2 + i].z, r[2 + i].w);
        }
    }
}

template <int MODE>
DI void attn_tile(AttnSmem& sm, const bf16x8 (&qf)[4], f32x16 (&o)[2], float& m, float& l, const float inv_l, const int lo, const int hi,
                  const int lane, const int tokl, const int jbase) {
    const int rr = lane & 31, hh = lane >> 5;
    f32x16 s[2];
#pragma unroll
    for (int mt = 0; mt < 2; ++mt) {
#pragma unroll
        for (int i = 0; i < 16; ++i) s[mt][i] = 0.f;
#pragma unroll
        for (int ks = 0; ks < 4; ++ks) {
            const bf16x8 kf = *(const bf16x8*)&sm.k[(mt * 32 + rr) * 72 + ks * 16 + hh * 8];
            s[mt] = MFMA32(kf, qf[ks], s[mt]);
        }
        asm volatile("" ::: "memory");
    }
    const float L2E = 1.4426950408889634f;
    const int lo2 = lo - 4 * hh, hi2 = hi - 4 * hh;
    float mx = -1e30f;
#pragma unroll
    for (int mt = 0; mt < 2; ++mt)
#pragma unroll
        for (int i = 0; i < 16; ++i) {
            const int kc_ = mt * 32 + (i & 3) + 8 * (i >> 2);
            float v = s[mt][i] * L2E;
            v = (kc_ >= lo2 && kc_ <= hi2) ? v : -1e30f;
            s[mt][i] = v; mx = fmaxf(mx, v);
        }
    float mref = m;
    if (MODE != 2) {
        mx = fmaxf(mx, __shfl_xor(mx, 32));
        const float mnew = fmaxf(m, mx);
        const float alpha = __builtin_amdgcn_exp2f(m - mnew);
        m = mnew; mref = mnew;
        l *= alpha;
        if (MODE == 1) {
#pragma unroll
            for (int dt = 0; dt < 2; ++dt)
#pragma unroll
                for (int i = 0; i < 16; ++i) o[dt][i] *= alpha;
        }
    }
    float psum = 0.f;
#pragma unroll
    for (int mt = 0; mt < 2; ++mt)
#pragma unroll
        for (int i = 0; i < 16; ++i) {
            const float v = s[mt][i];
            float pv = (v > -1e29f) ? __builtin_amdgcn_exp2f(v - mref) : 0.f;
            if (MODE == 2) pv *= inv_l;
            s[mt][i] = pv; psum += pv;
        }
    if (MODE != 2) l += psum;
    if (MODE == 0) return;
    if (MODE == 2) {
#pragma unroll
        for (int mt = 0; mt < 2; ++mt)
#pragma unroll
            for (int jj = 0; jj < 4; ++jj) {
                float q4 = (s[mt][4 * jj] + s[mt][4 * jj + 1]) + (s[mt][4 * jj + 2] + s[mt][4 * jj + 3]);
                float e3 = s[mt][4 * jj + 3];
                q4 += __shfl_xor(q4, 1); q4 += __shfl_xor(q4, 2);
                e3 += __shfl_xor(e3, 1); e3 += __shfl_xor(e3, 2);
                if ((rr & 3) == 0) {
                    const int j = jbase + mt * 8 + 2 * jj + hh;
                    atomicAdd(&sm.imp[tokl * 256 + j], q4);
                    if (j + 1 < 256) atomicAdd(&sm.imp[tokl * 256 + j + 1], e3);
                }
            }
    }
#pragma unroll
    for (int mt = 0; mt < 2; ++mt)
#pragma unroll
        for (int s2 = 0; s2 < 2; ++s2) {
            uint4 pu;
            pu.x = pack2(s[mt][8 * s2 + 0], s[mt][8 * s2 + 1]); pu.y = pack2(s[mt][8 * s2 + 2], s[mt][8 * s2 + 3]);
            pu.z = pack2(s[mt][8 * s2 + 4], s[mt][8 * s2 + 5]); pu.w = pack2(s[mt][8 * s2 + 6], s[mt][8 * s2 + 7]);
            const bf16x8 pf = __builtin_bit_cast(bf16x8, pu);
            asm volatile("" ::: "memory");
#pragma unroll
            for (int dt = 0; dt < 2; ++dt) {
                const bf16_t* vp = &sm.vt[(dt * 32 + rr) * 68 + mt * 32 + s2 * 16 + hh * 4];
                const uint2 v0 = *(const uint2*)vp, v1 = *(const uint2*)(vp + 8);
                const bf16x8 vf = __builtin_bit_cast(bf16x8, make_uint4(v0.x, v0.y, v1.x, v1.y));
                o[dt] = MFMA32(vf, pf, o[dt]);
            }
        }
}

DI unsigned wave_umax(unsigned v) {
#pragma unroll
    for (int o = 32; o; o >>= 1) { const unsigned t = (unsigned)__shfl_xor((int)v, o); v = v > t ? v : t; }
    return v;
}

DI void attn_unit(const P& p, int u, char* smem) {
    AttnSmem& sm = *(AttnSmem*)smem;
    const int tid = threadIdx.x, wave = tid >> 6, lane = tid & 63, rr = lane & 31, hh = lane >> 5;
    const int tile = 511 - (u >> 2), bhk = u & 3, b = bhk >> 1, hk = bhk & 1, t0 = tile * 32;
    const int tokl = wave * 8 + (rr >> 2), t = t0 + tokl, g = rr & 3, head = hk * 4 + g;
    const size_t tokg = (size_t)b * S_ + t;
    bf16x8 qf[4];
#pragma unroll
    for (int ks = 0; ks < 4; ++ks) qf[ks] = *(const bf16x8*)(p.proj + tokg * PLD + QC + head * 64 + ks * 16 + hh * 8);
    float gate[3];
#pragma unroll
    for (int i = 0; i < 3; ++i) gate[i] = sigmoidf_(__uint_as_float((unsigned)p.proj[tokg * PLD + GC + head * 3 + i] << 16));
#pragma unroll
    for (int i = 0; i < 8; ++i) *(float4*)&sm.imp[(tid + i * 256) * 4] = make_float4(0.f, 0.f, 0.f, 0.f);
    sm.selbits[tid] = 0u;
    f32x16 o[2];
#pragma unroll
    for (int dt = 0; dt < 2; ++dt)
#pragma unroll
        for (int i = 0; i < 16; ++i) o[dt][i] = 0.f;
    float* park = &sm.imp[wave * 2048 + lane];
    uint4 rg[4];
    const int ntc = (t0 >> 10) + 1;
    const int vmaxi = (t >= 31) ? ((t - 31) >> 4) : -1;
    const bf16_t* kcb = p.kc + (size_t)bhk * 1024 * 64;
    const bf16_t* vcb = p.vcT + (size_t)bhk * 64 * 1024;
    float m = -1e30f, l = 0.f;
    attn_load(kcb, 64, vcb, 1024, rg, tid, false);
    for (int j = 0; j < ntc; ++j) {
        __syncthreads();
        attn_store(sm, rg, tid, false);
        __syncthreads();
        if (j + 1 < ntc) attn_load(kcb + (size_t)(j + 1) * 64 * 64, 64, vcb, 1024, rg, tid, false);
        attn_tile<0>(sm, qf, o, m, l, 0.f, 0, vmaxi - j * 64, lane, tokl, 0);
    }
    {
        const float lt = l + __shfl_xor(l, 32);
        const float inv_l = lt > 0.f ? 1.f / lt : 0.f;
        attn_load(kcb, 64, vcb, 1024, rg, tid, true);
        for (int j = 0; j < ntc; ++j) {
            __syncthreads();
            attn_store(sm, rg, tid, true);
            __syncthreads();
            if (j + 1 < ntc) attn_load(kcb + (size_t)(j + 1) * 64 * 64, 64, vcb + (j + 1) * 64, 1024, rg, tid, true);
            attn_tile<2>(sm, qf, o, m, l, inv_l, 0, vmaxi - j * 64, lane, tokl, j * 16);
        }
    }
    __syncthreads();
    const int cur = t0 >> 6;
    for (int tk = 0; tk < 8; ++tk) {
        const int tl = wave * 8 + tk;
        const float* ip = &sm.imp[tl * 256];
        unsigned nib = 0u;
        if (cur <= 15) {
#pragma unroll
            for (int e = 0; e < 4; ++e) if (lane * 4 + e <= cur) nib |= 1u << e;
        } else {
            unsigned k0, k1, k2, k3;
            {
                const float4 iv = *(const float4*)(ip + lane * 4);
                const int j0 = lane * 4;
                k0 = (j0 >= 1 && j0 <= cur - 2) ? ((__float_as_uint(iv.x) & 0xFFFFFF00u) | (unsigned)(255 - j0)) : 0u;
                k1 = (j0 + 1 <= cur - 2) ? ((__float_as_uint(iv.y) & 0xFFFFFF00u) | (unsigned)(254 - j0)) : 0u;
                k2 = (j0 + 2 <= cur - 2) ? ((__float_as_uint(iv.z) & 0xFFFFFF00u) | (unsigned)(253 - j0)) : 0u;
                k3 = (j0 + 3 <= cur - 2) ? ((__float_as_uint(iv.w) & 0xFFFFFF00u) | (unsigned)(252 - j0)) : 0u;
#pragma unroll
                for (int e = 0; e < 4; ++e) { const int j = j0 + e; if (j == 0 || j == cur || j == cur - 1) nib |= 1u << e; }
            }
            for (int r = 0; r < 13; ++r) {
                unsigned lm = k0 > k1 ? k0 : k1; const unsigned lm2 = k2 > k3 ? k2 : k3; lm = lm > lm2 ? lm : lm2;
                const unsigned wm = wave_umax(lm);
                if (k0 == wm) { k0 = 0u; nib |= 1u; }
                if (k1 == wm) { k1 = 0u; nib |= 2u; }
                if (k2 == wm) { k2 = 0u; nib |= 4u; }
                if (k3 == wm) { k3 = 0u; nib |= 8u; }
            }
        }
        atomicOr(&sm.selbits[tl * 8 + (lane >> 3)], nib << ((lane & 7) * 4));
    }
    __syncthreads();
    if (tid < 32) {
        const int w = tid >> 3, d = tid & 7; unsigned uu = 0u;
#pragma unroll
        for (int k = 0; k < 8; ++k) uu |= sm.selbits[(w * 8 + k) * 8 + d];
        sm.wunion[w * 8 + d] = uu;
    }
    __syncthreads();
    if (tid < 8) sm.bunion[tid] = sm.wunion[tid] | sm.wunion[8 + tid] | sm.wunion[16 + tid] | sm.wunion[24 + tid];
    __syncthreads();
#pragma unroll
    for (int dt = 0; dt < 2; ++dt)
#pragma unroll
        for (int i = 0; i < 16; ++i) { park[(dt * 16 + i) * 64] = gate[0] * o[dt][i]; o[dt][i] = 0.f; }
    {
        const bf16_t* kb = p.proj + (size_t)(b * S_) * PLD + KVC + 2 * 128 + hk * 64;
        const bf16_t* vb = p.vT + (size_t)((0 * 4 + bhk) * 64) * S_;
        m = -1e30f; l = 0.f;
        auto nextj = [&](int j) -> int {
            ++j;
            while (j <= cur) {
                const unsigned w = sm.bunion[j >> 5] >> (j & 31);
                if (w) { j += __ffs((int)w) - 1; return j <= cur ? j : -1; }
                j = (j | 31) + 1;
            }
            return -1;
        };
        int j = nextj(-1);
        if (j >= 0) attn_load(kb + (size_t)j * 64 * PLD, PLD, vb + j * 64, S_, rg, tid, true);
        while (j >= 0) {
            __syncthreads();
            attn_store(sm, rg, tid, true);
            __syncthreads();
            const int jn = nextj(j);
            if (jn >= 0) attn_load(kb + (size_t)jn * 64 * PLD, PLD, vb + jn * 64, S_, rg, tid, true);
            if ((sm.wunion[wave * 8 + (j >> 5)] >> (j & 31)) & 1u) {
                const bool selme = (sm.selbits[tokl * 8 + (j >> 5)] >> (j & 31)) & 1u;
                const int hi = selme ? (j < cur ? 63 : t - j * 64) : -1;
                attn_tile<1>(sm, qf, o, m, l, 0.f, 0, hi, lane, tokl, 0);
            }
            j = jn;
        }
        const float lt = l + __shfl_xor(l, 32);
        const float sc = lt > 0.f ? gate[1] / lt : 0.f;
#pragma unroll
        for (int dt = 0; dt < 2; ++dt)
#pragma unroll
            for (int i = 0; i < 16; ++i) { park[(dt * 16 + i) * 64] += sc * o[dt][i]; o[dt][i] = 0.f; }
    }
    {
        const bf16_t* kb = p.proj + (size_t)(b * S_) * PLD + KVC + 4 * 128 + hk * 64;
        const bf16_t* vb = p.vT + (size_t)((1 * 4 + bhk) * 64) * S_;
        m = -1e30f; l = 0.f;
        const int jlo = (t0 >= 511) ? ((t0 - 511) >> 6) : 0, jhi = t0 >> 6;
        attn_load(kb + (size_t)jlo * 64 * PLD, PLD, vb + jlo * 64, S_, rg, tid, true);
        for (int j = jlo; j <= jhi; ++j) {
            __syncthreads();
            attn_store(sm, rg, tid, true);
            __syncthreads();
            if (j + 1 <= jhi) attn_load(kb + (size_t)(j + 1) * 64 * PLD, PLD, vb + (j + 1) * 64, S_, rg, tid, true);
            attn_tile<1>(sm, qf, o, m, l, 0.f, t - 511 - j * 64, t - j * 64, lane, tokl, 0);
        }
        const float lt = l + __shfl_xor(l, 32);
        const float sc = lt > 0.f ? gate[2] / lt : 0.f;
#pragma unroll
        for (int dt = 0; dt < 2; ++dt)
#pragma unroll
            for (int i = 0; i < 16; ++i) o[dt][i] = park[(dt * 16 + i) * 64] + sc * o[dt][i];
    }
    bf16_t* mp = p.A + tokg * 1024 + 512 + head * 64;
#pragma unroll
    for (int dt = 0; dt < 2; ++dt)
#pragma unroll
        for (int jj = 0; jj < 4; ++jj) {
            uint2 ov; ov.x = pack2(o[dt][4 * jj], o[dt][4 * jj + 1]); ov.y = pack2(o[dt][4 * jj + 2], o[dt][4 * jj + 3]);
            *(uint2*)(mp + dt * 32 + jj * 8 + hh * 4) = ov;
        }
}

DI void phase4(const P& p, char* smem) {
    for (int su = blockIdx.x; su < 128; su += gridDim.x) scan_unit(p, su, smem);
    AttnSmem& sm = *(AttnSmem*)smem;
    while (true) {
        __syncthreads();
        if (threadIdx.x == 0) sm.unit = (int)atomicAdd(p.counter, 1u);
        __syncthreads();
        const int u = sm.unit;
        if (u >= 2048) break;
        attn_unit(p, u, smem);
    }
}

DI void phase4b(const P& p) {
    const int tid = threadIdx.x;
    for (int it = blockIdx.x; it < T_ / 4; it += gridDim.x) {
        const int gi = it * 4 + (tid >> 6), cgp = tid & 63, h = cgp >> 3, c8 = (cgp & 7) * 8, col = cgp * 8, b = gi >> 14, s = gi & (S_ - 1);
        const float4 y0 = *(const float4*)(p.yraw + (size_t)gi * 512 + col), y1 = *(const float4*)(p.yraw + (size_t)gi * 512 + col + 4);
        float y[8] = {y0.x, y0.y, y0.z, y0.w, y1.x, y1.y, y1.z, y1.w};
        const bf16_t* sp = p.stream + ((size_t)((b * 8 + h) * S_ + s) * 6) * 64 + c8;
        float km[8], r[8], v[8], gg[8];
        unpack8(*(const uint4*)(sp + 64), km); unpack8(*(const uint4*)(sp + 256), r); unpack8(*(const uint4*)(sp + 320), v);
        unpack8(*(const uint4*)(p.gbuf + (size_t)gi * 512 + col), gg);
        float sum = 0.f, bon = 0.f;
#pragma unroll
        for (int e = 0; e < 8; ++e) { sum += y[e]; bon += r[e] * km[e] * p.r_k[col + e]; }
        sum += __shfl_xor(sum, 1); sum += __shfl_xor(sum, 2); sum += __shfl_xor(sum, 4);
        bon += __shfl_xor(bon, 1); bon += __shfl_xor(bon, 2); bon += __shfl_xor(bon, 4);
        const float mean = sum * (1.f / 64.f);
        float var = 0.f;
#pragma unroll
        for (int e = 0; e < 8; ++e) { y[e] -= mean; var += y[e] * y[e]; }
        var += __shfl_xor(var, 1); var += __shfl_xor(var, 2); var += __shfl_xor(var, 4);
        const float rs = rsqrtf(var * (1.f / 64.f) + 64e-5f);
        float o[8];
#pragma unroll
        for (int e = 0; e < 8; ++e) o[e] = (y[e] * rs * p.lnx_w[col + e] + p.lnx_b[col + e] + bon * v[e]) * gg[e];
        *(uint4*)(p.A + (size_t)gi * 1024 + col) = pack8(o);
    }
}

struct EpiFfn2 {
    float* out;
    DI void operator()(const f32x16 (&acc)[2][2], int rowbase, int colbase, int lane) const {
        const int rr = lane & 31, hh = lane >> 5;
#pragma unroll
        for (int w = 0; w < 2; ++w)
#pragma unroll
            for (int t = 0; t < 2; ++t)
#pragma unroll
                for (int j = 0; j < 4; ++j) {
                    float4* o = (float4*)(out + (size_t)(rowbase + t * 32 + rr) * 1024 + colbase + w * 32 + j * 8 + hh * 4);
                    float4 xv = *o;
                    xv.x += acc[w][t][4 * j]; xv.y += acc[w][t][4 * j + 1]; xv.z += acc[w][t][4 * j + 2]; xv.w += acc[w][t][4 * j + 3];
                    *o = xv;
                }
    }
};

DI void final_item(float* io, const float* g, int idx) {
    const int row = idx * 4 + (threadIdx.x >> 6), lane = threadIdx.x & 63;
    float4* sp = (float4*)(io + (size_t)row * 1024);
    float4 v[4]; float ss = 0.f;
#pragma unroll
    for (int i = 0; i < 4; ++i) { v[i] = sp[lane + 64 * i]; ss += v[i].x * v[i].x + v[i].y * v[i].y + v[i].z * v[i].z + v[i].w * v[i].w; }
    ss = wave_sum(ss);
    const float rs = rsqrtf(ss * (1.f / 1024.f) + 1e-6f);
#pragma unroll
    for (int i = 0; i < 4; ++i) {
        const float4 gv = ((const float4*)g)[lane + 64 * i];
        sp[lane + 64 * i] = make_float4(v[i].x * rs * gv.x, v[i].y * rs * gv.y, v[i].z * rs * gv.z, v[i].w * rs * gv.w);
    }
}

DI void run_phase(const P& p, int ph, char* smem) {
    switch (ph) {
    case 0: phase0(p, smem); break;
    case 1:
        for (int it = blockIdx.x; it < 256 * 25; it += gridDim.x) {
            const int mt = it / 25, nt = it - mt * 25;
            gemm_tile(AFPlain{p.A, 1024}, p.WinT + (size_t)nt * 128 * 1024, 1024, mt * 128, nt * 128, EpiProj{p.proj}, smem);
        }
        break;
    case 2: phase2(p, smem); break;
    case 3: phase3(p, smem); break;
    case 4: phase4(p, smem); break;
    case 5: phase4b(p); break;
    case 6:
        for (int it = blockIdx.x; it < 256 * 8; it += gridDim.x) {
            const int mt = it >> 3, nt = it & 7;
            gemm_tile(AFPlain{p.A, 1024}, p.WoutT + (size_t)nt * 128 * 1024, 1024, mt * 128, nt * 128, EpiOut{p.out, p.x}, smem);
        }
        break;
    case 7:
        for (int it = blockIdx.x; it < T_ / 4; it += gridDim.x) rms_item(p.out, p.norm_ffn, p.A, it);
        break;
    case 8:
        for (int it = blockIdx.x; it < 256 * 44; it += gridDim.x) {
            const int mt = it / 44, nt = it - mt * 44;
            gemm_tile(AFPlain{p.A, 1024}, p.WguT + (size_t)nt * 128 * 1024, 1024, mt * 128, nt * 128, EpiFfn1{p.stream}, smem);
        }
        break;
    case 9:
        for (int it = blockIdx.x; it < 256 * 8; it += gridDim.x) {
            const int mt = it >> 3, nt = it & 7;
            gemm_tile(AFPlain{p.stream, DFF}, p.WdnT + (size_t)nt * 128 * DFF, DFF, mt * 128, nt * 128, EpiFfn2{p.out}, smem);
        }
        break;
    default:
        for (int it = blockIdx.x; it < T_ / 4; it += gridDim.x) final_item(p.out, p.norm_final, it);
        break;
    }
}
constexpr int NPHASE = 11;
constexpr int SMEM_BYTES = 57344;

__global__ void __launch_bounds__(NTHR, 2) mega_kernel(P p) {
    __shared__ __attribute__((aligned(16))) char smem[SMEM_BYTES];
    cg::grid_group grid = cg::this_grid();
    run_phase(p, 0, smem); grid.sync();
    run_phase(p, 1, smem); grid.sync();
    run_phase(p, 2, smem); grid.sync();
    run_phase(p, 3, smem); grid.sync();
    run_phase(p, 4, smem); grid.sync();
    run_phase(p, 5, smem); grid.sync();
    run_phase(p, 6, smem); grid.sync();
    run_phase(p, 7, smem); grid.sync();
    run_phase(p, 8, smem); grid.sync();
    run_phase(p, 9, smem); grid.sync();
    run_phase(p, 10, smem);
}
__global__ void __launch_bounds__(NTHR, 2) phase_kernel(P p, int ph) {
    __shared__ __attribute__((aligned(16))) char smem[SMEM_BYTES];
    run_phase(p, ph, smem);
}

extern "C" void kernel_launch(void* const* d_in, const int* in_sizes, int n_in, void* d_out, int out_size, void* d_ws, size_t ws_size,
                              hipStream_t stream) {
    P p{};
    p.x = (const float*)d_in[0]; p.pos = (const int*)d_in[1]; p.norm_mix = (const float*)d_in[2]; p.w_in = (const float*)d_in[3];
    p.mu = (const float*)d_in[4]; p.w0 = (const float*)d_in[5]; p.w2 = (const float*)d_in[6]; p.a0 = (const float*)d_in[7];
    p.a2 = (const float*)d_in[8]; p.g2 = (const float*)d_in[9]; p.k_k = (const float*)d_in[10]; p.k_a = (const float*)d_in[11];
    p.r_k = (const float*)d_in[12]; p.lnx_w = (const float*)d_in[13]; p.lnx_b = (const float*)d_in[14]; p.pe_k = (const float*)d_in[15];
    p.wk1 = (const float*)d_in[16]; p.bk1 = (const float*)d_in[17]; p.wk2 = (const float*)d_in[18]; p.pe_v = (const float*)d_in[19];
    p.wv1 = (const float*)d_in[20]; p.bv1 = (const float*)d_in[21]; p.wv2 = (const float*)d_in[22]; p.w_out = (const float*)d_in[23];
    p.norm_ffn = (const float*)d_in[24]; p.w_gate = (const float*)d_in[25]; p.w_up = (const float*)d_in[26]; p.w_down = (const float*)d_in[27];
    p.norm_final = (const float*)d_in[28];
    p.out = (float*)d_out;
    char* ws = (char*)d_ws;
    size_t off = 0;
    auto take = [&](size_t bytes) { char* r = ws + off; off += (bytes + 255) & ~(size_t)255; return r; };
    p.WinT = (bf16_t*)take((size_t)3200 * 1024 * 2);
    p.WoutT = (bf16_t*)take((size_t)1024 * 1024 * 2);
    p.WguT = (bf16_t*)take((size_t)5632 * 1024 * 2);
    p.WdnT = (bf16_t*)take((size_t)1024 * DFF * 2);
    p.w2T = (bf16_t*)take(512 * 64 * 2);
    p.a2T = (bf16_t*)take(512 * 64 * 2);
    p.g2T = (bf16_t*)take(512 * 160 * 2);
    p.w1T = (bf16_t*)take((size_t)2 * 256 * 2048 * 2);
    p.wc2T = (bf16_t*)take(2 * 128 * 256 * 2);
    p.b1p = (float*)take(512 * 4);
    p.cosT = (float*)take((size_t)T_ * 8 * 4);
    p.sinT = (float*)take((size_t)T_ * 8 * 4);
    p.counter = (unsigned*)take(256);
    off = (size_t)32 << 20;
    p.A = (bf16_t*)take((size_t)T_ * 1024 * 2);
    p.proj = (bf16_t*)take((size_t)T_ * PLD * 2);
    p.stream = (bf16_t*)take((size_t)T_ * 8 * 384 * 2);
    if (off > ws_size) fprintf(stderr, "workspace too small: need %zu have %zu\n", off, ws_size);
    char* ob = (char*)d_out;
    p.gbuf = (bf16_t*)ob;
    p.yraw = (float*)(ob + ((size_t)32 << 20));
    p.vT = (bf16_t*)(ob + ((size_t)96 << 20));
    p.hid = (bf16_t*)(ob + ((size_t)112 << 20));
    p.kc = (bf16_t*)(ob + ((size_t)116 << 20));
    p.vcT = (bf16_t*)(ob + ((size_t)116 << 20) + (512 << 10));
#if MK_SINGLE
    static int grid_blocks = 0;
    if (!grid_blocks) {
        int dev = 0, cus = 0, per_cu = 0;
        hipGetDevice(&dev);
        hipDeviceGetAttribute(&cus, hipDeviceAttributeMultiprocessorCount, dev);
        hipOccupancyMaxActiveBlocksPerMultiprocessor(&per_cu, mega_kernel, NTHR, 0);
        if (per_cu > 2) per_cu = 2;
        if (per_cu < 1) per_cu = 1;
        grid_blocks = cus * per_cu;
    }
    void* args[] = {&p};
    hipError_t e = hipLaunchCooperativeKernel((void*)mega_kernel, dim3(grid_blocks), dim3(NTHR), args, 0, stream);
    if (e != hipSuccess) fprintf(stderr, "cooperative launch failed: %s (grid %d)\n", hipGetErrorString(e), grid_blocks);
#else
    for (int ph = 0; ph < NPHASE; ++ph) phase_kernel<<<512, NTHR, 0, stream>>>(p, ph);
#endif
}
```

```cpp
#include <hip/hip_runtime.h>
#include <hip/hip_cooperative_groups.h>
#include <cstdio>
namespace cg = cooperative_groups;

#ifndef MK_SINGLE
#define MK_SINGLE 1
#endif

#define DI __device__ __forceinline__
typedef unsigned short bf16_t;
typedef short bf16x8 __attribute__((ext_vector_type(8)));
typedef float f32x16 __attribute__((ext_vector_type(16)));
typedef __bf16 bf2_t __attribute__((ext_vector_type(2)));
typedef float f2_t __attribute__((ext_vector_type(2)));

constexpr int T_ = 32768, S_ = 16384;
constexpr int PLD = 3200;
constexpr int QC = 1856, KVC = 2368, GC = 3136;
constexpr int DFF = 2816;
constexpr int NTHR = 256;

#define MFMA32(a, b, c) __builtin_amdgcn_mfma_f32_32x32x16_bf16((a), (b), (c), 0, 0, 0)

DI unsigned pack2(float a, float b) { f2_t v = {a, b}; return __builtin_bit_cast(unsigned, __builtin_convertvector(v, bf2_t)); }
DI float bflo(unsigned u) { return __uint_as_float(u << 16); }
DI float bfhi(unsigned u) { return __uint_as_float(u & 0xffff0000u); }
DI bf16_t f2bf(float a) { return (bf16_t)(pack2(a, 0.f) & 0xffffu); }
DI void unpack8(const uint4& u, float (&f)[8]) {
    f[0] = bflo(u.x); f[1] = bfhi(u.x); f[2] = bflo(u.y); f[3] = bfhi(u.y);
    f[4] = bflo(u.z); f[5] = bfhi(u.z); f[6] = bflo(u.w); f[7] = bfhi(u.w);
}
DI uint4 pack8(const float (&f)[8]) { uint4 u; u.x = pack2(f[0], f[1]); u.y = pack2(f[2], f[3]); u.z = pack2(f[4], f[5]); u.w = pack2(f[6], f[7]); return u; }
DI float wave_sum(float v) {
#pragma unroll
    for (int o = 32; o; o >>= 1) v += __shfl_xor(v, o);
    return v;
}
DI float sigmoidf_(float x) { return 1.f / (1.f + __expf(-x)); }
DI int crow(int reg, int h) { return (reg & 3) + 8 * (reg >> 2) + 4 * h; }

struct P {
    const float* x; const int* pos; const float *norm_mix, *w_in, *mu, *w0, *w2, *a0, *a2, *g2, *k_k, *k_a, *r_k, *lnx_w, *lnx_b,
        *pe_k, *wk1, *bk1, *wk2, *pe_v, *wv1, *bv1, *wv2, *w_out, *norm_ffn, *w_gate, *w_up, *w_down, *norm_final;
    float* out;
    bf16_t *WinT, *WoutT, *WguT, *WdnT, *w2T, *a2T, *g2T, *w1T, *wc2T;
    float *b1p, *cosT, *sinT;
    unsigned* counter; unsigned* bar;
    bf16_t *A, *proj, *stream;
    bf16_t* gbuf; float* yraw; bf16_t *vT, *hid, *kc, *vcT;
};

DI float tr_val(const P& p, int job, int k, int n) {
    switch (job) {
    case 0: { int c = n < 1824 ? n : ((n >= 1856 && n < 3160) ? n - 32 : -1); return c >= 0 ? p.w_in[(size_t)k * 3128 + c] : 0.f; }
    case 1: return p.w_out[k * 1024 + n];
    case 2: { int q = n >> 6, r = n & 63; return r < 32 ? p.w_gate[(size_t)k * DFF + q * 32 + r] : p.w_up[(size_t)k * DFF + q * 32 + r - 32]; }
    case 3: return p.w_down[(size_t)k * 1024 + n];
    case 4: return p.w2[k * 512 + n];
    case 5: return p.a2[k * 512 + n];
    case 6: return p.g2[k * 512 + n];
    case 7: return p.wk1[k * 256 + n];
    case 8: return p.wv1[k * 256 + n];
    case 9: return n < 64 ? p.wk2[k * 64 + n] : 0.f;
    default: return n < 64 ? p.wv2[k * 64 + n] : 0.f;
    }
}
DI void tr_item(const P& p, int it, float* tile) {
    int job, K, N; bf16_t* dst;
    if (it < 800) { job = 0; K = 1024; N = 3200; dst = p.WinT; }
    else if (it < 1056) { job = 1; it -= 800; K = 1024; N = 1024; dst = p.WoutT; }
    else if (it < 2464) { job = 2; it -= 1056; K = 1024; N = 5632; dst = p.WguT; }
    else if (it < 3168) { job = 3; it -= 2464; K = 2816; N = 1024; dst = p.WdnT; }
    else if (it < 3176) { job = 4; it -= 3168; K = 64; N = 512; dst = p.w2T; }
    else if (it < 3184) { job = 5; it -= 3176; K = 64; N = 512; dst = p.a2T; }
    else if (it < 3208) { job = 6; it -= 3184; K = 160; N = 512; dst = p.g2T; }
    else if (it < 3336) { job = 7; it -= 3208; K = 2048; N = 256; dst = p.w1T; }
    else if (it < 3464) { job = 8; it -= 3336; K = 2048; N = 256; dst = p.w1T + 256 * 2048; }
    else if (it < 3472) { job = 9; it -= 3464; K = 256; N = 128; dst = p.wc2T; }
    else { job = 10; it -= 3472; K = 256; N = 128; dst = p.wc2T + 128 * 256; }
    const int nt = N >> 6;
    const int k0 = (it / nt) * 64, n0 = (it % nt) * 64;
    const int tid = threadIdx.x;
    __syncthreads();
#pragma unroll 4
    for (int i = 0; i < 16; ++i) {
        const int kk = i * 4 + (tid >> 6), nn = tid & 63;
        tile[kk * 65 + nn] = (k0 + kk < K) ? tr_val(p, job, k0 + kk, n0 + nn) : 0.f;
    }
    __syncthreads();
#pragma unroll 4
    for (int i = 0; i < 16; ++i) {
        const int nn = i * 4 + (tid >> 6), kk = tid & 63;
        if (k0 + kk < K) dst[(size_t)(n0 + nn) * K + k0 + kk] = f2bf(tile[kk * 65 + nn]);
    }
}
DI void b1_item(const P& p, int idx) {
    const int kv = idx >> 4, jc = idx & 15, tid = threadIdx.x;
    const float* pe = kv ? p.pe_v : p.pe_k; const float* w1 = kv ? p.wv1 : p.wk1; const float* b1 = kv ? p.bv1 : p.bk1;
    const int j = jc * 16 + (tid >> 4), kl = tid & 15;
    float s = 0.f;
    for (int i = 0; i < 128; ++i) { const int k = kl + 16 * i; s += pe[k] * w1[k * 256 + j]; }
    s += __shfl_xor(s, 1); s += __shfl_xor(s, 2); s += __shfl_xor(s, 4); s += __shfl_xor(s, 8);
    if (kl == 0) p.b1p[kv * 256 + j] = b1[j] + s;
}
DI void sincos_d(float ang, float& c, float& s) {
    double x = (double)ang;
    const double TWO_PI = 6.283185307179586476925286766559;
    double n = __builtin_rint(x * (1.0 / TWO_PI));
    double r = x - n * TWO_PI;
    double q = r * 0.25;
    double q2 = q * q;
    double sn = q * (1.0 + q2 * (-1.0 / 6 + q2 * (1.0 / 120 + q2 * (-1.0 / 5040 + q2 * (1.0 / 362880 + q2 * (-1.0 / 39916800 + q2 * (1.0 / 6227020800.0)))))));
    double cs = 1.0 + q2 * (-0.5 + q2 * (1.0 / 24 + q2 * (-1.0 / 720 + q2 * (1.0 / 40320 + q2 * (-1.0 / 3628800 + q2 * (1.0 / 479001600.0))))));
    double s2 = 2 * sn * cs, c2 = 1 - 2 * sn * sn;
    double s4 = 2 * s2 * c2, c4 = 1 - 2 * s2 * s2;
    c = (float)c4; s = (float)s4;
}
DI void cs_item(const P& p, int idx) {
    const int e = idx * 256 + threadIdx.x, tok = e >> 3, f = e & 7;
    const float invf[8] = {1.000000000e+00f, 1.939227432e-01f, 3.760603070e-02f, 7.292664610e-03f, 1.414213562e-03f, 2.742481884e-04f, 5.318295734e-05f, 1.031338525e-05f};
    float iv = invf[0];
#pragma unroll
    for (int i = 1; i < 8; ++i) iv = (f == i) ? invf[i] : iv;
    const float ang = (float)p.pos[tok] * iv;
    float c, s; sincos_d(ang, c, s);
    p.cosT[e] = c; p.sinT[e] = s;
}
DI void rms_item(const float* src, const float* g, bf16_t* dst, int idx) {
    const int row = idx * 4 + (threadIdx.x >> 6), lane = threadIdx.x & 63;
    const float4* sp = (const float4*)(src + (size_t)row * 1024);
    float4 v[4]; float ss = 0.f;
#pragma unroll
    for (int i = 0; i < 4; ++i) { v[i] = sp[lane + 64 * i]; ss += v[i].x * v[i].x + v[i].y * v[i].y + v[i].z * v[i].z + v[i].w * v[i].w; }
    ss = wave_sum(ss);
    const float rs = rsqrtf(ss * (1.f / 1024.f) + 1e-6f);
#pragma unroll
    for (int i = 0; i < 4; ++i) {
        const float4 gv = ((const float4*)g)[lane + 64 * i];
        uint2 o; o.x = pack2(v[i].x * rs * gv.x, v[i].y * rs * gv.y); o.y = pack2(v[i].z * rs * gv.z, v[i].w * rs * gv.w);
        *(uint2*)(dst + (size_t)row * 1024 + (lane + 64 * i) * 4) = o;
    }
}
DI void phase0(const P& p, char* smem) {
    if (blockIdx.x == 0 && threadIdx.x == 0) *p.counter = 0u;
    constexpr int NTR = 3480, NB1 = 32, NCS = 1024, NXN = 8192;
    for (int it = blockIdx.x; it < NTR + NB1 + NCS + NXN; it += gridDim.x) {
        if (it < NTR) tr_item(p, it, (float*)smem);
        else if (it < NTR + NB1) b1_item(p, it - NTR);
        else if (it < NTR + NB1 + NCS) cs_item(p, it - NTR - NB1);
        else rms_item(p.x, p.norm_mix, p.A, it - NTR - NB1 - NCS);
    }
}

struct AFPlain { const bf16_t* A; int lda; DI uint4 load(int row, int k) const { return *(const uint4*)(A + (size_t)row * lda + k); } };
struct AFCmp {
    const bf16_t* base;
    DI uint4 load(int r, int k) const { int tok = 16 * r + (k >> 6); tok = tok < S_ ? tok : S_ - 1; return *(const uint4*)(base + (size_t)tok * PLD + (k & 63)); }
};

template <class AF, class EPI>
DI void gemm_tile(const AF af, const bf16_t* __restrict__ Bt, const int K, const int m0, const int n0, const EPI epi, char* smem) {
    bf16_t* sA = (bf16_t*)smem; bf16_t* sB = sA + 128 * 72;
    const int tid = threadIdx.x, wave = tid >> 6, lane = tid & 63, wm = wave >> 1, wn = wave & 1, rr = lane & 31, hh = lane >> 5;
    f32x16 acc[2][2];
#pragma unroll
    for (int a = 0; a < 2; ++a)
#pragma unroll
        for (int b = 0; b < 2; ++b)
#pragma unroll
            for (int i = 0; i < 16; ++i) acc[a][b][i] = 0.f;
    const int lrow = tid >> 3, lk = (tid & 7) * 8;
#define GLOAD(KO) \
    ra0 = af.load(m0 + lrow, (KO) + lk); ra1 = af.load(m0 + lrow + 32, (KO) + lk); ra2 = af.load(m0 + lrow + 64, (KO) + lk); ra3 = af.load(m0 + lrow + 96, (KO) + lk); \
    rb0 = *(const uint4*)(Bt + (size_t)(lrow) * K + (KO) + lk); rb1 = *(const uint4*)(Bt + (size_t)(lrow + 32) * K + (KO) + lk); \
    rb2 = *(const uint4*)(Bt + (size_t)(lrow + 64) * K + (KO) + lk); rb3 = *(const uint4*)(Bt + (size_t)(lrow + 96) * K + (KO) + lk);
    uint4 ra0, ra1, ra2, ra3, rb0, rb1, rb2, rb3;
    GLOAD(0)
#pragma unroll 1
    for (int k0 = 0; k0 < K; k0 += 64) {
        __syncthreads();
        *(uint4*)&sA[(lrow) * 72 + lk] = ra0; *(uint4*)&sA[(lrow + 32) * 72 + lk] = ra1; *(uint4*)&sA[(lrow + 64) * 72 + lk] = ra2; *(uint4*)&sA[(lrow + 96) * 72 + lk] = ra3;
        *(uint4*)&sB[(lrow) * 72 + lk] = rb0; *(uint4*)&sB[(lrow + 32) * 72 + lk] = rb1; *(uint4*)&sB[(lrow + 64) * 72 + lk] = rb2; *(uint4*)&sB[(lrow + 96) * 72 + lk] = rb3;
        __syncthreads();
        if (k0 + 64 < K) { GLOAD(k0 + 64) }
#pragma unroll
        for (int ks = 0; ks < 4; ++ks) {
            bf16x8 tf[2], wf[2];
#pragma unroll
            for (int t = 0; t < 2; ++t) tf[t] = *(const bf16x8*)&sA[(wm * 64 + t * 32 + rr) * 72 + ks * 16 + hh * 8];
#pragma unroll
            for (int w = 0; w < 2; ++w) wf[w] = *(const bf16x8*)&sB[(wn * 64 + w * 32 + rr) * 72 + ks * 16 + hh * 8];
#pragma unroll
            for (int w = 0; w < 2; ++w)
#pragma unroll
                for (int t = 0; t < 2; ++t) acc[w][t] = MFMA32(wf[w], tf[t], acc[w][t]);
        }
    }
#undef GLOAD
    epi(acc, m0 + wm * 64, n0 + wn * 64, lane);
}

struct EpiProj {
    bf16_t* C;
    DI void operator()(const f32x16 (&acc)[2][2], int rowbase, int colbase, int lane) const {
        const int rr = lane & 31, hh = lane >> 5;
#pragma unroll
        for (int w = 0; w < 2; ++w)
#pragma unroll
            for (int t = 0; t < 2; ++t)
#pragma unroll
                for (int j = 0; j < 4; ++j) {
                    uint2 o; o.x = pack2(acc[w][t][4 * j], acc[w][t][4 * j + 1]); o.y = pack2(acc[w][t][4 * j + 2], acc[w][t][4 * j + 3]);
                    *(uint2*)(C + (size_t)(rowbase + t * 32 + rr) * PLD + colbase + w * 32 + j * 8 + hh * 4) = o;
                }
    }
};
struct EpiHid {
    bf16_t* H; const float* bias;
    DI void operator()(const f32x16 (&acc)[2][2], int rowbase, int colbase, int lane) const {
        const int rr = lane & 31, hh = lane >> 5;
#pragma unroll
        for (int w = 0; w < 2; ++w)
#pragma unroll
            for (int t = 0; t < 2; ++t)
#pragma unroll
                for (int j = 0; j < 4; ++j) {
                    const int col = colbase + w * 32 + j * 8 + hh * 4;
                    const float4 bv = *(const float4*)(bias + col);
                    float v0 = acc[w][t][4 * j] + bv.x, v1 = acc[w][t][4 * j + 1] + bv.y, v2 = acc[w][t][4 * j + 2] + bv.z, v3 = acc[w][t][4 * j + 3] + bv.w;
                    v0 *= sigmoidf_(v0); v1 *= sigmoidf_(v1); v2 *= sigmoidf_(v2); v3 *= sigmoidf_(v3);
                    uint2 o; o.x = pack2(v0, v1); o.y = pack2(v2, v3);
                    *(uint2*)(H + (size_t)(rowbase + t * 32 + rr) * 256 + col) = o;
                }
    }
};
struct EpiKc {
    bf16_t* kc; const float *cosT, *sinT; int tokbase;
    DI void operator()(const f32x16 (&acc)[2][2], int rowbase, int colbase, int lane) const {
        if (colbase != 0) return;
        const int rr = lane & 31, hh = lane >> 5;
#pragma unroll
        for (int t = 0; t < 2; ++t) {
            const int r = rowbase + t * 32 + rr;
            int tk = 31 + 16 * r; tk = tk < S_ ? tk : S_ - 1;
            const float4 c = *(const float4*)(cosT + (size_t)(tokbase + tk) * 8 + hh * 4), s = *(const float4*)(sinT + (size_t)(tokbase + tk) * 8 + hh * 4);
            bf16_t* kp = kc + (size_t)r * 64 + hh * 4;
            const float a0 = acc[0][t][0], a1 = acc[0][t][1], a2 = acc[0][t][2], a3 = acc[0][t][3];
            const float b0 = acc[0][t][4], b1 = acc[0][t][5], b2 = acc[0][t][6], b3 = acc[0][t][7];
            uint2 o;
            o.x = pack2(a0 * c.x - b0 * s.x, a1 * c.y - b1 * s.y); o.y = pack2(a2 * c.z - b2 * s.z, a3 * c.w - b3 * s.w);
            *(uint2*)(kp) = o;
            o.x = pack2(b0 * c.x + a0 * s.x, b1 * c.y + a1 * s.y); o.y = pack2(b2 * c.z + a2 * s.z, b3 * c.w + a3 * s.w);
            *(uint2*)(kp + 8) = o;
#pragma unroll
            for (int j = 2; j < 4; ++j) {
                o.x = pack2(acc[0][t][4 * j], acc[0][t][4 * j + 1]); o.y = pack2(acc[0][t][4 * j + 2], acc[0][t][4 * j + 3]);
                *(uint2*)(kp + j * 8) = o;
            }
#pragma unroll
            for (int j = 0; j < 4; ++j) {
                o.x = pack2(acc[1][t][4 * j], acc[1][t][4 * j + 1]); o.y = pack2(acc[1][t][4 * j + 2], acc[1][t][4 * j + 3]);
                *(uint2*)(kp + 32 + j * 8) = o;
            }
        }
    }
};
struct EpiVc {
    bf16_t* vcT; char* smem;
    DI void operator()(const f32x16 (&acc)[2][2], int rowbase, int colbase, int lane) const {
        const int rr = lane & 31, hh = lane >> 5;
        bf16_t* tl = (bf16_t*)smem;
        __syncthreads();
        if (colbase == 0) {
            const int rl = rowbase & 127;
#pragma unroll
            for (int w = 0; w < 2; ++w)
#pragma unroll
                for (int t = 0; t < 2; ++t)
#pragma unroll
                    for (int i = 0; i < 16; ++i) tl[(w * 32 + crow(i, hh)) * 136 + rl + t * 32 + rr] = f2bf(acc[w][t][i]);
        }
        __syncthreads();
        const int m0 = rowbase & ~127;
#pragma unroll
        for (int i = 0; i < 4; ++i) {
            const int c = threadIdx.x + i * 256, d = c >> 4, ch = c & 15;
            *(uint4*)(vcT + (size_t)d * 1024 + m0 + ch * 8) = *(const uint4*)&tl[d * 136 + ch * 8];
        }
    }
};
struct EpiOut {
    float* out; const float* x;
    DI void operator()(const f32x16 (&acc)[2][2], int rowbase, int colbase, int lane) const {
        const int rr = lane & 31, hh = lane >> 5;
#pragma unroll
        for (int w = 0; w < 2; ++w)
#pragma unroll
            for (int t = 0; t < 2; ++t)
#pragma unroll
                for (int j = 0; j < 4; ++j) {
                    const size_t o = (size_t)(rowbase + t * 32 + rr) * 1024 + colbase + w * 32 + j * 8 + hh * 4;
                    float4 xv = *(const float4*)(x + o);
                    xv.x += acc[w][t][4 * j]; xv.y += acc[w][t][4 * j + 1]; xv.z += acc[w][t][4 * j + 2]; xv.w += acc[w][t][4 * j + 3];
                    *(float4*)(out + o) = xv;
                }
    }
};
struct EpiFfn1 {
    bf16_t* act;
    DI void operator()(const f32x16 (&acc)[2][2], int rowbase, int colbase, int lane) const {
        const int rr = lane & 31, hh = lane >> 5;
        const int cb = (colbase >> 6) * 32;
#pragma unroll
        for (int t = 0; t < 2; ++t)
#pragma unroll
            for (int j = 0; j < 4; ++j) {
                float v[4];
#pragma unroll
                for (int i = 0; i < 4; ++i) { const float g = acc[0][t][4 * j + i], u = acc[1][t][4 * j + i]; v[i] = g * sigmoidf_(g) * u; }
                uint2 o; o.x = pack2(v[0], v[1]); o.y = pack2(v[2], v[3]);
                *(uint2*)(act + (size_t)(rowbase + t * 32 + rr) * DFF + cb + j * 8 + hh * 4) = o;
            }
    }
};

DI void rwkv_prep(const P& p, int idx, char* smem) {
    const int tile = idx >> 3, h = idx & 7, tt0 = tile * 32;
    const int tid = threadIdx.x, wave = tid >> 6, lane = tid & 63, rr = lane & 31, hh = lane >> 5;
    bf16_t* lat = (bf16_t*)smem;
    float* res = (float*)(smem + 32 * 296 * 2);
    __syncthreads();
    for (int c = tid; c < 32 * 36; c += NTHR) {
        const int tok = c / 36, ch = c - tok * 36, gi = tt0 + tok, col = 1536 + ch * 8;
        const uint4 cu = *(const uint4*)(p.proj + (size_t)gi * PLD + col);
        uint4 pv = make_uint4(0, 0, 0, 0);
        if ((gi & (S_ - 1)) != 0) pv = *(const uint4*)(p.proj + (size_t)(gi - 1) * PLD + col);
        float a[8], b[8]; unpack8(cu, a); unpack8(pv, b);
        const float4 m0 = *(const float4*)(p.mu + col), m1 = *(const float4*)(p.mu + col + 4);
        const float mu[8] = {m0.x, m0.y, m0.z, m0.w, m1.x, m1.y, m1.z, m1.w};
#pragma unroll
        for (int e = 0; e < 8; ++e) {
            float x = a[e] + (b[e] - a[e]) * mu[e];
            if (ch < 8) x = tanhf(x); else if (ch >= 16) x = sigmoidf_(x);
            a[e] = x;
        }
        *(uint4*)&lat[tok * 296 + ch * 8] = pack8(a);
    }
    __syncthreads();
    if (wave < 2) {
        const int mt = wave;
        f32x16 aw, aa;
#pragma unroll
        for (int i = 0; i < 16; ++i) { aw[i] = 0.f; aa[i] = 0.f; }
#pragma unroll
        for (int ks = 0; ks < 4; ++ks) {
            const bf16x8 wf = *(const bf16x8*)(p.w2T + (size_t)(h * 64 + mt * 32 + rr) * 64 + ks * 16 + hh * 8);
            const bf16x8 af = *(const bf16x8*)(p.a2T + (size_t)(h * 64 + mt * 32 + rr) * 64 + ks * 16 + hh * 8);
            const bf16x8 l0 = *(const bf16x8*)&lat[rr * 296 + ks * 16 + hh * 8];
            const bf16x8 l1 = *(const bf16x8*)&lat[rr * 296 + 64 + ks * 16 + hh * 8];
            aw = MFMA32(wf, l0, aw); aa = MFMA32(af, l1, aa);
        }
#pragma unroll
        for (int j = 0; j < 4; ++j) {
            *(float4*)&res[(0 * 32 + rr) * 64 + mt * 32 + j * 8 + hh * 4] = make_float4(aw[4 * j], aw[4 * j + 1], aw[4 * j + 2], aw[4 * j + 3]);
            *(float4*)&res[(1 * 32 + rr) * 64 + mt * 32 + j * 8 + hh * 4] = make_float4(aa[4 * j], aa[4 * j + 1], aa[4 * j + 2], aa[4 * j + 3]);
        }
    } else {
        const int mt = wave - 2;
        f32x16 ag;
#pragma unroll
        for (int i = 0; i < 16; ++i) ag[i] = 0.f;
#pragma unroll
        for (int ks = 0; ks < 10; ++ks) {
            const bf16x8 gf = *(const bf16x8*)(p.g2T + (size_t)(h * 64 + mt * 32 + rr) * 160 + ks * 16 + hh * 8);
            const bf16x8 l2 = *(const bf16x8*)&lat[rr * 296 + 128 + ks * 16 + hh * 8];
            ag = MFMA32(gf, l2, ag);
        }
#pragma unroll
        for (int j = 0; j < 4; ++j)
            *(float4*)&res[(2 * 32 + rr) * 64 + mt * 32 + j * 8 + hh * 4] = make_float4(ag[4 * j], ag[4 * j + 1], ag[4 * j + 2], ag[4 * j + 3]);
    }
    __syncthreads();
    {
        const int tok = tid >> 3, cgp = tid & 7, gi = tt0 + tok, b = gi >> 14, s = gi & (S_ - 1), cb = h * 64 + cgp * 8;
        const bool first = (s == 0);
        float r[8], k[8], v[8];
        {
            float a[8], pb[8];
            const bf16_t* pr = p.proj + (size_t)gi * PLD;
#pragma unroll
            for (int q = 0; q < 3; ++q) {
                const int col = q * 512 + cb;
                unpack8(*(const uint4*)(pr + col), a);
                if (first) {
#pragma unroll
                    for (int e = 0; e < 8; ++e) pb[e] = 0.f;
                } else unpack8(*(const uint4*)(pr - PLD + col), pb);
                const float4 m0 = *(const float4*)(p.mu + col), m1 = *(const float4*)(p.mu + col + 4);
                const float mu[8] = {m0.x, m0.y, m0.z, m0.w, m1.x, m1.y, m1.z, m1.w};
#pragma unroll
                for (int e = 0; e < 8; ++e) {
                    const float x = a[e] + (pb[e] - a[e]) * mu[e];
                    if (q == 0) r[e] = x; else if (q == 1) k[e] = x; else v[e] = x;
                }
            }
        }
        float om[8], av[8], gg[8], kk[8], km[8], bb[8];
        float ss = 0.f;
#pragma unroll
        for (int e = 0; e < 8; ++e) {
            const float wp = res[(0 * 32 + tok) * 64 + cgp * 8 + e] + p.w0[cb + e];
            const float z = -wp;
            const float sp = fmaxf(z, 0.f) + log1pf(__expf(-fabsf(z)));
            const float w = -sp - 0.5f;
            om[e] = -expm1f(-__expf(w));
            av[e] = sigmoidf_(res[(1 * 32 + tok) * 64 + cgp * 8 + e] + p.a0[cb + e]);
            gg[e] = res[(2 * 32 + tok) * 64 + cgp * 8 + e];
            kk[e] = k[e] * p.k_k[cb + e];
            ss += kk[e] * kk[e];
            km[e] = k[e] * (1.f + (av[e] - 1.f) * p.k_a[cb + e]);
        }
        ss += __shfl_xor(ss, 1); ss += __shfl_xor(ss, 2); ss += __shfl_xor(ss, 4);
        const float inv = 1.f / fmaxf(sqrtf(ss), 1e-12f);
#pragma unroll
        for (int e = 0; e < 8; ++e) { kk[e] *= inv; bb[e] = kk[e] * av[e]; }
        bf16_t* sp = p.stream + ((size_t)((b * 8 + h) * S_ + s) * 6) * 64 + cgp * 8;
        *(uint4*)(sp) = pack8(om); *(uint4*)(sp + 64) = pack8(km); *(uint4*)(sp + 128) = pack8(kk);
        *(uint4*)(sp + 192) = pack8(bb); *(uint4*)(sp + 256) = pack8(r); *(uint4*)(sp + 320) = pack8(v);
        *(uint4*)(p.gbuf + (size_t)gi * 512 + cb) = pack8(gg);
    }
}

DI void rope_item(const P& p, int idx, char* smem) {
    const int tt0 = idx * 64, tid = threadIdx.x;
    bf16_t* vtile = (bf16_t*)smem;
    __syncthreads();
#pragma unroll 1
    for (int it = 0; it < 2; ++it) {
        const int item = tid + it * 256, tok = item >> 3, head = item & 7, gi = tt0 + tok;
        bf16_t* ptr = p.proj + (size_t)gi * PLD + QC + head * 64;
        const float4 c0 = *(const float4*)(p.cosT + (size_t)gi * 8), c1 = *(const float4*)(p.cosT + (size_t)gi * 8 + 4);
        const float4 s0 = *(const float4*)(p.sinT + (size_t)gi * 8), s1 = *(const float4*)(p.sinT + (size_t)gi * 8 + 4);
        const float cc[8] = {c0.x, c0.y, c0.z, c0.w, c1.x, c1.y, c1.z, c1.w}, sn[8] = {s0.x, s0.y, s0.z, s0.w, s1.x, s1.y, s1.z, s1.w};
        float a[8], b[8];
        unpack8(*(const uint4*)ptr, a); unpack8(*(const uint4*)(ptr + 8), b);
#pragma unroll
        for (int e = 0; e < 8; ++e) { const float x1 = a[e], x2 = b[e]; a[e] = (x1 * cc[e] - x2 * sn[e]) * 0.125f; b[e] = (x2 * cc[e] + x1 * sn[e]) * 0.125f; }
        *(uint4*)ptr = pack8(a); *(uint4*)(ptr + 8) = pack8(b);
#pragma unroll
        for (int q = 2; q < 8; ++q) {
            unpack8(*(const uint4*)(ptr + q * 8), a);
#pragma unroll
            for (int e = 0; e < 8; ++e) a[e] *= 0.125f;
            *(uint4*)(ptr + q * 8) = pack8(a);
        }
    }
    {
        const int tok = tid >> 2, sel = (tid >> 1) & 1, hk = tid & 1, gi = tt0 + tok;
        const float4 c0 = *(const float4*)(p.cosT + (size_t)gi * 8), c1 = *(const float4*)(p.cosT + (size_t)gi * 8 + 4);
        const float4 s0 = *(const float4*)(p.sinT + (size_t)gi * 8), s1 = *(const float4*)(p.sinT + (size_t)gi * 8 + 4);
        const float cc[8] = {c0.x, c0.y, c0.z, c0.w, c1.x, c1.y, c1.z, c1.w}, sn[8] = {s0.x, s0.y, s0.z, s0.w, s1.x, s1.y, s1.z, s1.w};
        float a[8], b[8];
        {
            bf16_t* ptr = p.proj + (size_t)gi * PLD + KVC + (sel ? 4 : 2) * 128 + hk * 64;
            unpack8(*(const uint4*)ptr, a); unpack8(*(const uint4*)(ptr + 8), b);
#pragma unroll
            for (int e = 0; e < 8; ++e) { const float x1 = a[e], x2 = b[e]; a[e] = x1 * cc[e] - x2 * sn[e]; b[e] = x2 * cc[e] + x1 * sn[e]; }
            *(uint4*)ptr = pack8(a); *(uint4*)(ptr + 8) = pack8(b);
        }
        {
            const bf16_t* ptr = p.proj + (size_t)gi * PLD + KVC + (sel ? 5 : 3) * 128 + hk * 64;
            bf16_t* vt = vtile + (size_t)((sel * 2 + hk) * 64) * 72 + tok;
            unpack8(*(const uint4*)ptr, a); unpack8(*(const uint4*)(ptr + 8), b);
#pragma unroll
            for (int e = 0; e < 8; ++e) { const float x1 = a[e], x2 = b[e]; a[e] = x1 * cc[e] - x2 * sn[e]; b[e] = x2 * cc[e] + x1 * sn[e]; }
#pragma unroll
            for (int e = 0; e < 8; ++e) { vt[e * 72] = f2bf(a[e]); vt[(8 + e) * 72] = f2bf(b[e]); }
#pragma unroll
            for (int q = 2; q < 8; ++q) {
                const uint4 u = *(const uint4*)(ptr + q * 8);
                const unsigned w[4] = {u.x, u.y, u.z, u.w};
#pragma unroll
                for (int e = 0; e < 4; ++e) { vt[(q * 8 + 2 * e) * 72] = (bf16_t)(w[e] & 0xffffu); vt[(q * 8 + 2 * e + 1) * 72] = (bf16_t)(w[e] >> 16); }
            }
        }
    }
    __syncthreads();
    const int b = tt0 >> 14, s0 = tt0 & (S_ - 1);
#pragma unroll
    for (int i = 0; i < 8; ++i) {
        const int c = tid + i * 256, grp = c >> 9, d = (c >> 3) & 63, ch = c & 7, sel = grp >> 1, hk = grp & 1;
        const uint4 u = *(const uint4*)&vtile[(size_t)(grp * 64 + d) * 72 + ch * 8];
        *(uint4*)(p.vT + ((size_t)((sel * 4 + b * 2 + hk) * 64 + d)) * S_ + s0 + ch * 8) = u;
    }
}

DI void phase2(const P& p, char* smem) {
    for (int it = blockIdx.x; it < 128 + 512 + 8192; it += gridDim.x) {
        if (it < 128) {
            const int kv = it >> 6, bhk = (it >> 4) & 3, mt = (it >> 1) & 7, nt = it & 1, b = bhk >> 1, hk = bhk & 1;
            AFCmp af{p.proj + (size_t)(b * S_) * PLD + KVC + kv * 128 + hk * 64};
            EpiHid ep{p.hid + (size_t)((kv * 4 + bhk) * 1024) * 256, p.b1p + kv * 256};
            gemm_tile(af, p.w1T + (size_t)(kv * 256 + nt * 128) * 2048, 2048, mt * 128, nt * 128, ep, smem);
        } else if (it < 640) rope_item(p, it - 128, smem);
        else rwkv_prep(p, it - 640, smem);
    }
}
DI void phase3(const P& p, char* smem) {
    for (int it = blockIdx.x; it < 64; it += gridDim.x) {
        const int kv = it >> 5, bhk = (it >> 3) & 3, mt = it & 7, b = bhk >> 1;
        AFPlain af{p.hid + (size_t)((kv * 4 + bhk) * 1024) * 256, 256};
        if (kv == 0) { EpiKc ep{p.kc + (size_t)bhk * 1024 * 64, p.cosT, p.sinT, b * S_}; gemm_tile(af, p.wc2T, 256, mt * 128, 0, ep, smem); }
        else { EpiVc ep{p.vcT + (size_t)bhk * 64 * 1024, smem}; gemm_tile(af, p.wc2T + 128 * 256, 256, mt * 128, 0, ep, smem); }
    }
}

template <int CTRL> DI float dpp_add(float x) { return x + __int_as_float(__builtin_amdgcn_mov_dpp(__float_as_int(x), CTRL, 0xF, 0xF, true)); }
DI float red16(float x) { x = dpp_add<0xB1>(x); x = dpp_add<0x4E>(x); x = dpp_add<0x141>(x); x = dpp_add<0x140>(x); return x; }

DI void scan_unit(const P& p, int su, char* smem) {
    const int xcd = su & 7, kq = su >> 3, bh = xcd * 2 + (kq >> 3), oct = kq & 7, b = bh >> 3, h = bh & 7;
    const int tid = threadIdx.x, wave = tid >> 6, lane = tid & 63;
    float* buf = (float*)smem;
    const bf16_t* sbase = p.stream + (size_t)bh * S_ * 384;
    uint4 rg[3];
    __syncthreads();
#pragma unroll
    for (int i = 0; i < 3; ++i) rg[i] = *(const uint4*)(sbase + (size_t)(tid + i * 256) * 8);
#pragma unroll
    for (int i = 0; i < 3; ++i) {
        const int ci = tid + i * 256; float f[8]; unpack8(rg[i], f);
        if ((ci % 48) < 8) {
#pragma unroll
            for (int e = 0; e < 8; ++e) f[e] = 1.f - f[e];
        }
        float* d = buf + ci * 8;
        *(float4*)d = make_float4(f[0], f[1], f[2], f[3]); *(float4*)(d + 4) = make_float4(f[4], f[5], f[6], f[7]);
    }
    __syncthreads();
    const int rl = lane >> 4, ks = lane & 15, row = oct * 8 + wave * 4 + rl;
    f2_t sA = {0.f, 0.f}, sB = {0.f, 0.f};
    if (wave < 2) __builtin_amdgcn_s_setprio(3);
    float* yout = p.yraw + (size_t)(b * S_) * 512 + h * 64 + row;
    for (int c = 0; c < 1024; ++c) {
        if (c + 1 < 1024) {
#pragma unroll
            for (int i = 0; i < 3; ++i) rg[i] = *(const uint4*)(sbase + (size_t)(c + 1) * 6144 + (size_t)(tid + i * 256) * 8);
        }
        if (wave < 2) {
            const float* cb = buf + (c & 1) * 6144 + ks * 4;
            const float* vb = buf + (c & 1) * 6144 + 320 + row;
            float yp[16];
            float4 dec = *(const float4*)(cb), km = *(const float4*)(cb + 64), kk = *(const float4*)(cb + 128), bb = *(const float4*)(cb + 192), rv = *(const float4*)(cb + 256);
            float v = vb[0];
#pragma unroll
            for (int st = 0; st < 16; ++st) {
                float4 ndec = dec, nkm = km, nkk = kk, nbb = bb, nrv = rv; float nv = v;
                if (st < 15) {
                    const float* rec = cb + (st + 1) * 384;
                    ndec = *(const float4*)(rec); nkm = *(const float4*)(rec + 64); nkk = *(const float4*)(rec + 128); nbb = *(const float4*)(rec + 192); nrv = *(const float4*)(rec + 256);
                    nv = vb[(st + 1) * 384];
                }
                const f2_t vv = {v, v};
                const f2_t d01 = {dec.x, dec.y}, d23 = {dec.z, dec.w}, m01 = {km.x, km.y}, m23 = {km.z, km.w};
                const f2_t k01 = {kk.x, kk.y}, k23 = {kk.z, kk.w}, b01 = {bb.x, bb.y}, b23 = {bb.z, bb.w}, r01 = {rv.x, rv.y}, r23 = {rv.z, rv.w};
                const f2_t tA = sA * d01 + vv * m01, tB = sB * d23 + vv * m23;
                f2_t pa = sA * k01; pa = sB * k23 + pa;
                const float sa = red16(pa.x + pa.y);
                const f2_t sav = {sa, sa};
                sA = tA - sav * b01; sB = tB - sav * b23;
                f2_t ya = sA * r01; ya = sB * r23 + ya;
                yp[st] = ya.x + ya.y;
                dec = ndec; km = nkm; kk = nkk; bb = nbb; rv = nrv; v = nv;
            }
#pragma unroll
            for (int i = 0; i < 16; ++i) yp[i] = dpp_add<0xB1>(yp[i]);
#pragma unroll
            for (int i = 0; i < 16; ++i) yp[i] = dpp_add<0x4E>(yp[i]);
#pragma unroll
            for (int i = 0; i < 16; ++i) yp[i] = dpp_add<0x141>(yp[i]);
#pragma unroll
            for (int i = 0; i < 16; ++i) yp[i] = dpp_add<0x140>(yp[i]);
            if (ks == 0) {
#pragma unroll
                for (int i = 0; i < 16; ++i) yout[(size_t)(c * 16 + i) * 512] = yp[i];
            }
        }
        if (c + 1 < 1024) {
            float* nb = buf + ((c + 1) & 1) * 6144;
#pragma unroll
            for (int i = 0; i < 3; ++i) {
                const int ci = tid + i * 256; float f[8]; unpack8(rg[i], f);
                if ((ci % 48) < 8) {
#pragma unroll
                    for (int e = 0; e < 8; ++e) f[e] = 1.f - f[e];
                }
                float* d = nb + ci * 8;
                *(float4*)d = make_float4(f[0], f[1], f[2], f[3]); *(float4*)(d + 4) = make_float4(f[4], f[5], f[6], f[7]);
            }
        }
        __syncthreads();
    }
    __builtin_amdgcn_s_setprio(0);
}

struct AttnSmem {
    bf16_t k[64 * 72];
    bf16_t vt[64 * 68];
    float imp[32 * 256];
    unsigned selbits[32 * 8];
    unsigned wunion[4 * 8];
    unsigned bunion[8];
    int unit;
};

DI void attn_load(const bf16_t* kbase, int kstride, const bf16_t* vtbase, int vtstride, uint4 (&r)[4], int tid, bool needv) {
#pragma unroll
    for (int i = 0; i < 2; ++i) { const int c = tid + i * 256; r[i] = *(const uint4*)(kbase + (size_t)(c >> 3) * kstride + (c & 7) * 8); }
    if (needv) {
#pragma unroll
        for (int i = 0; i < 2; ++i) { const int c = tid + i * 256; r[2 + i] = *(const uint4*)(vtbase + (size_t)(c >> 3) * vtstride + (c & 7) * 8); }
    }
}
DI void attn_store(AttnSmem& sm, const uint4 (&r)[4], int tid, bool needv) {
#pragma unroll
    for (int i = 0; i < 2; ++i) { const int c = tid + i * 256; *(uint4*)&sm.k[(c >> 3) * 72 + (c & 7) * 8] = r[i]; }
    if (needv) {
#pragma unroll
        for (int i = 0; i < 2; ++i) {
            const int c = tid + i * 256; bf16_t* d = &sm.vt[(c >> 3) * 68 + (c & 7) * 8];
            *(uint2*)d = make_uint2(r[2 + i].x, r[2 + i].y); *(uint2*)(d + 4) = make_uint2(r[2 + i].z, r[2 + i].w);
        }
    }
}

template <int MODE>
DI void attn_tile(AttnSmem& sm, const bf16x8 (&qf)[4], f32x16 (&o)[2], float& m, float& l, const float inv_l, const int lo, const int hi,
                  const int lane, const int tokl, const int jbase) {
    const int rr = lane & 31, hh = lane >> 5;
    f32x16 s[2];
#pragma unroll
    for (int mt = 0; mt < 2; ++mt) {
#pragma unroll
        for (int i = 0; i < 16; ++i) s[mt][i] = 0.f;
#pragma unroll
        for (int ks = 0; ks < 4; ++ks) {
            const bf16x8 kf = *(const bf16x8*)&sm.k[(mt * 32 + rr) * 72 + ks * 16 + hh * 8];
            s[mt] = MFMA32(kf, qf[ks], s[mt]);
        }
        asm volatile("" ::: "memory");
    }
    const float L2E = 1.4426950408889634f;
    const int lo2 = lo - 4 * hh, hi2 = hi - 4 * hh;
    float mx = -1e30f;
#pragma unroll
    for (int mt = 0; mt < 2; ++mt)
#pragma unroll
        for (int i = 0; i < 16; ++i) {
            const int kc_ = mt * 32 + (i & 3) + 8 * (i >> 2);
            float v = s[mt][i] * L2E;
            v = (kc_ >= lo2 && kc_ <= hi2) ? v : -1e30f;
            s[mt][i] = v; mx = fmaxf(mx, v);
        }
    float mref = m;
    if (MODE != 2) {
        mx = fmaxf(mx, __shfl_xor(mx, 32));
        const float mnew = fmaxf(m, mx);
        const float alpha = __builtin_amdgcn_exp2f(m - mnew);
        m = mnew; mref = mnew;
        l *= alpha;
        if (MODE == 1) {
#pragma unroll
            for (int dt = 0; dt < 2; ++dt)
#pragma unroll
                for (int i = 0; i < 16; ++i) o[dt][i] *= alpha;
        }
    }
    float psum = 0.f;
#pragma unroll
    for (int mt = 0; mt < 2; ++mt)
#pragma unroll
        for (int i = 0; i < 16; ++i) {
            const float v = s[mt][i];
            float pv = (v > -1e29f) ? __builtin_amdgcn_exp2f(v - mref) : 0.f;
            if (MODE == 2) pv *= inv_l;
            s[mt][i] = pv; psum += pv;
        }
    if (MODE != 2) l += psum;
    if (MODE == 0) return;
    if (MODE == 2) {
#pragma unroll
        for (int mt = 0; mt < 2; ++mt)
#pragma unroll
            for (int jj = 0; jj < 4; ++jj) {
                float q4 = (s[mt][4 * jj] + s[mt][4 * jj + 1]) + (s[mt][4 * jj + 2] + s[mt][4 * jj + 3]);
                float e3 = s[mt][4 * jj + 3];
                q4 += __shfl_xor(q4, 1); q4 += __shfl_xor(q4, 2);
                e3 += __shfl_xor(e3, 1); e3 += __shfl_xor(e3, 2);
                if ((rr & 3) == 0) {
                    const int j = jbase + mt * 8 + 2 * jj + hh;
                    atomicAdd(&sm.imp[tokl * 256 + j], q4);
                    if (j + 1 < 256) atomicAdd(&sm.imp[tokl * 256 + j + 1], e3);
                }
            }
    }
#pragma unroll
    for (int mt = 0; mt < 2; ++mt)
#pragma unroll
        for (int s2 = 0; s2 < 2; ++s2) {
            uint4 pu;
            pu.x = pack2(s[mt][8 * s2 + 0], s[mt][8 * s2 + 1]); pu.y = pack2(s[mt][8 * s2 + 2], s[mt][8 * s2 + 3]);
            pu.z = pack2(s[mt][8 * s2 + 4], s[mt][8 * s2 + 5]); pu.w = pack2(s[mt][8 * s2 + 6], s[mt][8 * s2 + 7]);
            const bf16x8 pf = __builtin_bit_cast(bf16x8, pu);
            asm volatile("" ::: "memory");
#pragma unroll
            for (int dt = 0; dt < 2; ++dt) {
                const bf16_t* vp = &sm.vt[(dt * 32 + rr) * 68 + mt * 32 + s2 * 16 + hh * 4];
                const uint2 v0 = *(const uint2*)vp, v1 = *(const uint2*)(vp + 8);
                const bf16x8 vf = __builtin_bit_cast(bf16x8, make_uint4(v0.x, v0.y, v1.x, v1.y));
                o[dt] = MFMA32(vf, pf, o[dt]);
            }
        }
}

DI unsigned wave_umax(unsigned v) {
#pragma unroll
    for (int o = 32; o; o >>= 1) { const unsigned t = (unsigned)__shfl_xor((int)v, o); v = v > t ? v : t; }
    return v;
}

DI void attn_unit(const P& p, int u, char* smem) {
    AttnSmem& sm = *(AttnSmem*)smem;
    const int tid = threadIdx.x, wave = tid >> 6, lane = tid & 63, rr = lane & 31, hh = lane >> 5;
    const int tile = 511 - (u >> 2), bhk = u & 3, b = bhk >> 1, hk = bhk & 1, t0 = tile * 32;
    const int tokl = wave * 8 + (rr >> 2), t = t0 + tokl, g = rr & 3, head = hk * 4 + g;
    const size_t tokg = (size_t)b * S_ + t;
    bf16x8 qf[4];
#pragma unroll
    for (int ks = 0; ks < 4; ++ks) qf[ks] = *(const bf16x8*)(p.proj + tokg * PLD + QC + head * 64 + ks * 16 + hh * 8);
    float gate[3];
#pragma unroll
    for (int i = 0; i < 3; ++i) gate[i] = sigmoidf_(__uint_as_float((unsigned)p.proj[tokg * PLD + GC + head * 3 + i] << 16));
#pragma unroll
    for (int i = 0; i < 8; ++i) *(float4*)&sm.imp[(tid + i * 256) * 4] = make_float4(0.f, 0.f, 0.f, 0.f);
    sm.selbits[tid] = 0u;
    f32x16 o[2];
#pragma unroll
    for (int dt = 0; dt < 2; ++dt)
#pragma unroll
        for (int i = 0; i < 16; ++i) o[dt][i] = 0.f;
    float* park = &sm.imp[wave * 2048 + lane];
    uint4 rg[4];
    const int ntc = (t0 >> 10) + 1;
    const int vmaxi = (t >= 31) ? ((t - 31) >> 4) : -1;
    const bf16_t* kcb = p.kc + (size_t)bhk * 1024 * 64;
    const bf16_t* vcb = p.vcT + (size_t)bhk * 64 * 1024;
    float m = -1e30f, l = 0.f;
    attn_load(kcb, 64, vcb, 1024, rg, tid, false);
    for (int j = 0; j < ntc; ++j) {
        __syncthreads();
        attn_store(sm, rg, tid, false);
        __syncthreads();
        if (j + 1 < ntc) attn_load(kcb + (size_t)(j + 1) * 64 * 64, 64, vcb, 1024, rg, tid, false);
        attn_tile<0>(sm, qf, o, m, l, 0.f, 0, vmaxi - j * 64, lane, tokl, 0);
    }
    {
        const float lt = l + __shfl_xor(l, 32);
        const float inv_l = lt > 0.f ? 1.f / lt : 0.f;
        attn_load(kcb, 64, vcb, 1024, rg, tid, true);
        for (int j = 0; j < ntc; ++j) {
            __syncthreads();
            attn_store(sm, rg, tid, true);
            __syncthreads();
            if (j + 1 < ntc) attn_load(kcb + (size_t)(j + 1) * 64 * 64, 64, vcb + (j + 1) * 64, 1024, rg, tid, true);
            attn_tile<2>(sm, qf, o, m, l, inv_l, 0, vmaxi - j * 64, lane, tokl, j * 16);
        }
    }
    __syncthreads();
    const int cur = t0 >> 6;
    for (int tk = 0; tk < 8; ++tk) {
        const int tl = wave * 8 + tk;
        const float* ip = &sm.imp[tl * 256];
        unsigned nib = 0u;
        if (cur <= 15) {
#pragma unroll
            for (int e = 0; e < 4; ++e) if (lane * 4 + e <= cur) nib |= 1u << e;
        } else {
            unsigned k0, k1, k2, k3;
            {
                const float4 iv = *(const float4*)(ip + lane * 4);
                const int j0 = lane * 4;
                k0 = (j0 >= 1 && j0 <= cur - 2) ? ((__float_as_uint(iv.x) & 0xFFFFFF00u) | (unsigned)(255 - j0)) : 0u;
                k1 = (j0 + 1 <= cur - 2) ? ((__float_as_uint(iv.y) & 0xFFFFFF00u) | (unsigned)(254 - j0)) : 0u;
                k2 = (j0 + 2 <= cur - 2) ? ((__float_as_uint(iv.z) & 0xFFFFFF00u) | (unsigned)(253 - j0)) : 0u;
                k3 = (j0 + 3 <= cur - 2) ? ((__float_as_uint(iv.w) & 0xFFFFFF00u) | (unsigned)(252 - j0)) : 0u;
#pragma unroll
                for (int e = 0; e < 4; ++e) { const int j = j0 + e; if (j == 0 || j == cur || j == cur - 1) nib |= 1u << e; }
            }
            for (int r = 0; r < 13; ++r) {
                unsigned lm = k0 > k1 ? k0 : k1; const unsigned lm2 = k2 > k3 ? k2 : k3; lm = lm > lm2 ? lm : lm2;
                const unsigned wm = wave_umax(lm);
                if (k0 == wm) { k0 = 0u; nib |= 1u; }
                if (k1 == wm) { k1 = 0u; nib |= 2u; }
                if (k2 == wm) { k2 = 0u; nib |= 4u; }
                if (k3 == wm) { k3 = 0u; nib |= 8u; }
            }
        }
        atomicOr(&sm.selbits[tl * 8 + (lane >> 3)], nib << ((lane & 7) * 4));
    }
    __syncthreads();
    if (tid < 32) {
        const int w = tid >> 3, d = tid & 7; unsigned uu = 0u;
#pragma unroll
        for (int k = 0; k < 8; ++k) uu |= sm.selbits[(w * 8 + k) * 8 + d];
        sm.wunion[w * 8 + d] = uu;
    }
    __syncthreads();
    if (tid < 8) sm.bunion[tid] = sm.wunion[tid] | sm.wunion[8 + tid] | sm.wunion[16 + tid] | sm.wunion[24 + tid];
    __syncthreads();
#pragma unroll
    for (int dt = 0; dt < 2; ++dt)
#pragma unroll
        for (int i = 0; i < 16; ++i) { park[(dt * 16 + i) * 64] = gate[0] * o[dt][i]; o[dt][i] = 0.f; }
    {
        const bf16_t* kb = p.proj + (size_t)(b * S_) * PLD + KVC + 2 * 128 + hk * 64;
        const bf16_t* vb = p.vT + (size_t)((0 * 4 + bhk) * 64) * S_;
        m = -1e30f; l = 0.f;
        auto nextj = [&](int j) -> int {
            ++j;
            while (j <= cur) {
                const unsigned w = sm.bunion[j >> 5] >> (j & 31);
                if (w) { j += __ffs((int)w) - 1; return j <= cur ? j : -1; }
                j = (j | 31) + 1;
            }
            return -1;
        };
        int j = nextj(-1);
        if (j >= 0) attn_load(kb + (size_t)j * 64 * PLD, PLD, vb + j * 64, S_, rg, tid, true);
        while (j >= 0) {
            __syncthreads();
            attn_store(sm, rg, tid, true);
            __syncthreads();
            const int jn = nextj(j);
            if (jn >= 0) attn_load(kb + (size_t)jn * 64 * PLD, PLD, vb + jn * 64, S_, rg, tid, true);
            if ((sm.wunion[wave * 8 + (j >> 5)] >> (j & 31)) & 1u) {
                const bool selme = (sm.selbits[tokl * 8 + (j >> 5)] >> (j & 31)) & 1u;
                const int hi = selme ? (j < cur ? 63 : t - j * 64) : -1;
                attn_tile<1>(sm, qf, o, m, l, 0.f, 0, hi, lane, tokl, 0);
            }
            j = jn;
        }
        const float lt = l + __shfl_xor(l, 32);
        const float sc = lt > 0.f ? gate[1] / lt : 0.f;
#pragma unroll
        for (int dt = 0; dt < 2; ++dt)
#pragma unroll
            for (int i = 0; i < 16; ++i) { park[(dt * 16 + i) * 64] += sc * o[dt][i]; o[dt][i] = 0.f; }
    }
    {
        const bf16_t* kb = p.proj + (size_t)(b * S_) * PLD + KVC + 4 * 128 + hk * 64;
        const bf16_t* vb = p.vT + (size_t)((1 * 4 + bhk) * 64) * S_;
        m = -1e30f; l = 0.f;
        const int jlo = (t0 >= 511) ? ((t0 - 511) >> 6) : 0, jhi = t0 >> 6;
        attn_load(kb + (size_t)jlo * 64 * PLD, PLD, vb + jlo * 64, S_, rg, tid, true);
        for (int j = jlo; j <= jhi; ++j) {
            __syncthreads();
            attn_store(sm, rg, tid, true);
            __syncthreads();
            if (j + 1 <= jhi) attn_load(kb + (size_t)(j + 1) * 64 * PLD, PLD, vb + (j + 1) * 64, S_, rg, tid, true);
            attn_tile<1>(sm, qf, o, m, l, 0.f, t - 511 - j * 64, t - j * 64, lane, tokl, 0);
        }
        const float lt = l + __shfl_xor(l, 32);
        const float sc = lt > 0.f ? gate[2] / lt : 0.f;
#pragma unroll
        for (int dt = 0; dt < 2; ++dt)
#pragma unroll
            for (int i = 0; i < 16; ++i) o[dt][i] = park[(dt * 16 + i) * 64] + sc * o[dt][i];
    }
    bf16_t* mp = p.A + tokg * 1024 + 512 + head * 64;
#pragma unroll
    for (int dt = 0; dt < 2; ++dt)
#pragma unroll
        for (int jj = 0; jj < 4; ++jj) {
            uint2 ov; ov.x = pack2(o[dt][4 * jj], o[dt][4 * jj + 1]); ov.y = pack2(o[dt][4 * jj + 2], o[dt][4 * jj + 3]);
            *(uint2*)(mp + dt * 32 + jj * 8 + hh * 4) = ov;
        }
}

DI void phase4(const P& p, char* smem) {
    for (int su = blockIdx.x; su < 128; su += gridDim.x) scan_unit(p, su, smem);
    AttnSmem& sm = *(AttnSmem*)smem;
    while (true) {
        __syncthreads();
        if (threadIdx.x == 0) sm.unit = (int)atomicAdd(p.counter, 1u);
        __syncthreads();
        const int u = sm.unit;
        if (u >= 2048) break;
        attn_unit(p, u, smem);
    }
}

DI void phase4b(const P& p) {
    const int tid = threadIdx.x;
    for (int it = blockIdx.x; it < T_ / 4; it += gridDim.x) {
        const int gi = it * 4 + (tid >> 6), cgp = tid & 63, h = cgp >> 3, c8 = (cgp & 7) * 8, col = cgp * 8, b = gi >> 14, s = gi & (S_ - 1);
        const float4 y0 = *(const float4*)(p.yraw + (size_t)gi * 512 + col), y1 = *(const float4*)(p.yraw + (size_t)gi * 512 + col + 4);
        float y[8] = {y0.x, y0.y, y0.z, y0.w, y1.x, y1.y, y1.z, y1.w};
        const bf16_t* sp = p.stream + ((size_t)((b * 8 + h) * S_ + s) * 6) * 64 + c8;
        float km[8], r[8], v[8], gg[8];
        unpack8(*(const uint4*)(sp + 64), km); unpack8(*(const uint4*)(sp + 256), r); unpack8(*(const uint4*)(sp + 320), v);
        unpack8(*(const uint4*)(p.gbuf + (size_t)gi * 512 + col), gg);
        float sum = 0.f, bon = 0.f;
#pragma unroll
        for (int e = 0; e < 8; ++e) { sum += y[e]; bon += r[e] * km[e] * p.r_k[col + e]; }
        sum += __shfl_xor(sum, 1); sum += __shfl_xor(sum, 2); sum += __shfl_xor(sum, 4);
        bon += __shfl_xor(bon, 1); bon += __shfl_xor(bon, 2); bon += __shfl_xor(bon, 4);
        const float mean = sum * (1.f / 64.f);
        float var = 0.f;
#pragma unroll
        for (int e = 0; e < 8; ++e) { y[e] -= mean; var += y[e] * y[e]; }
        var += __shfl_xor(var, 1); var += __shfl_xor(var, 2); var += __shfl_xor(var, 4);
        const float rs = rsqrtf(var * (1.f / 64.f) + 64e-5f);
        float o[8];
#pragma unroll
        for (int e = 0; e < 8; ++e) o[e] = (y[e] * rs * p.lnx_w[col + e] + p.lnx_b[col + e] + bon * v[e]) * gg[e];
        *(uint4*)(p.A + (size_t)gi * 1024 + col) = pack8(o);
    }
}

struct EpiFfn2 {
    float* out;
    DI void operator()(const f32x16 (&acc)[2][2], int rowbase, int colbase, int lane) const {
        const int rr = lane & 31, hh = lane >> 5;
#pragma unroll
        for (int w = 0; w < 2; ++w)
#pragma unroll
            for (int t = 0; t < 2; ++t)
#pragma unroll
                for (int j = 0; j < 4; ++j) {
                    float4* o = (float4*)(out + (size_t)(rowbase + t * 32 + rr) * 1024 + colbase + w * 32 + j * 8 + hh * 4);
                    float4 xv = *o;
                    xv.x += acc[w][t][4 * j]; xv.y += acc[w][t][4 * j + 1]; xv.z += acc[w][t][4 * j + 2]; xv.w += acc[w][t][4 * j + 3];
                    *o = xv;
                }
    }
};

DI void final_item(float* io, const float* g, int idx) {
    const int row = idx * 4 + (threadIdx.x >> 6), lane = threadIdx.x & 63;
    float4* sp = (float4*)(io + (size_t)row * 1024);
    float4 v[4]; float ss = 0.f;
#pragma unroll
    for (int i = 0; i < 4; ++i) { v[i] = sp[lane + 64 * i]; ss += v[i].x * v[i].x + v[i].y * v[i].y + v[i].z * v[i].z + v[i].w * v[i].w; }
    ss = wave_sum(ss);
    const float rs = rsqrtf(ss * (1.f / 1024.f) + 1e-6f);
#pragma unroll
    for (int i = 0; i < 4; ++i) {
        const float4 gv = ((const float4*)g)[lane + 64 * i];
        sp[lane + 64 * i] = make_float4(v[i].x * rs * gv.x, v[i].y * rs * gv.y, v[i].z * rs * gv.z, v[i].w * rs * gv.w);
    }
}

DI void run_phase(const P& p, int ph, char* smem) {
    switch (ph) {
    case 0: phase0(p, smem); break;
    case 1:
        for (int it = blockIdx.x; it < 256 * 25; it += gridDim.x) {
            const int mt = it / 25, nt = it - mt * 25;
            gemm_tile(AFPlain{p.A, 1024}, p.WinT + (size_t)nt * 128 * 1024, 1024, mt * 128, nt * 128, EpiProj{p.proj}, smem);
        }
        break;
    case 2: phase2(p, smem); break;
    case 3: phase3(p, smem); break;
    case 4: phase4(p, smem); break;
    case 5: phase4b(p); break;
    case 6:
        for (int it = blockIdx.x; it < 256 * 8; it += gridDim.x) {
            const int mt = it >> 3, nt = it & 7;
            gemm_tile(AFPlain{p.A, 1024}, p.WoutT + (size_t)nt * 128 * 1024, 1024, mt * 128, nt * 128, EpiOut{p.out, p.x}, smem);
        }
        break;
    case 7:
        for (int it = blockIdx.x; it < T_ / 4; it += gridDim.x) rms_item(p.out, p.norm_ffn, p.A, it);
        break;
    case 8:
        for (int it = blockIdx.x; it < 256 * 44; it += gridDim.x) {
            const int mt = it / 44, nt = it - mt * 44;
            gemm_tile(AFPlain{p.A, 1024}, p.WguT + (size_t)nt * 128 * 1024, 1024, mt * 128, nt * 128, EpiFfn1{p.stream}, smem);
        }
        break;
    case 9:
        for (int it = blockIdx.x; it < 256 * 8; it += gridDim.x) {
            const int mt = it >> 3, nt = it & 7;
            gemm_tile(AFPlain{p.stream, DFF}, p.WdnT + (size_t)nt * 128 * DFF, DFF, mt * 128, nt * 128, EpiFfn2{p.out}, smem);
        }
        break;
    default:
        for (int it = blockIdx.x; it < T_ / 4; it += gridDim.x) final_item(p.out, p.norm_final, it);
        break;
    }
}
constexpr int NPHASE = 11;
constexpr int SMEM_BYTES = 57344;


#define XB_TMO      128
#define XB_XCNT(j)  (256  + 64 * (j))
#define XB_XSUB(j)  (1280 + 64 * (j))
#define XB_XGEN(j)  (2304 + 64 * (j))
#define XB_TOP      3328
#define XB_TOPGEN   3392
#define XCD_BAR_WORDS 3456
#define XB_SPIN_CAP (1u << 18)
#define LAS __attribute__((address_space(3)))
DI unsigned xb_ld(unsigned* p) { return __hip_atomic_load(p, __ATOMIC_RELAXED, __HIP_MEMORY_SCOPE_AGENT); }
DI unsigned xb_add(unsigned* p, unsigned v) { return __hip_atomic_fetch_add(p, v, __ATOMIC_RELAXED, __HIP_MEMORY_SCOPE_AGENT); }
DI unsigned xb_xcc_id() { return (unsigned)__builtin_amdgcn_s_getreg((3 << 11) | 20) & 0xFu; }
#define XB_SPIN(cond, bar) do { unsigned _sp = 0; while (cond) { __builtin_amdgcn_s_sleep(1); \
    if ((++_sp & 255u) == 0u) { if (xb_ld(&(bar)[XB_TMO])) break; if (_sp > XB_SPIN_CAP) { atomicAdd(&(bar)[XB_TMO], 1u); break; } } } } while (0)
struct XcdBarrier { unsigned* bar; unsigned x; volatile LAS unsigned* st; };
DI XcdBarrier xcd_barrier_post(unsigned* bar, volatile LAS unsigned* st) {
    XcdBarrier b; b.bar = bar; b.x = xb_xcc_id(); b.st = st;
    if (threadIdx.x == 0) (void)xb_add(&bar[XB_XCNT(b.x)], 1u);
    return b;
}
DI void xcd_barrier_complete(unsigned* bar, unsigned x, unsigned& nloc, unsigned& nx) {
    const unsigned G = gridDim.x * gridDim.y * gridDim.z;
    unsigned sum, cnt, mine, sp = 0u;
    for (;;) {
        sum = 0u; cnt = 0u; mine = 0u;
#pragma unroll
        for (unsigned j = 0; j < 16; ++j) { const unsigned c = xb_ld(&bar[XB_XCNT(j)]); sum += c; cnt += (c > 0u) ? 1u : 0u; mine = (j == x) ? c : mine; }
        if (sum == G) break;
        __builtin_amdgcn_s_sleep(1);
        if ((++sp & 255u) == 0u) { if (xb_ld(&bar[XB_TMO])) break; if (sp > XB_SPIN_CAP) { atomicAdd(&bar[XB_TMO], 1u); break; } }
    }
    nloc = mine > 0u ? mine : 1u; nx = cnt > 0u ? cnt : 1u;
}
DI void xcd_barrier(const XcdBarrier& b) {
    asm volatile("s_waitcnt vmcnt(0)" ::: "memory");
    __syncthreads();
    if (threadIdx.x == 0) {
        unsigned* bar = b.bar;
        __builtin_amdgcn_s_waitcnt(0);
        unsigned nloc = b.st[0], nx = b.st[1];
        if (nloc == 0u) { xcd_barrier_complete(bar, b.x, nloc, nx); b.st[0] = nloc; b.st[1] = nx; }
        const unsigned old = xb_add(&bar[XB_XSUB(b.x)], 1u);
        const unsigned gen = old / nloc;
        if (old + 1u == (gen + 1u) * nloc) {
            __builtin_amdgcn_fence(__ATOMIC_RELEASE, "agent");
            asm volatile("s_waitcnt vmcnt(0)" ::: "memory");
            const unsigned og = xb_add(&bar[XB_TOP], 1u);
            const unsigned tg = og / nx;
            if (og + 1u == (tg + 1u) * nx) xb_add(&bar[XB_TOPGEN], 1u);
            else XB_SPIN(xb_ld(&bar[XB_TOPGEN]) == tg, bar);
            __builtin_amdgcn_fence(__ATOMIC_ACQUIRE, "agent");
            xb_add(&bar[XB_XGEN(b.x)], 1u);
            asm volatile("s_waitcnt vmcnt(0)" ::: "memory");
        } else {
            XB_SPIN(xb_ld(&bar[XB_XGEN(b.x)]) == gen, bar);
            __builtin_amdgcn_fence(__ATOMIC_ACQUIRE, "agent");
            asm volatile("s_waitcnt vmcnt(0)" ::: "memory");
        }
    }
    __syncthreads();
}

__global__ void __launch_bounds__(NTHR, 2) mega_kernel(P p) {
    __shared__ __attribute__((aligned(16))) char smem[SMEM_BYTES];
    __shared__ uint4 xb_words;
    cg::grid_group grid = cg::this_grid();
    if (p.x == nullptr) grid.sync();
    if (threadIdx.x == 0) xb_words = make_uint4(0u, 0u, 0u, 0u);
    __syncthreads();
    const XcdBarrier xb = xcd_barrier_post(p.bar, (volatile LAS unsigned*)&xb_words);
    run_phase(p, 0, smem); xcd_barrier(xb);
    run_phase(p, 1, smem); xcd_barrier(xb);
    run_phase(p, 2, smem); xcd_barrier(xb);
    run_phase(p, 3, smem); xcd_barrier(xb);
    run_phase(p, 4, smem); xcd_barrier(xb);
    run_phase(p, 5, smem); xcd_barrier(xb);
    run_phase(p, 6, smem); xcd_barrier(xb);
    run_phase(p, 7, smem); xcd_barrier(xb);
    run_phase(p, 8, smem); xcd_barrier(xb);
    run_phase(p, 9, smem); xcd_barrier(xb);
    run_phase(p, 10, smem);
}
__global__ void __launch_bounds__(NTHR, 2) phase_kernel(P p, int ph) {
    __shared__ __attribute__((aligned(16))) char smem[SMEM_BYTES];
    run_phase(p, ph, smem);
}

extern "C" void kernel_launch(void* const* d_in, const int* in_sizes, int n_in, void* d_out, int out_size, void* d_ws, size_t ws_size,
                              hipStream_t stream) {
    P p{};
    p.x = (const float*)d_in[0]; p.pos = (const int*)d_in[1]; p.norm_mix = (const float*)d_in[2]; p.w_in = (const float*)d_in[3];
    p.mu = (const float*)d_in[4]; p.w0 = (const float*)d_in[5]; p.w2 = (const float*)d_in[6]; p.a0 = (const float*)d_in[7];
    p.a2 = (const float*)d_in[8]; p.g2 = (const float*)d_in[9]; p.k_k = (const float*)d_in[10]; p.k_a = (const float*)d_in[11];
    p.r_k = (const float*)d_in[12]; p.lnx_w = (const float*)d_in[13]; p.lnx_b = (const float*)d_in[14]; p.pe_k = (const float*)d_in[15];
    p.wk1 = (const float*)d_in[16]; p.bk1 = (const float*)d_in[17]; p.wk2 = (const float*)d_in[18]; p.pe_v = (const float*)d_in[19];
    p.wv1 = (const float*)d_in[20]; p.bv1 = (const float*)d_in[21]; p.wv2 = (const float*)d_in[22]; p.w_out = (const float*)d_in[23];
    p.norm_ffn = (const float*)d_in[24]; p.w_gate = (const float*)d_in[25]; p.w_up = (const float*)d_in[26]; p.w_down = (const float*)d_in[27];
    p.norm_final = (const float*)d_in[28];
    p.out = (float*)d_out;
    char* ws = (char*)d_ws;
    size_t off = 0;
    auto take = [&](size_t bytes) { char* r = ws + off; off += (bytes + 255) & ~(size_t)255; return r; };
    p.WinT = (bf16_t*)take((size_t)3200 * 1024 * 2);
    p.WoutT = (bf16_t*)take((size_t)1024 * 1024 * 2);
    p.WguT = (bf16_t*)take((size_t)5632 * 1024 * 2);
    p.WdnT = (bf16_t*)take((size_t)1024 * DFF * 2);
    p.w2T = (bf16_t*)take(512 * 64 * 2);
    p.a2T = (bf16_t*)take(512 * 64 * 2);
    p.g2T = (bf16_t*)take(512 * 160 * 2);
    p.w1T = (bf16_t*)take((size_t)2 * 256 * 2048 * 2);
    p.wc2T = (bf16_t*)take(2 * 128 * 256 * 2);
    p.b1p = (float*)take(512 * 4);
    p.cosT = (float*)take((size_t)T_ * 8 * 4);
    p.sinT = (float*)take((size_t)T_ * 8 * 4);
    p.counter = (unsigned*)take(256);
    p.bar = (unsigned*)take(XCD_BAR_WORDS * 4);
    off = (size_t)32 << 20;
    p.A = (bf16_t*)take((size_t)T_ * 1024 * 2);
    p.proj = (bf16_t*)take((size_t)T_ * PLD * 2);
    p.stream = (bf16_t*)take((size_t)T_ * 8 * 384 * 2);
    if (off > ws_size) fprintf(stderr, "workspace too small: need %zu have %zu\n", off, ws_size);
    char* ob = (char*)d_out;
    p.gbuf = (bf16_t*)ob;
    p.yraw = (float*)(ob + ((size_t)32 << 20));
    p.vT = (bf16_t*)(ob + ((size_t)96 << 20));
    p.hid = (bf16_t*)(ob + ((size_t)112 << 20));
    p.kc = (bf16_t*)(ob + ((size_t)116 << 20));
    p.vcT = (bf16_t*)(ob + ((size_t)116 << 20) + (512 << 10));
#if MK_SINGLE
    static int grid_blocks = 0;
    if (!grid_blocks) {
        int dev = 0, cus = 0, per_cu = 0;
        hipGetDevice(&dev);
        hipDeviceGetAttribute(&cus, hipDeviceAttributeMultiprocessorCount, dev);
        hipOccupancyMaxActiveBlocksPerMultiprocessor(&per_cu, mega_kernel, NTHR, 0);
        if (per_cu > 2) per_cu = 2;
        if (per_cu < 1) per_cu = 1;
        grid_blocks = cus * per_cu;
    }
    (void)hipMemsetAsync(p.bar, 0, XCD_BAR_WORDS * 4, stream);
    void* args[] = {&p};
    hipError_t e = hipLaunchCooperativeKernel((void*)mega_kernel, dim3(grid_blocks), dim3(NTHR), args, 0, stream);
    if (e != hipSuccess) fprintf(stderr, "cooperative launch failed: %s (grid %d)\n", hipGetErrorString(e), grid_blocks);
#else
    for (int ph = 0; ph < NPHASE; ++ph) phase_kernel<<<512, NTHR, 0, stream>>>(p, ph);
#endif
}
```

```cpp
#include <hip/hip_runtime.h>
#include <hip/hip_cooperative_groups.h>
#include <cstdio>
namespace cg = cooperative_groups;

#ifndef MK_SINGLE
#define MK_SINGLE 1
#endif

#define DI __device__ __forceinline__
typedef unsigned short bf16_t;
typedef short bf16x8 __attribute__((ext_vector_type(8)));
typedef float f32x16 __attribute__((ext_vector_type(16)));
typedef __bf16 bf2_t __attribute__((ext_vector_type(2)));
typedef float f2_t __attribute__((ext_vector_type(2)));

constexpr int T_ = 32768, S_ = 16384;
constexpr int PLD = 3200;
constexpr int QC = 1856, KVC = 2368, GC = 3136;
constexpr int DFF = 2816;
constexpr int NTHR = 256;

#define MFMA32(a, b, c) __builtin_amdgcn_mfma_f32_32x32x16_bf16((a), (b), (c), 0, 0, 0)

DI unsigned pack2(float a, float b) { f2_t v = {a, b}; return __builtin_bit_cast(unsigned, __builtin_convertvector(v, bf2_t)); }
DI float bflo(unsigned u) { return __uint_as_float(u << 16); }
DI float bfhi(unsigned u) { return __uint_as_float(u & 0xffff0000u); }
DI bf16_t f2bf(float a) { return (bf16_t)(pack2(a, 0.f) & 0xffffu); }
DI void unpack8(const uint4& u, float (&f)[8]) {
    f[0] = bflo(u.x); f[1] = bfhi(u.x); f[2] = bflo(u.y); f[3] = bfhi(u.y);
    f[4] = bflo(u.z); f[5] = bfhi(u.z); f[6] = bflo(u.w); f[7] = bfhi(u.w);
}
DI uint4 pack8(const float (&f)[8]) { uint4 u; u.x = pack2(f[0], f[1]); u.y = pack2(f[2], f[3]); u.z = pack2(f[4], f[5]); u.w = pack2(f[6], f[7]); return u; }
DI float wave_sum(float v) {
#pragma unroll
    for (int o = 32; o; o >>= 1) v += __shfl_xor(v, o);
    return v;
}
DI float sigmoidf_(float x) { return 1.f / (1.f + __expf(-x)); }
DI int crow(int reg, int h) { return (reg & 3) + 8 * (reg >> 2) + 4 * h; }

struct P {
    const float* x; const int* pos; const float *norm_mix, *w_in, *mu, *w0, *w2, *a0, *a2, *g2, *k_k, *k_a, *r_k, *lnx_w, *lnx_b,
        *pe_k, *wk1, *bk1, *wk2, *pe_v, *wv1, *bv1, *wv2, *w_out, *norm_ffn, *w_gate, *w_up, *w_down, *norm_final;
    float* out;
    bf16_t *WinT, *WoutT, *WguT, *WdnT, *w2T, *a2T, *g2T, *w1T, *wc2T;
    float *b1p, *cosT, *sinT;
    unsigned* counter; unsigned* bar;
    bf16_t *A, *proj, *stream;
    bf16_t* gbuf; float* yraw; bf16_t *vT, *hid, *kc, *vcT;
};

DI float tr_val(const P& p, int job, int k, int n) {
    switch (job) {
    case 0: { int c = n < 1824 ? n : ((n >= 1856 && n < 3160) ? n - 32 : -1); return c >= 0 ? p.w_in[(size_t)k * 3128 + c] : 0.f; }
    case 1: return p.w_out[k * 1024 + n];
    case 2: { int q = n >> 6, r = n & 63; return r < 32 ? p.w_gate[(size_t)k * DFF + q * 32 + r] : p.w_up[(size_t)k * DFF + q * 32 + r - 32]; }
    case 3: return p.w_down[(size_t)k * 1024 + n];
    case 4: return p.w2[k * 512 + n];
    case 5: return p.a2[k * 512 + n];
    case 6: return p.g2[k * 512 + n];
    case 7: return p.wk1[k * 256 + n];
    case 8: return p.wv1[k * 256 + n];
    case 9: return n < 64 ? p.wk2[k * 64 + n] : 0.f;
    default: return n < 64 ? p.wv2[k * 64 + n] : 0.f;
    }
}
DI void tr_item(const P& p, int it, float* tile) {
    int job, K, N; bf16_t* dst;
    if (it < 800) { job = 0; K = 1024; N = 3200; dst = p.WinT; }
    else if (it < 1056) { job = 1; it -= 800; K = 1024; N = 1024; dst = p.WoutT; }
    else if (it < 2464) { job = 2; it -= 1056; K = 1024; N = 5632; dst = p.WguT; }
    else if (it < 3168) { job = 3; it -= 2464; K = 2816; N = 1024; dst = p.WdnT; }
    else if (it < 3176) { job = 4; it -= 3168; K = 64; N = 512; dst = p.w2T; }
    else if (it < 3184) { job = 5; it -= 3176; K = 64; N = 512; dst = p.a2T; }
    else if (it < 3208) { job = 6; it -= 3184; K = 160; N = 512; dst = p.g2T; }
    else if (it < 3336) { job = 7; it -= 3208; K = 2048; N = 256; dst = p.w1T; }
    else if (it < 3464) { job = 8; it -= 3336; K = 2048; N = 256; dst = p.w1T + 256 * 2048; }
    else if (it < 3472) { job = 9; it -= 3464; K = 256; N = 128; dst = p.wc2T; }
    else { job = 10; it -= 3472; K = 256; N = 128; dst = p.wc2T + 128 * 256; }
    const int nt = N >> 6;
    const int k0 = (it / nt) * 64, n0 = (it % nt) * 64;
    const int tid = threadIdx.x;
    __syncthreads();
#pragma unroll 4
    for (int i = 0; i < 16; ++i) {
        const int kk = i * 4 + (tid >> 6), nn = tid & 63;
        tile[kk * 65 + nn] = (k0 + kk < K) ? tr_val(p, job, k0 + kk, n0 + nn) : 0.f;
    }
    __syncthreads();
#pragma unroll 4
    for (int i = 0; i < 16; ++i) {
        const int nn = i * 4 + (tid >> 6), kk = tid & 63;
        if (k0 + kk < K) dst[(size_t)(n0 + nn) * K + k0 + kk] = f2bf(tile[kk * 65 + nn]);
    }
}
DI void b1_item(const P& p, int idx) {
    const int kv = idx >> 4, jc = idx & 15, tid = threadIdx.x;
    const float* pe = kv ? p.pe_v : p.pe_k; const float* w1 = kv ? p.wv1 : p.wk1; const float* b1 = kv ? p.bv1 : p.bk1;
    const int j = jc * 16 + (tid >> 4), kl = tid & 15;
    float s = 0.f;
    for (int i = 0; i < 128; ++i) { const int k = kl + 16 * i; s += pe[k] * w1[k * 256 + j]; }
    s += __shfl_xor(s, 1); s += __shfl_xor(s, 2); s += __shfl_xor(s, 4); s += __shfl_xor(s, 8);
    if (kl == 0) p.b1p[kv * 256 + j] = b1[j] + s;
}
DI void sincos_d(float ang, float& c, float& s) {
    double x = (double)ang;
    const double TWO_PI = 6.283185307179586476925286766559;
    double n = __builtin_rint(x * (1.0 / TWO_PI));
    double r = x - n * TWO_PI;
    double q = r * 0.25;
    double q2 = q * q;
    double sn = q * (1.0 + q2 * (-1.0 / 6 + q2 * (1.0 / 120 + q2 * (-1.0 / 5040 + q2 * (1.0 / 362880 + q2 * (-1.0 / 39916800 + q2 * (1.0 / 6227020800.0)))))));
    double cs = 1.0 + q2 * (-0.5 + q2 * (1.0 / 24 + q2 * (-1.0 / 720 + q2 * (1.0 / 40320 + q2 * (-1.0 / 3628800 + q2 * (1.0 / 479001600.0))))));
    double s2 = 2 * sn * cs, c2 = 1 - 2 * sn * sn;
    double s4 = 2 * s2 * c2, c4 = 1 - 2 * s2 * s2;
    c = (float)c4; s = (float)s4;
}
DI void cs_item(const P& p, int idx) {
    const int e = idx * 256 + threadIdx.x, tok = e >> 3, f = e & 7;
    const float invf[8] = {1.000000000e+00f, 1.939227432e-01f, 3.760603070e-02f, 7.292664610e-03f, 1.414213562e-03f, 2.742481884e-04f, 5.318295734e-05f, 1.031338525e-05f};
    float iv = invf[0];
#pragma unroll
    for (int i = 1; i < 8; ++i) iv = (f == i) ? invf[i] : iv;
    const float ang = (float)p.pos[tok] * iv;
    float c, s; sincos_d(ang, c, s);
    p.cosT[e] = c; p.sinT[e] = s;
}
DI void rms_item(const float* src, const float* g, bf16_t* dst, int idx) {
    const int row = idx * 4 + (threadIdx.x >> 6), lane = threadIdx.x & 63;
    const float4* sp = (const float4*)(src + (size_t)row * 1024);
    float4 v[4]; float ss = 0.f;
#pragma unroll
    for (int i = 0; i < 4; ++i) { v[i] = sp[lane + 64 * i]; ss += v[i].x * v[i].x + v[i].y * v[i].y + v[i].z * v[i].z + v[i].w * v[i].w; }
    ss = wave_sum(ss);
    const float rs = rsqrtf(ss * (1.f / 1024.f) + 1e-6f);
#pragma unroll
    for (int i = 0; i < 4; ++i) {
        const float4 gv = ((const float4*)g)[lane + 64 * i];
        uint2 o; o.x = pack2(v[i].x * rs * gv.x, v[i].y * rs * gv.y); o.y = pack2(v[i].z * rs * gv.z, v[i].w * rs * gv.w);
        *(uint2*)(dst + (size_t)row * 1024 + (lane + 64 * i) * 4) = o;
    }
}
DI void phase0(const P& p, char* smem) {
    if (blockIdx.x == 0 && threadIdx.x == 0) *p.counter = 0u;
    constexpr int NTR = 3480, NB1 = 32, NCS = 1024, NXN = 8192;
    for (int it = blockIdx.x; it < NTR + NB1 + NCS + NXN; it += gridDim.x) {
        if (it < NTR) tr_item(p, it, (float*)smem);
        else if (it < NTR + NB1) b1_item(p, it - NTR);
        else if (it < NTR + NB1 + NCS) cs_item(p, it - NTR - NB1);
        else rms_item(p.x, p.norm_mix, p.A, it - NTR - NB1 - NCS);
    }
}

struct AFPlain { const bf16_t* A; int lda; DI uint4 load(int row, int k) const { return *(const uint4*)(A + (size_t)row * lda + k); } };
struct AFCmp {
    const bf16_t* base;
    DI uint4 load(int r, int k) const { int tok = 16 * r + (k >> 6); tok = tok < S_ ? tok : S_ - 1; return *(const uint4*)(base + (size_t)tok * PLD + (k & 63)); }
};

template <class AF, class EPI>
DI void gemm_tile(const AF af, const bf16_t* __restrict__ Bt, const int K, const int m0, const int n0, const EPI epi, char* smem) {
    bf16_t* sA = (bf16_t*)smem; bf16_t* sB = sA + 128 * 72;
    const int tid = threadIdx.x, wave = tid >> 6, lane = tid & 63, wm = wave >> 1, wn = wave & 1, rr = lane & 31, hh = lane >> 5;
    f32x16 acc[2][2];
#pragma unroll
    for (int a = 0; a < 2; ++a)
#pragma unroll
        for (int b = 0; b < 2; ++b)
#pragma unroll
            for (int i = 0; i < 16; ++i) acc[a][b][i] = 0.f;
    const int lrow = tid >> 3, lk = (tid & 7) * 8;
#define GLOAD(KO) \
    ra0 = af.load(m0 + lrow, (KO) + lk); ra1 = af.load(m0 + lrow + 32, (KO) + lk); ra2 = af.load(m0 + lrow + 64, (KO) + lk); ra3 = af.load(m0 + lrow + 96, (KO) + lk); \
    rb0 = *(const uint4*)(Bt + (size_t)(lrow) * K + (KO) + lk); rb1 = *(const uint4*)(Bt + (size_t)(lrow + 32) * K + (KO) + lk); \
    rb2 = *(const uint4*)(Bt + (size_t)(lrow + 64) * K + (KO) + lk); rb3 = *(const uint4*)(Bt + (size_t)(lrow + 96) * K + (KO) + lk);
    uint4 ra0, ra1, ra2, ra3, rb0, rb1, rb2, rb3;
    GLOAD(0)
#pragma unroll 1
    for (int k0 = 0; k0 < K; k0 += 64) {
        __syncthreads();
        *(uint4*)&sA[(lrow) * 72 + lk] = ra0; *(uint4*)&sA[(lrow + 32) * 72 + lk] = ra1; *(uint4*)&sA[(lrow + 64) * 72 + lk] = ra2; *(uint4*)&sA[(lrow + 96) * 72 + lk] = ra3;
        *(uint4*)&sB[(lrow) * 72 + lk] = rb0; *(uint4*)&sB[(lrow + 32) * 72 + lk] = rb1; *(uint4*)&sB[(lrow + 64) * 72 + lk] = rb2; *(uint4*)&sB[(lrow + 96) * 72 + lk] = rb3;
        __syncthreads();
        if (k0 + 64 < K) { GLOAD(k0 + 64) }
#pragma unroll
        for (int ks = 0; ks < 4; ++ks) {
            bf16x8 tf[2], wf[2];
#pragma unroll
            for (int t = 0; t < 2; ++t) tf[t] = *(const bf16x8*)&sA[(wm * 64 + t * 32 + rr) * 72 + ks * 16 + hh * 8];
#pragma unroll
            for (int w = 0; w < 2; ++w) wf[w] = *(const bf16x8*)&sB[(wn * 64 + w * 32 + rr) * 72 + ks * 16 + hh * 8];
#pragma unroll
            for (int w = 0; w < 2; ++w)
#pragma unroll
                for (int t = 0; t < 2; ++t) acc[w][t] = MFMA32(wf[w], tf[t], acc[w][t]);
        }
    }
#undef GLOAD
    epi(acc, m0 + wm * 64, n0 + wn * 64, lane);
}

struct EpiProj {
    bf16_t* C;
    DI void operator()(const f32x16 (&acc)[2][2], int rowbase, int colbase, int lane) const {
        const int rr = lane & 31, hh = lane >> 5;
#pragma unroll
        for (int w = 0; w < 2; ++w)
#pragma unroll
            for (int t = 0; t < 2; ++t)
#pragma unroll
                for (int j = 0; j < 4; ++j) {
                    uint2 o; o.x = pack2(acc[w][t][4 * j], acc[w][t][4 * j + 1]); o.y = pack2(acc[w][t][4 * j + 2], acc[w][t][4 * j + 3]);
                    *(uint2*)(C + (size_t)(rowbase + t * 32 + rr) * PLD + colbase + w * 32 + j * 8 + hh * 4) = o;
                }
    }
};
struct EpiHid {
    bf16_t* H; const float* bias;
    DI void operator()(const f32x16 (&acc)[2][2], int rowbase, int colbase, int lane) const {
        const int rr = lane & 31, hh = lane >> 5;
#pragma unroll
        for (int w = 0; w < 2; ++w)
#pragma unroll
            for (int t = 0; t < 2; ++t)
#pragma unroll
                for (int j = 0; j < 4; ++j) {
                    const int col = colbase + w * 32 + j * 8 + hh * 4;
                    const float4 bv = *(const float4*)(bias + col);
                    float v0 = acc[w][t][4 * j] + bv.x, v1 = acc[w][t][4 * j + 1] + bv.y, v2 = acc[w][t][4 * j + 2] + bv.z, v3 = acc[w][t][4 * j + 3] + bv.w;
                    v0 *= sigmoidf_(v0); v1 *= sigmoidf_(v1); v2 *= sigmoidf_(v2); v3 *= sigmoidf_(v3);
                    uint2 o; o.x = pack2(v0, v1); o.y = pack2(v2, v3);
                    *(uint2*)(H + (size_t)(rowbase + t * 32 + rr) * 256 + col) = o;
                }
    }
};
struct EpiKc {
    bf16_t* kc; const float *cosT, *sinT; int tokbase;
    DI void operator()(const f32x16 (&acc)[2][2], int rowbase, int colbase, int lane) const {
        if (colbase != 0) return;
        const int rr = lane & 31, hh = lane >> 5;
#pragma unroll
        for (int t = 0; t < 2; ++t) {
            const int r = rowbase + t * 32 + rr;
            int tk = 31 + 16 * r; tk = tk < S_ ? tk : S_ - 1;
            const float4 c = *(const float4*)(cosT + (size_t)(tokbase + tk) * 8 + hh * 4), s = *(const float4*)(sinT + (size_t)(tokbase + tk) * 8 + hh * 4);
            bf16_t* kp = kc + (size_t)r * 64 + hh * 4;
            const float a0 = acc[0][t][0], a1 = acc[0][t][1], a2 = acc[0][t][2], a3 = acc[0][t][3];
            const float b0 = acc[0][t][4], b1 = acc[0][t][5], b2 = acc[0][t][6], b3 = acc[0][t][7];
            uint2 o;
            o.x = pack2(a0 * c.x - b0 * s.x, a1 * c.y - b1 * s.y); o.y = pack2(a2 * c.z - b2 * s.z, a3 * c.w - b3 * s.w);
            *(uint2*)(kp) = o;
            o.x = pack2(b0 * c.x + a0 * s.x, b1 * c.y + a1 * s.y); o.y = pack2(b2 * c.z + a2 * s.z, b3 * c.w + a3 * s.w);
            *(uint2*)(kp + 8) = o;
#pragma unroll
            for (int j = 2; j < 4; ++j) {
                o.x = pack2(acc[0][t][4 * j], acc[0][t][4 * j + 1]); o.y = pack2(acc[0][t][4 * j + 2], acc[0][t][4 * j + 3]);
                *(uint2*)(kp + j * 8) = o;
            }
#pragma unroll
            for (int j = 0; j < 4; ++j) {
                o.x = pack2(acc[1][t][4 * j], acc[1][t][4 * j + 1]); o.y = pack2(acc[1][t][4 * j + 2], acc[1][t][4 * j + 3]);
                *(uint2*)(kp + 32 + j * 8) = o;
            }
        }
    }
};
struct EpiVc {
    bf16_t* vcT; char* smem;
    DI void operator()(const f32x16 (&acc)[2][2], int rowbase, int colbase, int lane) const {
        const int rr = lane & 31, hh = lane >> 5;
        bf16_t* tl = (bf16_t*)smem;
        __syncthreads();
        if (colbase == 0) {
            const int rl = rowbase & 127;
#pragma unroll
            for (int w = 0; w < 2; ++w)
#pragma unroll
                for (int t = 0; t < 2; ++t)
#pragma unroll
                    for (int i = 0; i < 16; ++i) tl[(w * 32 + crow(i, hh)) * 136 + rl + t * 32 + rr] = f2bf(acc[w][t][i]);
        }
        __syncthreads();
        const int m0 = rowbase & ~127;
#pragma unroll
        for (int i = 0; i < 4; ++i) {
            const int c = threadIdx.x + i * 256, d = c >> 4, ch = c & 15;
            *(uint4*)(vcT + (size_t)d * 1024 + m0 + ch * 8) = *(const uint4*)&tl[d * 136 + ch * 8];
        }
    }
};
struct EpiOut {
    float* out; const float* x;
    DI void operator()(const f32x16 (&acc)[2][2], int rowbase, int colbase, int lane) const {
        const int rr = lane & 31, hh = lane >> 5;
#pragma unroll
        for (int w = 0; w < 2; ++w)
#pragma unroll
            for (int t = 0; t < 2; ++t)
#pragma unroll
                for (int j = 0; j < 4; ++j) {
                    const size_t o = (size_t)(rowbase + t * 32 + rr) * 1024 + colbase + w * 32 + j * 8 + hh * 4;
                    float4 xv = *(const float4*)(x + o);
                    xv.x += acc[w][t][4 * j]; xv.y += acc[w][t][4 * j + 1]; xv.z += acc[w][t][4 * j + 2]; xv.w += acc[w][t][4 * j + 3];
                    *(float4*)(out + o) = xv;
                }
    }
};
struct EpiFfn1 {
    bf16_t* act;
    DI void operator()(const f32x16 (&acc)[2][2], int rowbase, int colbase, int lane) const {
        const int rr = lane & 31, hh = lane >> 5;
        const int cb = (colbase >> 6) * 32;
#pragma unroll
        for (int t = 0; t < 2; ++t)
#pragma unroll
            for (int j = 0; j < 4; ++j) {
                float v[4];
#pragma unroll
                for (int i = 0; i < 4; ++i) { const float g = acc[0][t][4 * j + i], u = acc[1][t][4 * j + i]; v[i] = g * sigmoidf_(g) * u; }
                uint2 o; o.x = pack2(v[0], v[1]); o.y = pack2(v[2], v[3]);
                *(uint2*)(act + (size_t)(rowbase + t * 32 + rr) * DFF + cb + j * 8 + hh * 4) = o;
            }
    }
};

DI void rwkv_prep(const P& p, int idx, char* smem) {
    const int tile = idx >> 3, h = idx & 7, tt0 = tile * 32;
    const int tid = threadIdx.x, wave = tid >> 6, lane = tid & 63, rr = lane & 31, hh = lane >> 5;
    bf16_t* lat = (bf16_t*)smem;
    float* res = (float*)(smem + 32 * 296 * 2);
    __syncthreads();
    for (int c = tid; c < 32 * 36; c += NTHR) {
        const int tok = c / 36, ch = c - tok * 36, gi = tt0 + tok, col = 1536 + ch * 8;
        const uint4 cu = *(const uint4*)(p.proj + (size_t)gi * PLD + col);
        uint4 pv = make_uint4(0, 0, 0, 0);
        if ((gi & (S_ - 1)) != 0) pv = *(const uint4*)(p.proj + (size_t)(gi - 1) * PLD + col);
        float a[8], b[8]; unpack8(cu, a); unpack8(pv, b);
        const float4 m0 = *(const float4*)(p.mu + col), m1 = *(const float4*)(p.mu + col + 4);
        const float mu[8] = {m0.x, m0.y, m0.z, m0.w, m1.x, m1.y, m1.z, m1.w};
#pragma unroll
        for (int e = 0; e < 8; ++e) {
            float x = a[e] + (b[e] - a[e]) * mu[e];
            if (ch < 8) x = tanhf(x); else if (ch >= 16) x = sigmoidf_(x);
            a[e] = x;
        }
        *(uint4*)&lat[tok * 296 + ch * 8] = pack8(a);
    }
    __syncthreads();
    if (wave < 2) {
        const int mt = wave;
        f32x16 aw, aa;
#pragma unroll
        for (int i = 0; i < 16; ++i) { aw[i] = 0.f; aa[i] = 0.f; }
#pragma unroll
        for (int ks = 0; ks < 4; ++ks) {
            const bf16x8 wf = *(const bf16x8*)(p.w2T + (size_t)(h * 64 + mt * 32 + rr) * 64 + ks * 16 + hh * 8);
            const bf16x8 af = *(const bf16x8*)(p.a2T + (size_t)(h * 64 + mt * 32 + rr) * 64 + ks * 16 + hh * 8);
            const bf16x8 l0 = *(const bf16x8*)&lat[rr * 296 + ks * 16 + hh * 8];
            const bf16x8 l1 = *(const bf16x8*)&lat[rr * 296 + 64 + ks * 16 + hh * 8];
            aw = MFMA32(wf, l0, aw); aa = MFMA32(af, l1, aa);
        }
#pragma unroll
        for (int j = 0; j < 4; ++j) {
            *(float4*)&res[(0 * 32 + rr) * 64 + mt * 32 + j * 8 + hh * 4] = make_float4(aw[4 * j], aw[4 * j + 1], aw[4 * j + 2], aw[4 * j + 3]);
            *(float4*)&res[(1 * 32 + rr) * 64 + mt * 32 + j * 8 + hh * 4] = make_float4(aa[4 * j], aa[4 * j + 1], aa[4 * j + 2], aa[4 * j + 3]);
        }
    } else {
        const int mt = wave - 2;
        f32x16 ag;
#pragma unroll
        for (int i = 0; i < 16; ++i) ag[i] = 0.f;
#pragma unroll
        for (int ks = 0; ks < 10; ++ks) {
            const bf16x8 gf = *(const bf16x8*)(p.g2T + (size_t)(h * 64 + mt * 32 + rr) * 160 + ks * 16 + hh * 8);
            const bf16x8 l2 = *(const bf16x8*)&lat[rr * 296 + 128 + ks * 16 + hh * 8];
            ag = MFMA32(gf, l2, ag);
        }
#pragma unroll
        for (int j = 0; j < 4; ++j)
            *(float4*)&res[(2 * 32 + rr) * 64 + mt * 32 + j * 8 + hh * 4] = make_float4(ag[4 * j], ag[4 * j + 1], ag[4 * j + 2], ag[4 * j + 3]);
    }
    __syncthreads();
    {
        const int tok = tid >> 3, cgp = tid & 7, gi = tt0 + tok, b = gi >> 14, s = gi & (S_ - 1), cb = h * 64 + cgp * 8;
        const bool first = (s == 0);
        float r[8], k[8], v[8];
        {
            float a[8], pb[8];
            const bf16_t* pr = p.proj + (size_t)gi * PLD;
#pragma unroll
            for (int q = 0; q < 3; ++q) {
                const int col = q * 512 + cb;
                unpack8(*(const uint4*)(pr + col), a);
                if (first) {
#pragma unroll
                    for (int e = 0; e < 8; ++e) pb[e] = 0.f;
                } else unpack8(*(const uint4*)(pr - PLD + col), pb);
                const float4 m0 = *(const float4*)(p.mu + col), m1 = *(const float4*)(p.mu + col + 4);
                const float mu[8] = {m0.x, m0.y, m0.z, m0.w, m1.x, m1.y, m1.z, m1.w};
#pragma unroll
                for (int e = 0; e < 8; ++e) {
                    const float x = a[e] + (pb[e] - a[e]) * mu[e];
                    if (q == 0) r[e] = x; else if (q == 1) k[e] = x; else v[e] = x;
                }
            }
        }
        float om[8], av[8], gg[8], kk[8], km[8], bb[8];
        float ss = 0.f;
#pragma unroll
        for (int e = 0; e < 8; ++e) {
            const float wp = res[(0 * 32 + tok) * 64 + cgp * 8 + e] + p.w0[cb + e];
            const float z = -wp;
            const float sp = fmaxf(z, 0.f) + log1pf(__expf(-fabsf(z)));
            const float w = -sp - 0.5f;
            om[e] = -expm1f(-__expf(w));
            av[e] = sigmoidf_(res[(1 * 32 + tok) * 64 + cgp * 8 + e] + p.a0[cb + e]);
            gg[e] = res[(2 * 32 + tok) * 64 + cgp * 8 + e];
            kk[e] = k[e] * p.k_k[cb + e];
            ss += kk[e] * kk[e];
            km[e] = k[e] * (1.f + (av[e] - 1.f) * p.k_a[cb + e]);
        }
        ss += __shfl_xor(ss, 1); ss += __shfl_xor(ss, 2); ss += __shfl_xor(ss, 4);
        const float inv = 1.f / fmaxf(sqrtf(ss), 1e-12f);
#pragma unroll
        for (int e = 0; e < 8; ++e) { kk[e] *= inv; bb[e] = kk[e] * av[e]; }
        bf16_t* sp = p.stream + ((size_t)((b * 8 + h) * S_ + s) * 6) * 64 + cgp * 8;
        *(uint4*)(sp) = pack8(om); *(uint4*)(sp + 64) = pack8(km); *(uint4*)(sp + 128) = pack8(kk);
        *(uint4*)(sp + 192) = pack8(bb); *(uint4*)(sp + 256) = pack8(r); *(uint4*)(sp + 320) = pack8(v);
        *(uint4*)(p.gbuf + (size_t)gi * 512 + cb) = pack8(gg);
    }
}

DI void rope_item(const P& p, int idx, char* smem) {
    const int tt0 = idx * 64, tid = threadIdx.x;
    bf16_t* vtile = (bf16_t*)smem;
    __syncthreads();
#pragma unroll 1
    for (int it = 0; it < 2; ++it) {
        const int item = tid + it * 256, tok = item >> 3, head = item & 7, gi = tt0 + tok;
        bf16_t* ptr = p.proj + (size_t)gi * PLD + QC + head * 64;
        const float4 c0 = *(const float4*)(p.cosT + (size_t)gi * 8), c1 = *(const float4*)(p.cosT + (size_t)gi * 8 + 4);
        const float4 s0 = *(const float4*)(p.sinT + (size_t)gi * 8), s1 = *(const float4*)(p.sinT + (size_t)gi * 8 + 4);
        const float cc[8] = {c0.x, c0.y, c0.z, c0.w, c1.x, c1.y, c1.z, c1.w}, sn[8] = {s0.x, s0.y, s0.z, s0.w, s1.x, s1.y, s1.z, s1.w};
        float a[8], b[8];
        unpack8(*(const uint4*)ptr, a); unpack8(*(const uint4*)(ptr + 8), b);
#pragma unroll
        for (int e = 0; e < 8; ++e) { const float x1 = a[e], x2 = b[e]; a[e] = (x1 * cc[e] - x2 * sn[e]) * 0.125f; b[e] = (x2 * cc[e] + x1 * sn[e]) * 0.125f; }
        *(uint4*)ptr = pack8(a); *(uint4*)(ptr + 8) = pack8(b);
#pragma unroll
        for (int q = 2; q < 8; ++q) {
            unpack8(*(const uint4*)(ptr + q * 8), a);
#pragma unroll
            for (int e = 0; e < 8; ++e) a[e] *= 0.125f;
            *(uint4*)(ptr + q * 8) = pack8(a);
        }
    }
    {
        const int tok = tid >> 2, sel = (tid >> 1) & 1, hk = tid & 1, gi = tt0 + tok;
        const float4 c0 = *(const float4*)(p.cosT + (size_t)gi * 8), c1 = *(const float4*)(p.cosT + (size_t)gi * 8 + 4);
        const float4 s0 = *(const float4*)(p.sinT + (size_t)gi * 8), s1 = *(const float4*)(p.sinT + (size_t)gi * 8 + 4);
        const float cc[8] = {c0.x, c0.y, c0.z, c0.w, c1.x, c1.y, c1.z, c1.w}, sn[8] = {s0.x, s0.y, s0.z, s0.w, s1.x, s1.y, s1.z, s1.w};
        float a[8], b[8];
        {
            bf16_t* ptr = p.proj + (size_t)gi * PLD + KVC + (sel ? 4 : 2) * 128 + hk * 64;
            unpack8(*(const uint4*)ptr, a); unpack8(*(const uint4*)(ptr + 8), b);
#pragma unroll
            for (int e = 0; e < 8; ++e) { const float x1 = a[e], x2 = b[e]; a[e] = x1 * cc[e] - x2 * sn[e]; b[e] = x2 * cc[e] + x1 * sn[e]; }
            *(uint4*)ptr = pack8(a); *(uint4*)(ptr + 8) = pack8(b);
        }
        {
            const bf16_t* ptr = p.proj + (size_t)gi * PLD + KVC + (sel ? 5 : 3) * 128 + hk * 64;
            bf16_t* vt = vtile + (size_t)((sel * 2 + hk) * 64) * 72 + tok;
            unpack8(*(const uint4*)ptr, a); unpack8(*(const uint4*)(ptr + 8), b);
#pragma unroll
            for (int e = 0; e < 8; ++e) { const float x1 = a[e], x2 = b[e]; a[e] = x1 * cc[e] - x2 * sn[e]; b[e] = x2 * cc[e] + x1 * sn[e]; }
#pragma unroll
            for (int e = 0; e < 8; ++e) { vt[e * 72] = f2bf(a[e]); vt[(8 + e) * 72] = f2bf(b[e]); }
#pragma unroll
            for (int q = 2; q < 8; ++q) {
                const uint4 u = *(const uint4*)(ptr + q * 8);
                const unsigned w[4] = {u.x, u.y, u.z, u.w};
#pragma unroll
                for (int e = 0; e < 4; ++e) { vt[(q * 8 + 2 * e) * 72] = (bf16_t)(w[e] & 0xffffu); vt[(q * 8 + 2 * e + 1) * 72] = (bf16_t)(w[e] >> 16); }
            }
        }
    }
    __syncthreads();
    const int b = tt0 >> 14, s0 = tt0 & (S_ - 1);
#pragma unroll
    for (int i = 0; i < 8; ++i) {
        const int c = tid + i * 256, grp = c >> 9, d = (c >> 3) & 63, ch = c & 7, sel = grp >> 1, hk = grp & 1;
        const uint4 u = *(const uint4*)&vtile[(size_t)(grp * 64 + d) * 72 + ch * 8];
        *(uint4*)(p.vT + ((size_t)((sel * 4 + b * 2 + hk) * 64 + d)) * S_ + s0 + ch * 8) = u;
    }
}

DI void phase2(const P& p, char* smem) {
    for (int it = blockIdx.x; it < 128 + 512 + 8192; it += gridDim.x) {
        if (it < 128) {
            const int kv = it >> 6, bhk = (it >> 4) & 3, mt = (it >> 1) & 7, nt = it & 1, b = bhk >> 1, hk = bhk & 1;
            AFCmp af{p.proj + (size_t)(b * S_) * PLD + KVC + kv * 128 + hk * 64};
            EpiHid ep{p.hid + (size_t)((kv * 4 + bhk) * 1024) * 256, p.b1p + kv * 256};
            gemm_tile(af, p.w1T + (size_t)(kv * 256 + nt * 128) * 2048, 2048, mt * 128, nt * 128, ep, smem);
        } else if (it < 640) rope_item(p, it - 128, smem);
        else rwkv_prep(p, it - 640, smem);
    }
}
DI void phase3(const P& p, char* smem) {
    for (int it = blockIdx.x; it < 64; it += gridDim.x) {
        const int kv = it >> 5, bhk = (it >> 3) & 3, mt = it & 7, b = bhk >> 1;
        AFPlain af{p.hid + (size_t)((kv * 4 + bhk) * 1024) * 256, 256};
        if (kv == 0) { EpiKc ep{p.kc + (size_t)bhk * 1024 * 64, p.cosT, p.sinT, b * S_}; gemm_tile(af, p.wc2T, 256, mt * 128, 0, ep, smem); }
        else { EpiVc ep{p.vcT + (size_t)bhk * 64 * 1024, smem}; gemm_tile(af, p.wc2T + 128 * 256, 256, mt * 128, 0, ep, smem); }
    }
}

template <int CTRL> DI float dpp_add(float x) { return x + __int_as_float(__builtin_amdgcn_mov_dpp(__float_as_int(x), CTRL, 0xF, 0xF, true)); }
DI float red16(float x) { x = dpp_add<0xB1>(x); x = dpp_add<0x4E>(x); x = dpp_add<0x141>(x); x = dpp_add<0x140>(x); return x; }

DI void cvt_store(const uint4 u, const bool isom, float* d) {
    float f0 = bflo(u.x), f1 = bfhi(u.x), f2 = bflo(u.y), f3 = bfhi(u.y), f4 = bflo(u.z), f5 = bfhi(u.z), f6 = bflo(u.w), f7 = bfhi(u.w);
    if (isom) { f0 = 1.f - f0; f1 = 1.f - f1; f2 = 1.f - f2; f3 = 1.f - f3; f4 = 1.f - f4; f5 = 1.f - f5; f6 = 1.f - f6; f7 = 1.f - f7; }
    *(float4*)d = make_float4(f0, f1, f2, f3); *(float4*)(d + 4) = make_float4(f4, f5, f6, f7);
}
DI void scan_unit(const P& p, int su, char* smem) {
    const int xcd = su & 7, kq = su >> 3, bh = xcd * 2 + (kq >> 3), oct = kq & 7, b = bh >> 3, h = bh & 7;
    const int tid = threadIdx.x, wave = tid >> 6, lane = tid & 63;
    float* buf = (float*)smem;
    float* ypb = (float*)(smem + 49152);
    const bf16_t* sbase = p.stream + (size_t)bh * S_ * 384;
    __syncthreads();
#pragma unroll
    for (int i = 0; i < 3; ++i) { const int ci = tid + i * 256; cvt_store(*(const uint4*)(sbase + (size_t)ci * 8), (ci % 48) < 8, buf + ci * 8); }
    __syncthreads();
    if (wave < 2) {
        const int rl = lane >> 4, ks = lane & 15, row = oct * 8 + wave * 4 + rl;
        f2_t sA = {0.f, 0.f}, sB = {0.f, 0.f};
        __builtin_amdgcn_s_setprio(3);
        for (int c = 0; c < 1024; ++c) {
            const float* cb = buf + (c & 1) * 6144 + ks * 4;
            const float* vb = buf + (c & 1) * 6144 + 320 + row;
            float* yo = ypb + ((c & 1) * 2 + wave) * 1024 + lane;
            float4 dec = *(const float4*)(cb), km = *(const float4*)(cb + 64), kk = *(const float4*)(cb + 128), bb = *(const float4*)(cb + 192), rv = *(const float4*)(cb + 256);
            float v = vb[0];
#pragma unroll
            for (int st = 0; st < 16; ++st) {
                float4 ndec = dec, nkm = km, nkk = kk, nbb = bb, nrv = rv; float nv = v;
                if (st < 15) {
                    const float* rec = cb + (st + 1) * 384;
                    ndec = *(const float4*)(rec); nkm = *(const float4*)(rec + 64); nkk = *(const float4*)(rec + 128); nbb = *(const float4*)(rec + 192); nrv = *(const float4*)(rec + 256);
                    nv = vb[(st + 1) * 384];
                }
                const f2_t vv = {v, v};
                const f2_t d01 = {dec.x, dec.y}, d23 = {dec.z, dec.w}, m01 = {km.x, km.y}, m23 = {km.z, km.w};
                const f2_t k01 = {kk.x, kk.y}, k23 = {kk.z, kk.w}, b01 = {bb.x, bb.y}, b23 = {bb.z, bb.w}, r01 = {rv.x, rv.y}, r23 = {rv.z, rv.w};
                const f2_t tA = sA * d01 + vv * m01, tB = sB * d23 + vv * m23;
                f2_t pa = sA * k01; pa = sB * k23 + pa;
                const float sa = red16(pa.x + pa.y);
                const f2_t sav = {sa, sa};
                sA = tA - sav * b01; sB = tB - sav * b23;
                f2_t ya = sA * r01; ya = sB * r23 + ya;
                yo[st * 64] = ya.x + ya.y;
                dec = ndec; km = nkm; kk = nkk; bb = nbb; rv = nrv; v = nv;
            }
            __syncthreads();
        }
        __builtin_amdgcn_s_setprio(0);
    } else {
        const int ht = tid - 128;
        const int ystep = ht >> 3, r8 = ht & 7;
        float* yout = p.yraw + (size_t)(b * S_) * 512 + h * 64 + oct * 8 + r8;
        const float* ysrc = ypb + (r8 >> 2) * 1024 + ystep * 64 + (r8 & 3) * 16;
        uint4 ra0, ra1, ra2, ra3, ra4, ra5, rb0, rb1, rb2, rb3, rb4, rb5;
#define SLOAD(R, CH) { const bf16_t* sp_ = sbase + (size_t)(CH) * 6144 + (size_t)ht * 8; \
        R##0 = *(const uint4*)(sp_); R##1 = *(const uint4*)(sp_ + 1024); R##2 = *(const uint4*)(sp_ + 2048); R##3 = *(const uint4*)(sp_ + 3072); R##4 = *(const uint4*)(sp_ + 4096); R##5 = *(const uint4*)(sp_ + 5120); }
#define SSTORE(R, BI) { float* d_ = buf + (BI) * 6144 + ht * 8; const bool om_ = (ht % 48) < 8; \
        cvt_store(R##0, om_, d_); cvt_store(R##1, ((ht + 128) % 48) < 8, d_ + 1024); cvt_store(R##2, ((ht + 256) % 48) < 8, d_ + 2048); \
        cvt_store(R##3, ((ht + 384) % 48) < 8, d_ + 3072); cvt_store(R##4, ((ht + 512) % 48) < 8, d_ + 4096); cvt_store(R##5, ((ht + 640) % 48) < 8, d_ + 5120); }
#define YRED(C) { const float* ys_ = ysrc + ((C) & 1) * 2048; const float4 a_ = *(const float4*)ys_, b_ = *(const float4*)(ys_ + 4), c_ = *(const float4*)(ys_ + 8), d_ = *(const float4*)(ys_ + 12); \
        yout[(size_t)((C) * 16 + ystep) * 512] = ((a_.x + a_.y) + (a_.z + a_.w)) + ((b_.x + b_.y) + (b_.z + b_.w)) + ((c_.x + c_.y) + (c_.z + c_.w)) + ((d_.x + d_.y) + (d_.z + d_.w)); }
        SLOAD(ra, 1)
        for (int c = 0; c < 1024; c += 2) {
            if (c + 2 < 1024) SLOAD(rb, c + 2)
            SSTORE(ra, 1)
            if (c >= 1) YRED(c - 1)
            __syncthreads();
            if (c + 3 < 1024) SLOAD(ra, c + 3)
            if (c + 2 < 1024) SSTORE(rb, 0)
            YRED(c)
            __syncthreads();
        }
        YRED(1023)
#undef SLOAD
#undef SSTORE
#undef YRED
    }
}

struct AttnSmem {
    bf16_t k[64 * 72];
    bf16_t vt[64 * 68];
    float imp[32 * 256];
    unsigned selbits[32 * 8];
    unsigned wunion[4 * 8];
    unsigned bunion[8];
    int unit;
};

DI void attn_load(const bf16_t* kbase, int kstride, const bf16_t* vtbase, int vtstride, uint4 (&r)[4], int tid, bool needv) {
#pragma unroll
    for (int i = 0; i < 2; ++i) { const int c = tid + i * 256; r[i] = *(const uint4*)(kbase + (size_t)(c >> 3) * kstride + (c & 7) * 8); }
    if (needv) {
#pragma unroll
        for (int i = 0; i < 2; ++i) { const int c = tid + i * 256; r[2 + i] = *(const uint4*)(vtbase + (size_t)(c >> 3) * vtstride + (c & 7) * 8); }
    }
}
DI void attn_store(AttnSmem& sm, const uint4 (&r)[4], int tid, bool needv) {
#pragma unroll
    for (int i = 0; i < 2; ++i) { const int c = tid + i * 256; *(uint4*)&sm.k[(c >> 3) * 72 + (c & 7) * 8] = r[i]; }
    if (needv) {
#pragma unroll
        for (int i = 0; i < 2; ++i) {
            const int c = tid + i * 256; bf16_t* d = &sm.vt[(c >> 3) * 68 + (c & 7) * 8];
            *(uint2*)d = make_uint2(r[2 + i].x, r[2 + i].y); *(uint2*)(d + 4) = make_uint2(r[2 + i].z, r[2 + i].w);
        }
    }
}

template <int MODE>
DI void attn_tile(AttnSmem& sm, const bf16x8 (&qf)[4], f32x16 (&o)[2], float& m, float& l, const float inv_l, const int lo, const int hi,
                  const int lane, const int tokl, const int jbase) {
    const int rr = lane & 31, hh = lane >> 5;
    f32x16 s[2];
#pragma unroll
    for (int mt = 0; mt < 2; ++mt) {
#pragma unroll
        for (int i = 0; i < 16; ++i) s[mt][i] = 0.f;
#pragma unroll
        for (int ks = 0; ks < 4; ++ks) {
            const bf16x8 kf = *(const bf16x8*)&sm.k[(mt * 32 + rr) * 72 + ks * 16 + hh * 8];
            s[mt] = MFMA32(kf, qf[ks], s[mt]);
        }
        asm volatile("" ::: "memory");
    }
    const float L2E = 1.4426950408889634f;
    const int lo2 = lo - 4 * hh, hi2 = hi - 4 * hh;
    float mx = -1e30f;
#pragma unroll
    for (int mt = 0; mt < 2; ++mt)
#pragma unroll
        for (int i = 0; i < 16; ++i) {
            const int kc_ = mt * 32 + (i & 3) + 8 * (i >> 2);
            float v = s[mt][i] * L2E;
            v = (kc_ >= lo2 && kc_ <= hi2) ? v : -1e30f;
            s[mt][i] = v; mx = fmaxf(mx, v);
        }
    float mref = m;
    if (MODE != 2) {
        mx = fmaxf(mx, __shfl_xor(mx, 32));
        const float mnew = fmaxf(m, mx);
        const float alpha = __builtin_amdgcn_exp2f(m - mnew);
        m = mnew; mref = mnew;
        l *= alpha;
        if (MODE == 1) {
#pragma unroll
            for (int dt = 0; dt < 2; ++dt)
#pragma unroll
                for (int i = 0; i < 16; ++i) o[dt][i] *= alpha;
        }
    }
    float psum = 0.f;
#pragma unroll
    for (int mt = 0; mt < 2; ++mt)
#pragma unroll
        for (int i = 0; i < 16; ++i) {
            const float v = s[mt][i];
            float pv = (v > -1e29f) ? __builtin_amdgcn_exp2f(v - mref) : 0.f;
            if (MODE == 2) pv *= inv_l;
            s[mt][i] = pv; psum += pv;
        }
    if (MODE != 2) l += psum;
    if (MODE == 0) return;
    if (MODE == 2) {
#pragma unroll
        for (int mt = 0; mt < 2; ++mt)
#pragma unroll
            for (int jj = 0; jj < 4; ++jj) {
                float q4 = (s[mt][4 * jj] + s[mt][4 * jj + 1]) + (s[mt][4 * jj + 2] + s[mt][4 * jj + 3]);
                float e3 = s[mt][4 * jj + 3];
                q4 += __shfl_xor(q4, 1); q4 += __shfl_xor(q4, 2);
                e3 += __shfl_xor(e3, 1); e3 += __shfl_xor(e3, 2);
                if ((rr & 3) == 0) {
                    const int j = jbase + mt * 8 + 2 * jj + hh;
                    atomicAdd(&sm.imp[tokl * 256 + j], q4);
                    if (j + 1 < 256) atomicAdd(&sm.imp[tokl * 256 + j + 1], e3);
                }
            }
    }
#pragma unroll
    for (int mt = 0; mt < 2; ++mt)
#pragma unroll
        for (int s2 = 0; s2 < 2; ++s2) {
            uint4 pu;
            pu.x = pack2(s[mt][8 * s2 + 0], s[mt][8 * s2 + 1]); pu.y = pack2(s[mt][8 * s2 + 2], s[mt][8 * s2 + 3]);
            pu.z = pack2(s[mt][8 * s2 + 4], s[mt][8 * s2 + 5]); pu.w = pack2(s[mt][8 * s2 + 6], s[mt][8 * s2 + 7]);
            const bf16x8 pf = __builtin_bit_cast(bf16x8, pu);
            asm volatile("" ::: "memory");
#pragma unroll
            for (int dt = 0; dt < 2; ++dt) {
                const bf16_t* vp = &sm.vt[(dt * 32 + rr) * 68 + mt * 32 + s2 * 16 + hh * 4];
                const uint2 v0 = *(const uint2*)vp, v1 = *(const uint2*)(vp + 8);
                const bf16x8 vf = __builtin_bit_cast(bf16x8, make_uint4(v0.x, v0.y, v1.x, v1.y));
                o[dt] = MFMA32(vf, pf, o[dt]);
            }
        }
}

DI unsigned wave_umax(unsigned v) {
#pragma unroll
    for (int o = 32; o; o >>= 1) { const unsigned t = (unsigned)__shfl_xor((int)v, o); v = v > t ? v : t; }
    return v;
}

DI void attn_unit(const P& p, int u, char* smem) {
    AttnSmem& sm = *(AttnSmem*)smem;
    const int tid = threadIdx.x, wave = tid >> 6, lane = tid & 63, rr = lane & 31, hh = lane >> 5;
    const int tile = 511 - (u >> 2), bhk = u & 3, b = bhk >> 1, hk = bhk & 1, t0 = tile * 32;
    const int tokl = wave * 8 + (rr >> 2), t = t0 + tokl, g = rr & 3, head = hk * 4 + g;
    const size_t tokg = (size_t)b * S_ + t;
    bf16x8 qf[4];
#pragma unroll
    for (int ks = 0; ks < 4; ++ks) qf[ks] = *(const bf16x8*)(p.proj + tokg * PLD + QC + head * 64 + ks * 16 + hh * 8);
    float gate[3];
#pragma unroll
    for (int i = 0; i < 3; ++i) gate[i] = sigmoidf_(__uint_as_float((unsigned)p.proj[tokg * PLD + GC + head * 3 + i] << 16));
#pragma unroll
    for (int i = 0; i < 8; ++i) *(float4*)&sm.imp[(tid + i * 256) * 4] = make_float4(0.f, 0.f, 0.f, 0.f);
    sm.selbits[tid] = 0u;
    f32x16 o[2];
#pragma unroll
    for (int dt = 0; dt < 2; ++dt)
#pragma unroll
        for (int i = 0; i < 16; ++i) o[dt][i] = 0.f;
    float* park = &sm.imp[wave * 2048 + lane];
    uint4 rg[4];
    const int ntc = (t0 >> 10) + 1;
    const int vmaxi = (t >= 31) ? ((t - 31) >> 4) : -1;
    const bf16_t* kcb = p.kc + (size_t)bhk * 1024 * 64;
    const bf16_t* vcb = p.vcT + (size_t)bhk * 64 * 1024;
    float m = -1e30f, l = 0.f;
    attn_load(kcb, 64, vcb, 1024, rg, tid, false);
    for (int j = 0; j < ntc; ++j) {
        __syncthreads();
        attn_store(sm, rg, tid, false);
        __syncthreads();
        if (j + 1 < ntc) attn_load(kcb + (size_t)(j + 1) * 64 * 64, 64, vcb, 1024, rg, tid, false);
        attn_tile<0>(sm, qf, o, m, l, 0.f, 0, vmaxi - j * 64, lane, tokl, 0);
    }
    {
        const float lt = l + __shfl_xor(l, 32);
        const float inv_l = lt > 0.f ? 1.f / lt : 0.f;
        attn_load(kcb, 64, vcb, 1024, rg, tid, true);
        for (int j = 0; j < ntc; ++j) {
            __syncthreads();
            attn_store(sm, rg, tid, true);
            __syncthreads();
            if (j + 1 < ntc) attn_load(kcb + (size_t)(j + 1) * 64 * 64, 64, vcb + (j + 1) * 64, 1024, rg, tid, true);
            attn_tile<2>(sm, qf, o, m, l, inv_l, 0, vmaxi - j * 64, lane, tokl, j * 16);
        }
    }
    __syncthreads();
    const int cur = t0 >> 6;
    for (int tk = 0; tk < 8; ++tk) {
        const int tl = wave * 8 + tk;
        const float* ip = &sm.imp[tl * 256];
        unsigned nib = 0u;
        if (cur <= 15) {
#pragma unroll
            for (int e = 0; e < 4; ++e) if (lane * 4 + e <= cur) nib |= 1u << e;
        } else {
            unsigned k0, k1, k2, k3;
            {
                const float4 iv = *(const float4*)(ip + lane * 4);
                const int j0 = lane * 4;
                k0 = (j0 >= 1 && j0 <= cur - 2) ? ((__float_as_uint(iv.x) & 0xFFFFFF00u) | (unsigned)(255 - j0)) : 0u;
                k1 = (j0 + 1 <= cur - 2) ? ((__float_as_uint(iv.y) & 0xFFFFFF00u) | (unsigned)(254 - j0)) : 0u;
                k2 = (j0 + 2 <= cur - 2) ? ((__float_as_uint(iv.z) & 0xFFFFFF00u) | (unsigned)(253 - j0)) : 0u;
                k3 = (j0 + 3 <= cur - 2) ? ((__float_as_uint(iv.w) & 0xFFFFFF00u) | (unsigned)(252 - j0)) : 0u;
#pragma unroll
                for (int e = 0; e < 4; ++e) { const int j = j0 + e; if (j == 0 || j == cur || j == cur - 1) nib |= 1u << e; }
            }
            for (int r = 0; r < 13; ++r) {
                unsigned lm = k0 > k1 ? k0 : k1; const unsigned lm2 = k2 > k3 ? k2 : k3; lm = lm > lm2 ? lm : lm2;
                const unsigned wm = wave_umax(lm);
                if (k0 == wm) { k0 = 0u; nib |= 1u; }
                if (k1 == wm) { k1 = 0u; nib |= 2u; }
                if (k2 == wm) { k2 = 0u; nib |= 4u; }
                if (k3 == wm) { k3 = 0u; nib |= 8u; }
            }
        }
        atomicOr(&sm.selbits[tl * 8 + (lane >> 3)], nib << ((lane & 7) * 4));
    }
    __syncthreads();
    if (tid < 32) {
        const int w = tid >> 3, d = tid & 7; unsigned uu = 0u;
#pragma unroll
        for (int k = 0; k < 8; ++k) uu |= sm.selbits[(w * 8 + k) * 8 + d];
        sm.wunion[w * 8 + d] = uu;
    }
    __syncthreads();
    if (tid < 8) sm.bunion[tid] = sm.wunion[tid] | sm.wunion[8 + tid] | sm.wunion[16 + tid] | sm.wunion[24 + tid];
    __syncthreads();
#pragma unroll
    for (int dt = 0; dt < 2; ++dt)
#pragma unroll
        for (int i = 0; i < 16; ++i) { park[(dt * 16 + i) * 64] = gate[0] * o[dt][i]; o[dt][i] = 0.f; }
    {
        const bf16_t* kb = p.proj + (size_t)(b * S_) * PLD + KVC + 2 * 128 + hk * 64;
        const bf16_t* vb = p.vT + (size_t)((0 * 4 + bhk) * 64) * S_;
        m = -1e30f; l = 0.f;
        auto nextj = [&](int j) -> int {
            ++j;
            while (j <= cur) {
                const unsigned w = sm.bunion[j >> 5] >> (j & 31);
                if (w) { j += __ffs((int)w) - 1; return j <= cur ? j : -1; }
                j = (j | 31) + 1;
            }
            return -1;
        };
        int j = nextj(-1);
        if (j >= 0) attn_load(kb + (size_t)j * 64 * PLD, PLD, vb + j * 64, S_, rg, tid, true);
        while (j >= 0) {
            __syncthreads();
            attn_store(sm, rg, tid, true);
            __syncthreads();
            const int jn = nextj(j);
            if (jn >= 0) attn_load(kb + (size_t)jn * 64 * PLD, PLD, vb + jn * 64, S_, rg, tid, true);
            if ((sm.wunion[wave * 8 + (j >> 5)] >> (j & 31)) & 1u) {
                const bool selme = (sm.selbits[tokl * 8 + (j >> 5)] >> (j & 31)) & 1u;
                const int hi = selme ? (j < cur ? 63 : t - j * 64) : -1;
                attn_tile<1>(sm, qf, o, m, l, 0.f, 0, hi, lane, tokl, 0);
            }
            j = jn;
        }
        const float lt = l + __shfl_xor(l, 32);
        const float sc = lt > 0.f ? gate[1] / lt : 0.f;
#pragma unroll
        for (int dt = 0; dt < 2; ++dt)
#pragma unroll
            for (int i = 0; i < 16; ++i) { park[(dt * 16 + i) * 64] += sc * o[dt][i]; o[dt][i] = 0.f; }
    }
    {
        const bf16_t* kb = p.proj + (size_t)(b * S_) * PLD + KVC + 4 * 128 + hk * 64;
        const bf16_t* vb = p.vT + (size_t)((1 * 4 + bhk) * 64) * S_;
        m = -1e30f; l = 0.f;
        const int jlo = (t0 >= 511) ? ((t0 - 511) >> 6) : 0, jhi = t0 >> 6;
        attn_load(kb + (size_t)jlo * 64 * PLD, PLD, vb + jlo * 64, S_, rg, tid, true);
        for (int j = jlo; j <= jhi; ++j) {
            __syncthreads();
            attn_store(sm, rg, tid, true);
            __syncthreads();
            if (j + 1 <= jhi) attn_load(kb + (size_t)(j + 1) * 64 * PLD, PLD, vb + (j + 1) * 64, S_, rg, tid, true);
            attn_tile<1>(sm, qf, o, m, l, 0.f, t - 511 - j * 64, t - j * 64, lane, tokl, 0);
        }
        const float lt = l + __shfl_xor(l, 32);
        const float sc = lt > 0.f ? gate[2] / lt : 0.f;
#pragma unroll
        for (int dt = 0; dt < 2; ++dt)
#pragma unroll
            for (int i = 0; i < 16; ++i) o[dt][i] = park[(dt * 16 + i) * 64] + sc * o[dt][i];
    }
    bf16_t* mp = p.A + tokg * 1024 + 512 + head * 64;
#pragma unroll
    for (int dt = 0; dt < 2; ++dt)
#pragma unroll
        for (int jj = 0; jj < 4; ++jj) {
            uint2 ov; ov.x = pack2(o[dt][4 * jj], o[dt][4 * jj + 1]); ov.y = pack2(o[dt][4 * jj + 2], o[dt][4 * jj + 3]);
            *(uint2*)(mp + dt * 32 + jj * 8 + hh * 4) = ov;
        }
}

DI void phase4(const P& p, char* smem) {
    for (int su = blockIdx.x; su < 128; su += gridDim.x) scan_unit(p, su, smem);
    AttnSmem& sm = *(AttnSmem*)smem;
    while (true) {
        __syncthreads();
        if (threadIdx.x == 0) sm.unit = (int)atomicAdd(p.counter, 1u);
        __syncthreads();
        const int u = sm.unit;
        if (u >= 2048) break;
        attn_unit(p, u, smem);
    }
}

DI void phase4b(const P& p) {
    const int tid = threadIdx.x;
    for (int it = blockIdx.x; it < T_ / 4; it += gridDim.x) {
        const int gi = it * 4 + (tid >> 6), cgp = tid & 63, h = cgp >> 3, c8 = (cgp & 7) * 8, col = cgp * 8, b = gi >> 14, s = gi & (S_ - 1);
        const float4 y0 = *(const float4*)(p.yraw + (size_t)gi * 512 + col), y1 = *(const float4*)(p.yraw + (size_t)gi * 512 + col + 4);
        float y[8] = {y0.x, y0.y, y0.z, y0.w, y1.x, y1.y, y1.z, y1.w};
        const bf16_t* sp = p.stream + ((size_t)((b * 8 + h) * S_ + s) * 6) * 64 + c8;
        float km[8], r[8], v[8], gg[8];
        unpack8(*(const uint4*)(sp + 64), km); unpack8(*(const uint4*)(sp + 256), r); unpack8(*(const uint4*)(sp + 320), v);
        unpack8(*(const uint4*)(p.gbuf + (size_t)gi * 512 + col), gg);
        float sum = 0.f, bon = 0.f;
#pragma unroll
        for (int e = 0; e < 8; ++e) { sum += y[e]; bon += r[e] * km[e] * p.r_k[col + e]; }
        sum += __shfl_xor(sum, 1); sum += __shfl_xor(sum, 2); sum += __shfl_xor(sum, 4);
        bon += __shfl_xor(bon, 1); bon += __shfl_xor(bon, 2); bon += __shfl_xor(bon, 4);
        const float mean = sum * (1.f / 64.f);
        float var = 0.f;
#pragma unroll
        for (int e = 0; e < 8; ++e) { y[e] -= mean; var += y[e] * y[e]; }
        var += __shfl_xor(var, 1); var += __shfl_xor(var, 2); var += __shfl_xor(var, 4);
        const float rs = rsqrtf(var * (1.f / 64.f) + 64e-5f);
        float o[8];
#pragma unroll
        for (int e = 0; e < 8; ++e) o[e] = (y[e] * rs * p.lnx_w[col + e] + p.lnx_b[col + e] + bon * v[e]) * gg[e];
        *(uint4*)(p.A + (size_t)gi * 1024 + col) = pack8(o);
    }
}

struct EpiFfn2 {
    float* out;
    DI void operator()(const f32x16 (&acc)[2][2], int rowbase, int colbase, int lane) const {
        const int rr = lane & 31, hh = lane >> 5;
#pragma unroll
        for (int w = 0; w < 2; ++w)
#pragma unroll
            for (int t = 0; t < 2; ++t)
#pragma unroll
                for (int j = 0; j < 4; ++j) {
                    float4* o = (float4*)(out + (size_t)(rowbase + t * 32 + rr) * 1024 + colbase + w * 32 + j * 8 + hh * 4);
                    float4 xv = *o;
                    xv.x += acc[w][t][4 * j]; xv.y += acc[w][t][4 * j + 1]; xv.z += acc[w][t][4 * j + 2]; xv.w += acc[w][t][4 * j + 3];
                    *o = xv;
                }
    }
};

DI void final_item(float* io, const float* g, int idx) {
    const int row = idx * 4 + (threadIdx.x >> 6), lane = threadIdx.x & 63;
    float4* sp = (float4*)(io + (size_t)row * 1024);
    float4 v[4]; float ss = 0.f;
#pragma unroll
    for (int i = 0; i < 4; ++i) { v[i] = sp[lane + 64 * i]; ss += v[i].x * v[i].x + v[i].y * v[i].y + v[i].z * v[i].z + v[i].w * v[i].w; }
    ss = wave_sum(ss);
    const float rs = rsqrtf(ss * (1.f / 1024.f) + 1e-6f);
#pragma unroll
    for (int i = 0; i < 4; ++i) {
        const float4 gv = ((const float4*)g)[lane + 64 * i];
        sp[lane + 64 * i] = make_float4(v[i].x * rs * gv.x, v[i].y * rs * gv.y, v[i].z * rs * gv.z, v[i].w * rs * gv.w);
    }
}

DI void run_phase(const P& p, int ph, char* smem) {
    switch (ph) {
    case 0: phase0(p, smem); break;
    case 1:
        for (int it = blockIdx.x; it < 256 * 25; it += gridDim.x) {
            const int mt = it / 25, nt = it - mt * 25;
            gemm_tile(AFPlain{p.A, 1024}, p.WinT + (size_t)nt * 128 * 1024, 1024, mt * 128, nt * 128, EpiProj{p.proj}, smem);
        }
        break;
    case 2: phase2(p, smem); break;
    case 3: phase3(p, smem); break;
    case 4: phase4(p, smem); break;
    case 5: phase4b(p); break;
    case 6:
        for (int it = blockIdx.x; it < 256 * 8; it += gridDim.x) {
            const int mt = it >> 3, nt = it & 7;
            gemm_tile(AFPlain{p.A, 1024}, p.WoutT + (size_t)nt * 128 * 1024, 1024, mt * 128, nt * 128, EpiOut{p.out, p.x}, smem);
        }
        break;
    case 7:
        for (int it = blockIdx.x; it < T_ / 4; it += gridDim.x) rms_item(p.out, p.norm_ffn, p.A, it);
        break;
    case 8:
        for (int it = blockIdx.x; it < 256 * 44; it += gridDim.x) {
            const int mt = it / 44, nt = it - mt * 44;
            gemm_tile(AFPlain{p.A, 1024}, p.WguT + (size_t)nt * 128 * 1024, 1024, mt * 128, nt * 128, EpiFfn1{p.stream}, smem);
        }
        break;
    case 9:
        for (int it = blockIdx.x; it < 256 * 8; it += gridDim.x) {
            const int mt = it >> 3, nt = it & 7;
            gemm_tile(AFPlain{p.stream, DFF}, p.WdnT + (size_t)nt * 128 * DFF, DFF, mt * 128, nt * 128, EpiFfn2{p.out}, smem);
        }
        break;
    default:
        for (int it = blockIdx.x; it < T_ / 4; it += gridDim.x) final_item(p.out, p.norm_final, it);
        break;
    }
}
constexpr int NPHASE = 11;
constexpr int SMEM_BYTES = 65536;


#define XB_TMO      128
#define XB_XCNT(j)  (256  + 64 * (j))
#define XB_XSUB(j)  (1280 + 64 * (j))
#define XB_XGEN(j)  (2304 + 64 * (j))
#define XB_TOP      3328
#define XB_TOPGEN   3392
#define XCD_BAR_WORDS 3456
#define XB_SPIN_CAP (1u << 18)
#define LAS __attribute__((address_space(3)))
DI unsigned xb_ld(unsigned* p) { return __hip_atomic_load(p, __ATOMIC_RELAXED, __HIP_MEMORY_SCOPE_AGENT); }
DI unsigned xb_add(unsigned* p, unsigned v) { return __hip_atomic_fetch_add(p, v, __ATOMIC_RELAXED, __HIP_MEMORY_SCOPE_AGENT); }
DI unsigned xb_xcc_id() { return (unsigned)__builtin_amdgcn_s_getreg((3 << 11) | 20) & 0xFu; }
#define XB_SPIN(cond, bar) do { unsigned _sp = 0; while (cond) { __builtin_amdgcn_s_sleep(1); \
    if ((++_sp & 255u) == 0u) { if (xb_ld(&(bar)[XB_TMO])) break; if (_sp > XB_SPIN_CAP) { atomicAdd(&(bar)[XB_TMO], 1u); break; } } } } while (0)
struct XcdBarrier { unsigned* bar; unsigned x; volatile LAS unsigned* st; };
DI XcdBarrier xcd_barrier_post(unsigned* bar, volatile LAS unsigned* st) {
    XcdBarrier b; b.bar = bar; b.x = xb_xcc_id(); b.st = st;
    if (threadIdx.x == 0) (void)xb_add(&bar[XB_XCNT(b.x)], 1u);
    return b;
}
DI void xcd_barrier_complete(unsigned* bar, unsigned x, unsigned& nloc, unsigned& nx) {
    const unsigned G = gridDim.x * gridDim.y * gridDim.z;
    unsigned sum, cnt, mine, sp = 0u;
    for (;;) {
        sum = 0u; cnt = 0u; mine = 0u;
#pragma unroll
        for (unsigned j = 0; j < 16; ++j) { const unsigned c = xb_ld(&bar[XB_XCNT(j)]); sum += c; cnt += (c > 0u) ? 1u : 0u; mine = (j == x) ? c : mine; }
        if (sum == G) break;
        __builtin_amdgcn_s_sleep(1);
        if ((++sp & 255u) == 0u) { if (xb_ld(&bar[XB_TMO])) break; if (sp > XB_SPIN_CAP) { atomicAdd(&bar[XB_TMO], 1u); break; } }
    }
    nloc = mine > 0u ? mine : 1u; nx = cnt > 0u ? cnt : 1u;
}
DI void xcd_barrier(const XcdBarrier& b) {
    asm volatile("s_waitcnt vmcnt(0)" ::: "memory");
    __syncthreads();
    if (threadIdx.x == 0) {
        unsigned* bar = b.bar;
        __builtin_amdgcn_s_waitcnt(0);
        unsigned nloc = b.st[0], nx = b.st[1];
        if (nloc == 0u) { xcd_barrier_complete(bar, b.x, nloc, nx); b.st[0] = nloc; b.st[1] = nx; }
        const unsigned old = xb_add(&bar[XB_XSUB(b.x)], 1u);
        const unsigned gen = old / nloc;
        if (old + 1u == (gen + 1u) * nloc) {
            __builtin_amdgcn_fence(__ATOMIC_RELEASE, "agent");
            asm volatile("s_waitcnt vmcnt(0)" ::: "memory");
            const unsigned og = xb_add(&bar[XB_TOP], 1u);
            const unsigned tg = og / nx;
            if (og + 1u == (tg + 1u) * nx) xb_add(&bar[XB_TOPGEN], 1u);
            else XB_SPIN(xb_ld(&bar[XB_TOPGEN]) == tg, bar);
            __builtin_amdgcn_fence(__ATOMIC_ACQUIRE, "agent");
            xb_add(&bar[XB_XGEN(b.x)], 1u);
            asm volatile("s_waitcnt vmcnt(0)" ::: "memory");
        } else {
            XB_SPIN(xb_ld(&bar[XB_XGEN(b.x)]) == gen, bar);
            __builtin_amdgcn_fence(__ATOMIC_ACQUIRE, "agent");
            asm volatile("s_waitcnt vmcnt(0)" ::: "memory");
        }
    }
    __syncthreads();
}

__global__ void __launch_bounds__(NTHR, 2) mega_kernel(P p) {
    __shared__ __attribute__((aligned(16))) char smem[SMEM_BYTES];
    __shared__ uint4 xb_words;
    cg::grid_group grid = cg::this_grid();
    if (p.x == nullptr) grid.sync();
    if (threadIdx.x == 0) xb_words = make_uint4(0u, 0u, 0u, 0u);
    __syncthreads();
    const XcdBarrier xb = xcd_barrier_post(p.bar, (volatile LAS unsigned*)&xb_words);
    run_phase(p, 0, smem); xcd_barrier(xb);
    run_phase(p, 1, smem); xcd_barrier(xb);
    run_phase(p, 2, smem); xcd_barrier(xb);
    run_phase(p, 3, smem); xcd_barrier(xb);
    run_phase(p, 4, smem); xcd_barrier(xb);
    run_phase(p, 5, smem); xcd_barrier(xb);
    run_phase(p, 6, smem); xcd_barrier(xb);
    run_phase(p, 7, smem); xcd_barrier(xb);
    run_phase(p, 8, smem); xcd_barrier(xb);
    run_phase(p, 9, smem); xcd_barrier(xb);
    run_phase(p, 10, smem);
}
__global__ void __launch_bounds__(NTHR, 2) phase_kernel(P p, int ph) {
    __shared__ __attribute__((aligned(16))) char smem[SMEM_BYTES];
    run_phase(p, ph, smem);
}

extern "C" void kernel_launch(void* const* d_in, const int* in_sizes, int n_in, void* d_out, int out_size, void* d_ws, size_t ws_size,
                              hipStream_t stream) {
    P p{};
    p.x = (const float*)d_in[0]; p.pos = (const int*)d_in[1]; p.norm_mix = (const float*)d_in[2]; p.w_in = (const float*)d_in[3];
    p.mu = (const float*)d_in[4]; p.w0 = (const float*)d_in[5]; p.w2 = (const float*)d_in[6]; p.a0 = (const float*)d_in[7];
    p.a2 = (const float*)d_in[8]; p.g2 = (const float*)d_in[9]; p.k_k = (const float*)d_in[10]; p.k_a = (const float*)d_in[11];
    p.r_k = (const float*)d_in[12]; p.lnx_w = (const float*)d_in[13]; p.lnx_b = (const float*)d_in[14]; p.pe_k = (const float*)d_in[15];
    p.wk1 = (const float*)d_in[16]; p.bk1 = (const float*)d_in[17]; p.wk2 = (const float*)d_in[18]; p.pe_v = (const float*)d_in[19];
    p.wv1 = (const float*)d_in[20]; p.bv1 = (const float*)d_in[21]; p.wv2 = (const float*)d_in[22]; p.w_out = (const float*)d_in[23];
    p.norm_ffn = (const float*)d_in[24]; p.w_gate = (const float*)d_in[25]; p.w_up = (const float*)d_in[26]; p.w_down = (const float*)d_in[27];
    p.norm_final = (const float*)d_in[28];
    p.out = (float*)d_out;
    char* ws = (char*)d_ws;
    size_t off = 0;
    auto take = [&](size_t bytes) { char* r = ws + off; off += (bytes + 255) & ~(size_t)255; return r; };
    p.WinT = (bf16_t*)take((size_t)3200 * 1024 * 2);
    p.WoutT = (bf16_t*)take((size_t)1024 * 1024 * 2);
    p.WguT = (bf16_t*)take((size_t)5632 * 1024 * 2);
    p.WdnT = (bf16_t*)take((size_t)1024 * DFF * 2);
    p.w2T = (bf16_t*)take(512 * 64 * 2);
    p.a2T = (bf16_t*)take(512 * 64 * 2);
    p.g2T = (bf16_t*)take(512 * 160 * 2);
    p.w1T = (bf16_t*)take((size_t)2 * 256 * 2048 * 2);
    p.wc2T = (bf16_t*)take(2 * 128 * 256 * 2);
    p.b1p = (float*)take(512 * 4);
    p.cosT = (float*)take((size_t)T_ * 8 * 4);
    p.sinT = (float*)take((size_t)T_ * 8 * 4);
    p.counter = (unsigned*)take(256);
    p.bar = (unsigned*)take(XCD_BAR_WORDS * 4);
    off = (size_t)32 << 20;
    p.A = (bf16_t*)take((size_t)T_ * 1024 * 2);
    p.proj = (bf16_t*)take((size_t)T_ * PLD * 2);
    p.stream = (bf16_t*)take((size_t)T_ * 8 * 384 * 2);
    if (off > ws_size) fprintf(stderr, "workspace too small: need %zu have %zu\n", off, ws_size);
    char* ob = (char*)d_out;
    p.gbuf = (bf16_t*)ob;
    p.yraw = (float*)(ob + ((size_t)32 << 20));
    p.vT = (bf16_t*)(ob + ((size_t)96 << 20));
    p.hid = (bf16_t*)(ob + ((size_t)112 << 20));
    p.kc = (bf16_t*)(ob + ((size_t)116 << 20));
    p.vcT = (bf16_t*)(ob + ((size_t)116 << 20) + (512 << 10));
#if MK_SINGLE
    static int grid_blocks = 0;
    if (!grid_blocks) {
        int dev = 0, cus = 0, per_cu = 0;
        hipGetDevice(&dev);
        hipDeviceGetAttribute(&cus, hipDeviceAttributeMultiprocessorCount, dev);
        hipOccupancyMaxActiveBlocksPerMultiprocessor(&per_cu, mega_kernel, NTHR, 0);
        if (per_cu > 2) per_cu = 2;
        if (per_cu < 1) per_cu = 1;
        grid_blocks = cus * per_cu;
    }
    (void)hipMemsetAsync(p.bar, 0, XCD_BAR_WORDS * 4, stream);
    void* args[] = {&p};
    hipError_t e = hipLaunchCooperativeKernel((void*)mega_kernel, dim3(grid_blocks), dim3(NTHR), args, 0, stream);
    if (e != hipSuccess) fprintf(stderr, "cooperative launch failed: %s (grid %d)\n", hipGetErrorString(e), grid_blocks);
#else
    for (int ph = 0; ph < NPHASE; ++ph) phase_kernel<<<512, NTHR, 0, stream>>>(p, ph);
#endif
}
```

```cpp
#include <hip/hip_runtime.h>
#include <hip/hip_cooperative_groups.h>
#include <cstdio>
namespace cg = cooperative_groups;

#ifndef MK_SINGLE
#define MK_SINGLE 1
#endif

#define DI __device__ __forceinline__
typedef unsigned short bf16_t;
typedef short bf16x8 __attribute__((ext_vector_type(8)));
typedef float f32x16 __attribute__((ext_vector_type(16)));
typedef __bf16 bf2_t __attribute__((ext_vector_type(2)));
typedef float f2_t __attribute__((ext_vector_type(2)));

constexpr int T_ = 32768, S_ = 16384;
constexpr int PLD = 3200;
constexpr int QC = 1856, KVC = 2368, GC = 3136;
constexpr int DFF = 2816;
constexpr int NTHR = 256;
constexpr float QSC = 0.125f * 1.4426950408889634f;

#define MFMA32(a, b, c) __builtin_amdgcn_mfma_f32_32x32x16_bf16((a), (b), (c), 0, 0, 0)

DI unsigned pack2(float a, float b) { f2_t v = {a, b}; return __builtin_bit_cast(unsigned, __builtin_convertvector(v, bf2_t)); }
DI float bflo(unsigned u) { return __uint_as_float(u << 16); }
DI float bfhi(unsigned u) { return __uint_as_float(u & 0xffff0000u); }
DI bf16_t f2bf(float a) { return (bf16_t)(pack2(a, 0.f) & 0xffffu); }
DI void unpack8(const uint4& u, float (&f)[8]) {
    f[0] = bflo(u.x); f[1] = bfhi(u.x); f[2] = bflo(u.y); f[3] = bfhi(u.y);
    f[4] = bflo(u.z); f[5] = bfhi(u.z); f[6] = bflo(u.w); f[7] = bfhi(u.w);
}
DI uint4 pack8(const float (&f)[8]) { uint4 u; u.x = pack2(f[0], f[1]); u.y = pack2(f[2], f[3]); u.z = pack2(f[4], f[5]); u.w = pack2(f[6], f[7]); return u; }
DI float wave_sum(float v) {
#pragma unroll
    for (int o = 32; o; o >>= 1) v += __shfl_xor(v, o);
    return v;
}
DI float sigmoidf_(float x) { return 1.f / (1.f + __expf(-x)); }
DI int crow(int reg, int h) { return (reg & 3) + 8 * (reg >> 2) + 4 * h; }

struct P {
    const float* x; const int* pos; const float *norm_mix, *w_in, *mu, *w0, *w2, *a0, *a2, *g2, *k_k, *k_a, *r_k, *lnx_w, *lnx_b,
        *pe_k, *wk1, *bk1, *wk2, *pe_v, *wv1, *bv1, *wv2, *w_out, *norm_ffn, *w_gate, *w_up, *w_down, *norm_final;
    float* out;
    bf16_t *WinT, *WoutT, *WguT, *WdnT, *w2T, *a2T, *g2T, *w1T, *wc2T;
    float *b1p, *cosT, *sinT;
    unsigned* counter; unsigned* bar;
    bf16_t *A, *proj, *stream;
    bf16_t* gbuf; float* yraw; bf16_t *vT, *hid, *kc, *vcT;
};

DI float tr_val(const P& p, int job, int k, int n) {
    switch (job) {
    case 0: { int c = n < 1824 ? n : ((n >= 1856 && n < 3160) ? n - 32 : -1); return c >= 0 ? p.w_in[(size_t)k * 3128 + c] : 0.f; }
    case 1: return p.w_out[k * 1024 + n];
    case 2: { int q = n >> 6, r = n & 63; return r < 32 ? p.w_gate[(size_t)k * DFF + q * 32 + r] : p.w_up[(size_t)k * DFF + q * 32 + r - 32]; }
    case 3: return p.w_down[(size_t)k * 1024 + n];
    case 4: return p.w2[k * 512 + n];
    case 5: return p.a2[k * 512 + n];
    case 6: return p.g2[k * 512 + n];
    case 7: return p.wk1[k * 256 + n];
    case 8: return p.wv1[k * 256 + n];
    case 9: return n < 64 ? p.wk2[k * 64 + n] : 0.f;
    default: return n < 64 ? p.wv2[k * 64 + n] : 0.f;
    }
}
DI void tr_item(const P& p, int it, float* tile) {
    int job, K, N; bf16_t* dst;
    if (it < 800) { job = 0; K = 1024; N = 3200; dst = p.WinT; }
    else if (it < 1056) { job = 1; it -= 800; K = 1024; N = 1024; dst = p.WoutT; }
    else if (it < 2464) { job = 2; it -= 1056; K = 1024; N = 5632; dst = p.WguT; }
    else if (it < 3168) { job = 3; it -= 2464; K = 2816; N = 1024; dst = p.WdnT; }
    else if (it < 3176) { job = 4; it -= 3168; K = 64; N = 512; dst = p.w2T; }
    else if (it < 3184) { job = 5; it -= 3176; K = 64; N = 512; dst = p.a2T; }
    else if (it < 3208) { job = 6; it -= 3184; K = 160; N = 512; dst = p.g2T; }
    else if (it < 3336) { job = 7; it -= 3208; K = 2048; N = 256; dst = p.w1T; }
    else if (it < 3464) { job = 8; it -= 3336; K = 2048; N = 256; dst = p.w1T + 256 * 2048; }
    else if (it < 3472) { job = 9; it -= 3464; K = 256; N = 128; dst = p.wc2T; }
    else { job = 10; it -= 3472; K = 256; N = 128; dst = p.wc2T + 128 * 256; }
    const int nt = N >> 6;
    const int k0 = (it / nt) * 64, n0 = (it % nt) * 64;
    const int tid = threadIdx.x;
    __syncthreads();
#pragma unroll 4
    for (int i = 0; i < 16; ++i) {
        const int kk = i * 4 + (tid >> 6), nn = tid & 63;
        tile[kk * 65 + nn] = (k0 + kk < K) ? tr_val(p, job, k0 + kk, n0 + nn) : 0.f;
    }
    __syncthreads();
#pragma unroll 4
    for (int i = 0; i < 16; ++i) {
        const int nn = i * 4 + (tid >> 6), kk = tid & 63;
        if (k0 + kk < K) dst[(size_t)(n0 + nn) * K + k0 + kk] = f2bf(tile[kk * 65 + nn]);
    }
}
DI void b1_item(const P& p, int idx) {
    const int kv = idx >> 4, jc = idx & 15, tid = threadIdx.x;
    const float* pe = kv ? p.pe_v : p.pe_k; const float* w1 = kv ? p.wv1 : p.wk1; const float* b1 = kv ? p.bv1 : p.bk1;
    const int j = jc * 16 + (tid >> 4), kl = tid & 15;
    float s = 0.f;
    for (int i = 0; i < 128; ++i) { const int k = kl + 16 * i; s += pe[k] * w1[k * 256 + j]; }
    s += __shfl_xor(s, 1); s += __shfl_xor(s, 2); s += __shfl_xor(s, 4); s += __shfl_xor(s, 8);
    if (kl == 0) p.b1p[kv * 256 + j] = b1[j] + s;
}
DI void sincos_d(float ang, float& c, float& s) {
    double x = (double)ang;
    const double TWO_PI = 6.283185307179586476925286766559;
    double n = __builtin_rint(x * (1.0 / TWO_PI));
    double r = x - n * TWO_PI;
    double q = r * 0.25;
    double q2 = q * q;
    double sn = q * (1.0 + q2 * (-1.0 / 6 + q2 * (1.0 / 120 + q2 * (-1.0 / 5040 + q2 * (1.0 / 362880 + q2 * (-1.0 / 39916800 + q2 * (1.0 / 6227020800.0)))))));
    double cs = 1.0 + q2 * (-0.5 + q2 * (1.0 / 24 + q2 * (-1.0 / 720 + q2 * (1.0 / 40320 + q2 * (-1.0 / 3628800 + q2 * (1.0 / 479001600.0))))));
    double s2 = 2 * sn * cs, c2 = 1 - 2 * sn * sn;
    double s4 = 2 * s2 * c2, c4 = 1 - 2 * s2 * s2;
    c = (float)c4; s = (float)s4;
}
DI void cs_item(const P& p, int idx) {
    const int e = idx * 256 + threadIdx.x, tok = e >> 3, f = e & 7;
    const float invf[8] = {1.000000000e+00f, 1.939227432e-01f, 3.760603070e-02f, 7.292664610e-03f, 1.414213562e-03f, 2.742481884e-04f, 5.318295734e-05f, 1.031338525e-05f};
    float iv = invf[0];
#pragma unroll
    for (int i = 1; i < 8; ++i) iv = (f == i) ? invf[i] : iv;
    const float ang = (float)p.pos[tok] * iv;
    float c, s; sincos_d(ang, c, s);
    p.cosT[e] = c; p.sinT[e] = s;
}
DI void rms_item(const float* src, const float* g, bf16_t* dst, int idx) {
    const int row = idx * 4 + (threadIdx.x >> 6), lane = threadIdx.x & 63;
    const float4* sp = (const float4*)(src + (size_t)row * 1024);
    float4 v[4]; float ss = 0.f;
#pragma unroll
    for (int i = 0; i < 4; ++i) { v[i] = sp[lane + 64 * i]; ss += v[i].x * v[i].x + v[i].y * v[i].y + v[i].z * v[i].z + v[i].w * v[i].w; }
    ss = wave_sum(ss);
    const float rs = rsqrtf(ss * (1.f / 1024.f) + 1e-6f);
#pragma unroll
    for (int i = 0; i < 4; ++i) {
        const float4 gv = ((const float4*)g)[lane + 64 * i];
        uint2 o; o.x = pack2(v[i].x * rs * gv.x, v[i].y * rs * gv.y); o.y = pack2(v[i].z * rs * gv.z, v[i].w * rs * gv.w);
        *(uint2*)(dst + (size_t)row * 1024 + (lane + 64 * i) * 4) = o;
    }
}
DI void phase0(const P& p, char* smem) {
    if (blockIdx.x == 0 && threadIdx.x == 0) *p.counter = 0u;
    constexpr int NTR = 3480, NB1 = 32, NCS = 1024, NXN = 8192;
    for (int it = blockIdx.x; it < NTR + NB1 + NCS + NXN; it += gridDim.x) {
        if (it < NTR) tr_item(p, it, (float*)smem);
        else if (it < NTR + NB1) b1_item(p, it - NTR);
        else if (it < NTR + NB1 + NCS) cs_item(p, it - NTR - NB1);
        else rms_item(p.x, p.norm_mix, p.A, it - NTR - NB1 - NCS);
    }
}

struct AFPlain { const bf16_t* A; int lda; DI uint4 load(int row, int k) const { return *(const uint4*)(A + (size_t)row * lda + k); } };
struct AFCmp {
    const bf16_t* base;
    DI uint4 load(int r, int k) const { int tok = 16 * r + (k >> 6); tok = tok < S_ ? tok : S_ - 1; return *(const uint4*)(base + (size_t)tok * PLD + (k & 63)); }
};

template <class AF, class EPI>
DI void gemm_tile(const AF af, const bf16_t* __restrict__ Bt, const int K, const int m0, const int n0, const EPI epi, char* smem) {
    bf16_t* sA = (bf16_t*)smem; bf16_t* sB = sA + 128 * 72;
    const int tid = threadIdx.x, wave = tid >> 6, lane = tid & 63, wm = wave >> 1, wn = wave & 1, rr = lane & 31, hh = lane >> 5;
    f32x16 acc[2][2];
#pragma unroll
    for (int a = 0; a < 2; ++a)
#pragma unroll
        for (int b = 0; b < 2; ++b)
#pragma unroll
            for (int i = 0; i < 16; ++i) acc[a][b][i] = 0.f;
    const int lrow = tid >> 3, lk = (tid & 7) * 8;
#define GLOAD(KO) \
    ra0 = af.load(m0 + lrow, (KO) + lk); ra1 = af.load(m0 + lrow + 32, (KO) + lk); ra2 = af.load(m0 + lrow + 64, (KO) + lk); ra3 = af.load(m0 + lrow + 96, (KO) + lk); \
    rb0 = *(const uint4*)(Bt + (size_t)(lrow) * K + (KO) + lk); rb1 = *(const uint4*)(Bt + (size_t)(lrow + 32) * K + (KO) + lk); \
    rb2 = *(const uint4*)(Bt + (size_t)(lrow + 64) * K + (KO) + lk); rb3 = *(const uint4*)(Bt + (size_t)(lrow + 96) * K + (KO) + lk);
    uint4 ra0, ra1, ra2, ra3, rb0, rb1, rb2, rb3;
    GLOAD(0)
#pragma unroll 1
    for (int k0 = 0; k0 < K; k0 += 64) {
        __syncthreads();
        *(uint4*)&sA[(lrow) * 72 + lk] = ra0; *(uint4*)&sA[(lrow + 32) * 72 + lk] = ra1; *(uint4*)&sA[(lrow + 64) * 72 + lk] = ra2; *(uint4*)&sA[(lrow + 96) * 72 + lk] = ra3;
        *(uint4*)&sB[(lrow) * 72 + lk] = rb0; *(uint4*)&sB[(lrow + 32) * 72 + lk] = rb1; *(uint4*)&sB[(lrow + 64) * 72 + lk] = rb2; *(uint4*)&sB[(lrow + 96) * 72 + lk] = rb3;
        __syncthreads();
        if (k0 + 64 < K) { GLOAD(k0 + 64) }
#pragma unroll
        for (int ks = 0; ks < 4; ++ks) {
            bf16x8 tf[2], wf[2];
#pragma unroll
            for (int t = 0; t < 2; ++t) tf[t] = *(const bf16x8*)&sA[(wm * 64 + t * 32 + rr) * 72 + ks * 16 + hh * 8];
#pragma unroll
            for (int w = 0; w < 2; ++w) wf[w] = *(const bf16x8*)&sB[(wn * 64 + w * 32 + rr) * 72 + ks * 16 + hh * 8];
#pragma unroll
            for (int w = 0; w < 2; ++w)
#pragma unroll
                for (int t = 0; t < 2; ++t) acc[w][t] = MFMA32(wf[w], tf[t], acc[w][t]);
        }
    }
#undef GLOAD
    epi(acc, m0 + wm * 64, n0 + wn * 64, lane);
}

struct EpiProj {
    bf16_t* C;
    DI void operator()(const f32x16 (&acc)[2][2], int rowbase, int colbase, int lane) const {
        const int rr = lane & 31, hh = lane >> 5;
#pragma unroll
        for (int w = 0; w < 2; ++w)
#pragma unroll
            for (int t = 0; t < 2; ++t)
#pragma unroll
                for (int j = 0; j < 4; ++j) {
                    uint2 o; o.x = pack2(acc[w][t][4 * j], acc[w][t][4 * j + 1]); o.y = pack2(acc[w][t][4 * j + 2], acc[w][t][4 * j + 3]);
                    *(uint2*)(C + (size_t)(rowbase + t * 32 + rr) * PLD + colbase + w * 32 + j * 8 + hh * 4) = o;
                }
    }
};
struct EpiHid {
    bf16_t* H; const float* bias;
    DI void operator()(const f32x16 (&acc)[2][2], int rowbase, int colbase, int lane) const {
        const int rr = lane & 31, hh = lane >> 5;
#pragma unroll
        for (int w = 0; w < 2; ++w)
#pragma unroll
            for (int t = 0; t < 2; ++t)
#pragma unroll
                for (int j = 0; j < 4; ++j) {
                    const int col = colbase + w * 32 + j * 8 + hh * 4;
                    const float4 bv = *(const float4*)(bias + col);
                    float v0 = acc[w][t][4 * j] + bv.x, v1 = acc[w][t][4 * j + 1] + bv.y, v2 = acc[w][t][4 * j + 2] + bv.z, v3 = acc[w][t][4 * j + 3] + bv.w;
                    v0 *= sigmoidf_(v0); v1 *= sigmoidf_(v1); v2 *= sigmoidf_(v2); v3 *= sigmoidf_(v3);
                    uint2 o; o.x = pack2(v0, v1); o.y = pack2(v2, v3);
                    *(uint2*)(H + (size_t)(rowbase + t * 32 + rr) * 256 + col) = o;
                }
    }
};
struct EpiKc {
    bf16_t* kc; const float *cosT, *sinT; int tokbase;
    DI void operator()(const f32x16 (&acc)[2][2], int rowbase, int colbase, int lane) const {
        if (colbase != 0) return;
        const int rr = lane & 31, hh = lane >> 5;
#pragma unroll
        for (int t = 0; t < 2; ++t) {
            const int r = rowbase + t * 32 + rr;
            int tk = 31 + 16 * r; tk = tk < S_ ? tk : S_ - 1;
            const float4 c = *(const float4*)(cosT + (size_t)(tokbase + tk) * 8 + hh * 4), s = *(const float4*)(sinT + (size_t)(tokbase + tk) * 8 + hh * 4);
            bf16_t* kp = kc + (size_t)r * 64 + hh * 4;
            const float a0 = acc[0][t][0], a1 = acc[0][t][1], a2 = acc[0][t][2], a3 = acc[0][t][3];
            const float b0 = acc[0][t][4], b1 = acc[0][t][5], b2 = acc[0][t][6], b3 = acc[0][t][7];
            uint2 o;
            o.x = pack2(a0 * c.x - b0 * s.x, a1 * c.y - b1 * s.y); o.y = pack2(a2 * c.z - b2 * s.z, a3 * c.w - b3 * s.w);
            *(uint2*)(kp) = o;
            o.x = pack2(b0 * c.x + a0 * s.x, b1 * c.y + a1 * s.y); o.y = pack2(b2 * c.z + a2 * s.z, b3 * c.w + a3 * s.w);
            *(uint2*)(kp + 8) = o;
#pragma unroll
            for (int j = 2; j < 4; ++j) {
                o.x = pack2(acc[0][t][4 * j], acc[0][t][4 * j + 1]); o.y = pack2(acc[0][t][4 * j + 2], acc[0][t][4 * j + 3]);
                *(uint2*)(kp + j * 8) = o;
            }
#pragma unroll
            for (int j = 0; j < 4; ++j) {
                o.x = pack2(acc[1][t][4 * j], acc[1][t][4 * j + 1]); o.y = pack2(acc[1][t][4 * j + 2], acc[1][t][4 * j + 3]);
                *(uint2*)(kp + 32 + j * 8) = o;
            }
        }
    }
};
struct EpiVc {
    bf16_t* vcT; char* smem;
    DI void operator()(const f32x16 (&acc)[2][2], int rowbase, int colbase, int lane) const {
        const int rr = lane & 31, hh = lane >> 5;
        bf16_t* tl = (bf16_t*)smem;
        __syncthreads();
        if (colbase == 0) {
            const int rl = rowbase & 127;
#pragma unroll
            for (int w = 0; w < 2; ++w)
#pragma unroll
                for (int t = 0; t < 2; ++t)
#pragma unroll
                    for (int i = 0; i < 16; ++i) tl[(w * 32 + crow(i, hh)) * 136 + rl + t * 32 + rr] = f2bf(acc[w][t][i]);
        }
        __syncthreads();
        const int m0 = rowbase & ~127;
#pragma unroll
        for (int i = 0; i < 4; ++i) {
            const int c = threadIdx.x + i * 256, d = c >> 4, ch = c & 15;
            *(uint4*)(vcT + (size_t)d * 1024 + m0 + ch * 8) = *(const uint4*)&tl[d * 136 + ch * 8];
        }
    }
};
struct EpiOut {
    float* out; const float* x;
    DI void operator()(const f32x16 (&acc)[2][2], int rowbase, int colbase, int lane) const {
        const int rr = lane & 31, hh = lane >> 5;
#pragma unroll
        for (int w = 0; w < 2; ++w)
#pragma unroll
            for (int t = 0; t < 2; ++t)
#pragma unroll
                for (int j = 0; j < 4; ++j) {
                    const size_t o = (size_t)(rowbase + t * 32 + rr) * 1024 + colbase + w * 32 + j * 8 + hh * 4;
                    float4 xv = *(const float4*)(x + o);
                    xv.x += acc[w][t][4 * j]; xv.y += acc[w][t][4 * j + 1]; xv.z += acc[w][t][4 * j + 2]; xv.w += acc[w][t][4 * j + 3];
                    *(float4*)(out + o) = xv;
                }
    }
};
struct EpiFfn1 {
    bf16_t* act;
    DI void operator()(const f32x16 (&acc)[2][2], int rowbase, int colbase, int lane) const {
        const int rr = lane & 31, hh = lane >> 5;
        const int cb = (colbase >> 6) * 32;
#pragma unroll
        for (int t = 0; t < 2; ++t)
#pragma unroll
            for (int j = 0; j < 4; ++j) {
                float v[4];
#pragma unroll
                for (int i = 0; i < 4; ++i) { const float g = acc[0][t][4 * j + i], u = acc[1][t][4 * j + i]; v[i] = g * sigmoidf_(g) * u; }
                uint2 o; o.x = pack2(v[0], v[1]); o.y = pack2(v[2], v[3]);
                *(uint2*)(act + (size_t)(rowbase + t * 32 + rr) * DFF + cb + j * 8 + hh * 4) = o;
            }
    }
};

DI void rwkv_prep(const P& p, int idx, char* smem) {
    const int tile = idx >> 3, h = idx & 7, tt0 = tile * 32;
    const int tid = threadIdx.x, wave = tid >> 6, lane = tid & 63, rr = lane & 31, hh = lane >> 5;
    bf16_t* lat = (bf16_t*)smem;
    float* res = (float*)(smem + 32 * 296 * 2);
    __syncthreads();
    for (int c = tid; c < 32 * 36; c += NTHR) {
        const int tok = c / 36, ch = c - tok * 36, gi = tt0 + tok, col = 1536 + ch * 8;
        const uint4 cu = *(const uint4*)(p.proj + (size_t)gi * PLD + col);
        uint4 pv = make_uint4(0, 0, 0, 0);
        if ((gi & (S_ - 1)) != 0) pv = *(const uint4*)(p.proj + (size_t)(gi - 1) * PLD + col);
        float a[8], b[8]; unpack8(cu, a); unpack8(pv, b);
        const float4 m0 = *(const float4*)(p.mu + col), m1 = *(const float4*)(p.mu + col + 4);
        const float mu[8] = {m0.x, m0.y, m0.z, m0.w, m1.x, m1.y, m1.z, m1.w};
#pragma unroll
        for (int e = 0; e < 8; ++e) {
            float x = a[e] + (b[e] - a[e]) * mu[e];
            if (ch < 8) x = 1.f - 2.f / (1.f + __expf(2.f * x)); else if (ch >= 16) x = sigmoidf_(x);
            a[e] = x;
        }
        *(uint4*)&lat[tok * 296 + ch * 8] = pack8(a);
    }
    __syncthreads();
    if (wave < 2) {
        const int mt = wave;
        f32x16 aw, aa;
#pragma unroll
        for (int i = 0; i < 16; ++i) { aw[i] = 0.f; aa[i] = 0.f; }
#pragma unroll
        for (int ks = 0; ks < 4; ++ks) {
            const bf16x8 wf = *(const bf16x8*)(p.w2T + (size_t)(h * 64 + mt * 32 + rr) * 64 + ks * 16 + hh * 8);
            const bf16x8 af = *(const bf16x8*)(p.a2T + (size_t)(h * 64 + mt * 32 + rr) * 64 + ks * 16 + hh * 8);
            const bf16x8 l0 = *(const bf16x8*)&lat[rr * 296 + ks * 16 + hh * 8];
            const bf16x8 l1 = *(const bf16x8*)&lat[rr * 296 + 64 + ks * 16 + hh * 8];
            aw = MFMA32(wf, l0, aw); aa = MFMA32(af, l1, aa);
        }
#pragma unroll
        for (int j = 0; j < 4; ++j) {
            *(float4*)&res[(0 * 32 + rr) * 64 + mt * 32 + j * 8 + hh * 4] = make_float4(aw[4 * j], aw[4 * j + 1], aw[4 * j + 2], aw[4 * j + 3]);
            *(float4*)&res[(1 * 32 + rr) * 64 + mt * 32 + j * 8 + hh * 4] = make_float4(aa[4 * j], aa[4 * j + 1], aa[4 * j + 2], aa[4 * j + 3]);
        }
    } else {
        const int mt = wave - 2;
        f32x16 ag;
#pragma unroll
        for (int i = 0; i < 16; ++i) ag[i] = 0.f;
#pragma unroll
        for (int ks = 0; ks < 10; ++ks) {
            const bf16x8 gf = *(const bf16x8*)(p.g2T + (size_t)(h * 64 + mt * 32 + rr) * 160 + ks * 16 + hh * 8);
            const bf16x8 l2 = *(const bf16x8*)&lat[rr * 296 + 128 + ks * 16 + hh * 8];
            ag = MFMA32(gf, l2, ag);
        }
#pragma unroll
        for (int j = 0; j < 4; ++j)
            *(float4*)&res[(2 * 32 + rr) * 64 + mt * 32 + j * 8 + hh * 4] = make_float4(ag[4 * j], ag[4 * j + 1], ag[4 * j + 2], ag[4 * j + 3]);
    }
    __syncthreads();
    {
        const int tok = tid >> 3, cgp = tid & 7, gi = tt0 + tok, b = gi >> 14, s = gi & (S_ - 1), cb = h * 64 + cgp * 8;
        const bool first = (s == 0);
        float r[8], k[8], v[8];
        {
            float a[8], pb[8];
            const bf16_t* pr = p.proj + (size_t)gi * PLD;
#pragma unroll
            for (int q = 0; q < 3; ++q) {
                const int col = q * 512 + cb;
                unpack8(*(const uint4*)(pr + col), a);
                if (first) {
#pragma unroll
                    for (int e = 0; e < 8; ++e) pb[e] = 0.f;
                } else unpack8(*(const uint4*)(pr - PLD + col), pb);
                const float4 m0 = *(const float4*)(p.mu + col), m1 = *(const float4*)(p.mu + col + 4);
                const float mu[8] = {m0.x, m0.y, m0.z, m0.w, m1.x, m1.y, m1.z, m1.w};
#pragma unroll
                for (int e = 0; e < 8; ++e) {
                    const float x = a[e] + (pb[e] - a[e]) * mu[e];
                    if (q == 0) r[e] = x; else if (q == 1) k[e] = x; else v[e] = x;
                }
            }
        }
        float om[8], av[8], gg[8], kk[8], km[8], bb[8];
        float ss = 0.f;
#pragma unroll
        for (int e = 0; e < 8; ++e) {
            const float wp = res[(0 * 32 + tok) * 64 + cgp * 8 + e] + p.w0[cb + e];
            const float z = -wp;
            const float sp = fmaxf(z, 0.f) + __logf(1.f + __expf(-fabsf(z)));
            const float w = -sp - 0.5f;
            om[e] = 1.f - __expf(-__expf(w));
            av[e] = sigmoidf_(res[(1 * 32 + tok) * 64 + cgp * 8 + e] + p.a0[cb + e]);
            gg[e] = res[(2 * 32 + tok) * 64 + cgp * 8 + e];
            kk[e] = k[e] * p.k_k[cb + e];
            ss += kk[e] * kk[e];
            km[e] = k[e] * (1.f + (av[e] - 1.f) * p.k_a[cb + e]);
        }
        ss += __shfl_xor(ss, 1); ss += __shfl_xor(ss, 2); ss += __shfl_xor(ss, 4);
        const float inv = 1.f / fmaxf(sqrtf(ss), 1e-12f);
#pragma unroll
        for (int e = 0; e < 8; ++e) { kk[e] *= inv; bb[e] = kk[e] * av[e]; }
        bf16_t* sp = p.stream + ((size_t)((b * 8 + h) * S_ + s) * 6) * 64 + cgp * 8;
        *(uint4*)(sp) = pack8(om); *(uint4*)(sp + 64) = pack8(km); *(uint4*)(sp + 128) = pack8(kk);
        *(uint4*)(sp + 192) = pack8(bb); *(uint4*)(sp + 256) = pack8(r); *(uint4*)(sp + 320) = pack8(v);
        *(uint4*)(p.gbuf + (size_t)gi * 512 + cb) = pack8(gg);
    }
}

DI void rope_item(const P& p, int idx, char* smem) {
    const int tt0 = idx * 64, tid = threadIdx.x;
    bf16_t* vtile = (bf16_t*)smem;
    __syncthreads();
#pragma unroll 1
    for (int it = 0; it < 2; ++it) {
        const int item = tid + it * 256, tok = item >> 3, head = item & 7, gi = tt0 + tok;
        bf16_t* ptr = p.proj + (size_t)gi * PLD + QC + head * 64;
        const float4 c0 = *(const float4*)(p.cosT + (size_t)gi * 8), c1 = *(const float4*)(p.cosT + (size_t)gi * 8 + 4);
        const float4 s0 = *(const float4*)(p.sinT + (size_t)gi * 8), s1 = *(const float4*)(p.sinT + (size_t)gi * 8 + 4);
        const float cc[8] = {c0.x, c0.y, c0.z, c0.w, c1.x, c1.y, c1.z, c1.w}, sn[8] = {s0.x, s0.y, s0.z, s0.w, s1.x, s1.y, s1.z, s1.w};
        float a[8], b[8];
        unpack8(*(const uint4*)ptr, a); unpack8(*(const uint4*)(ptr + 8), b);
#pragma unroll
        for (int e = 0; e < 8; ++e) { const float x1 = a[e], x2 = b[e]; a[e] = (x1 * cc[e] - x2 * sn[e]) * QSC; b[e] = (x2 * cc[e] + x1 * sn[e]) * QSC; }
        *(uint4*)ptr = pack8(a); *(uint4*)(ptr + 8) = pack8(b);
#pragma unroll
        for (int q = 2; q < 8; ++q) {
            unpack8(*(const uint4*)(ptr + q * 8), a);
#pragma unroll
            for (int e = 0; e < 8; ++e) a[e] *= QSC;
            *(uint4*)(ptr + q * 8) = pack8(a);
        }
    }
    {
        const int tok = tid >> 2, sel = (tid >> 1) & 1, hk = tid & 1, gi = tt0 + tok;
        const float4 c0 = *(const float4*)(p.cosT + (size_t)gi * 8), c1 = *(const float4*)(p.cosT + (size_t)gi * 8 + 4);
        const float4 s0 = *(const float4*)(p.sinT + (size_t)gi * 8), s1 = *(const float4*)(p.sinT + (size_t)gi * 8 + 4);
        const float cc[8] = {c0.x, c0.y, c0.z, c0.w, c1.x, c1.y, c1.z, c1.w}, sn[8] = {s0.x, s0.y, s0.z, s0.w, s1.x, s1.y, s1.z, s1.w};
        float a[8], b[8];
        {
            bf16_t* ptr = p.proj + (size_t)gi * PLD + KVC + (sel ? 4 : 2) * 128 + hk * 64;
            unpack8(*(const uint4*)ptr, a); unpack8(*(const uint4*)(ptr + 8), b);
#pragma unroll
            for (int e = 0; e < 8; ++e) { const float x1 = a[e], x2 = b[e]; a[e] = x1 * cc[e] - x2 * sn[e]; b[e] = x2 * cc[e] + x1 * sn[e]; }
            *(uint4*)ptr = pack8(a); *(uint4*)(ptr + 8) = pack8(b);
        }
        {
            const bf16_t* ptr = p.proj + (size_t)gi * PLD + KVC + (sel ? 5 : 3) * 128 + hk * 64;
            bf16_t* vt = vtile + (size_t)((sel * 2 + hk) * 64) * 72 + tok;
            unpack8(*(const uint4*)ptr, a); unpack8(*(const uint4*)(ptr + 8), b);
#pragma unroll
            for (int e = 0; e < 8; ++e) { const float x1 = a[e], x2 = b[e]; a[e] = x1 * cc[e] - x2 * sn[e]; b[e] = x2 * cc[e] + x1 * sn[e]; }
#pragma unroll
            for (int e = 0; e < 8; ++e) { vt[e * 72] = f2bf(a[e]); vt[(8 + e) * 72] = f2bf(b[e]); }
#pragma unroll
            for (int q = 2; q < 8; ++q) {
                const uint4 u = *(const uint4*)(ptr + q * 8);
                const unsigned w[4] = {u.x, u.y, u.z, u.w};
#pragma unroll
                for (int e = 0; e < 4; ++e) { vt[(q * 8 + 2 * e) * 72] = (bf16_t)(w[e] & 0xffffu); vt[(q * 8 + 2 * e + 1) * 72] = (bf16_t)(w[e] >> 16); }
            }
        }
    }
    __syncthreads();
    const int b = tt0 >> 14, s0 = tt0 & (S_ - 1);
#pragma unroll
    for (int i = 0; i < 8; ++i) {
        const int c = tid + i * 256, grp = c >> 9, d = (c >> 3) & 63, ch = c & 7, sel = grp >> 1, hk = grp & 1;
        const uint4 u = *(const uint4*)&vtile[(size_t)(grp * 64 + d) * 72 + ch * 8];
        *(uint4*)(p.vT + ((size_t)((sel * 4 + b * 2 + hk) * 64 + d)) * S_ + s0 + ch * 8) = u;
    }
}

DI void phase2(const P& p, char* smem) {
    for (int it = blockIdx.x; it < 128 + 512 + 8192; it += gridDim.x) {
        if (it < 128) {
            const int kv = it >> 6, bhk = (it >> 4) & 3, mt = (it >> 1) & 7, nt = it & 1, b = bhk >> 1, hk = bhk & 1;
            AFCmp af{p.proj + (size_t)(b * S_) * PLD + KVC + kv * 128 + hk * 64};
            EpiHid ep{p.hid + (size_t)((kv * 4 + bhk) * 1024) * 256, p.b1p + kv * 256};
            gemm_tile(af, p.w1T + (size_t)(kv * 256 + nt * 128) * 2048, 2048, mt * 128, nt * 128, ep, smem);
        } else if (it < 640) rope_item(p, it - 128, smem);
        else rwkv_prep(p, it - 640, smem);
    }
}
DI void phase3(const P& p, char* smem) {
    for (int it = blockIdx.x; it < 64; it += gridDim.x) {
        const int kv = it >> 5, bhk = (it >> 3) & 3, mt = it & 7, b = bhk >> 1;
        AFPlain af{p.hid + (size_t)((kv * 4 + bhk) * 1024) * 256, 256};
        if (kv == 0) { EpiKc ep{p.kc + (size_t)bhk * 1024 * 64, p.cosT, p.sinT, b * S_}; gemm_tile(af, p.wc2T, 256, mt * 128, 0, ep, smem); }
        else { EpiVc ep{p.vcT + (size_t)bhk * 64 * 1024, smem}; gemm_tile(af, p.wc2T + 128 * 256, 256, mt * 128, 0, ep, smem); }
    }
}

template <int CTRL> DI float dpp_add(float x) { return x + __int_as_float(__builtin_amdgcn_mov_dpp(__float_as_int(x), CTRL, 0xF, 0xF, true)); }
DI float red16(float x) { x = dpp_add<0xB1>(x); x = dpp_add<0x4E>(x); x = dpp_add<0x141>(x); x = dpp_add<0x140>(x); return x; }

DI void cvt_store(const uint4 u, const bool isom, float* d) {
    float f0 = bflo(u.x), f1 = bfhi(u.x), f2 = bflo(u.y), f3 = bfhi(u.y), f4 = bflo(u.z), f5 = bfhi(u.z), f6 = bflo(u.w), f7 = bfhi(u.w);
    if (isom) { f0 = 1.f - f0; f1 = 1.f - f1; f2 = 1.f - f2; f3 = 1.f - f3; f4 = 1.f - f4; f5 = 1.f - f5; f6 = 1.f - f6; f7 = 1.f - f7; }
    *(float4*)d = make_float4(f0, f1, f2, f3); *(float4*)(d + 4) = make_float4(f4, f5, f6, f7);
}
DI void scan_unit(const P& p, int su, char* smem) {
    const int xcd = su & 7, kq = su >> 3, bh = xcd * 2 + (kq >> 3), oct = kq & 7, b = bh >> 3, h = bh & 7;
    const int tid = threadIdx.x, wave = tid >> 6, lane = tid & 63;
    float* buf = (float*)smem;
    float* ypb = (float*)(smem + 49152);
    const bf16_t* sbase = p.stream + (size_t)bh * S_ * 384;
    __syncthreads();
#pragma unroll
    for (int i = 0; i < 3; ++i) { const int ci = tid + i * 256; cvt_store(*(const uint4*)(sbase + (size_t)ci * 8), (ci % 48) < 8, buf + ci * 8); }
    __syncthreads();
    if (wave < 2) {
        const int rl = lane >> 4, ks = lane & 15, row = oct * 8 + wave * 4 + rl;
        f2_t sA = {0.f, 0.f}, sB = {0.f, 0.f};
        __builtin_amdgcn_s_setprio(3);
        for (int c = 0; c < 1024; ++c) {
            const float* cb = buf + (c & 1) * 6144 + ks * 4;
            const float* vb = buf + (c & 1) * 6144 + 320 + row;
            float* yo = ypb + ((c & 1) * 2 + wave) * 1024 + lane;
            float4 dec = *(const float4*)(cb), km = *(const float4*)(cb + 64), kk = *(const float4*)(cb + 128), bb = *(const float4*)(cb + 192), rv = *(const float4*)(cb + 256);
            float v = vb[0];
#pragma unroll
            for (int st = 0; st < 16; ++st) {
                float4 ndec = dec, nkm = km, nkk = kk, nbb = bb, nrv = rv; float nv = v;
                if (st < 15) {
                    const float* rec = cb + (st + 1) * 384;
                    ndec = *(const float4*)(rec); nkm = *(const float4*)(rec + 64); nkk = *(const float4*)(rec + 128); nbb = *(const float4*)(rec + 192); nrv = *(const float4*)(rec + 256);
                    nv = vb[(st + 1) * 384];
                }
                const f2_t vv = {v, v};
                const f2_t d01 = {dec.x, dec.y}, d23 = {dec.z, dec.w}, m01 = {km.x, km.y}, m23 = {km.z, km.w};
                const f2_t k01 = {kk.x, kk.y}, k23 = {kk.z, kk.w}, b01 = {bb.x, bb.y}, b23 = {bb.z, bb.w}, r01 = {rv.x, rv.y}, r23 = {rv.z, rv.w};
                const f2_t tA = sA * d01 + vv * m01, tB = sB * d23 + vv * m23;
                f2_t pa = sA * k01; pa = sB * k23 + pa;
                const float sa = red16(pa.x + pa.y);
                const f2_t sav = {sa, sa};
                sA = tA - sav * b01; sB = tB - sav * b23;
                f2_t ya = sA * r01; ya = sB * r23 + ya;
                yo[st * 64] = ya.x + ya.y;
                dec = ndec; km = nkm; kk = nkk; bb = nbb; rv = nrv; v = nv;
            }
            __syncthreads();
        }
        __builtin_amdgcn_s_setprio(0);
    } else {
        const int ht = tid - 128;
        const int ystep = ht >> 3, r8 = ht & 7;
        float* yout = p.yraw + (size_t)(b * S_) * 512 + h * 64 + oct * 8 + r8;
        const float* ysrc = ypb + (r8 >> 2) * 1024 + ystep * 64 + (r8 & 3) * 16;
        uint4 ra0, ra1, ra2, ra3, ra4, ra5, rb0, rb1, rb2, rb3, rb4, rb5;
#define SLOAD(R, CH) { const bf16_t* sp_ = sbase + (size_t)(CH) * 6144 + (size_t)ht * 8; \
        R##0 = *(const uint4*)(sp_); R##1 = *(const uint4*)(sp_ + 1024); R##2 = *(const uint4*)(sp_ + 2048); R##3 = *(const uint4*)(sp_ + 3072); R##4 = *(const uint4*)(sp_ + 4096); R##5 = *(const uint4*)(sp_ + 5120); }
#define SSTORE(R, BI) { float* d_ = buf + (BI) * 6144 + ht * 8; const bool om_ = (ht % 48) < 8; \
        cvt_store(R##0, om_, d_); cvt_store(R##1, ((ht + 128) % 48) < 8, d_ + 1024); cvt_store(R##2, ((ht + 256) % 48) < 8, d_ + 2048); \
        cvt_store(R##3, ((ht + 384) % 48) < 8, d_ + 3072); cvt_store(R##4, ((ht + 512) % 48) < 8, d_ + 4096); cvt_store(R##5, ((ht + 640) % 48) < 8, d_ + 5120); }
#define YRED(C) { const float* ys_ = ysrc + ((C) & 1) * 2048; const float4 a_ = *(const float4*)ys_, b_ = *(const float4*)(ys_ + 4), c_ = *(const float4*)(ys_ + 8), d_ = *(const float4*)(ys_ + 12); \
        yout[(size_t)((C) * 16 + ystep) * 512] = ((a_.x + a_.y) + (a_.z + a_.w)) + ((b_.x + b_.y) + (b_.z + b_.w)) + ((c_.x + c_.y) + (c_.z + c_.w)) + ((d_.x + d_.y) + (d_.z + d_.w)); }
        SLOAD(ra, 1)
        for (int c = 0; c < 1024; c += 2) {
            if (c + 2 < 1024) SLOAD(rb, c + 2)
            SSTORE(ra, 1)
            if (c >= 1) YRED(c - 1)
            __syncthreads();
            if (c + 3 < 1024) SLOAD(ra, c + 3)
            if (c + 2 < 1024) SSTORE(rb, 0)
            YRED(c)
            __syncthreads();
        }
        YRED(1023)
#undef SLOAD
#undef SSTORE
#undef YRED
    }
}

struct AttnSmem {
    bf16_t k[64 * 72];
    bf16_t vt[64 * 68];
    float imp[32 * 256];
    unsigned selbits[32 * 8];
    unsigned wunion[4 * 8];
    unsigned bunion[8];
    int unit;
};

DI void attn_load(const bf16_t* kbase, int kstride, const bf16_t* vtbase, int vtstride, uint4 (&r)[4], int tid, bool needv) {
#pragma unroll
    for (int i = 0; i < 2; ++i) { const int c = tid + i * 256; r[i] = *(const uint4*)(kbase + (size_t)(c >> 3) * kstride + (c & 7) * 8); }
    if (needv) {
#pragma unroll
        for (int i = 0; i < 2; ++i) { const int c = tid + i * 256; r[2 + i] = *(const uint4*)(vtbase + (size_t)(c >> 3) * vtstride + (c & 7) * 8); }
    }
}
DI void attn_store(AttnSmem& sm, const uint4 (&r)[4], int tid, bool needv) {
#pragma unroll
    for (int i = 0; i < 2; ++i) { const int c = tid + i * 256; *(uint4*)&sm.k[(c >> 3) * 72 + (c & 7) * 8] = r[i]; }
    if (needv) {
#pragma unroll
        for (int i = 0; i < 2; ++i) {
            const int c = tid + i * 256; bf16_t* d = &sm.vt[(c >> 3) * 68 + (c & 7) * 8];
            *(uint2*)d = make_uint2(r[2 + i].x, r[2 + i].y); *(uint2*)(d + 4) = make_uint2(r[2 + i].z, r[2 + i].w);
        }
    }
}

template <int MODE, bool EM>
DI void attn_tile(AttnSmem& sm, const bf16x8 (&qf)[4], f32x16 (&o)[2], float& m, float& l, const float inv_l, const int lo, const int hi, const bool lane_on,
                  const int lane, const int tokl, const int jbase) {
    const int rr = lane & 31, hh = lane >> 5;
    f32x16 s[2];
#pragma unroll
    for (int mt = 0; mt < 2; ++mt) {
#pragma unroll
        for (int i = 0; i < 16; ++i) s[mt][i] = 0.f;
#pragma unroll
        for (int ks = 0; ks < 4; ++ks) {
            const bf16x8 kf = *(const bf16x8*)&sm.k[(mt * 32 + rr) * 72 + ks * 16 + hh * 8];
            s[mt] = MFMA32(kf, qf[ks], s[mt]);
        }
        asm volatile("" ::: "memory");
    }
    float mx = -1e30f;
    if (EM) {
        const int lo2 = lo - 4 * hh, hi2 = hi - 4 * hh;
#pragma unroll
        for (int mt = 0; mt < 2; ++mt)
#pragma unroll
            for (int i = 0; i < 16; ++i) {
                const int kc_ = mt * 32 + (i & 3) + 8 * (i >> 2);
                float v = s[mt][i];
                v = (kc_ >= lo2 && kc_ <= hi2) ? v : -1e30f;
                s[mt][i] = v; mx = fmaxf(mx, v);
            }
    } else {
#pragma unroll
        for (int mt = 0; mt < 2; ++mt)
#pragma unroll
            for (int i = 0; i < 16; ++i) mx = fmaxf(mx, s[mt][i]);
        mx = lane_on ? mx : -1e30f;
    }
    float mref = m;
    if (MODE != 2) {
        mx = fmaxf(mx, __shfl_xor(mx, 32));
        const float mnew = fmaxf(m, mx);
        const float alpha = __builtin_amdgcn_exp2f(m - mnew);
        m = mnew; mref = mnew;
        l *= alpha;
        if (MODE == 1) {
#pragma unroll
            for (int dt = 0; dt < 2; ++dt)
#pragma unroll
                for (int i = 0; i < 16; ++i) o[dt][i] *= alpha;
        }
    }
    if (!EM) mref = lane_on ? mref : 1e30f;
    float psum = 0.f;
#pragma unroll
    for (int mt = 0; mt < 2; ++mt)
#pragma unroll
        for (int i = 0; i < 16; ++i) {
            const float v = s[mt][i];
            float pv;
            if (EM) pv = (v > -1e29f) ? __builtin_amdgcn_exp2f(v - mref) : 0.f;
            else pv = __builtin_amdgcn_exp2f(v - mref);
            if (MODE == 2) pv *= inv_l;
            s[mt][i] = pv; psum += pv;
        }
    if (MODE != 2) l += psum;
    if (MODE == 0) return;
    if (MODE == 2) {
#pragma unroll
        for (int mt = 0; mt < 2; ++mt)
#pragma unroll
            for (int jj = 0; jj < 4; ++jj) {
                float q4 = (s[mt][4 * jj] + s[mt][4 * jj + 1]) + (s[mt][4 * jj + 2] + s[mt][4 * jj + 3]);
                float e3 = s[mt][4 * jj + 3];
                q4 += __shfl_xor(q4, 1); q4 += __shfl_xor(q4, 2);
                e3 += __shfl_xor(e3, 1); e3 += __shfl_xor(e3, 2);
                if ((rr & 3) == 0) {
                    const int j = jbase + mt * 8 + 2 * jj + hh;
                    atomicAdd(&sm.imp[tokl * 256 + j], q4);
                    if (j + 1 < 256) atomicAdd(&sm.imp[tokl * 256 + j + 1], e3);
                }
            }
    }
#pragma unroll
    for (int mt = 0; mt < 2; ++mt)
#pragma unroll
        for (int s2 = 0; s2 < 2; ++s2) {
            uint4 pu;
            pu.x = pack2(s[mt][8 * s2 + 0], s[mt][8 * s2 + 1]); pu.y = pack2(s[mt][8 * s2 + 2], s[mt][8 * s2 + 3]);
            pu.z = pack2(s[mt][8 * s2 + 4], s[mt][8 * s2 + 5]); pu.w = pack2(s[mt][8 * s2 + 6], s[mt][8 * s2 + 7]);
            const bf16x8 pf = __builtin_bit_cast(bf16x8, pu);
            asm volatile("" ::: "memory");
#pragma unroll
            for (int dt = 0; dt < 2; ++dt) {
                const bf16_t* vp = &sm.vt[(dt * 32 + rr) * 68 + mt * 32 + s2 * 16 + hh * 4];
                const uint2 v0 = *(const uint2*)vp, v1 = *(const uint2*)(vp + 8);
                const bf16x8 vf = __builtin_bit_cast(bf16x8, make_uint4(v0.x, v0.y, v1.x, v1.y));
                o[dt] = MFMA32(vf, pf, o[dt]);
            }
        }
}

DI unsigned wave_umax(unsigned v) {
#pragma unroll
    for (int o = 32; o; o >>= 1) { const unsigned t = (unsigned)__shfl_xor((int)v, o); v = v > t ? v : t; }
    return v;
}

DI void attn_unit(const P& p, int u, char* smem) {
    AttnSmem& sm = *(AttnSmem*)smem;
    const int tid = threadIdx.x, wave = tid >> 6, lane = tid & 63, rr = lane & 31, hh = lane >> 5;
    const int tile = 511 - (u >> 2), bhk = u & 3, b = bhk >> 1, hk = bhk & 1, t0 = tile * 32;
    const int tokl = wave * 8 + (rr >> 2), t = t0 + tokl, g = rr & 3, head = hk * 4 + g;
    const size_t tokg = (size_t)b * S_ + t;
    bf16x8 qf[4];
#pragma unroll
    for (int ks = 0; ks < 4; ++ks) qf[ks] = *(const bf16x8*)(p.proj + tokg * PLD + QC + head * 64 + ks * 16 + hh * 8);
    float gate[3];
#pragma unroll
    for (int i = 0; i < 3; ++i) gate[i] = sigmoidf_(__uint_as_float((unsigned)p.proj[tokg * PLD + GC + head * 3 + i] << 16));
#pragma unroll
    for (int i = 0; i < 8; ++i) *(float4*)&sm.imp[(tid + i * 256) * 4] = make_float4(0.f, 0.f, 0.f, 0.f);
    sm.selbits[tid] = 0u;
    f32x16 o[2];
#pragma unroll
    for (int dt = 0; dt < 2; ++dt)
#pragma unroll
        for (int i = 0; i < 16; ++i) o[dt][i] = 0.f;
    float* park = &sm.imp[wave * 2048 + lane];
    uint4 rg[4];
    const int ntc = (t0 >> 10) + 1;
    const int vmaxi = (t >= 31) ? ((t - 31) >> 4) : -1;
    const int twmin = t0 + wave * 8;
    const int wvmin = (twmin >= 31) ? ((twmin - 31) >> 4) : -1;
    const bf16_t* kcb = p.kc + (size_t)bhk * 1024 * 64;
    const bf16_t* vcb = p.vcT + (size_t)bhk * 64 * 1024;
    float m = -1e30f, l = 0.f;
    attn_load(kcb, 64, vcb, 1024, rg, tid, false);
    for (int j = 0; j < ntc; ++j) {
        __syncthreads();
        attn_store(sm, rg, tid, false);
        __syncthreads();
        if (j + 1 < ntc) attn_load(kcb + (size_t)(j + 1) * 64 * 64, 64, vcb, 1024, rg, tid, false);
        if (j * 64 + 63 <= wvmin) attn_tile<0, false>(sm, qf, o, m, l, 0.f, 0, 0, true, lane, tokl, 0);
        else attn_tile<0, true>(sm, qf, o, m, l, 0.f, 0, vmaxi - j * 64, true, lane, tokl, 0);
    }
    {
        const float lt = l + __shfl_xor(l, 32);
        const float inv_l = lt > 0.f ? 1.f / lt : 0.f;
        attn_load(kcb, 64, vcb, 1024, rg, tid, true);
        for (int j = 0; j < ntc; ++j) {
            __syncthreads();
            attn_store(sm, rg, tid, true);
            __syncthreads();
            if (j + 1 < ntc) attn_load(kcb + (size_t)(j + 1) * 64 * 64, 64, vcb + (j + 1) * 64, 1024, rg, tid, true);
            if (j * 64 + 63 <= wvmin) attn_tile<2, false>(sm, qf, o, m, l, inv_l, 0, 0, true, lane, tokl, j * 16);
            else attn_tile<2, true>(sm, qf, o, m, l, inv_l, 0, vmaxi - j * 64, true, lane, tokl, j * 16);
        }
    }
    __syncthreads();
    const int cur = t0 >> 6;
    for (int tk = 0; tk < 8; ++tk) {
        const int tl = wave * 8 + tk;
        const float* ip = &sm.imp[tl * 256];
        unsigned nib = 0u;
        if (cur <= 15) {
#pragma unroll
            for (int e = 0; e < 4; ++e) if (lane * 4 + e <= cur) nib |= 1u << e;
        } else {
            unsigned k0, k1, k2, k3;
            {
                const float4 iv = *(const float4*)(ip + lane * 4);
                const int j0 = lane * 4;
                k0 = (j0 >= 1 && j0 <= cur - 2) ? ((__float_as_uint(iv.x) & 0xFFFFFF00u) | (unsigned)(255 - j0)) : 0u;
                k1 = (j0 + 1 <= cur - 2) ? ((__float_as_uint(iv.y) & 0xFFFFFF00u) | (unsigned)(254 - j0)) : 0u;
                k2 = (j0 + 2 <= cur - 2) ? ((__float_as_uint(iv.z) & 0xFFFFFF00u) | (unsigned)(253 - j0)) : 0u;
                k3 = (j0 + 3 <= cur - 2) ? ((__float_as_uint(iv.w) & 0xFFFFFF00u) | (unsigned)(252 - j0)) : 0u;
#pragma unroll
                for (int e = 0; e < 4; ++e) { const int j = j0 + e; if (j == 0 || j == cur || j == cur - 1) nib |= 1u << e; }
            }
            for (int r = 0; r < 13; ++r) {
                unsigned lm = k0 > k1 ? k0 : k1; const unsigned lm2 = k2 > k3 ? k2 : k3; lm = lm > lm2 ? lm : lm2;
                const unsigned wm = wave_umax(lm);
                if (k0 == wm) { k0 = 0u; nib |= 1u; }
                if (k1 == wm) { k1 = 0u; nib |= 2u; }
                if (k2 == wm) { k2 = 0u; nib |= 4u; }
                if (k3 == wm) { k3 = 0u; nib |= 8u; }
            }
        }
        atomicOr(&sm.selbits[tl * 8 + (lane >> 3)], nib << ((lane & 7) * 4));
    }
    __syncthreads();
    if (tid < 32) {
        const int w = tid >> 3, d = tid & 7; unsigned uu = 0u;
#pragma unroll
        for (int k = 0; k < 8; ++k) uu |= sm.selbits[(w * 8 + k) * 8 + d];
        sm.wunion[w * 8 + d] = uu;
    }
    __syncthreads();
    if (tid < 8) sm.bunion[tid] = sm.wunion[tid] | sm.wunion[8 + tid] | sm.wunion[16 + tid] | sm.wunion[24 + tid];
    __syncthreads();
#pragma unroll
    for (int dt = 0; dt < 2; ++dt)
#pragma unroll
        for (int i = 0; i < 16; ++i) { park[(dt * 16 + i) * 64] = gate[0] * o[dt][i]; o[dt][i] = 0.f; }
    {
        const bf16_t* kb = p.proj + (size_t)(b * S_) * PLD + KVC + 2 * 128 + hk * 64;
        const bf16_t* vb = p.vT + (size_t)((0 * 4 + bhk) * 64) * S_;
        m = -1e30f; l = 0.f;
        auto nextj = [&](int j) -> int {
            ++j;
            while (j <= cur) {
                const unsigned w = sm.bunion[j >> 5] >> (j & 31);
                if (w) { j += __ffs((int)w) - 1; return j <= cur ? j : -1; }
                j = (j | 31) + 1;
            }
            return -1;
        };
        int j = nextj(-1);
        if (j >= 0) attn_load(kb + (size_t)j * 64 * PLD, PLD, vb + j * 64, S_, rg, tid, true);
        while (j >= 0) {
            __syncthreads();
            attn_store(sm, rg, tid, true);
            __syncthreads();
            const int jn = nextj(j);
            if (jn >= 0) attn_load(kb + (size_t)jn * 64 * PLD, PLD, vb + jn * 64, S_, rg, tid, true);
            if ((sm.wunion[wave * 8 + (j >> 5)] >> (j & 31)) & 1u) {
                const bool selme = (sm.selbits[tokl * 8 + (j >> 5)] >> (j & 31)) & 1u;
                if (j < cur) attn_tile<1, false>(sm, qf, o, m, l, 0.f, 0, 0, selme, lane, tokl, 0);
                else attn_tile<1, true>(sm, qf, o, m, l, 0.f, 0, selme ? t - j * 64 : -1, true, lane, tokl, 0);
            }
            j = jn;
        }
        const float lt = l + __shfl_xor(l, 32);
        const float sc = lt > 0.f ? gate[1] / lt : 0.f;
#pragma unroll
        for (int dt = 0; dt < 2; ++dt)
#pragma unroll
            for (int i = 0; i < 16; ++i) { park[(dt * 16 + i) * 64] += sc * o[dt][i]; o[dt][i] = 0.f; }
    }
    {
        const bf16_t* kb = p.proj + (size_t)(b * S_) * PLD + KVC + 4 * 128 + hk * 64;
        const bf16_t* vb = p.vT + (size_t)((1 * 4 + bhk) * 64) * S_;
        m = -1e30f; l = 0.f;
        const int jlo = (t0 >= 511) ? ((t0 - 511) >> 6) : 0, jhi = t0 >> 6;
        attn_load(kb + (size_t)jlo * 64 * PLD, PLD, vb + jlo * 64, S_, rg, tid, true);
        for (int j = jlo; j <= jhi; ++j) {
            __syncthreads();
            attn_store(sm, rg, tid, true);
            __syncthreads();
            if (j + 1 <= jhi) attn_load(kb + (size_t)(j + 1) * 64 * PLD, PLD, vb + (j + 1) * 64, S_, rg, tid, true);
            if (j * 64 >= twmin + 7 - 511 && j * 64 + 63 <= twmin) attn_tile<1, false>(sm, qf, o, m, l, 0.f, 0, 0, true, lane, tokl, 0);
            else attn_tile<1, true>(sm, qf, o, m, l, 0.f, t - 511 - j * 64, t - j * 64, true, lane, tokl, 0);
        }
        const float lt = l + __shfl_xor(l, 32);
        const float sc = lt > 0.f ? gate[2] / lt : 0.f;
#pragma unroll
        for (int dt = 0; dt < 2; ++dt)
#pragma unroll
            for (int i = 0; i < 16; ++i) o[dt][i] = park[(dt * 16 + i) * 64] + sc * o[dt][i];
    }
    bf16_t* mp = p.A + tokg * 1024 + 512 + head * 64;
#pragma unroll
    for (int dt = 0; dt < 2; ++dt)
#pragma unroll
        for (int jj = 0; jj < 4; ++jj) {
            uint2 ov; ov.x = pack2(o[dt][4 * jj], o[dt][4 * jj + 1]); ov.y = pack2(o[dt][4 * jj + 2], o[dt][4 * jj + 3]);
            *(uint2*)(mp + dt * 32 + jj * 8 + hh * 4) = ov;
        }
}

DI void phase4(const P& p, char* smem) {
    for (int su = blockIdx.x; su < 128; su += gridDim.x) scan_unit(p, su, smem);
    AttnSmem& sm = *(AttnSmem*)smem;
    while (true) {
        __syncthreads();
        if (threadIdx.x == 0) sm.unit = (int)atomicAdd(p.counter, 1u);
        __syncthreads();
        const int u = sm.unit;
        if (u >= 2048) break;
        attn_unit(p, u, smem);
    }
}

DI void phase4b(const P& p) {
    const int tid = threadIdx.x;
    for (int it = blockIdx.x; it < T_ / 4; it += gridDim.x) {
        const int gi = it * 4 + (tid >> 6), cgp = tid & 63, h = cgp >> 3, c8 = (cgp & 7) * 8, col = cgp * 8, b = gi >> 14, s = gi & (S_ - 1);
        const float4 y0 = *(const float4*)(p.yraw + (size_t)gi * 512 + col), y1 = *(const float4*)(p.yraw + (size_t)gi * 512 + col + 4);
        float y[8] = {y0.x, y0.y, y0.z, y0.w, y1.x, y1.y, y1.z, y1.w};
        const bf16_t* sp = p.stream + ((size_t)((b * 8 + h) * S_ + s) * 6) * 64 + c8;
        float km[8], r[8], v[8], gg[8];
        unpack8(*(const uint4*)(sp + 64), km); unpack8(*(const uint4*)(sp + 256), r); unpack8(*(const uint4*)(sp + 320), v);
        unpack8(*(const uint4*)(p.gbuf + (size_t)gi * 512 + col), gg);
        float sum = 0.f, bon = 0.f;
#pragma unroll
        for (int e = 0; e < 8; ++e) { sum += y[e]; bon += r[e] * km[e] * p.r_k[col + e]; }
        sum += __shfl_xor(sum, 1); sum += __shfl_xor(sum, 2); sum += __shfl_xor(sum, 4);
        bon += __shfl_xor(bon, 1); bon += __shfl_xor(bon, 2); bon += __shfl_xor(bon, 4);
        const float mean = sum * (1.f / 64.f);
        float var = 0.f;
#pragma unroll
        for (int e = 0; e < 8; ++e) { y[e] -= mean; var += y[e] * y[e]; }
        var += __shfl_xor(var, 1); var += __shfl_xor(var, 2); var += __shfl_xor(var, 4);
        const float rs = rsqrtf(var * (1.f / 64.f) + 64e-5f);
        float o[8];
#pragma unroll
        for (int e = 0; e < 8; ++e) o[e] = (y[e] * rs * p.lnx_w[col + e] + p.lnx_b[col + e] + bon * v[e]) * gg[e];
        *(uint4*)(p.A + (size_t)gi * 1024 + col) = pack8(o);
    }
}

struct EpiFfn2 {
    float* out;
    DI void operator()(const f32x16 (&acc)[2][2], int rowbase, int colbase, int lane) const {
        const int rr = lane & 31, hh = lane >> 5;
#pragma unroll
        for (int w = 0; w < 2; ++w)
#pragma unroll
            for (int t = 0; t < 2; ++t)
#pragma unroll
                for (int j = 0; j < 4; ++j) {
                    float4* o = (float4*)(out + (size_t)(rowbase + t * 32 + rr) * 1024 + colbase + w * 32 + j * 8 + hh * 4);
                    float4 xv = *o;
                    xv.x += acc[w][t][4 * j]; xv.y += acc[w][t][4 * j + 1]; xv.z += acc[w][t][4 * j + 2]; xv.w += acc[w][t][4 * j + 3];
                    *o = xv;
                }
    }
};

DI void final_item(float* io, const float* g, int idx) {
    const int row = idx * 4 + (threadIdx.x >> 6), lane = threadIdx.x & 63;
    float4* sp = (float4*)(io + (size_t)row * 1024);
    float4 v[4]; float ss = 0.f;
#pragma unroll
    for (int i = 0; i < 4; ++i) { v[i] = sp[lane + 64 * i]; ss += v[i].x * v[i].x + v[i].y * v[i].y + v[i].z * v[i].z + v[i].w * v[i].w; }
    ss = wave_sum(ss);
    const float rs = rsqrtf(ss * (1.f / 1024.f) + 1e-6f);
#pragma unroll
    for (int i = 0; i < 4; ++i) {
        const float4 gv = ((const float4*)g)[lane + 64 * i];
        sp[lane + 64 * i] = make_float4(v[i].x * rs * gv.x, v[i].y * rs * gv.y, v[i].z * rs * gv.z, v[i].w * rs * gv.w);
    }
}

DI void run_phase(const P& p, int ph, char* smem) {
    switch (ph) {
    case 0: phase0(p, smem); break;
    case 1:
        for (int it = blockIdx.x; it < 256 * 25; it += gridDim.x) {
            const int mt = it / 25, nt = it - mt * 25;
            gemm_tile(AFPlain{p.A, 1024}, p.WinT + (size_t)nt * 128 * 1024, 1024, mt * 128, nt * 128, EpiProj{p.proj}, smem);
        }
        break;
    case 2: phase2(p, smem); break;
    case 3: phase3(p, smem); break;
    case 4: phase4(p, smem); break;
    case 5: phase4b(p); break;
    case 6:
        for (int it = blockIdx.x; it < 256 * 8; it += gridDim.x) {
            const int mt = it >> 3, nt = it & 7;
            gemm_tile(AFPlain{p.A, 1024}, p.WoutT + (size_t)nt * 128 * 1024, 1024, mt * 128, nt * 128, EpiOut{p.out, p.x}, smem);
        }
        break;
    case 7:
        for (int it = blockIdx.x; it < T_ / 4; it += gridDim.x) rms_item(p.out, p.norm_ffn, p.A, it);
        break;
    case 8:
        for (int it = blockIdx.x; it < 256 * 44; it += gridDim.x) {
            const int mt = it / 44, nt = it - mt * 44;
            gemm_tile(AFPlain{p.A, 1024}, p.WguT + (size_t)nt * 128 * 1024, 1024, mt * 128, nt * 128, EpiFfn1{p.stream}, smem);
        }
        break;
    case 9:
        for (int it = blockIdx.x; it < 256 * 8; it += gridDim.x) {
            const int mt = it >> 3, nt = it & 7;
            gemm_tile(AFPlain{p.stream, DFF}, p.WdnT + (size_t)nt * 128 * DFF, DFF, mt * 128, nt * 128, EpiFfn2{p.out}, smem);
        }
        break;
    default:
        for (int it = blockIdx.x; it < T_ / 4; it += gridDim.x) final_item(p.out, p.norm_final, it);
        break;
    }
}
constexpr int NPHASE = 11;
constexpr int SMEM_BYTES = 65536;


#define XB_TMO      128
#define XB_XCNT(j)  (256  + 64 * (j))
#define XB_XSUB(j)  (1280 + 64 * (j))
#define XB_XGEN(j)  (2304 + 64 * (j))
#define XB_TOP      3328
#define XB_TOPGEN   3392
#define XCD_BAR_WORDS 3456
#define XB_SPIN_CAP (1u << 18)
#define LAS __attribute__((address_space(3)))
DI unsigned xb_ld(unsigned* p) { return __hip_atomic_load(p, __ATOMIC_RELAXED, __HIP_MEMORY_SCOPE_AGENT); }
DI unsigned xb_add(unsigned* p, unsigned v) { return __hip_atomic_fetch_add(p, v, __ATOMIC_RELAXED, __HIP_MEMORY_SCOPE_AGENT); }
DI unsigned xb_xcc_id() { return (unsigned)__builtin_amdgcn_s_getreg((3 << 11) | 20) & 0xFu; }
#define XB_SPIN(cond, bar) do { unsigned _sp = 0; while (cond) { __builtin_amdgcn_s_sleep(1); \
    if ((++_sp & 255u) == 0u) { if (xb_ld(&(bar)[XB_TMO])) break; if (_sp > XB_SPIN_CAP) { atomicAdd(&(bar)[XB_TMO], 1u); break; } } } } while (0)
struct XcdBarrier { unsigned* bar; unsigned x; volatile LAS unsigned* st; };
DI XcdBarrier xcd_barrier_post(unsigned* bar, volatile LAS unsigned* st) {
    XcdBarrier b; b.bar = bar; b.x = xb_xcc_id(); b.st = st;
    if (threadIdx.x == 0) (void)xb_add(&bar[XB_XCNT(b.x)], 1u);
    return b;
}
DI void xcd_barrier_complete(unsigned* bar, unsigned x, unsigned& nloc, unsigned& nx) {
    const unsigned G = gridDim.x * gridDim.y * gridDim.z;
    unsigned sum, cnt, mine, sp = 0u;
    for (;;) {
        sum = 0u; cnt = 0u; mine = 0u;
#pragma unroll
        for (unsigned j = 0; j < 16; ++j) { const unsigned c = xb_ld(&bar[XB_XCNT(j)]); sum += c; cnt += (c > 0u) ? 1u : 0u; mine = (j == x) ? c : mine; }
        if (sum == G) break;
        __builtin_amdgcn_s_sleep(1);
        if ((++sp & 255u) == 0u) { if (xb_ld(&bar[XB_TMO])) break; if (sp > XB_SPIN_CAP) { atomicAdd(&bar[XB_TMO], 1u); break; } }
    }
    nloc = mine > 0u ? mine : 1u; nx = cnt > 0u ? cnt : 1u;
}
DI void xcd_barrier(const XcdBarrier& b) {
    asm volatile("s_waitcnt vmcnt(0)" ::: "memory");
    __syncthreads();
    if (threadIdx.x == 0) {
        unsigned* bar = b.bar;
        __builtin_amdgcn_s_waitcnt(0);
        unsigned nloc = b.st[0], nx = b.st[1];
        if (nloc == 0u) { xcd_barrier_complete(bar, b.x, nloc, nx); b.st[0] = nloc; b.st[1] = nx; }
        const unsigned old = xb_add(&bar[XB_XSUB(b.x)], 1u);
        const unsigned gen = old / nloc;
        if (old + 1u == (gen + 1u) * nloc) {
            __builtin_amdgcn_fence(__ATOMIC_RELEASE, "agent");
            asm volatile("s_waitcnt vmcnt(0)" ::: "memory");
            const unsigned og = xb_add(&bar[XB_TOP], 1u);
            const unsigned tg = og / nx;
            if (og + 1u == (tg + 1u) * nx) xb_add(&bar[XB_TOPGEN], 1u);
            else XB_SPIN(xb_ld(&bar[XB_TOPGEN]) == tg, bar);
            __builtin_amdgcn_fence(__ATOMIC_ACQUIRE, "agent");
            xb_add(&bar[XB_XGEN(b.x)], 1u);
            asm volatile("s_waitcnt vmcnt(0)" ::: "memory");
        } else {
            XB_SPIN(xb_ld(&bar[XB_XGEN(b.x)]) == gen, bar);
            __builtin_amdgcn_fence(__ATOMIC_ACQUIRE, "agent");
            asm volatile("s_waitcnt vmcnt(0)" ::: "memory");
        }
    }
    __syncthreads();
}

__global__ void __launch_bounds__(NTHR, 2) mega_kernel(P p) {
    __shared__ __attribute__((aligned(16))) char smem[SMEM_BYTES];
    __shared__ uint4 xb_words;
    cg::grid_group grid = cg::this_grid();
    if (p.x == nullptr) grid.sync();
    if (threadIdx.x == 0) xb_words = make_uint4(0u, 0u, 0u, 0u);
    __syncthreads();
    const XcdBarrier xb = xcd_barrier_post(p.bar, (volatile LAS unsigned*)&xb_words);
    run_phase(p, 0, smem); xcd_barrier(xb);
    run_phase(p, 1, smem); xcd_barrier(xb);
    run_phase(p, 2, smem); xcd_barrier(xb);
    run_phase(p, 3, smem); xcd_barrier(xb);
    run_phase(p, 4, smem); xcd_barrier(xb);
    run_phase(p, 5, smem); xcd_barrier(xb);
    run_phase(p, 6, smem); xcd_barrier(xb);
    run_phase(p, 7, smem); xcd_barrier(xb);
    run_phase(p, 8, smem); xcd_barrier(xb);
    run_phase(p, 9, smem); xcd_barrier(xb);
    run_phase(p, 10, smem);
}
__global__ void __launch_bounds__(NTHR, 2) phase_kernel(P p, int ph) {
    __shared__ __attribute__((aligned(16))) char smem[SMEM_BYTES];
    run_phase(p, ph, smem);
}

extern "C" void kernel_launch(void* const* d_in, const int* in_sizes, int n_in, void* d_out, int out_size, void* d_ws, size_t ws_size,
                              hipStream_t stream) {
    P p{};
    p.x = (const float*)d_in[0]; p.pos = (const int*)d_in[1]; p.norm_mix = (const float*)d_in[2]; p.w_in = (const float*)d_in[3];
    p.mu = (const float*)d_in[4]; p.w0 = (const float*)d_in[5]; p.w2 = (const float*)d_in[6]; p.a0 = (const float*)d_in[7];
    p.a2 = (const float*)d_in[8]; p.g2 = (const float*)d_in[9]; p.k_k = (const float*)d_in[10]; p.k_a = (const float*)d_in[11];
    p.r_k = (const float*)d_in[12]; p.lnx_w = (const float*)d_in[13]; p.lnx_b = (const float*)d_in[14]; p.pe_k = (const float*)d_in[15];
    p.wk1 = (const float*)d_in[16]; p.bk1 = (const float*)d_in[17]; p.wk2 = (const float*)d_in[18]; p.pe_v = (const float*)d_in[19];
    p.wv1 = (const float*)d_in[20]; p.bv1 = (const float*)d_in[21]; p.wv2 = (const float*)d_in[22]; p.w_out = (const float*)d_in[23];
    p.norm_ffn = (const float*)d_in[24]; p.w_gate = (const float*)d_in[25]; p.w_up = (const float*)d_in[26]; p.w_down = (const float*)d_in[27];
    p.norm_final = (const float*)d_in[28];
    p.out = (float*)d_out;
    char* ws = (char*)d_ws;
    size_t off = 0;
    auto take = [&](size_t bytes) { char* r = ws + off; off += (bytes + 255) & ~(size_t)255; return r; };
    p.WinT = (bf16_t*)take((size_t)3200 * 1024 * 2);
    p.WoutT = (bf16_t*)take((size_t)1024 * 1024 * 2);
    p.WguT = (bf16_t*)take((size_t)5632 * 1024 * 2);
    p.WdnT = (bf16_t*)take((size_t)1024 * DFF * 2);
    p.w2T = (bf16_t*)take(512 * 64 * 2);
    p.a2T = (bf16_t*)take(512 * 64 * 2);
    p.g2T = (bf16_t*)take(512 * 160 * 2);
    p.w1T = (bf16_t*)take((size_t)2 * 256 * 2048 * 2);
    p.wc2T = (bf16_t*)take(2 * 128 * 256 * 2);
    p.b1p = (float*)take(512 * 4);
    p.cosT = (float*)take((size_t)T_ * 8 * 4);
    p.sinT = (float*)take((size_t)T_ * 8 * 4);
    p.counter = (unsigned*)take(256);
    p.bar = (unsigned*)take(XCD_BAR_WORDS * 4);
    off = (size_t)32 << 20;
    p.A = (bf16_t*)take((size_t)T_ * 1024 * 2);
    p.proj = (bf16_t*)take((size_t)T_ * PLD * 2);
    p.stream = (bf16_t*)take((size_t)T_ * 8 * 384 * 2);
    if (off > ws_size) fprintf(stderr, "workspace too small: need %zu have %zu\n", off, ws_size);
    char* ob = (char*)d_out;
    p.gbuf = (bf16_t*)ob;
    p.yraw = (float*)(ob + ((size_t)32 << 20));
    p.vT = (bf16_t*)(ob + ((size_t)96 << 20));
    p.hid = (bf16_t*)(ob + ((size_t)112 << 20));
    p.kc = (bf16_t*)(ob + ((size_t)116 << 20));
    p.vcT = (bf16_t*)(ob + ((size_t)116 << 20) + (512 << 10));
#if MK_SINGLE
    static int grid_blocks = 0;
    if (!grid_blocks) {
        int dev = 0, cus = 0, per_cu = 0;
        hipGetDevice(&dev);
        hipDeviceGetAttribute(&cus, hipDeviceAttributeMultiprocessorCount, dev);
        hipOccupancyMaxActiveBlocksPerMultiprocessor(&per_cu, mega_kernel, NTHR, 0);
        if (per_cu > 2) per_cu = 2;
        if (per_cu < 1) per_cu = 1;
        grid_blocks = cus * per_cu;
    }
    (void)hipMemsetAsync(p.bar, 0, XCD_BAR_WORDS * 4, stream);
    void* args[] = {&p};
    hipError_t e = hipLaunchCooperativeKernel((void*)mega_kernel, dim3(grid_blocks), dim3(NTHR), args, 0, stream);
    if (e != hipSuccess) fprintf(stderr, "cooperative launch failed: %s (grid %d)\n", hipGetErrorString(e), grid_blocks);
#else
    for (int ph = 0; ph < NPHASE; ++ph) phase_kernel<<<512, NTHR, 0, stream>>>(p, ph);
#endif
}
```

```cpp
#include <hip/hip_runtime.h>
#include <hip/hip_cooperative_groups.h>
#include <cstdio>
namespace cg = cooperative_groups;

#ifndef MK_SINGLE
#define MK_SINGLE 1
#endif

#define DI __device__ __forceinline__
typedef unsigned short bf16_t;
typedef short bf16x8 __attribute__((ext_vector_type(8)));
typedef float f32x16 __attribute__((ext_vector_type(16)));
typedef __bf16 bf2_t __attribute__((ext_vector_type(2)));
typedef float f2_t __attribute__((ext_vector_type(2)));

constexpr int T_ = 32768, S_ = 16384;
constexpr int PLD = 3200;
constexpr int QC = 1856, KVC = 2368, GC = 3136;
constexpr int DFF = 2816;
constexpr int NTHR = 256;
constexpr float QSC = 0.125f * 1.4426950408889634f;

#define MFMA32(a, b, c) __builtin_amdgcn_mfma_f32_32x32x16_bf16((a), (b), (c), 0, 0, 0)

DI int tidx() { int r; asm volatile("v_mov_b32 %0, %1" : "=v"(r) : "v"(threadIdx.x)); return r; }
DI unsigned pack2(float a, float b) { f2_t v = {a, b}; return __builtin_bit_cast(unsigned, __builtin_convertvector(v, bf2_t)); }
DI float bflo(unsigned u) { return __uint_as_float(u << 16); }
DI float bfhi(unsigned u) { return __uint_as_float(u & 0xffff0000u); }
DI bf16_t f2bf(float a) { return (bf16_t)(pack2(a, 0.f) & 0xffffu); }
DI void unpack8(const uint4& u, float (&f)[8]) {
    f[0] = bflo(u.x); f[1] = bfhi(u.x); f[2] = bflo(u.y); f[3] = bfhi(u.y);
    f[4] = bflo(u.z); f[5] = bfhi(u.z); f[6] = bflo(u.w); f[7] = bfhi(u.w);
}
DI uint4 pack8(const float (&f)[8]) { uint4 u; u.x = pack2(f[0], f[1]); u.y = pack2(f[2], f[3]); u.z = pack2(f[4], f[5]); u.w = pack2(f[6], f[7]); return u; }
DI float wave_sum(float v) {
#pragma unroll
    for (int o = 32; o; o >>= 1) v += __shfl_xor(v, o);
    return v;
}
DI float sigmoidf_(float x) { return 1.f / (1.f + __expf(-x)); }
DI int crow(int reg, int h) { return (reg & 3) + 8 * (reg >> 2) + 4 * h; }

struct P {
    const float* x; const int* pos; const float *norm_mix, *w_in, *mu, *w0, *w2, *a0, *a2, *g2, *k_k, *k_a, *r_k, *lnx_w, *lnx_b,
        *pe_k, *wk1, *bk1, *wk2, *pe_v, *wv1, *bv1, *wv2, *w_out, *norm_ffn, *w_gate, *w_up, *w_down, *norm_final;
    float* out;
    bf16_t *WinT, *WoutT, *WguT, *WdnT, *w2T, *a2T, *g2T, *w1T, *wc2T;
    float *b1p, *cosT, *sinT;
    unsigned* counter; unsigned* bar;
    bf16_t *A, *proj, *stream;
    bf16_t* gbuf; float* yraw; bf16_t *vT, *hid, *kc, *vcT;
};

DI float tr_val(const P& p, int job, int k, int n) {
    switch (job) {
    case 0: { int c = n < 1824 ? n : ((n >= 1856 && n < 3160) ? n - 32 : -1); return c >= 0 ? p.w_in[(size_t)k * 3128 + c] : 0.f; }
    case 1: return p.w_out[k * 1024 + n];
    case 2: { int q = n >> 6, r = n & 63; return r < 32 ? p.w_gate[(size_t)k * DFF + q * 32 + r] : p.w_up[(size_t)k * DFF + q * 32 + r - 32]; }
    case 3: return p.w_down[(size_t)k * 1024 + n];
    case 4: return p.w2[k * 512 + n];
    case 5: return p.a2[k * 512 + n];
    case 6: return p.g2[k * 512 + n];
    case 7: return p.wk1[k * 256 + n];
    case 8: return p.wv1[k * 256 + n];
    case 9: return n < 64 ? p.wk2[k * 64 + n] : 0.f;
    default: return n < 64 ? p.wv2[k * 64 + n] : 0.f;
    }
}
DI void tr_item(const P& p, int it, float* tile) {
    int job, K, N; bf16_t* dst;
    if (it < 800) { job = 0; K = 1024; N = 3200; dst = p.WinT; }
    else if (it < 1056) { job = 1; it -= 800; K = 1024; N = 1024; dst = p.WoutT; }
    else if (it < 2464) { job = 2; it -= 1056; K = 1024; N = 5632; dst = p.WguT; }
    else if (it < 3168) { job = 3; it -= 2464; K = 2816; N = 1024; dst = p.WdnT; }
    else if (it < 3176) { job = 4; it -= 3168; K = 64; N = 512; dst = p.w2T; }
    else if (it < 3184) { job = 5; it -= 3176; K = 64; N = 512; dst = p.a2T; }
    else if (it < 3208) { job = 6; it -= 3184; K = 160; N = 512; dst = p.g2T; }
    else if (it < 3336) { job = 7; it -= 3208; K = 2048; N = 256; dst = p.w1T; }
    else if (it < 3464) { job = 8; it -= 3336; K = 2048; N = 256; dst = p.w1T + 256 * 2048; }
    else if (it < 3472) { job = 9; it -= 3464; K = 256; N = 128; dst = p.wc2T; }
    else { job = 10; it -= 3472; K = 256; N = 128; dst = p.wc2T + 128 * 256; }
    const int nt = N >> 6;
    const int k0 = (it / nt) * 64, n0 = (it % nt) * 64;
    const int tid = tidx();
    __syncthreads();
#pragma unroll 4
    for (int i = 0; i < 16; ++i) {
        const int kk = i * 4 + (tid >> 6), nn = tid & 63;
        tile[kk * 65 + nn] = (k0 + kk < K) ? tr_val(p, job, k0 + kk, n0 + nn) : 0.f;
    }
    __syncthreads();
#pragma unroll 4
    for (int i = 0; i < 16; ++i) {
        const int nn = i * 4 + (tid >> 6), kk = tid & 63;
        if (k0 + kk < K) dst[(size_t)(n0 + nn) * K + k0 + kk] = f2bf(tile[kk * 65 + nn]);
    }
}
DI void b1_item(const P& p, int idx) {
    const int kv = idx >> 4, jc = idx & 15, tid = tidx();
    const float* pe = kv ? p.pe_v : p.pe_k; const float* w1 = kv ? p.wv1 : p.wk1; const float* b1 = kv ? p.bv1 : p.bk1;
    const int j = jc * 16 + (tid >> 4), kl = tid & 15;
    float s = 0.f;
    for (int i = 0; i < 128; ++i) { const int k = kl + 16 * i; s += pe[k] * w1[k * 256 + j]; }
    s += __shfl_xor(s, 1); s += __shfl_xor(s, 2); s += __shfl_xor(s, 4); s += __shfl_xor(s, 8);
    if (kl == 0) p.b1p[kv * 256 + j] = b1[j] + s;
}
DI void sincos_d(float ang, float& c, float& s) {
    double x = (double)ang;
    const double TWO_PI = 6.283185307179586476925286766559;
    double n = __builtin_rint(x * (1.0 / TWO_PI));
    double r = x - n * TWO_PI;
    double q = r * 0.25;
    double q2 = q * q;
    double sn = q * (1.0 + q2 * (-1.0 / 6 + q2 * (1.0 / 120 + q2 * (-1.0 / 5040 + q2 * (1.0 / 362880 + q2 * (-1.0 / 39916800 + q2 * (1.0 / 6227020800.0)))))));
    double cs = 1.0 + q2 * (-0.5 + q2 * (1.0 / 24 + q2 * (-1.0 / 720 + q2 * (1.0 / 40320 + q2 * (-1.0 / 3628800 + q2 * (1.0 / 479001600.0))))));
    double s2 = 2 * sn * cs, c2 = 1 - 2 * sn * sn;
    double s4 = 2 * s2 * c2, c4 = 1 - 2 * s2 * s2;
    c = (float)c4; s = (float)s4;
}
DI void cs_item(const P& p, int idx) {
    const int e = idx * 256 + tidx(), tok = e >> 3, f = e & 7;
    const float invf[8] = {1.000000000e+00f, 1.939227432e-01f, 3.760603070e-02f, 7.292664610e-03f, 1.414213562e-03f, 2.742481884e-04f, 5.318295734e-05f, 1.031338525e-05f};
    float iv = invf[0];
#pragma unroll
    for (int i = 1; i < 8; ++i) iv = (f == i) ? invf[i] : iv;
    const float ang = (float)p.pos[tok] * iv;
    float c, s; sincos_d(ang, c, s);
    p.cosT[e] = c; p.sinT[e] = s;
}
DI void rms_item(const float* src, const float* g, bf16_t* dst, int idx) {
    const int row = idx * 4 + (tidx() >> 6), lane = tidx() & 63;
    const float4* sp = (const float4*)(src + (size_t)row * 1024);
    float4 v[4]; float ss = 0.f;
#pragma unroll
    for (int i = 0; i < 4; ++i) { v[i] = sp[lane + 64 * i]; ss += v[i].x * v[i].x + v[i].y * v[i].y + v[i].z * v[i].z + v[i].w * v[i].w; }
    ss = wave_sum(ss);
    const float rs = rsqrtf(ss * (1.f / 1024.f) + 1e-6f);
#pragma unroll
    for (int i = 0; i < 4; ++i) {
        const float4 gv = ((const float4*)g)[lane + 64 * i];
        uint2 o; o.x = pack2(v[i].x * rs * gv.x, v[i].y * rs * gv.y); o.y = pack2(v[i].z * rs * gv.z, v[i].w * rs * gv.w);
        *(uint2*)(dst + (size_t)row * 1024 + (lane + 64 * i) * 4) = o;
    }
}
DI void phase0(const P& p, char* smem) {
    if (blockIdx.x == 0 && tidx() == 0) *p.counter = 0u;
    constexpr int NTR = 3480, NB1 = 32, NCS = 1024, NXN = 8192;
    for (int it = blockIdx.x; it < NTR + NB1 + NCS + NXN; it += gridDim.x) {
        if (it < NTR) tr_item(p, it, (float*)smem);
        else if (it < NTR + NB1) b1_item(p, it - NTR);
        else if (it < NTR + NB1 + NCS) cs_item(p, it - NTR - NB1);
        else rms_item(p.x, p.norm_mix, p.A, it - NTR - NB1 - NCS);
    }
}

struct AFPlain { const bf16_t* A; int lda; DI uint4 load(int row, int k) const { return *(const uint4*)(A + (size_t)row * lda + k); } };
struct AFCmp {
    const bf16_t* base;
    DI uint4 load(int r, int k) const { int tok = 16 * r + (k >> 6); tok = tok < S_ ? tok : S_ - 1; return *(const uint4*)(base + (size_t)tok * PLD + (k & 63)); }
};

template <class AF, class EPI>
DI void gemm_tile(const AF af, const bf16_t* __restrict__ Bt, const int K, const int m0, const int n0, const EPI epi, char* smem) {
    const int tid = tidx(), wave = tid >> 6, lane = tid & 63, wm = wave >> 1, wn = wave & 1, rr = lane & 31, hh = lane >> 5;
    f32x16 acc[2][2];
#pragma unroll
    for (int a = 0; a < 2; ++a)
#pragma unroll
        for (int b = 0; b < 2; ++b)
#pragma unroll
            for (int i = 0; i < 16; ++i) acc[a][b][i] = 0.f;
    const int lrow = tid >> 3, lk = (tid & 7) * 8;
#define GLOAD(R, KO) \
    R##a0 = af.load(m0 + lrow, (KO) + lk); R##a1 = af.load(m0 + lrow + 32, (KO) + lk); R##a2 = af.load(m0 + lrow + 64, (KO) + lk); R##a3 = af.load(m0 + lrow + 96, (KO) + lk); \
    R##b0 = *(const uint4*)(Bt + (size_t)(lrow) * K + (KO) + lk); R##b1 = *(const uint4*)(Bt + (size_t)(lrow + 32) * K + (KO) + lk); \
    R##b2 = *(const uint4*)(Bt + (size_t)(lrow + 64) * K + (KO) + lk); R##b3 = *(const uint4*)(Bt + (size_t)(lrow + 96) * K + (KO) + lk);
#define GSTORE(R, SA, SB) \
    *(uint4*)&(SA)[(lrow) * 72 + lk] = R##a0; *(uint4*)&(SA)[(lrow + 32) * 72 + lk] = R##a1; *(uint4*)&(SA)[(lrow + 64) * 72 + lk] = R##a2; *(uint4*)&(SA)[(lrow + 96) * 72 + lk] = R##a3; \
    *(uint4*)&(SB)[(lrow) * 72 + lk] = R##b0; *(uint4*)&(SB)[(lrow + 32) * 72 + lk] = R##b1; *(uint4*)&(SB)[(lrow + 64) * 72 + lk] = R##b2; *(uint4*)&(SB)[(lrow + 96) * 72 + lk] = R##b3;
#define GCOMPUTE(SA, SB) \
    _Pragma("unroll") for (int ks = 0; ks < 4; ++ks) { \
        bf16x8 tf0 = *(const bf16x8*)&(SA)[(wm * 64 + rr) * 72 + ks * 16 + hh * 8], tf1 = *(const bf16x8*)&(SA)[(wm * 64 + 32 + rr) * 72 + ks * 16 + hh * 8]; \
        bf16x8 wf0 = *(const bf16x8*)&(SB)[(wn * 64 + rr) * 72 + ks * 16 + hh * 8], wf1 = *(const bf16x8*)&(SB)[(wn * 64 + 32 + rr) * 72 + ks * 16 + hh * 8]; \
        acc[0][0] = MFMA32(wf0, tf0, acc[0][0]); acc[0][1] = MFMA32(wf0, tf1, acc[0][1]); acc[1][0] = MFMA32(wf1, tf0, acc[1][0]); acc[1][1] = MFMA32(wf1, tf1, acc[1][1]); }
    uint4 Xa0, Xa1, Xa2, Xa3, Xb0, Xb1, Xb2, Xb3, Ya0, Ya1, Ya2, Ya3, Yb0, Yb1, Yb2, Yb3;
    bf16_t* const sA0 = (bf16_t*)smem; bf16_t* const sB0 = sA0 + 128 * 72; bf16_t* const sA1 = sB0 + 128 * 72; bf16_t* const sB1 = sA1 + 128 * 72;
    GLOAD(X, 0)
    GLOAD(Y, 64)
    __syncthreads();
    GSTORE(X, sA0, sB0)
    __syncthreads();
#pragma unroll 1
    for (int k0 = 0; k0 < K; k0 += 128) {
        const bool more = (k0 + 128 < K);
        if (more) { GLOAD(X, k0 + 128) }
        GCOMPUTE(sA0, sB0)
        GSTORE(Y, sA1, sB1)
        __syncthreads();
        if (more) { GLOAD(Y, k0 + 192) }
        GCOMPUTE(sA1, sB1)
        if (more) { GSTORE(X, sA0, sB0) }
        __syncthreads();
    }
#undef GLOAD
#undef GSTORE
#undef GCOMPUTE
    epi(acc, m0 + wm * 64, n0 + wn * 64, lane);
}

struct EpiProj {
    bf16_t* C;
    DI void operator()(const f32x16 (&acc)[2][2], int rowbase, int colbase, int lane) const {
        const int rr = lane & 31, hh = lane >> 5;
#pragma unroll
        for (int w = 0; w < 2; ++w)
#pragma unroll
            for (int t = 0; t < 2; ++t)
#pragma unroll
                for (int j = 0; j < 4; ++j) {
                    uint2 o; o.x = pack2(acc[w][t][4 * j], acc[w][t][4 * j + 1]); o.y = pack2(acc[w][t][4 * j + 2], acc[w][t][4 * j + 3]);
                    *(uint2*)(C + (size_t)(rowbase + t * 32 + rr) * PLD + colbase + w * 32 + j * 8 + hh * 4) = o;
                }
    }
};
struct EpiHid {
    bf16_t* H; const float* bias;
    DI void operator()(const f32x16 (&acc)[2][2], int rowbase, int colbase, int lane) const {
        const int rr = lane & 31, hh = lane >> 5;
#pragma unroll
        for (int w = 0; w < 2; ++w)
#pragma unroll
            for (int t = 0; t < 2; ++t)
#pragma unroll
                for (int j = 0; j < 4; ++j) {
                    const int col = colbase + w * 32 + j * 8 + hh * 4;
                    const float4 bv = *(const float4*)(bias + col);
                    float v0 = acc[w][t][4 * j] + bv.x, v1 = acc[w][t][4 * j + 1] + bv.y, v2 = acc[w][t][4 * j + 2] + bv.z, v3 = acc[w][t][4 * j + 3] + bv.w;
                    v0 *= sigmoidf_(v0); v1 *= sigmoidf_(v1); v2 *= sigmoidf_(v2); v3 *= sigmoidf_(v3);
                    uint2 o; o.x = pack2(v0, v1); o.y = pack2(v2, v3);
                    *(uint2*)(H + (size_t)(rowbase + t * 32 + rr) * 256 + col) = o;
                }
    }
};
struct EpiKc {
    bf16_t* kc; const float *cosT, *sinT; int tokbase;
    DI void operator()(const f32x16 (&acc)[2][2], int rowbase, int colbase, int lane) const {
        if (colbase != 0) return;
        const int rr = lane & 31, hh = lane >> 5;
#pragma unroll
        for (int t = 0; t < 2; ++t) {
            const int r = rowbase + t * 32 + rr;
            int tk = 31 + 16 * r; tk = tk < S_ ? tk : S_ - 1;
            const float4 c = *(const float4*)(cosT + (size_t)(tokbase + tk) * 8 + hh * 4), s = *(const float4*)(sinT + (size_t)(tokbase + tk) * 8 + hh * 4);
            bf16_t* kp = kc + (size_t)r * 64 + hh * 4;
            const float a0 = acc[0][t][0], a1 = acc[0][t][1], a2 = acc[0][t][2], a3 = acc[0][t][3];
            const float b0 = acc[0][t][4], b1 = acc[0][t][5], b2 = acc[0][t][6], b3 = acc[0][t][7];
            uint2 o;
            o.x = pack2(a0 * c.x - b0 * s.x, a1 * c.y - b1 * s.y); o.y = pack2(a2 * c.z - b2 * s.z, a3 * c.w - b3 * s.w);
            *(uint2*)(kp) = o;
            o.x = pack2(b0 * c.x + a0 * s.x, b1 * c.y + a1 * s.y); o.y = pack2(b2 * c.z + a2 * s.z, b3 * c.w + a3 * s.w);
            *(uint2*)(kp + 8) = o;
#pragma unroll
            for (int j = 2; j < 4; ++j) {
                o.x = pack2(acc[0][t][4 * j], acc[0][t][4 * j + 1]); o.y = pack2(acc[0][t][4 * j + 2], acc[0][t][4 * j + 3]);
                *(uint2*)(kp + j * 8) = o;
            }
#pragma unroll
            for (int j = 0; j < 4; ++j) {
                o.x = pack2(acc[1][t][4 * j], acc[1][t][4 * j + 1]); o.y = pack2(acc[1][t][4 * j + 2], acc[1][t][4 * j + 3]);
                *(uint2*)(kp + 32 + j * 8) = o;
            }
        }
    }
};
struct EpiVc {
    bf16_t* vcT; char* smem;
    DI void operator()(const f32x16 (&acc)[2][2], int rowbase, int colbase, int lane) const {
        const int rr = lane & 31, hh = lane >> 5;
        bf16_t* tl = (bf16_t*)smem;
        __syncthreads();
        if (colbase == 0) {
            const int rl = rowbase & 127;
#pragma unroll
            for (int w = 0; w < 2; ++w)
#pragma unroll
                for (int t = 0; t < 2; ++t)
#pragma unroll
                    for (int i = 0; i < 16; ++i) tl[(w * 32 + crow(i, hh)) * 136 + rl + t * 32 + rr] = f2bf(acc[w][t][i]);
        }
        __syncthreads();
        const int m0 = rowbase & ~127;
#pragma unroll
        for (int i = 0; i < 4; ++i) {
            const int c = tidx() + i * 256, d = c >> 4, ch = c & 15;
            *(uint4*)(vcT + (size_t)d * 1024 + m0 + ch * 8) = *(const uint4*)&tl[d * 136 + ch * 8];
        }
    }
};
struct EpiOut {
    float* out; const float* x;
    DI void operator()(const f32x16 (&acc)[2][2], int rowbase, int colbase, int lane) const {
        const int rr = lane & 31, hh = lane >> 5;
#pragma unroll
        for (int w = 0; w < 2; ++w)
#pragma unroll
            for (int t = 0; t < 2; ++t)
#pragma unroll
                for (int j = 0; j < 4; ++j) {
                    const size_t o = (size_t)(rowbase + t * 32 + rr) * 1024 + colbase + w * 32 + j * 8 + hh * 4;
                    float4 xv = *(const float4*)(x + o);
                    xv.x += acc[w][t][4 * j]; xv.y += acc[w][t][4 * j + 1]; xv.z += acc[w][t][4 * j + 2]; xv.w += acc[w][t][4 * j + 3];
                    *(float4*)(out + o) = xv;
                }
    }
};
struct EpiFfn1 {
    bf16_t* act;
    DI void operator()(const f32x16 (&acc)[2][2], int rowbase, int colbase, int lane) const {
        const int rr = lane & 31, hh = lane >> 5;
        const int cb = (colbase >> 6) * 32;
#pragma unroll
        for (int t = 0; t < 2; ++t)
#pragma unroll
            for (int j = 0; j < 4; ++j) {
                float v[4];
#pragma unroll
                for (int i = 0; i < 4; ++i) { const float g = acc[0][t][4 * j + i], u = acc[1][t][4 * j + i]; v[i] = g * sigmoidf_(g) * u; }
                uint2 o; o.x = pack2(v[0], v[1]); o.y = pack2(v[2], v[3]);
                *(uint2*)(act + (size_t)(rowbase + t * 32 + rr) * DFF + cb + j * 8 + hh * 4) = o;
            }
    }
};

DI void rwkv_prep(const P& p, int idx, char* smem) {
    const int tile = idx, tt0 = tile * 32;
    const int tid = tidx(), wave = tid >> 6, lane = tid & 63, rr = lane & 31, hh = lane >> 5;
    bf16_t* lat = (bf16_t*)smem;
    float* res = (float*)(smem + 32 * 296 * 2);
    __syncthreads();
    for (int c = tid; c < 32 * 36; c += NTHR) {
        const int tok = c / 36, ch = c - tok * 36, gi = tt0 + tok, col = 1536 + ch * 8;
        const uint4 cu = *(const uint4*)(p.proj + (size_t)gi * PLD + col);
        uint4 pv = make_uint4(0, 0, 0, 0);
        if ((gi & (S_ - 1)) != 0) pv = *(const uint4*)(p.proj + (size_t)(gi - 1) * PLD + col);
        float a[8], b[8]; unpack8(cu, a); unpack8(pv, b);
        const float4 m0 = *(const float4*)(p.mu + col), m1 = *(const float4*)(p.mu + col + 4);
        const float mu[8] = {m0.x, m0.y, m0.z, m0.w, m1.x, m1.y, m1.z, m1.w};
#pragma unroll
        for (int e = 0; e < 8; ++e) {
            float x = a[e] + (b[e] - a[e]) * mu[e];
            if (ch < 8) x = 1.f - 2.f / (1.f + __expf(2.f * x)); else if (ch >= 16) x = sigmoidf_(x);
            a[e] = x;
        }
        *(uint4*)&lat[tok * 296 + ch * 8] = pack8(a);
    }
    __syncthreads();
#pragma unroll 1
    for (int h = 0; h < 8; ++h) {
    if (wave < 2) {
        const int mt = wave;
        f32x16 aw, aa;
#pragma unroll
        for (int i = 0; i < 16; ++i) { aw[i] = 0.f; aa[i] = 0.f; }
#pragma unroll
        for (int ks = 0; ks < 4; ++ks) {
            const bf16x8 wf = *(const bf16x8*)(p.w2T + (size_t)(h * 64 + mt * 32 + rr) * 64 + ks * 16 + hh * 8);
            const bf16x8 af = *(const bf16x8*)(p.a2T + (size_t)(h * 64 + mt * 32 + rr) * 64 + ks * 16 + hh * 8);
            const bf16x8 l0 = *(const bf16x8*)&lat[rr * 296 + ks * 16 + hh * 8];
            const bf16x8 l1 = *(const bf16x8*)&lat[rr * 296 + 64 + ks * 16 + hh * 8];
            aw = MFMA32(wf, l0, aw); aa = MFMA32(af, l1, aa);
        }
#pragma unroll
        for (int j = 0; j < 4; ++j) {
            *(float4*)&res[(0 * 32 + rr) * 64 + mt * 32 + j * 8 + hh * 4] = make_float4(aw[4 * j], aw[4 * j + 1], aw[4 * j + 2], aw[4 * j + 3]);
            *(float4*)&res[(1 * 32 + rr) * 64 + mt * 32 + j * 8 + hh * 4] = make_float4(aa[4 * j], aa[4 * j + 1], aa[4 * j + 2], aa[4 * j + 3]);
        }
    } else {
        const int mt = wave - 2;
        f32x16 ag;
#pragma unroll
        for (int i = 0; i < 16; ++i) ag[i] = 0.f;
#pragma unroll
        for (int ks = 0; ks < 10; ++ks) {
            const bf16x8 gf = *(const bf16x8*)(p.g2T + (size_t)(h * 64 + mt * 32 + rr) * 160 + ks * 16 + hh * 8);
            const bf16x8 l2 = *(const bf16x8*)&lat[rr * 296 + 128 + ks * 16 + hh * 8];
            ag = MFMA32(gf, l2, ag);
        }
#pragma unroll
        for (int j = 0; j < 4; ++j)
            *(float4*)&res[(2 * 32 + rr) * 64 + mt * 32 + j * 8 + hh * 4] = make_float4(ag[4 * j], ag[4 * j + 1], ag[4 * j + 2], ag[4 * j + 3]);
    }
    __syncthreads();
    {
        const int tok = tid >> 3, cgp = tid & 7, gi = tt0 + tok, b = gi >> 14, s = gi & (S_ - 1), cb = h * 64 + cgp * 8;
        const bool first = (s == 0);
        float r[8], k[8], v[8];
        {
            float a[8], pb[8];
            const bf16_t* pr = p.proj + (size_t)gi * PLD;
#pragma unroll
            for (int q = 0; q < 3; ++q) {
                const int col = q * 512 + cb;
                unpack8(*(const uint4*)(pr + col), a);
                if (first) {
#pragma unroll
                    for (int e = 0; e < 8; ++e) pb[e] = 0.f;
                } else unpack8(*(const uint4*)(pr - PLD + col), pb);
                const float4 m0 = *(const float4*)(p.mu + col), m1 = *(const float4*)(p.mu + col + 4);
                const float mu[8] = {m0.x, m0.y, m0.z, m0.w, m1.x, m1.y, m1.z, m1.w};
#pragma unroll
                for (int e = 0; e < 8; ++e) {
                    const float x = a[e] + (pb[e] - a[e]) * mu[e];
                    if (q == 0) r[e] = x; else if (q == 1) k[e] = x; else v[e] = x;
                }
            }
        }
        float om[8], av[8], gg[8], kk[8], km[8], bb[8];
        float ss = 0.f;
#pragma unroll
        for (int e = 0; e < 8; ++e) {
            const float wp = res[(0 * 32 + tok) * 64 + cgp * 8 + e] + p.w0[cb + e];
            const float z = -wp;
            const float sp = fmaxf(z, 0.f) + __logf(1.f + __expf(-fabsf(z)));
            const float w = -sp - 0.5f;
            om[e] = 1.f - __expf(-__expf(w));
            av[e] = sigmoidf_(res[(1 * 32 + tok) * 64 + cgp * 8 + e] + p.a0[cb + e]);
            gg[e] = res[(2 * 32 + tok) * 64 + cgp * 8 + e];
            kk[e] = k[e] * p.k_k[cb + e];
            ss += kk[e] * kk[e];
            km[e] = k[e] * (1.f + (av[e] - 1.f) * p.k_a[cb + e]);
        }
        ss += __shfl_xor(ss, 1); ss += __shfl_xor(ss, 2); ss += __shfl_xor(ss, 4);
        const float inv = 1.f / fmaxf(sqrtf(ss), 1e-12f);
#pragma unroll
        for (int e = 0; e < 8; ++e) { kk[e] *= inv; bb[e] = kk[e] * av[e]; }
        bf16_t* sp = p.stream + ((size_t)((b * 8 + h) * S_ + s) * 6) * 64 + cgp * 8;
        *(uint4*)(sp) = pack8(om); *(uint4*)(sp + 64) = pack8(km); *(uint4*)(sp + 128) = pack8(kk);
        *(uint4*)(sp + 192) = pack8(bb); *(uint4*)(sp + 256) = pack8(r); *(uint4*)(sp + 320) = pack8(v);
        *(uint4*)(p.gbuf + (size_t)gi * 512 + cb) = pack8(gg);
    }
    __syncthreads();
    }
}

DI void rope_item(const P& p, int idx, char* smem) {
    const int tt0 = idx * 64, tid = tidx();
    bf16_t* vtile = (bf16_t*)smem;
    __syncthreads();
#pragma unroll 1
    for (int it = 0; it < 2; ++it) {
        const int item = tid + it * 256, tok = item >> 3, head = item & 7, gi = tt0 + tok;
        bf16_t* ptr = p.proj + (size_t)gi * PLD + QC + head * 64;
        const float4 c0 = *(const float4*)(p.cosT + (size_t)gi * 8), c1 = *(const float4*)(p.cosT + (size_t)gi * 8 + 4);
        const float4 s0 = *(const float4*)(p.sinT + (size_t)gi * 8), s1 = *(const float4*)(p.sinT + (size_t)gi * 8 + 4);
        const float cc[8] = {c0.x, c0.y, c0.z, c0.w, c1.x, c1.y, c1.z, c1.w}, sn[8] = {s0.x, s0.y, s0.z, s0.w, s1.x, s1.y, s1.z, s1.w};
        float a[8], b[8];
        unpack8(*(const uint4*)ptr, a); unpack8(*(const uint4*)(ptr + 8), b);
#pragma unroll
        for (int e = 0; e < 8; ++e) { const float x1 = a[e], x2 = b[e]; a[e] = (x1 * cc[e] - x2 * sn[e]) * QSC; b[e] = (x2 * cc[e] + x1 * sn[e]) * QSC; }
        *(uint4*)ptr = pack8(a); *(uint4*)(ptr + 8) = pack8(b);
#pragma unroll
        for (int q = 2; q < 8; ++q) {
            unpack8(*(const uint4*)(ptr + q * 8), a);
#pragma unroll
            for (int e = 0; e < 8; ++e) a[e] *= QSC;
            *(uint4*)(ptr + q * 8) = pack8(a);
        }
    }
    {
        const int tok = tid >> 2, sel = (tid >> 1) & 1, hk = tid & 1, gi = tt0 + tok;
        const float4 c0 = *(const float4*)(p.cosT + (size_t)gi * 8), c1 = *(const float4*)(p.cosT + (size_t)gi * 8 + 4);
        const float4 s0 = *(const float4*)(p.sinT + (size_t)gi * 8), s1 = *(const float4*)(p.sinT + (size_t)gi * 8 + 4);
        const float cc[8] = {c0.x, c0.y, c0.z, c0.w, c1.x, c1.y, c1.z, c1.w}, sn[8] = {s0.x, s0.y, s0.z, s0.w, s1.x, s1.y, s1.z, s1.w};
        float a[8], b[8];
        {
            bf16_t* ptr = p.proj + (size_t)gi * PLD + KVC + (sel ? 4 : 2) * 128 + hk * 64;
            unpack8(*(const uint4*)ptr, a); unpack8(*(const uint4*)(ptr + 8), b);
#pragma unroll
            for (int e = 0; e < 8; ++e) { const float x1 = a[e], x2 = b[e]; a[e] = x1 * cc[e] - x2 * sn[e]; b[e] = x2 * cc[e] + x1 * sn[e]; }
            *(uint4*)ptr = pack8(a); *(uint4*)(ptr + 8) = pack8(b);
        }
        {
            const bf16_t* ptr = p.proj + (size_t)gi * PLD + KVC + (sel ? 5 : 3) * 128 + hk * 64;
            bf16_t* vt = vtile + (size_t)((sel * 2 + hk) * 64) * 72 + tok;
            unpack8(*(const uint4*)ptr, a); unpack8(*(const uint4*)(ptr + 8), b);
#pragma unroll
            for (int e = 0; e < 8; ++e) { const float x1 = a[e], x2 = b[e]; a[e] = x1 * cc[e] - x2 * sn[e]; b[e] = x2 * cc[e] + x1 * sn[e]; }
#pragma unroll
            for (int e = 0; e < 8; ++e) { vt[e * 72] = f2bf(a[e]); vt[(8 + e) * 72] = f2bf(b[e]); }
#pragma unroll
            for (int q = 2; q < 8; ++q) {
                const uint4 u = *(const uint4*)(ptr + q * 8);
                const unsigned w[4] = {u.x, u.y, u.z, u.w};
#pragma unroll
                for (int e = 0; e < 4; ++e) { vt[(q * 8 + 2 * e) * 72] = (bf16_t)(w[e] & 0xffffu); vt[(q * 8 + 2 * e + 1) * 72] = (bf16_t)(w[e] >> 16); }
            }
        }
    }
    __syncthreads();
    const int b = tt0 >> 14, s0 = tt0 & (S_ - 1);
#pragma unroll
    for (int i = 0; i < 8; ++i) {
        const int c = tid + i * 256, grp = c >> 9, d = (c >> 3) & 63, ch = c & 7, sel = grp >> 1, hk = grp & 1;
        const uint4 u = *(const uint4*)&vtile[(size_t)(grp * 64 + d) * 72 + ch * 8];
        *(uint4*)(p.vT + ((size_t)((sel * 4 + b * 2 + hk) * 64 + d)) * S_ + s0 + ch * 8) = u;
    }
}

DI void phase2(const P& p, char* smem) {
    for (int it = blockIdx.x; it < 128 + 512 + 1024; it += gridDim.x) {
        if (it < 128) {
            const int kv = it >> 6, bhk = (it >> 4) & 3, mt = (it >> 1) & 7, nt = it & 1, b = bhk >> 1, hk = bhk & 1;
            AFCmp af{p.proj + (size_t)(b * S_) * PLD + KVC + kv * 128 + hk * 64};
            EpiHid ep{p.hid + (size_t)((kv * 4 + bhk) * 1024) * 256, p.b1p + kv * 256};
            gemm_tile(af, p.w1T + (size_t)(kv * 256 + nt * 128) * 2048, 2048, mt * 128, nt * 128, ep, smem);
        } else if (it < 640) rope_item(p, it - 128, smem);
        else rwkv_prep(p, it - 640, smem);
    }
}
DI void phase3(const P& p, char* smem) {
    for (int it = blockIdx.x; it < 64; it += gridDim.x) {
        const int kv = it >> 5, bhk = (it >> 3) & 3, mt = it & 7, b = bhk >> 1;
        AFPlain af{p.hid + (size_t)((kv * 4 + bhk) * 1024) * 256, 256};
        if (kv == 0) { EpiKc ep{p.kc + (size_t)bhk * 1024 * 64, p.cosT, p.sinT, b * S_}; gemm_tile(af, p.wc2T, 256, mt * 128, 0, ep, smem); }
        else { EpiVc ep{p.vcT + (size_t)bhk * 64 * 1024, smem}; gemm_tile(af, p.wc2T + 128 * 256, 256, mt * 128, 0, ep, smem); }
    }
}

template <int CTRL> DI float dpp_add(float x) { return x + __int_as_float(__builtin_amdgcn_mov_dpp(__float_as_int(x), CTRL, 0xF, 0xF, true)); }
DI float red16(float x) { x = dpp_add<0xB1>(x); x = dpp_add<0x4E>(x); x = dpp_add<0x141>(x); x = dpp_add<0x140>(x); return x; }

DI void cvt_store(const uint4 u, const bool isom, float* d) {
    float f0 = bflo(u.x), f1 = bfhi(u.x), f2 = bflo(u.y), f3 = bfhi(u.y), f4 = bflo(u.z), f5 = bfhi(u.z), f6 = bflo(u.w), f7 = bfhi(u.w);
    if (isom) { f0 = 1.f - f0; f1 = 1.f - f1; f2 = 1.f - f2; f3 = 1.f - f3; f4 = 1.f - f4; f5 = 1.f - f5; f6 = 1.f - f6; f7 = 1.f - f7; }
    *(float4*)d = make_float4(f0, f1, f2, f3); *(float4*)(d + 4) = make_float4(f4, f5, f6, f7);
}
DI void scan_unit(const P& p, int su, char* smem) {
    const int xcd = su & 7, kq = su >> 3, bh = xcd * 2 + (kq >> 3), oct = kq & 7, b = bh >> 3, h = bh & 7;
    const int tid = tidx(), wave = tid >> 6, lane = tid & 63;
    float* buf = (float*)smem;
    float* ypb = (float*)(smem + 49152);
    const bf16_t* sbase = p.stream + (size_t)bh * S_ * 384;
    __syncthreads();
#pragma unroll
    for (int i = 0; i < 3; ++i) { const int ci = tid + i * 256; cvt_store(*(const uint4*)(sbase + (size_t)ci * 8), (ci % 48) < 8, buf + ci * 8); }
    __syncthreads();
    if (wave < 2) {
        const int rl = lane >> 4, ks = lane & 15, row = oct * 8 + wave * 4 + rl;
        f2_t sA = {0.f, 0.f}, sB = {0.f, 0.f};
        __builtin_amdgcn_s_setprio(3);
        for (int c = 0; c < 1024; ++c) {
            const float* cb = buf + (c & 1) * 6144 + ks * 4;
            const float* vb = buf + (c & 1) * 6144 + 320 + row;
            float* yo = ypb + ((c & 1) * 2 + wave) * 1024 + lane;
            float4 dec = *(const float4*)(cb), km = *(const float4*)(cb + 64), kk = *(const float4*)(cb + 128), bb = *(const float4*)(cb + 192), rv = *(const float4*)(cb + 256);
            float v = vb[0];
#pragma unroll
            for (int st = 0; st < 16; ++st) {
                float4 ndec = dec, nkm = km, nkk = kk, nbb = bb, nrv = rv; float nv = v;
                if (st < 15) {
                    const float* rec = cb + (st + 1) * 384;
                    ndec = *(const float4*)(rec); nkm = *(const float4*)(rec + 64); nkk = *(const float4*)(rec + 128); nbb = *(const float4*)(rec + 192); nrv = *(const float4*)(rec + 256);
                    nv = vb[(st + 1) * 384];
                }
                const f2_t vv = {v, v};
                const f2_t d01 = {dec.x, dec.y}, d23 = {dec.z, dec.w}, m01 = {km.x, km.y}, m23 = {km.z, km.w};
                const f2_t k01 = {kk.x, kk.y}, k23 = {kk.z, kk.w}, b01 = {bb.x, bb.y}, b23 = {bb.z, bb.w}, r01 = {rv.x, rv.y}, r23 = {rv.z, rv.w};
                const f2_t tA = sA * d01 + vv * m01, tB = sB * d23 + vv * m23;
                f2_t pa = sA * k01; pa = sB * k23 + pa;
                const float sa = red16(pa.x + pa.y);
                const f2_t sav = {sa, sa};
                sA = tA - sav * b01; sB = tB - sav * b23;
                f2_t ya = sA * r01; ya = sB * r23 + ya;
                yo[st * 64] = ya.x + ya.y;
                dec = ndec; km = nkm; kk = nkk; bb = nbb; rv = nrv; v = nv;
            }
            __syncthreads();
        }
        __builtin_amdgcn_s_setprio(0);
    } else {
        const int ht = tid - 128;
        const int ystep = ht >> 3, r8 = ht & 7;
        float* yout = p.yraw + (size_t)(b * S_) * 512 + h * 64 + oct * 8 + r8;
        const float* ysrc = ypb + (r8 >> 2) * 1024 + ystep * 64 + (r8 & 3) * 16;
        uint4 ra0, ra1, ra2, ra3, ra4, ra5, rb0, rb1, rb2, rb3, rb4, rb5;
#define SLOAD(R, CH) { const bf16_t* sp_ = sbase + (size_t)(CH) * 6144 + (size_t)ht * 8; \
        R##0 = *(const uint4*)(sp_); R##1 = *(const uint4*)(sp_ + 1024); R##2 = *(const uint4*)(sp_ + 2048); R##3 = *(const uint4*)(sp_ + 3072); R##4 = *(const uint4*)(sp_ + 4096); R##5 = *(const uint4*)(sp_ + 5120); }
#define SSTORE(R, BI) { float* d_ = buf + (BI) * 6144 + ht * 8; const bool om_ = (ht % 48) < 8; \
        cvt_store(R##0, om_, d_); cvt_store(R##1, ((ht + 128) % 48) < 8, d_ + 1024); cvt_store(R##2, ((ht + 256) % 48) < 8, d_ + 2048); \
        cvt_store(R##3, ((ht + 384) % 48) < 8, d_ + 3072); cvt_store(R##4, ((ht + 512) % 48) < 8, d_ + 4096); cvt_store(R##5, ((ht + 640) % 48) < 8, d_ + 5120); }
#define YRED(C) { const float* ys_ = ysrc + ((C) & 1) * 2048; const float4 a_ = *(const float4*)ys_, b_ = *(const float4*)(ys_ + 4), c_ = *(const float4*)(ys_ + 8), d_ = *(const float4*)(ys_ + 12); \
        yout[(size_t)((C) * 16 + ystep) * 512] = ((a_.x + a_.y) + (a_.z + a_.w)) + ((b_.x + b_.y) + (b_.z + b_.w)) + ((c_.x + c_.y) + (c_.z + c_.w)) + ((d_.x + d_.y) + (d_.z + d_.w)); }
        SLOAD(ra, 1)
        for (int c = 0; c < 1024; c += 2) {
            if (c + 2 < 1024) SLOAD(rb, c + 2)
            SSTORE(ra, 1)
            if (c >= 1) YRED(c - 1)
            __syncthreads();
            if (c + 3 < 1024) SLOAD(ra, c + 3)
            if (c + 2 < 1024) SSTORE(rb, 0)
            YRED(c)
            __syncthreads();
        }
        YRED(1023)
#undef SLOAD
#undef SSTORE
#undef YRED
    }
}

struct AttnSmem {
    bf16_t k[64 * 72];
    bf16_t vt[64 * 68];
    float imp[32 * 256];
    unsigned selbits[32 * 8];
    unsigned wunion[4 * 8];
    unsigned bunion[8];
    int unit;
    int pad_[3];
    uint4 q[4 * 4 * 64];
};

#define ATTN_LOAD(KBASE, KSTRIDE, VTBASE, VTSTRIDE, NEEDV) { \
    rk0 = *(const uint4*)((KBASE) + (size_t)(tid >> 3) * (KSTRIDE) + (tid & 7) * 8); \
    rk1 = *(const uint4*)((KBASE) + (size_t)((tid >> 3) + 32) * (KSTRIDE) + (tid & 7) * 8); \
    if (NEEDV) { rv0 = *(const uint4*)((VTBASE) + (size_t)(tid >> 3) * (VTSTRIDE) + (tid & 7) * 8); \
                 rv1 = *(const uint4*)((VTBASE) + (size_t)((tid >> 3) + 32) * (VTSTRIDE) + (tid & 7) * 8); } }
#define ATTN_STORE(NEEDV) { \
    *(uint4*)&sm.k[(tid >> 3) * 72 + (tid & 7) * 8] = rk0; *(uint4*)&sm.k[((tid >> 3) + 32) * 72 + (tid & 7) * 8] = rk1; \
    if (NEEDV) { bf16_t* d0_ = &sm.vt[(tid >> 3) * 68 + (tid & 7) * 8]; bf16_t* d1_ = &sm.vt[((tid >> 3) + 32) * 68 + (tid & 7) * 8]; \
        *(uint2*)d0_ = make_uint2(rv0.x, rv0.y); *(uint2*)(d0_ + 4) = make_uint2(rv0.z, rv0.w); \
        *(uint2*)d1_ = make_uint2(rv1.x, rv1.y); *(uint2*)(d1_ + 4) = make_uint2(rv1.z, rv1.w); } }

template <int MODE, bool EM>
DI void attn_tile(AttnSmem& sm, const uint4* qs, f32x16 (&o)[2], float& m, float& l, const float inv_l, const int lo, const int hi, const bool lane_on,
                  const int lane, const int tokl, const int jbase) {
    const int rr = lane & 31, hh = lane >> 5;
    f32x16 s[2];
#pragma unroll
    for (int mt = 0; mt < 2; ++mt) {
#pragma unroll
        for (int i = 0; i < 16; ++i) s[mt][i] = 0.f;
#pragma unroll
        for (int ks = 0; ks < 4; ++ks) {
            const bf16x8 kf = *(const bf16x8*)&sm.k[(mt * 32 + rr) * 72 + ks * 16 + hh * 8];
            const bf16x8 qv = __builtin_bit_cast(bf16x8, qs[ks * 64]);
            s[mt] = MFMA32(kf, qv, s[mt]);
        }
        asm volatile("" ::: "memory");
    }
    float mx = -1e30f;
    if (EM) {
        const int lo2 = lo - 4 * hh, hi2 = hi - 4 * hh;
#pragma unroll
        for (int mt = 0; mt < 2; ++mt)
#pragma unroll
            for (int i = 0; i < 16; ++i) {
                const int kc_ = mt * 32 + (i & 3) + 8 * (i >> 2);
                float v = s[mt][i];
                v = (kc_ >= lo2 && kc_ <= hi2) ? v : -1e30f;
                s[mt][i] = v; mx = fmaxf(mx, v);
            }
    } else {
#pragma unroll
        for (int mt = 0; mt < 2; ++mt)
#pragma unroll
            for (int i = 0; i < 16; ++i) mx = fmaxf(mx, s[mt][i]);
        mx = lane_on ? mx : -1e30f;
    }
    float mref = m;
    if (MODE != 2) {
        mx = fmaxf(mx, __shfl_xor(mx, 32));
        const float mnew = fmaxf(m, mx);
        const float alpha = __builtin_amdgcn_exp2f(m - mnew);
        m = mnew; mref = mnew;
        l *= alpha;
        if (MODE == 1) {
#pragma unroll
            for (int dt = 0; dt < 2; ++dt)
#pragma unroll
                for (int i = 0; i < 16; ++i) o[dt][i] *= alpha;
        }
    }
    if (!EM) mref = lane_on ? mref : 1e30f;
    float psum = 0.f;
#pragma unroll
    for (int mt = 0; mt < 2; ++mt)
#pragma unroll
        for (int i = 0; i < 16; ++i) {
            const float v = s[mt][i];
            float pv;
            if (EM) pv = (v > -1e29f) ? __builtin_amdgcn_exp2f(v - mref) : 0.f;
            else pv = __builtin_amdgcn_exp2f(v - mref);
            if (MODE == 2) pv *= inv_l;
            s[mt][i] = pv; psum += pv;
        }
    if (MODE != 2) l += psum;
    if (MODE == 0) return;
    if (MODE == 2) {
#pragma unroll
        for (int mt = 0; mt < 2; ++mt)
#pragma unroll
            for (int jj = 0; jj < 4; ++jj) {
                float q4 = (s[mt][4 * jj] + s[mt][4 * jj + 1]) + (s[mt][4 * jj + 2] + s[mt][4 * jj + 3]);
                float e3 = s[mt][4 * jj + 3];
                q4 += __shfl_xor(q4, 1); q4 += __shfl_xor(q4, 2);
                e3 += __shfl_xor(e3, 1); e3 += __shfl_xor(e3, 2);
                if ((rr & 3) == 0) {
                    const int j = jbase + mt * 8 + 2 * jj + hh;
                    atomicAdd(&sm.imp[tokl * 256 + j], q4);
                    if (j + 1 < 256) atomicAdd(&sm.imp[tokl * 256 + j + 1], e3);
                }
            }
    }
#pragma unroll
    for (int mt = 0; mt < 2; ++mt)
#pragma unroll
        for (int s2 = 0; s2 < 2; ++s2) {
            uint4 pu;
            pu.x = pack2(s[mt][8 * s2 + 0], s[mt][8 * s2 + 1]); pu.y = pack2(s[mt][8 * s2 + 2], s[mt][8 * s2 + 3]);
            pu.z = pack2(s[mt][8 * s2 + 4], s[mt][8 * s2 + 5]); pu.w = pack2(s[mt][8 * s2 + 6], s[mt][8 * s2 + 7]);
            const bf16x8 pf = __builtin_bit_cast(bf16x8, pu);
            asm volatile("" ::: "memory");
#pragma unroll
            for (int dt = 0; dt < 2; ++dt) {
                const bf16_t* vp = &sm.vt[(dt * 32 + rr) * 68 + mt * 32 + s2 * 16 + hh * 4];
                const uint2 v0 = *(const uint2*)vp, v1 = *(const uint2*)(vp + 8);
                const bf16x8 vf = __builtin_bit_cast(bf16x8, make_uint4(v0.x, v0.y, v1.x, v1.y));
                o[dt] = MFMA32(vf, pf, o[dt]);
            }
        }
}

DI unsigned wave_umax(unsigned v) {
#pragma unroll
    for (int o = 32; o; o >>= 1) { const unsigned t = (unsigned)__shfl_xor((int)v, o); v = v > t ? v : t; }
    return v;
}

DI void attn_unit(const P& p, int u, char* smem) {
    AttnSmem& sm = *(AttnSmem*)smem;
    const int tid = tidx(), wave = tid >> 6, lane = tid & 63, rr = lane & 31, hh = lane >> 5;
    const int tile = 511 - (u >> 2), bhk = u & 3, b = bhk >> 1, hk = bhk & 1, t0 = tile * 32;
    const int tokl = wave * 8 + (rr >> 2), t = t0 + tokl, g = rr & 3, head = hk * 4 + g;
    const size_t tokg = (size_t)b * S_ + t;
    uint4* qs = &sm.q[wave * 256 + lane];
#pragma unroll
    for (int ks = 0; ks < 4; ++ks) qs[ks * 64] = *(const uint4*)(p.proj + tokg * PLD + QC + head * 64 + ks * 16 + hh * 8);
#define GATE(i) sigmoidf_(__uint_as_float((unsigned)p.proj[((size_t)b * S_ + t) * PLD + GC + head * 3 + (i)] << 16))
#pragma unroll
    for (int i = 0; i < 8; ++i) *(float4*)&sm.imp[(tid + i * 256) * 4] = make_float4(0.f, 0.f, 0.f, 0.f);
    sm.selbits[tid] = 0u;
    f32x16 o[2];
#pragma unroll
    for (int dt = 0; dt < 2; ++dt)
#pragma unroll
        for (int i = 0; i < 16; ++i) o[dt][i] = 0.f;
    float* park = &sm.imp[wave * 2048 + lane];
    uint4 rk0, rk1, rv0 = make_uint4(0, 0, 0, 0), rv1 = make_uint4(0, 0, 0, 0);
    const int ntc = (t0 >> 10) + 1;
    const int vmaxi = (t >= 31) ? ((t - 31) >> 4) : -1;
    const int twmin = t0 + wave * 8;
    const int wvmin = (twmin >= 31) ? ((twmin - 31) >> 4) : -1;
    const bf16_t* kcb = p.kc + (size_t)bhk * 1024 * 64;
    const bf16_t* vcb = p.vcT + (size_t)bhk * 64 * 1024;
    float m = -1e30f, l = 0.f;
    ATTN_LOAD(kcb, 64, vcb, 1024, false)
    for (int j = 0; j < ntc; ++j) {
        __syncthreads();
        ATTN_STORE(false)
        __syncthreads();
        if (j + 1 < ntc) ATTN_LOAD(kcb + (size_t)(j + 1) * 64 * 64, 64, vcb, 1024, false)
        if (j * 64 + 63 <= wvmin) attn_tile<0, false>(sm, qs, o, m, l, 0.f, 0, 0, true, lane, tokl, 0);
        else attn_tile<0, true>(sm, qs, o, m, l, 0.f, 0, vmaxi - j * 64, true, lane, tokl, 0);
    }
    {
        const float lt = l + __shfl_xor(l, 32);
        const float inv_l = lt > 0.f ? 1.f / lt : 0.f;
        ATTN_LOAD(kcb, 64, vcb, 1024, true)
        for (int j = 0; j < ntc; ++j) {
            __syncthreads();
            ATTN_STORE(true)
            __syncthreads();
            if (j + 1 < ntc) ATTN_LOAD(kcb + (size_t)(j + 1) * 64 * 64, 64, vcb + (j + 1) * 64, 1024, true)
            if (j * 64 + 63 <= wvmin) attn_tile<2, false>(sm, qs, o, m, l, inv_l, 0, 0, true, lane, tokl, j * 16);
            else attn_tile<2, true>(sm, qs, o, m, l, inv_l, 0, vmaxi - j * 64, true, lane, tokl, j * 16);
        }
    }
    __syncthreads();
    const int cur = t0 >> 6;
    for (int tk = 0; tk < 8; ++tk) {
        const int tl = wave * 8 + tk;
        const float* ip = &sm.imp[tl * 256];
        unsigned nib = 0u;
        if (cur <= 15) {
#pragma unroll
            for (int e = 0; e < 4; ++e) if (lane * 4 + e <= cur) nib |= 1u << e;
        } else {
            unsigned k0, k1, k2, k3;
            {
                const float4 iv = *(const float4*)(ip + lane * 4);
                const int j0 = lane * 4;
                k0 = (j0 >= 1 && j0 <= cur - 2) ? ((__float_as_uint(iv.x) & 0xFFFFFF00u) | (unsigned)(255 - j0)) : 0u;
                k1 = (j0 + 1 <= cur - 2) ? ((__float_as_uint(iv.y) & 0xFFFFFF00u) | (unsigned)(254 - j0)) : 0u;
                k2 = (j0 + 2 <= cur - 2) ? ((__float_as_uint(iv.z) & 0xFFFFFF00u) | (unsigned)(253 - j0)) : 0u;
                k3 = (j0 + 3 <= cur - 2) ? ((__float_as_uint(iv.w) & 0xFFFFFF00u) | (unsigned)(252 - j0)) : 0u;
#pragma unroll
                for (int e = 0; e < 4; ++e) { const int j = j0 + e; if (j == 0 || j == cur || j == cur - 1) nib |= 1u << e; }
            }
            for (int r = 0; r < 13; ++r) {
                unsigned lm = k0 > k1 ? k0 : k1; const unsigned lm2 = k2 > k3 ? k2 : k3; lm = lm > lm2 ? lm : lm2;
                const unsigned wm = wave_umax(lm);
                if (k0 == wm) { k0 = 0u; nib |= 1u; }
                if (k1 == wm) { k1 = 0u; nib |= 2u; }
                if (k2 == wm) { k2 = 0u; nib |= 4u; }
                if (k3 == wm) { k3 = 0u; nib |= 8u; }
            }
        }
        atomicOr(&sm.selbits[tl * 8 + (lane >> 3)], nib << ((lane & 7) * 4));
    }
    __syncthreads();
    if (tid < 32) {
        const int w = tid >> 3, d = tid & 7; unsigned uu = 0u;
#pragma unroll
        for (int k = 0; k < 8; ++k) uu |= sm.selbits[(w * 8 + k) * 8 + d];
        sm.wunion[w * 8 + d] = uu;
    }
    __syncthreads();
    if (tid < 8) sm.bunion[tid] = sm.wunion[tid] | sm.wunion[8 + tid] | sm.wunion[16 + tid] | sm.wunion[24 + tid];
    __syncthreads();
    {
        const float g0 = GATE(0);
#pragma unroll
        for (int dt = 0; dt < 2; ++dt)
#pragma unroll
            for (int i = 0; i < 16; ++i) { park[(dt * 16 + i) * 64] = g0 * o[dt][i]; o[dt][i] = 0.f; }
    }
    {
        const bf16_t* kb = p.proj + (size_t)(b * S_) * PLD + KVC + 2 * 128 + hk * 64;
        const bf16_t* vb = p.vT + (size_t)((0 * 4 + bhk) * 64) * S_;
        m = -1e30f; l = 0.f;
        auto nextj = [&](int j) -> int {
            ++j;
            while (j <= cur) {
                const unsigned w = sm.bunion[j >> 5] >> (j & 31);
                if (w) { j += __ffs((int)w) - 1; return j <= cur ? j : -1; }
                j = (j | 31) + 1;
            }
            return -1;
        };
        int j = nextj(-1);
        if (j >= 0) ATTN_LOAD(kb + (size_t)j * 64 * PLD, PLD, vb + j * 64, S_, true)
        while (j >= 0) {
            __syncthreads();
            ATTN_STORE(true)
            __syncthreads();
            const int jn = nextj(j);
            if (jn >= 0) ATTN_LOAD(kb + (size_t)jn * 64 * PLD, PLD, vb + jn * 64, S_, true)
            if ((sm.wunion[wave * 8 + (j >> 5)] >> (j & 31)) & 1u) {
                const bool selme = (sm.selbits[tokl * 8 + (j >> 5)] >> (j & 31)) & 1u;
                if (j < cur) attn_tile<1, false>(sm, qs, o, m, l, 0.f, 0, 0, selme, lane, tokl, 0);
                else attn_tile<1, true>(sm, qs, o, m, l, 0.f, 0, selme ? t - j * 64 : -1, true, lane, tokl, 0);
            }
            j = jn;
        }
        const float lt = l + __shfl_xor(l, 32);
        const float sc = lt > 0.f ? GATE(1) / lt : 0.f;
#pragma unroll
        for (int dt = 0; dt < 2; ++dt)
#pragma unroll
            for (int i = 0; i < 16; ++i) { park[(dt * 16 + i) * 64] += sc * o[dt][i]; o[dt][i] = 0.f; }
    }
    {
        const bf16_t* kb = p.proj + (size_t)(b * S_) * PLD + KVC + 4 * 128 + hk * 64;
        const bf16_t* vb = p.vT + (size_t)((1 * 4 + bhk) * 64) * S_;
        m = -1e30f; l = 0.f;
        const int jlo = (t0 >= 511) ? ((t0 - 511) >> 6) : 0, jhi = t0 >> 6;
        ATTN_LOAD(kb + (size_t)jlo * 64 * PLD, PLD, vb + jlo * 64, S_, true)
        for (int j = jlo; j <= jhi; ++j) {
            __syncthreads();
            ATTN_STORE(true)
            __syncthreads();
            if (j + 1 <= jhi) ATTN_LOAD(kb + (size_t)(j + 1) * 64 * PLD, PLD, vb + (j + 1) * 64, S_, true)
            if (j * 64 >= twmin + 7 - 511 && j * 64 + 63 <= twmin) attn_tile<1, false>(sm, qs, o, m, l, 0.f, 0, 0, true, lane, tokl, 0);
            else attn_tile<1, true>(sm, qs, o, m, l, 0.f, t - 511 - j * 64, t - j * 64, true, lane, tokl, 0);
        }
        const float lt = l + __shfl_xor(l, 32);
        const float sc = lt > 0.f ? GATE(2) / lt : 0.f;
#pragma unroll
        for (int dt = 0; dt < 2; ++dt)
#pragma unroll
            for (int i = 0; i < 16; ++i) o[dt][i] = park[(dt * 16 + i) * 64] + sc * o[dt][i];
    }
    bf16_t* mp = p.A + tokg * 1024 + 512 + head * 64;
#pragma unroll
    for (int dt = 0; dt < 2; ++dt)
#pragma unroll
        for (int jj = 0; jj < 4; ++jj) {
            uint2 ov; ov.x = pack2(o[dt][4 * jj], o[dt][4 * jj + 1]); ov.y = pack2(o[dt][4 * jj + 2], o[dt][4 * jj + 3]);
            *(uint2*)(mp + dt * 32 + jj * 8 + hh * 4) = ov;
        }
}

DI void phase4(const P& p, char* smem) {
    for (int su = blockIdx.x; su < 128; su += gridDim.x) scan_unit(p, su, smem);
    AttnSmem& sm = *(AttnSmem*)smem;
    while (true) {
        __syncthreads();
        if (tidx() == 0) sm.unit = (int)atomicAdd(p.counter, 1u);
        __syncthreads();
        const int u = sm.unit;
        if (u >= 2048) break;
        attn_unit(p, u, smem);
    }
}

DI void phase4b(const P& p) {
    const int tid = tidx();
    for (int it = blockIdx.x; it < T_ / 4; it += gridDim.x) {
        const int gi = it * 4 + (tid >> 6), cgp = tid & 63, h = cgp >> 3, c8 = (cgp & 7) * 8, col = cgp * 8, b = gi >> 14, s = gi & (S_ - 1);
        const float4 y0 = *(const float4*)(p.yraw + (size_t)gi * 512 + col), y1 = *(const float4*)(p.yraw + (size_t)gi * 512 + col + 4);
        float y[8] = {y0.x, y0.y, y0.z, y0.w, y1.x, y1.y, y1.z, y1.w};
        const bf16_t* sp = p.stream + ((size_t)((b * 8 + h) * S_ + s) * 6) * 64 + c8;
        float km[8], r[8], v[8], gg[8];
        unpack8(*(const uint4*)(sp + 64), km); unpack8(*(const uint4*)(sp + 256), r); unpack8(*(const uint4*)(sp + 320), v);
        unpack8(*(const uint4*)(p.gbuf + (size_t)gi * 512 + col), gg);
        float sum = 0.f, bon = 0.f;
#pragma unroll
        for (int e = 0; e < 8; ++e) { sum += y[e]; bon += r[e] * km[e] * p.r_k[col + e]; }
        sum += __shfl_xor(sum, 1); sum += __shfl_xor(sum, 2); sum += __shfl_xor(sum, 4);
        bon += __shfl_xor(bon, 1); bon += __shfl_xor(bon, 2); bon += __shfl_xor(bon, 4);
        const float mean = sum * (1.f / 64.f);
        float var = 0.f;
#pragma unroll
        for (int e = 0; e < 8; ++e) { y[e] -= mean; var += y[e] * y[e]; }
        var += __shfl_xor(var, 1); var += __shfl_xor(var, 2); var += __shfl_xor(var, 4);
        const float rs = rsqrtf(var * (1.f / 64.f) + 64e-5f);
        float o[8];
#pragma unroll
        for (int e = 0; e < 8; ++e) o[e] = (y[e] * rs * p.lnx_w[col + e] + p.lnx_b[col + e] + bon * v[e]) * gg[e];
        *(uint4*)(p.A + (size_t)gi * 1024 + col) = pack8(o);
    }
}

struct EpiFfn2 {
    float* out;
    DI void operator()(const f32x16 (&acc)[2][2], int rowbase, int colbase, int lane) const {
        const int rr = lane & 31, hh = lane >> 5;
#pragma unroll
        for (int w = 0; w < 2; ++w)
#pragma unroll
            for (int t = 0; t < 2; ++t)
#pragma unroll
                for (int j = 0; j < 4; ++j) {
                    float4* o = (float4*)(out + (size_t)(rowbase + t * 32 + rr) * 1024 + colbase + w * 32 + j * 8 + hh * 4);
                    float4 xv = *o;
                    xv.x += acc[w][t][4 * j]; xv.y += acc[w][t][4 * j + 1]; xv.z += acc[w][t][4 * j + 2]; xv.w += acc[w][t][4 * j + 3];
                    *o = xv;
                }
    }
};

DI void final_item(float* io, const float* g, int idx) {
    const int row = idx * 4 + (tidx() >> 6), lane = tidx() & 63;
    float4* sp = (float4*)(io + (size_t)row * 1024);
    float4 v[4]; float ss = 0.f;
#pragma unroll
    for (int i = 0; i < 4; ++i) { v[i] = sp[lane + 64 * i]; ss += v[i].x * v[i].x + v[i].y * v[i].y + v[i].z * v[i].z + v[i].w * v[i].w; }
    ss = wave_sum(ss);
    const float rs = rsqrtf(ss * (1.f / 1024.f) + 1e-6f);
#pragma unroll
    for (int i = 0; i < 4; ++i) {
        const float4 gv = ((const float4*)g)[lane + 64 * i];
        sp[lane + 64 * i] = make_float4(v[i].x * rs * gv.x, v[i].y * rs * gv.y, v[i].z * rs * gv.z, v[i].w * rs * gv.w);
    }
}

DI bool gemm_order(const int round, const int NT, int& mt, int& nt) {
    if (gridDim.x == 512) {
        const int xcd = blockIdx.x & 7, lb = blockIdx.x >> 3;
        const int q = round * 64 + lb;
        if (q >= 32 * NT) return false;
        mt = xcd * 32 + (q / (8 * NT)) * 8 + (q & 7);
        nt = (q >> 3) % NT;
        return true;
    }
    const int it = round * gridDim.x + blockIdx.x;
    if (it >= 256 * NT) return false;
    mt = it / NT; nt = it - mt * NT;
    return true;
}

DI void run_phase(const P& p, int ph, char* smem) {
    switch (ph) {
    case 0: phase0(p, smem); break;
    case 1:
        for (int rd = 0;; ++rd) {
            int mt, nt; if (!gemm_order(rd, 25, mt, nt)) break;
            gemm_tile(AFPlain{p.A, 1024}, p.WinT + (size_t)nt * 128 * 1024, 1024, mt * 128, nt * 128, EpiProj{p.proj}, smem);
        }
        break;
    case 2: phase2(p, smem); break;
    case 3: phase3(p, smem); break;
    case 4: phase4(p, smem); break;
    case 5: phase4b(p); break;
    case 6:
        for (int rd = 0;; ++rd) {
            int mt, nt; if (!gemm_order(rd, 8, mt, nt)) break;
            gemm_tile(AFPlain{p.A, 1024}, p.WoutT + (size_t)nt * 128 * 1024, 1024, mt * 128, nt * 128, EpiOut{p.out, p.x}, smem);
        }
        break;
    case 7:
        for (int it = blockIdx.x; it < T_ / 4; it += gridDim.x) rms_item(p.out, p.norm_ffn, p.A, it);
        break;
    case 8:
        for (int rd = 0;; ++rd) {
            int mt, nt; if (!gemm_order(rd, 44, mt, nt)) break;
            gemm_tile(AFPlain{p.A, 1024}, p.WguT + (size_t)nt * 128 * 1024, 1024, mt * 128, nt * 128, EpiFfn1{p.stream}, smem);
        }
        break;
    case 9:
        for (int rd = 0;; ++rd) {
            int mt, nt; if (!gemm_order(rd, 8, mt, nt)) break;
            gemm_tile(AFPlain{p.stream, DFF}, p.WdnT + (size_t)nt * 128 * DFF, DFF, mt * 128, nt * 128, EpiFfn2{p.out}, smem);
        }
        break;
    default:
        for (int it = blockIdx.x; it < T_ / 4; it += gridDim.x) final_item(p.out, p.norm_final, it);
        break;
    }
}
constexpr int NPHASE = 11;
constexpr int SMEM_BYTES = 73728;


#define XB_TMO      128
#define XB_XCNT(j)  (256  + 64 * (j))
#define XB_XSUB(j)  (1280 + 64 * (j))
#define XB_XGEN(j)  (2304 + 64 * (j))
#define XB_TOP      3328
#define XB_TOPGEN   3392
#define XCD_BAR_WORDS 3456
#define XB_SPIN_CAP (1u << 18)
#define LAS __attribute__((address_space(3)))
DI unsigned xb_ld(unsigned* p) { return __hip_atomic_load(p, __ATOMIC_RELAXED, __HIP_MEMORY_SCOPE_AGENT); }
DI unsigned xb_add(unsigned* p, unsigned v) { return __hip_atomic_fetch_add(p, v, __ATOMIC_RELAXED, __HIP_MEMORY_SCOPE_AGENT); }
DI unsigned xb_xcc_id() { return (unsigned)__builtin_amdgcn_s_getreg((3 << 11) | 20) & 0xFu; }
#define XB_SPIN(cond, bar) do { unsigned _sp = 0; while (cond) { __builtin_amdgcn_s_sleep(1); \
    if ((++_sp & 255u) == 0u) { if (xb_ld(&(bar)[XB_TMO])) break; if (_sp > XB_SPIN_CAP) { atomicAdd(&(bar)[XB_TMO], 1u); break; } } } } while (0)
struct XcdBarrier { unsigned* bar; unsigned x; volatile LAS unsigned* st; };
DI XcdBarrier xcd_barrier_post(unsigned* bar, volatile LAS unsigned* st) {
    XcdBarrier b; b.bar = bar; b.x = xb_xcc_id(); b.st = st;
    if (tidx() == 0) (void)xb_add(&bar[XB_XCNT(b.x)], 1u);
    return b;
}
DI void xcd_barrier_complete(unsigned* bar, unsigned x, unsigned& nloc, unsigned& nx) {
    const unsigned G = gridDim.x * gridDim.y * gridDim.z;
    unsigned sum, cnt, mine, sp = 0u;
    for (;;) {
        sum = 0u; cnt = 0u; mine = 0u;
#pragma unroll
        for (unsigned j = 0; j < 16; ++j) { const unsigned c = xb_ld(&bar[XB_XCNT(j)]); sum += c; cnt += (c > 0u) ? 1u : 0u; mine = (j == x) ? c : mine; }
        if (sum == G) break;
        __builtin_amdgcn_s_sleep(1);
        if ((++sp & 255u) == 0u) { if (xb_ld(&bar[XB_TMO])) break; if (sp > XB_SPIN_CAP) { atomicAdd(&bar[XB_TMO], 1u); break; } }
    }
    nloc = mine > 0u ? mine : 1u; nx = cnt > 0u ? cnt : 1u;
}
DI void xcd_barrier(const XcdBarrier& b) {
    asm volatile("s_waitcnt vmcnt(0)" ::: "memory");
    __syncthreads();
    if (tidx() == 0) {
        unsigned* bar = b.bar;
        __builtin_amdgcn_s_waitcnt(0);
        unsigned nloc = b.st[0], nx = b.st[1];
        if (nloc == 0u) { xcd_barrier_complete(bar, b.x, nloc, nx); b.st[0] = nloc; b.st[1] = nx; }
        const unsigned old = xb_add(&bar[XB_XSUB(b.x)], 1u);
        const unsigned gen = old / nloc;
        if (old + 1u == (gen + 1u) * nloc) {
            __builtin_amdgcn_fence(__ATOMIC_RELEASE, "agent");
            asm volatile("s_waitcnt vmcnt(0)" ::: "memory");
            const unsigned og = xb_add(&bar[XB_TOP], 1u);
            const unsigned tg = og / nx;
            if (og + 1u == (tg + 1u) * nx) xb_add(&bar[XB_TOPGEN], 1u);
            else XB_SPIN(xb_ld(&bar[XB_TOPGEN]) == tg, bar);
            __builtin_amdgcn_fence(__ATOMIC_ACQUIRE, "agent");
            xb_add(&bar[XB_XGEN(b.x)], 1u);
            asm volatile("s_waitcnt vmcnt(0)" ::: "memory");
        } else {
            XB_SPIN(xb_ld(&bar[XB_XGEN(b.x)]) == gen, bar);
            __builtin_amdgcn_fence(__ATOMIC_ACQUIRE, "agent");
            asm volatile("s_waitcnt vmcnt(0)" ::: "memory");
        }
    }
    __syncthreads();
}

__global__ void __launch_bounds__(NTHR, 2) mega_kernel(P p) {
    __shared__ __attribute__((aligned(16))) char smem[SMEM_BYTES];
    __shared__ uint4 xb_words;
    cg::grid_group grid = cg::this_grid();
    if (p.x == nullptr) grid.sync();
    if (tidx() == 0) xb_words = make_uint4(0u, 0u, 0u, 0u);
    __syncthreads();
    const XcdBarrier xb = xcd_barrier_post(p.bar, (volatile LAS unsigned*)&xb_words);
    run_phase(p, 0, smem); xcd_barrier(xb);
    run_phase(p, 1, smem); xcd_barrier(xb);
    run_phase(p, 2, smem); xcd_barrier(xb);
    run_phase(p, 3, smem); xcd_barrier(xb);
    run_phase(p, 4, smem); xcd_barrier(xb);
    run_phase(p, 5, smem); xcd_barrier(xb);
    run_phase(p, 6, smem); xcd_barrier(xb);
    run_phase(p, 7, smem); xcd_barrier(xb);
    run_phase(p, 8, smem); xcd_barrier(xb);
    run_phase(p, 9, smem); xcd_barrier(xb);
    run_phase(p, 10, smem);
}
__global__ void __launch_bounds__(NTHR, 2) phase_kernel(P p, int ph) {
    __shared__ __attribute__((aligned(16))) char smem[SMEM_BYTES];
    run_phase(p, ph, smem);
}

extern "C" void kernel_launch(void* const* d_in, const int* in_sizes, int n_in, void* d_out, int out_size, void* d_ws, size_t ws_size,
                              hipStream_t stream) {
    P p{};
    p.x = (const float*)d_in[0]; p.pos = (const int*)d_in[1]; p.norm_mix = (const float*)d_in[2]; p.w_in = (const float*)d_in[3];
    p.mu = (const float*)d_in[4]; p.w0 = (const float*)d_in[5]; p.w2 = (const float*)d_in[6]; p.a0 = (const float*)d_in[7];
    p.a2 = (const float*)d_in[8]; p.g2 = (const float*)d_in[9]; p.k_k = (const float*)d_in[10]; p.k_a = (const float*)d_in[11];
    p.r_k = (const float*)d_in[12]; p.lnx_w = (const float*)d_in[13]; p.lnx_b = (const float*)d_in[14]; p.pe_k = (const float*)d_in[15];
    p.wk1 = (const float*)d_in[16]; p.bk1 = (const float*)d_in[17]; p.wk2 = (const float*)d_in[18]; p.pe_v = (const float*)d_in[19];
    p.wv1 = (const float*)d_in[20]; p.bv1 = (const float*)d_in[21]; p.wv2 = (const float*)d_in[22]; p.w_out = (const float*)d_in[23];
    p.norm_ffn = (const float*)d_in[24]; p.w_gate = (const float*)d_in[25]; p.w_up = (const float*)d_in[26]; p.w_down = (const float*)d_in[27];
    p.norm_final = (const float*)d_in[28];
    p.out = (float*)d_out;
    char* ws = (char*)d_ws;
    size_t off = 0;
    auto take = [&](size_t bytes) { char* r = ws + off; off += (bytes + 255) & ~(size_t)255; return r; };
    p.WinT = (bf16_t*)take((size_t)3200 * 1024 * 2);
    p.WoutT = (bf16_t*)take((size_t)1024 * 1024 * 2);
    p.WguT = (bf16_t*)take((size_t)5632 * 1024 * 2);
    p.WdnT = (bf16_t*)take((size_t)1024 * DFF * 2);
    p.w2T = (bf16_t*)take(512 * 64 * 2);
    p.a2T = (bf16_t*)take(512 * 64 * 2);
    p.g2T = (bf16_t*)take(512 * 160 * 2);
    p.w1T = (bf16_t*)take((size_t)2 * 256 * 2048 * 2);
    p.wc2T = (bf16_t*)take(2 * 128 * 256 * 2);
    p.b1p = (float*)take(512 * 4);
    p.cosT = (float*)take((size_t)T_ * 8 * 4);
    p.sinT = (float*)take((size_t)T_ * 8 * 4);
    p.counter = (unsigned*)take(256);
    p.bar = (unsigned*)take(XCD_BAR_WORDS * 4);
    off = (size_t)32 << 20;
    p.A = (bf16_t*)take((size_t)T_ * 1024 * 2);
    p.proj = (bf16_t*)take((size_t)T_ * PLD * 2);
    p.stream = (bf16_t*)take((size_t)T_ * 8 * 384 * 2);
    if (off > ws_size) fprintf(stderr, "workspace too small: need %zu have %zu\n", off, ws_size);
    char* ob = (char*)d_out;
    p.gbuf = (bf16_t*)ob;
    p.yraw = (float*)(ob + ((size_t)32 << 20));
    p.vT = (bf16_t*)(ob + ((size_t)96 << 20));
    p.hid = (bf16_t*)(ob + ((size_t)112 << 20));
    p.kc = (bf16_t*)(ob + ((size_t)116 << 20));
    p.vcT = (bf16_t*)(ob + ((size_t)116 << 20) + (512 << 10));
#if MK_SINGLE
    static int grid_blocks = 0;
    if (!grid_blocks) {
        int dev = 0, cus = 0, per_cu = 0;
        hipGetDevice(&dev);
        hipDeviceGetAttribute(&cus, hipDeviceAttributeMultiprocessorCount, dev);
        hipOccupancyMaxActiveBlocksPerMultiprocessor(&per_cu, mega_kernel, NTHR, 0);
        if (per_cu > 2) per_cu = 2;
        if (per_cu < 1) per_cu = 1;
        grid_blocks = cus * per_cu;
    }
    (void)hipMemsetAsync(p.bar, 0, XCD_BAR_WORDS * 4, stream);
    void* args[] = {&p};
    hipError_t e = hipLaunchCooperativeKernel((void*)mega_kernel, dim3(grid_blocks), dim3(NTHR), args, 0, stream);
    if (e != hipSuccess) fprintf(stderr, "cooperative launch failed: %s (grid %d)\n", hipGetErrorString(e), grid_blocks);
#else
    for (int ph = 0; ph < NPHASE; ++ph) phase_kernel<<<512, NTHR, 0, stream>>>(p, ph);
#endif
}
```

```cpp
#include <hip/hip_runtime.h>
#include <hip/hip_cooperative_groups.h>
#include <cstdio>
namespace cg = cooperative_groups;

#ifndef MK_SINGLE
#define MK_SINGLE 1
#endif

#define DI __device__ __forceinline__
typedef unsigned short bf16_t;
typedef short bf16x8 __attribute__((ext_vector_type(8)));
typedef float f32x16 __attribute__((ext_vector_type(16)));
typedef __bf16 bf2_t __attribute__((ext_vector_type(2)));
typedef float f2_t __attribute__((ext_vector_type(2)));

constexpr int T_ = 32768, S_ = 16384;
constexpr int PLD = 3200;
constexpr int QC = 1856, KVC = 2368, GC = 3136;
constexpr int DFF = 2816;
constexpr int NTHR = 256;
constexpr float QSC = 0.125f * 1.4426950408889634f;

#define MFMA32(a, b, c) __builtin_amdgcn_mfma_f32_32x32x16_bf16((a), (b), (c), 0, 0, 0)

DI int tidx() { int r; asm volatile("v_mov_b32 %0, %1" : "=v"(r) : "v"(threadIdx.x)); return r; }
DI unsigned pack2(float a, float b) { f2_t v = {a, b}; return __builtin_bit_cast(unsigned, __builtin_convertvector(v, bf2_t)); }
DI float bflo(unsigned u) { return __uint_as_float(u << 16); }
DI float bfhi(unsigned u) { return __uint_as_float(u & 0xffff0000u); }
DI bf16_t f2bf(float a) { return (bf16_t)(pack2(a, 0.f) & 0xffffu); }
DI void unpack8(const uint4& u, float (&f)[8]) {
    f[0] = bflo(u.x); f[1] = bfhi(u.x); f[2] = bflo(u.y); f[3] = bfhi(u.y);
    f[4] = bflo(u.z); f[5] = bfhi(u.z); f[6] = bflo(u.w); f[7] = bfhi(u.w);
}
DI uint4 pack8(const float (&f)[8]) { uint4 u; u.x = pack2(f[0], f[1]); u.y = pack2(f[2], f[3]); u.z = pack2(f[4], f[5]); u.w = pack2(f[6], f[7]); return u; }
DI float wave_sum(float v) {
#pragma unroll
    for (int o = 32; o; o >>= 1) v += __shfl_xor(v, o);
    return v;
}
DI float sigmoidf_(float x) { return 1.f / (1.f + __expf(-x)); }
DI int crow(int reg, int h) { return (reg & 3) + 8 * (reg >> 2) + 4 * h; }

struct P {
    const float* x; const int* pos; const float *norm_mix, *w_in, *mu, *w0, *w2, *a0, *a2, *g2, *k_k, *k_a, *r_k, *lnx_w, *lnx_b,
        *pe_k, *wk1, *bk1, *wk2, *pe_v, *wv1, *bv1, *wv2, *w_out, *norm_ffn, *w_gate, *w_up, *w_down, *norm_final;
    float* out;
    bf16_t *WinT, *WoutT, *WguT, *WdnT, *w2T, *a2T, *g2T, *w1T, *wc2T;
    float *b1p, *cosT, *sinT;
    unsigned* counter; unsigned* bar;
    bf16_t *A, *proj, *stream;
    bf16_t* gbuf; float* yraw; bf16_t *vT, *hid, *kc, *vcT;
};

DI float tr_val(const P& p, int job, int k, int n) {
    switch (job) {
    case 0: { int c = n < 1824 ? n : ((n >= 1856 && n < 3160) ? n - 32 : -1); return c >= 0 ? p.w_in[(size_t)k * 3128 + c] : 0.f; }
    case 1: return p.w_out[k * 1024 + n];
    case 2: { int q = n >> 6, r = n & 63; return r < 32 ? p.w_gate[(size_t)k * DFF + q * 32 + r] : p.w_up[(size_t)k * DFF + q * 32 + r - 32]; }
    case 3: return p.w_down[(size_t)k * 1024 + n];
    case 4: return p.w2[k * 512 + n];
    case 5: return p.a2[k * 512 + n];
    case 6: return p.g2[k * 512 + n];
    case 7: return p.wk1[k * 256 + n];
    case 8: return p.wv1[k * 256 + n];
    case 9: return n < 64 ? p.wk2[k * 64 + n] : 0.f;
    default: return n < 64 ? p.wv2[k * 64 + n] : 0.f;
    }
}
DI void tr_item(const P& p, int it, float* tile) {
    int job, K, N; bf16_t* dst;
    if (it < 800) { job = 0; K = 1024; N = 3200; dst = p.WinT; }
    else if (it < 1056) { job = 1; it -= 800; K = 1024; N = 1024; dst = p.WoutT; }
    else if (it < 2464) { job = 2; it -= 1056; K = 1024; N = 5632; dst = p.WguT; }
    else if (it < 3168) { job = 3; it -= 2464; K = 2816; N = 1024; dst = p.WdnT; }
    else if (it < 3176) { job = 4; it -= 3168; K = 64; N = 512; dst = p.w2T; }
    else if (it < 3184) { job = 5; it -= 3176; K = 64; N = 512; dst = p.a2T; }
    else if (it < 3208) { job = 6; it -= 3184; K = 160; N = 512; dst = p.g2T; }
    else if (it < 3336) { job = 7; it -= 3208; K = 2048; N = 256; dst = p.w1T; }
    else if (it < 3464) { job = 8; it -= 3336; K = 2048; N = 256; dst = p.w1T + 256 * 2048; }
    else if (it < 3472) { job = 9; it -= 3464; K = 256; N = 128; dst = p.wc2T; }
    else { job = 10; it -= 3472; K = 256; N = 128; dst = p.wc2T + 128 * 256; }
    const int nt = N >> 6;
    const int k0 = (it / nt) * 64, n0 = (it % nt) * 64;
    const int tid = tidx();
    __syncthreads();
#pragma unroll 4
    for (int i = 0; i < 16; ++i) {
        const int kk = i * 4 + (tid >> 6), nn = tid & 63;
        tile[kk * 65 + nn] = (k0 + kk < K) ? tr_val(p, job, k0 + kk, n0 + nn) : 0.f;
    }
    __syncthreads();
#pragma unroll 4
    for (int i = 0; i < 16; ++i) {
        const int nn = i * 4 + (tid >> 6), kk = tid & 63;
        if (k0 + kk < K) dst[(size_t)(n0 + nn) * K + k0 + kk] = f2bf(tile[kk * 65 + nn]);
    }
}
DI void b1_item(const P& p, int idx) {
    const int kv = idx >> 4, jc = idx & 15, tid = tidx();
    const float* pe = kv ? p.pe_v : p.pe_k; const float* w1 = kv ? p.wv1 : p.wk1; const float* b1 = kv ? p.bv1 : p.bk1;
    const int j = jc * 16 + (tid >> 4), kl = tid & 15;
    float s = 0.f;
    for (int i = 0; i < 128; ++i) { const int k = kl + 16 * i; s += pe[k] * w1[k * 256 + j]; }
    s += __shfl_xor(s, 1); s += __shfl_xor(s, 2); s += __shfl_xor(s, 4); s += __shfl_xor(s, 8);
    if (kl == 0) p.b1p[kv * 256 + j] = b1[j] + s;
}
DI void sincos_d(float ang, float& c, float& s) {
    double x = (double)ang;
    const double TWO_PI = 6.283185307179586476925286766559;
    double n = __builtin_rint(x * (1.0 / TWO_PI));
    double r = x - n * TWO_PI;
    double q = r * 0.25;
    double q2 = q * q;
    double sn = q * (1.0 + q2 * (-1.0 / 6 + q2 * (1.0 / 120 + q2 * (-1.0 / 5040 + q2 * (1.0 / 362880 + q2 * (-1.0 / 39916800 + q2 * (1.0 / 6227020800.0)))))));
    double cs = 1.0 + q2 * (-0.5 + q2 * (1.0 / 24 + q2 * (-1.0 / 720 + q2 * (1.0 / 40320 + q2 * (-1.0 / 3628800 + q2 * (1.0 / 479001600.0))))));
    double s2 = 2 * sn * cs, c2 = 1 - 2 * sn * sn;
    double s4 = 2 * s2 * c2, c4 = 1 - 2 * s2 * s2;
    c = (float)c4; s = (float)s4;
}
DI void cs_item(const P& p, int idx) {
    const int e = idx * 256 + tidx(), tok = e >> 3, f = e & 7;
    const float invf[8] = {1.000000000e+00f, 1.939227432e-01f, 3.760603070e-02f, 7.292664610e-03f, 1.414213562e-03f, 2.742481884e-04f, 5.318295734e-05f, 1.031338525e-05f};
    float iv = invf[0];
#pragma unroll
    for (int i = 1; i < 8; ++i) iv = (f == i) ? invf[i] : iv;
    const float ang = (float)p.pos[tok] * iv;
    float c, s; sincos_d(ang, c, s);
    p.cosT[e] = c; p.sinT[e] = s;
}
DI void rms_item(const float* src, const float* g, bf16_t* dst, int idx) {
    const int row = idx * 4 + (tidx() >> 6), lane = tidx() & 63;
    const float4* sp = (const float4*)(src + (size_t)row * 1024);
    float4 v[4]; float ss = 0.f;
#pragma unroll
    for (int i = 0; i < 4; ++i) { v[i] = sp[lane + 64 * i]; ss += v[i].x * v[i].x + v[i].y * v[i].y + v[i].z * v[i].z + v[i].w * v[i].w; }
    ss = wave_sum(ss);
    const float rs = rsqrtf(ss * (1.f / 1024.f) + 1e-6f);
#pragma unroll
    for (int i = 0; i < 4; ++i) {
        const float4 gv = ((const float4*)g)[lane + 64 * i];
        uint2 o; o.x = pack2(v[i].x * rs * gv.x, v[i].y * rs * gv.y); o.y = pack2(v[i].z * rs * gv.z, v[i].w * rs * gv.w);
        *(uint2*)(dst + (size_t)row * 1024 + (lane + 64 * i) * 4) = o;
    }
}
DI void phase0(const P& p, char* smem) {
    if (blockIdx.x == 0 && tidx() == 0) *p.counter = 0u;
    constexpr int NTR = 3480, NB1 = 32, NCS = 1024, NXN = 8192;
    for (int it = blockIdx.x; it < NTR + NB1 + NCS + NXN; it += gridDim.x) {
        if (it < NTR) tr_item(p, it, (float*)smem);
        else if (it < NTR + NB1) b1_item(p, it - NTR);
        else if (it < NTR + NB1 + NCS) cs_item(p, it - NTR - NB1);
        else rms_item(p.x, p.norm_mix, p.A, it - NTR - NB1 - NCS);
    }
}

struct AFPlain { const bf16_t* A; int lda; DI uint4 load(int row, int k) const { return *(const uint4*)(A + (size_t)row * lda + k); } };
struct AFCmp {
    const bf16_t* base;
    DI uint4 load(int r, int k) const { int tok = 16 * r + (k >> 6); tok = tok < S_ ? tok : S_ - 1; return *(const uint4*)(base + (size_t)tok * PLD + (k & 63)); }
};

template <int KU, class AF, class EPI>
DI void gemm_tile(const AF af, const bf16_t* __restrict__ Bt, const int K, const int m0, const int n0, const EPI epi, char* smem) {
    const int tid = tidx(), wave = tid >> 6, lane = tid & 63, wm = wave >> 1, wn = wave & 1, rr = lane & 31, hh = lane >> 5;
    f32x16 acc[2][2];
#pragma unroll
    for (int a = 0; a < 2; ++a)
#pragma unroll
        for (int b = 0; b < 2; ++b)
#pragma unroll
            for (int i = 0; i < 16; ++i) acc[a][b][i] = 0.f;
    const int lrow = tid >> 3, lk = (tid & 7) * 8;
#define GLOAD(R, KO) \
    R##a0 = af.load(m0 + lrow, (KO) + lk); R##a1 = af.load(m0 + lrow + 32, (KO) + lk); R##a2 = af.load(m0 + lrow + 64, (KO) + lk); R##a3 = af.load(m0 + lrow + 96, (KO) + lk); \
    R##b0 = *(const uint4*)(Bt + (size_t)(lrow) * K + (KO) + lk); R##b1 = *(const uint4*)(Bt + (size_t)(lrow + 32) * K + (KO) + lk); \
    R##b2 = *(const uint4*)(Bt + (size_t)(lrow + 64) * K + (KO) + lk); R##b3 = *(const uint4*)(Bt + (size_t)(lrow + 96) * K + (KO) + lk);
#define GSTORE(R, SA, SB) \
    *(uint4*)&(SA)[(lrow) * 72 + lk] = R##a0; *(uint4*)&(SA)[(lrow + 32) * 72 + lk] = R##a1; *(uint4*)&(SA)[(lrow + 64) * 72 + lk] = R##a2; *(uint4*)&(SA)[(lrow + 96) * 72 + lk] = R##a3; \
    *(uint4*)&(SB)[(lrow) * 72 + lk] = R##b0; *(uint4*)&(SB)[(lrow + 32) * 72 + lk] = R##b1; *(uint4*)&(SB)[(lrow + 64) * 72 + lk] = R##b2; *(uint4*)&(SB)[(lrow + 96) * 72 + lk] = R##b3;
#define GCOMPUTE(SA, SB) \
    _Pragma("unroll") for (int ks = 0; ks < 4; ++ks) { \
        bf16x8 tf0 = *(const bf16x8*)&(SA)[(wm * 64 + rr) * 72 + ks * 16 + hh * 8], tf1 = *(const bf16x8*)&(SA)[(wm * 64 + 32 + rr) * 72 + ks * 16 + hh * 8]; \
        bf16x8 wf0 = *(const bf16x8*)&(SB)[(wn * 64 + rr) * 72 + ks * 16 + hh * 8], wf1 = *(const bf16x8*)&(SB)[(wn * 64 + 32 + rr) * 72 + ks * 16 + hh * 8]; \
        acc[0][0] = MFMA32(wf0, tf0, acc[0][0]); acc[0][1] = MFMA32(wf0, tf1, acc[0][1]); acc[1][0] = MFMA32(wf1, tf0, acc[1][0]); acc[1][1] = MFMA32(wf1, tf1, acc[1][1]); }
    uint4 Xa0, Xa1, Xa2, Xa3, Xb0, Xb1, Xb2, Xb3, Ya0, Ya1, Ya2, Ya3, Yb0, Yb1, Yb2, Yb3;
    bf16_t* const sA0 = (bf16_t*)smem; bf16_t* const sB0 = sA0 + 128 * 72; bf16_t* const sA1 = sB0 + 128 * 72; bf16_t* const sB1 = sA1 + 128 * 72;
    GLOAD(X, 0)
    GLOAD(Y, 64)
    __syncthreads();
    GSTORE(X, sA0, sB0)
    __syncthreads();
#pragma unroll KU
    for (int k0 = 0; k0 < K; k0 += 128) {
        const bool more = (k0 + 128 < K);
        if (more) { GLOAD(X, k0 + 128) }
        GCOMPUTE(sA0, sB0)
        GSTORE(Y, sA1, sB1)
        __syncthreads();
        if (more) { GLOAD(Y, k0 + 192) }
        GCOMPUTE(sA1, sB1)
        if (more) { GSTORE(X, sA0, sB0) }
        __syncthreads();
    }
#undef GLOAD
#undef GSTORE
#undef GCOMPUTE
    epi(acc, m0 + wm * 64, n0 + wn * 64, lane);
}

struct EpiProj {
    bf16_t* C;
    DI void operator()(const f32x16 (&acc)[2][2], int rowbase, int colbase, int lane) const {
        const int rr = lane & 31, hh = lane >> 5;
#pragma unroll
        for (int w = 0; w < 2; ++w)
#pragma unroll
            for (int t = 0; t < 2; ++t)
#pragma unroll
                for (int j = 0; j < 4; ++j) {
                    uint2 o; o.x = pack2(acc[w][t][4 * j], acc[w][t][4 * j + 1]); o.y = pack2(acc[w][t][4 * j + 2], acc[w][t][4 * j + 3]);
                    *(uint2*)(C + (size_t)(rowbase + t * 32 + rr) * PLD + colbase + w * 32 + j * 8 + hh * 4) = o;
                }
    }
};
struct EpiHid {
    bf16_t* H; const float* bias;
    DI void operator()(const f32x16 (&acc)[2][2], int rowbase, int colbase, int lane) const {
        const int rr = lane & 31, hh = lane >> 5;
#pragma unroll
        for (int w = 0; w < 2; ++w)
#pragma unroll
            for (int t = 0; t < 2; ++t)
#pragma unroll
                for (int j = 0; j < 4; ++j) {
                    const int col = colbase + w * 32 + j * 8 + hh * 4;
                    const float4 bv = *(const float4*)(bias + col);
                    float v0 = acc[w][t][4 * j] + bv.x, v1 = acc[w][t][4 * j + 1] + bv.y, v2 = acc[w][t][4 * j + 2] + bv.z, v3 = acc[w][t][4 * j + 3] + bv.w;
                    v0 *= sigmoidf_(v0); v1 *= sigmoidf_(v1); v2 *= sigmoidf_(v2); v3 *= sigmoidf_(v3);
                    uint2 o; o.x = pack2(v0, v1); o.y = pack2(v2, v3);
                    *(uint2*)(H + (size_t)(rowbase + t * 32 + rr) * 256 + col) = o;
                }
    }
};
struct EpiKc {
    bf16_t* kc; const float *cosT, *sinT; int tokbase;
    DI void operator()(const f32x16 (&acc)[2][2], int rowbase, int colbase, int lane) const {
        if (colbase != 0) return;
        const int rr = lane & 31, hh = lane >> 5;
#pragma unroll
        for (int t = 0; t < 2; ++t) {
            const int r = rowbase + t * 32 + rr;
            int tk = 31 + 16 * r; tk = tk < S_ ? tk : S_ - 1;
            const float4 c = *(const float4*)(cosT + (size_t)(tokbase + tk) * 8 + hh * 4), s = *(const float4*)(sinT + (size_t)(tokbase + tk) * 8 + hh * 4);
            bf16_t* kp = kc + (size_t)r * 64 + hh * 4;
            const float a0 = acc[0][t][0], a1 = acc[0][t][1], a2 = acc[0][t][2], a3 = acc[0][t][3];
            const float b0 = acc[0][t][4], b1 = acc[0][t][5], b2 = acc[0][t][6], b3 = acc[0][t][7];
            uint2 o;
            o.x = pack2(a0 * c.x - b0 * s.x, a1 * c.y - b1 * s.y); o.y = pack2(a2 * c.z - b2 * s.z, a3 * c.w - b3 * s.w);
            *(uint2*)(kp) = o;
            o.x = pack2(b0 * c.x + a0 * s.x, b1 * c.y + a1 * s.y); o.y = pack2(b2 * c.z + a2 * s.z, b3 * c.w + a3 * s.w);
            *(uint2*)(kp + 8) = o;
#pragma unroll
            for (int j = 2; j < 4; ++j) {
                o.x = pack2(acc[0][t][4 * j], acc[0][t][4 * j + 1]); o.y = pack2(acc[0][t][4 * j + 2], acc[0][t][4 * j + 3]);
                *(uint2*)(kp + j * 8) = o;
            }
#pragma unroll
            for (int j = 0; j < 4; ++j) {
                o.x = pack2(acc[1][t][4 * j], acc[1][t][4 * j + 1]); o.y = pack2(acc[1][t][4 * j + 2], acc[1][t][4 * j + 3]);
                *(uint2*)(kp + 32 + j * 8) = o;
            }
        }
    }
};
struct EpiVc {
    bf16_t* vcT; char* smem;
    DI void operator()(const f32x16 (&acc)[2][2], int rowbase, int colbase, int lane) const {
        const int rr = lane & 31, hh = lane >> 5;
        bf16_t* tl = (bf16_t*)smem;
        __syncthreads();
        if (colbase == 0) {
            const int rl = rowbase & 127;
#pragma unroll
            for (int w = 0; w < 2; ++w)
#pragma unroll
                for (int t = 0; t < 2; ++t)
#pragma unroll
                    for (int i = 0; i < 16; ++i) tl[(w * 32 + crow(i, hh)) * 136 + rl + t * 32 + rr] = f2bf(acc[w][t][i]);
        }
        __syncthreads();
        const int m0 = rowbase & ~127;
#pragma unroll
        for (int i = 0; i < 4; ++i) {
            const int c = tidx() + i * 256, d = c >> 4, ch = c & 15;
            *(uint4*)(vcT + (size_t)d * 1024 + m0 + ch * 8) = *(const uint4*)&tl[d * 136 + ch * 8];
        }
    }
};
struct EpiOut {
    float* out; const float* x;
    DI void operator()(const f32x16 (&acc)[2][2], int rowbase, int colbase, int lane) const {
        const int rr = lane & 31, hh = lane >> 5;
#pragma unroll
        for (int w = 0; w < 2; ++w)
#pragma unroll
            for (int t = 0; t < 2; ++t)
#pragma unroll
                for (int j = 0; j < 4; ++j) {
                    const size_t o = (size_t)(rowbase + t * 32 + rr) * 1024 + colbase + w * 32 + j * 8 + hh * 4;
                    float4 xv = *(const float4*)(x + o);
                    xv.x += acc[w][t][4 * j]; xv.y += acc[w][t][4 * j + 1]; xv.z += acc[w][t][4 * j + 2]; xv.w += acc[w][t][4 * j + 3];
                    *(float4*)(out + o) = xv;
                }
    }
};
struct EpiFfn1 {
    bf16_t* act;
    DI void operator()(const f32x16 (&acc)[2][2], int rowbase, int colbase, int lane) const {
        const int rr = lane & 31, hh = lane >> 5;
        const int cb = (colbase >> 6) * 32;
#pragma unroll
        for (int t = 0; t < 2; ++t)
#pragma unroll
            for (int j = 0; j < 4; ++j) {
                float v[4];
#pragma unroll
                for (int i = 0; i < 4; ++i) { const float g = acc[0][t][4 * j + i], u = acc[1][t][4 * j + i]; v[i] = g * sigmoidf_(g) * u; }
                uint2 o; o.x = pack2(v[0], v[1]); o.y = pack2(v[2], v[3]);
                *(uint2*)(act + (size_t)(rowbase + t * 32 + rr) * DFF + cb + j * 8 + hh * 4) = o;
            }
    }
};

DI void rwkv_prep(const P& p, int idx, char* smem) {
    const int tile = idx, tt0 = tile * 32;
    const int tid = tidx(), wave = tid >> 6, lane = tid & 63, rr = lane & 31, hh = lane >> 5;
    bf16_t* lat = (bf16_t*)smem;
    float* res = (float*)(smem + 32 * 296 * 2);
    __syncthreads();
    for (int c = tid; c < 32 * 36; c += NTHR) {
        const int tok = c / 36, ch = c - tok * 36, gi = tt0 + tok, col = 1536 + ch * 8;
        const uint4 cu = *(const uint4*)(p.proj + (size_t)gi * PLD + col);
        uint4 pv = make_uint4(0, 0, 0, 0);
        if ((gi & (S_ - 1)) != 0) pv = *(const uint4*)(p.proj + (size_t)(gi - 1) * PLD + col);
        float a[8], b[8]; unpack8(cu, a); unpack8(pv, b);
        const float4 m0 = *(const float4*)(p.mu + col), m1 = *(const float4*)(p.mu + col + 4);
        const float mu[8] = {m0.x, m0.y, m0.z, m0.w, m1.x, m1.y, m1.z, m1.w};
#pragma unroll
        for (int e = 0; e < 8; ++e) {
            float x = a[e] + (b[e] - a[e]) * mu[e];
            if (ch < 8) x = 1.f - 2.f / (1.f + __expf(2.f * x)); else if (ch >= 16) x = sigmoidf_(x);
            a[e] = x;
        }
        *(uint4*)&lat[tok * 296 + ch * 8] = pack8(a);
    }
    __syncthreads();
#pragma unroll 1
    for (int h = 0; h < 8; ++h) {
    if (wave < 2) {
        const int mt = wave;
        f32x16 aw, aa;
#pragma unroll
        for (int i = 0; i < 16; ++i) { aw[i] = 0.f; aa[i] = 0.f; }
#pragma unroll
        for (int ks = 0; ks < 4; ++ks) {
            const bf16x8 wf = *(const bf16x8*)(p.w2T + (size_t)(h * 64 + mt * 32 + rr) * 64 + ks * 16 + hh * 8);
            const bf16x8 af = *(const bf16x8*)(p.a2T + (size_t)(h * 64 + mt * 32 + rr) * 64 + ks * 16 + hh * 8);
            const bf16x8 l0 = *(const bf16x8*)&lat[rr * 296 + ks * 16 + hh * 8];
            const bf16x8 l1 = *(const bf16x8*)&lat[rr * 296 + 64 + ks * 16 + hh * 8];
            aw = MFMA32(wf, l0, aw); aa = MFMA32(af, l1, aa);
        }
#pragma unroll
        for (int j = 0; j < 4; ++j) {
            *(float4*)&res[(0 * 32 + rr) * 64 + mt * 32 + j * 8 + hh * 4] = make_float4(aw[4 * j], aw[4 * j + 1], aw[4 * j + 2], aw[4 * j + 3]);
            *(float4*)&res[(1 * 32 + rr) * 64 + mt * 32 + j * 8 + hh * 4] = make_float4(aa[4 * j], aa[4 * j + 1], aa[4 * j + 2], aa[4 * j + 3]);
        }
    } else {
        const int mt = wave - 2;
        f32x16 ag;
#pragma unroll
        for (int i = 0; i < 16; ++i) ag[i] = 0.f;
#pragma unroll
        for (int ks = 0; ks < 10; ++ks) {
            const bf16x8 gf = *(const bf16x8*)(p.g2T + (size_t)(h * 64 + mt * 32 + rr) * 160 + ks * 16 + hh * 8);
            const bf16x8 l2 = *(const bf16x8*)&lat[rr * 296 + 128 + ks * 16 + hh * 8];
            ag = MFMA32(gf, l2, ag);
        }
#pragma unroll
        for (int j = 0; j < 4; ++j)
            *(float4*)&res[(2 * 32 + rr) * 64 + mt * 32 + j * 8 + hh * 4] = make_float4(ag[4 * j], ag[4 * j + 1], ag[4 * j + 2], ag[4 * j + 3]);
    }
    __syncthreads();
    {
        const int tok = tid >> 3, cgp = tid & 7, gi = tt0 + tok, b = gi >> 14, s = gi & (S_ - 1), cb = h * 64 + cgp * 8;
        const bool first = (s == 0);
        float r[8], k[8], v[8];
        {
            float a[8], pb[8];
            const bf16_t* pr = p.proj + (size_t)gi * PLD;
#pragma unroll
            for (int q = 0; q < 3; ++q) {
                const int col = q * 512 + cb;
                unpack8(*(const uint4*)(pr + col), a);
                if (first) {
#pragma unroll
                    for (int e = 0; e < 8; ++e) pb[e] = 0.f;
                } else unpack8(*(const uint4*)(pr - PLD + col), pb);
                const float4 m0 = *(const float4*)(p.mu + col), m1 = *(const float4*)(p.mu + col + 4);
                const float mu[8] = {m0.x, m0.y, m0.z, m0.w, m1.x, m1.y, m1.z, m1.w};
#pragma unroll
                for (int e = 0; e < 8; ++e) {
                    const float x = a[e] + (pb[e] - a[e]) * mu[e];
                    if (q == 0) r[e] = x; else if (q == 1) k[e] = x; else v[e] = x;
                }
            }
        }
        float om[8], av[8], gg[8], kk[8], km[8], bb[8];
        float ss = 0.f;
#pragma unroll
        for (int e = 0; e < 8; ++e) {
            const float wp = res[(0 * 32 + tok) * 64 + cgp * 8 + e] + p.w0[cb + e];
            const float z = -wp;
            const float sp = fmaxf(z, 0.f) + __logf(1.f + __expf(-fabsf(z)));
            const float w = -sp - 0.5f;
            om[e] = 1.f - __expf(-__expf(w));
            av[e] = sigmoidf_(res[(1 * 32 + tok) * 64 + cgp * 8 + e] + p.a0[cb + e]);
            gg[e] = res[(2 * 32 + tok) * 64 + cgp * 8 + e];
            kk[e] = k[e] * p.k_k[cb + e];
            ss += kk[e] * kk[e];
            km[e] = k[e] * (1.f + (av[e] - 1.f) * p.k_a[cb + e]);
        }
        ss += __shfl_xor(ss, 1); ss += __shfl_xor(ss, 2); ss += __shfl_xor(ss, 4);
        const float inv = 1.f / fmaxf(sqrtf(ss), 1e-12f);
#pragma unroll
        for (int e = 0; e < 8; ++e) { kk[e] *= inv; bb[e] = kk[e] * av[e]; }
        bf16_t* sp = p.stream + ((size_t)((b * 8 + h) * S_ + s) * 6) * 64 + cgp * 8;
        *(uint4*)(sp) = pack8(om); *(uint4*)(sp + 64) = pack8(km); *(uint4*)(sp + 128) = pack8(kk);
        *(uint4*)(sp + 192) = pack8(bb); *(uint4*)(sp + 256) = pack8(r); *(uint4*)(sp + 320) = pack8(v);
        *(uint4*)(p.gbuf + (size_t)gi * 512 + cb) = pack8(gg);
    }
    __syncthreads();
    }
}

DI void rope_item(const P& p, int idx, char* smem) {
    const int tt0 = idx * 64, tid = tidx();
    bf16_t* vtile = (bf16_t*)smem;
    __syncthreads();
#pragma unroll 1
    for (int it = 0; it < 2; ++it) {
        const int item = tid + it * 256, tok = item >> 3, head = item & 7, gi = tt0 + tok;
        bf16_t* ptr = p.proj + (size_t)gi * PLD + QC + head * 64;
        const float4 c0 = *(const float4*)(p.cosT + (size_t)gi * 8), c1 = *(const float4*)(p.cosT + (size_t)gi * 8 + 4);
        const float4 s0 = *(const float4*)(p.sinT + (size_t)gi * 8), s1 = *(const float4*)(p.sinT + (size_t)gi * 8 + 4);
        const float cc[8] = {c0.x, c0.y, c0.z, c0.w, c1.x, c1.y, c1.z, c1.w}, sn[8] = {s0.x, s0.y, s0.z, s0.w, s1.x, s1.y, s1.z, s1.w};
        float a[8], b[8];
        unpack8(*(const uint4*)ptr, a); unpack8(*(const uint4*)(ptr + 8), b);
#pragma unroll
        for (int e = 0; e < 8; ++e) { const float x1 = a[e], x2 = b[e]; a[e] = (x1 * cc[e] - x2 * sn[e]) * QSC; b[e] = (x2 * cc[e] + x1 * sn[e]) * QSC; }
        *(uint4*)ptr = pack8(a); *(uint4*)(ptr + 8) = pack8(b);
#pragma unroll
        for (int q = 2; q < 8; ++q) {
            unpack8(*(const uint4*)(ptr + q * 8), a);
#pragma unroll
            for (int e = 0; e < 8; ++e) a[e] *= QSC;
            *(uint4*)(ptr + q * 8) = pack8(a);
        }
    }
    {
        const int tok = tid >> 2, sel = (tid >> 1) & 1, hk = tid & 1, gi = tt0 + tok;
        const float4 c0 = *(const float4*)(p.cosT + (size_t)gi * 8), c1 = *(const float4*)(p.cosT + (size_t)gi * 8 + 4);
        const float4 s0 = *(const float4*)(p.sinT + (size_t)gi * 8), s1 = *(const float4*)(p.sinT + (size_t)gi * 8 + 4);
        const float cc[8] = {c0.x, c0.y, c0.z, c0.w, c1.x, c1.y, c1.z, c1.w}, sn[8] = {s0.x, s0.y, s0.z, s0.w, s1.x, s1.y, s1.z, s1.w};
        float a[8], b[8];
        {
            bf16_t* ptr = p.proj + (size_t)gi * PLD + KVC + (sel ? 4 : 2) * 128 + hk * 64;
            unpack8(*(const uint4*)ptr, a); unpack8(*(const uint4*)(ptr + 8), b);
#pragma unroll
            for (int e = 0; e < 8; ++e) { const float x1 = a[e], x2 = b[e]; a[e] = x1 * cc[e] - x2 * sn[e]; b[e] = x2 * cc[e] + x1 * sn[e]; }
            *(uint4*)ptr = pack8(a); *(uint4*)(ptr + 8) = pack8(b);
        }
        {
            const bf16_t* ptr = p.proj + (size_t)gi * PLD + KVC + (sel ? 5 : 3) * 128 + hk * 64;
            bf16_t* vt = vtile + (size_t)((sel * 2 + hk) * 64) * 72 + tok;
            unpack8(*(const uint4*)ptr, a); unpack8(*(const uint4*)(ptr + 8), b);
#pragma unroll
            for (int e = 0; e < 8; ++e) { const float x1 = a[e], x2 = b[e]; a[e] = x1 * cc[e] - x2 * sn[e]; b[e] = x2 * cc[e] + x1 * sn[e]; }
#pragma unroll
            for (int e = 0; e < 8; ++e) { vt[e * 72] = f2bf(a[e]); vt[(8 + e) * 72] = f2bf(b[e]); }
#pragma unroll
            for (int q = 2; q < 8; ++q) {
                const uint4 u = *(const uint4*)(ptr + q * 8);
                const unsigned w[4] = {u.x, u.y, u.z, u.w};
#pragma unroll
                for (int e = 0; e < 4; ++e) { vt[(q * 8 + 2 * e) * 72] = (bf16_t)(w[e] & 0xffffu); vt[(q * 8 + 2 * e + 1) * 72] = (bf16_t)(w[e] >> 16); }
            }
        }
    }
    __syncthreads();
    const int b = tt0 >> 14, s0 = tt0 & (S_ - 1);
#pragma unroll
    for (int i = 0; i < 8; ++i) {
        const int c = tid + i * 256, grp = c >> 9, d = (c >> 3) & 63, ch = c & 7, sel = grp >> 1, hk = grp & 1;
        const uint4 u = *(const uint4*)&vtile[(size_t)(grp * 64 + d) * 72 + ch * 8];
        *(uint4*)(p.vT + ((size_t)((sel * 4 + b * 2 + hk) * 64 + d)) * S_ + s0 + ch * 8) = u;
    }
}

DI void phase2(const P& p, char* smem) {
    for (int it = blockIdx.x; it < 128 + 512 + 1024; it += gridDim.x) {
        if (it < 128) {
            const int kv = it >> 6, bhk = (it >> 4) & 3, mt = (it >> 1) & 7, nt = it & 1, b = bhk >> 1, hk = bhk & 1;
            AFCmp af{p.proj + (size_t)(b * S_) * PLD + KVC + kv * 128 + hk * 64};
            EpiHid ep{p.hid + (size_t)((kv * 4 + bhk) * 1024) * 256, p.b1p + kv * 256};
            gemm_tile<1>(af, p.w1T + (size_t)(kv * 256 + nt * 128) * 2048, 2048, mt * 128, nt * 128, ep, smem);
        } else if (it < 640) rope_item(p, it - 128, smem);
        else rwkv_prep(p, it - 640, smem);
    }
}
DI void phase3(const P& p, char* smem) {
    for (int it = blockIdx.x; it < 64; it += gridDim.x) {
        const int kv = it >> 5, bhk = (it >> 3) & 3, mt = it & 7, b = bhk >> 1;
        AFPlain af{p.hid + (size_t)((kv * 4 + bhk) * 1024) * 256, 256};
        if (kv == 0) { EpiKc ep{p.kc + (size_t)bhk * 1024 * 64, p.cosT, p.sinT, b * S_}; gemm_tile<1>(af, p.wc2T, 256, mt * 128, 0, ep, smem); }
        else { EpiVc ep{p.vcT + (size_t)bhk * 64 * 1024, smem}; gemm_tile<1>(af, p.wc2T + 128 * 256, 256, mt * 128, 0, ep, smem); }
    }
}

template <int CTRL> DI float dpp_add(float x) { return x + __int_as_float(__builtin_amdgcn_mov_dpp(__float_as_int(x), CTRL, 0xF, 0xF, true)); }
DI float red16(float x) { x = dpp_add<0xB1>(x); x = dpp_add<0x4E>(x); x = dpp_add<0x141>(x); x = dpp_add<0x140>(x); return x; }

DI void cvt_store(const uint4 u, const bool isom, float* d) {
    float f0 = bflo(u.x), f1 = bfhi(u.x), f2 = bflo(u.y), f3 = bfhi(u.y), f4 = bflo(u.z), f5 = bfhi(u.z), f6 = bflo(u.w), f7 = bfhi(u.w);
    if (isom) { f0 = 1.f - f0; f1 = 1.f - f1; f2 = 1.f - f2; f3 = 1.f - f3; f4 = 1.f - f4; f5 = 1.f - f5; f6 = 1.f - f6; f7 = 1.f - f7; }
    *(float4*)d = make_float4(f0, f1, f2, f3); *(float4*)(d + 4) = make_float4(f4, f5, f6, f7);
}
DI void scan_unit(const P& p, int su, char* smem) {
    const int xcd = su & 7, kq = su >> 3, bh = xcd * 2 + (kq >> 3), oct = kq & 7, b = bh >> 3, h = bh & 7;
    const int tid = tidx(), wave = tid >> 6, lane = tid & 63;
    float* buf = (float*)smem;
    float* ypb = (float*)(smem + 49152);
    const bf16_t* sbase = p.stream + (size_t)bh * S_ * 384;
    __syncthreads();
#pragma unroll
    for (int i = 0; i < 3; ++i) { const int ci = tid + i * 256; cvt_store(*(const uint4*)(sbase + (size_t)ci * 8), (ci % 48) < 8, buf + ci * 8); }
    __syncthreads();
    if (wave < 2) {
        const int rl = lane >> 4, ks = lane & 15, row = oct * 8 + wave * 4 + rl;
        f2_t sA = {0.f, 0.f}, sB = {0.f, 0.f};
        __builtin_amdgcn_s_setprio(3);
        for (int c = 0; c < 1024; ++c) {
            const float* cb = buf + (c & 1) * 6144 + ks * 4;
            const float* vb = buf + (c & 1) * 6144 + 320 + row;
            float* yo = ypb + ((c & 1) * 2 + wave) * 1024 + lane;
            float4 dec = *(const float4*)(cb), km = *(const float4*)(cb + 64), kk = *(const float4*)(cb + 128), bb = *(const float4*)(cb + 192), rv = *(const float4*)(cb + 256);
            float v = vb[0];
#pragma unroll
            for (int st = 0; st < 16; ++st) {
                float4 ndec = dec, nkm = km, nkk = kk, nbb = bb, nrv = rv; float nv = v;
                if (st < 15) {
                    const float* rec = cb + (st + 1) * 384;
                    ndec = *(const float4*)(rec); nkm = *(const float4*)(rec + 64); nkk = *(const float4*)(rec + 128); nbb = *(const float4*)(rec + 192); nrv = *(const float4*)(rec + 256);
                    nv = vb[(st + 1) * 384];
                }
                const f2_t vv = {v, v};
                const f2_t d01 = {dec.x, dec.y}, d23 = {dec.z, dec.w}, m01 = {km.x, km.y}, m23 = {km.z, km.w};
                const f2_t k01 = {kk.x, kk.y}, k23 = {kk.z, kk.w}, b01 = {bb.x, bb.y}, b23 = {bb.z, bb.w}, r01 = {rv.x, rv.y}, r23 = {rv.z, rv.w};
                const f2_t tA = sA * d01 + vv * m01, tB = sB * d23 + vv * m23;
                f2_t pa = sA * k01; pa = sB * k23 + pa;
                const float sa = red16(pa.x + pa.y);
                const f2_t sav = {sa, sa};
                sA = tA - sav * b01; sB = tB - sav * b23;
                f2_t ya = sA * r01; ya = sB * r23 + ya;
                yo[st * 64] = ya.x + ya.y;
                dec = ndec; km = nkm; kk = nkk; bb = nbb; rv = nrv; v = nv;
            }
            __syncthreads();
        }
        __builtin_amdgcn_s_setprio(0);
    } else {
        const int ht = tid - 128;
        const int ystep = ht >> 3, r8 = ht & 7;
        float* yout = p.yraw + (size_t)(b * S_) * 512 + h * 64 + oct * 8 + r8;
        const float* ysrc = ypb + (r8 >> 2) * 1024 + ystep * 64 + (r8 & 3) * 16;
        uint4 ra0, ra1, ra2, ra3, ra4, ra5, rb0, rb1, rb2, rb3, rb4, rb5;
#define SLOAD(R, CH) { const bf16_t* sp_ = sbase + (size_t)(CH) * 6144 + (size_t)ht * 8; \
        R##0 = *(const uint4*)(sp_); R##1 = *(const uint4*)(sp_ + 1024); R##2 = *(const uint4*)(sp_ + 2048); R##3 = *(const uint4*)(sp_ + 3072); R##4 = *(const uint4*)(sp_ + 4096); R##5 = *(const uint4*)(sp_ + 5120); }
#define SSTORE(R, BI) { float* d_ = buf + (BI) * 6144 + ht * 8; const bool om_ = (ht % 48) < 8; \
        cvt_store(R##0, om_, d_); cvt_store(R##1, ((ht + 128) % 48) < 8, d_ + 1024); cvt_store(R##2, ((ht + 256) % 48) < 8, d_ + 2048); \
        cvt_store(R##3, ((ht + 384) % 48) < 8, d_ + 3072); cvt_store(R##4, ((ht + 512) % 48) < 8, d_ + 4096); cvt_store(R##5, ((ht + 640) % 48) < 8, d_ + 5120); }
#define YRED(C) { const float* ys_ = ysrc + ((C) & 1) * 2048; const float4 a_ = *(const float4*)ys_, b_ = *(const float4*)(ys_ + 4), c_ = *(const float4*)(ys_ + 8), d_ = *(const float4*)(ys_ + 12); \
        yout[(size_t)((C) * 16 + ystep) * 512] = ((a_.x + a_.y) + (a_.z + a_.w)) + ((b_.x + b_.y) + (b_.z + b_.w)) + ((c_.x + c_.y) + (c_.z + c_.w)) + ((d_.x + d_.y) + (d_.z + d_.w)); }
        SLOAD(ra, 1)
        for (int c = 0; c < 1024; c += 2) {
            if (c + 2 < 1024) SLOAD(rb, c + 2)
            SSTORE(ra, 1)
            if (c >= 1) YRED(c - 1)
            __syncthreads();
            if (c + 3 < 1024) SLOAD(ra, c + 3)
            if (c + 2 < 1024) SSTORE(rb, 0)
            YRED(c)
            __syncthreads();
        }
        YRED(1023)
#undef SLOAD
#undef SSTORE
#undef YRED
    }
}

struct AttnSmem {
    bf16_t k[64 * 72];
    bf16_t vt[64 * 68];
    float imp[32 * 256];
    unsigned selbits[32 * 8];
    unsigned wunion[4 * 8];
    unsigned bunion[8];
    int unit;
    int pad_[3];
    uint4 q[4 * 4 * 64];
};

#define ATTN_LOAD(KBASE, KSTRIDE, VTBASE, VTSTRIDE, NEEDV) { \
    rk0 = *(const uint4*)((KBASE) + (size_t)(tid >> 3) * (KSTRIDE) + (tid & 7) * 8); \
    rk1 = *(const uint4*)((KBASE) + (size_t)((tid >> 3) + 32) * (KSTRIDE) + (tid & 7) * 8); \
    if (NEEDV) { rv0 = *(const uint4*)((VTBASE) + (size_t)(tid >> 3) * (VTSTRIDE) + (tid & 7) * 8); \
                 rv1 = *(const uint4*)((VTBASE) + (size_t)((tid >> 3) + 32) * (VTSTRIDE) + (tid & 7) * 8); } }
#define ATTN_STORE(NEEDV) { \
    *(uint4*)&sm.k[(tid >> 3) * 72 + (tid & 7) * 8] = rk0; *(uint4*)&sm.k[((tid >> 3) + 32) * 72 + (tid & 7) * 8] = rk1; \
    if (NEEDV) { bf16_t* d0_ = &sm.vt[(tid >> 3) * 68 + (tid & 7) * 8]; bf16_t* d1_ = &sm.vt[((tid >> 3) + 32) * 68 + (tid & 7) * 8]; \
        *(uint2*)d0_ = make_uint2(rv0.x, rv0.y); *(uint2*)(d0_ + 4) = make_uint2(rv0.z, rv0.w); \
        *(uint2*)d1_ = make_uint2(rv1.x, rv1.y); *(uint2*)(d1_ + 4) = make_uint2(rv1.z, rv1.w); } }

template <int MODE, bool EM>
DI void attn_tile(AttnSmem& sm, const uint4* qs, f32x16 (&o)[2], float& m, float& l, const float inv_l, const int lo, const int hi, const bool lane_on,
                  const int lane, const int tokl, const int jbase) {
    const int rr = lane & 31, hh = lane >> 5;
    f32x16 s[2];
#pragma unroll
    for (int mt = 0; mt < 2; ++mt) {
#pragma unroll
        for (int i = 0; i < 16; ++i) s[mt][i] = 0.f;
#pragma unroll
        for (int ks = 0; ks < 4; ++ks) {
            const bf16x8 kf = *(const bf16x8*)&sm.k[(mt * 32 + rr) * 72 + ks * 16 + hh * 8];
            const bf16x8 qv = __builtin_bit_cast(bf16x8, qs[ks * 64]);
            s[mt] = MFMA32(kf, qv, s[mt]);
        }
        asm volatile("" ::: "memory");
    }
    float mx = -1e30f;
    if (EM) {
        const int lo2 = lo - 4 * hh, hi2 = hi - 4 * hh;
#pragma unroll
        for (int mt = 0; mt < 2; ++mt)
#pragma unroll
            for (int i = 0; i < 16; ++i) {
                const int kc_ = mt * 32 + (i & 3) + 8 * (i >> 2);
                float v = s[mt][i];
                v = (kc_ >= lo2 && kc_ <= hi2) ? v : -1e30f;
                s[mt][i] = v; mx = fmaxf(mx, v);
            }
    } else {
#pragma unroll
        for (int mt = 0; mt < 2; ++mt)
#pragma unroll
            for (int i = 0; i < 16; ++i) mx = fmaxf(mx, s[mt][i]);
        mx = lane_on ? mx : -1e30f;
    }
    float mref = m;
    if (MODE != 2) {
        mx = fmaxf(mx, __shfl_xor(mx, 32));
        const float mnew = fmaxf(m, mx);
        const float alpha = __builtin_amdgcn_exp2f(m - mnew);
        m = mnew; mref = mnew;
        l *= alpha;
        if (MODE == 1) {
#pragma unroll
            for (int dt = 0; dt < 2; ++dt)
#pragma unroll
                for (int i = 0; i < 16; ++i) o[dt][i] *= alpha;
        }
    }
    if (!EM) mref = lane_on ? mref : 1e30f;
    float psum = 0.f;
#pragma unroll
    for (int mt = 0; mt < 2; ++mt)
#pragma unroll
        for (int i = 0; i < 16; ++i) {
            const float v = s[mt][i];
            float pv;
            if (EM) pv = (v > -1e29f) ? __builtin_amdgcn_exp2f(v - mref) : 0.f;
            else pv = __builtin_amdgcn_exp2f(v - mref);
            if (MODE == 2) pv *= inv_l;
            s[mt][i] = pv; psum += pv;
        }
    if (MODE != 2) l += psum;
    if (MODE == 0) return;
    if (MODE == 2) {
#pragma unroll
        for (int mt = 0; mt < 2; ++mt)
#pragma unroll
            for (int jj = 0; jj < 4; ++jj) {
                float q4 = (s[mt][4 * jj] + s[mt][4 * jj + 1]) + (s[mt][4 * jj + 2] + s[mt][4 * jj + 3]);
                float e3 = s[mt][4 * jj + 3];
                q4 += __shfl_xor(q4, 1); q4 += __shfl_xor(q4, 2);
                e3 += __shfl_xor(e3, 1); e3 += __shfl_xor(e3, 2);
                if ((rr & 3) == 0) {
                    const int j = jbase + mt * 8 + 2 * jj + hh;
                    atomicAdd(&sm.imp[tokl * 256 + j], q4);
                    if (j + 1 < 256) atomicAdd(&sm.imp[tokl * 256 + j + 1], e3);
                }
            }
    }
#pragma unroll
    for (int mt = 0; mt < 2; ++mt)
#pragma unroll
        for (int s2 = 0; s2 < 2; ++s2) {
            uint4 pu;
            pu.x = pack2(s[mt][8 * s2 + 0], s[mt][8 * s2 + 1]); pu.y = pack2(s[mt][8 * s2 + 2], s[mt][8 * s2 + 3]);
            pu.z = pack2(s[mt][8 * s2 + 4], s[mt][8 * s2 + 5]); pu.w = pack2(s[mt][8 * s2 + 6], s[mt][8 * s2 + 7]);
            const bf16x8 pf = __builtin_bit_cast(bf16x8, pu);
            asm volatile("" ::: "memory");
#pragma unroll
            for (int dt = 0; dt < 2; ++dt) {
                const bf16_t* vp = &sm.vt[(dt * 32 + rr) * 68 + mt * 32 + s2 * 16 + hh * 4];
                const uint2 v0 = *(const uint2*)vp, v1 = *(const uint2*)(vp + 8);
                const bf16x8 vf = __builtin_bit_cast(bf16x8, make_uint4(v0.x, v0.y, v1.x, v1.y));
                o[dt] = MFMA32(vf, pf, o[dt]);
            }
        }
}

DI unsigned wave_umax(unsigned v) {
#pragma unroll
    for (int o = 32; o; o >>= 1) { const unsigned t = (unsigned)__shfl_xor((int)v, o); v = v > t ? v : t; }
    return v;
}

DI void attn_unit(const P& p, int u, char* smem) {
    AttnSmem& sm = *(AttnSmem*)smem;
    const int tid = tidx(), wave = tid >> 6, lane = tid & 63, rr = lane & 31, hh = lane >> 5;
    const int tile = 511 - (u >> 2), bhk = u & 3, b = bhk >> 1, hk = bhk & 1, t0 = tile * 32;
    const int tokl = wave * 8 + (rr >> 2), t = t0 + tokl, g = rr & 3, head = hk * 4 + g;
    const size_t tokg = (size_t)b * S_ + t;
    uint4* qs = &sm.q[wave * 256 + lane];
#pragma unroll
    for (int ks = 0; ks < 4; ++ks) qs[ks * 64] = *(const uint4*)(p.proj + tokg * PLD + QC + head * 64 + ks * 16 + hh * 8);
#define GATE(i) sigmoidf_(__uint_as_float((unsigned)p.proj[((size_t)b * S_ + t) * PLD + GC + head * 3 + (i)] << 16))
#pragma unroll
    for (int i = 0; i < 8; ++i) *(float4*)&sm.imp[(tid + i * 256) * 4] = make_float4(0.f, 0.f, 0.f, 0.f);
    sm.selbits[tid] = 0u;
    f32x16 o[2];
#pragma unroll
    for (int dt = 0; dt < 2; ++dt)
#pragma unroll
        for (int i = 0; i < 16; ++i) o[dt][i] = 0.f;
    float* park = &sm.imp[wave * 2048 + lane];
    uint4 rk0, rk1, rv0 = make_uint4(0, 0, 0, 0), rv1 = make_uint4(0, 0, 0, 0);
    const int ntc = (t0 >> 10) + 1;
    const int vmaxi = (t >= 31) ? ((t - 31) >> 4) : -1;
    const int twmin = t0 + wave * 8;
    const int wvmin = (twmin >= 31) ? ((twmin - 31) >> 4) : -1;
    const bf16_t* kcb = p.kc + (size_t)bhk * 1024 * 64;
    const bf16_t* vcb = p.vcT + (size_t)bhk * 64 * 1024;
    float m = -1e30f, l = 0.f;
    ATTN_LOAD(kcb, 64, vcb, 1024, false)
    for (int j = 0; j < ntc; ++j) {
        __syncthreads();
        ATTN_STORE(false)
        __syncthreads();
        if (j + 1 < ntc) ATTN_LOAD(kcb + (size_t)(j + 1) * 64 * 64, 64, vcb, 1024, false)
        if (j * 64 + 63 <= wvmin) attn_tile<0, false>(sm, qs, o, m, l, 0.f, 0, 0, true, lane, tokl, 0);
        else attn_tile<0, true>(sm, qs, o, m, l, 0.f, 0, vmaxi - j * 64, true, lane, tokl, 0);
    }
    {
        const float lt = l + __shfl_xor(l, 32);
        const float inv_l = lt > 0.f ? 1.f / lt : 0.f;
        ATTN_LOAD(kcb, 64, vcb, 1024, true)
        for (int j = 0; j < ntc; ++j) {
            __syncthreads();
            ATTN_STORE(true)
            __syncthreads();
            if (j + 1 < ntc) ATTN_LOAD(kcb + (size_t)(j + 1) * 64 * 64, 64, vcb + (j + 1) * 64, 1024, true)
            if (j * 64 + 63 <= wvmin) attn_tile<2, false>(sm, qs, o, m, l, inv_l, 0, 0, true, lane, tokl, j * 16);
            else attn_tile<2, true>(sm, qs, o, m, l, inv_l, 0, vmaxi - j * 64, true, lane, tokl, j * 16);
        }
    }
    __syncthreads();
    const int cur = t0 >> 6;
    for (int tk = 0; tk < 8; ++tk) {
        const int tl = wave * 8 + tk;
        const float* ip = &sm.imp[tl * 256];
        unsigned nib = 0u;
        if (cur <= 15) {
#pragma unroll
            for (int e = 0; e < 4; ++e) if (lane * 4 + e <= cur) nib |= 1u << e;
        } else {
            unsigned k0, k1, k2, k3;
            {
                const float4 iv = *(const float4*)(ip + lane * 4);
                const int j0 = lane * 4;
                k0 = (j0 >= 1 && j0 <= cur - 2) ? ((__float_as_uint(iv.x) & 0xFFFFFF00u) | (unsigned)(255 - j0)) : 0u;
                k1 = (j0 + 1 <= cur - 2) ? ((__float_as_uint(iv.y) & 0xFFFFFF00u) | (unsigned)(254 - j0)) : 0u;
                k2 = (j0 + 2 <= cur - 2) ? ((__float_as_uint(iv.z) & 0xFFFFFF00u) | (unsigned)(253 - j0)) : 0u;
                k3 = (j0 + 3 <= cur - 2) ? ((__float_as_uint(iv.w) & 0xFFFFFF00u) | (unsigned)(252 - j0)) : 0u;
#pragma unroll
                for (int e = 0; e < 4; ++e) { const int j = j0 + e; if (j == 0 || j == cur || j == cur - 1) nib |= 1u << e; }
            }
            for (int r = 0; r < 13; ++r) {
                unsigned lm = k0 > k1 ? k0 : k1; const unsigned lm2 = k2 > k3 ? k2 : k3; lm = lm > lm2 ? lm : lm2;
                const unsigned wm = wave_umax(lm);
                if (k0 == wm) { k0 = 0u; nib |= 1u; }
                if (k1 == wm) { k1 = 0u; nib |= 2u; }
                if (k2 == wm) { k2 = 0u; nib |= 4u; }
                if (k3 == wm) { k3 = 0u; nib |= 8u; }
            }
        }
        atomicOr(&sm.selbits[tl * 8 + (lane >> 3)], nib << ((lane & 7) * 4));
    }
    __syncthreads();
    if (tid < 32) {
        const int w = tid >> 3, d = tid & 7; unsigned uu = 0u;
#pragma unroll
        for (int k = 0; k < 8; ++k) uu |= sm.selbits[(w * 8 + k) * 8 + d];
        sm.wunion[w * 8 + d] = uu;
    }
    __syncthreads();
    if (tid < 8) sm.bunion[tid] = sm.wunion[tid] | sm.wunion[8 + tid] | sm.wunion[16 + tid] | sm.wunion[24 + tid];
    __syncthreads();
    {
        const float g0 = GATE(0);
#pragma unroll
        for (int dt = 0; dt < 2; ++dt)
#pragma unroll
            for (int i = 0; i < 16; ++i) { park[(dt * 16 + i) * 64] = g0 * o[dt][i]; o[dt][i] = 0.f; }
    }
    {
        const bf16_t* kb = p.proj + (size_t)(b * S_) * PLD + KVC + 2 * 128 + hk * 64;
        const bf16_t* vb = p.vT + (size_t)((0 * 4 + bhk) * 64) * S_;
        m = -1e30f; l = 0.f;
        auto nextj = [&](int j) -> int {
            ++j;
            while (j <= cur) {
                const unsigned w = sm.bunion[j >> 5] >> (j & 31);
                if (w) { j += __ffs((int)w) - 1; return j <= cur ? j : -1; }
                j = (j | 31) + 1;
            }
            return -1;
        };
        int j = nextj(-1);
        if (j >= 0) ATTN_LOAD(kb + (size_t)j * 64 * PLD, PLD, vb + j * 64, S_, true)
        while (j >= 0) {
            __syncthreads();
            ATTN_STORE(true)
            __syncthreads();
            const int jn = nextj(j);
            if (jn >= 0) ATTN_LOAD(kb + (size_t)jn * 64 * PLD, PLD, vb + jn * 64, S_, true)
            if ((sm.wunion[wave * 8 + (j >> 5)] >> (j & 31)) & 1u) {
                const bool selme = (sm.selbits[tokl * 8 + (j >> 5)] >> (j & 31)) & 1u;
                if (j < cur) attn_tile<1, false>(sm, qs, o, m, l, 0.f, 0, 0, selme, lane, tokl, 0);
                else attn_tile<1, true>(sm, qs, o, m, l, 0.f, 0, selme ? t - j * 64 : -1, true, lane, tokl, 0);
            }
            j = jn;
        }
        const float lt = l + __shfl_xor(l, 32);
        const float sc = lt > 0.f ? GATE(1) / lt : 0.f;
#pragma unroll
        for (int dt = 0; dt < 2; ++dt)
#pragma unroll
            for (int i = 0; i < 16; ++i) { park[(dt * 16 + i) * 64] += sc * o[dt][i]; o[dt][i] = 0.f; }
    }
    {
        const bf16_t* kb = p.proj + (size_t)(b * S_) * PLD + KVC + 4 * 128 + hk * 64;
        const bf16_t* vb = p.vT + (size_t)((1 * 4 + bhk) * 64) * S_;
        m = -1e30f; l = 0.f;
        const int jlo = (t0 >= 511) ? ((t0 - 511) >> 6) : 0, jhi = t0 >> 6;
        ATTN_LOAD(kb + (size_t)jlo * 64 * PLD, PLD, vb + jlo * 64, S_, true)
        for (int j = jlo; j <= jhi; ++j) {
            __syncthreads();
            ATTN_STORE(true)
            __syncthreads();
            if (j + 1 <= jhi) ATTN_LOAD(kb + (size_t)(j + 1) * 64 * PLD, PLD, vb + (j + 1) * 64, S_, true)
            if (j * 64 >= twmin + 7 - 511 && j * 64 + 63 <= twmin) attn_tile<1, false>(sm, qs, o, m, l, 0.f, 0, 0, true, lane, tokl, 0);
            else attn_tile<1, true>(sm, qs, o, m, l, 0.f, t - 511 - j * 64, t - j * 64, true, lane, tokl, 0);
        }
        const float lt = l + __shfl_xor(l, 32);
        const float sc = lt > 0.f ? GATE(2) / lt : 0.f;
#pragma unroll
        for (int dt = 0; dt < 2; ++dt)
#pragma unroll
            for (int i = 0; i < 16; ++i) o[dt][i] = park[(dt * 16 + i) * 64] + sc * o[dt][i];
    }
    bf16_t* mp = p.A + tokg * 1024 + 512 + head * 64;
#pragma unroll
    for (int dt = 0; dt < 2; ++dt)
#pragma unroll
        for (int jj = 0; jj < 4; ++jj) {
            uint2 ov; ov.x = pack2(o[dt][4 * jj], o[dt][4 * jj + 1]); ov.y = pack2(o[dt][4 * jj + 2], o[dt][4 * jj + 3]);
            *(uint2*)(mp + dt * 32 + jj * 8 + hh * 4) = ov;
        }
}

DI void phase4(const P& p, char* smem) {
    for (int su = blockIdx.x; su < 128; su += gridDim.x) scan_unit(p, su, smem);
    AttnSmem& sm = *(AttnSmem*)smem;
    while (true) {
        __syncthreads();
        if (tidx() == 0) sm.unit = (int)atomicAdd(p.counter, 1u);
        __syncthreads();
        const int u = sm.unit;
        if (u >= 2048) break;
        attn_unit(p, u, smem);
    }
}

DI void phase4b(const P& p) {
    const int tid = tidx();
    for (int it = blockIdx.x; it < T_ / 4; it += gridDim.x) {
        const int gi = it * 4 + (tid >> 6), cgp = tid & 63, h = cgp >> 3, c8 = (cgp & 7) * 8, col = cgp * 8, b = gi >> 14, s = gi & (S_ - 1);
        const float4 y0 = *(const float4*)(p.yraw + (size_t)gi * 512 + col), y1 = *(const float4*)(p.yraw + (size_t)gi * 512 + col + 4);
        float y[8] = {y0.x, y0.y, y0.z, y0.w, y1.x, y1.y, y1.z, y1.w};
        const bf16_t* sp = p.stream + ((size_t)((b * 8 + h) * S_ + s) * 6) * 64 + c8;
        float km[8], r[8], v[8], gg[8];
        unpack8(*(const uint4*)(sp + 64), km); unpack8(*(const uint4*)(sp + 256), r); unpack8(*(const uint4*)(sp + 320), v);
        unpack8(*(const uint4*)(p.gbuf + (size_t)gi * 512 + col), gg);
        float sum = 0.f, bon = 0.f;
#pragma unroll
        for (int e = 0; e < 8; ++e) { sum += y[e]; bon += r[e] * km[e] * p.r_k[col + e]; }
        sum += __shfl_xor(sum, 1); sum += __shfl_xor(sum, 2); sum += __shfl_xor(sum, 4);
        bon += __shfl_xor(bon, 1); bon += __shfl_xor(bon, 2); bon += __shfl_xor(bon, 4);
        const float mean = sum * (1.f / 64.f);
        float var = 0.f;
#pragma unroll
        for (int e = 0; e < 8; ++e) { y[e] -= mean; var += y[e] * y[e]; }
        var += __shfl_xor(var, 1); var += __shfl_xor(var, 2); var += __shfl_xor(var, 4);
        const float rs = rsqrtf(var * (1.f / 64.f) + 64e-5f);
        float o[8];
#pragma unroll
        for (int e = 0; e < 8; ++e) o[e] = (y[e] * rs * p.lnx_w[col + e] + p.lnx_b[col + e] + bon * v[e]) * gg[e];
        *(uint4*)(p.A + (size_t)gi * 1024 + col) = pack8(o);
    }
}

struct EpiFfn2 {
    float* out;
    DI void operator()(const f32x16 (&acc)[2][2], int rowbase, int colbase, int lane) const {
        const int rr = lane & 31, hh = lane >> 5;
#pragma unroll
        for (int w = 0; w < 2; ++w)
#pragma unroll
            for (int t = 0; t < 2; ++t)
#pragma unroll
                for (int j = 0; j < 4; ++j) {
                    float4* o = (float4*)(out + (size_t)(rowbase + t * 32 + rr) * 1024 + colbase + w * 32 + j * 8 + hh * 4);
                    float4 xv = *o;
                    xv.x += acc[w][t][4 * j]; xv.y += acc[w][t][4 * j + 1]; xv.z += acc[w][t][4 * j + 2]; xv.w += acc[w][t][4 * j + 3];
                    *o = xv;
                }
    }
};

DI void final_item(float* io, const float* g, int idx) {
    const int row = idx * 4 + (tidx() >> 6), lane = tidx() & 63;
    float4* sp = (float4*)(io + (size_t)row * 1024);
    float4 v[4]; float ss = 0.f;
#pragma unroll
    for (int i = 0; i < 4; ++i) { v[i] = sp[lane + 64 * i]; ss += v[i].x * v[i].x + v[i].y * v[i].y + v[i].z * v[i].z + v[i].w * v[i].w; }
    ss = wave_sum(ss);
    const float rs = rsqrtf(ss * (1.f / 1024.f) + 1e-6f);
#pragma unroll
    for (int i = 0; i < 4; ++i) {
        const float4 gv = ((const float4*)g)[lane + 64 * i];
        sp[lane + 64 * i] = make_float4(v[i].x * rs * gv.x, v[i].y * rs * gv.y, v[i].z * rs * gv.z, v[i].w * rs * gv.w);
    }
}

DI bool gemm_order(const int round, const int NT, int& mt, int& nt) {
    if (gridDim.x == 512) {
        const int xcd = blockIdx.x & 7, lb = blockIdx.x >> 3;
        const int q = round * 64 + lb;
        if (q >= 32 * NT) return false;
        mt = xcd * 32 + (q / (8 * NT)) * 8 + (q & 7);
        nt = (q >> 3) % NT;
        return true;
    }
    const int it = round * gridDim.x + blockIdx.x;
    if (it >= 256 * NT) return false;
    mt = it / NT; nt = it - mt * NT;
    return true;
}

DI void run_phase(const P& p, int ph, char* smem) {
    switch (ph) {
    case 0: phase0(p, smem); break;
    case 1:
        for (int rd = 0;; ++rd) {
            int mt, nt; if (!gemm_order(rd, 25, mt, nt)) break;
            gemm_tile<8>(AFPlain{p.A, 1024}, p.WinT + (size_t)nt * 128 * 1024, 1024, mt * 128, nt * 128, EpiProj{p.proj}, smem);
        }
        break;
    case 2: phase2(p, smem); break;
    case 3: phase3(p, smem); break;
    case 4: phase4(p, smem); break;
    case 5: phase4b(p); break;
    case 6:
        for (int rd = 0;; ++rd) {
            int mt, nt; if (!gemm_order(rd, 8, mt, nt)) break;
            gemm_tile<8>(AFPlain{p.A, 1024}, p.WoutT + (size_t)nt * 128 * 1024, 1024, mt * 128, nt * 128, EpiOut{p.out, p.x}, smem);
        }
        break;
    case 7:
        for (int it = blockIdx.x; it < T_ / 4; it += gridDim.x) rms_item(p.out, p.norm_ffn, p.A, it);
        break;
    case 8:
        for (int rd = 0;; ++rd) {
            int mt, nt; if (!gemm_order(rd, 44, mt, nt)) break;
            gemm_tile<8>(AFPlain{p.A, 1024}, p.WguT + (size_t)nt * 128 * 1024, 1024, mt * 128, nt * 128, EpiFfn1{p.stream}, smem);
        }
        break;
    case 9:
        for (int rd = 0;; ++rd) {
            int mt, nt; if (!gemm_order(rd, 8, mt, nt)) break;
            gemm_tile<1>(AFPlain{p.stream, DFF}, p.WdnT + (size_t)nt * 128 * DFF, DFF, mt * 128, nt * 128, EpiFfn2{p.out}, smem);
        }
        break;
    default:
        for (int it = blockIdx.x; it < T_ / 4; it += gridDim.x) final_item(p.out, p.norm_final, it);
        break;
    }
}
constexpr int NPHASE = 11;
constexpr int SMEM_BYTES = 73728;


#define XB_TMO      128
#define XB_XCNT(j)  (256  + 64 * (j))
#define XB_XSUB(j)  (1280 + 64 * (j))
#define XB_XGEN(j)  (2304 + 64 * (j))
#define XB_TOP      3328
#define XB_TOPGEN   3392
#define XCD_BAR_WORDS 3456
#define XB_SPIN_CAP (1u << 22)
#define LAS __attribute__((address_space(3)))
DI unsigned xb_ld(unsigned* p) { return __hip_atomic_load(p, __ATOMIC_RELAXED, __HIP_MEMORY_SCOPE_AGENT); }
DI unsigned xb_add(unsigned* p, unsigned v) { return __hip_atomic_fetch_add(p, v, __ATOMIC_RELAXED, __HIP_MEMORY_SCOPE_AGENT); }
DI unsigned xb_xcc_id() { return (unsigned)__builtin_amdgcn_s_getreg((3 << 11) | 20) & 0xFu; }
#define XB_SPIN(cond, bar) do { unsigned _sp = 0; while (cond) { __builtin_amdgcn_s_sleep(1); \
    if ((++_sp & 255u) == 0u) { if (xb_ld(&(bar)[XB_TMO])) break; if (_sp > XB_SPIN_CAP) { atomicAdd(&(bar)[XB_TMO], 1u); break; } } } } while (0)
struct XcdBarrier { unsigned* bar; unsigned x; volatile LAS unsigned* st; };
DI XcdBarrier xcd_barrier_post(unsigned* bar, volatile LAS unsigned* st) {
    XcdBarrier b; b.bar = bar; b.x = xb_xcc_id(); b.st = st;
    if (tidx() == 0) (void)xb_add(&bar[XB_XCNT(b.x)], 1u);
    return b;
}
DI void xcd_barrier_complete(unsigned* bar, unsigned x, unsigned& nloc, unsigned& nx) {
    const unsigned G = gridDim.x * gridDim.y * gridDim.z;
    unsigned sum, cnt, mine, sp = 0u;
    for (;;) {
        sum = 0u; cnt = 0u; mine = 0u;
#pragma unroll
        for (unsigned j = 0; j < 16; ++j) { const unsigned c = xb_ld(&bar[XB_XCNT(j)]); sum += c; cnt += (c > 0u) ? 1u : 0u; mine = (j == x) ? c : mine; }
        if (sum == G) break;
        __builtin_amdgcn_s_sleep(1);
        if ((++sp & 255u) == 0u) { if (xb_ld(&bar[XB_TMO])) break; if (sp > XB_SPIN_CAP) { atomicAdd(&bar[XB_TMO], 1u); break; } }
    }
    nloc = mine > 0u ? mine : 1u; nx = cnt > 0u ? cnt : 1u;
}
DI void xcd_barrier(const XcdBarrier& b) {
    asm volatile("s_waitcnt vmcnt(0)" ::: "memory");
    __syncthreads();
    if (tidx() == 0) {
        unsigned* bar = b.bar;
        __builtin_amdgcn_s_waitcnt(0);
        unsigned nloc = b.st[0], nx = b.st[1];
        if (nloc == 0u) { xcd_barrier_complete(bar, b.x, nloc, nx); b.st[0] = nloc; b.st[1] = nx; }
        const unsigned old = xb_add(&bar[XB_XSUB(b.x)], 1u);
        const unsigned gen = old / nloc;
        if (old + 1u == (gen + 1u) * nloc) {
            __builtin_amdgcn_fence(__ATOMIC_RELEASE, "agent");
            asm volatile("s_waitcnt vmcnt(0)" ::: "memory");
            const unsigned og = xb_add(&bar[XB_TOP], 1u);
            const unsigned tg = og / nx;
            if (og + 1u == (tg + 1u) * nx) xb_add(&bar[XB_TOPGEN], 1u);
            else XB_SPIN(xb_ld(&bar[XB_TOPGEN]) == tg, bar);
            __builtin_amdgcn_fence(__ATOMIC_ACQUIRE, "agent");
            xb_add(&bar[XB_XGEN(b.x)], 1u);
            asm volatile("s_waitcnt vmcnt(0)" ::: "memory");
        } else {
            XB_SPIN(xb_ld(&bar[XB_XGEN(b.x)]) == gen, bar);
            __builtin_amdgcn_fence(__ATOMIC_ACQUIRE, "agent");
            asm volatile("s_waitcnt vmcnt(0)" ::: "memory");
        }
    }
    __syncthreads();
}

__global__ void __launch_bounds__(NTHR, 2) mega_kernel(P p) {
    __shared__ __attribute__((aligned(16))) char smem[SMEM_BYTES];
    __shared__ uint4 xb_words;
    cg::grid_group grid = cg::this_grid();
    if (p.x == nullptr) grid.sync();
    if (tidx() == 0) xb_words = make_uint4(0u, 0u, 0u, 0u);
    __syncthreads();
    const XcdBarrier xb = xcd_barrier_post(p.bar, (volatile LAS unsigned*)&xb_words);
    run_phase(p, 0, smem); xcd_barrier(xb);
    run_phase(p, 1, smem); xcd_barrier(xb);
    run_phase(p, 2, smem); xcd_barrier(xb);
    run_phase(p, 3, smem); xcd_barrier(xb);
    run_phase(p, 4, smem); xcd_barrier(xb);
    run_phase(p, 5, smem); xcd_barrier(xb);
    run_phase(p, 6, smem); xcd_barrier(xb);
    run_phase(p, 7, smem); xcd_barrier(xb);
    run_phase(p, 8, smem); xcd_barrier(xb);
    run_phase(p, 9, smem); xcd_barrier(xb);
    run_phase(p, 10, smem);
}
__global__ void __launch_bounds__(NTHR, 2) phase_kernel(P p, int ph) {
    __shared__ __attribute__((aligned(16))) char smem[SMEM_BYTES];
    run_phase(p, ph, smem);
}

extern "C" void kernel_launch(void* const* d_in, const int* in_sizes, int n_in, void* d_out, int out_size, void* d_ws, size_t ws_size,
                              hipStream_t stream) {
    P p{};
    p.x = (const float*)d_in[0]; p.pos = (const int*)d_in[1]; p.norm_mix = (const float*)d_in[2]; p.w_in = (const float*)d_in[3];
    p.mu = (const float*)d_in[4]; p.w0 = (const float*)d_in[5]; p.w2 = (const float*)d_in[6]; p.a0 = (const float*)d_in[7];
    p.a2 = (const float*)d_in[8]; p.g2 = (const float*)d_in[9]; p.k_k = (const float*)d_in[10]; p.k_a = (const float*)d_in[11];
    p.r_k = (const float*)d_in[12]; p.lnx_w = (const float*)d_in[13]; p.lnx_b = (const float*)d_in[14]; p.pe_k = (const float*)d_in[15];
    p.wk1 = (const float*)d_in[16]; p.bk1 = (const float*)d_in[17]; p.wk2 = (const float*)d_in[18]; p.pe_v = (const float*)d_in[19];
    p.wv1 = (const float*)d_in[20]; p.bv1 = (const float*)d_in[21]; p.wv2 = (const float*)d_in[22]; p.w_out = (const float*)d_in[23];
    p.norm_ffn = (const float*)d_in[24]; p.w_gate = (const float*)d_in[25]; p.w_up = (const float*)d_in[26]; p.w_down = (const float*)d_in[27];
    p.norm_final = (const float*)d_in[28];
    p.out = (float*)d_out;
    char* ws = (char*)d_ws;
    size_t off = 0;
    auto take = [&](size_t bytes) { char* r = ws + off; off += (bytes + 255) & ~(size_t)255; return r; };
    p.WinT = (bf16_t*)take((size_t)3200 * 1024 * 2);
    p.WoutT = (bf16_t*)take((size_t)1024 * 1024 * 2);
    p.WguT = (bf16_t*)take((size_t)5632 * 1024 * 2);
    p.WdnT = (bf16_t*)take((size_t)1024 * DFF * 2);
    p.w2T = (bf16_t*)take(512 * 64 * 2);
    p.a2T = (bf16_t*)take(512 * 64 * 2);
    p.g2T = (bf16_t*)take(512 * 160 * 2);
    p.w1T = (bf16_t*)take((size_t)2 * 256 * 2048 * 2);
    p.wc2T = (bf16_t*)take(2 * 128 * 256 * 2);
    p.b1p = (float*)take(512 * 4);
    p.cosT = (float*)take((size_t)T_ * 8 * 4);
    p.sinT = (float*)take((size_t)T_ * 8 * 4);
    p.counter = (unsigned*)take(256);
    p.bar = (unsigned*)take(XCD_BAR_WORDS * 4);
    off = (size_t)32 << 20;
    p.A = (bf16_t*)take((size_t)T_ * 1024 * 2);
    p.proj = (bf16_t*)take((size_t)T_ * PLD * 2);
    p.stream = (bf16_t*)take((size_t)T_ * 8 * 384 * 2);
    if (off > ws_size) fprintf(stderr, "workspace too small: need %zu have %zu\n", off, ws_size);
    char* ob = (char*)d_out;
    p.gbuf = (bf16_t*)ob;
    p.yraw = (float*)(ob + ((size_t)32 << 20));
    p.vT = (bf16_t*)(ob + ((size_t)96 << 20));
    p.hid = (bf16_t*)(ob + ((size_t)112 << 20));
    p.kc = (bf16_t*)(ob + ((size_t)116 << 20));
    p.vcT = (bf16_t*)(ob + ((size_t)116 << 20) + (512 << 10));
#if MK_SINGLE
    static int grid_blocks = 0;
    if (!grid_blocks) {
        int dev = 0, cus = 0, per_cu = 0;
        hipGetDevice(&dev);
        hipDeviceGetAttribute(&cus, hipDeviceAttributeMultiprocessorCount, dev);
        hipOccupancyMaxActiveBlocksPerMultiprocessor(&per_cu, mega_kernel, NTHR, 0);
        if (per_cu > 2) per_cu = 2;
        if (per_cu < 1) per_cu = 1;
        grid_blocks = cus * per_cu;
    }
    (void)hipMemsetAsync(p.bar, 0, XCD_BAR_WORDS * 4, stream);
    void* args[] = {&p};
    hipError_t e = hipLaunchCooperativeKernel((void*)mega_kernel, dim3(grid_blocks), dim3(NTHR), args, 0, stream);
    if (e != hipSuccess) fprintf(stderr, "cooperative launch failed: %s (grid %d)\n", hipGetErrorString(e), grid_blocks);
#else
    for (int ph = 0; ph < NPHASE; ++ph) phase_kernel<<<512, NTHR, 0, stream>>>(p, ph);
#endif
}
```

```cpp
#include <hip/hip_runtime.h>
#include <hip/hip_cooperative_groups.h>
#include <cstdio>
namespace cg = cooperative_groups;

#ifndef MK_SINGLE
#define MK_SINGLE 1
#endif

#define DI __device__ __forceinline__
typedef unsigned short bf16_t;
typedef short bf16x8 __attribute__((ext_vector_type(8)));
typedef float f32x16 __attribute__((ext_vector_type(16)));
typedef __bf16 bf2_t __attribute__((ext_vector_type(2)));
typedef float f2_t __attribute__((ext_vector_type(2)));

constexpr int T_ = 32768, S_ = 16384;
constexpr int PLD = 3200;
constexpr int QC = 1856, KVC = 2368, GC = 3136;
constexpr int DFF = 2816;
constexpr int NTHR = 256;
constexpr float QSC = 0.125f * 1.4426950408889634f;

#define MFMA32(a, b, c) __builtin_amdgcn_mfma_f32_32x32x16_bf16((a), (b), (c), 0, 0, 0)

DI int tidx() { int r; asm volatile("v_mov_b32 %0, %1" : "=v"(r) : "v"(threadIdx.x)); return r; }
DI unsigned pack2(float a, float b) { f2_t v = {a, b}; return __builtin_bit_cast(unsigned, __builtin_convertvector(v, bf2_t)); }
DI float bflo(unsigned u) { return __uint_as_float(u << 16); }
DI float bfhi(unsigned u) { return __uint_as_float(u & 0xffff0000u); }
DI bf16_t f2bf(float a) { return (bf16_t)(pack2(a, 0.f) & 0xffffu); }
DI void unpack8(const uint4& u, float (&f)[8]) {
    f[0] = bflo(u.x); f[1] = bfhi(u.x); f[2] = bflo(u.y); f[3] = bfhi(u.y);
    f[4] = bflo(u.z); f[5] = bfhi(u.z); f[6] = bflo(u.w); f[7] = bfhi(u.w);
}
DI uint4 pack8(const float (&f)[8]) { uint4 u; u.x = pack2(f[0], f[1]); u.y = pack2(f[2], f[3]); u.z = pack2(f[4], f[5]); u.w = pack2(f[6], f[7]); return u; }
DI float wave_sum(float v) {
#pragma unroll
    for (int o = 32; o; o >>= 1) v += __shfl_xor(v, o);
    return v;
}
DI float sigmoidf_(float x) { return 1.f / (1.f + __expf(-x)); }
DI int crow(int reg, int h) { return (reg & 3) + 8 * (reg >> 2) + 4 * h; }

struct P {
    const float* x; const int* pos; const float *norm_mix, *w_in, *mu, *w0, *w2, *a0, *a2, *g2, *k_k, *k_a, *r_k, *lnx_w, *lnx_b,
        *pe_k, *wk1, *bk1, *wk2, *pe_v, *wv1, *bv1, *wv2, *w_out, *norm_ffn, *w_gate, *w_up, *w_down, *norm_final;
    float* out;
    bf16_t *WinT, *WoutT, *WguT, *WdnT, *w2T, *a2T, *g2T, *w1T, *wc2T;
    float *b1p, *cosT, *sinT;
    unsigned* counter; unsigned* bar;
    bf16_t *A, *proj, *stream;
    bf16_t* gbuf; float* yraw; bf16_t *vT, *hid, *kc, *vcT;
};

DI float tr_val(const P& p, int job, int k, int n) {
    switch (job) {
    case 0: { int c = n < 1824 ? n : ((n >= 1856 && n < 3160) ? n - 32 : -1); return c >= 0 ? p.w_in[(size_t)k * 3128 + c] : 0.f; }
    case 1: return p.w_out[k * 1024 + n];
    case 2: { int q = n >> 6, r = n & 63; return r < 32 ? p.w_gate[(size_t)k * DFF + q * 32 + r] : p.w_up[(size_t)k * DFF + q * 32 + r - 32]; }
    case 3: return p.w_down[(size_t)k * 1024 + n];
    case 4: return p.w2[k * 512 + n];
    case 5: return p.a2[k * 512 + n];
    case 6: return p.g2[k * 512 + n];
    case 7: return p.wk1[k * 256 + n];
    case 8: return p.wv1[k * 256 + n];
    case 9: return n < 64 ? p.wk2[k * 64 + n] : 0.f;
    default: return n < 64 ? p.wv2[k * 64 + n] : 0.f;
    }
}
DI void tr_item(const P& p, int it, float* tile) {
    int job, K, N; bf16_t* dst;
    if (it < 800) { job = 0; K = 1024; N = 3200; dst = p.WinT; }
    else if (it < 1056) { job = 1; it -= 800; K = 1024; N = 1024; dst = p.WoutT; }
    else if (it < 2464) { job = 2; it -= 1056; K = 1024; N = 5632; dst = p.WguT; }
    else if (it < 3168) { job = 3; it -= 2464; K = 2816; N = 1024; dst = p.WdnT; }
    else if (it < 3176) { job = 4; it -= 3168; K = 64; N = 512; dst = p.w2T; }
    else if (it < 3184) { job = 5; it -= 3176; K = 64; N = 512; dst = p.a2T; }
    else if (it < 3208) { job = 6; it -= 3184; K = 160; N = 512; dst = p.g2T; }
    else if (it < 3336) { job = 7; it -= 3208; K = 2048; N = 256; dst = p.w1T; }
    else if (it < 3464) { job = 8; it -= 3336; K = 2048; N = 256; dst = p.w1T + 256 * 2048; }
    else if (it < 3472) { job = 9; it -= 3464; K = 256; N = 128; dst = p.wc2T; }
    else { job = 10; it -= 3472; K = 256; N = 128; dst = p.wc2T + 128 * 256; }
    const int nt = N >> 6;
    const int k0 = (it / nt) * 64, n0 = (it % nt) * 64;
    const int tid = tidx();
    __syncthreads();
#pragma unroll 4
    for (int i = 0; i < 16; ++i) {
        const int kk = i * 4 + (tid >> 6), nn = tid & 63;
        tile[kk * 65 + nn] = (k0 + kk < K) ? tr_val(p, job, k0 + kk, n0 + nn) : 0.f;
    }
    __syncthreads();
#pragma unroll 4
    for (int i = 0; i < 16; ++i) {
        const int nn = i * 4 + (tid >> 6), kk = tid & 63;
        if (k0 + kk < K) dst[(size_t)(n0 + nn) * K + k0 + kk] = f2bf(tile[kk * 65 + nn]);
    }
}
DI void b1_item(const P& p, int idx) {
    const int kv = idx >> 4, jc = idx & 15, tid = tidx();
    const float* pe = kv ? p.pe_v : p.pe_k; const float* w1 = kv ? p.wv1 : p.wk1; const float* b1 = kv ? p.bv1 : p.bk1;
    const int j = jc * 16 + (tid >> 4), kl = tid & 15;
    float s = 0.f;
    for (int i = 0; i < 128; ++i) { const int k = kl + 16 * i; s += pe[k] * w1[k * 256 + j]; }
    s += __shfl_xor(s, 1); s += __shfl_xor(s, 2); s += __shfl_xor(s, 4); s += __shfl_xor(s, 8);
    if (kl == 0) p.b1p[kv * 256 + j] = b1[j] + s;
}
DI void sincos_d(float ang, float& c, float& s) {
    double x = (double)ang;
    const double TWO_PI = 6.283185307179586476925286766559;
    double n = __builtin_rint(x * (1.0 / TWO_PI));
    double r = x - n * TWO_PI;
    double q = r * 0.25;
    double q2 = q * q;
    double sn = q * (1.0 + q2 * (-1.0 / 6 + q2 * (1.0 / 120 + q2 * (-1.0 / 5040 + q2 * (1.0 / 362880 + q2 * (-1.0 / 39916800 + q2 * (1.0 / 6227020800.0)))))));
    double cs = 1.0 + q2 * (-0.5 + q2 * (1.0 / 24 + q2 * (-1.0 / 720 + q2 * (1.0 / 40320 + q2 * (-1.0 / 3628800 + q2 * (1.0 / 479001600.0))))));
    double s2 = 2 * sn * cs, c2 = 1 - 2 * sn * sn;
    double s4 = 2 * s2 * c2, c4 = 1 - 2 * s2 * s2;
    c = (float)c4; s = (float)s4;
}
DI void cs_item(const P& p, int idx) {
    const int e = idx * 256 + tidx(), tok = e >> 3, f = e & 7;
    const float invf[8] = {1.000000000e+00f, 1.939227432e-01f, 3.760603070e-02f, 7.292664610e-03f, 1.414213562e-03f, 2.742481884e-04f, 5.318295734e-05f, 1.031338525e-05f};
    float iv = invf[0];
#pragma unroll
    for (int i = 1; i < 8; ++i) iv = (f == i) ? invf[i] : iv;
    const float ang = (float)p.pos[tok] * iv;
    float c, s; sincos_d(ang, c, s);
    p.cosT[e] = c; p.sinT[e] = s;
}
DI void rms_item(const float* src, const float* g, bf16_t* dst, int idx) {
    const int row = idx * 4 + (tidx() >> 6), lane = tidx() & 63;
    const float4* sp = (const float4*)(src + (size_t)row * 1024);
    float4 v[4]; float ss = 0.f;
#pragma unroll
    for (int i = 0; i < 4; ++i) { v[i] = sp[lane + 64 * i]; ss += v[i].x * v[i].x + v[i].y * v[i].y + v[i].z * v[i].z + v[i].w * v[i].w; }
    ss = wave_sum(ss);
    const float rs = rsqrtf(ss * (1.f / 1024.f) + 1e-6f);
#pragma unroll
    for (int i = 0; i < 4; ++i) {
        const float4 gv = ((const float4*)g)[lane + 64 * i];
        uint2 o; o.x = pack2(v[i].x * rs * gv.x, v[i].y * rs * gv.y); o.y = pack2(v[i].z * rs * gv.z, v[i].w * rs * gv.w);
        *(uint2*)(dst + (size_t)row * 1024 + (lane + 64 * i) * 4) = o;
    }
}
DI void phase0(const P& p, char* smem) {
    if (blockIdx.x == 0 && tidx() == 0) *p.counter = 0u;
    constexpr int NTR = 3480, NB1 = 32, NCS = 1024, NXN = 8192;
    for (int it = blockIdx.x; it < NTR + NB1 + NCS + NXN; it += gridDim.x) {
        if (it < NTR) tr_item(p, it, (float*)smem);
        else if (it < NTR + NB1) b1_item(p, it - NTR);
        else if (it < NTR + NB1 + NCS) cs_item(p, it - NTR - NB1);
        else rms_item(p.x, p.norm_mix, p.A, it - NTR - NB1 - NCS);
    }
}

struct AFPlain { const bf16_t* A; int lda; DI uint4 load(int row, int k) const { return *(const uint4*)(A + (size_t)row * lda + k); } };
struct AFCmp {
    const bf16_t* base;
    DI uint4 load(int r, int k) const { int tok = 16 * r + (k >> 6); tok = tok < S_ ? tok : S_ - 1; return *(const uint4*)(base + (size_t)tok * PLD + (k & 63)); }
};

template <int KU, class AF, class EPI>
DI void gemm_tile(const AF af, const bf16_t* __restrict__ Bt, const int K, const int m0, const int n0, const EPI epi, char* smem) {
    const int tid = tidx(), wave = tid >> 6, lane = tid & 63, wm = wave >> 1, wn = wave & 1, rr = lane & 31, hh = lane >> 5;
    f32x16 acc[2][2];
#pragma unroll
    for (int a = 0; a < 2; ++a)
#pragma unroll
        for (int b = 0; b < 2; ++b)
#pragma unroll
            for (int i = 0; i < 16; ++i) acc[a][b][i] = 0.f;
    const int lrow = tid >> 3, lk = (tid & 7) * 8;
#define GLOAD(R, KO) \
    R##a0 = af.load(m0 + lrow, (KO) + lk); R##a1 = af.load(m0 + lrow + 32, (KO) + lk); R##a2 = af.load(m0 + lrow + 64, (KO) + lk); R##a3 = af.load(m0 + lrow + 96, (KO) + lk); \
    R##b0 = *(const uint4*)(Bt + (size_t)(lrow) * K + (KO) + lk); R##b1 = *(const uint4*)(Bt + (size_t)(lrow + 32) * K + (KO) + lk); \
    R##b2 = *(const uint4*)(Bt + (size_t)(lrow + 64) * K + (KO) + lk); R##b3 = *(const uint4*)(Bt + (size_t)(lrow + 96) * K + (KO) + lk);
#define GSTORE(R, SA, SB) \
    *(uint4*)&(SA)[(lrow) * 72 + lk] = R##a0; *(uint4*)&(SA)[(lrow + 32) * 72 + lk] = R##a1; *(uint4*)&(SA)[(lrow + 64) * 72 + lk] = R##a2; *(uint4*)&(SA)[(lrow + 96) * 72 + lk] = R##a3; \
    *(uint4*)&(SB)[(lrow) * 72 + lk] = R##b0; *(uint4*)&(SB)[(lrow + 32) * 72 + lk] = R##b1; *(uint4*)&(SB)[(lrow + 64) * 72 + lk] = R##b2; *(uint4*)&(SB)[(lrow + 96) * 72 + lk] = R##b3;
#define GCOMPUTE(SA, SB) \
    _Pragma("unroll") for (int ks = 0; ks < 4; ++ks) { \
        bf16x8 tf0 = *(const bf16x8*)&(SA)[(wm * 64 + rr) * 72 + ks * 16 + hh * 8], tf1 = *(const bf16x8*)&(SA)[(wm * 64 + 32 + rr) * 72 + ks * 16 + hh * 8]; \
        bf16x8 wf0 = *(const bf16x8*)&(SB)[(wn * 64 + rr) * 72 + ks * 16 + hh * 8], wf1 = *(const bf16x8*)&(SB)[(wn * 64 + 32 + rr) * 72 + ks * 16 + hh * 8]; \
        acc[0][0] = MFMA32(wf0, tf0, acc[0][0]); acc[0][1] = MFMA32(wf0, tf1, acc[0][1]); acc[1][0] = MFMA32(wf1, tf0, acc[1][0]); acc[1][1] = MFMA32(wf1, tf1, acc[1][1]); }
    uint4 Xa0, Xa1, Xa2, Xa3, Xb0, Xb1, Xb2, Xb3, Ya0, Ya1, Ya2, Ya3, Yb0, Yb1, Yb2, Yb3;
    bf16_t* const sA0 = (bf16_t*)smem; bf16_t* const sB0 = sA0 + 128 * 72; bf16_t* const sA1 = sB0 + 128 * 72; bf16_t* const sB1 = sA1 + 128 * 72;
    GLOAD(X, 0)
    GLOAD(Y, 64)
    __syncthreads();
    GSTORE(X, sA0, sB0)
    __syncthreads();
#pragma unroll KU
    for (int k0 = 0; k0 < K; k0 += 128) {
        const bool more = (k0 + 128 < K);
        if (more) { GLOAD(X, k0 + 128) }
        GCOMPUTE(sA0, sB0)
        GSTORE(Y, sA1, sB1)
        __syncthreads();
        __builtin_amdgcn_sched_barrier(0);
        if (more) { GLOAD(Y, k0 + 192) }
        GCOMPUTE(sA1, sB1)
        if (more) { GSTORE(X, sA0, sB0) }
        __syncthreads();
        __builtin_amdgcn_sched_barrier(0);
    }
#undef GLOAD
#undef GSTORE
#undef GCOMPUTE
    epi(acc, m0 + wm * 64, n0 + wn * 64, lane);
}

struct EpiProj {
    bf16_t* C;
    DI void operator()(const f32x16 (&acc)[2][2], int rowbase, int colbase, int lane) const {
        const int rr = lane & 31, hh = lane >> 5;
#pragma unroll
        for (int w = 0; w < 2; ++w)
#pragma unroll
            for (int t = 0; t < 2; ++t)
#pragma unroll
                for (int j = 0; j < 4; ++j) {
                    uint2 o; o.x = pack2(acc[w][t][4 * j], acc[w][t][4 * j + 1]); o.y = pack2(acc[w][t][4 * j + 2], acc[w][t][4 * j + 3]);
                    *(uint2*)(C + (size_t)(rowbase + t * 32 + rr) * PLD + colbase + w * 32 + j * 8 + hh * 4) = o;
                }
    }
};
struct EpiHid {
    bf16_t* H; const float* bias;
    DI void operator()(const f32x16 (&acc)[2][2], int rowbase, int colbase, int lane) const {
        const int rr = lane & 31, hh = lane >> 5;
#pragma unroll
        for (int w = 0; w < 2; ++w)
#pragma unroll
            for (int t = 0; t < 2; ++t)
#pragma unroll
                for (int j = 0; j < 4; ++j) {
                    const int col = colbase + w * 32 + j * 8 + hh * 4;
                    const float4 bv = *(const float4*)(bias + col);
                    float v0 = acc[w][t][4 * j] + bv.x, v1 = acc[w][t][4 * j + 1] + bv.y, v2 = acc[w][t][4 * j + 2] + bv.z, v3 = acc[w][t][4 * j + 3] + bv.w;
                    v0 *= sigmoidf_(v0); v1 *= sigmoidf_(v1); v2 *= sigmoidf_(v2); v3 *= sigmoidf_(v3);
                    uint2 o; o.x = pack2(v0, v1); o.y = pack2(v2, v3);
                    *(uint2*)(H + (size_t)(rowbase + t * 32 + rr) * 256 + col) = o;
                }
    }
};
struct EpiKc {
    bf16_t* kc; const float *cosT, *sinT; int tokbase;
    DI void operator()(const f32x16 (&acc)[2][2], int rowbase, int colbase, int lane) const {
        if (colbase != 0) return;
        const int rr = lane & 31, hh = lane >> 5;
#pragma unroll
        for (int t = 0; t < 2; ++t) {
            const int r = rowbase + t * 32 + rr;
            int tk = 31 + 16 * r; tk = tk < S_ ? tk : S_ - 1;
            const float4 c = *(const float4*)(cosT + (size_t)(tokbase + tk) * 8 + hh * 4), s = *(const float4*)(sinT + (size_t)(tokbase + tk) * 8 + hh * 4);
            bf16_t* kp = kc + (size_t)r * 64 + hh * 4;
            const float a0 = acc[0][t][0], a1 = acc[0][t][1], a2 = acc[0][t][2], a3 = acc[0][t][3];
            const float b0 = acc[0][t][4], b1 = acc[0][t][5], b2 = acc[0][t][6], b3 = acc[0][t][7];
            uint2 o;
            o.x = pack2(a0 * c.x - b0 * s.x, a1 * c.y - b1 * s.y); o.y = pack2(a2 * c.z - b2 * s.z, a3 * c.w - b3 * s.w);
            *(uint2*)(kp) = o;
            o.x = pack2(b0 * c.x + a0 * s.x, b1 * c.y + a1 * s.y); o.y = pack2(b2 * c.z + a2 * s.z, b3 * c.w + a3 * s.w);
            *(uint2*)(kp + 8) = o;
#pragma unroll
            for (int j = 2; j < 4; ++j) {
                o.x = pack2(acc[0][t][4 * j], acc[0][t][4 * j + 1]); o.y = pack2(acc[0][t][4 * j + 2], acc[0][t][4 * j + 3]);
                *(uint2*)(kp + j * 8) = o;
            }
#pragma unroll
            for (int j = 0; j < 4; ++j) {
                o.x = pack2(acc[1][t][4 * j], acc[1][t][4 * j + 1]); o.y = pack2(acc[1][t][4 * j + 2], acc[1][t][4 * j + 3]);
                *(uint2*)(kp + 32 + j * 8) = o;
            }
        }
    }
};
struct EpiVc {
    bf16_t* vcT; char* smem;
    DI void operator()(const f32x16 (&acc)[2][2], int rowbase, int colbase, int lane) const {
        const int rr = lane & 31, hh = lane >> 5;
        bf16_t* tl = (bf16_t*)smem;
        __syncthreads();
        if (colbase == 0) {
            const int rl = rowbase & 127;
#pragma unroll
            for (int w = 0; w < 2; ++w)
#pragma unroll
                for (int t = 0; t < 2; ++t)
#pragma unroll
                    for (int i = 0; i < 16; ++i) tl[(w * 32 + crow(i, hh)) * 136 + rl + t * 32 + rr] = f2bf(acc[w][t][i]);
        }
        __syncthreads();
        const int m0 = rowbase & ~127;
#pragma unroll
        for (int i = 0; i < 4; ++i) {
            const int c = tidx() + i * 256, d = c >> 4, ch = c & 15;
            *(uint4*)(vcT + (size_t)d * 1024 + m0 + ch * 8) = *(const uint4*)&tl[d * 136 + ch * 8];
        }
    }
};
struct EpiOut {
    float* out; const float* x;
    DI void operator()(const f32x16 (&acc)[2][2], int rowbase, int colbase, int lane) const {
        const int rr = lane & 31, hh = lane >> 5;
#pragma unroll
        for (int w = 0; w < 2; ++w)
#pragma unroll
            for (int t = 0; t < 2; ++t)
#pragma unroll
                for (int j = 0; j < 4; ++j) {
                    const size_t o = (size_t)(rowbase + t * 32 + rr) * 1024 + colbase + w * 32 + j * 8 + hh * 4;
                    float4 xv = *(const float4*)(x + o);
                    xv.x += acc[w][t][4 * j]; xv.y += acc[w][t][4 * j + 1]; xv.z += acc[w][t][4 * j + 2]; xv.w += acc[w][t][4 * j + 3];
                    *(float4*)(out + o) = xv;
                }
    }
};
struct EpiFfn1 {
    bf16_t* act;
    DI void operator()(const f32x16 (&acc)[2][2], int rowbase, int colbase, int lane) const {
        const int rr = lane & 31, hh = lane >> 5;
        const int cb = (colbase >> 6) * 32;
#pragma unroll
        for (int t = 0; t < 2; ++t)
#pragma unroll
            for (int j = 0; j < 4; ++j) {
                float v[4];
#pragma unroll
                for (int i = 0; i < 4; ++i) { const float g = acc[0][t][4 * j + i], u = acc[1][t][4 * j + i]; v[i] = g * sigmoidf_(g) * u; }
                uint2 o; o.x = pack2(v[0], v[1]); o.y = pack2(v[2], v[3]);
                *(uint2*)(act + (size_t)(rowbase + t * 32 + rr) * DFF + cb + j * 8 + hh * 4) = o;
            }
    }
};

DI void rwkv_prep(const P& p, int idx, char* smem) {
    const int tile = idx, tt0 = tile * 32;
    const int tid = tidx(), wave = tid >> 6, lane = tid & 63, rr = lane & 31, hh = lane >> 5;
    bf16_t* lat = (bf16_t*)smem;
    float* res = (float*)(smem + 32 * 296 * 2);
    __syncthreads();
    for (int c = tid; c < 32 * 36; c += NTHR) {
        const int tok = c / 36, ch = c - tok * 36, gi = tt0 + tok, col = 1536 + ch * 8;
        const uint4 cu = *(const uint4*)(p.proj + (size_t)gi * PLD + col);
        uint4 pv = make_uint4(0, 0, 0, 0);
        if ((gi & (S_ - 1)) != 0) pv = *(const uint4*)(p.proj + (size_t)(gi - 1) * PLD + col);
        float a[8], b[8]; unpack8(cu, a); unpack8(pv, b);
        const float4 m0 = *(const float4*)(p.mu + col), m1 = *(const float4*)(p.mu + col + 4);
        const float mu[8] = {m0.x, m0.y, m0.z, m0.w, m1.x, m1.y, m1.z, m1.w};
#pragma unroll
        for (int e = 0; e < 8; ++e) {
            float x = a[e] + (b[e] - a[e]) * mu[e];
            if (ch < 8) x = 1.f - 2.f / (1.f + __expf(2.f * x)); else if (ch >= 16) x = sigmoidf_(x);
            a[e] = x;
        }
        *(uint4*)&lat[tok * 296 + ch * 8] = pack8(a);
    }
    __syncthreads();
#pragma unroll 1
    for (int h = 0; h < 8; ++h) {
    if (wave < 2) {
        const int mt = wave;
        f32x16 aw, aa;
#pragma unroll
        for (int i = 0; i < 16; ++i) { aw[i] = 0.f; aa[i] = 0.f; }
#pragma unroll
        for (int ks = 0; ks < 4; ++ks) {
            const bf16x8 wf = *(const bf16x8*)(p.w2T + (size_t)(h * 64 + mt * 32 + rr) * 64 + ks * 16 + hh * 8);
            const bf16x8 af = *(const bf16x8*)(p.a2T + (size_t)(h * 64 + mt * 32 + rr) * 64 + ks * 16 + hh * 8);
            const bf16x8 l0 = *(const bf16x8*)&lat[rr * 296 + ks * 16 + hh * 8];
            const bf16x8 l1 = *(const bf16x8*)&lat[rr * 296 + 64 + ks * 16 + hh * 8];
            aw = MFMA32(wf, l0, aw); aa = MFMA32(af, l1, aa);
        }
#pragma unroll
        for (int j = 0; j < 4; ++j) {
            *(float4*)&res[(0 * 32 + rr) * 64 + mt * 32 + j * 8 + hh * 4] = make_float4(aw[4 * j], aw[4 * j + 1], aw[4 * j + 2], aw[4 * j + 3]);
            *(float4*)&res[(1 * 32 + rr) * 64 + mt * 32 + j * 8 + hh * 4] = make_float4(aa[4 * j], aa[4 * j + 1], aa[4 * j + 2], aa[4 * j + 3]);
        }
    } else {
        const int mt = wave - 2;
        f32x16 ag;
#pragma unroll
        for (int i = 0; i < 16; ++i) ag[i] = 0.f;
#pragma unroll
        for (int ks = 0; ks < 10; ++ks) {
            const bf16x8 gf = *(const bf16x8*)(p.g2T + (size_t)(h * 64 + mt * 32 + rr) * 160 + ks * 16 + hh * 8);
            const bf16x8 l2 = *(const bf16x8*)&lat[rr * 296 + 128 + ks * 16 + hh * 8];
            ag = MFMA32(gf, l2, ag);
        }
#pragma unroll
        for (int j = 0; j < 4; ++j)
            *(float4*)&res[(2 * 32 + rr) * 64 + mt * 32 + j * 8 + hh * 4] = make_float4(ag[4 * j], ag[4 * j + 1], ag[4 * j + 2], ag[4 * j + 3]);
    }
    __syncthreads();
    {
        const int tok = tid >> 3, cgp = tid & 7, gi = tt0 + tok, b = gi >> 14, s = gi & (S_ - 1), cb = h * 64 + cgp * 8;
        const bool first = (s == 0);
        float r[8], k[8], v[8];
        {
            float a[8], pb[8];
            const bf16_t* pr = p.proj + (size_t)gi * PLD;
#pragma unroll
            for (int q = 0; q < 3; ++q) {
                const int col = q * 512 + cb;
                unpack8(*(const uint4*)(pr + col), a);
                if (first) {
#pragma unroll
                    for (int e = 0; e < 8; ++e) pb[e] = 0.f;
                } else unpack8(*(const uint4*)(pr - PLD + col), pb);
                const float4 m0 = *(const float4*)(p.mu + col), m1 = *(const float4*)(p.mu + col + 4);
                const float mu[8] = {m0.x, m0.y, m0.z, m0.w, m1.x, m1.y, m1.z, m1.w};
#pragma unroll
                for (int e = 0; e < 8; ++e) {
                    const float x = a[e] + (pb[e] - a[e]) * mu[e];
                    if (q == 0) r[e] = x; else if (q == 1) k[e] = x; else v[e] = x;
                }
            }
        }
        float om[8], av[8], gg[8], kk[8], km[8], bb[8];
        float ss = 0.f;
#pragma unroll
        for (int e = 0; e < 8; ++e) {
            const float wp = res[(0 * 32 + tok) * 64 + cgp * 8 + e] + p.w0[cb + e];
            const float z = -wp;
            const float sp = fmaxf(z, 0.f) + __logf(1.f + __expf(-fabsf(z)));
            const float w = -sp - 0.5f;
            om[e] = 1.f - __expf(-__expf(w));
            av[e] = sigmoidf_(res[(1 * 32 + tok) * 64 + cgp * 8 + e] + p.a0[cb + e]);
            gg[e] = res[(2 * 32 + tok) * 64 + cgp * 8 + e];
            kk[e] = k[e] * p.k_k[cb + e];
            ss += kk[e] * kk[e];
            km[e] = k[e] * (1.f + (av[e] - 1.f) * p.k_a[cb + e]);
        }
        ss += __shfl_xor(ss, 1); ss += __shfl_xor(ss, 2); ss += __shfl_xor(ss, 4);
        const float inv = 1.f / fmaxf(sqrtf(ss), 1e-12f);
#pragma unroll
        for (int e = 0; e < 8; ++e) { kk[e] *= inv; bb[e] = kk[e] * av[e]; }
        bf16_t* sp = p.stream + ((size_t)((b * 8 + h) * S_ + s) * 6) * 64 + cgp * 8;
        *(uint4*)(sp) = pack8(om); *(uint4*)(sp + 64) = pack8(km); *(uint4*)(sp + 128) = pack8(kk);
        *(uint4*)(sp + 192) = pack8(bb); *(uint4*)(sp + 256) = pack8(r); *(uint4*)(sp + 320) = pack8(v);
        *(uint4*)(p.gbuf + (size_t)gi * 512 + cb) = pack8(gg);
    }
    __syncthreads();
    }
}

DI void rope_item(const P& p, int idx, char* smem) {
    const int tt0 = idx * 64, tid = tidx();
    bf16_t* vtile = (bf16_t*)smem;
    __syncthreads();
#pragma unroll 1
    for (int it = 0; it < 2; ++it) {
        const int item = tid + it * 256, tok = item >> 3, head = item & 7, gi = tt0 + tok;
        bf16_t* ptr = p.proj + (size_t)gi * PLD + QC + head * 64;
        const float4 c0 = *(const float4*)(p.cosT + (size_t)gi * 8), c1 = *(const float4*)(p.cosT + (size_t)gi * 8 + 4);
        const float4 s0 = *(const float4*)(p.sinT + (size_t)gi * 8), s1 = *(const float4*)(p.sinT + (size_t)gi * 8 + 4);
        const float cc[8] = {c0.x, c0.y, c0.z, c0.w, c1.x, c1.y, c1.z, c1.w}, sn[8] = {s0.x, s0.y, s0.z, s0.w, s1.x, s1.y, s1.z, s1.w};
        float a[8], b[8];
        unpack8(*(const uint4*)ptr, a); unpack8(*(const uint4*)(ptr + 8), b);
#pragma unroll
        for (int e = 0; e < 8; ++e) { const float x1 = a[e], x2 = b[e]; a[e] = (x1 * cc[e] - x2 * sn[e]) * QSC; b[e] = (x2 * cc[e] + x1 * sn[e]) * QSC; }
        *(uint4*)ptr = pack8(a); *(uint4*)(ptr + 8) = pack8(b);
#pragma unroll
        for (int q = 2; q < 8; ++q) {
            unpack8(*(const uint4*)(ptr + q * 8), a);
#pragma unroll
            for (int e = 0; e < 8; ++e) a[e] *= QSC;
            *(uint4*)(ptr + q * 8) = pack8(a);
        }
    }
    {
        const int tok = tid >> 2, sel = (tid >> 1) & 1, hk = tid & 1, gi = tt0 + tok;
        const float4 c0 = *(const float4*)(p.cosT + (size_t)gi * 8), c1 = *(const float4*)(p.cosT + (size_t)gi * 8 + 4);
        const float4 s0 = *(const float4*)(p.sinT + (size_t)gi * 8), s1 = *(const float4*)(p.sinT + (size_t)gi * 8 + 4);
        const float cc[8] = {c0.x, c0.y, c0.z, c0.w, c1.x, c1.y, c1.z, c1.w}, sn[8] = {s0.x, s0.y, s0.z, s0.w, s1.x, s1.y, s1.z, s1.w};
        float a[8], b[8];
        {
            bf16_t* ptr = p.proj + (size_t)gi * PLD + KVC + (sel ? 4 : 2) * 128 + hk * 64;
            unpack8(*(const uint4*)ptr, a); unpack8(*(const uint4*)(ptr + 8), b);
#pragma unroll
            for (int e = 0; e < 8; ++e) { const float x1 = a[e], x2 = b[e]; a[e] = x1 * cc[e] - x2 * sn[e]; b[e] = x2 * cc[e] + x1 * sn[e]; }
            *(uint4*)ptr = pack8(a); *(uint4*)(ptr + 8) = pack8(b);
        }
        {
            const bf16_t* ptr = p.proj + (size_t)gi * PLD + KVC + (sel ? 5 : 3) * 128 + hk * 64;
            bf16_t* vt = vtile + (size_t)((sel * 2 + hk) * 64) * 72 + tok;
            unpack8(*(const uint4*)ptr, a); unpack8(*(const uint4*)(ptr + 8), b);
#pragma unroll
            for (int e = 0; e < 8; ++e) { const float x1 = a[e], x2 = b[e]; a[e] = x1 * cc[e] - x2 * sn[e]; b[e] = x2 * cc[e] + x1 * sn[e]; }
#pragma unroll
            for (int e = 0; e < 8; ++e) { vt[e * 72] = f2bf(a[e]); vt[(8 + e) * 72] = f2bf(b[e]); }
#pragma unroll
            for (int q = 2; q < 8; ++q) {
                const uint4 u = *(const uint4*)(ptr + q * 8);
                const unsigned w[4] = {u.x, u.y, u.z, u.w};
#pragma unroll
                for (int e = 0; e < 4; ++e) { vt[(q * 8 + 2 * e) * 72] = (bf16_t)(w[e] & 0xffffu); vt[(q * 8 + 2 * e + 1) * 72] = (bf16_t)(w[e] >> 16); }
            }
        }
    }
    __syncthreads();
    const int b = tt0 >> 14, s0 = tt0 & (S_ - 1);
#pragma unroll
    for (int i = 0; i < 8; ++i) {
        const int c = tid + i * 256, grp = c >> 9, d = (c >> 3) & 63, ch = c & 7, sel = grp >> 1, hk = grp & 1;
        const uint4 u = *(const uint4*)&vtile[(size_t)(grp * 64 + d) * 72 + ch * 8];
        *(uint4*)(p.vT + ((size_t)((sel * 4 + b * 2 + hk) * 64 + d)) * S_ + s0 + ch * 8) = u;
    }
}

DI void phase2(const P& p, char* smem) {
    for (int it = blockIdx.x; it < 128 + 512 + 1024; it += gridDim.x) {
        if (it < 128) {
            const int kv = it >> 6, bhk = (it >> 4) & 3, mt = (it >> 1) & 7, nt = it & 1, b = bhk >> 1, hk = bhk & 1;
            AFCmp af{p.proj + (size_t)(b * S_) * PLD + KVC + kv * 128 + hk * 64};
            EpiHid ep{p.hid + (size_t)((kv * 4 + bhk) * 1024) * 256, p.b1p + kv * 256};
            gemm_tile<1>(af, p.w1T + (size_t)(kv * 256 + nt * 128) * 2048, 2048, mt * 128, nt * 128, ep, smem);
        } else if (it < 640) rope_item(p, it - 128, smem);
        else rwkv_prep(p, it - 640, smem);
    }
}
DI void phase3(const P& p, char* smem) {
    for (int it = blockIdx.x; it < 64; it += gridDim.x) {
        const int kv = it >> 5, bhk = (it >> 3) & 3, mt = it & 7, b = bhk >> 1;
        AFPlain af{p.hid + (size_t)((kv * 4 + bhk) * 1024) * 256, 256};
        if (kv == 0) { EpiKc ep{p.kc + (size_t)bhk * 1024 * 64, p.cosT, p.sinT, b * S_}; gemm_tile<1>(af, p.wc2T, 256, mt * 128, 0, ep, smem); }
        else { EpiVc ep{p.vcT + (size_t)bhk * 64 * 1024, smem}; gemm_tile<1>(af, p.wc2T + 128 * 256, 256, mt * 128, 0, ep, smem); }
    }
}

template <int CTRL> DI float dpp_add(float x) { return x + __int_as_float(__builtin_amdgcn_mov_dpp(__float_as_int(x), CTRL, 0xF, 0xF, true)); }
DI float red16(float x) { x = dpp_add<0xB1>(x); x = dpp_add<0x4E>(x); x = dpp_add<0x141>(x); x = dpp_add<0x140>(x); return x; }

DI void cvt_store(const uint4 u, const bool isom, float* d) {
    float f0 = bflo(u.x), f1 = bfhi(u.x), f2 = bflo(u.y), f3 = bfhi(u.y), f4 = bflo(u.z), f5 = bfhi(u.z), f6 = bflo(u.w), f7 = bfhi(u.w);
    if (isom) { f0 = 1.f - f0; f1 = 1.f - f1; f2 = 1.f - f2; f3 = 1.f - f3; f4 = 1.f - f4; f5 = 1.f - f5; f6 = 1.f - f6; f7 = 1.f - f7; }
    *(float4*)d = make_float4(f0, f1, f2, f3); *(float4*)(d + 4) = make_float4(f4, f5, f6, f7);
}
DI void scan_unit(const P& p, int su, char* smem) {
    const int xcd = su & 7, kq = su >> 3, bh = xcd * 2 + (kq >> 3), oct = kq & 7, b = bh >> 3, h = bh & 7;
    const int tid = tidx(), wave = tid >> 6, lane = tid & 63;
    float* buf = (float*)smem;
    float* ypb = (float*)(smem + 49152);
    const bf16_t* sbase = p.stream + (size_t)bh * S_ * 384;
    __syncthreads();
#pragma unroll
    for (int i = 0; i < 3; ++i) { const int ci = tid + i * 256; cvt_store(*(const uint4*)(sbase + (size_t)ci * 8), (ci % 48) < 8, buf + ci * 8); }
    __syncthreads();
    if (wave < 2) {
        const int rl = lane >> 4, ks = lane & 15, row = oct * 8 + wave * 4 + rl;
        f2_t sA = {0.f, 0.f}, sB = {0.f, 0.f};
        __builtin_amdgcn_s_setprio(3);
        for (int c = 0; c < 1024; ++c) {
            const float* cb = buf + (c & 1) * 6144 + ks * 4;
            const float* vb = buf + (c & 1) * 6144 + 320 + row;
            float* yo = ypb + ((c & 1) * 2 + wave) * 1024 + lane;
            float4 dec = *(const float4*)(cb), km = *(const float4*)(cb + 64), kk = *(const float4*)(cb + 128), bb = *(const float4*)(cb + 192), rv = *(const float4*)(cb + 256);
            float v = vb[0];
            float4 dec1 = *(const float4*)(cb + 384), km1 = *(const float4*)(cb + 384 + 64), kk1 = *(const float4*)(cb + 384 + 128), bb1 = *(const float4*)(cb + 384 + 192), rv1 = *(const float4*)(cb + 384 + 256);
            float v1 = vb[384];
#pragma unroll
            for (int st = 0; st < 16; ++st) {
                float4 dec2 = dec1, km2 = km1, kk2 = kk1, bb2 = bb1, rv2 = rv1; float v2 = v1;
                if (st < 14) {
                    const float* rec = cb + (st + 2) * 384;
                    dec2 = *(const float4*)(rec); km2 = *(const float4*)(rec + 64); kk2 = *(const float4*)(rec + 128); bb2 = *(const float4*)(rec + 192); rv2 = *(const float4*)(rec + 256);
                    v2 = vb[(st + 2) * 384];
                }
                __builtin_amdgcn_sched_barrier(0x207);
                const f2_t vv = {v, v};
                const f2_t d01 = {dec.x, dec.y}, d23 = {dec.z, dec.w}, m01 = {km.x, km.y}, m23 = {km.z, km.w};
                const f2_t k01 = {kk.x, kk.y}, k23 = {kk.z, kk.w}, b01 = {bb.x, bb.y}, b23 = {bb.z, bb.w}, r01 = {rv.x, rv.y}, r23 = {rv.z, rv.w};
                const f2_t tA = sA * d01 + vv * m01, tB = sB * d23 + vv * m23;
                f2_t pa = sA * k01; pa = sB * k23 + pa;
                const float sa = red16(pa.x + pa.y);
                const f2_t sav = {sa, sa};
                sA = tA - sav * b01; sB = tB - sav * b23;
                f2_t ya = sA * r01; ya = sB * r23 + ya;
                yo[st * 64] = ya.x + ya.y;
                dec = dec1; km = km1; kk = kk1; bb = bb1; rv = rv1; v = v1;
                dec1 = dec2; km1 = km2; kk1 = kk2; bb1 = bb2; rv1 = rv2; v1 = v2;
            }
            __syncthreads();
        }
        __builtin_amdgcn_s_setprio(0);
    } else {
        const int ht = tid - 128;
        const int ystep = ht >> 3, r8 = ht & 7;
        float* yout = p.yraw + (size_t)(b * S_) * 512 + h * 64 + oct * 8 + r8;
        const float* ysrc = ypb + (r8 >> 2) * 1024 + ystep * 64 + (r8 & 3) * 16;
        uint4 ra0, ra1, ra2, ra3, ra4, ra5, rb0, rb1, rb2, rb3, rb4, rb5;
#define SLOAD(R, CH) { const bf16_t* sp_ = sbase + (size_t)(CH) * 6144 + (size_t)ht * 8; \
        R##0 = *(const uint4*)(sp_); R##1 = *(const uint4*)(sp_ + 1024); R##2 = *(const uint4*)(sp_ + 2048); R##3 = *(const uint4*)(sp_ + 3072); R##4 = *(const uint4*)(sp_ + 4096); R##5 = *(const uint4*)(sp_ + 5120); }
#define SSTORE(R, BI) { float* d_ = buf + (BI) * 6144 + ht * 8; const bool om_ = (ht % 48) < 8; \
        cvt_store(R##0, om_, d_); cvt_store(R##1, ((ht + 128) % 48) < 8, d_ + 1024); cvt_store(R##2, ((ht + 256) % 48) < 8, d_ + 2048); \
        cvt_store(R##3, ((ht + 384) % 48) < 8, d_ + 3072); cvt_store(R##4, ((ht + 512) % 48) < 8, d_ + 4096); cvt_store(R##5, ((ht + 640) % 48) < 8, d_ + 5120); }
#define YRED(C) { const float* ys_ = ysrc + ((C) & 1) * 2048; const float4 a_ = *(const float4*)ys_, b_ = *(const float4*)(ys_ + 4), c_ = *(const float4*)(ys_ + 8), d_ = *(const float4*)(ys_ + 12); \
        yout[(size_t)((C) * 16 + ystep) * 512] = ((a_.x + a_.y) + (a_.z + a_.w)) + ((b_.x + b_.y) + (b_.z + b_.w)) + ((c_.x + c_.y) + (c_.z + c_.w)) + ((d_.x + d_.y) + (d_.z + d_.w)); }
        SLOAD(ra, 1)
        for (int c = 0; c < 1024; c += 2) {
            if (c + 2 < 1024) SLOAD(rb, c + 2)
            SSTORE(ra, 1)
            if (c >= 1) YRED(c - 1)
            __syncthreads();
            if (c + 3 < 1024) SLOAD(ra, c + 3)
            if (c + 2 < 1024) SSTORE(rb, 0)
            YRED(c)
            __syncthreads();
        }
        YRED(1023)
#undef SLOAD
#undef SSTORE
#undef YRED
    }
}

struct AttnSmem {
    bf16_t k[64 * 72];
    bf16_t vt[64 * 68];
    float imp[32 * 256];
    unsigned selbits[32 * 8];
    unsigned wunion[4 * 8];
    unsigned bunion[8];
    int unit;
    int pad_[3];
    uint4 q[4 * 4 * 64];
};

#define ATTN_LOAD(KBASE, KSTRIDE, VTBASE, VTSTRIDE, NEEDV) { \
    rk0 = *(const uint4*)((KBASE) + (size_t)(tid >> 3) * (KSTRIDE) + (tid & 7) * 8); \
    rk1 = *(const uint4*)((KBASE) + (size_t)((tid >> 3) + 32) * (KSTRIDE) + (tid & 7) * 8); \
    if (NEEDV) { rv0 = *(const uint4*)((VTBASE) + (size_t)(tid >> 3) * (VTSTRIDE) + (tid & 7) * 8); \
                 rv1 = *(const uint4*)((VTBASE) + (size_t)((tid >> 3) + 32) * (VTSTRIDE) + (tid & 7) * 8); } }
#define ATTN_STORE(NEEDV) { \
    *(uint4*)&sm.k[(tid >> 3) * 72 + (tid & 7) * 8] = rk0; *(uint4*)&sm.k[((tid >> 3) + 32) * 72 + (tid & 7) * 8] = rk1; \
    if (NEEDV) { bf16_t* d0_ = &sm.vt[(tid >> 3) * 68 + (tid & 7) * 8]; bf16_t* d1_ = &sm.vt[((tid >> 3) + 32) * 68 + (tid & 7) * 8]; \
        *(uint2*)d0_ = make_uint2(rv0.x, rv0.y); *(uint2*)(d0_ + 4) = make_uint2(rv0.z, rv0.w); \
        *(uint2*)d1_ = make_uint2(rv1.x, rv1.y); *(uint2*)(d1_ + 4) = make_uint2(rv1.z, rv1.w); } }

template <int MODE, bool EM>
DI void attn_tile(AttnSmem& sm, const uint4* qs, f32x16 (&o)[2], float& m, float& l, const float inv_l, const int lo, const int hi, const bool lane_on,
                  const int lane, const int tokl, const int jbase) {
    const int rr = lane & 31, hh = lane >> 5;
    f32x16 s[2];
#pragma unroll
    for (int mt = 0; mt < 2; ++mt) {
#pragma unroll
        for (int i = 0; i < 16; ++i) s[mt][i] = 0.f;
#pragma unroll
        for (int ks = 0; ks < 4; ++ks) {
            const bf16x8 kf = *(const bf16x8*)&sm.k[(mt * 32 + rr) * 72 + ks * 16 + hh * 8];
            const bf16x8 qv = __builtin_bit_cast(bf16x8, qs[ks * 64]);
            s[mt] = MFMA32(kf, qv, s[mt]);
        }
        asm volatile("" ::: "memory");
    }
    (void)m;
    __builtin_amdgcn_sched_barrier(0);
    float psum = 0.f;
    if (EM) {
        const int lo2 = lo - 4 * hh, hi2 = hi - 4 * hh;
#pragma unroll
        for (int mt = 0; mt < 2; ++mt)
#pragma unroll
            for (int i = 0; i < 16; ++i) {
                const int kc_ = mt * 32 + (i & 3) + 8 * (i >> 2);
                float v = s[mt][i];
                v = (kc_ >= lo2 && kc_ <= hi2) ? v : -1e30f;
                float pv = __builtin_amdgcn_exp2f(v);
                if (MODE == 2) pv *= inv_l;
                s[mt][i] = pv; psum += pv;
            }
    } else {
        const float off = lane_on ? 0.f : -1e30f;
#pragma unroll
        for (int mt = 0; mt < 2; ++mt)
#pragma unroll
            for (int i = 0; i < 16; ++i) {
                float pv = __builtin_amdgcn_exp2f(s[mt][i] + off);
                if (MODE == 2) pv *= inv_l;
                s[mt][i] = pv; psum += pv;
            }
    }
    __builtin_amdgcn_sched_barrier(0);
    if (MODE != 2) l += psum;
    if (MODE == 0) return;
    if (MODE == 2) {
#pragma unroll
        for (int mt = 0; mt < 2; ++mt)
#pragma unroll
            for (int jj = 0; jj < 4; ++jj) {
                float q4 = (s[mt][4 * jj] + s[mt][4 * jj + 1]) + (s[mt][4 * jj + 2] + s[mt][4 * jj + 3]);
                float e3 = s[mt][4 * jj + 3];
                q4 += __shfl_xor(q4, 1); q4 += __shfl_xor(q4, 2);
                e3 += __shfl_xor(e3, 1); e3 += __shfl_xor(e3, 2);
                if ((rr & 3) == 0) {
                    const int j = jbase + mt * 8 + 2 * jj + hh;
                    atomicAdd(&sm.imp[tokl * 256 + j], q4);
                    if (j + 1 < 256) atomicAdd(&sm.imp[tokl * 256 + j + 1], e3);
                }
            }
    }
#pragma unroll
    for (int mt = 0; mt < 2; ++mt)
#pragma unroll
        for (int s2 = 0; s2 < 2; ++s2) {
            uint4 pu;
            pu.x = pack2(s[mt][8 * s2 + 0], s[mt][8 * s2 + 1]); pu.y = pack2(s[mt][8 * s2 + 2], s[mt][8 * s2 + 3]);
            pu.z = pack2(s[mt][8 * s2 + 4], s[mt][8 * s2 + 5]); pu.w = pack2(s[mt][8 * s2 + 6], s[mt][8 * s2 + 7]);
            const bf16x8 pf = __builtin_bit_cast(bf16x8, pu);
            asm volatile("" ::: "memory");
#pragma unroll
            for (int dt = 0; dt < 2; ++dt) {
                const bf16_t* vp = &sm.vt[(dt * 32 + rr) * 68 + mt * 32 + s2 * 16 + hh * 4];
                const uint2 v0 = *(const uint2*)vp, v1 = *(const uint2*)(vp + 8);
                const bf16x8 vf = __builtin_bit_cast(bf16x8, make_uint4(v0.x, v0.y, v1.x, v1.y));
                o[dt] = MFMA32(vf, pf, o[dt]);
            }
        }
}

DI unsigned wave_umax(unsigned v) {
#pragma unroll
    for (int o = 32; o; o >>= 1) { const unsigned t = (unsigned)__shfl_xor((int)v, o); v = v > t ? v : t; }
    return v;
}


typedef unsigned u32x4 __attribute__((ext_vector_type(4)));
#define GLD16(R, PTR) asm volatile("global_load_dwordx4 %0, %1, off" : "=&v"(R) : "v"(PTR))
template <bool NEEDV, class NextF, class KPtrF, class VPtrF, class CompF>
DI void attn_pipe(AttnSmem& sm, const int tid, int j, const NextF next, const KPtrF kptr, const int kst, const VPtrF vptr, const int vst, const CompF comp) {
    if (j < 0) return;
    u32x4 Ak0, Ak1, Av0 = {0u, 0u, 0u, 0u}, Av1 = {0u, 0u, 0u, 0u}, Bk0, Bk1, Bv0 = {0u, 0u, 0u, 0u}, Bv1 = {0u, 0u, 0u, 0u};
    const int lr = tid >> 3, lc = (tid & 7) * 8;
#define PIPE_LOADS(S, JJ) { const bf16_t* kp_ = kptr(JJ) + (size_t)lr * kst + lc; GLD16(S##k0, kp_); GLD16(S##k1, kp_ + (size_t)32 * kst); \
        if (NEEDV) { const bf16_t* vp_ = vptr(JJ) + (size_t)lr * vst + lc; GLD16(S##v0, vp_); GLD16(S##v1, vp_ + (size_t)32 * vst); } }
#define PIPE_WAIT(S) { if (NEEDV) asm volatile("s_waitcnt vmcnt(4)" : "+v"(S##k0), "+v"(S##k1), "+v"(S##v0), "+v"(S##v1)); \
        else asm volatile("s_waitcnt vmcnt(2)" : "+v"(S##k0), "+v"(S##k1)); }
#define PIPE_STORES(S) { *(u32x4*)&sm.k[lr * 72 + lc] = S##k0; *(u32x4*)&sm.k[(lr + 32) * 72 + lc] = S##k1; \
        if (NEEDV) { bf16_t* d0_ = &sm.vt[lr * 68 + lc]; bf16_t* d1_ = &sm.vt[(lr + 32) * 68 + lc]; \
            *(uint2*)d0_ = make_uint2(S##v0.x, S##v0.y); *(uint2*)(d0_ + 4) = make_uint2(S##v0.z, S##v0.w); \
            *(uint2*)d1_ = make_uint2(S##v1.x, S##v1.y); *(uint2*)(d1_ + 4) = make_uint2(S##v1.z, S##v1.w); } }
    int jn = next(j);
    PIPE_LOADS(A, j)
    PIPE_LOADS(B, (jn >= 0 ? jn : j))
    while (true) {
        __syncthreads();
        PIPE_WAIT(A)
        PIPE_STORES(A)
        __syncthreads();
        const int jnn = jn >= 0 ? next(jn) : -1;
        PIPE_LOADS(A, (jnn >= 0 ? jnn : j))
        comp(j);
        if (jn < 0) break;
        __syncthreads();
        PIPE_WAIT(B)
        PIPE_STORES(B)
        __syncthreads();
        const int jnnn = jnn >= 0 ? next(jnn) : -1;
        PIPE_LOADS(B, (jnnn >= 0 ? jnnn : jn))
        comp(jn);
        if (jnn < 0) break;
        j = jnn; jn = jnnn;
    }
    asm volatile("s_waitcnt vmcnt(0)" : "+v"(Ak0), "+v"(Ak1), "+v"(Av0), "+v"(Av1), "+v"(Bk0), "+v"(Bk1), "+v"(Bv0), "+v"(Bv1));
#undef PIPE_LOADS
#undef PIPE_WAIT
#undef PIPE_STORES
}

DI void attn_unit(const P& p, int u, char* smem) {
    AttnSmem& sm = *(AttnSmem*)smem;
    const int tid = tidx(), wave = tid >> 6, lane = tid & 63, rr = lane & 31, hh = lane >> 5;
    const int tile = 511 - (u >> 2), bhk = u & 3, b = bhk >> 1, hk = bhk & 1, t0 = tile * 32;
    const int tokl = wave * 8 + (rr >> 2), t = t0 + tokl, g = rr & 3, head = hk * 4 + g;
    const size_t tokg = (size_t)b * S_ + t;
    uint4* qs = &sm.q[wave * 256 + lane];
#pragma unroll
    for (int ks = 0; ks < 4; ++ks) qs[ks * 64] = *(const uint4*)(p.proj + tokg * PLD + QC + head * 64 + ks * 16 + hh * 8);
#define GATE(i) sigmoidf_(__uint_as_float((unsigned)p.proj[((size_t)b * S_ + t) * PLD + GC + head * 3 + (i)] << 16))
#pragma unroll
    for (int i = 0; i < 8; ++i) *(float4*)&sm.imp[(tid + i * 256) * 4] = make_float4(0.f, 0.f, 0.f, 0.f);
    sm.selbits[tid] = 0u;
    f32x16 o[2];
#pragma unroll
    for (int dt = 0; dt < 2; ++dt)
#pragma unroll
        for (int i = 0; i < 16; ++i) o[dt][i] = 0.f;
    float* park = &sm.imp[wave * 2048 + lane];
    const int ntc = (t0 >> 10) + 1;
    const int vmaxi = (t >= 31) ? ((t - 31) >> 4) : -1;
    const int twmin = t0 + wave * 8;
    const int wvmin = (twmin >= 31) ? ((twmin - 31) >> 4) : -1;
    const bf16_t* kcb = p.kc + (size_t)bhk * 1024 * 64;
    const bf16_t* vcb = p.vcT + (size_t)bhk * 64 * 1024;
    float m = -1e30f, l = 0.f;
    {
        auto nxt = [&](int j) -> int { return j + 1 < ntc ? j + 1 : -1; };
        auto kp = [&](int j) -> const bf16_t* { return kcb + (size_t)j * 64 * 64; };
        auto vp = [&](int j) -> const bf16_t* { return vcb + j * 64; };
        attn_pipe<false>(sm, tid, 0, nxt, kp, 64, vp, 1024, [&](int j) {
            if (j * 64 + 63 <= wvmin) attn_tile<0, false>(sm, qs, o, m, l, 0.f, 0, 0, true, lane, tokl, 0);
            else attn_tile<0, true>(sm, qs, o, m, l, 0.f, 0, vmaxi - j * 64, true, lane, tokl, 0);
        });
        const float lt = l + __shfl_xor(l, 32);
        const float inv_l = lt > 0.f ? 1.f / lt : 0.f;
        attn_pipe<true>(sm, tid, 0, nxt, kp, 64, vp, 1024, [&](int j) {
            if (j * 64 + 63 <= wvmin) attn_tile<2, false>(sm, qs, o, m, l, inv_l, 0, 0, true, lane, tokl, j * 16);
            else attn_tile<2, true>(sm, qs, o, m, l, inv_l, 0, vmaxi - j * 64, true, lane, tokl, j * 16);
        });
    }
    __syncthreads();
    const int cur = t0 >> 6;
    for (int tk = 0; tk < 8; ++tk) {
        const int tl = wave * 8 + tk;
        const float* ip = &sm.imp[tl * 256];
        unsigned nib = 0u;
        if (cur <= 15) {
#pragma unroll
            for (int e = 0; e < 4; ++e) if (lane * 4 + e <= cur) nib |= 1u << e;
        } else {
            unsigned k0, k1, k2, k3;
            {
                const float4 iv = *(const float4*)(ip + lane * 4);
                const int j0 = lane * 4;
                k0 = (j0 >= 1 && j0 <= cur - 2) ? ((__float_as_uint(iv.x) & 0xFFFFFF00u) | (unsigned)(255 - j0)) : 0u;
                k1 = (j0 + 1 <= cur - 2) ? ((__float_as_uint(iv.y) & 0xFFFFFF00u) | (unsigned)(254 - j0)) : 0u;
                k2 = (j0 + 2 <= cur - 2) ? ((__float_as_uint(iv.z) & 0xFFFFFF00u) | (unsigned)(253 - j0)) : 0u;
                k3 = (j0 + 3 <= cur - 2) ? ((__float_as_uint(iv.w) & 0xFFFFFF00u) | (unsigned)(252 - j0)) : 0u;
#pragma unroll
                for (int e = 0; e < 4; ++e) { const int j = j0 + e; if (j == 0 || j == cur || j == cur - 1) nib |= 1u << e; }
            }
            for (int r = 0; r < 13; ++r) {
                unsigned lm = k0 > k1 ? k0 : k1; const unsigned lm2 = k2 > k3 ? k2 : k3; lm = lm > lm2 ? lm : lm2;
                const unsigned wm = wave_umax(lm);
                if (k0 == wm) { k0 = 0u; nib |= 1u; }
                if (k1 == wm) { k1 = 0u; nib |= 2u; }
                if (k2 == wm) { k2 = 0u; nib |= 4u; }
                if (k3 == wm) { k3 = 0u; nib |= 8u; }
            }
        }
        atomicOr(&sm.selbits[tl * 8 + (lane >> 3)], nib << ((lane & 7) * 4));
    }
    __syncthreads();
    if (tid < 32) {
        const int w = tid >> 3, d = tid & 7; unsigned uu = 0u;
#pragma unroll
        for (int k = 0; k < 8; ++k) uu |= sm.selbits[(w * 8 + k) * 8 + d];
        sm.wunion[w * 8 + d] = uu;
    }
    __syncthreads();
    if (tid < 8) sm.bunion[tid] = sm.wunion[tid] | sm.wunion[8 + tid] | sm.wunion[16 + tid] | sm.wunion[24 + tid];
    __syncthreads();
    {
        const float g0 = GATE(0);
#pragma unroll
        for (int dt = 0; dt < 2; ++dt)
#pragma unroll
            for (int i = 0; i < 16; ++i) { park[(dt * 16 + i) * 64] = g0 * o[dt][i]; o[dt][i] = 0.f; }
    }
    {
        const bf16_t* kb = p.proj + (size_t)(b * S_) * PLD + KVC + 2 * 128 + hk * 64;
        const bf16_t* vb = p.vT + (size_t)((0 * 4 + bhk) * 64) * S_;
        m = -1e30f; l = 0.f;
        auto nextj = [&](int j) -> int {
            ++j;
            while (j <= cur) {
                const unsigned w = sm.bunion[j >> 5] >> (j & 31);
                if (w) { j += __ffs((int)w) - 1; return j <= cur ? j : -1; }
                j = (j | 31) + 1;
            }
            return -1;
        };
        attn_pipe<true>(sm, tid, nextj(-1), nextj, [&](int j) -> const bf16_t* { return kb + (size_t)j * 64 * PLD; }, PLD,
                        [&](int j) -> const bf16_t* { return vb + j * 64; }, S_, [&](int j) {
            if ((sm.wunion[wave * 8 + (j >> 5)] >> (j & 31)) & 1u) {
                const bool selme = (sm.selbits[tokl * 8 + (j >> 5)] >> (j & 31)) & 1u;
                if (j < cur) attn_tile<1, false>(sm, qs, o, m, l, 0.f, 0, 0, selme, lane, tokl, 0);
                else attn_tile<1, true>(sm, qs, o, m, l, 0.f, 0, selme ? t - j * 64 : -1, true, lane, tokl, 0);
            }
        });
        const float lt = l + __shfl_xor(l, 32);
        const float sc = lt > 0.f ? GATE(1) / lt : 0.f;
#pragma unroll
        for (int dt = 0; dt < 2; ++dt)
#pragma unroll
            for (int i = 0; i < 16; ++i) { park[(dt * 16 + i) * 64] += sc * o[dt][i]; o[dt][i] = 0.f; }
    }
    {
        const bf16_t* kb = p.proj + (size_t)(b * S_) * PLD + KVC + 4 * 128 + hk * 64;
        const bf16_t* vb = p.vT + (size_t)((1 * 4 + bhk) * 64) * S_;
        m = -1e30f; l = 0.f;
        const int jlo = (t0 >= 511) ? ((t0 - 511) >> 6) : 0, jhi = t0 >> 6;
        attn_pipe<true>(sm, tid, jlo, [&](int j) -> int { return j + 1 <= jhi ? j + 1 : -1; }, [&](int j) -> const bf16_t* { return kb + (size_t)j * 64 * PLD; }, PLD,
                        [&](int j) -> const bf16_t* { return vb + j * 64; }, S_, [&](int j) {
            if (j * 64 >= twmin + 7 - 511 && j * 64 + 63 <= twmin) attn_tile<1, false>(sm, qs, o, m, l, 0.f, 0, 0, true, lane, tokl, 0);
            else attn_tile<1, true>(sm, qs, o, m, l, 0.f, t - 511 - j * 64, t - j * 64, true, lane, tokl, 0);
        });
        const float lt = l + __shfl_xor(l, 32);
        const float sc = lt > 0.f ? GATE(2) / lt : 0.f;
#pragma unroll
        for (int dt = 0; dt < 2; ++dt)
#pragma unroll
            for (int i = 0; i < 16; ++i) o[dt][i] = park[(dt * 16 + i) * 64] + sc * o[dt][i];
    }
    bf16_t* mp = p.A + tokg * 1024 + 512 + head * 64;
#pragma unroll
    for (int dt = 0; dt < 2; ++dt)
#pragma unroll
        for (int jj = 0; jj < 4; ++jj) {
            uint2 ov; ov.x = pack2(o[dt][4 * jj], o[dt][4 * jj + 1]); ov.y = pack2(o[dt][4 * jj + 2], o[dt][4 * jj + 3]);
            *(uint2*)(mp + dt * 32 + jj * 8 + hh * 4) = ov;
        }
}

DI void phase4(const P& p, char* smem) {
    for (int su = blockIdx.x; su < 128; su += gridDim.x) scan_unit(p, su, smem);
    AttnSmem& sm = *(AttnSmem*)smem;
    while (true) {
        __syncthreads();
        if (tidx() == 0) sm.unit = (int)atomicAdd(p.counter, 1u);
        __syncthreads();
        const int u = sm.unit;
        if (u >= 2048) break;
        attn_unit(p, u, smem);
    }
}

DI void phase4b(const P& p) {
    const int tid = tidx();
    for (int it = blockIdx.x; it < T_ / 4; it += gridDim.x) {
        const int gi = it * 4 + (tid >> 6), cgp = tid & 63, h = cgp >> 3, c8 = (cgp & 7) * 8, col = cgp * 8, b = gi >> 14, s = gi & (S_ - 1);
        const float4 y0 = *(const float4*)(p.yraw + (size_t)gi * 512 + col), y1 = *(const float4*)(p.yraw + (size_t)gi * 512 + col + 4);
        float y[8] = {y0.x, y0.y, y0.z, y0.w, y1.x, y1.y, y1.z, y1.w};
        const bf16_t* sp = p.stream + ((size_t)((b * 8 + h) * S_ + s) * 6) * 64 + c8;
        float km[8], r[8], v[8], gg[8];
        unpack8(*(const uint4*)(sp + 64), km); unpack8(*(const uint4*)(sp + 256), r); unpack8(*(const uint4*)(sp + 320), v);
        unpack8(*(const uint4*)(p.gbuf + (size_t)gi * 512 + col), gg);
        float sum = 0.f, bon = 0.f;
#pragma unroll
        for (int e = 0; e < 8; ++e) { sum += y[e]; bon += r[e] * km[e] * p.r_k[col + e]; }
        sum += __shfl_xor(sum, 1); sum += __shfl_xor(sum, 2); sum += __shfl_xor(sum, 4);
        bon += __shfl_xor(bon, 1); bon += __shfl_xor(bon, 2); bon += __shfl_xor(bon, 4);
        const float mean = sum * (1.f / 64.f);
        float var = 0.f;
#pragma unroll
        for (int e = 0; e < 8; ++e) { y[e] -= mean; var += y[e] * y[e]; }
        var += __shfl_xor(var, 1); var += __shfl_xor(var, 2); var += __shfl_xor(var, 4);
        const float rs = rsqrtf(var * (1.f / 64.f) + 64e-5f);
        float o[8];
#pragma unroll
        for (int e = 0; e < 8; ++e) o[e] = (y[e] * rs * p.lnx_w[col + e] + p.lnx_b[col + e] + bon * v[e]) * gg[e];
        *(uint4*)(p.A + (size_t)gi * 1024 + col) = pack8(o);
    }
}

struct EpiFfn2 {
    float* out;
    DI void operator()(const f32x16 (&acc)[2][2], int rowbase, int colbase, int lane) const {
        const int rr = lane & 31, hh = lane >> 5;
#pragma unroll
        for (int w = 0; w < 2; ++w)
#pragma unroll
            for (int t = 0; t < 2; ++t)
#pragma unroll
                for (int j = 0; j < 4; ++j) {
                    float4* o = (float4*)(out + (size_t)(rowbase + t * 32 + rr) * 1024 + colbase + w * 32 + j * 8 + hh * 4);
                    float4 xv = *o;
                    xv.x += acc[w][t][4 * j]; xv.y += acc[w][t][4 * j + 1]; xv.z += acc[w][t][4 * j + 2]; xv.w += acc[w][t][4 * j + 3];
                    *o = xv;
                }
    }
};

DI void final_item(float* io, const float* g, int idx) {
    const int row = idx * 4 + (tidx() >> 6), lane = tidx() & 63;
    float4* sp = (float4*)(io + (size_t)row * 1024);
    float4 v[4]; float ss = 0.f;
#pragma unroll
    for (int i = 0; i < 4; ++i) { v[i] = sp[lane + 64 * i]; ss += v[i].x * v[i].x + v[i].y * v[i].y + v[i].z * v[i].z + v[i].w * v[i].w; }
    ss = wave_sum(ss);
    const float rs = rsqrtf(ss * (1.f / 1024.f) + 1e-6f);
#pragma unroll
    for (int i = 0; i < 4; ++i) {
        const float4 gv = ((const float4*)g)[lane + 64 * i];
        sp[lane + 64 * i] = make_float4(v[i].x * rs * gv.x, v[i].y * rs * gv.y, v[i].z * rs * gv.z, v[i].w * rs * gv.w);
    }
}

DI bool gemm_order(const int round, const int NT, int& mt, int& nt) {
    if (gridDim.x == 512) {
        const int xcd = blockIdx.x & 7, lb = blockIdx.x >> 3;
        const int q = round * 64 + lb;
        if (q >= 32 * NT) return false;
        mt = xcd * 32 + (q / (8 * NT)) * 8 + (q & 7);
        nt = (q >> 3) % NT;
        return true;
    }
    const int it = round * gridDim.x + blockIdx.x;
    if (it >= 256 * NT) return false;
    mt = it / NT; nt = it - mt * NT;
    return true;
}

DI void run_phase(const P& p, int ph, char* smem) {
    switch (ph) {
    case 0: phase0(p, smem); break;
    case 1:
        for (int rd = 0;; ++rd) {
            int mt, nt; if (!gemm_order(rd, 25, mt, nt)) break;
            gemm_tile<8>(AFPlain{p.A, 1024}, p.WinT + (size_t)nt * 128 * 1024, 1024, mt * 128, nt * 128, EpiProj{p.proj}, smem);
        }
        break;
    case 2: phase2(p, smem); break;
    case 3: phase3(p, smem); break;
    case 4: phase4(p, smem); break;
    case 5: phase4b(p); break;
    case 6:
        for (int rd = 0;; ++rd) {
            int mt, nt; if (!gemm_order(rd, 8, mt, nt)) break;
            gemm_tile<8>(AFPlain{p.A, 1024}, p.WoutT + (size_t)nt * 128 * 1024, 1024, mt * 128, nt * 128, EpiOut{p.out, p.x}, smem);
        }
        break;
    case 7:
        for (int it = blockIdx.x; it < T_ / 4; it += gridDim.x) rms_item(p.out, p.norm_ffn, p.A, it);
        break;
    case 8:
        for (int rd = 0;; ++rd) {
            int mt, nt; if (!gemm_order(rd, 44, mt, nt)) break;
            gemm_tile<8>(AFPlain{p.A, 1024}, p.WguT + (size_t)nt * 128 * 1024, 1024, mt * 128, nt * 128, EpiFfn1{p.stream}, smem);
        }
        break;
    case 9:
        for (int rd = 0;; ++rd) {
            int mt, nt; if (!gemm_order(rd, 8, mt, nt)) break;
            gemm_tile<1>(AFPlain{p.stream, DFF}, p.WdnT + (size_t)nt * 128 * DFF, DFF, mt * 128, nt * 128, EpiFfn2{p.out}, smem);
        }
        break;
    default:
        for (int it = blockIdx.x; it < T_ / 4; it += gridDim.x) final_item(p.out, p.norm_final, it);
        break;
    }
}
constexpr int NPHASE = 11;
constexpr int SMEM_BYTES = 73728;


#define XB_TMO      128
#define XB_XCNT(j)  (256  + 64 * (j))
#define XB_XSUB(j)  (1280 + 64 * (j))
#define XB_XGEN(j)  (2304 + 64 * (j))
#define XB_TOP      3328
#define XB_TOPGEN   3392
#define XCD_BAR_WORDS 3456
#define XB_SPIN_CAP (1u << 22)
#define LAS __attribute__((address_space(3)))
DI unsigned xb_ld(unsigned* p) { return __hip_atomic_load(p, __ATOMIC_RELAXED, __HIP_MEMORY_SCOPE_AGENT); }
DI unsigned xb_add(unsigned* p, unsigned v) { return __hip_atomic_fetch_add(p, v, __ATOMIC_RELAXED, __HIP_MEMORY_SCOPE_AGENT); }
DI unsigned xb_xcc_id() { return (unsigned)__builtin_amdgcn_s_getreg((3 << 11) | 20) & 0xFu; }
#define XB_SPIN(cond, bar) do { unsigned _sp = 0; while (cond) { __builtin_amdgcn_s_sleep(1); \
    if ((++_sp & 255u) == 0u) { if (xb_ld(&(bar)[XB_TMO])) break; if (_sp > XB_SPIN_CAP) { atomicAdd(&(bar)[XB_TMO], 1u); break; } } } } while (0)
struct XcdBarrier { unsigned* bar; unsigned x; volatile LAS unsigned* st; };
DI XcdBarrier xcd_barrier_post(unsigned* bar, volatile LAS unsigned* st) {
    XcdBarrier b; b.bar = bar; b.x = xb_xcc_id(); b.st = st;
    if (tidx() == 0) (void)xb_add(&bar[XB_XCNT(b.x)], 1u);
    return b;
}
DI void xcd_barrier_complete(unsigned* bar, unsigned x, unsigned& nloc, unsigned& nx) {
    const unsigned G = gridDim.x * gridDim.y * gridDim.z;
    unsigned sum, cnt, mine, sp = 0u;
    for (;;) {
        sum = 0u; cnt = 0u; mine = 0u;
#pragma unroll
        for (unsigned j = 0; j < 16; ++j) { const unsigned c = xb_ld(&bar[XB_XCNT(j)]); sum += c; cnt += (c > 0u) ? 1u : 0u; mine = (j == x) ? c : mine; }
        if (sum == G) break;
        __builtin_amdgcn_s_sleep(1);
        if ((++sp & 255u) == 0u) { if (xb_ld(&bar[XB_TMO])) break; if (sp > XB_SPIN_CAP) { atomicAdd(&bar[XB_TMO], 1u); break; } }
    }
    nloc = mine > 0u ? mine : 1u; nx = cnt > 0u ? cnt : 1u;
}
DI void xcd_barrier(const XcdBarrier& b) {
    asm volatile("s_waitcnt vmcnt(0)" ::: "memory");
    __syncthreads();
    if (tidx() == 0) {
        unsigned* bar = b.bar;
        __builtin_amdgcn_s_waitcnt(0);
        unsigned nloc = b.st[0], nx = b.st[1];
        if (nloc == 0u) { xcd_barrier_complete(bar, b.x, nloc, nx); b.st[0] = nloc; b.st[1] = nx; }
        const unsigned old = xb_add(&bar[XB_XSUB(b.x)], 1u);
        const unsigned gen = old / nloc;
        if (old + 1u == (gen + 1u) * nloc) {
            __builtin_amdgcn_fence(__ATOMIC_RELEASE, "agent");
            asm volatile("s_waitcnt vmcnt(0)" ::: "memory");
            const unsigned og = xb_add(&bar[XB_TOP], 1u);
            const unsigned tg = og / nx;
            if (og + 1u == (tg + 1u) * nx) xb_add(&bar[XB_TOPGEN], 1u);
            else XB_SPIN(xb_ld(&bar[XB_TOPGEN]) == tg, bar);
            __builtin_amdgcn_fence(__ATOMIC_ACQUIRE, "agent");
            xb_add(&bar[XB_XGEN(b.x)], 1u);
            asm volatile("s_waitcnt vmcnt(0)" ::: "memory");
        } else {
            XB_SPIN(xb_ld(&bar[XB_XGEN(b.x)]) == gen, bar);
            __builtin_amdgcn_fence(__ATOMIC_ACQUIRE, "agent");
            asm volatile("s_waitcnt vmcnt(0)" ::: "memory");
        }
    }
    __syncthreads();
}

__global__ void __launch_bounds__(NTHR, 2) mega_kernel(P p) {
    __shared__ __attribute__((aligned(16))) char smem[SMEM_BYTES];
    __shared__ uint4 xb_words;
    cg::grid_group grid = cg::this_grid();
    if (p.x == nullptr) grid.sync();
    if (tidx() == 0) xb_words = make_uint4(0u, 0u, 0u, 0u);
    __syncthreads();
    const XcdBarrier xb = xcd_barrier_post(p.bar, (volatile LAS unsigned*)&xb_words);
    run_phase(p, 0, smem); xcd_barrier(xb);
    run_phase(p, 1, smem); xcd_barrier(xb);
    run_phase(p, 2, smem); xcd_barrier(xb);
    run_phase(p, 3, smem); xcd_barrier(xb);
    run_phase(p, 4, smem); xcd_barrier(xb);
    run_phase(p, 5, smem); xcd_barrier(xb);
    run_phase(p, 6, smem); xcd_barrier(xb);
    run_phase(p, 7, smem); xcd_barrier(xb);
    run_phase(p, 8, smem); xcd_barrier(xb);
    run_phase(p, 9, smem); xcd_barrier(xb);
    run_phase(p, 10, smem);
}
__global__ void __launch_bounds__(NTHR, 2) phase_kernel(P p, int ph) {
    __shared__ __attribute__((aligned(16))) char smem[SMEM_BYTES];
    run_phase(p, ph, smem);
}

extern "C" void kernel_launch(void* const* d_in, const int* in_sizes, int n_in, void* d_out, int out_size, void* d_ws, size_t ws_size,
                              hipStream_t stream) {
    P p{};
    p.x = (const float*)d_in[0]; p.pos = (const int*)d_in[1]; p.norm_mix = (const float*)d_in[2]; p.w_in = (const float*)d_in[3];
    p.mu = (const float*)d_in[4]; p.w0 = (const float*)d_in[5]; p.w2 = (const float*)d_in[6]; p.a0 = (const float*)d_in[7];
    p.a2 = (const float*)d_in[8]; p.g2 = (const float*)d_in[9]; p.k_k = (const float*)d_in[10]; p.k_a = (const float*)d_in[11];
    p.r_k = (const float*)d_in[12]; p.lnx_w = (const float*)d_in[13]; p.lnx_b = (const float*)d_in[14]; p.pe_k = (const float*)d_in[15];
    p.wk1 = (const float*)d_in[16]; p.bk1 = (const float*)d_in[17]; p.wk2 = (const float*)d_in[18]; p.pe_v = (const float*)d_in[19];
    p.wv1 = (const float*)d_in[20]; p.bv1 = (const float*)d_in[21]; p.wv2 = (const float*)d_in[22]; p.w_out = (const float*)d_in[23];
    p.norm_ffn = (const float*)d_in[24]; p.w_gate = (const float*)d_in[25]; p.w_up = (const float*)d_in[26]; p.w_down = (const float*)d_in[27];
    p.norm_final = (const float*)d_in[28];
    p.out = (float*)d_out;
    char* ws = (char*)d_ws;
    size_t off = 0;
    auto take = [&](size_t bytes) { char* r = ws + off; off += (bytes + 255) & ~(size_t)255; return r; };
    p.WinT = (bf16_t*)take((size_t)3200 * 1024 * 2);
    p.WoutT = (bf16_t*)take((size_t)1024 * 1024 * 2);
    p.WguT = (bf16_t*)take((size_t)5632 * 1024 * 2);
    p.WdnT = (bf16_t*)take((size_t)1024 * DFF * 2);
    p.w2T = (bf16_t*)take(512 * 64 * 2);
    p.a2T = (bf16_t*)take(512 * 64 * 2);
    p.g2T = (bf16_t*)take(512 * 160 * 2);
    p.w1T = (bf16_t*)take((size_t)2 * 256 * 2048 * 2);
    p.wc2T = (bf16_t*)take(2 * 128 * 256 * 2);
    p.b1p = (float*)take(512 * 4);
    p.cosT = (float*)take((size_t)T_ * 8 * 4);
    p.sinT = (float*)take((size_t)T_ * 8 * 4);
    p.counter = (unsigned*)take(256);
    p.bar = (unsigned*)take(XCD_BAR_WORDS * 4);
    off = (size_t)32 << 20;
    p.A = (bf16_t*)take((size_t)T_ * 1024 * 2);
    p.proj = (bf16_t*)take((size_t)T_ * PLD * 2);
    p.stream = (bf16_t*)take((size_t)T_ * 8 * 384 * 2);
    if (off > ws_size) fprintf(stderr, "workspace too small: need %zu have %zu\n", off, ws_size);
    char* ob = (char*)d_out;
    p.gbuf = (bf16_t*)ob;
    p.yraw = (float*)(ob + ((size_t)32 << 20));
    p.vT = (bf16_t*)(ob + ((size_t)96 << 20));
    p.hid = (bf16_t*)(ob + ((size_t)112 << 20));
    p.kc = (bf16_t*)(ob + ((size_t)116 << 20));
    p.vcT = (bf16_t*)(ob + ((size_t)116 << 20) + (512 << 10));
#if MK_SINGLE
    static int grid_blocks = 0;
    if (!grid_blocks) {
        int dev = 0, cus = 0, per_cu = 0;
        hipGetDevice(&dev);
        hipDeviceGetAttribute(&cus, hipDeviceAttributeMultiprocessorCount, dev);
        hipOccupancyMaxActiveBlocksPerMultiprocessor(&per_cu, mega_kernel, NTHR, 0);
        if (per_cu > 2) per_cu = 2;
        if (per_cu < 1) per_cu = 1;
        grid_blocks = cus * per_cu;
    }
    (void)hipMemsetAsync(p.bar, 0, XCD_BAR_WORDS * 4, stream);
    void* args[] = {&p};
    hipError_t e = hipLaunchCooperativeKernel((void*)mega_kernel, dim3(grid_blocks), dim3(NTHR), args, 0, stream);
    if (e != hipSuccess) fprintf(stderr, "cooperative launch failed: %s (grid %d)\n", hipGetErrorString(e), grid_blocks);
#else
    for (int ph = 0; ph < NPHASE; ++ph) phase_kernel<<<512, NTHR, 0, stream>>>(p, ph);
#endif
}
```

```cpp
#include <hip/hip_runtime.h>
#include <hip/hip_cooperative_groups.h>
#include <cstdio>
namespace cg = cooperative_groups;

#ifndef MK_SINGLE
#define MK_SINGLE 1
#endif

#define DI __device__ __forceinline__
typedef unsigned short bf16_t;
typedef short bf16x8 __attribute__((ext_vector_type(8)));
typedef float f32x16 __attribute__((ext_vector_type(16)));
typedef __bf16 bf2_t __attribute__((ext_vector_type(2)));
typedef float f2_t __attribute__((ext_vector_type(2)));

constexpr int T_ = 32768, S_ = 16384;
constexpr int PLD = 3200;
constexpr int QC = 1856, KVC = 2368, GC = 3136;
constexpr int DFF = 2816;
constexpr int NTHR = 256;
constexpr float QSC = 0.125f * 1.4426950408889634f;

#define MFMA32(a, b, c) __builtin_amdgcn_mfma_f32_32x32x16_bf16((a), (b), (c), 0, 0, 0)

DI int tidx() { int r; asm volatile("v_mov_b32 %0, %1" : "=v"(r) : "v"(threadIdx.x)); return r; }
DI unsigned pack2(float a, float b) { f2_t v = {a, b}; return __builtin_bit_cast(unsigned, __builtin_convertvector(v, bf2_t)); }
DI float bflo(unsigned u) { return __uint_as_float(u << 16); }
DI float bfhi(unsigned u) { return __uint_as_float(u & 0xffff0000u); }
DI bf16_t f2bf(float a) { return (bf16_t)(pack2(a, 0.f) & 0xffffu); }
DI void unpack8(const uint4& u, float (&f)[8]) {
    f[0] = bflo(u.x); f[1] = bfhi(u.x); f[2] = bflo(u.y); f[3] = bfhi(u.y);
    f[4] = bflo(u.z); f[5] = bfhi(u.z); f[6] = bflo(u.w); f[7] = bfhi(u.w);
}
DI uint4 pack8(const float (&f)[8]) { uint4 u; u.x = pack2(f[0], f[1]); u.y = pack2(f[2], f[3]); u.z = pack2(f[4], f[5]); u.w = pack2(f[6], f[7]); return u; }
DI float wave_sum(float v) {
#pragma unroll
    for (int o = 32; o; o >>= 1) v += __shfl_xor(v, o);
    return v;
}
DI float sigmoidf_(float x) { return 1.f / (1.f + __expf(-x)); }
DI int crow(int reg, int h) { return (reg & 3) + 8 * (reg >> 2) + 4 * h; }

struct P {
    const float* x; const int* pos; const float *norm_mix, *w_in, *mu, *w0, *w2, *a0, *a2, *g2, *k_k, *k_a, *r_k, *lnx_w, *lnx_b,
        *pe_k, *wk1, *bk1, *wk2, *pe_v, *wv1, *bv1, *wv2, *w_out, *norm_ffn, *w_gate, *w_up, *w_down, *norm_final;
    float* out;
    bf16_t *WinT, *WoutT, *WguT, *WdnT, *w2T, *a2T, *g2T, *w1T, *wc2T;
    float *b1p, *cosT, *sinT;
    unsigned* counter; unsigned* bar;
    bf16_t *A, *proj, *stream;
    bf16_t* gbuf; float* yraw; bf16_t *vT, *hid, *kc, *vcT, *ksw, *vsw;
};

DI float tr_val(const P& p, int job, int k, int n) {
    switch (job) {
    case 0: { int c = n < 1824 ? n : ((n >= 1856 && n < 3160) ? n - 32 : -1); return c >= 0 ? p.w_in[(size_t)k * 3128 + c] : 0.f; }
    case 1: return p.w_out[k * 1024 + n];
    case 2: { int q = n >> 6, r = n & 63; return r < 32 ? p.w_gate[(size_t)k * DFF + q * 32 + r] : p.w_up[(size_t)k * DFF + q * 32 + r - 32]; }
    case 3: return p.w_down[(size_t)k * 1024 + n];
    case 4: return p.w2[k * 512 + n];
    case 5: return p.a2[k * 512 + n];
    case 6: return p.g2[k * 512 + n];
    case 7: return p.wk1[k * 256 + n];
    case 8: return p.wv1[k * 256 + n];
    case 9: return n < 64 ? p.wk2[k * 64 + n] : 0.f;
    default: return n < 64 ? p.wv2[k * 64 + n] : 0.f;
    }
}
DI void tr_item(const P& p, int it, float* tile) {
    int job, K, N; bf16_t* dst;
    if (it < 800) { job = 0; K = 1024; N = 3200; dst = p.WinT; }
    else if (it < 1056) { job = 1; it -= 800; K = 1024; N = 1024; dst = p.WoutT; }
    else if (it < 2464) { job = 2; it -= 1056; K = 1024; N = 5632; dst = p.WguT; }
    else if (it < 3168) { job = 3; it -= 2464; K = 2816; N = 1024; dst = p.WdnT; }
    else if (it < 3176) { job = 4; it -= 3168; K = 64; N = 512; dst = p.w2T; }
    else if (it < 3184) { job = 5; it -= 3176; K = 64; N = 512; dst = p.a2T; }
    else if (it < 3208) { job = 6; it -= 3184; K = 160; N = 512; dst = p.g2T; }
    else if (it < 3336) { job = 7; it -= 3208; K = 2048; N = 256; dst = p.w1T; }
    else if (it < 3464) { job = 8; it -= 3336; K = 2048; N = 256; dst = p.w1T + 256 * 2048; }
    else if (it < 3472) { job = 9; it -= 3464; K = 256; N = 128; dst = p.wc2T; }
    else { job = 10; it -= 3472; K = 256; N = 128; dst = p.wc2T + 128 * 256; }
    const int nt = N >> 6;
    const int k0 = (it / nt) * 64, n0 = (it % nt) * 64;
    const int tid = tidx();
    __syncthreads();
#pragma unroll 4
    for (int i = 0; i < 16; ++i) {
        const int kk = i * 4 + (tid >> 6), nn = tid & 63;
        tile[kk * 65 + nn] = (k0 + kk < K) ? tr_val(p, job, k0 + kk, n0 + nn) : 0.f;
    }
    __syncthreads();
#pragma unroll 4
    for (int i = 0; i < 16; ++i) {
        const int nn = i * 4 + (tid >> 6), kk = tid & 63;
        if (k0 + kk < K) dst[(size_t)(n0 + nn) * K + k0 + kk] = f2bf(tile[kk * 65 + nn]);
    }
}
DI void b1_item(const P& p, int idx) {
    const int kv = idx >> 4, jc = idx & 15, tid = tidx();
    const float* pe = kv ? p.pe_v : p.pe_k; const float* w1 = kv ? p.wv1 : p.wk1; const float* b1 = kv ? p.bv1 : p.bk1;
    const int j = jc * 16 + (tid >> 4), kl = tid & 15;
    float s = 0.f;
    for (int i = 0; i < 128; ++i) { const int k = kl + 16 * i; s += pe[k] * w1[k * 256 + j]; }
    s += __shfl_xor(s, 1); s += __shfl_xor(s, 2); s += __shfl_xor(s, 4); s += __shfl_xor(s, 8);
    if (kl == 0) p.b1p[kv * 256 + j] = b1[j] + s;
}
DI void sincos_d(float ang, float& c, float& s) {
    double x = (double)ang;
    const double TWO_PI = 6.283185307179586476925286766559;
    double n = __builtin_rint(x * (1.0 / TWO_PI));
    double r = x - n * TWO_PI;
    double q = r * 0.25;
    double q2 = q * q;
    double sn = q * (1.0 + q2 * (-1.0 / 6 + q2 * (1.0 / 120 + q2 * (-1.0 / 5040 + q2 * (1.0 / 362880 + q2 * (-1.0 / 39916800 + q2 * (1.0 / 6227020800.0)))))));
    double cs = 1.0 + q2 * (-0.5 + q2 * (1.0 / 24 + q2 * (-1.0 / 720 + q2 * (1.0 / 40320 + q2 * (-1.0 / 3628800 + q2 * (1.0 / 479001600.0))))));
    double s2 = 2 * sn * cs, c2 = 1 - 2 * sn * sn;
    double s4 = 2 * s2 * c2, c4 = 1 - 2 * s2 * s2;
    c = (float)c4; s = (float)s4;
}
DI void cs_item(const P& p, int idx) {
    const int e = idx * 256 + tidx(), tok = e >> 3, f = e & 7;
    const float invf[8] = {1.000000000e+00f, 1.939227432e-01f, 3.760603070e-02f, 7.292664610e-03f, 1.414213562e-03f, 2.742481884e-04f, 5.318295734e-05f, 1.031338525e-05f};
    float iv = invf[0];
#pragma unroll
    for (int i = 1; i < 8; ++i) iv = (f == i) ? invf[i] : iv;
    const float ang = (float)p.pos[tok] * iv;
    float c, s; sincos_d(ang, c, s);
    p.cosT[e] = c; p.sinT[e] = s;
}
DI void rms_item(const float* src, const float* g, bf16_t* dst, int idx) {
    const int row = idx * 4 + (tidx() >> 6), lane = tidx() & 63;
    const float4* sp = (const float4*)(src + (size_t)row * 1024);
    float4 v[4]; float ss = 0.f;
#pragma unroll
    for (int i = 0; i < 4; ++i) { v[i] = sp[lane + 64 * i]; ss += v[i].x * v[i].x + v[i].y * v[i].y + v[i].z * v[i].z + v[i].w * v[i].w; }
    ss = wave_sum(ss);
    const float rs = rsqrtf(ss * (1.f / 1024.f) + 1e-6f);
#pragma unroll
    for (int i = 0; i < 4; ++i) {
        const float4 gv = ((const float4*)g)[lane + 64 * i];
        uint2 o; o.x = pack2(v[i].x * rs * gv.x, v[i].y * rs * gv.y); o.y = pack2(v[i].z * rs * gv.z, v[i].w * rs * gv.w);
        *(uint2*)(dst + (size_t)row * 1024 + (lane + 64 * i) * 4) = o;
    }
}
DI void phase0(const P& p, char* smem) {
    if (blockIdx.x == 0 && tidx() < 8) p.counter[tidx()] = 0u;
    constexpr int NTR = 3480, NB1 = 32, NCS = 1024, NXN = 8192;
    for (int it = blockIdx.x; it < NTR + NB1 + NCS + NXN; it += gridDim.x) {
        if (it < NTR) tr_item(p, it, (float*)smem);
        else if (it < NTR + NB1) b1_item(p, it - NTR);
        else if (it < NTR + NB1 + NCS) cs_item(p, it - NTR - NB1);
        else rms_item(p.x, p.norm_mix, p.A, it - NTR - NB1 - NCS);
    }
}

struct AFPlain { const bf16_t* A; int lda; DI uint4 load(int row, int k) const { return *(const uint4*)(A + (size_t)row * lda + k); } };
struct AFCmp {
    const bf16_t* base;
    DI uint4 load(int r, int k) const { int tok = 16 * r + (k >> 6); tok = tok < S_ ? tok : S_ - 1; return *(const uint4*)(base + (size_t)tok * PLD + (k & 63)); }
};

template <int KU, class AF, class EPI>
DI void gemm_tile(const AF af, const bf16_t* __restrict__ Bt, const int K, const int m0, const int n0, const EPI epi, char* smem) {
    const int tid = tidx(), wave = tid >> 6, lane = tid & 63, wm = wave >> 1, wn = wave & 1, rr = lane & 31, hh = lane >> 5;
    f32x16 acc[2][2];
#pragma unroll
    for (int a = 0; a < 2; ++a)
#pragma unroll
        for (int b = 0; b < 2; ++b)
#pragma unroll
            for (int i = 0; i < 16; ++i) acc[a][b][i] = 0.f;
    const int lrow = tid >> 3, lk = (tid & 7) * 8;
#define GLOAD(R, KO) \
    R##a0 = af.load(m0 + lrow, (KO) + lk); R##a1 = af.load(m0 + lrow + 32, (KO) + lk); R##a2 = af.load(m0 + lrow + 64, (KO) + lk); R##a3 = af.load(m0 + lrow + 96, (KO) + lk); \
    R##b0 = *(const uint4*)(Bt + (size_t)(lrow) * K + (KO) + lk); R##b1 = *(const uint4*)(Bt + (size_t)(lrow + 32) * K + (KO) + lk); \
    R##b2 = *(const uint4*)(Bt + (size_t)(lrow + 64) * K + (KO) + lk); R##b3 = *(const uint4*)(Bt + (size_t)(lrow + 96) * K + (KO) + lk);
#define GSTORE(R, SA, SB) \
    *(uint4*)&(SA)[(lrow) * 72 + lk] = R##a0; *(uint4*)&(SA)[(lrow + 32) * 72 + lk] = R##a1; *(uint4*)&(SA)[(lrow + 64) * 72 + lk] = R##a2; *(uint4*)&(SA)[(lrow + 96) * 72 + lk] = R##a3; \
    *(uint4*)&(SB)[(lrow) * 72 + lk] = R##b0; *(uint4*)&(SB)[(lrow + 32) * 72 + lk] = R##b1; *(uint4*)&(SB)[(lrow + 64) * 72 + lk] = R##b2; *(uint4*)&(SB)[(lrow + 96) * 72 + lk] = R##b3;
#define GCOMPUTE(SA, SB) \
    _Pragma("unroll") for (int ks = 0; ks < 4; ++ks) { \
        bf16x8 tf0 = *(const bf16x8*)&(SA)[(wm * 64 + rr) * 72 + ks * 16 + hh * 8], tf1 = *(const bf16x8*)&(SA)[(wm * 64 + 32 + rr) * 72 + ks * 16 + hh * 8]; \
        bf16x8 wf0 = *(const bf16x8*)&(SB)[(wn * 64 + rr) * 72 + ks * 16 + hh * 8], wf1 = *(const bf16x8*)&(SB)[(wn * 64 + 32 + rr) * 72 + ks * 16 + hh * 8]; \
        acc[0][0] = MFMA32(wf0, tf0, acc[0][0]); acc[0][1] = MFMA32(wf0, tf1, acc[0][1]); acc[1][0] = MFMA32(wf1, tf0, acc[1][0]); acc[1][1] = MFMA32(wf1, tf1, acc[1][1]); }
    uint4 Xa0, Xa1, Xa2, Xa3, Xb0, Xb1, Xb2, Xb3, Ya0, Ya1, Ya2, Ya3, Yb0, Yb1, Yb2, Yb3;
    bf16_t* const sA0 = (bf16_t*)smem; bf16_t* const sB0 = sA0 + 128 * 72; bf16_t* const sA1 = sB0 + 128 * 72; bf16_t* const sB1 = sA1 + 128 * 72;
    GLOAD(X, 0)
    GLOAD(Y, 64)
    __syncthreads();
    GSTORE(X, sA0, sB0)
    __syncthreads();
#pragma unroll KU
    for (int k0 = 0; k0 < K; k0 += 128) {
        const bool more = (k0 + 128 < K);
        if (more) { GLOAD(X, k0 + 128) }
        GCOMPUTE(sA0, sB0)
        GSTORE(Y, sA1, sB1)
        __syncthreads();
        __builtin_amdgcn_sched_barrier(0);
        if (more) { GLOAD(Y, k0 + 192) }
        GCOMPUTE(sA1, sB1)
        if (more) { GSTORE(X, sA0, sB0) }
        __syncthreads();
        __builtin_amdgcn_sched_barrier(0);
    }
#undef GLOAD
#undef GSTORE
#undef GCOMPUTE
    epi(acc, m0 + wm * 64, n0 + wn * 64, lane);
}

struct EpiProj {
    bf16_t* C;
    DI void operator()(const f32x16 (&acc)[2][2], int rowbase, int colbase, int lane) const {
        const int rr = lane & 31, hh = lane >> 5;
#pragma unroll
        for (int w = 0; w < 2; ++w)
#pragma unroll
            for (int t = 0; t < 2; ++t)
#pragma unroll
                for (int j = 0; j < 4; ++j) {
                    uint2 o; o.x = pack2(acc[w][t][4 * j], acc[w][t][4 * j + 1]); o.y = pack2(acc[w][t][4 * j + 2], acc[w][t][4 * j + 3]);
                    *(uint2*)(C + (size_t)(rowbase + t * 32 + rr) * PLD + colbase + w * 32 + j * 8 + hh * 4) = o;
                }
    }
};
struct EpiHid {
    bf16_t* H; const float* bias;
    DI void operator()(const f32x16 (&acc)[2][2], int rowbase, int colbase, int lane) const {
        const int rr = lane & 31, hh = lane >> 5;
#pragma unroll
        for (int w = 0; w < 2; ++w)
#pragma unroll
            for (int t = 0; t < 2; ++t)
#pragma unroll
                for (int j = 0; j < 4; ++j) {
                    const int col = colbase + w * 32 + j * 8 + hh * 4;
                    const float4 bv = *(const float4*)(bias + col);
                    float v0 = acc[w][t][4 * j] + bv.x, v1 = acc[w][t][4 * j + 1] + bv.y, v2 = acc[w][t][4 * j + 2] + bv.z, v3 = acc[w][t][4 * j + 3] + bv.w;
                    v0 *= sigmoidf_(v0); v1 *= sigmoidf_(v1); v2 *= sigmoidf_(v2); v3 *= sigmoidf_(v3);
                    uint2 o; o.x = pack2(v0, v1); o.y = pack2(v2, v3);
                    *(uint2*)(H + (size_t)(rowbase + t * 32 + rr) * 256 + col) = o;
                }
    }
};
struct EpiKc {
    bf16_t* kc; const float *cosT, *sinT; int tokbase;
    DI void operator()(const f32x16 (&acc)[2][2], int rowbase, int colbase, int lane) const {
        if (colbase != 0) return;
        const int rr = lane & 31, hh = lane >> 5;
#pragma unroll
        for (int t = 0; t < 2; ++t) {
            const int r = rowbase + t * 32 + rr;
            int tk = 31 + 16 * r; tk = tk < S_ ? tk : S_ - 1;
            const float4 c = *(const float4*)(cosT + (size_t)(tokbase + tk) * 8 + hh * 4), s = *(const float4*)(sinT + (size_t)(tokbase + tk) * 8 + hh * 4);
            bf16_t* kp = kc + (size_t)r * 64 + hh * 4;
            const float a0 = acc[0][t][0], a1 = acc[0][t][1], a2 = acc[0][t][2], a3 = acc[0][t][3];
            const float b0 = acc[0][t][4], b1 = acc[0][t][5], b2 = acc[0][t][6], b3 = acc[0][t][7];
            uint2 o;
            o.x = pack2(a0 * c.x - b0 * s.x, a1 * c.y - b1 * s.y); o.y = pack2(a2 * c.z - b2 * s.z, a3 * c.w - b3 * s.w);
            *(uint2*)(kp) = o;
            o.x = pack2(b0 * c.x + a0 * s.x, b1 * c.y + a1 * s.y); o.y = pack2(b2 * c.z + a2 * s.z, b3 * c.w + a3 * s.w);
            *(uint2*)(kp + 8) = o;
#pragma unroll
            for (int j = 2; j < 4; ++j) {
                o.x = pack2(acc[0][t][4 * j], acc[0][t][4 * j + 1]); o.y = pack2(acc[0][t][4 * j + 2], acc[0][t][4 * j + 3]);
                *(uint2*)(kp + j * 8) = o;
            }
#pragma unroll
            for (int j = 0; j < 4; ++j) {
                o.x = pack2(acc[1][t][4 * j], acc[1][t][4 * j + 1]); o.y = pack2(acc[1][t][4 * j + 2], acc[1][t][4 * j + 3]);
                *(uint2*)(kp + 32 + j * 8) = o;
            }
        }
    }
};
struct EpiVc {
    bf16_t* vcT; char* smem;
    DI void operator()(const f32x16 (&acc)[2][2], int rowbase, int colbase, int lane) const {
        const int rr = lane & 31, hh = lane >> 5;
        bf16_t* tl = (bf16_t*)smem;
        __syncthreads();
        if (colbase == 0) {
            const int rl = rowbase & 127;
#pragma unroll
            for (int w = 0; w < 2; ++w)
#pragma unroll
                for (int t = 0; t < 2; ++t)
#pragma unroll
                    for (int i = 0; i < 16; ++i) tl[(w * 32 + crow(i, hh)) * 136 + rl + t * 32 + rr] = f2bf(acc[w][t][i]);
        }
        __syncthreads();
        const int m0 = rowbase & ~127;
#pragma unroll
        for (int i = 0; i < 4; ++i) {
            const int c = tidx() + i * 256, d = c >> 4, ch = c & 15;
            *(uint4*)(vcT + (size_t)d * 1024 + m0 + ch * 8) = *(const uint4*)&tl[d * 136 + ch * 8];
        }
    }
};
struct EpiOut {
    float* out; const float* x;
    DI void operator()(const f32x16 (&acc)[2][2], int rowbase, int colbase, int lane) const {
        const int rr = lane & 31, hh = lane >> 5;
#pragma unroll
        for (int w = 0; w < 2; ++w)
#pragma unroll
            for (int t = 0; t < 2; ++t)
#pragma unroll
                for (int j = 0; j < 4; ++j) {
                    const size_t o = (size_t)(rowbase + t * 32 + rr) * 1024 + colbase + w * 32 + j * 8 + hh * 4;
                    float4 xv = *(const float4*)(x + o);
                    xv.x += acc[w][t][4 * j]; xv.y += acc[w][t][4 * j + 1]; xv.z += acc[w][t][4 * j + 2]; xv.w += acc[w][t][4 * j + 3];
                    *(float4*)(out + o) = xv;
                }
    }
};
struct EpiFfn1 {
    bf16_t* act;
    DI void operator()(const f32x16 (&acc)[2][2], int rowbase, int colbase, int lane) const {
        const int rr = lane & 31, hh = lane >> 5;
        const int cb = (colbase >> 6) * 32;
#pragma unroll
        for (int t = 0; t < 2; ++t)
#pragma unroll
            for (int j = 0; j < 4; ++j) {
                float v[4];
#pragma unroll
                for (int i = 0; i < 4; ++i) { const float g = acc[0][t][4 * j + i], u = acc[1][t][4 * j + i]; v[i] = g * sigmoidf_(g) * u; }
                uint2 o; o.x = pack2(v[0], v[1]); o.y = pack2(v[2], v[3]);
                *(uint2*)(act + (size_t)(rowbase + t * 32 + rr) * DFF + cb + j * 8 + hh * 4) = o;
            }
    }
};

DI void rwkv_prep(const P& p, int idx, char* smem) {
    const int tile = idx, tt0 = tile * 32;
    const int tid = tidx(), wave = tid >> 6, lane = tid & 63, rr = lane & 31, hh = lane >> 5;
    bf16_t* lat = (bf16_t*)smem;
    float* res = (float*)(smem + 32 * 296 * 2);
    __syncthreads();
    for (int c = tid; c < 32 * 36; c += NTHR) {
        const int tok = c / 36, ch = c - tok * 36, gi = tt0 + tok, col = 1536 + ch * 8;
        const uint4 cu = *(const uint4*)(p.proj + (size_t)gi * PLD + col);
        uint4 pv = make_uint4(0, 0, 0, 0);
        if ((gi & (S_ - 1)) != 0) pv = *(const uint4*)(p.proj + (size_t)(gi - 1) * PLD + col);
        float a[8], b[8]; unpack8(cu, a); unpack8(pv, b);
        const float4 m0 = *(const float4*)(p.mu + col), m1 = *(const float4*)(p.mu + col + 4);
        const float mu[8] = {m0.x, m0.y, m0.z, m0.w, m1.x, m1.y, m1.z, m1.w};
#pragma unroll
        for (int e = 0; e < 8; ++e) {
            float x = a[e] + (b[e] - a[e]) * mu[e];
            if (ch < 8) x = 1.f - 2.f / (1.f + __expf(2.f * x)); else if (ch >= 16) x = sigmoidf_(x);
            a[e] = x;
        }
        *(uint4*)&lat[tok * 296 + ch * 8] = pack8(a);
    }
    __syncthreads();
#pragma unroll 1
    for (int h = 0; h < 8; ++h) {
    if (wave < 2) {
        const int mt = wave;
        f32x16 aw, aa;
#pragma unroll
        for (int i = 0; i < 16; ++i) { aw[i] = 0.f; aa[i] = 0.f; }
#pragma unroll
        for (int ks = 0; ks < 4; ++ks) {
            const bf16x8 wf = *(const bf16x8*)(p.w2T + (size_t)(h * 64 + mt * 32 + rr) * 64 + ks * 16 + hh * 8);
            const bf16x8 af = *(const bf16x8*)(p.a2T + (size_t)(h * 64 + mt * 32 + rr) * 64 + ks * 16 + hh * 8);
            const bf16x8 l0 = *(const bf16x8*)&lat[rr * 296 + ks * 16 + hh * 8];
            const bf16x8 l1 = *(const bf16x8*)&lat[rr * 296 + 64 + ks * 16 + hh * 8];
            aw = MFMA32(wf, l0, aw); aa = MFMA32(af, l1, aa);
        }
#pragma unroll
        for (int j = 0; j < 4; ++j) {
            *(float4*)&res[(0 * 32 + rr) * 64 + mt * 32 + j * 8 + hh * 4] = make_float4(aw[4 * j], aw[4 * j + 1], aw[4 * j + 2], aw[4 * j + 3]);
            *(float4*)&res[(1 * 32 + rr) * 64 + mt * 32 + j * 8 + hh * 4] = make_float4(aa[4 * j], aa[4 * j + 1], aa[4 * j + 2], aa[4 * j + 3]);
        }
    } else {
        const int mt = wave - 2;
        f32x16 ag;
#pragma unroll
        for (int i = 0; i < 16; ++i) ag[i] = 0.f;
#pragma unroll
        for (int ks = 0; ks < 10; ++ks) {
            const bf16x8 gf = *(const bf16x8*)(p.g2T + (size_t)(h * 64 + mt * 32 + rr) * 160 + ks * 16 + hh * 8);
            const bf16x8 l2 = *(const bf16x8*)&lat[rr * 296 + 128 + ks * 16 + hh * 8];
            ag = MFMA32(gf, l2, ag);
        }
#pragma unroll
        for (int j = 0; j < 4; ++j)
            *(float4*)&res[(2 * 32 + rr) * 64 + mt * 32 + j * 8 + hh * 4] = make_float4(ag[4 * j], ag[4 * j + 1], ag[4 * j + 2], ag[4 * j + 3]);
    }
    __syncthreads();
    {
        const int tok = tid >> 3, cgp = tid & 7, gi = tt0 + tok, b = gi >> 14, s = gi & (S_ - 1), cb = h * 64 + cgp * 8;
        const bool first = (s == 0);
        float r[8], k[8], v[8];
        {
            float a[8], pb[8];
            const bf16_t* pr = p.proj + (size_t)gi * PLD;
#pragma unroll
            for (int q = 0; q < 3; ++q) {
                const int col = q * 512 + cb;
                unpack8(*(const uint4*)(pr + col), a);
                if (first) {
#pragma unroll
                    for (int e = 0; e < 8; ++e) pb[e] = 0.f;
                } else unpack8(*(const uint4*)(pr - PLD + col), pb);
                const float4 m0 = *(const float4*)(p.mu + col), m1 = *(const float4*)(p.mu + col + 4);
                const float mu[8] = {m0.x, m0.y, m0.z, m0.w, m1.x, m1.y, m1.z, m1.w};
#pragma unroll
                for (int e = 0; e < 8; ++e) {
                    const float x = a[e] + (pb[e] - a[e]) * mu[e];
                    if (q == 0) r[e] = x; else if (q == 1) k[e] = x; else v[e] = x;
                }
            }
        }
        float om[8], av[8], gg[8], kk[8], km[8], bb[8];
        float ss = 0.f;
#pragma unroll
        for (int e = 0; e < 8; ++e) {
            const float wp = res[(0 * 32 + tok) * 64 + cgp * 8 + e] + p.w0[cb + e];
            const float z = -wp;
            const float sp = fmaxf(z, 0.f) + __logf(1.f + __expf(-fabsf(z)));
            const float w = -sp - 0.5f;
            om[e] = 1.f - __expf(-__expf(w));
            av[e] = sigmoidf_(res[(1 * 32 + tok) * 64 + cgp * 8 + e] + p.a0[cb + e]);
            gg[e] = res[(2 * 32 + tok) * 64 + cgp * 8 + e];
            kk[e] = k[e] * p.k_k[cb + e];
            ss += kk[e] * kk[e];
            km[e] = k[e] * (1.f + (av[e] - 1.f) * p.k_a[cb + e]);
        }
        ss += __shfl_xor(ss, 1); ss += __shfl_xor(ss, 2); ss += __shfl_xor(ss, 4);
        const float inv = 1.f / fmaxf(sqrtf(ss), 1e-12f);
#pragma unroll
        for (int e = 0; e < 8; ++e) { kk[e] *= inv; bb[e] = kk[e] * av[e]; }
        bf16_t* sp = p.stream + ((size_t)((b * 8 + h) * S_ + s) * 6) * 64 + cgp * 8;
        *(uint4*)(sp) = pack8(om); *(uint4*)(sp + 64) = pack8(km); *(uint4*)(sp + 128) = pack8(kk);
        *(uint4*)(sp + 192) = pack8(bb); *(uint4*)(sp + 256) = pack8(r); *(uint4*)(sp + 320) = pack8(v);
        *(uint4*)(p.gbuf + (size_t)gi * 512 + cb) = pack8(gg);
    }
    __syncthreads();
    }
}

DI void rope_item(const P& p, int idx, char* smem) {
    const int tt0 = idx * 64, tid = tidx();
    bf16_t* vtile = (bf16_t*)smem;
    bf16_t* ktile = vtile + 4 * 64 * 72;
    __syncthreads();
#pragma unroll 1
    for (int it = 0; it < 2; ++it) {
        const int item = tid + it * 256, tok = item >> 3, head = item & 7, gi = tt0 + tok;
        bf16_t* ptr = p.proj + (size_t)gi * PLD + QC + head * 64;
        const float4 c0 = *(const float4*)(p.cosT + (size_t)gi * 8), c1 = *(const float4*)(p.cosT + (size_t)gi * 8 + 4);
        const float4 s0 = *(const float4*)(p.sinT + (size_t)gi * 8), s1 = *(const float4*)(p.sinT + (size_t)gi * 8 + 4);
        const float cc[8] = {c0.x, c0.y, c0.z, c0.w, c1.x, c1.y, c1.z, c1.w}, sn[8] = {s0.x, s0.y, s0.z, s0.w, s1.x, s1.y, s1.z, s1.w};
        float a[8], b[8];
        unpack8(*(const uint4*)ptr, a); unpack8(*(const uint4*)(ptr + 8), b);
#pragma unroll
        for (int e = 0; e < 8; ++e) { const float x1 = a[e], x2 = b[e]; a[e] = (x1 * cc[e] - x2 * sn[e]) * QSC; b[e] = (x2 * cc[e] + x1 * sn[e]) * QSC; }
        *(uint4*)ptr = pack8(a); *(uint4*)(ptr + 8) = pack8(b);
#pragma unroll
        for (int q = 2; q < 8; ++q) {
            unpack8(*(const uint4*)(ptr + q * 8), a);
#pragma unroll
            for (int e = 0; e < 8; ++e) a[e] *= QSC;
            *(uint4*)(ptr + q * 8) = pack8(a);
        }
    }
    {
        const int tok = tid >> 2, sel = (tid >> 1) & 1, hk = tid & 1, gi = tt0 + tok;
        const float4 c0 = *(const float4*)(p.cosT + (size_t)gi * 8), c1 = *(const float4*)(p.cosT + (size_t)gi * 8 + 4);
        const float4 s0 = *(const float4*)(p.sinT + (size_t)gi * 8), s1 = *(const float4*)(p.sinT + (size_t)gi * 8 + 4);
        const float cc[8] = {c0.x, c0.y, c0.z, c0.w, c1.x, c1.y, c1.z, c1.w}, sn[8] = {s0.x, s0.y, s0.z, s0.w, s1.x, s1.y, s1.z, s1.w};
        float a[8], b[8];
        {
            bf16_t* ptr = p.proj + (size_t)gi * PLD + KVC + (sel ? 4 : 2) * 128 + hk * 64;
            unpack8(*(const uint4*)ptr, a); unpack8(*(const uint4*)(ptr + 8), b);
#pragma unroll
            for (int e = 0; e < 8; ++e) { const float x1 = a[e], x2 = b[e]; a[e] = x1 * cc[e] - x2 * sn[e]; b[e] = x2 * cc[e] + x1 * sn[e]; }
            const uint4 ra_ = pack8(a), rb_ = pack8(b);
            *(uint4*)ptr = ra_; *(uint4*)(ptr + 8) = rb_;
            if (sel == 0) {
                bf16_t* kt = ktile + (size_t)(hk * 64 + tok) * 72;
                *(uint4*)kt = ra_; *(uint4*)(kt + 8) = rb_;
#pragma unroll
                for (int q = 2; q < 8; ++q) *(uint4*)(kt + q * 8) = *(const uint4*)(ptr + q * 8);
            }
        }
        {
            const bf16_t* ptr = p.proj + (size_t)gi * PLD + KVC + (sel ? 5 : 3) * 128 + hk * 64;
            bf16_t* vt = vtile + (size_t)((sel * 2 + hk) * 64) * 72 + tok;
            unpack8(*(const uint4*)ptr, a); unpack8(*(const uint4*)(ptr + 8), b);
#pragma unroll
            for (int e = 0; e < 8; ++e) { const float x1 = a[e], x2 = b[e]; a[e] = x1 * cc[e] - x2 * sn[e]; b[e] = x2 * cc[e] + x1 * sn[e]; }
#pragma unroll
            for (int e = 0; e < 8; ++e) { vt[e * 72] = f2bf(a[e]); vt[(8 + e) * 72] = f2bf(b[e]); }
#pragma unroll
            for (int q = 2; q < 8; ++q) {
                const uint4 u = *(const uint4*)(ptr + q * 8);
                const unsigned w[4] = {u.x, u.y, u.z, u.w};
#pragma unroll
                for (int e = 0; e < 4; ++e) { vt[(q * 8 + 2 * e) * 72] = (bf16_t)(w[e] & 0xffffu); vt[(q * 8 + 2 * e + 1) * 72] = (bf16_t)(w[e] >> 16); }
            }
        }
    }
    __syncthreads();
    const int b = tt0 >> 14, s0 = tt0 & (S_ - 1);
#pragma unroll
    for (int i = 0; i < 8; ++i) {
        const int c = tid + i * 256, grp = c >> 9, d = (c >> 3) & 63, ch = c & 7, sel = grp >> 1, hk = grp & 1;
        const uint4 u = *(const uint4*)&vtile[(size_t)(grp * 64 + d) * 72 + ch * 8];
        *(uint4*)(p.vT + ((size_t)((sel * 4 + b * 2 + hk) * 64 + d)) * S_ + s0 + ch * 8) = u;
    }
    const int blk = s0 >> 6;
#pragma unroll
    for (int i = 0; i < 4; ++i) {
        const int c = tid + i * 256, hk = c >> 9, g8 = (c >> 6) & 7, ln = c & 63, rr = ln & 31, hh = ln >> 5;
        const size_t dsto = ((size_t)(((b * 2 + hk) * 256 + blk) * 8 + g8) * 64 + ln) * 8;
        {
            const int mt = g8 >> 2, ks = g8 & 3;
            *(uint4*)(p.ksw + dsto) = *(const uint4*)&ktile[(size_t)(hk * 64 + mt * 32 + rr) * 72 + ks * 16 + hh * 8];
        }
        {
            const int mt = g8 >> 2, s2 = (g8 >> 1) & 1, dt = g8 & 1;
            const bf16_t* row = &vtile[(size_t)((0 * 2 + hk) * 64 + dt * 32 + rr) * 72 + mt * 32 + 16 * s2 + 4 * hh];
            const uint2 lo = *(const uint2*)row, hi = *(const uint2*)(row + 8);
            *(uint4*)(p.vsw + dsto) = make_uint4(lo.x, lo.y, hi.x, hi.y);
        }
    }
}

DI void cmp1_item(const P& p, const int it, char* smem) {
    const int kv = it >> 6, bhk = (it >> 4) & 3, mt = (it >> 1) & 7, nt = it & 1, b = bhk >> 1, hk = bhk & 1;
    AFCmp af{p.proj + (size_t)(b * S_) * PLD + KVC + kv * 128 + hk * 64};
    EpiHid ep{p.hid + (size_t)((kv * 4 + bhk) * 1024) * 256, p.b1p + kv * 256};
    gemm_tile<1>(af, p.w1T + (size_t)(kv * 256 + nt * 128) * 2048, 2048, mt * 128, nt * 128, ep, smem);
}
DI void cmp2_item(const P& p, const int it, char* smem) {
    const int kv = it >> 5, bhk = (it >> 3) & 3, mt = it & 7, b = bhk >> 1;
    AFPlain af{p.hid + (size_t)((kv * 4 + bhk) * 1024) * 256, 256};
    if (kv == 0) { EpiKc ep{p.kc + (size_t)bhk * 1024 * 64, p.cosT, p.sinT, b * S_}; gemm_tile<1>(af, p.wc2T, 256, mt * 128, 0, ep, smem); }
    else { EpiVc ep{p.vcT + (size_t)bhk * 64 * 1024, smem}; gemm_tile<1>(af, p.wc2T + 128 * 256, 256, mt * 128, 0, ep, smem); }
}
DI void phase2(const P& p, char* smem) {
    for (int it = blockIdx.x; it < 128 + 512 + 1024; it += gridDim.x) {
        if (it < 128) cmp1_item(p, it, smem);
        else if (it < 640) rope_item(p, it - 128, smem);
        else rwkv_prep(p, it - 640, smem);
    }
}
DI void phase3(const P& p, char* smem) {
    for (int it = blockIdx.x; it < 64; it += gridDim.x) cmp2_item(p, it, smem);
}

template <int CTRL> DI float dpp_add(float x) { return x + __int_as_float(__builtin_amdgcn_mov_dpp(__float_as_int(x), CTRL, 0xF, 0xF, true)); }
DI float red16(float x) { x = dpp_add<0xB1>(x); x = dpp_add<0x4E>(x); x = dpp_add<0x141>(x); x = dpp_add<0x140>(x); return x; }

DI void cvt_store(const uint4 u, const bool isom, float* d) {
    float f0 = bflo(u.x), f1 = bfhi(u.x), f2 = bflo(u.y), f3 = bfhi(u.y), f4 = bflo(u.z), f5 = bfhi(u.z), f6 = bflo(u.w), f7 = bfhi(u.w);
    if (isom) { f0 = 1.f - f0; f1 = 1.f - f1; f2 = 1.f - f2; f3 = 1.f - f3; f4 = 1.f - f4; f5 = 1.f - f5; f6 = 1.f - f6; f7 = 1.f - f7; }
    *(float4*)d = make_float4(f0, f1, f2, f3); *(float4*)(d + 4) = make_float4(f4, f5, f6, f7);
}
DI void scan_unit(const P& p, int su, char* smem) {
    const int xcd = su & 7, kq = su >> 3, bh = xcd * 2 + (kq >> 3), oct = kq & 7, b = bh >> 3, h = bh & 7;
    const int tid = tidx(), wave = tid >> 6, lane = tid & 63;
    float* buf = (float*)smem;
    float* ypb = (float*)(smem + 49152);
    const bf16_t* sbase = p.stream + (size_t)bh * S_ * 384;
    __syncthreads();
#pragma unroll
    for (int i = 0; i < 3; ++i) { const int ci = tid + i * 256; cvt_store(*(const uint4*)(sbase + (size_t)ci * 8), (ci % 48) < 8, buf + ci * 8); }
    __syncthreads();
    if (wave < 2) {
        const int rl = lane >> 4, ks = lane & 15, row = oct * 8 + wave * 4 + rl;
        f2_t sA = {0.f, 0.f}, sB = {0.f, 0.f};
        __builtin_amdgcn_s_setprio(3);
        for (int c = 0; c < 1024; ++c) {
            const float* cb = buf + (c & 1) * 6144 + ks * 4;
            const float* vb = buf + (c & 1) * 6144 + 320 + row;
            float* yo = ypb + ((c & 1) * 2 + wave) * 1024 + lane;
            float4 dec = *(const float4*)(cb), km = *(const float4*)(cb + 64), kk = *(const float4*)(cb + 128), bb = *(const float4*)(cb + 192), rv = *(const float4*)(cb + 256);
            float v = vb[0];
            float4 dec1 = *(const float4*)(cb + 384), km1 = *(const float4*)(cb + 384 + 64), kk1 = *(const float4*)(cb + 384 + 128), bb1 = *(const float4*)(cb + 384 + 192), rv1 = *(const float4*)(cb + 384 + 256);
            float v1 = vb[384];
#pragma unroll
            for (int st = 0; st < 16; ++st) {
                float4 dec2 = dec1, km2 = km1, kk2 = kk1, bb2 = bb1, rv2 = rv1; float v2 = v1;
                if (st < 14) {
                    const float* rec = cb + (st + 2) * 384;
                    dec2 = *(const float4*)(rec); km2 = *(const float4*)(rec + 64); kk2 = *(const float4*)(rec + 128); bb2 = *(const float4*)(rec + 192); rv2 = *(const float4*)(rec + 256);
                    v2 = vb[(st + 2) * 384];
                }
                __builtin_amdgcn_sched_barrier(0x207);
                const f2_t vv = {v, v};
                const f2_t d01 = {dec.x, dec.y}, d23 = {dec.z, dec.w}, m01 = {km.x, km.y}, m23 = {km.z, km.w};
                const f2_t k01 = {kk.x, kk.y}, k23 = {kk.z, kk.w}, b01 = {bb.x, bb.y}, b23 = {bb.z, bb.w}, r01 = {rv.x, rv.y}, r23 = {rv.z, rv.w};
                const f2_t tA = sA * d01 + vv * m01, tB = sB * d23 + vv * m23;
                f2_t pa = sA * k01; pa = sB * k23 + pa;
                const float sa = red16(pa.x + pa.y);
                const f2_t sav = {sa, sa};
                sA = tA - sav * b01; sB = tB - sav * b23;
                f2_t ya = sA * r01; ya = sB * r23 + ya;
                yo[st * 64] = ya.x + ya.y;
                dec = dec1; km = km1; kk = kk1; bb = bb1; rv = rv1; v = v1;
                dec1 = dec2; km1 = km2; kk1 = kk2; bb1 = bb2; rv1 = rv2; v1 = v2;
            }
            __syncthreads();
        }
        __builtin_amdgcn_s_setprio(0);
    } else {
        const int ht = tid - 128;
        const int ystep = ht >> 3, r8 = ht & 7;
        float* yout = p.yraw + (size_t)(b * S_) * 512 + h * 64 + oct * 8 + r8;
        const float* ysrc = ypb + (r8 >> 2) * 1024 + ystep * 64 + (r8 & 3) * 16;
        uint4 ra0, ra1, ra2, ra3, ra4, ra5, rb0, rb1, rb2, rb3, rb4, rb5;
#define SLOAD(R, CH) { const bf16_t* sp_ = sbase + (size_t)(CH) * 6144 + (size_t)ht * 8; \
        R##0 = *(const uint4*)(sp_); R##1 = *(const uint4*)(sp_ + 1024); R##2 = *(const uint4*)(sp_ + 2048); R##3 = *(const uint4*)(sp_ + 3072); R##4 = *(const uint4*)(sp_ + 4096); R##5 = *(const uint4*)(sp_ + 5120); }
#define SSTORE(R, BI) { float* d_ = buf + (BI) * 6144 + ht * 8; const bool om_ = (ht % 48) < 8; \
        cvt_store(R##0, om_, d_); cvt_store(R##1, ((ht + 128) % 48) < 8, d_ + 1024); cvt_store(R##2, ((ht + 256) % 48) < 8, d_ + 2048); \
        cvt_store(R##3, ((ht + 384) % 48) < 8, d_ + 3072); cvt_store(R##4, ((ht + 512) % 48) < 8, d_ + 4096); cvt_store(R##5, ((ht + 640) % 48) < 8, d_ + 5120); }
#define YRED(C) { const float* ys_ = ysrc + ((C) & 1) * 2048; const float4 a_ = *(const float4*)ys_, b_ = *(const float4*)(ys_ + 4), c_ = *(const float4*)(ys_ + 8), d_ = *(const float4*)(ys_ + 12); \
        yout[(size_t)((C) * 16 + ystep) * 512] = ((a_.x + a_.y) + (a_.z + a_.w)) + ((b_.x + b_.y) + (b_.z + b_.w)) + ((c_.x + c_.y) + (c_.z + c_.w)) + ((d_.x + d_.y) + (d_.z + d_.w)); }
        SLOAD(ra, 1)
        for (int c = 0; c < 1024; c += 2) {
            if (c + 2 < 1024) SLOAD(rb, c + 2)
            SSTORE(ra, 1)
            if (c >= 1) YRED(c - 1)
            __syncthreads();
            if (c + 3 < 1024) SLOAD(ra, c + 3)
            if (c + 2 < 1024) SSTORE(rb, 0)
            YRED(c)
            __syncthreads();
        }
        YRED(1023)
#undef SLOAD
#undef SSTORE
#undef YRED
    }
}

struct AttnSmem {
    bf16_t k[64 * 72];
    bf16_t vt[64 * 68];
    float imp[32 * 256];
    unsigned selbits[32 * 8];
    unsigned wunion[4 * 8];
    unsigned bunion[8];
    int unit;
    int pad_[3];
    uint4 q[4 * 4 * 64];
};

#define ATTN_LOAD(KBASE, KSTRIDE, VTBASE, VTSTRIDE, NEEDV) { \
    rk0 = *(const uint4*)((KBASE) + (size_t)(tid >> 3) * (KSTRIDE) + (tid & 7) * 8); \
    rk1 = *(const uint4*)((KBASE) + (size_t)((tid >> 3) + 32) * (KSTRIDE) + (tid & 7) * 8); \
    if (NEEDV) { rv0 = *(const uint4*)((VTBASE) + (size_t)(tid >> 3) * (VTSTRIDE) + (tid & 7) * 8); \
                 rv1 = *(const uint4*)((VTBASE) + (size_t)((tid >> 3) + 32) * (VTSTRIDE) + (tid & 7) * 8); } }
#define ATTN_STORE(NEEDV) { \
    *(uint4*)&sm.k[(tid >> 3) * 72 + (tid & 7) * 8] = rk0; *(uint4*)&sm.k[((tid >> 3) + 32) * 72 + (tid & 7) * 8] = rk1; \
    if (NEEDV) { bf16_t* d0_ = &sm.vt[(tid >> 3) * 68 + (tid & 7) * 8]; bf16_t* d1_ = &sm.vt[((tid >> 3) + 32) * 68 + (tid & 7) * 8]; \
        *(uint2*)d0_ = make_uint2(rv0.x, rv0.y); *(uint2*)(d0_ + 4) = make_uint2(rv0.z, rv0.w); \
        *(uint2*)d1_ = make_uint2(rv1.x, rv1.y); *(uint2*)(d1_ + 4) = make_uint2(rv1.z, rv1.w); } }

template <int MODE, bool EM>
DI void attn_tile(AttnSmem& sm, const uint4* qs, f32x16 (&o)[2], float& m, float& l, const float inv_l, const int lo, const int hi, const bool lane_on,
                  const int lane, const int tokl, const int jbase) {
    const int rr = lane & 31, hh = lane >> 5;
    f32x16 s[2];
#pragma unroll
    for (int mt = 0; mt < 2; ++mt) {
#pragma unroll
        for (int i = 0; i < 16; ++i) s[mt][i] = 0.f;
#pragma unroll
        for (int ks = 0; ks < 4; ++ks) {
            const bf16x8 kf = *(const bf16x8*)&sm.k[(mt * 32 + rr) * 72 + ks * 16 + hh * 8];
            const bf16x8 qv = __builtin_bit_cast(bf16x8, qs[ks * 64]);
            s[mt] = MFMA32(kf, qv, s[mt]);
        }
        asm volatile("" ::: "memory");
    }
    (void)m;
    __builtin_amdgcn_sched_barrier(0);
    float psum = 0.f;
    if (EM) {
        const int lo2 = lo - 4 * hh, hi2 = hi - 4 * hh;
#pragma unroll
        for (int mt = 0; mt < 2; ++mt)
#pragma unroll
            for (int i = 0; i < 16; ++i) {
                const int kc_ = mt * 32 + (i & 3) + 8 * (i >> 2);
                float v = s[mt][i];
                v = (kc_ >= lo2 && kc_ <= hi2) ? v : -1e30f;
                float pv = __builtin_amdgcn_exp2f(v);
                if (MODE == 2) pv *= inv_l;
                s[mt][i] = pv; psum += pv;
            }
    } else {
        const float off = lane_on ? 0.f : -1e30f;
#pragma unroll
        for (int mt = 0; mt < 2; ++mt)
#pragma unroll
            for (int i = 0; i < 16; ++i) {
                float pv = __builtin_amdgcn_exp2f(s[mt][i] + off);
                if (MODE == 2) pv *= inv_l;
                s[mt][i] = pv; psum += pv;
            }
    }
    __builtin_amdgcn_sched_barrier(0);
    if (MODE != 2) l += psum;
    if (MODE == 0) return;
    if (MODE == 2) {
#pragma unroll
        for (int mt = 0; mt < 2; ++mt)
#pragma unroll
            for (int jj = 0; jj < 4; ++jj) {
                float q4 = (s[mt][4 * jj] + s[mt][4 * jj + 1]) + (s[mt][4 * jj + 2] + s[mt][4 * jj + 3]);
                float e3 = s[mt][4 * jj + 3];
                q4 += __shfl_xor(q4, 1); q4 += __shfl_xor(q4, 2);
                e3 += __shfl_xor(e3, 1); e3 += __shfl_xor(e3, 2);
                if ((rr & 3) == 0) {
                    const int j = jbase + mt * 8 + 2 * jj + hh;
                    atomicAdd(&sm.imp[tokl * 256 + j], q4);
                    if (j + 1 < 256) atomicAdd(&sm.imp[tokl * 256 + j + 1], e3);
                }
            }
    }
#pragma unroll
    for (int mt = 0; mt < 2; ++mt)
#pragma unroll
        for (int s2 = 0; s2 < 2; ++s2) {
            uint4 pu;
            pu.x = pack2(s[mt][8 * s2 + 0], s[mt][8 * s2 + 1]); pu.y = pack2(s[mt][8 * s2 + 2], s[mt][8 * s2 + 3]);
            pu.z = pack2(s[mt][8 * s2 + 4], s[mt][8 * s2 + 5]); pu.w = pack2(s[mt][8 * s2 + 6], s[mt][8 * s2 + 7]);
            const bf16x8 pf = __builtin_bit_cast(bf16x8, pu);
            asm volatile("" ::: "memory");
#pragma unroll
            for (int dt = 0; dt < 2; ++dt) {
                const bf16_t* vp = &sm.vt[(dt * 32 + rr) * 68 + mt * 32 + s2 * 16 + hh * 4];
                const uint2 v0 = *(const uint2*)vp, v1 = *(const uint2*)(vp + 8);
                const bf16x8 vf = __builtin_bit_cast(bf16x8, make_uint4(v0.x, v0.y, v1.x, v1.y));
                o[dt] = MFMA32(vf, pf, o[dt]);
            }
        }
}

DI unsigned wave_umax(unsigned v) {
#pragma unroll
    for (int o = 32; o; o >>= 1) { const unsigned t = (unsigned)__shfl_xor((int)v, o); v = v > t ? v : t; }
    return v;
}


typedef unsigned u32x4 __attribute__((ext_vector_type(4)));
#define GLD16(R, PTR) asm volatile("global_load_dwordx4 %0, %1, off" : "=&v"(R) : "v"(PTR))
template <bool NEEDV, class NextF, class KPtrF, class VPtrF, class CompF>
DI void attn_pipe(AttnSmem& sm, const int tid, int j, const NextF next, const KPtrF kptr, const int kst, const VPtrF vptr, const int vst, const CompF comp) {
    if (j < 0) return;
    u32x4 Ak0, Ak1, Av0 = {0u, 0u, 0u, 0u}, Av1 = {0u, 0u, 0u, 0u}, Bk0, Bk1, Bv0 = {0u, 0u, 0u, 0u}, Bv1 = {0u, 0u, 0u, 0u};
    const int lr = tid >> 3, lc = (tid & 7) * 8;
#define PIPE_LOADS(S, JJ) { const bf16_t* kp_ = kptr(JJ) + (size_t)lr * kst + lc; GLD16(S##k0, kp_); GLD16(S##k1, kp_ + (size_t)32 * kst); \
        if (NEEDV) { const bf16_t* vp_ = vptr(JJ) + (size_t)lr * vst + lc; GLD16(S##v0, vp_); GLD16(S##v1, vp_ + (size_t)32 * vst); } }
#define PIPE_WAIT(S) { if (NEEDV) asm volatile("s_waitcnt vmcnt(4)" : "+v"(S##k0), "+v"(S##k1), "+v"(S##v0), "+v"(S##v1)); \
        else asm volatile("s_waitcnt vmcnt(2)" : "+v"(S##k0), "+v"(S##k1)); }
#define PIPE_STORES(S) { *(u32x4*)&sm.k[lr * 72 + lc] = S##k0; *(u32x4*)&sm.k[(lr + 32) * 72 + lc] = S##k1; \
        if (NEEDV) { bf16_t* d0_ = &sm.vt[lr * 68 + lc]; bf16_t* d1_ = &sm.vt[(lr + 32) * 68 + lc]; \
            *(uint2*)d0_ = make_uint2(S##v0.x, S##v0.y); *(uint2*)(d0_ + 4) = make_uint2(S##v0.z, S##v0.w); \
            *(uint2*)d1_ = make_uint2(S##v1.x, S##v1.y); *(uint2*)(d1_ + 4) = make_uint2(S##v1.z, S##v1.w); } }
    int jn = next(j);
    PIPE_LOADS(A, j)
    PIPE_LOADS(B, (jn >= 0 ? jn : j))
    while (true) {
        __syncthreads();
        PIPE_WAIT(A)
        PIPE_STORES(A)
        __syncthreads();
        const int jnn = jn >= 0 ? next(jn) : -1;
        PIPE_LOADS(A, (jnn >= 0 ? jnn : j))
        comp(j);
        if (jn < 0) break;
        __syncthreads();
        PIPE_WAIT(B)
        PIPE_STORES(B)
        __syncthreads();
        const int jnnn = jnn >= 0 ? next(jnn) : -1;
        PIPE_LOADS(B, (jnnn >= 0 ? jnnn : jn))
        comp(jn);
        if (jnn < 0) break;
        j = jnn; jn = jnnn;
    }
    asm volatile("s_waitcnt vmcnt(0)" : "+v"(Ak0), "+v"(Ak1), "+v"(Av0), "+v"(Av1), "+v"(Bk0), "+v"(Bk1), "+v"(Bv0), "+v"(Bv1));
#undef PIPE_LOADS
#undef PIPE_WAIT
#undef PIPE_STORES
}


template <bool EM>
DI void sel_scores(const u32x4 k0, const u32x4 k1, const u32x4 k2, const u32x4 k3, const u32x4 k4, const u32x4 k5, const u32x4 k6, const u32x4 k7,
                   const uint4* qs, float& l, const int lo, const int hi, const bool lane_on, const int lane,
                   u32x4& pf0, u32x4& pf1, u32x4& pf2, u32x4& pf3) {
    const int hh = lane >> 5;
    f32x16 s0, s1;
#pragma unroll
    for (int i = 0; i < 16; ++i) { s0[i] = 0.f; s1[i] = 0.f; }
    {
        const bf16x8 q0 = __builtin_bit_cast(bf16x8, qs[0]), q1 = __builtin_bit_cast(bf16x8, qs[64]), q2 = __builtin_bit_cast(bf16x8, qs[128]), q3 = __builtin_bit_cast(bf16x8, qs[192]);
        s0 = MFMA32(__builtin_bit_cast(bf16x8, k0), q0, s0); s1 = MFMA32(__builtin_bit_cast(bf16x8, k4), q0, s1);
        s0 = MFMA32(__builtin_bit_cast(bf16x8, k1), q1, s0); s1 = MFMA32(__builtin_bit_cast(bf16x8, k5), q1, s1);
        s0 = MFMA32(__builtin_bit_cast(bf16x8, k2), q2, s0); s1 = MFMA32(__builtin_bit_cast(bf16x8, k6), q2, s1);
        s0 = MFMA32(__builtin_bit_cast(bf16x8, k3), q3, s0); s1 = MFMA32(__builtin_bit_cast(bf16x8, k7), q3, s1);
    }
    float psum = 0.f;
    if (EM) {
        const int lo2 = lo - 4 * hh, hi2 = hi - 4 * hh;
#pragma unroll
        for (int i = 0; i < 16; ++i) {
            const int kc_ = (i & 3) + 8 * (i >> 2);
            float v = (kc_ >= lo2 && kc_ <= hi2) ? s0[i] : -1e30f;
            float w = (kc_ + 32 >= lo2 && kc_ + 32 <= hi2) ? s1[i] : -1e30f;
            v = __builtin_amdgcn_exp2f(v); w = __builtin_amdgcn_exp2f(w);
            s0[i] = v; s1[i] = w; psum += v + w;
        }
    } else {
        const float off = lane_on ? 0.f : -1e30f;
#pragma unroll
        for (int i = 0; i < 16; ++i) {
            const float v = __builtin_amdgcn_exp2f(s0[i] + off), w = __builtin_amdgcn_exp2f(s1[i] + off);
            s0[i] = v; s1[i] = w; psum += v + w;
        }
    }
    l += psum;
    pf0.x = pack2(s0[0], s0[1]); pf0.y = pack2(s0[2], s0[3]); pf0.z = pack2(s0[4], s0[5]); pf0.w = pack2(s0[6], s0[7]);
    pf1.x = pack2(s0[8], s0[9]); pf1.y = pack2(s0[10], s0[11]); pf1.z = pack2(s0[12], s0[13]); pf1.w = pack2(s0[14], s0[15]);
    pf2.x = pack2(s1[0], s1[1]); pf2.y = pack2(s1[2], s1[3]); pf2.z = pack2(s1[4], s1[5]); pf2.w = pack2(s1[6], s1[7]);
    pf3.x = pack2(s1[8], s1[9]); pf3.y = pack2(s1[10], s1[11]); pf3.z = pack2(s1[12], s1[13]); pf3.w = pack2(s1[14], s1[15]);
}
DI void sel_pv(const u32x4 v0, const u32x4 v1, const u32x4 v2, const u32x4 v3, const u32x4 v4, const u32x4 v5, const u32x4 v6, const u32x4 v7,
               const u32x4 pf0, const u32x4 pf1, const u32x4 pf2, const u32x4 pf3, f32x16 (&o)[2]) {
    o[0] = MFMA32(__builtin_bit_cast(bf16x8, v0), __builtin_bit_cast(bf16x8, pf0), o[0]); o[1] = MFMA32(__builtin_bit_cast(bf16x8, v1), __builtin_bit_cast(bf16x8, pf0), o[1]);
    o[0] = MFMA32(__builtin_bit_cast(bf16x8, v2), __builtin_bit_cast(bf16x8, pf1), o[0]); o[1] = MFMA32(__builtin_bit_cast(bf16x8, v3), __builtin_bit_cast(bf16x8, pf1), o[1]);
    o[0] = MFMA32(__builtin_bit_cast(bf16x8, v4), __builtin_bit_cast(bf16x8, pf2), o[0]); o[1] = MFMA32(__builtin_bit_cast(bf16x8, v5), __builtin_bit_cast(bf16x8, pf2), o[1]);
    o[0] = MFMA32(__builtin_bit_cast(bf16x8, v6), __builtin_bit_cast(bf16x8, pf3), o[0]); o[1] = MFMA32(__builtin_bit_cast(bf16x8, v7), __builtin_bit_cast(bf16x8, pf3), o[1]);
}

DI void attn_unit(const P& p, int u, char* smem) {
    AttnSmem& sm = *(AttnSmem*)smem;
    const int tid = tidx(), wave = tid >> 6, lane = tid & 63, rr = lane & 31, hh = lane >> 5;
    const int tile = 511 - (u >> 2), bhk = u & 3, b = bhk >> 1, hk = bhk & 1, t0 = tile * 32;
    const int tokl = wave * 8 + (rr >> 2), t = t0 + tokl, g = rr & 3, head = hk * 4 + g;
    const size_t tokg = (size_t)b * S_ + t;
    uint4* qs = &sm.q[wave * 256 + lane];
#pragma unroll
    for (int ks = 0; ks < 4; ++ks) qs[ks * 64] = *(const uint4*)(p.proj + tokg * PLD + QC + head * 64 + ks * 16 + hh * 8);
#define GATE(i) sigmoidf_(__uint_as_float((unsigned)p.proj[((size_t)b * S_ + t) * PLD + GC + head * 3 + (i)] << 16))
#pragma unroll
    for (int i = 0; i < 8; ++i) *(float4*)&sm.imp[(tid + i * 256) * 4] = make_float4(0.f, 0.f, 0.f, 0.f);
    sm.selbits[tid] = 0u;
    f32x16 o[2];
#pragma unroll
    for (int dt = 0; dt < 2; ++dt)
#pragma unroll
        for (int i = 0; i < 16; ++i) o[dt][i] = 0.f;
    float* park = &sm.imp[wave * 2048 + lane];
    const int ntc = (t0 >> 10) + 1;
    const int vmaxi = (t >= 31) ? ((t - 31) >> 4) : -1;
    const int twmin = t0 + wave * 8;
    const int wvmin = (twmin >= 31) ? ((twmin - 31) >> 4) : -1;
    const bf16_t* kcb = p.kc + (size_t)bhk * 1024 * 64;
    const bf16_t* vcb = p.vcT + (size_t)bhk * 64 * 1024;
    float m = -1e30f, l = 0.f;
    {
        auto nxt = [&](int j) -> int { return j + 1 < ntc ? j + 1 : -1; };
        auto kp = [&](int j) -> const bf16_t* { return kcb + (size_t)j * 64 * 64; };
        auto vp = [&](int j) -> const bf16_t* { return vcb + j * 64; };
        attn_pipe<false>(sm, tid, 0, nxt, kp, 64, vp, 1024, [&](int j) {
            if (j * 64 + 63 <= wvmin) attn_tile<0, false>(sm, qs, o, m, l, 0.f, 0, 0, true, lane, tokl, 0);
            else attn_tile<0, true>(sm, qs, o, m, l, 0.f, 0, vmaxi - j * 64, true, lane, tokl, 0);
        });
        const float lt = l + __shfl_xor(l, 32);
        const float inv_l = lt > 0.f ? 1.f / lt : 0.f;
        attn_pipe<true>(sm, tid, 0, nxt, kp, 64, vp, 1024, [&](int j) {
            if (j * 64 + 63 <= wvmin) attn_tile<2, false>(sm, qs, o, m, l, inv_l, 0, 0, true, lane, tokl, j * 16);
            else attn_tile<2, true>(sm, qs, o, m, l, inv_l, 0, vmaxi - j * 64, true, lane, tokl, j * 16);
        });
    }
    __syncthreads();
    const int cur = t0 >> 6;
    for (int tk = 0; tk < 8; ++tk) {
        const int tl = wave * 8 + tk;
        const float* ip = &sm.imp[tl * 256];
        unsigned nib = 0u;
        if (cur <= 15) {
#pragma unroll
            for (int e = 0; e < 4; ++e) if (lane * 4 + e <= cur) nib |= 1u << e;
        } else {
            unsigned k0, k1, k2, k3;
            {
                const float4 iv = *(const float4*)(ip + lane * 4);
                const int j0 = lane * 4;
                k0 = (j0 >= 1 && j0 <= cur - 2) ? ((__float_as_uint(iv.x) & 0xFFFFFF00u) | (unsigned)(255 - j0)) : 0u;
                k1 = (j0 + 1 <= cur - 2) ? ((__float_as_uint(iv.y) & 0xFFFFFF00u) | (unsigned)(254 - j0)) : 0u;
                k2 = (j0 + 2 <= cur - 2) ? ((__float_as_uint(iv.z) & 0xFFFFFF00u) | (unsigned)(253 - j0)) : 0u;
                k3 = (j0 + 3 <= cur - 2) ? ((__float_as_uint(iv.w) & 0xFFFFFF00u) | (unsigned)(252 - j0)) : 0u;
#pragma unroll
                for (int e = 0; e < 4; ++e) { const int j = j0 + e; if (j == 0 || j == cur || j == cur - 1) nib |= 1u << e; }
            }
            for (int r = 0; r < 13; ++r) {
                unsigned lm = k0 > k1 ? k0 : k1; const unsigned lm2 = k2 > k3 ? k2 : k3; lm = lm > lm2 ? lm : lm2;
                const unsigned wm = wave_umax(lm);
                if (k0 == wm) { k0 = 0u; nib |= 1u; }
                if (k1 == wm) { k1 = 0u; nib |= 2u; }
                if (k2 == wm) { k2 = 0u; nib |= 4u; }
                if (k3 == wm) { k3 = 0u; nib |= 8u; }
            }
        }
        atomicOr(&sm.selbits[tl * 8 + (lane >> 3)], nib << ((lane & 7) * 4));
    }
    __syncthreads();
    if (tid < 32) {
        const int w = tid >> 3, d = tid & 7; unsigned uu = 0u;
#pragma unroll
        for (int k = 0; k < 8; ++k) uu |= sm.selbits[(w * 8 + k) * 8 + d];
        sm.wunion[w * 8 + d] = uu;
    }
    __syncthreads();
    if (tid < 8) sm.bunion[tid] = sm.wunion[tid] | sm.wunion[8 + tid] | sm.wunion[16 + tid] | sm.wunion[24 + tid];
    __syncthreads();
    {
        const float g0 = GATE(0);
#pragma unroll
        for (int dt = 0; dt < 2; ++dt)
#pragma unroll
            for (int i = 0; i < 16; ++i) { park[(dt * 16 + i) * 64] = g0 * o[dt][i]; o[dt][i] = 0.f; }
    }
    {
        const bf16_t* kb = p.proj + (size_t)(b * S_) * PLD + KVC + 2 * 128 + hk * 64;
        const bf16_t* vb = p.vT + (size_t)((0 * 4 + bhk) * 64) * S_;
        m = -1e30f; l = 0.f;
        (void)kb; (void)vb;
        auto nextw = [&](int j) -> int {
            ++j;
            while (j <= cur) {
                const unsigned w = sm.wunion[wave * 8 + (j >> 5)] >> (j & 31);
                if (w) { j += __ffs((int)w) - 1; return j <= cur ? j : -1; }
                j = (j | 31) + 1;
            }
            return -1;
        };
        const bf16_t* kswb = p.ksw + ((size_t)bhk * 256 * 512 + lane) * 8;
        const bf16_t* vswb = p.vsw + ((size_t)bhk * 256 * 512 + lane) * 8;
        u32x4 A0, A1, A2, A3, A4, A5, A6, A7, B0, B1, B2, B3, B4, B5, B6, B7, V0, V1, V2, V3, V4, V5, V6, V7, pf0, pf1, pf2, pf3;
#define SEL_LD8(R, BASE, JJ) { const bf16_t* b_ = (BASE) + (size_t)(JJ) * 4096; GLD16(R##0, b_); GLD16(R##1, b_ + 512); GLD16(R##2, b_ + 1024); GLD16(R##3, b_ + 1536); \
        GLD16(R##4, b_ + 2048); GLD16(R##5, b_ + 2560); GLD16(R##6, b_ + 3072); GLD16(R##7, b_ + 3584); }
#define SEL_WAIT8(R, N) asm volatile("s_waitcnt vmcnt(" #N ")" : "+v"(R##0), "+v"(R##1), "+v"(R##2), "+v"(R##3), "+v"(R##4), "+v"(R##5), "+v"(R##6), "+v"(R##7))
#define SEL_TILE(K, JJ) { \
        const int jj_ = (JJ); \
        const bool selme_ = (sm.selbits[tokl * 8 + (jj_ >> 5)] >> (jj_ & 31)) & 1u; \
        SEL_WAIT8(K, 16); \
        if (jj_ < cur) sel_scores<false>(K##0, K##1, K##2, K##3, K##4, K##5, K##6, K##7, qs, l, 0, 0, selme_, lane, pf0, pf1, pf2, pf3); \
        else sel_scores<true>(K##0, K##1, K##2, K##3, K##4, K##5, K##6, K##7, qs, l, 0, selme_ ? t - jj_ * 64 : -1, true, lane, pf0, pf1, pf2, pf3); \
        SEL_WAIT8(V, 8); \
        sel_pv(V0, V1, V2, V3, V4, V5, V6, V7, pf0, pf1, pf2, pf3, o); }
        int j = nextw(-1);
        if (j >= 0) {
            SEL_LD8(A, kswb, j)
            while (true) {
                const int jn = nextw(j);
                SEL_LD8(V, vswb, j)
                SEL_LD8(B, kswb, (jn >= 0 ? jn : j))
                SEL_TILE(A, j)
                if (jn < 0) break;
                const int jnn = nextw(jn);
                SEL_LD8(V, vswb, jn)
                SEL_LD8(A, kswb, (jnn >= 0 ? jnn : jn))
                SEL_TILE(B, jn)
                if (jnn < 0) break;
                j = jnn;
            }
            asm volatile("s_waitcnt vmcnt(0)" : "+v"(A0), "+v"(A1), "+v"(A2), "+v"(A3), "+v"(A4), "+v"(A5), "+v"(A6), "+v"(A7), "+v"(B0), "+v"(B1), "+v"(B2), "+v"(B3), "+v"(B4), "+v"(B5), "+v"(B6), "+v"(B7));
            asm volatile("s_waitcnt vmcnt(0)" : "+v"(V0), "+v"(V1), "+v"(V2), "+v"(V3), "+v"(V4), "+v"(V5), "+v"(V6), "+v"(V7));
        }
#undef SEL_LD8
#undef SEL_WAIT8
#undef SEL_TILE
        const float lt = l + __shfl_xor(l, 32);
        const float sc = lt > 0.f ? GATE(1) / lt : 0.f;
#pragma unroll
        for (int dt = 0; dt < 2; ++dt)
#pragma unroll
            for (int i = 0; i < 16; ++i) { park[(dt * 16 + i) * 64] += sc * o[dt][i]; o[dt][i] = 0.f; }
    }
    {
        const bf16_t* kb = p.proj + (size_t)(b * S_) * PLD + KVC + 4 * 128 + hk * 64;
        const bf16_t* vb = p.vT + (size_t)((1 * 4 + bhk) * 64) * S_;
        m = -1e30f; l = 0.f;
        const int jlo = (t0 >= 511) ? ((t0 - 511) >> 6) : 0, jhi = t0 >> 6;
        attn_pipe<true>(sm, tid, jlo, [&](int j) -> int { return j + 1 <= jhi ? j + 1 : -1; }, [&](int j) -> const bf16_t* { return kb + (size_t)j * 64 * PLD; }, PLD,
                        [&](int j) -> const bf16_t* { return vb + j * 64; }, S_, [&](int j) {
            if (j * 64 >= twmin + 7 - 511 && j * 64 + 63 <= twmin) attn_tile<1, false>(sm, qs, o, m, l, 0.f, 0, 0, true, lane, tokl, 0);
            else attn_tile<1, true>(sm, qs, o, m, l, 0.f, t - 511 - j * 64, t - j * 64, true, lane, tokl, 0);
        });
        const float lt = l + __shfl_xor(l, 32);
        const float sc = lt > 0.f ? GATE(2) / lt : 0.f;
#pragma unroll
        for (int dt = 0; dt < 2; ++dt)
#pragma unroll
            for (int i = 0; i < 16; ++i) o[dt][i] = park[(dt * 16 + i) * 64] + sc * o[dt][i];
    }
    bf16_t* mp = p.A + tokg * 1024 + 512 + head * 64;
#pragma unroll
    for (int dt = 0; dt < 2; ++dt)
#pragma unroll
        for (int jj = 0; jj < 4; ++jj) {
            uint2 ov; ov.x = pack2(o[dt][4 * jj], o[dt][4 * jj + 1]); ov.y = pack2(o[dt][4 * jj + 2], o[dt][4 * jj + 3]);
            *(uint2*)(mp + dt * 32 + jj * 8 + hh * 4) = ov;
        }
}

DI void phase4(const P& p, char* smem) {
    for (int su = blockIdx.x; su < 128; su += gridDim.x) scan_unit(p, su, smem);
    AttnSmem& sm = *(AttnSmem*)smem;
    while (true) {
        __syncthreads();
        if (tidx() == 0) sm.unit = (int)atomicAdd(p.counter, 1u);
        __syncthreads();
        const int u = sm.unit;
        if (u >= 2048) break;
        attn_unit(p, u, smem);
    }
}

DI void phase4b(const P& p) {
    const int tid = tidx();
    for (int it = blockIdx.x; it < T_ / 4; it += gridDim.x) {
        const int gi = it * 4 + (tid >> 6), cgp = tid & 63, h = cgp >> 3, c8 = (cgp & 7) * 8, col = cgp * 8, b = gi >> 14, s = gi & (S_ - 1);
        const float4 y0 = *(const float4*)(p.yraw + (size_t)gi * 512 + col), y1 = *(const float4*)(p.yraw + (size_t)gi * 512 + col + 4);
        float y[8] = {y0.x, y0.y, y0.z, y0.w, y1.x, y1.y, y1.z, y1.w};
        const bf16_t* sp = p.stream + ((size_t)((b * 8 + h) * S_ + s) * 6) * 64 + c8;
        float km[8], r[8], v[8], gg[8];
        unpack8(*(const uint4*)(sp + 64), km); unpack8(*(const uint4*)(sp + 256), r); unpack8(*(const uint4*)(sp + 320), v);
        unpack8(*(const uint4*)(p.gbuf + (size_t)gi * 512 + col), gg);
        float sum = 0.f, bon = 0.f;
#pragma unroll
        for (int e = 0; e < 8; ++e) { sum += y[e]; bon += r[e] * km[e] * p.r_k[col + e]; }
        sum += __shfl_xor(sum, 1); sum += __shfl_xor(sum, 2); sum += __shfl_xor(sum, 4);
        bon += __shfl_xor(bon, 1); bon += __shfl_xor(bon, 2); bon += __shfl_xor(bon, 4);
        const float mean = sum * (1.f / 64.f);
        float var = 0.f;
#pragma unroll
        for (int e = 0; e < 8; ++e) { y[e] -= mean; var += y[e] * y[e]; }
        var += __shfl_xor(var, 1); var += __shfl_xor(var, 2); var += __shfl_xor(var, 4);
        const float rs = rsqrtf(var * (1.f / 64.f) + 64e-5f);
        float o[8];
#pragma unroll
        for (int e = 0; e < 8; ++e) o[e] = (y[e] * rs * p.lnx_w[col + e] + p.lnx_b[col + e] + bon * v[e]) * gg[e];
        *(uint4*)(p.A + (size_t)gi * 1024 + col) = pack8(o);
    }
}

struct EpiFfn2 {
    float* out;
    DI void operator()(const f32x16 (&acc)[2][2], int rowbase, int colbase, int lane) const {
        const int rr = lane & 31, hh = lane >> 5;
#pragma unroll
        for (int w = 0; w < 2; ++w)
#pragma unroll
            for (int t = 0; t < 2; ++t)
#pragma unroll
                for (int j = 0; j < 4; ++j) {
                    float4* o = (float4*)(out + (size_t)(rowbase + t * 32 + rr) * 1024 + colbase + w * 32 + j * 8 + hh * 4);
                    float4 xv = *o;
                    xv.x += acc[w][t][4 * j]; xv.y += acc[w][t][4 * j + 1]; xv.z += acc[w][t][4 * j + 2]; xv.w += acc[w][t][4 * j + 3];
                    *o = xv;
                }
    }
};

DI void final_item(float* io, const float* g, int idx) {
    const int row = idx * 4 + (tidx() >> 6), lane = tidx() & 63;
    float4* sp = (float4*)(io + (size_t)row * 1024);
    float4 v[4]; float ss = 0.f;
#pragma unroll
    for (int i = 0; i < 4; ++i) { v[i] = sp[lane + 64 * i]; ss += v[i].x * v[i].x + v[i].y * v[i].y + v[i].z * v[i].z + v[i].w * v[i].w; }
    ss = wave_sum(ss);
    const float rs = rsqrtf(ss * (1.f / 1024.f) + 1e-6f);
#pragma unroll
    for (int i = 0; i < 4; ++i) {
        const float4 gv = ((const float4*)g)[lane + 64 * i];
        sp[lane + 64 * i] = make_float4(v[i].x * rs * gv.x, v[i].y * rs * gv.y, v[i].z * rs * gv.z, v[i].w * rs * gv.w);
    }
}

DI bool gemm_order(const int round, const int NT, int& mt, int& nt) {
    if (gridDim.x == 512) {
        const int xcd = blockIdx.x & 7, lb = blockIdx.x >> 3;
        const int q = round * 64 + lb;
        if (q >= 32 * NT) return false;
        mt = xcd * 32 + (q / (8 * NT)) * 8 + (q & 7);
        nt = (q >> 3) % NT;
        return true;
    }
    const int it = round * gridDim.x + blockIdx.x;
    if (it >= 256 * NT) return false;
    mt = it / NT; nt = it - mt * NT;
    return true;
}

DI void run_phase(const P& p, int ph, char* smem) {
    switch (ph) {
    case 0: phase0(p, smem); break;
    case 1:
        for (int rd = 0;; ++rd) {
            int mt, nt; if (!gemm_order(rd, 25, mt, nt)) break;
            gemm_tile<8>(AFPlain{p.A, 1024}, p.WinT + (size_t)nt * 128 * 1024, 1024, mt * 128, nt * 128, EpiProj{p.proj}, smem);
        }
        break;
    case 2: phase2(p, smem); break;
    case 3: phase3(p, smem); break;
    case 4: phase4(p, smem); break;
    case 5: phase4b(p); break;
    case 6:
        for (int rd = 0;; ++rd) {
            int mt, nt; if (!gemm_order(rd, 8, mt, nt)) break;
            gemm_tile<8>(AFPlain{p.A, 1024}, p.WoutT + (size_t)nt * 128 * 1024, 1024, mt * 128, nt * 128, EpiOut{p.out, p.x}, smem);
        }
        break;
    case 7:
        for (int it = blockIdx.x; it < T_ / 4; it += gridDim.x) rms_item(p.out, p.norm_ffn, p.A, it);
        break;
    case 8:
        for (int rd = 0;; ++rd) {
            int mt, nt; if (!gemm_order(rd, 44, mt, nt)) break;
            gemm_tile<8>(AFPlain{p.A, 1024}, p.WguT + (size_t)nt * 128 * 1024, 1024, mt * 128, nt * 128, EpiFfn1{p.stream}, smem);
        }
        break;
    case 9:
        for (int rd = 0;; ++rd) {
            int mt, nt; if (!gemm_order(rd, 8, mt, nt)) break;
            gemm_tile<1>(AFPlain{p.stream, DFF}, p.WdnT + (size_t)nt * 128 * DFF, DFF, mt * 128, nt * 128, EpiFfn2{p.out}, smem);
        }
        break;
    default:
        for (int it = blockIdx.x; it < T_ / 4; it += gridDim.x) final_item(p.out, p.norm_final, it);
        break;
    }
}
constexpr int NPHASE = 11;
constexpr int SMEM_BYTES = 73728;


#define XB_TMO      128
#define XB_XCNT(j)  (256  + 64 * (j))
#define XB_XSUB(j)  (1280 + 64 * (j))
#define XB_XGEN(j)  (2304 + 64 * (j))
#define XB_TOP      3328
#define XB_TOPGEN   3392
#define XCD_BAR_WORDS 3456
#define XB_SPIN_CAP (1u << 22)
#define LAS __attribute__((address_space(3)))
DI unsigned xb_ld(unsigned* p) { return __hip_atomic_load(p, __ATOMIC_RELAXED, __HIP_MEMORY_SCOPE_AGENT); }
DI unsigned xb_add(unsigned* p, unsigned v) { return __hip_atomic_fetch_add(p, v, __ATOMIC_RELAXED, __HIP_MEMORY_SCOPE_AGENT); }
DI unsigned xb_xcc_id() { return (unsigned)__builtin_amdgcn_s_getreg((3 << 11) | 20) & 0xFu; }
#define XB_SPIN(cond, bar) do { unsigned _sp = 0; while (cond) { __builtin_amdgcn_s_sleep(1); \
    if ((++_sp & 255u) == 0u) { if (xb_ld(&(bar)[XB_TMO])) break; if (_sp > XB_SPIN_CAP) { atomicAdd(&(bar)[XB_TMO], 1u); break; } } } } while (0)
struct XcdBarrier { unsigned* bar; unsigned x; volatile LAS unsigned* st; unsigned G; };
DI XcdBarrier xcd_barrier_post(unsigned* bar, volatile LAS unsigned* st, const unsigned G) {
    XcdBarrier b; b.bar = bar; b.x = xb_xcc_id(); b.st = st; b.G = G;
    if (tidx() == 0) (void)xb_add(&bar[XB_XCNT(b.x)], 1u);
    return b;
}
DI void xcd_barrier_complete(unsigned* bar, unsigned x, unsigned& nloc, unsigned& nx, const unsigned G) {
    unsigned sum, cnt, mine, sp = 0u;
    for (;;) {
        sum = 0u; cnt = 0u; mine = 0u;
#pragma unroll
        for (unsigned j = 0; j < 16; ++j) { const unsigned c = xb_ld(&bar[XB_XCNT(j)]); sum += c; cnt += (c > 0u) ? 1u : 0u; mine = (j == x) ? c : mine; }
        if (sum == G) break;
        __builtin_amdgcn_s_sleep(1);
        if ((++sp & 255u) == 0u) { if (xb_ld(&bar[XB_TMO])) break; if (sp > XB_SPIN_CAP) { atomicAdd(&bar[XB_TMO], 1u); break; } }
    }
    nloc = mine > 0u ? mine : 1u; nx = cnt > 0u ? cnt : 1u;
}
DI void xcd_barrier(const XcdBarrier& b) {
    asm volatile("s_waitcnt vmcnt(0)" ::: "memory");
    __syncthreads();
    if (tidx() == 0) {
        unsigned* bar = b.bar;
        __builtin_amdgcn_s_waitcnt(0);
        unsigned nloc = b.st[0], nx = b.st[1];
        if (nloc == 0u) { xcd_barrier_complete(bar, b.x, nloc, nx, b.G); b.st[0] = nloc; b.st[1] = nx; }
        const unsigned old = xb_add(&bar[XB_XSUB(b.x)], 1u);
        const unsigned gen = old / nloc;
        if (old + 1u == (gen + 1u) * nloc) {
            __builtin_amdgcn_fence(__ATOMIC_RELEASE, "agent");
            asm volatile("s_waitcnt vmcnt(0)" ::: "memory");
            const unsigned og = xb_add(&bar[XB_TOP], 1u);
            const unsigned tg = og / nx;
            if (og + 1u == (tg + 1u) * nx) xb_add(&bar[XB_TOPGEN], 1u);
            else XB_SPIN(xb_ld(&bar[XB_TOPGEN]) == tg, bar);
            __builtin_amdgcn_fence(__ATOMIC_ACQUIRE, "agent");
            xb_add(&bar[XB_XGEN(b.x)], 1u);
            asm volatile("s_waitcnt vmcnt(0)" ::: "memory");
        } else {
            XB_SPIN(xb_ld(&bar[XB_XGEN(b.x)]) == gen, bar);
            __builtin_amdgcn_fence(__ATOMIC_ACQUIRE, "agent");
            asm volatile("s_waitcnt vmcnt(0)" ::: "memory");
        }
    }
    __syncthreads();
}

DI void phase4_fused(const P& p, char* smem, const XcdBarrier& xb2) {
    const int tid = tidx();
    if (blockIdx.x < 128) {
        scan_unit(p, blockIdx.x, smem);
        if (tid == 0) {
            unsigned sp = 0u;
            while (xb_ld(p.counter + 4) == 0u) { __builtin_amdgcn_s_sleep(8); if (++sp > (1u << 22)) break; }
            __builtin_amdgcn_fence(__ATOMIC_ACQUIRE, "agent");
            asm volatile("s_waitcnt vmcnt(0)" ::: "memory");
        }
        __syncthreads();
    } else {
        const int lb = blockIdx.x - 128;
        for (int it = lb; it < 2560; it += 384) {
            const int mt = it / 10, nt = 15 + (it - mt * 10);
            gemm_tile<8>(AFPlain{p.A, 1024}, p.WinT + (size_t)nt * 128 * 1024, 1024, mt * 128, nt * 128, EpiProj{p.proj}, smem);
        }
        xcd_barrier(xb2);
        for (int it = lb; it < 640; it += 384) { if (it < 128) cmp1_item(p, it, smem); else rope_item(p, it - 128, smem); }
        xcd_barrier(xb2);
        for (int it = lb; it < 64; it += 384) cmp2_item(p, it, smem);
        xcd_barrier(xb2);
        if (lb == 0 && tid == 0) __hip_atomic_store(p.counter + 4, 1u, __ATOMIC_RELEASE, __HIP_MEMORY_SCOPE_AGENT);
    }
    AttnSmem& sm = *(AttnSmem*)smem;
    while (true) {
        __syncthreads();
        if (tidx() == 0) sm.unit = (int)atomicAdd(p.counter, 1u);
        __syncthreads();
        const int u = sm.unit;
        if (u >= 2048) break;
        attn_unit(p, u, smem);
    }
}

__global__ void __launch_bounds__(NTHR, 2) mega_kernel(P p) {
    __shared__ __attribute__((aligned(16))) char smem[SMEM_BYTES];
    __shared__ uint4 xb_words;
    __shared__ uint4 xb_words2;
    cg::grid_group grid = cg::this_grid();
    if (p.x == nullptr) grid.sync();
    if (tidx() == 0) { xb_words = make_uint4(0u, 0u, 0u, 0u); xb_words2 = make_uint4(0u, 0u, 0u, 0u); }
    __syncthreads();
    const XcdBarrier xb = xcd_barrier_post(p.bar, (volatile LAS unsigned*)&xb_words, gridDim.x);
    run_phase(p, 0, smem); xcd_barrier(xb);
    if (gridDim.x == 512) {
        XcdBarrier xb2; xb2.bar = p.bar + XCD_BAR_WORDS; xb2.x = xb.x; xb2.st = (volatile LAS unsigned*)&xb_words2; xb2.G = 384u;
        if (blockIdx.x >= 128 && tidx() == 0) (void)xb_add(&xb2.bar[XB_XCNT(xb2.x)], 1u);
        for (int rd = 0;; ++rd) {
            int mt, nt; if (!gemm_order(rd, 15, mt, nt)) break;
            gemm_tile<8>(AFPlain{p.A, 1024}, p.WinT + (size_t)nt * 128 * 1024, 1024, mt * 128, nt * 128, EpiProj{p.proj}, smem);
        }
        xcd_barrier(xb);
        for (int it = blockIdx.x; it < 1024; it += gridDim.x) rwkv_prep(p, it, smem);
        xcd_barrier(xb);
        phase4_fused(p, smem, xb2);
        xcd_barrier(xb);
    } else {
        run_phase(p, 1, smem); xcd_barrier(xb);
        run_phase(p, 2, smem); xcd_barrier(xb);
        run_phase(p, 3, smem); xcd_barrier(xb);
        run_phase(p, 4, smem); xcd_barrier(xb);
    }
    run_phase(p, 5, smem); xcd_barrier(xb);
    run_phase(p, 6, smem); xcd_barrier(xb);
    run_phase(p, 7, smem); xcd_barrier(xb);
    run_phase(p, 8, smem); xcd_barrier(xb);
    run_phase(p, 9, smem); xcd_barrier(xb);
    run_phase(p, 10, smem);
}
__global__ void __launch_bounds__(NTHR, 2) phase_kernel(P p, int ph) {
    __shared__ __attribute__((aligned(16))) char smem[SMEM_BYTES];
    run_phase(p, ph, smem);
}

extern "C" void kernel_launch(void* const* d_in, const int* in_sizes, int n_in, void* d_out, int out_size, void* d_ws, size_t ws_size,
                              hipStream_t stream) {
    P p{};
    p.x = (const float*)d_in[0]; p.pos = (const int*)d_in[1]; p.norm_mix = (const float*)d_in[2]; p.w_in = (const float*)d_in[3];
    p.mu = (const float*)d_in[4]; p.w0 = (const float*)d_in[5]; p.w2 = (const float*)d_in[6]; p.a0 = (const float*)d_in[7];
    p.a2 = (const float*)d_in[8]; p.g2 = (const float*)d_in[9]; p.k_k = (const float*)d_in[10]; p.k_a = (const float*)d_in[11];
    p.r_k = (const float*)d_in[12]; p.lnx_w = (const float*)d_in[13]; p.lnx_b = (const float*)d_in[14]; p.pe_k = (const float*)d_in[15];
    p.wk1 = (const float*)d_in[16]; p.bk1 = (const float*)d_in[17]; p.wk2 = (const float*)d_in[18]; p.pe_v = (const float*)d_in[19];
    p.wv1 = (const float*)d_in[20]; p.bv1 = (const float*)d_in[21]; p.wv2 = (const float*)d_in[22]; p.w_out = (const float*)d_in[23];
    p.norm_ffn = (const float*)d_in[24]; p.w_gate = (const float*)d_in[25]; p.w_up = (const float*)d_in[26]; p.w_down = (const float*)d_in[27];
    p.norm_final = (const float*)d_in[28];
    p.out = (float*)d_out;
    char* ws = (char*)d_ws;
    size_t off = 0;
    auto take = [&](size_t bytes) { char* r = ws + off; off += (bytes + 255) & ~(size_t)255; return r; };
    p.WinT = (bf16_t*)take((size_t)3200 * 1024 * 2);
    p.WoutT = (bf16_t*)take((size_t)1024 * 1024 * 2);
    p.WguT = (bf16_t*)take((size_t)5632 * 1024 * 2);
    p.WdnT = (bf16_t*)take((size_t)1024 * DFF * 2);
    p.w2T = (bf16_t*)take(512 * 64 * 2);
    p.a2T = (bf16_t*)take(512 * 64 * 2);
    p.g2T = (bf16_t*)take(512 * 160 * 2);
    p.w1T = (bf16_t*)take((size_t)2 * 256 * 2048 * 2);
    p.wc2T = (bf16_t*)take(2 * 128 * 256 * 2);
    p.b1p = (float*)take(512 * 4);
    p.cosT = (float*)take((size_t)T_ * 8 * 4);
    p.sinT = (float*)take((size_t)T_ * 8 * 4);
    p.counter = (unsigned*)take(256);
    p.bar = (unsigned*)take(2 * XCD_BAR_WORDS * 4);
    off = (size_t)32 << 20;
    p.A = (bf16_t*)take((size_t)T_ * 1024 * 2);
    p.proj = (bf16_t*)take((size_t)T_ * PLD * 2);
    p.stream = (bf16_t*)take((size_t)T_ * 8 * 384 * 2);
    p.ksw = (bf16_t*)take((size_t)4 * 256 * 4096 * 2);
    p.vsw = (bf16_t*)take((size_t)4 * 256 * 4096 * 2);
    if (off > ws_size) fprintf(stderr, "workspace too small: need %zu have %zu\n", off, ws_size);
    char* ob = (char*)d_out;
    p.gbuf = (bf16_t*)ob;
    p.yraw = (float*)(ob + ((size_t)32 << 20));
    p.vT = (bf16_t*)(ob + ((size_t)96 << 20));
    p.hid = (bf16_t*)(ob + ((size_t)112 << 20));
    p.kc = (bf16_t*)(ob + ((size_t)116 << 20));
    p.vcT = (bf16_t*)(ob + ((size_t)116 << 20) + (512 << 10));
#if MK_SINGLE
    static int grid_blocks = 0;
    if (!grid_blocks) {
        int dev = 0, cus = 0, per_cu = 0;
        hipGetDevice(&dev);
        hipDeviceGetAttribute(&cus, hipDeviceAttributeMultiprocessorCount, dev);
        hipOccupancyMaxActiveBlocksPerMultiprocessor(&per_cu, mega_kernel, NTHR, 0);
        if (per_cu > 2) per_cu = 2;
        if (per_cu < 1) per_cu = 1;
        grid_blocks = cus * per_cu;
    }
    (void)hipMemsetAsync(p.bar, 0, 2 * XCD_BAR_WORDS * 4, stream);
    void* args[] = {&p};
    hipError_t e = hipLaunchCooperativeKernel((void*)mega_kernel, dim3(grid_blocks), dim3(NTHR), args, 0, stream);
    if (e != hipSuccess) fprintf(stderr, "cooperative launch failed: %s (grid %d)\n", hipGetErrorString(e), grid_blocks);
#else
    for (int ph = 0; ph < NPHASE; ++ph) phase_kernel<<<512, NTHR, 0, stream>>>(p, ph);
#endif
}
```

```cpp
#include <hip/hip_runtime.h>
#include <hip/hip_cooperative_groups.h>
#include <cstdio>
namespace cg = cooperative_groups;

#ifndef MK_SINGLE
#define MK_SINGLE 1
#endif

#define DI __device__ __forceinline__
typedef unsigned short bf16_t;
typedef short bf16x8 __attribute__((ext_vector_type(8)));
typedef float f32x16 __attribute__((ext_vector_type(16)));
typedef __bf16 bf2_t __attribute__((ext_vector_type(2)));
typedef float f2_t __attribute__((ext_vector_type(2)));

constexpr int T_ = 32768, S_ = 16384;
constexpr int PLD = 3200;
constexpr int QC = 1856, KVC = 2368, GC = 3136;
constexpr int DFF = 2816;
constexpr int NTHR = 256;
constexpr float QSC = 0.125f * 1.4426950408889634f;

#define MFMA32(a, b, c) __builtin_amdgcn_mfma_f32_32x32x16_bf16((a), (b), (c), 0, 0, 0)

DI int tidx() { int r; asm volatile("v_mov_b32 %0, %1" : "=v"(r) : "v"(threadIdx.x)); return r; }
DI unsigned pack2(float a, float b) { f2_t v = {a, b}; return __builtin_bit_cast(unsigned, __builtin_convertvector(v, bf2_t)); }
DI float bflo(unsigned u) { return __uint_as_float(u << 16); }
DI float bfhi(unsigned u) { return __uint_as_float(u & 0xffff0000u); }
DI bf16_t f2bf(float a) { return (bf16_t)(pack2(a, 0.f) & 0xffffu); }
DI void unpack8(const uint4& u, float (&f)[8]) {
    f[0] = bflo(u.x); f[1] = bfhi(u.x); f[2] = bflo(u.y); f[3] = bfhi(u.y);
    f[4] = bflo(u.z); f[5] = bfhi(u.z); f[6] = bflo(u.w); f[7] = bfhi(u.w);
}
DI uint4 pack8(const float (&f)[8]) { uint4 u; u.x = pack2(f[0], f[1]); u.y = pack2(f[2], f[3]); u.z = pack2(f[4], f[5]); u.w = pack2(f[6], f[7]); return u; }
DI float wave_sum(float v) {
#pragma unroll
    for (int o = 32; o; o >>= 1) v += __shfl_xor(v, o);
    return v;
}
DI float sigmoidf_(float x) { return 1.f / (1.f + __expf(-x)); }
DI int crow(int reg, int h) { return (reg & 3) + 8 * (reg >> 2) + 4 * h; }

struct P {
    const float* x; const int* pos; const float *norm_mix, *w_in, *mu, *w0, *w2, *a0, *a2, *g2, *k_k, *k_a, *r_k, *lnx_w, *lnx_b,
        *pe_k, *wk1, *bk1, *wk2, *pe_v, *wv1, *bv1, *wv2, *w_out, *norm_ffn, *w_gate, *w_up, *w_down, *norm_final;
    float* out;
    bf16_t *WinT, *WoutT, *WguT, *WdnT, *w2T, *a2T, *g2T, *w1T, *wc2T;
    float *b1p, *cosT, *sinT;
    unsigned* counter; unsigned* bar;
    bf16_t *A, *proj, *stream;
    bf16_t* gbuf; float* yraw; bf16_t *vT, *hid, *kc, *vcT, *ksw, *vsw;
};

DI float tr_val(const P& p, int job, int k, int n) {
    switch (job) {
    case 0: { int c = n < 1824 ? n : ((n >= 1856 && n < 3160) ? n - 32 : -1); return c >= 0 ? p.w_in[(size_t)k * 3128 + c] : 0.f; }
    case 1: return p.w_out[k * 1024 + n];
    case 2: { int q = n >> 6, r = n & 63; return r < 32 ? p.w_gate[(size_t)k * DFF + q * 32 + r] : p.w_up[(size_t)k * DFF + q * 32 + r - 32]; }
    case 3: return p.w_down[(size_t)k * 1024 + n];
    case 4: return p.w2[k * 512 + n];
    case 5: return p.a2[k * 512 + n];
    case 6: return p.g2[k * 512 + n];
    case 7: return p.wk1[k * 256 + n];
    case 8: return p.wv1[k * 256 + n];
    case 9: return n < 64 ? p.wk2[k * 64 + n] : 0.f;
    default: return n < 64 ? p.wv2[k * 64 + n] : 0.f;
    }
}
DI void tr_item(const P& p, int it, float* tile) {
    int job, K, N; bf16_t* dst;
    if (it < 800) { job = 0; K = 1024; N = 3200; dst = p.WinT; }
    else if (it < 1056) { job = 1; it -= 800; K = 1024; N = 1024; dst = p.WoutT; }
    else if (it < 2464) { job = 2; it -= 1056; K = 1024; N = 5632; dst = p.WguT; }
    else if (it < 3168) { job = 3; it -= 2464; K = 2816; N = 1024; dst = p.WdnT; }
    else if (it < 3176) { job = 4; it -= 3168; K = 64; N = 512; dst = p.w2T; }
    else if (it < 3184) { job = 5; it -= 3176; K = 64; N = 512; dst = p.a2T; }
    else if (it < 3208) { job = 6; it -= 3184; K = 160; N = 512; dst = p.g2T; }
    else if (it < 3336) { job = 7; it -= 3208; K = 2048; N = 256; dst = p.w1T; }
    else if (it < 3464) { job = 8; it -= 3336; K = 2048; N = 256; dst = p.w1T + 256 * 2048; }
    else if (it < 3472) { job = 9; it -= 3464; K = 256; N = 128; dst = p.wc2T; }
    else { job = 10; it -= 3472; K = 256; N = 128; dst = p.wc2T + 128 * 256; }
    const int nt = N >> 6;
    const int k0 = (it / nt) * 64, n0 = (it % nt) * 64;
    const int tid = tidx();
    __syncthreads();
#pragma unroll 4
    for (int i = 0; i < 16; ++i) {
        const int kk = i * 4 + (tid >> 6), nn = tid & 63;
        tile[kk * 65 + nn] = (k0 + kk < K) ? tr_val(p, job, k0 + kk, n0 + nn) : 0.f;
    }
    __syncthreads();
#pragma unroll 4
    for (int i = 0; i < 16; ++i) {
        const int nn = i * 4 + (tid >> 6), kk = tid & 63;
        if (k0 + kk < K) dst[(size_t)(n0 + nn) * K + k0 + kk] = f2bf(tile[kk * 65 + nn]);
    }
}
DI void b1_item(const P& p, int idx) {
    const int kv = idx >> 4, jc = idx & 15, tid = tidx();
    const float* pe = kv ? p.pe_v : p.pe_k; const float* w1 = kv ? p.wv1 : p.wk1; const float* b1 = kv ? p.bv1 : p.bk1;
    const int j = jc * 16 + (tid >> 4), kl = tid & 15;
    float s = 0.f;
    for (int i = 0; i < 128; ++i) { const int k = kl + 16 * i; s += pe[k] * w1[k * 256 + j]; }
    s += __shfl_xor(s, 1); s += __shfl_xor(s, 2); s += __shfl_xor(s, 4); s += __shfl_xor(s, 8);
    if (kl == 0) p.b1p[kv * 256 + j] = b1[j] + s;
}
DI void sincos_d(float ang, float& c, float& s) {
    double x = (double)ang;
    const double TWO_PI = 6.283185307179586476925286766559;
    double n = __builtin_rint(x * (1.0 / TWO_PI));
    double r = x - n * TWO_PI;
    double q = r * 0.25;
    double q2 = q * q;
    double sn = q * (1.0 + q2 * (-1.0 / 6 + q2 * (1.0 / 120 + q2 * (-1.0 / 5040 + q2 * (1.0 / 362880 + q2 * (-1.0 / 39916800 + q2 * (1.0 / 6227020800.0)))))));
    double cs = 1.0 + q2 * (-0.5 + q2 * (1.0 / 24 + q2 * (-1.0 / 720 + q2 * (1.0 / 40320 + q2 * (-1.0 / 3628800 + q2 * (1.0 / 479001600.0))))));
    double s2 = 2 * sn * cs, c2 = 1 - 2 * sn * sn;
    double s4 = 2 * s2 * c2, c4 = 1 - 2 * s2 * s2;
    c = (float)c4; s = (float)s4;
}
DI void cs_item(const P& p, int idx) {
    const int e = idx * 256 + tidx(), tok = e >> 3, f = e & 7;
    const float invf[8] = {1.000000000e+00f, 1.939227432e-01f, 3.760603070e-02f, 7.292664610e-03f, 1.414213562e-03f, 2.742481884e-04f, 5.318295734e-05f, 1.031338525e-05f};
    float iv = invf[0];
#pragma unroll
    for (int i = 1; i < 8; ++i) iv = (f == i) ? invf[i] : iv;
    const float ang = (float)p.pos[tok] * iv;
    float c, s; sincos_d(ang, c, s);
    p.cosT[e] = c; p.sinT[e] = s;
}
DI void rms_item(const float* src, const float* g, bf16_t* dst, int idx) {
    const int row = idx * 4 + (tidx() >> 6), lane = tidx() & 63;
    const float4* sp = (const float4*)(src + (size_t)row * 1024);
    float4 v[4]; float ss = 0.f;
#pragma unroll
    for (int i = 0; i < 4; ++i) { v[i] = sp[lane + 64 * i]; ss += v[i].x * v[i].x + v[i].y * v[i].y + v[i].z * v[i].z + v[i].w * v[i].w; }
    ss = wave_sum(ss);
    const float rs = rsqrtf(ss * (1.f / 1024.f) + 1e-6f);
#pragma unroll
    for (int i = 0; i < 4; ++i) {
        const float4 gv = ((const float4*)g)[lane + 64 * i];
        uint2 o; o.x = pack2(v[i].x * rs * gv.x, v[i].y * rs * gv.y); o.y = pack2(v[i].z * rs * gv.z, v[i].w * rs * gv.w);
        *(uint2*)(dst + (size_t)row * 1024 + (lane + 64 * i) * 4) = o;
    }
}
DI void phase0(const P& p, char* smem) {
    if (blockIdx.x == 0 && tidx() < 8) p.counter[tidx()] = 0u;
    constexpr int NTR = 3480, NB1 = 32, NCS = 1024, NXN = 8192;
    for (int it = blockIdx.x; it < NTR + NB1 + NCS + NXN; it += gridDim.x) {
        if (it < NTR) tr_item(p, it, (float*)smem);
        else if (it < NTR + NB1) b1_item(p, it - NTR);
        else if (it < NTR + NB1 + NCS) cs_item(p, it - NTR - NB1);
        else rms_item(p.x, p.norm_mix, p.A, it - NTR - NB1 - NCS);
    }
}

struct AFPlain { const bf16_t* A; int lda; DI uint4 load(int row, int k) const { return *(const uint4*)(A + (size_t)row * lda + k); } };
struct AFCmp {
    const bf16_t* base;
    DI uint4 load(int r, int k) const { int tok = 16 * r + (k >> 6); tok = tok < S_ ? tok : S_ - 1; return *(const uint4*)(base + (size_t)tok * PLD + (k & 63)); }
};

template <int KU, class AF, class EPI>
DI void gemm_tile(const AF af, const bf16_t* __restrict__ Bt, const int K, const int m0, const int n0, const EPI epi, char* smem) {
    const int tid = tidx(), wave = tid >> 6, lane = tid & 63, wm = wave >> 1, wn = wave & 1, rr = lane & 31, hh = lane >> 5;
    f32x16 acc[2][2];
#pragma unroll
    for (int a = 0; a < 2; ++a)
#pragma unroll
        for (int b = 0; b < 2; ++b)
#pragma unroll
            for (int i = 0; i < 16; ++i) acc[a][b][i] = 0.f;
    const int lrow = tid >> 3, lk = (tid & 7) * 8;
#define GLOAD(R, KO) \
    R##a0 = af.load(m0 + lrow, (KO) + lk); R##a1 = af.load(m0 + lrow + 32, (KO) + lk); R##a2 = af.load(m0 + lrow + 64, (KO) + lk); R##a3 = af.load(m0 + lrow + 96, (KO) + lk); \
    R##b0 = *(const uint4*)(Bt + (size_t)(lrow) * K + (KO) + lk); R##b1 = *(const uint4*)(Bt + (size_t)(lrow + 32) * K + (KO) + lk); \
    R##b2 = *(const uint4*)(Bt + (size_t)(lrow + 64) * K + (KO) + lk); R##b3 = *(const uint4*)(Bt + (size_t)(lrow + 96) * K + (KO) + lk);
#define GSTORE(R, SA, SB) \
    *(uint4*)&(SA)[(lrow) * 72 + lk] = R##a0; *(uint4*)&(SA)[(lrow + 32) * 72 + lk] = R##a1; *(uint4*)&(SA)[(lrow + 64) * 72 + lk] = R##a2; *(uint4*)&(SA)[(lrow + 96) * 72 + lk] = R##a3; \
    *(uint4*)&(SB)[(lrow) * 72 + lk] = R##b0; *(uint4*)&(SB)[(lrow + 32) * 72 + lk] = R##b1; *(uint4*)&(SB)[(lrow + 64) * 72 + lk] = R##b2; *(uint4*)&(SB)[(lrow + 96) * 72 + lk] = R##b3;
#define GCOMPUTE(SA, SB) \
    _Pragma("unroll") for (int ks = 0; ks < 4; ++ks) { \
        bf16x8 tf0 = *(const bf16x8*)&(SA)[(wm * 64 + rr) * 72 + ks * 16 + hh * 8], tf1 = *(const bf16x8*)&(SA)[(wm * 64 + 32 + rr) * 72 + ks * 16 + hh * 8]; \
        bf16x8 wf0 = *(const bf16x8*)&(SB)[(wn * 64 + rr) * 72 + ks * 16 + hh * 8], wf1 = *(const bf16x8*)&(SB)[(wn * 64 + 32 + rr) * 72 + ks * 16 + hh * 8]; \
        acc[0][0] = MFMA32(wf0, tf0, acc[0][0]); acc[0][1] = MFMA32(wf0, tf1, acc[0][1]); acc[1][0] = MFMA32(wf1, tf0, acc[1][0]); acc[1][1] = MFMA32(wf1, tf1, acc[1][1]); }
    uint4 Xa0, Xa1, Xa2, Xa3, Xb0, Xb1, Xb2, Xb3, Ya0, Ya1, Ya2, Ya3, Yb0, Yb1, Yb2, Yb3;
    bf16_t* const sA0 = (bf16_t*)smem; bf16_t* const sB0 = sA0 + 128 * 72; bf16_t* const sA1 = sB0 + 128 * 72; bf16_t* const sB1 = sA1 + 128 * 72;
    GLOAD(X, 0)
    GLOAD(Y, 64)
    __syncthreads();
    GSTORE(X, sA0, sB0)
    __syncthreads();
#pragma unroll KU
    for (int k0 = 0; k0 < K; k0 += 128) {
        const bool more = (k0 + 128 < K);
        if (more) { GLOAD(X, k0 + 128) }
        GCOMPUTE(sA0, sB0)
        GSTORE(Y, sA1, sB1)
        __syncthreads();
        __builtin_amdgcn_sched_barrier(0);
        if (more) { GLOAD(Y, k0 + 192) }
        GCOMPUTE(sA1, sB1)
        if (more) { GSTORE(X, sA0, sB0) }
        __syncthreads();
        __builtin_amdgcn_sched_barrier(0);
    }
#undef GLOAD
#undef GSTORE
#undef GCOMPUTE
    epi(acc, m0 + wm * 64, n0 + wn * 64, lane);
}

struct EpiProj {
    bf16_t* C;
    DI void operator()(const f32x16 (&acc)[2][2], int rowbase, int colbase, int lane) const {
        const int rr = lane & 31, hh = lane >> 5;
#pragma unroll
        for (int w = 0; w < 2; ++w)
#pragma unroll
            for (int t = 0; t < 2; ++t)
#pragma unroll
                for (int j = 0; j < 4; ++j) {
                    uint2 o; o.x = pack2(acc[w][t][4 * j], acc[w][t][4 * j + 1]); o.y = pack2(acc[w][t][4 * j + 2], acc[w][t][4 * j + 3]);
                    *(uint2*)(C + (size_t)(rowbase + t * 32 + rr) * PLD + colbase + w * 32 + j * 8 + hh * 4) = o;
                }
    }
};
struct EpiHid {
    bf16_t* H; const float* bias;
    DI void operator()(const f32x16 (&acc)[2][2], int rowbase, int colbase, int lane) const {
        const int rr = lane & 31, hh = lane >> 5;
#pragma unroll
        for (int w = 0; w < 2; ++w)
#pragma unroll
            for (int t = 0; t < 2; ++t)
#pragma unroll
                for (int j = 0; j < 4; ++j) {
                    const int col = colbase + w * 32 + j * 8 + hh * 4;
                    const float4 bv = *(const float4*)(bias + col);
                    float v0 = acc[w][t][4 * j] + bv.x, v1 = acc[w][t][4 * j + 1] + bv.y, v2 = acc[w][t][4 * j + 2] + bv.z, v3 = acc[w][t][4 * j + 3] + bv.w;
                    v0 *= sigmoidf_(v0); v1 *= sigmoidf_(v1); v2 *= sigmoidf_(v2); v3 *= sigmoidf_(v3);
                    uint2 o; o.x = pack2(v0, v1); o.y = pack2(v2, v3);
                    *(uint2*)(H + (size_t)(rowbase + t * 32 + rr) * 256 + col) = o;
                }
    }
};
struct EpiKc {
    bf16_t* kc; const float *cosT, *sinT; int tokbase;
    DI void operator()(const f32x16 (&acc)[2][2], int rowbase, int colbase, int lane) const {
        if (colbase != 0) return;
        const int rr = lane & 31, hh = lane >> 5;
#pragma unroll
        for (int t = 0; t < 2; ++t) {
            const int r = rowbase + t * 32 + rr;
            int tk = 31 + 16 * r; tk = tk < S_ ? tk : S_ - 1;
            const float4 c = *(const float4*)(cosT + (size_t)(tokbase + tk) * 8 + hh * 4), s = *(const float4*)(sinT + (size_t)(tokbase + tk) * 8 + hh * 4);
            bf16_t* kp = kc + (size_t)r * 64 + hh * 4;
            const float a0 = acc[0][t][0], a1 = acc[0][t][1], a2 = acc[0][t][2], a3 = acc[0][t][3];
            const float b0 = acc[0][t][4], b1 = acc[0][t][5], b2 = acc[0][t][6], b3 = acc[0][t][7];
            uint2 o;
            o.x = pack2(a0 * c.x - b0 * s.x, a1 * c.y - b1 * s.y); o.y = pack2(a2 * c.z - b2 * s.z, a3 * c.w - b3 * s.w);
            *(uint2*)(kp) = o;
            o.x = pack2(b0 * c.x + a0 * s.x, b1 * c.y + a1 * s.y); o.y = pack2(b2 * c.z + a2 * s.z, b3 * c.w + a3 * s.w);
            *(uint2*)(kp + 8) = o;
#pragma unroll
            for (int j = 2; j < 4; ++j) {
                o.x = pack2(acc[0][t][4 * j], acc[0][t][4 * j + 1]); o.y = pack2(acc[0][t][4 * j + 2], acc[0][t][4 * j + 3]);
                *(uint2*)(kp + j * 8) = o;
            }
#pragma unroll
            for (int j = 0; j < 4; ++j) {
                o.x = pack2(acc[1][t][4 * j], acc[1][t][4 * j + 1]); o.y = pack2(acc[1][t][4 * j + 2], acc[1][t][4 * j + 3]);
                *(uint2*)(kp + 32 + j * 8) = o;
            }
        }
    }
};
struct EpiVc {
    bf16_t* vcT; char* smem;
    DI void operator()(const f32x16 (&acc)[2][2], int rowbase, int colbase, int lane) const {
        const int rr = lane & 31, hh = lane >> 5;
        bf16_t* tl = (bf16_t*)smem;
        __syncthreads();
        if (colbase == 0) {
            const int rl = rowbase & 127;
#pragma unroll
            for (int w = 0; w < 2; ++w)
#pragma unroll
                for (int t = 0; t < 2; ++t)
#pragma unroll
                    for (int i = 0; i < 16; ++i) tl[(w * 32 + crow(i, hh)) * 136 + rl + t * 32 + rr] = f2bf(acc[w][t][i]);
        }
        __syncthreads();
        const int m0 = rowbase & ~127;
#pragma unroll
        for (int i = 0; i < 4; ++i) {
            const int c = tidx() + i * 256, d = c >> 4, ch = c & 15;
            *(uint4*)(vcT + (size_t)d * 1024 + m0 + ch * 8) = *(const uint4*)&tl[d * 136 + ch * 8];
        }
    }
};
struct EpiOut {
    float* out; const float* x;
    DI void operator()(const f32x16 (&acc)[2][2], int rowbase, int colbase, int lane) const {
        const int rr = lane & 31, hh = lane >> 5;
#pragma unroll
        for (int w = 0; w < 2; ++w)
#pragma unroll
            for (int t = 0; t < 2; ++t)
#pragma unroll
                for (int j = 0; j < 4; ++j) {
                    const size_t o = (size_t)(rowbase + t * 32 + rr) * 1024 + colbase + w * 32 + j * 8 + hh * 4;
                    float4 xv = *(const float4*)(x + o);
                    xv.x += acc[w][t][4 * j]; xv.y += acc[w][t][4 * j + 1]; xv.z += acc[w][t][4 * j + 2]; xv.w += acc[w][t][4 * j + 3];
                    *(float4*)(out + o) = xv;
                }
    }
};
struct EpiFfn1 {
    bf16_t* act;
    DI void operator()(const f32x16 (&acc)[2][2], int rowbase, int colbase, int lane) const {
        const int rr = lane & 31, hh = lane >> 5;
        const int cb = (colbase >> 6) * 32;
#pragma unroll
        for (int t = 0; t < 2; ++t)
#pragma unroll
            for (int j = 0; j < 4; ++j) {
                float v[4];
#pragma unroll
                for (int i = 0; i < 4; ++i) { const float g = acc[0][t][4 * j + i], u = acc[1][t][4 * j + i]; v[i] = g * sigmoidf_(g) * u; }
                uint2 o; o.x = pack2(v[0], v[1]); o.y = pack2(v[2], v[3]);
                *(uint2*)(act + (size_t)(rowbase + t * 32 + rr) * DFF + cb + j * 8 + hh * 4) = o;
            }
    }
};

DI void rwkv_prep(const P& p, int idx, char* smem) {
    const int tile = idx, tt0 = tile * 32;
    const int tid = tidx(), wave = tid >> 6, lane = tid & 63, rr = lane & 31, hh = lane >> 5;
    bf16_t* lat = (bf16_t*)smem;
    float* res = (float*)(smem + 32 * 296 * 2);
    __syncthreads();
    for (int c = tid; c < 32 * 36; c += NTHR) {
        const int tok = c / 36, ch = c - tok * 36, gi = tt0 + tok, col = 1536 + ch * 8;
        const uint4 cu = *(const uint4*)(p.proj + (size_t)gi * PLD + col);
        uint4 pv = make_uint4(0, 0, 0, 0);
        if ((gi & (S_ - 1)) != 0) pv = *(const uint4*)(p.proj + (size_t)(gi - 1) * PLD + col);
        float a[8], b[8]; unpack8(cu, a); unpack8(pv, b);
        const float4 m0 = *(const float4*)(p.mu + col), m1 = *(const float4*)(p.mu + col + 4);
        const float mu[8] = {m0.x, m0.y, m0.z, m0.w, m1.x, m1.y, m1.z, m1.w};
#pragma unroll
        for (int e = 0; e < 8; ++e) {
            float x = a[e] + (b[e] - a[e]) * mu[e];
            if (ch < 8) x = 1.f - 2.f / (1.f + __expf(2.f * x)); else if (ch >= 16) x = sigmoidf_(x);
            a[e] = x;
        }
        *(uint4*)&lat[tok * 296 + ch * 8] = pack8(a);
    }
    __syncthreads();
#pragma unroll 1
    for (int h = 0; h < 8; ++h) {
    if (wave < 2) {
        const int mt = wave;
        f32x16 aw, aa;
#pragma unroll
        for (int i = 0; i < 16; ++i) { aw[i] = 0.f; aa[i] = 0.f; }
#pragma unroll
        for (int ks = 0; ks < 4; ++ks) {
            const bf16x8 wf = *(const bf16x8*)(p.w2T + (size_t)(h * 64 + mt * 32 + rr) * 64 + ks * 16 + hh * 8);
            const bf16x8 af = *(const bf16x8*)(p.a2T + (size_t)(h * 64 + mt * 32 + rr) * 64 + ks * 16 + hh * 8);
            const bf16x8 l0 = *(const bf16x8*)&lat[rr * 296 + ks * 16 + hh * 8];
            const bf16x8 l1 = *(const bf16x8*)&lat[rr * 296 + 64 + ks * 16 + hh * 8];
            aw = MFMA32(wf, l0, aw); aa = MFMA32(af, l1, aa);
        }
#pragma unroll
        for (int j = 0; j < 4; ++j) {
            *(float4*)&res[(0 * 32 + rr) * 64 + mt * 32 + j * 8 + hh * 4] = make_float4(aw[4 * j], aw[4 * j + 1], aw[4 * j + 2], aw[4 * j + 3]);
            *(float4*)&res[(1 * 32 + rr) * 64 + mt * 32 + j * 8 + hh * 4] = make_float4(aa[4 * j], aa[4 * j + 1], aa[4 * j + 2], aa[4 * j + 3]);
        }
    } else {
        const int mt = wave - 2;
        f32x16 ag;
#pragma unroll
        for (int i = 0; i < 16; ++i) ag[i] = 0.f;
#pragma unroll
        for (int ks = 0; ks < 10; ++ks) {
            const bf16x8 gf = *(const bf16x8*)(p.g2T + (size_t)(h * 64 + mt * 32 + rr) * 160 + ks * 16 + hh * 8);
            const bf16x8 l2 = *(const bf16x8*)&lat[rr * 296 + 128 + ks * 16 + hh * 8];
            ag = MFMA32(gf, l2, ag);
        }
#pragma unroll
        for (int j = 0; j < 4; ++j)
            *(float4*)&res[(2 * 32 + rr) * 64 + mt * 32 + j * 8 + hh * 4] = make_float4(ag[4 * j], ag[4 * j + 1], ag[4 * j + 2], ag[4 * j + 3]);
    }
    __syncthreads();
    {
        const int tok = tid >> 3, cgp = tid & 7, gi = tt0 + tok, b = gi >> 14, s = gi & (S_ - 1), cb = h * 64 + cgp * 8;
        const bool first = (s == 0);
        float r[8], k[8], v[8];
        {
            float a[8], pb[8];
            const bf16_t* pr = p.proj + (size_t)gi * PLD;
#pragma unroll
            for (int q = 0; q < 3; ++q) {
                const int col = q * 512 + cb;
                unpack8(*(const uint4*)(pr + col), a);
                if (first) {
#pragma unroll
                    for (int e = 0; e < 8; ++e) pb[e] = 0.f;
                } else unpack8(*(const uint4*)(pr - PLD + col), pb);
                const float4 m0 = *(const float4*)(p.mu + col), m1 = *(const float4*)(p.mu + col + 4);
                const float mu[8] = {m0.x, m0.y, m0.z, m0.w, m1.x, m1.y, m1.z, m1.w};
#pragma unroll
                for (int e = 0; e < 8; ++e) {
                    const float x = a[e] + (pb[e] - a[e]) * mu[e];
                    if (q == 0) r[e] = x; else if (q == 1) k[e] = x; else v[e] = x;
                }
            }
        }
        float om[8], av[8], gg[8], kk[8], km[8], bb[8];
        float ss = 0.f;
#pragma unroll
        for (int e = 0; e < 8; ++e) {
            const float wp = res[(0 * 32 + tok) * 64 + cgp * 8 + e] + p.w0[cb + e];
            const float z = -wp;
            const float sp = fmaxf(z, 0.f) + __logf(1.f + __expf(-fabsf(z)));
            const float w = -sp - 0.5f;
            om[e] = 1.f - __expf(-__expf(w));
            av[e] = sigmoidf_(res[(1 * 32 + tok) * 64 + cgp * 8 + e] + p.a0[cb + e]);
            gg[e] = res[(2 * 32 + tok) * 64 + cgp * 8 + e];
            kk[e] = k[e] * p.k_k[cb + e];
            ss += kk[e] * kk[e];
            km[e] = k[e] * (1.f + (av[e] - 1.f) * p.k_a[cb + e]);
        }
        ss += __shfl_xor(ss, 1); ss += __shfl_xor(ss, 2); ss += __shfl_xor(ss, 4);
        const float inv = 1.f / fmaxf(sqrtf(ss), 1e-12f);
#pragma unroll
        for (int e = 0; e < 8; ++e) { kk[e] *= inv; bb[e] = kk[e] * av[e]; }
        bf16_t* sp = p.stream + ((size_t)((b * 8 + h) * S_ + s) * 6) * 64 + cgp * 8;
        *(uint4*)(sp) = pack8(om); *(uint4*)(sp + 64) = pack8(km); *(uint4*)(sp + 128) = pack8(kk);
        *(uint4*)(sp + 192) = pack8(bb); *(uint4*)(sp + 256) = pack8(r); *(uint4*)(sp + 320) = pack8(v);
        *(uint4*)(p.gbuf + (size_t)gi * 512 + cb) = pack8(gg);
    }
    __syncthreads();
    }
}

DI void rope_item(const P& p, int idx, char* smem) {
    const int tt0 = idx * 64, tid = tidx();
    bf16_t* vtile = (bf16_t*)smem;
    bf16_t* ktile = vtile + 4 * 64 * 72;
    __syncthreads();
#pragma unroll 1
    for (int it = 0; it < 2; ++it) {
        const int item = tid + it * 256, tok = item >> 3, head = item & 7, gi = tt0 + tok;
        bf16_t* ptr = p.proj + (size_t)gi * PLD + QC + head * 64;
        const float4 c0 = *(const float4*)(p.cosT + (size_t)gi * 8), c1 = *(const float4*)(p.cosT + (size_t)gi * 8 + 4);
        const float4 s0 = *(const float4*)(p.sinT + (size_t)gi * 8), s1 = *(const float4*)(p.sinT + (size_t)gi * 8 + 4);
        const float cc[8] = {c0.x, c0.y, c0.z, c0.w, c1.x, c1.y, c1.z, c1.w}, sn[8] = {s0.x, s0.y, s0.z, s0.w, s1.x, s1.y, s1.z, s1.w};
        float a[8], b[8];
        unpack8(*(const uint4*)ptr, a); unpack8(*(const uint4*)(ptr + 8), b);
#pragma unroll
        for (int e = 0; e < 8; ++e) { const float x1 = a[e], x2 = b[e]; a[e] = (x1 * cc[e] - x2 * sn[e]) * QSC; b[e] = (x2 * cc[e] + x1 * sn[e]) * QSC; }
        *(uint4*)ptr = pack8(a); *(uint4*)(ptr + 8) = pack8(b);
#pragma unroll
        for (int q = 2; q < 8; ++q) {
            unpack8(*(const uint4*)(ptr + q * 8), a);
#pragma unroll
            for (int e = 0; e < 8; ++e) a[e] *= QSC;
            *(uint4*)(ptr + q * 8) = pack8(a);
        }
    }
    {
        const int tok = tid >> 2, sel = (tid >> 1) & 1, hk = tid & 1, gi = tt0 + tok;
        const float4 c0 = *(const float4*)(p.cosT + (size_t)gi * 8), c1 = *(const float4*)(p.cosT + (size_t)gi * 8 + 4);
        const float4 s0 = *(const float4*)(p.sinT + (size_t)gi * 8), s1 = *(const float4*)(p.sinT + (size_t)gi * 8 + 4);
        const float cc[8] = {c0.x, c0.y, c0.z, c0.w, c1.x, c1.y, c1.z, c1.w}, sn[8] = {s0.x, s0.y, s0.z, s0.w, s1.x, s1.y, s1.z, s1.w};
        float a[8], b[8];
        {
            bf16_t* ptr = p.proj + (size_t)gi * PLD + KVC + (sel ? 4 : 2) * 128 + hk * 64;
            unpack8(*(const uint4*)ptr, a); unpack8(*(const uint4*)(ptr + 8), b);
#pragma unroll
            for (int e = 0; e < 8; ++e) { const float x1 = a[e], x2 = b[e]; a[e] = x1 * cc[e] - x2 * sn[e]; b[e] = x2 * cc[e] + x1 * sn[e]; }
            const uint4 ra_ = pack8(a), rb_ = pack8(b);
            *(uint4*)ptr = ra_; *(uint4*)(ptr + 8) = rb_;
            if (sel == 0) {
                bf16_t* kt = ktile + (size_t)(hk * 64 + tok) * 72;
                *(uint4*)kt = ra_; *(uint4*)(kt + 8) = rb_;
#pragma unroll
                for (int q = 2; q < 8; ++q) *(uint4*)(kt + q * 8) = *(const uint4*)(ptr + q * 8);
            }
        }
        {
            const bf16_t* ptr = p.proj + (size_t)gi * PLD + KVC + (sel ? 5 : 3) * 128 + hk * 64;
            bf16_t* vt = vtile + (size_t)((sel * 2 + hk) * 64) * 72 + tok;
            unpack8(*(const uint4*)ptr, a); unpack8(*(const uint4*)(ptr + 8), b);
#pragma unroll
            for (int e = 0; e < 8; ++e) { const float x1 = a[e], x2 = b[e]; a[e] = x1 * cc[e] - x2 * sn[e]; b[e] = x2 * cc[e] + x1 * sn[e]; }
#pragma unroll
            for (int e = 0; e < 8; ++e) { vt[e * 72] = f2bf(a[e]); vt[(8 + e) * 72] = f2bf(b[e]); }
#pragma unroll
            for (int q = 2; q < 8; ++q) {
                const uint4 u = *(const uint4*)(ptr + q * 8);
                const unsigned w[4] = {u.x, u.y, u.z, u.w};
#pragma unroll
                for (int e = 0; e < 4; ++e) { vt[(q * 8 + 2 * e) * 72] = (bf16_t)(w[e] & 0xffffu); vt[(q * 8 + 2 * e + 1) * 72] = (bf16_t)(w[e] >> 16); }
            }
        }
    }
    __syncthreads();
    const int b = tt0 >> 14, s0 = tt0 & (S_ - 1);
#pragma unroll
    for (int i = 0; i < 8; ++i) {
        const int c = tid + i * 256, grp = c >> 9, d = (c >> 3) & 63, ch = c & 7, sel = grp >> 1, hk = grp & 1;
        const uint4 u = *(const uint4*)&vtile[(size_t)(grp * 64 + d) * 72 + ch * 8];
        *(uint4*)(p.vT + ((size_t)((sel * 4 + b * 2 + hk) * 64 + d)) * S_ + s0 + ch * 8) = u;
    }
    const int blk = s0 >> 6;
#pragma unroll
    for (int i = 0; i < 4; ++i) {
        const int c = tid + i * 256, hk = c >> 9, g8 = (c >> 6) & 7, ln = c & 63, rr = ln & 31, hh = ln >> 5;
        const size_t dsto = ((size_t)(((b * 2 + hk) * 256 + blk) * 8 + g8) * 64 + ln) * 8;
        {
            const int mt = g8 >> 2, ks = g8 & 3;
            *(uint4*)(p.ksw + dsto) = *(const uint4*)&ktile[(size_t)(hk * 64 + mt * 32 + rr) * 72 + ks * 16 + hh * 8];
        }
        {
            const int mt = g8 >> 2, s2 = (g8 >> 1) & 1, dt = g8 & 1;
            const bf16_t* row = &vtile[(size_t)((0 * 2 + hk) * 64 + dt * 32 + rr) * 72 + mt * 32 + 16 * s2 + 4 * hh];
            const uint2 lo = *(const uint2*)row, hi = *(const uint2*)(row + 8);
            *(uint4*)(p.vsw + dsto) = make_uint4(lo.x, lo.y, hi.x, hi.y);
        }
    }
}

DI void cmp1_item(const P& p, const int it, char* smem) {
    const int kv = it >> 6, bhk = (it >> 4) & 3, mt = (it >> 1) & 7, nt = it & 1, b = bhk >> 1, hk = bhk & 1;
    AFCmp af{p.proj + (size_t)(b * S_) * PLD + KVC + kv * 128 + hk * 64};
    EpiHid ep{p.hid + (size_t)((kv * 4 + bhk) * 1024) * 256, p.b1p + kv * 256};
    gemm_tile<1>(af, p.w1T + (size_t)(kv * 256 + nt * 128) * 2048, 2048, mt * 128, nt * 128, ep, smem);
}
DI void cmp2_item(const P& p, const int it, char* smem) {
    const int kv = it >> 5, bhk = (it >> 3) & 3, mt = it & 7, b = bhk >> 1;
    AFPlain af{p.hid + (size_t)((kv * 4 + bhk) * 1024) * 256, 256};
    if (kv == 0) { EpiKc ep{p.kc + (size_t)bhk * 1024 * 64, p.cosT, p.sinT, b * S_}; gemm_tile<1>(af, p.wc2T, 256, mt * 128, 0, ep, smem); }
    else { EpiVc ep{p.vcT + (size_t)bhk * 64 * 1024, smem}; gemm_tile<1>(af, p.wc2T + 128 * 256, 256, mt * 128, 0, ep, smem); }
}
DI void phase2(const P& p, char* smem) {
    for (int it = blockIdx.x; it < 128 + 512 + 1024; it += gridDim.x) {
        if (it < 128) cmp1_item(p, it, smem);
        else if (it < 640) rope_item(p, it - 128, smem);
        else rwkv_prep(p, it - 640, smem);
    }
}
DI void phase3(const P& p, char* smem) {
    for (int it = blockIdx.x; it < 64; it += gridDim.x) cmp2_item(p, it, smem);
}

template <int CTRL> DI float dpp_add(float x) { return x + __int_as_float(__builtin_amdgcn_mov_dpp(__float_as_int(x), CTRL, 0xF, 0xF, true)); }
DI float red16(float x) { x = dpp_add<0xB1>(x); x = dpp_add<0x4E>(x); x = dpp_add<0x141>(x); x = dpp_add<0x140>(x); return x; }

DI void cvt_store(const uint4 u, const bool isom, float* d) {
    float f0 = bflo(u.x), f1 = bfhi(u.x), f2 = bflo(u.y), f3 = bfhi(u.y), f4 = bflo(u.z), f5 = bfhi(u.z), f6 = bflo(u.w), f7 = bfhi(u.w);
    if (isom) { f0 = 1.f - f0; f1 = 1.f - f1; f2 = 1.f - f2; f3 = 1.f - f3; f4 = 1.f - f4; f5 = 1.f - f5; f6 = 1.f - f6; f7 = 1.f - f7; }
    *(float4*)d = make_float4(f0, f1, f2, f3); *(float4*)(d + 4) = make_float4(f4, f5, f6, f7);
}
DI void scan_unit(const P& p, int su, char* smem) {
    const int xcd = su & 7, kq = su >> 3, bh = xcd * 2 + (kq >> 3), oct = kq & 7, b = bh >> 3, h = bh & 7;
    const int tid = tidx(), wave = tid >> 6, lane = tid & 63;
    float* buf = (float*)smem;
    float* ypb = (float*)(smem + 49152);
    const bf16_t* sbase = p.stream + (size_t)bh * S_ * 384;
    __syncthreads();
#pragma unroll
    for (int i = 0; i < 3; ++i) { const int ci = tid + i * 256; cvt_store(*(const uint4*)(sbase + (size_t)ci * 8), (ci % 48) < 8, buf + ci * 8); }
    __syncthreads();
    if (wave < 2) {
        const int rl = lane >> 4, ks = lane & 15, row = oct * 8 + wave * 4 + rl;
        f2_t sA = {0.f, 0.f}, sB = {0.f, 0.f};
        __builtin_amdgcn_s_setprio(3);
        for (int c = 0; c < 1024; ++c) {
            const float* cb = buf + (c & 1) * 6144 + ks * 4;
            const float* vb = buf + (c & 1) * 6144 + 320 + row;
            float* yo = ypb + ((c & 1) * 2 + wave) * 1024 + lane;
            float4 dec = *(const float4*)(cb), km = *(const float4*)(cb + 64), kk = *(const float4*)(cb + 128), bb = *(const float4*)(cb + 192), rv = *(const float4*)(cb + 256);
            float v = vb[0];
            float4 dec1 = *(const float4*)(cb + 384), km1 = *(const float4*)(cb + 384 + 64), kk1 = *(const float4*)(cb + 384 + 128), bb1 = *(const float4*)(cb + 384 + 192), rv1 = *(const float4*)(cb + 384 + 256);
            float v1 = vb[384];
#pragma unroll
            for (int st = 0; st < 16; ++st) {
                float4 dec2 = dec1, km2 = km1, kk2 = kk1, bb2 = bb1, rv2 = rv1; float v2 = v1;
                if (st < 14) {
                    const float* rec = cb + (st + 2) * 384;
                    dec2 = *(const float4*)(rec); km2 = *(const float4*)(rec + 64); kk2 = *(const float4*)(rec + 128); bb2 = *(const float4*)(rec + 192); rv2 = *(const float4*)(rec + 256);
                    v2 = vb[(st + 2) * 384];
                }
                __builtin_amdgcn_sched_barrier(0x207);
                const f2_t vv = {v, v};
                const f2_t d01 = {dec.x, dec.y}, d23 = {dec.z, dec.w}, m01 = {km.x, km.y}, m23 = {km.z, km.w};
                const f2_t k01 = {kk.x, kk.y}, k23 = {kk.z, kk.w}, b01 = {bb.x, bb.y}, b23 = {bb.z, bb.w}, r01 = {rv.x, rv.y}, r23 = {rv.z, rv.w};
                const f2_t tA = sA * d01 + vv * m01, tB = sB * d23 + vv * m23;
                f2_t pa = sA * k01; pa = sB * k23 + pa;
                const float sa = red16(pa.x + pa.y);
                const f2_t sav = {sa, sa};
                sA = tA - sav * b01; sB = tB - sav * b23;
                f2_t ya = sA * r01; ya = sB * r23 + ya;
                yo[st * 64] = ya.x + ya.y;
                dec = dec1; km = km1; kk = kk1; bb = bb1; rv = rv1; v = v1;
                dec1 = dec2; km1 = km2; kk1 = kk2; bb1 = bb2; rv1 = rv2; v1 = v2;
            }
            __syncthreads();
        }
        __builtin_amdgcn_s_setprio(0);
    } else {
        const int ht = tid - 128;
        const int ystep = ht >> 3, r8 = ht & 7;
        float* yout = p.yraw + (size_t)(b * S_) * 512 + h * 64 + oct * 8 + r8;
        const float* ysrc = ypb + (r8 >> 2) * 1024 + ystep * 64 + (r8 & 3) * 16;
        uint4 ra0, ra1, ra2, ra3, ra4, ra5, rb0, rb1, rb2, rb3, rb4, rb5;
#define SLOAD(R, CH) { const bf16_t* sp_ = sbase + (size_t)(CH) * 6144 + (size_t)ht * 8; \
        R##0 = *(const uint4*)(sp_); R##1 = *(const uint4*)(sp_ + 1024); R##2 = *(const uint4*)(sp_ + 2048); R##3 = *(const uint4*)(sp_ + 3072); R##4 = *(const uint4*)(sp_ + 4096); R##5 = *(const uint4*)(sp_ + 5120); }
#define SSTORE(R, BI) { float* d_ = buf + (BI) * 6144 + ht * 8; const bool om_ = (ht % 48) < 8; \
        cvt_store(R##0, om_, d_); cvt_store(R##1, ((ht + 128) % 48) < 8, d_ + 1024); cvt_store(R##2, ((ht + 256) % 48) < 8, d_ + 2048); \
        cvt_store(R##3, ((ht + 384) % 48) < 8, d_ + 3072); cvt_store(R##4, ((ht + 512) % 48) < 8, d_ + 4096); cvt_store(R##5, ((ht + 640) % 48) < 8, d_ + 5120); }
#define YRED(C) { const float* ys_ = ysrc + ((C) & 1) * 2048; const float4 a_ = *(const float4*)ys_, b_ = *(const float4*)(ys_ + 4), c_ = *(const float4*)(ys_ + 8), d_ = *(const float4*)(ys_ + 12); \
        yout[(size_t)((C) * 16 + ystep) * 512] = ((a_.x + a_.y) + (a_.z + a_.w)) + ((b_.x + b_.y) + (b_.z + b_.w)) + ((c_.x + c_.y) + (c_.z + c_.w)) + ((d_.x + d_.y) + (d_.z + d_.w)); }
        SLOAD(ra, 1)
        for (int c = 0; c < 1024; c += 2) {
            if (c + 2 < 1024) SLOAD(rb, c + 2)
            SSTORE(ra, 1)
            if (c >= 1) YRED(c - 1)
            __syncthreads();
            if (c + 3 < 1024) SLOAD(ra, c + 3)
            if (c + 2 < 1024) SSTORE(rb, 0)
            YRED(c)
            __syncthreads();
        }
        YRED(1023)
#undef SLOAD
#undef SSTORE
#undef YRED
    }
}

struct AttnSmem {
    bf16_t k[64 * 72];
    bf16_t vt[64 * 68];
    float imp[32 * 256];
    unsigned selbits[32 * 8];
    unsigned wunion[4 * 8];
    unsigned bunion[8];
    int unit;
    int pad_[3];
    uint4 q[4 * 4 * 64];
};

#define ATTN_LOAD(KBASE, KSTRIDE, VTBASE, VTSTRIDE, NEEDV) { \
    rk0 = *(const uint4*)((KBASE) + (size_t)(tid >> 3) * (KSTRIDE) + (tid & 7) * 8); \
    rk1 = *(const uint4*)((KBASE) + (size_t)((tid >> 3) + 32) * (KSTRIDE) + (tid & 7) * 8); \
    if (NEEDV) { rv0 = *(const uint4*)((VTBASE) + (size_t)(tid >> 3) * (VTSTRIDE) + (tid & 7) * 8); \
                 rv1 = *(const uint4*)((VTBASE) + (size_t)((tid >> 3) + 32) * (VTSTRIDE) + (tid & 7) * 8); } }
#define ATTN_STORE(NEEDV) { \
    *(uint4*)&sm.k[(tid >> 3) * 72 + (tid & 7) * 8] = rk0; *(uint4*)&sm.k[((tid >> 3) + 32) * 72 + (tid & 7) * 8] = rk1; \
    if (NEEDV) { bf16_t* d0_ = &sm.vt[(tid >> 3) * 68 + (tid & 7) * 8]; bf16_t* d1_ = &sm.vt[((tid >> 3) + 32) * 68 + (tid & 7) * 8]; \
        *(uint2*)d0_ = make_uint2(rv0.x, rv0.y); *(uint2*)(d0_ + 4) = make_uint2(rv0.z, rv0.w); \
        *(uint2*)d1_ = make_uint2(rv1.x, rv1.y); *(uint2*)(d1_ + 4) = make_uint2(rv1.z, rv1.w); } }

template <int MODE, bool EM>
DI void attn_tile(AttnSmem& sm, const uint4* qs, f32x16 (&o)[2], float& m, float& l, const float inv_l, const int lo, const int hi, const bool lane_on,
                  const int lane, const int tokl, const int jbase) {
    const int rr = lane & 31, hh = lane >> 5;
    f32x16 s[2];
#pragma unroll
    for (int mt = 0; mt < 2; ++mt) {
#pragma unroll
        for (int i = 0; i < 16; ++i) s[mt][i] = 0.f;
#pragma unroll
        for (int ks = 0; ks < 4; ++ks) {
            const bf16x8 kf = *(const bf16x8*)&sm.k[(mt * 32 + rr) * 72 + ks * 16 + hh * 8];
            const bf16x8 qv = __builtin_bit_cast(bf16x8, qs[ks * 64]);
            s[mt] = MFMA32(kf, qv, s[mt]);
        }
        asm volatile("" ::: "memory");
    }
    (void)m;
    __builtin_amdgcn_sched_barrier(0);
    float psum = 0.f;
    if (EM) {
        const int lo2 = lo - 4 * hh, hi2 = hi - 4 * hh;
#pragma unroll
        for (int mt = 0; mt < 2; ++mt)
#pragma unroll
            for (int i = 0; i < 16; ++i) {
                const int kc_ = mt * 32 + (i & 3) + 8 * (i >> 2);
                float v = s[mt][i];
                v = (kc_ >= lo2 && kc_ <= hi2) ? v : -1e30f;
                float pv = __builtin_amdgcn_exp2f(v);
                if (MODE == 2) pv *= inv_l;
                s[mt][i] = pv; psum += pv;
            }
    } else {
        const float off = lane_on ? 0.f : -1e30f;
#pragma unroll
        for (int mt = 0; mt < 2; ++mt)
#pragma unroll
            for (int i = 0; i < 16; ++i) {
                float pv = __builtin_amdgcn_exp2f(s[mt][i] + off);
                if (MODE == 2) pv *= inv_l;
                s[mt][i] = pv; psum += pv;
            }
    }
    __builtin_amdgcn_sched_barrier(0);
    if (MODE != 2) l += psum;
    if (MODE == 0) return;
    if (MODE == 2) {
#pragma unroll
        for (int mt = 0; mt < 2; ++mt)
#pragma unroll
            for (int jj = 0; jj < 4; ++jj) {
                float q4 = (s[mt][4 * jj] + s[mt][4 * jj + 1]) + (s[mt][4 * jj + 2] + s[mt][4 * jj + 3]);
                float e3 = s[mt][4 * jj + 3];
                q4 += __shfl_xor(q4, 1); q4 += __shfl_xor(q4, 2);
                e3 += __shfl_xor(e3, 1); e3 += __shfl_xor(e3, 2);
                if ((rr & 3) == 0) {
                    const int j = jbase + mt * 8 + 2 * jj + hh;
                    atomicAdd(&sm.imp[tokl * 256 + j], q4);
                    if (j + 1 < 256) atomicAdd(&sm.imp[tokl * 256 + j + 1], e3);
                }
            }
    }
#pragma unroll
    for (int mt = 0; mt < 2; ++mt)
#pragma unroll
        for (int s2 = 0; s2 < 2; ++s2) {
            uint4 pu;
            pu.x = pack2(s[mt][8 * s2 + 0], s[mt][8 * s2 + 1]); pu.y = pack2(s[mt][8 * s2 + 2], s[mt][8 * s2 + 3]);
            pu.z = pack2(s[mt][8 * s2 + 4], s[mt][8 * s2 + 5]); pu.w = pack2(s[mt][8 * s2 + 6], s[mt][8 * s2 + 7]);
            const bf16x8 pf = __builtin_bit_cast(bf16x8, pu);
            asm volatile("" ::: "memory");
#pragma unroll
            for (int dt = 0; dt < 2; ++dt) {
                const bf16_t* vp = &sm.vt[(dt * 32 + rr) * 68 + mt * 32 + s2 * 16 + hh * 4];
                const uint2 v0 = *(const uint2*)vp, v1 = *(const uint2*)(vp + 8);
                const bf16x8 vf = __builtin_bit_cast(bf16x8, make_uint4(v0.x, v0.y, v1.x, v1.y));
                o[dt] = MFMA32(vf, pf, o[dt]);
            }
        }
}

template <int CTRL> DI unsigned dpp_umax(unsigned x) { const unsigned t = (unsigned)__builtin_amdgcn_mov_dpp((int)x, CTRL, 0xF, 0xF, true); return x > t ? x : t; }
DI unsigned wave_umax(unsigned v) {
    v = dpp_umax<0xB1>(v); v = dpp_umax<0x4E>(v); v = dpp_umax<0x141>(v); v = dpp_umax<0x140>(v);
    const unsigned a = (unsigned)__builtin_amdgcn_readlane((int)v, 0), b = (unsigned)__builtin_amdgcn_readlane((int)v, 16);
    const unsigned c = (unsigned)__builtin_amdgcn_readlane((int)v, 32), d = (unsigned)__builtin_amdgcn_readlane((int)v, 48);
    const unsigned ab = a > b ? a : b, cd = c > d ? c : d;
    return ab > cd ? ab : cd;
}


typedef unsigned u32x4 __attribute__((ext_vector_type(4)));
#define GLD16(R, PTR) asm volatile("global_load_dwordx4 %0, %1, off" : "=&v"(R) : "v"(PTR))
template <bool NEEDV, class NextF, class KPtrF, class VPtrF, class CompF>
DI void attn_pipe(AttnSmem& sm, const int tid, int j, const NextF next, const KPtrF kptr, const int kst, const VPtrF vptr, const int vst, const CompF comp) {
    if (j < 0) return;
    u32x4 Ak0, Ak1, Av0 = {0u, 0u, 0u, 0u}, Av1 = {0u, 0u, 0u, 0u}, Bk0, Bk1, Bv0 = {0u, 0u, 0u, 0u}, Bv1 = {0u, 0u, 0u, 0u};
    const int lr = tid >> 3, lc = (tid & 7) * 8;
#define PIPE_LOADS(S, JJ) { const bf16_t* kp_ = kptr(JJ) + (size_t)lr * kst + lc; GLD16(S##k0, kp_); GLD16(S##k1, kp_ + (size_t)32 * kst); \
        if (NEEDV) { const bf16_t* vp_ = vptr(JJ) + (size_t)lr * vst + lc; GLD16(S##v0, vp_); GLD16(S##v1, vp_ + (size_t)32 * vst); } }
#define PIPE_WAIT(S) { if (NEEDV) asm volatile("s_waitcnt vmcnt(4)" : "+v"(S##k0), "+v"(S##k1), "+v"(S##v0), "+v"(S##v1)); \
        else asm volatile("s_waitcnt vmcnt(2)" : "+v"(S##k0), "+v"(S##k1)); }
#define PIPE_STORES(S) { *(u32x4*)&sm.k[lr * 72 + lc] = S##k0; *(u32x4*)&sm.k[(lr + 32) * 72 + lc] = S##k1; \
        if (NEEDV) { bf16_t* d0_ = &sm.vt[lr * 68 + lc]; bf16_t* d1_ = &sm.vt[(lr + 32) * 68 + lc]; \
            *(uint2*)d0_ = make_uint2(S##v0.x, S##v0.y); *(uint2*)(d0_ + 4) = make_uint2(S##v0.z, S##v0.w); \
            *(uint2*)d1_ = make_uint2(S##v1.x, S##v1.y); *(uint2*)(d1_ + 4) = make_uint2(S##v1.z, S##v1.w); } }
    int jn = next(j);
    PIPE_LOADS(A, j)
    PIPE_LOADS(B, (jn >= 0 ? jn : j))
    while (true) {
        __syncthreads();
        PIPE_WAIT(A)
        PIPE_STORES(A)
        __syncthreads();
        const int jnn = jn >= 0 ? next(jn) : -1;
        PIPE_LOADS(A, (jnn >= 0 ? jnn : j))
        comp(j);
        if (jn < 0) break;
        __syncthreads();
        PIPE_WAIT(B)
        PIPE_STORES(B)
        __syncthreads();
        const int jnnn = jnn >= 0 ? next(jnn) : -1;
        PIPE_LOADS(B, (jnnn >= 0 ? jnnn : jn))
        comp(jn);
        if (jnn < 0) break;
        j = jnn; jn = jnnn;
    }
    asm volatile("s_waitcnt vmcnt(0)" : "+v"(Ak0), "+v"(Ak1), "+v"(Av0), "+v"(Av1), "+v"(Bk0), "+v"(Bk1), "+v"(Bv0), "+v"(Bv1));
#undef PIPE_LOADS
#undef PIPE_WAIT
#undef PIPE_STORES
}


template <bool EM>
DI void sel_scores(const u32x4 k0, const u32x4 k1, const u32x4 k2, const u32x4 k3, const u32x4 k4, const u32x4 k5, const u32x4 k6, const u32x4 k7,
                   const uint4* qs, float& l, const int lo, const int hi, const bool lane_on, const int lane,
                   u32x4& pf0, u32x4& pf1, u32x4& pf2, u32x4& pf3) {
    const int hh = lane >> 5;
    f32x16 s0, s1;
#pragma unroll
    for (int i = 0; i < 16; ++i) { s0[i] = 0.f; s1[i] = 0.f; }
    {
        const bf16x8 q0 = __builtin_bit_cast(bf16x8, qs[0]), q1 = __builtin_bit_cast(bf16x8, qs[64]), q2 = __builtin_bit_cast(bf16x8, qs[128]), q3 = __builtin_bit_cast(bf16x8, qs[192]);
        s0 = MFMA32(__builtin_bit_cast(bf16x8, k0), q0, s0); s1 = MFMA32(__builtin_bit_cast(bf16x8, k4), q0, s1);
        s0 = MFMA32(__builtin_bit_cast(bf16x8, k1), q1, s0); s1 = MFMA32(__builtin_bit_cast(bf16x8, k5), q1, s1);
        s0 = MFMA32(__builtin_bit_cast(bf16x8, k2), q2, s0); s1 = MFMA32(__builtin_bit_cast(bf16x8, k6), q2, s1);
        s0 = MFMA32(__builtin_bit_cast(bf16x8, k3), q3, s0); s1 = MFMA32(__builtin_bit_cast(bf16x8, k7), q3, s1);
    }
    float psum = 0.f;
    if (EM) {
        const int lo2 = lo - 4 * hh, hi2 = hi - 4 * hh;
#pragma unroll
        for (int i = 0; i < 16; ++i) {
            const int kc_ = (i & 3) + 8 * (i >> 2);
            float v = (kc_ >= lo2 && kc_ <= hi2) ? s0[i] : -1e30f;
            float w = (kc_ + 32 >= lo2 && kc_ + 32 <= hi2) ? s1[i] : -1e30f;
            v = __builtin_amdgcn_exp2f(v); w = __builtin_amdgcn_exp2f(w);
            s0[i] = v; s1[i] = w; psum += v + w;
        }
    } else {
        const float off = lane_on ? 0.f : -1e30f;
#pragma unroll
        for (int i = 0; i < 16; ++i) {
            const float v = __builtin_amdgcn_exp2f(s0[i] + off), w = __builtin_amdgcn_exp2f(s1[i] + off);
            s0[i] = v; s1[i] = w; psum += v + w;
        }
    }
    l += psum;
    pf0.x = pack2(s0[0], s0[1]); pf0.y = pack2(s0[2], s0[3]); pf0.z = pack2(s0[4], s0[5]); pf0.w = pack2(s0[6], s0[7]);
    pf1.x = pack2(s0[8], s0[9]); pf1.y = pack2(s0[10], s0[11]); pf1.z = pack2(s0[12], s0[13]); pf1.w = pack2(s0[14], s0[15]);
    pf2.x = pack2(s1[0], s1[1]); pf2.y = pack2(s1[2], s1[3]); pf2.z = pack2(s1[4], s1[5]); pf2.w = pack2(s1[6], s1[7]);
    pf3.x = pack2(s1[8], s1[9]); pf3.y = pack2(s1[10], s1[11]); pf3.z = pack2(s1[12], s1[13]); pf3.w = pack2(s1[14], s1[15]);
}
DI void sel_pv(const u32x4 v0, const u32x4 v1, const u32x4 v2, const u32x4 v3, const u32x4 v4, const u32x4 v5, const u32x4 v6, const u32x4 v7,
               const u32x4 pf0, const u32x4 pf1, const u32x4 pf2, const u32x4 pf3, f32x16 (&o)[2]) {
    o[0] = MFMA32(__builtin_bit_cast(bf16x8, v0), __builtin_bit_cast(bf16x8, pf0), o[0]); o[1] = MFMA32(__builtin_bit_cast(bf16x8, v1), __builtin_bit_cast(bf16x8, pf0), o[1]);
    o[0] = MFMA32(__builtin_bit_cast(bf16x8, v2), __builtin_bit_cast(bf16x8, pf1), o[0]); o[1] = MFMA32(__builtin_bit_cast(bf16x8, v3), __builtin_bit_cast(bf16x8, pf1), o[1]);
    o[0] = MFMA32(__builtin_bit_cast(bf16x8, v4), __builtin_bit_cast(bf16x8, pf2), o[0]); o[1] = MFMA32(__builtin_bit_cast(bf16x8, v5), __builtin_bit_cast(bf16x8, pf2), o[1]);
    o[0] = MFMA32(__builtin_bit_cast(bf16x8, v6), __builtin_bit_cast(bf16x8, pf3), o[0]); o[1] = MFMA32(__builtin_bit_cast(bf16x8, v7), __builtin_bit_cast(bf16x8, pf3), o[1]);
}

DI void attn_unit(const P& p, int u, char* smem) {
    AttnSmem& sm = *(AttnSmem*)smem;
    const int tid = tidx(), wave = tid >> 6, lane = tid & 63, rr = lane & 31, hh = lane >> 5;
    const int tile = 511 - (u >> 2), bhk = u & 3, b = bhk >> 1, hk = bhk & 1, t0 = tile * 32;
    const int tokl = wave * 8 + (rr >> 2), t = t0 + tokl, g = rr & 3, head = hk * 4 + g;
    const size_t tokg = (size_t)b * S_ + t;
    uint4* qs = &sm.q[wave * 256 + lane];
#pragma unroll
    for (int ks = 0; ks < 4; ++ks) qs[ks * 64] = *(const uint4*)(p.proj + tokg * PLD + QC + head * 64 + ks * 16 + hh * 8);
#define GATE(i) sigmoidf_(__uint_as_float((unsigned)p.proj[((size_t)b * S_ + t) * PLD + GC + head * 3 + (i)] << 16))
#pragma unroll
    for (int i = 0; i < 8; ++i) *(float4*)&sm.imp[(tid + i * 256) * 4] = make_float4(0.f, 0.f, 0.f, 0.f);
    sm.selbits[tid] = 0u;
    f32x16 o[2];
#pragma unroll
    for (int dt = 0; dt < 2; ++dt)
#pragma unroll
        for (int i = 0; i < 16; ++i) o[dt][i] = 0.f;
    float* park = &sm.imp[wave * 2048 + lane];
    const int ntc = (t0 >> 10) + 1;
    const int vmaxi = (t >= 31) ? ((t - 31) >> 4) : -1;
    const int twmin = t0 + wave * 8;
    const int wvmin = (twmin >= 31) ? ((twmin - 31) >> 4) : -1;
    const bf16_t* kcb = p.kc + (size_t)bhk * 1024 * 64;
    const bf16_t* vcb = p.vcT + (size_t)bhk * 64 * 1024;
    float m = -1e30f, l = 0.f;
    {
        auto nxt = [&](int j) -> int { return j + 1 < ntc ? j + 1 : -1; };
        auto kp = [&](int j) -> const bf16_t* { return kcb + (size_t)j * 64 * 64; };
        auto vp = [&](int j) -> const bf16_t* { return vcb + j * 64; };
        attn_pipe<false>(sm, tid, 0, nxt, kp, 64, vp, 1024, [&](int j) {
            if (j * 64 + 63 <= wvmin) attn_tile<0, false>(sm, qs, o, m, l, 0.f, 0, 0, true, lane, tokl, 0);
            else attn_tile<0, true>(sm, qs, o, m, l, 0.f, 0, vmaxi - j * 64, true, lane, tokl, 0);
        });
        const float lt = l + __shfl_xor(l, 32);
        const float inv_l = lt > 0.f ? 1.f / lt : 0.f;
        attn_pipe<true>(sm, tid, 0, nxt, kp, 64, vp, 1024, [&](int j) {
            if (j * 64 + 63 <= wvmin) attn_tile<2, false>(sm, qs, o, m, l, inv_l, 0, 0, true, lane, tokl, j * 16);
            else attn_tile<2, true>(sm, qs, o, m, l, inv_l, 0, vmaxi - j * 64, true, lane, tokl, j * 16);
        });
    }
    __syncthreads();
    const int cur = t0 >> 6;
    for (int tk = 0; tk < 8; ++tk) {
        const int tl = wave * 8 + tk;
        const float* ip = &sm.imp[tl * 256];
        unsigned nib = 0u;
        if (cur <= 15) {
#pragma unroll
            for (int e = 0; e < 4; ++e) if (lane * 4 + e <= cur) nib |= 1u << e;
        } else {
            unsigned k0, k1, k2, k3;
            {
                const float4 iv = *(const float4*)(ip + lane * 4);
                const int j0 = lane * 4;
                k0 = (j0 >= 1 && j0 <= cur - 2) ? ((__float_as_uint(iv.x) & 0xFFFFFF00u) | (unsigned)(255 - j0)) : 0u;
                k1 = (j0 + 1 <= cur - 2) ? ((__float_as_uint(iv.y) & 0xFFFFFF00u) | (unsigned)(254 - j0)) : 0u;
                k2 = (j0 + 2 <= cur - 2) ? ((__float_as_uint(iv.z) & 0xFFFFFF00u) | (unsigned)(253 - j0)) : 0u;
                k3 = (j0 + 3 <= cur - 2) ? ((__float_as_uint(iv.w) & 0xFFFFFF00u) | (unsigned)(252 - j0)) : 0u;
#pragma unroll
                for (int e = 0; e < 4; ++e) { const int j = j0 + e; if (j == 0 || j == cur || j == cur - 1) nib |= 1u << e; }
            }
            for (int r = 0; r < 13; ++r) {
                unsigned lm = k0 > k1 ? k0 : k1; const unsigned lm2 = k2 > k3 ? k2 : k3; lm = lm > lm2 ? lm : lm2;
                const unsigned wm = wave_umax(lm);
                if (k0 == wm) { k0 = 0u; nib |= 1u; }
                if (k1 == wm) { k1 = 0u; nib |= 2u; }
                if (k2 == wm) { k2 = 0u; nib |= 4u; }
                if (k3 == wm) { k3 = 0u; nib |= 8u; }
            }
        }
        atomicOr(&sm.selbits[tl * 8 + (lane >> 3)], nib << ((lane & 7) * 4));
    }
    __syncthreads();
    if (tid < 32) {
        const int w = tid >> 3, d = tid & 7; unsigned uu = 0u;
#pragma unroll
        for (int k = 0; k < 8; ++k) uu |= sm.selbits[(w * 8 + k) * 8 + d];
        sm.wunion[w * 8 + d] = uu;
    }
    __syncthreads();
    if (tid < 8) sm.bunion[tid] = sm.wunion[tid] | sm.wunion[8 + tid] | sm.wunion[16 + tid] | sm.wunion[24 + tid];
    __syncthreads();
    {
        const float g0 = GATE(0);
#pragma unroll
        for (int dt = 0; dt < 2; ++dt)
#pragma unroll
            for (int i = 0; i < 16; ++i) { park[(dt * 16 + i) * 64] = g0 * o[dt][i]; o[dt][i] = 0.f; }
    }
    {
        const bf16_t* kb = p.proj + (size_t)(b * S_) * PLD + KVC + 2 * 128 + hk * 64;
        const bf16_t* vb = p.vT + (size_t)((0 * 4 + bhk) * 64) * S_;
        m = -1e30f; l = 0.f;
        (void)kb; (void)vb;
        auto nextw = [&](int j) -> int {
            ++j;
            while (j <= cur) {
                const unsigned w = sm.wunion[wave * 8 + (j >> 5)] >> (j & 31);
                if (w) { j += __ffs((int)w) - 1; return j <= cur ? j : -1; }
                j = (j | 31) + 1;
            }
            return -1;
        };
        const bf16_t* kswb = p.ksw + ((size_t)bhk * 256 * 512 + lane) * 8;
        const bf16_t* vswb = p.vsw + ((size_t)bhk * 256 * 512 + lane) * 8;
        u32x4 A0, A1, A2, A3, A4, A5, A6, A7, B0, B1, B2, B3, B4, B5, B6, B7, V0, V1, V2, V3, V4, V5, V6, V7, pf0, pf1, pf2, pf3;
#define SEL_LD8(R, BASE, JJ) { const bf16_t* b_ = (BASE) + (size_t)(JJ) * 4096; GLD16(R##0, b_); GLD16(R##1, b_ + 512); GLD16(R##2, b_ + 1024); GLD16(R##3, b_ + 1536); \
        GLD16(R##4, b_ + 2048); GLD16(R##5, b_ + 2560); GLD16(R##6, b_ + 3072); GLD16(R##7, b_ + 3584); }
#define SEL_WAIT8(R, N) asm volatile("s_waitcnt vmcnt(" #N ")" : "+v"(R##0), "+v"(R##1), "+v"(R##2), "+v"(R##3), "+v"(R##4), "+v"(R##5), "+v"(R##6), "+v"(R##7))
#define SEL_TILE(K, JJ) { \
        const int jj_ = (JJ); \
        const bool selme_ = (sm.selbits[tokl * 8 + (jj_ >> 5)] >> (jj_ & 31)) & 1u; \
        SEL_WAIT8(K, 16); \
        if (jj_ < cur) sel_scores<false>(K##0, K##1, K##2, K##3, K##4, K##5, K##6, K##7, qs, l, 0, 0, selme_, lane, pf0, pf1, pf2, pf3); \
        else sel_scores<true>(K##0, K##1, K##2, K##3, K##4, K##5, K##6, K##7, qs, l, 0, selme_ ? t - jj_ * 64 : -1, true, lane, pf0, pf1, pf2, pf3); \
        SEL_WAIT8(V, 8); \
        sel_pv(V0, V1, V2, V3, V4, V5, V6, V7, pf0, pf1, pf2, pf3, o); }
        int j = nextw(-1);
        if (j >= 0) {
            SEL_LD8(A, kswb, j)
            while (true) {
                const int jn = nextw(j);
                SEL_LD8(V, vswb, j)
                SEL_LD8(B, kswb, (jn >= 0 ? jn : j))
                SEL_TILE(A, j)
                if (jn < 0) break;
                const int jnn = nextw(jn);
                SEL_LD8(V, vswb, jn)
                SEL_LD8(A, kswb, (jnn >= 0 ? jnn : jn))
                SEL_TILE(B, jn)
                if (jnn < 0) break;
                j = jnn;
            }
            asm volatile("s_waitcnt vmcnt(0)" : "+v"(A0), "+v"(A1), "+v"(A2), "+v"(A3), "+v"(A4), "+v"(A5), "+v"(A6), "+v"(A7), "+v"(B0), "+v"(B1), "+v"(B2), "+v"(B3), "+v"(B4), "+v"(B5), "+v"(B6), "+v"(B7));
            asm volatile("s_waitcnt vmcnt(0)" : "+v"(V0), "+v"(V1), "+v"(V2), "+v"(V3), "+v"(V4), "+v"(V5), "+v"(V6), "+v"(V7));
        }
#undef SEL_LD8
#undef SEL_WAIT8
#undef SEL_TILE
        const float lt = l + __shfl_xor(l, 32);
        const float sc = lt > 0.f ? GATE(1) / lt : 0.f;
#pragma unroll
        for (int dt = 0; dt < 2; ++dt)
#pragma unroll
            for (int i = 0; i < 16; ++i) { park[(dt * 16 + i) * 64] += sc * o[dt][i]; o[dt][i] = 0.f; }
    }
    {
        const bf16_t* kb = p.proj + (size_t)(b * S_) * PLD + KVC + 4 * 128 + hk * 64;
        const bf16_t* vb = p.vT + (size_t)((1 * 4 + bhk) * 64) * S_;
        m = -1e30f; l = 0.f;
        const int jlo = (t0 >= 511) ? ((t0 - 511) >> 6) : 0, jhi = t0 >> 6;
        attn_pipe<true>(sm, tid, jlo, [&](int j) -> int { return j + 1 <= jhi ? j + 1 : -1; }, [&](int j) -> const bf16_t* { return kb + (size_t)j * 64 * PLD; }, PLD,
                        [&](int j) -> const bf16_t* { return vb + j * 64; }, S_, [&](int j) {
            if (j * 64 >= twmin + 7 - 511 && j * 64 + 63 <= twmin) attn_tile<1, false>(sm, qs, o, m, l, 0.f, 0, 0, true, lane, tokl, 0);
            else attn_tile<1, true>(sm, qs, o, m, l, 0.f, t - 511 - j * 64, t - j * 64, true, lane, tokl, 0);
        });
        const float lt = l + __shfl_xor(l, 32);
        const float sc = lt > 0.f ? GATE(2) / lt : 0.f;
#pragma unroll
        for (int dt = 0; dt < 2; ++dt)
#pragma unroll
            for (int i = 0; i < 16; ++i) o[dt][i] = park[(dt * 16 + i) * 64] + sc * o[dt][i];
    }
    bf16_t* mp = p.A + tokg * 1024 + 512 + head * 64;
#pragma unroll
    for (int dt = 0; dt < 2; ++dt)
#pragma unroll
        for (int jj = 0; jj < 4; ++jj) {
            uint2 ov; ov.x = pack2(o[dt][4 * jj], o[dt][4 * jj + 1]); ov.y = pack2(o[dt][4 * jj + 2], o[dt][4 * jj + 3]);
            *(uint2*)(mp + dt * 32 + jj * 8 + hh * 4) = ov;
        }
}

DI void phase4(const P& p, char* smem) {
    for (int su = blockIdx.x; su < 128; su += gridDim.x) scan_unit(p, su, smem);
    AttnSmem& sm = *(AttnSmem*)smem;
    while (true) {
        __syncthreads();
        if (tidx() == 0) sm.unit = (int)atomicAdd(p.counter, 1u);
        __syncthreads();
        const int u = sm.unit;
        if (u >= 2048) break;
        attn_unit(p, u, smem);
    }
}

DI void phase4b(const P& p) {
    const int tid = tidx();
    for (int it = blockIdx.x; it < T_ / 4; it += gridDim.x) {
        const int gi = it * 4 + (tid >> 6), cgp = tid & 63, h = cgp >> 3, c8 = (cgp & 7) * 8, col = cgp * 8, b = gi >> 14, s = gi & (S_ - 1);
        const float4 y0 = *(const float4*)(p.yraw + (size_t)gi * 512 + col), y1 = *(const float4*)(p.yraw + (size_t)gi * 512 + col + 4);
        float y[8] = {y0.x, y0.y, y0.z, y0.w, y1.x, y1.y, y1.z, y1.w};
        const bf16_t* sp = p.stream + ((size_t)((b * 8 + h) * S_ + s) * 6) * 64 + c8;
        float km[8], r[8], v[8], gg[8];
        unpack8(*(const uint4*)(sp + 64), km); unpack8(*(const uint4*)(sp + 256), r); unpack8(*(const uint4*)(sp + 320), v);
        unpack8(*(const uint4*)(p.gbuf + (size_t)gi * 512 + col), gg);
        float sum = 0.f, bon = 0.f;
#pragma unroll
        for (int e = 0; e < 8; ++e) { sum += y[e]; bon += r[e] * km[e] * p.r_k[col + e]; }
        sum += __shfl_xor(sum, 1); sum += __shfl_xor(sum, 2); sum += __shfl_xor(sum, 4);
        bon += __shfl_xor(bon, 1); bon += __shfl_xor(bon, 2); bon += __shfl_xor(bon, 4);
        const float mean = sum * (1.f / 64.f);
        float var = 0.f;
#pragma unroll
        for (int e = 0; e < 8; ++e) { y[e] -= mean; var += y[e] * y[e]; }
        var += __shfl_xor(var, 1); var += __shfl_xor(var, 2); var += __shfl_xor(var, 4);
        const float rs = rsqrtf(var * (1.f / 64.f) + 64e-5f);
        float o[8];
#pragma unroll
        for (int e = 0; e < 8; ++e) o[e] = (y[e] * rs * p.lnx_w[col + e] + p.lnx_b[col + e] + bon * v[e]) * gg[e];
        *(uint4*)(p.A + (size_t)gi * 1024 + col) = pack8(o);
    }
}

struct EpiFfn2 {
    float* out;
    DI void operator()(const f32x16 (&acc)[2][2], int rowbase, int colbase, int lane) const {
        const int rr = lane & 31, hh = lane >> 5;
#pragma unroll
        for (int w = 0; w < 2; ++w)
#pragma unroll
            for (int t = 0; t < 2; ++t)
#pragma unroll
                for (int j = 0; j < 4; ++j) {
                    float4* o = (float4*)(out + (size_t)(rowbase + t * 32 + rr) * 1024 + colbase + w * 32 + j * 8 + hh * 4);
                    float4 xv = *o;
                    xv.x += acc[w][t][4 * j]; xv.y += acc[w][t][4 * j + 1]; xv.z += acc[w][t][4 * j + 2]; xv.w += acc[w][t][4 * j + 3];
                    *o = xv;
                }
    }
};

DI void final_item(float* io, const float* g, int idx) {
    const int row = idx * 4 + (tidx() >> 6), lane = tidx() & 63;
    float4* sp = (float4*)(io + (size_t)row * 1024);
    float4 v[4]; float ss = 0.f;
#pragma unroll
    for (int i = 0; i < 4; ++i) { v[i] = sp[lane + 64 * i]; ss += v[i].x * v[i].x + v[i].y * v[i].y + v[i].z * v[i].z + v[i].w * v[i].w; }
    ss = wave_sum(ss);
    const float rs = rsqrtf(ss * (1.f / 1024.f) + 1e-6f);
#pragma unroll
    for (int i = 0; i < 4; ++i) {
        const float4 gv = ((const float4*)g)[lane + 64 * i];
        sp[lane + 64 * i] = make_float4(v[i].x * rs * gv.x, v[i].y * rs * gv.y, v[i].z * rs * gv.z, v[i].w * rs * gv.w);
    }
}

DI bool gemm_order(const int round, const int NT, int& mt, int& nt) {
    if (gridDim.x == 512) {
        const int xcd = blockIdx.x & 7, lb = blockIdx.x >> 3;
        const int q = round * 64 + lb;
        if (q >= 32 * NT) return false;
        mt = xcd * 32 + (q / (8 * NT)) * 8 + (q & 7);
        nt = (q >> 3) % NT;
        return true;
    }
    const int it = round * gridDim.x + blockIdx.x;
    if (it >= 256 * NT) return false;
    mt = it / NT; nt = it - mt * NT;
    return true;
}

DI void run_phase(const P& p, int ph, char* smem) {
    switch (ph) {
    case 0: phase0(p, smem); break;
    case 1:
        for (int rd = 0;; ++rd) {
            int mt, nt; if (!gemm_order(rd, 25, mt, nt)) break;
            gemm_tile<8>(AFPlain{p.A, 1024}, p.WinT + (size_t)nt * 128 * 1024, 1024, mt * 128, nt * 128, EpiProj{p.proj}, smem);
        }
        break;
    case 2: phase2(p, smem); break;
    case 3: phase3(p, smem); break;
    case 4: phase4(p, smem); break;
    case 5: phase4b(p); break;
    case 6:
        for (int rd = 0;; ++rd) {
            int mt, nt; if (!gemm_order(rd, 8, mt, nt)) break;
            gemm_tile<8>(AFPlain{p.A, 1024}, p.WoutT + (size_t)nt * 128 * 1024, 1024, mt * 128, nt * 128, EpiOut{p.out, p.x}, smem);
        }
        break;
    case 7:
        for (int it = blockIdx.x; it < T_ / 4; it += gridDim.x) rms_item(p.out, p.norm_ffn, p.A, it);
        break;
    case 8:
        for (int rd = 0;; ++rd) {
            int mt, nt; if (!gemm_order(rd, 44, mt, nt)) break;
            gemm_tile<8>(AFPlain{p.A, 1024}, p.WguT + (size_t)nt * 128 * 1024, 1024, mt * 128, nt * 128, EpiFfn1{p.stream}, smem);
        }
        break;
    case 9:
        for (int rd = 0;; ++rd) {
            int mt, nt; if (!gemm_order(rd, 8, mt, nt)) break;
            gemm_tile<1>(AFPlain{p.stream, DFF}, p.WdnT + (size_t)nt * 128 * DFF, DFF, mt * 128, nt * 128, EpiFfn2{p.out}, smem);
        }
        break;
    default:
        for (int it = blockIdx.x; it < T_ / 4; it += gridDim.x) final_item(p.out, p.norm_final, it);
        break;
    }
}
constexpr int NPHASE = 11;
constexpr int SMEM_BYTES = 73728;


#define XB_TMO      128
#define XB_XCNT(j)  (256  + 64 * (j))
#define XB_XSUB(j)  (1280 + 64 * (j))
#define XB_XGEN(j)  (2304 + 64 * (j))
#define XB_TOP      3328
#define XB_TOPGEN   3392
#define XCD_BAR_WORDS 3456
#define XB_SPIN_CAP (1u << 22)
#define LAS __attribute__((address_space(3)))
DI unsigned xb_ld(unsigned* p) { return __hip_atomic_load(p, __ATOMIC_RELAXED, __HIP_MEMORY_SCOPE_AGENT); }
DI unsigned xb_add(unsigned* p, unsigned v) { return __hip_atomic_fetch_add(p, v, __ATOMIC_RELAXED, __HIP_MEMORY_SCOPE_AGENT); }
DI unsigned xb_xcc_id() { return (unsigned)__builtin_amdgcn_s_getreg((3 << 11) | 20) & 0xFu; }
#define XB_SPIN(cond, bar) do { unsigned _sp = 0; while (cond) { __builtin_amdgcn_s_sleep(1); \
    if ((++_sp & 255u) == 0u) { if (xb_ld(&(bar)[XB_TMO])) break; if (_sp > XB_SPIN_CAP) { atomicAdd(&(bar)[XB_TMO], 1u); break; } } } } while (0)
struct XcdBarrier { unsigned* bar; unsigned x; volatile LAS unsigned* st; unsigned G; };
DI XcdBarrier xcd_barrier_post(unsigned* bar, volatile LAS unsigned* st, const unsigned G) {
    XcdBarrier b; b.bar = bar; b.x = xb_xcc_id(); b.st = st; b.G = G;
    if (tidx() == 0) (void)xb_add(&bar[XB_XCNT(b.x)], 1u);
    return b;
}
DI void xcd_barrier_complete(unsigned* bar, unsigned x, unsigned& nloc, unsigned& nx, const unsigned G) {
    unsigned sum, cnt, mine, sp = 0u;
    for (;;) {
        sum = 0u; cnt = 0u; mine = 0u;
#pragma unroll
        for (unsigned j = 0; j < 16; ++j) { const unsigned c = xb_ld(&bar[XB_XCNT(j)]); sum += c; cnt += (c > 0u) ? 1u : 0u; mine = (j == x) ? c : mine; }
        if (sum == G) break;
        __builtin_amdgcn_s_sleep(1);
        if ((++sp & 255u) == 0u) { if (xb_ld(&bar[XB_TMO])) break; if (sp > XB_SPIN_CAP) { atomicAdd(&bar[XB_TMO], 1u); break; } }
    }
    nloc = mine > 0u ? mine : 1u; nx = cnt > 0u ? cnt : 1u;
}
DI void xcd_barrier(const XcdBarrier& b) {
    asm volatile("s_waitcnt vmcnt(0)" ::: "memory");
    __syncthreads();
    if (tidx() == 0) {
        unsigned* bar = b.bar;
        __builtin_amdgcn_s_waitcnt(0);
        unsigned nloc = b.st[0], nx = b.st[1];
        if (nloc == 0u) { xcd_barrier_complete(bar, b.x, nloc, nx, b.G); b.st[0] = nloc; b.st[1] = nx; }
        const unsigned old = xb_add(&bar[XB_XSUB(b.x)], 1u);
        const unsigned gen = old / nloc;
        if (old + 1u == (gen + 1u) * nloc) {
            __builtin_amdgcn_fence(__ATOMIC_RELEASE, "agent");
            asm volatile("s_waitcnt vmcnt(0)" ::: "memory");
            const unsigned og = xb_add(&bar[XB_TOP], 1u);
            const unsigned tg = og / nx;
            if (og + 1u == (tg + 1u) * nx) xb_add(&bar[XB_TOPGEN], 1u);
            else XB_SPIN(xb_ld(&bar[XB_TOPGEN]) == tg, bar);
            __builtin_amdgcn_fence(__ATOMIC_ACQUIRE, "agent");
            xb_add(&bar[XB_XGEN(b.x)], 1u);
            asm volatile("s_waitcnt vmcnt(0)" ::: "memory");
        } else {
            XB_SPIN(xb_ld(&bar[XB_XGEN(b.x)]) == gen, bar);
            __builtin_amdgcn_fence(__ATOMIC_ACQUIRE, "agent");
            asm volatile("s_waitcnt vmcnt(0)" ::: "memory");
        }
    }
    __syncthreads();
}

DI void phase4_fused(const P& p, char* smem, const XcdBarrier& xb2) {
    const int tid = tidx();
    if (blockIdx.x < 128) {
        scan_unit(p, blockIdx.x, smem);
        if (tid == 0) {
            unsigned sp = 0u;
            while (xb_ld(p.counter + 4) == 0u) { __builtin_amdgcn_s_sleep(8); if (++sp > (1u << 22)) break; }
            __builtin_amdgcn_fence(__ATOMIC_ACQUIRE, "agent");
            asm volatile("s_waitcnt vmcnt(0)" ::: "memory");
        }
        __syncthreads();
    } else {
        const int lb = blockIdx.x - 128;
        for (int it = lb; it < 2560; it += 384) {
            const int mt = it / 10, nt = 15 + (it - mt * 10);
            gemm_tile<8>(AFPlain{p.A, 1024}, p.WinT + (size_t)nt * 128 * 1024, 1024, mt * 128, nt * 128, EpiProj{p.proj}, smem);
        }
        xcd_barrier(xb2);
        for (int it = lb; it < 640; it += 384) { if (it < 128) cmp1_item(p, it, smem); else rope_item(p, it - 128, smem); }
        xcd_barrier(xb2);
        for (int it = lb; it < 64; it += 384) cmp2_item(p, it, smem);
        xcd_barrier(xb2);
        if (lb == 0 && tid == 0) __hip_atomic_store(p.counter + 4, 1u, __ATOMIC_RELEASE, __HIP_MEMORY_SCOPE_AGENT);
    }
    AttnSmem& sm = *(AttnSmem*)smem;
    while (true) {
        __syncthreads();
        if (tidx() == 0) sm.unit = (int)atomicAdd(p.counter, 1u);
        __syncthreads();
        const int u = sm.unit;
        if (u >= 2048) break;
        attn_unit(p, u, smem);
    }
}

__global__ void __launch_bounds__(NTHR, 2) mega_kernel(P p) {
    __shared__ __attribute__((aligned(16))) char smem[SMEM_BYTES];
    __shared__ uint4 xb_words;
    __shared__ uint4 xb_words2;
    cg::grid_group grid = cg::this_grid();
    if (p.x == nullptr) grid.sync();
    if (tidx() == 0) { xb_words = make_uint4(0u, 0u, 0u, 0u); xb_words2 = make_uint4(0u, 0u, 0u, 0u); }
    __syncthreads();
    const XcdBarrier xb = xcd_barrier_post(p.bar, (volatile LAS unsigned*)&xb_words, gridDim.x);
    run_phase(p, 0, smem); xcd_barrier(xb);
    if (gridDim.x == 512) {
        XcdBarrier xb2; xb2.bar = p.bar + XCD_BAR_WORDS; xb2.x = xb.x; xb2.st = (volatile LAS unsigned*)&xb_words2; xb2.G = 384u;
        if (blockIdx.x >= 128 && tidx() == 0) (void)xb_add(&xb2.bar[XB_XCNT(xb2.x)], 1u);
        for (int rd = 0;; ++rd) {
            int mt, nt; if (!gemm_order(rd, 15, mt, nt)) break;
            gemm_tile<8>(AFPlain{p.A, 1024}, p.WinT + (size_t)nt * 128 * 1024, 1024, mt * 128, nt * 128, EpiProj{p.proj}, smem);
        }
        xcd_barrier(xb);
        for (int it = blockIdx.x; it < 1024; it += gridDim.x) rwkv_prep(p, it, smem);
        xcd_barrier(xb);
        phase4_fused(p, smem, xb2);
        xcd_barrier(xb);
    } else {
        run_phase(p, 1, smem); xcd_barrier(xb);
        run_phase(p, 2, smem); xcd_barrier(xb);
        run_phase(p, 3, smem); xcd_barrier(xb);
        run_phase(p, 4, smem); xcd_barrier(xb);
    }
    run_phase(p, 5, smem); xcd_barrier(xb);
    run_phase(p, 6, smem); xcd_barrier(xb);
    run_phase(p, 7, smem); xcd_barrier(xb);
    run_phase(p, 8, smem); xcd_barrier(xb);
    run_phase(p, 9, smem); xcd_barrier(xb);
    run_phase(p, 10, smem);
}
__global__ void __launch_bounds__(NTHR, 2) phase_kernel(P p, int ph) {
    __shared__ __attribute__((aligned(16))) char smem[SMEM_BYTES];
    run_phase(p, ph, smem);
}

extern "C" void kernel_launch(void* const* d_in, const int* in_sizes, int n_in, void* d_out, int out_size, void* d_ws, size_t ws_size,
                              hipStream_t stream) {
    P p{};
    p.x = (const float*)d_in[0]; p.pos = (const int*)d_in[1]; p.norm_mix = (const float*)d_in[2]; p.w_in = (const float*)d_in[3];
    p.mu = (const float*)d_in[4]; p.w0 = (const float*)d_in[5]; p.w2 = (const float*)d_in[6]; p.a0 = (const float*)d_in[7];
    p.a2 = (const float*)d_in[8]; p.g2 = (const float*)d_in[9]; p.k_k = (const float*)d_in[10]; p.k_a = (const float*)d_in[11];
    p.r_k = (const float*)d_in[12]; p.lnx_w = (const float*)d_in[13]; p.lnx_b = (const float*)d_in[14]; p.pe_k = (const float*)d_in[15];
    p.wk1 = (const float*)d_in[16]; p.bk1 = (const float*)d_in[17]; p.wk2 = (const float*)d_in[18]; p.pe_v = (const float*)d_in[19];
    p.wv1 = (const float*)d_in[20]; p.bv1 = (const float*)d_in[21]; p.wv2 = (const float*)d_in[22]; p.w_out = (const float*)d_in[23];
    p.norm_ffn = (const float*)d_in[24]; p.w_gate = (const float*)d_in[25]; p.w_up = (const float*)d_in[26]; p.w_down = (const float*)d_in[27];
    p.norm_final = (const float*)d_in[28];
    p.out = (float*)d_out;
    char* ws = (char*)d_ws;
    size_t off = 0;
    auto take = [&](size_t bytes) { char* r = ws + off; off += (bytes + 255) & ~(size_t)255; return r; };
    p.WinT = (bf16_t*)take((size_t)3200 * 1024 * 2);
    p.WoutT = (bf16_t*)take((size_t)1024 * 1024 * 2);
    p.WguT = (bf16_t*)take((size_t)5632 * 1024 * 2);
    p.WdnT = (bf16_t*)take((size_t)1024 * DFF * 2);
    p.w2T = (bf16_t*)take(512 * 64 * 2);
    p.a2T = (bf16_t*)take(512 * 64 * 2);
    p.g2T = (bf16_t*)take(512 * 160 * 2);
    p.w1T = (bf16_t*)take((size_t)2 * 256 * 2048 * 2);
    p.wc2T = (bf16_t*)take(2 * 128 * 256 * 2);
    p.b1p = (float*)take(512 * 4);
    p.cosT = (float*)take((size_t)T_ * 8 * 4);
    p.sinT = (float*)take((size_t)T_ * 8 * 4);
    p.counter = (unsigned*)take(256);
    p.bar = (unsigned*)take(2 * XCD_BAR_WORDS * 4);
    off = (size_t)32 << 20;
    p.A = (bf16_t*)take((size_t)T_ * 1024 * 2);
    p.proj = (bf16_t*)take((size_t)T_ * PLD * 2);
    p.stream = (bf16_t*)take((size_t)T_ * 8 * 384 * 2);
    p.ksw = (bf16_t*)take((size_t)4 * 256 * 4096 * 2);
    p.vsw = (bf16_t*)take((size_t)4 * 256 * 4096 * 2);
    if (off > ws_size) fprintf(stderr, "workspace too small: need %zu have %zu\n", off, ws_size);
    char* ob = (char*)d_out;
    p.gbuf = (bf16_t*)ob;
    p.yraw = (float*)(ob + ((size_t)32 << 20));
    p.vT = (bf16_t*)(ob + ((size_t)96 << 20));
    p.hid = (bf16_t*)(ob + ((size_t)112 << 20));
    p.kc = (bf16_t*)(ob + ((size_t)116 << 20));
    p.vcT = (bf16_t*)(ob + ((size_t)116 << 20) + (512 << 10));
#if MK_SINGLE
    static int grid_blocks = 0;
    if (!grid_blocks) {
        int dev = 0, cus = 0, per_cu = 0;
        hipGetDevice(&dev);
        hipDeviceGetAttribute(&cus, hipDeviceAttributeMultiprocessorCount, dev);
        hipOccupancyMaxActiveBlocksPerMultiprocessor(&per_cu, mega_kernel, NTHR, 0);
        if (per_cu > 2) per_cu = 2;
        if (per_cu < 1) per_cu = 1;
        grid_blocks = cus * per_cu;
    }
    (void)hipMemsetAsync(p.bar, 0, 2 * XCD_BAR_WORDS * 4, stream);
    void* args[] = {&p};
    hipError_t e = hipLaunchCooperativeKernel((void*)mega_kernel, dim3(grid_blocks), dim3(NTHR), args, 0, stream);
    if (e != hipSuccess) fprintf(stderr, "cooperative launch failed: %s (grid %d)\n", hipGetErrorString(e), grid_blocks);
#else
    for (int ph = 0; ph < NPHASE; ++ph) phase_kernel<<<512, NTHR, 0, stream>>>(p, ph);
#endif
}
```

```cpp
#include <hip/hip_runtime.h>
#include <hip/hip_cooperative_groups.h>
#include <cstdio>
namespace cg = cooperative_groups;

#ifndef MK_SINGLE
#define MK_SINGLE 1
#endif

#define DI __device__ __forceinline__
typedef unsigned short bf16_t;
typedef short bf16x8 __attribute__((ext_vector_type(8)));
typedef float f32x16 __attribute__((ext_vector_type(16)));
typedef __bf16 bf2_t __attribute__((ext_vector_type(2)));
typedef float f2_t __attribute__((ext_vector_type(2)));

constexpr int T_ = 32768, S_ = 16384;
constexpr int PLD = 3200;
constexpr int QC = 1856, KVC = 2368, GC = 3136;
constexpr int DFF = 2816;
constexpr int NTHR = 256;
constexpr float QSC = 0.125f * 1.4426950408889634f;

#define MFMA32(a, b, c) __builtin_amdgcn_mfma_f32_32x32x16_bf16((a), (b), (c), 0, 0, 0)

DI int tidx() { int r; asm volatile("v_mov_b32 %0, %1" : "=v"(r) : "v"(threadIdx.x)); return r; }
DI unsigned pack2(float a, float b) { f2_t v = {a, b}; return __builtin_bit_cast(unsigned, __builtin_convertvector(v, bf2_t)); }
DI float bflo(unsigned u) { return __uint_as_float(u << 16); }
DI float bfhi(unsigned u) { return __uint_as_float(u & 0xffff0000u); }
DI bf16_t f2bf(float a) { return (bf16_t)(pack2(a, 0.f) & 0xffffu); }
DI void unpack8(const uint4& u, float (&f)[8]) {
    f[0] = bflo(u.x); f[1] = bfhi(u.x); f[2] = bflo(u.y); f[3] = bfhi(u.y);
    f[4] = bflo(u.z); f[5] = bfhi(u.z); f[6] = bflo(u.w); f[7] = bfhi(u.w);
}
DI uint4 pack8(const float (&f)[8]) { uint4 u; u.x = pack2(f[0], f[1]); u.y = pack2(f[2], f[3]); u.z = pack2(f[4], f[5]); u.w = pack2(f[6], f[7]); return u; }
DI float wave_sum(float v) {
#pragma unroll
    for (int o = 32; o; o >>= 1) v += __shfl_xor(v, o);
    return v;
}
DI float sigmoidf_(float x) { return 1.f / (1.f + __expf(-x)); }
DI int crow(int reg, int h) { return (reg & 3) + 8 * (reg >> 2) + 4 * h; }

struct P {
    const float* x; const int* pos; const float *norm_mix, *w_in, *mu, *w0, *w2, *a0, *a2, *g2, *k_k, *k_a, *r_k, *lnx_w, *lnx_b,
        *pe_k, *wk1, *bk1, *wk2, *pe_v, *wv1, *bv1, *wv2, *w_out, *norm_ffn, *w_gate, *w_up, *w_down, *norm_final;
    float* out;
    bf16_t *WinT, *WoutT, *WguT, *WdnT, *w2T, *a2T, *g2T, *w1T, *wc2T;
    float *b1p, *cosT, *sinT;
    unsigned* counter; unsigned* bar;
    bf16_t *A, *proj, *stream;
    bf16_t* gbuf; float* yraw; bf16_t *vT, *hid, *kc, *vcT, *ksw, *vsw;
};

DI float tr_val(const P& p, int job, int k, int n) {
    switch (job) {
    case 0: { int c = n < 1824 ? n : ((n >= 1856 && n < 3160) ? n - 32 : -1); return c >= 0 ? p.w_in[(size_t)k * 3128 + c] : 0.f; }
    case 1: return p.w_out[k * 1024 + n];
    case 2: { int q = n >> 6, r = n & 63; return r < 32 ? p.w_gate[(size_t)k * DFF + q * 32 + r] : p.w_up[(size_t)k * DFF + q * 32 + r - 32]; }
    case 3: return p.w_down[(size_t)k * 1024 + n];
    case 4: return p.w2[k * 512 + n];
    case 5: return p.a2[k * 512 + n];
    case 6: return p.g2[k * 512 + n];
    case 7: return p.wk1[k * 256 + n];
    case 8: return p.wv1[k * 256 + n];
    case 9: return n < 64 ? p.wk2[k * 64 + n] : 0.f;
    default: return n < 64 ? p.wv2[k * 64 + n] : 0.f;
    }
}
DI void tr_item(const P& p, int it, float* tile) {
    int job, K, N; bf16_t* dst;
    if (it < 800) { job = 0; K = 1024; N = 3200; dst = p.WinT; }
    else if (it < 1056) { job = 1; it -= 800; K = 1024; N = 1024; dst = p.WoutT; }
    else if (it < 2464) { job = 2; it -= 1056; K = 1024; N = 5632; dst = p.WguT; }
    else if (it < 3168) { job = 3; it -= 2464; K = 2816; N = 1024; dst = p.WdnT; }
    else if (it < 3176) { job = 4; it -= 3168; K = 64; N = 512; dst = p.w2T; }
    else if (it < 3184) { job = 5; it -= 3176; K = 64; N = 512; dst = p.a2T; }
    else if (it < 3208) { job = 6; it -= 3184; K = 160; N = 512; dst = p.g2T; }
    else if (it < 3336) { job = 7; it -= 3208; K = 2048; N = 256; dst = p.w1T; }
    else if (it < 3464) { job = 8; it -= 3336; K = 2048; N = 256; dst = p.w1T + 256 * 2048; }
    else if (it < 3472) { job = 9; it -= 3464; K = 256; N = 128; dst = p.wc2T; }
    else { job = 10; it -= 3472; K = 256; N = 128; dst = p.wc2T + 128 * 256; }
    const int nt = N >> 6;
    const int k0 = (it / nt) * 64, n0 = (it % nt) * 64;
    const int tid = tidx();
    __syncthreads();
#pragma unroll 4
    for (int i = 0; i < 16; ++i) {
        const int kk = i * 4 + (tid >> 6), nn = tid & 63;
        tile[kk * 65 + nn] = (k0 + kk < K) ? tr_val(p, job, k0 + kk, n0 + nn) : 0.f;
    }
    __syncthreads();
#pragma unroll 4
    for (int i = 0; i < 16; ++i) {
        const int nn = i * 4 + (tid >> 6), kk = tid & 63;
        if (k0 + kk < K) dst[(size_t)(n0 + nn) * K + k0 + kk] = f2bf(tile[kk * 65 + nn]);
    }
}
DI void b1_item(const P& p, int idx) {
    const int kv = idx >> 4, jc = idx & 15, tid = tidx();
    const float* pe = kv ? p.pe_v : p.pe_k; const float* w1 = kv ? p.wv1 : p.wk1; const float* b1 = kv ? p.bv1 : p.bk1;
    const int j = jc * 16 + (tid >> 4), kl = tid & 15;
    float s = 0.f;
    for (int i = 0; i < 128; ++i) { const int k = kl + 16 * i; s += pe[k] * w1[k * 256 + j]; }
    s += __shfl_xor(s, 1); s += __shfl_xor(s, 2); s += __shfl_xor(s, 4); s += __shfl_xor(s, 8);
    if (kl == 0) p.b1p[kv * 256 + j] = b1[j] + s;
}
DI void sincos_d(float ang, float& c, float& s) {
    double x = (double)ang;
    const double TWO_PI = 6.283185307179586476925286766559;
    double n = __builtin_rint(x * (1.0 / TWO_PI));
    double r = x - n * TWO_PI;
    double q = r * 0.25;
    double q2 = q * q;
    double sn = q * (1.0 + q2 * (-1.0 / 6 + q2 * (1.0 / 120 + q2 * (-1.0 / 5040 + q2 * (1.0 / 362880 + q2 * (-1.0 / 39916800 + q2 * (1.0 / 6227020800.0)))))));
    double cs = 1.0 + q2 * (-0.5 + q2 * (1.0 / 24 + q2 * (-1.0 / 720 + q2 * (1.0 / 40320 + q2 * (-1.0 / 3628800 + q2 * (1.0 / 479001600.0))))));
    double s2 = 2 * sn * cs, c2 = 1 - 2 * sn * sn;
    double s4 = 2 * s2 * c2, c4 = 1 - 2 * s2 * s2;
    c = (float)c4; s = (float)s4;
}
DI void cs_item(const P& p, int idx) {
    const int e = idx * 256 + tidx(), tok = e >> 3, f = e & 7;
    const float invf[8] = {1.000000000e+00f, 1.939227432e-01f, 3.760603070e-02f, 7.292664610e-03f, 1.414213562e-03f, 2.742481884e-04f, 5.318295734e-05f, 1.031338525e-05f};
    float iv = invf[0];
#pragma unroll
    for (int i = 1; i < 8; ++i) iv = (f == i) ? invf[i] : iv;
    const float ang = (float)p.pos[tok] * iv;
    float c, s; sincos_d(ang, c, s);
    p.cosT[e] = c; p.sinT[e] = s;
}
DI void rms_item(const float* src, const float* g, bf16_t* dst, int idx) {
    const int row = idx * 4 + (tidx() >> 6), lane = tidx() & 63;
    const float4* sp = (const float4*)(src + (size_t)row * 1024);
    float4 v[4]; float ss = 0.f;
#pragma unroll
    for (int i = 0; i < 4; ++i) { v[i] = sp[lane + 64 * i]; ss += v[i].x * v[i].x + v[i].y * v[i].y + v[i].z * v[i].z + v[i].w * v[i].w; }
    ss = wave_sum(ss);
    const float rs = rsqrtf(ss * (1.f / 1024.f) + 1e-6f);
#pragma unroll
    for (int i = 0; i < 4; ++i) {
        const float4 gv = ((const float4*)g)[lane + 64 * i];
        uint2 o; o.x = pack2(v[i].x * rs * gv.x, v[i].y * rs * gv.y); o.y = pack2(v[i].z * rs * gv.z, v[i].w * rs * gv.w);
        *(uint2*)(dst + (size_t)row * 1024 + (lane + 64 * i) * 4) = o;
    }
}
DI void phase0(const P& p, char* smem) {
    if (blockIdx.x == 0 && tidx() < 8) p.counter[tidx()] = 0u;
    constexpr int NTR = 3480, NB1 = 32, NCS = 1024, NXN = 8192;
    for (int it = blockIdx.x; it < NTR + NB1 + NCS + NXN; it += gridDim.x) {
        if (it < NTR) tr_item(p, it, (float*)smem);
        else if (it < NTR + NB1) b1_item(p, it - NTR);
        else if (it < NTR + NB1 + NCS) cs_item(p, it - NTR - NB1);
        else rms_item(p.x, p.norm_mix, p.A, it - NTR - NB1 - NCS);
    }
}

struct AFPlain { const bf16_t* A; int lda; DI uint4 load(int row, int k) const { return *(const uint4*)(A + (size_t)row * lda + k); } };
struct AFCmp {
    const bf16_t* base;
    DI uint4 load(int r, int k) const { int tok = 16 * r + (k >> 6); tok = tok < S_ ? tok : S_ - 1; return *(const uint4*)(base + (size_t)tok * PLD + (k & 63)); }
};

template <int KU, class AF, class EPI>
DI void gemm_tile(const AF af, const bf16_t* __restrict__ Bt, const int K, const int m0, const int n0, const EPI epi, char* smem) {
    const int tid = tidx(), wave = tid >> 6, lane = tid & 63, wm = wave >> 1, wn = wave & 1, rr = lane & 31, hh = lane >> 5;
    f32x16 acc[2][2];
#pragma unroll
    for (int a = 0; a < 2; ++a)
#pragma unroll
        for (int b = 0; b < 2; ++b)
#pragma unroll
            for (int i = 0; i < 16; ++i) acc[a][b][i] = 0.f;
    const int lrow = tid >> 3, lk = (tid & 7) * 8;
#define GLOAD(R, KO) \
    R##a0 = af.load(m0 + lrow, (KO) + lk); R##a1 = af.load(m0 + lrow + 32, (KO) + lk); R##a2 = af.load(m0 + lrow + 64, (KO) + lk); R##a3 = af.load(m0 + lrow + 96, (KO) + lk); \
    R##b0 = *(const uint4*)(Bt + (size_t)(lrow) * K + (KO) + lk); R##b1 = *(const uint4*)(Bt + (size_t)(lrow + 32) * K + (KO) + lk); \
    R##b2 = *(const uint4*)(Bt + (size_t)(lrow + 64) * K + (KO) + lk); R##b3 = *(const uint4*)(Bt + (size_t)(lrow + 96) * K + (KO) + lk);
#define GSTORE(R, SA, SB) \
    *(uint4*)&(SA)[(lrow) * 72 + lk] = R##a0; *(uint4*)&(SA)[(lrow + 32) * 72 + lk] = R##a1; *(uint4*)&(SA)[(lrow + 64) * 72 + lk] = R##a2; *(uint4*)&(SA)[(lrow + 96) * 72 + lk] = R##a3; \
    *(uint4*)&(SB)[(lrow) * 72 + lk] = R##b0; *(uint4*)&(SB)[(lrow + 32) * 72 + lk] = R##b1; *(uint4*)&(SB)[(lrow + 64) * 72 + lk] = R##b2; *(uint4*)&(SB)[(lrow + 96) * 72 + lk] = R##b3;
#define GCOMPUTE(SA, SB) \
    _Pragma("unroll") for (int ks = 0; ks < 4; ++ks) { \
        bf16x8 tf0 = *(const bf16x8*)&(SA)[(wm * 64 + rr) * 72 + ks * 16 + hh * 8], tf1 = *(const bf16x8*)&(SA)[(wm * 64 + 32 + rr) * 72 + ks * 16 + hh * 8]; \
        bf16x8 wf0 = *(const bf16x8*)&(SB)[(wn * 64 + rr) * 72 + ks * 16 + hh * 8], wf1 = *(const bf16x8*)&(SB)[(wn * 64 + 32 + rr) * 72 + ks * 16 + hh * 8]; \
        acc[0][0] = MFMA32(wf0, tf0, acc[0][0]); acc[0][1] = MFMA32(wf0, tf1, acc[0][1]); acc[1][0] = MFMA32(wf1, tf0, acc[1][0]); acc[1][1] = MFMA32(wf1, tf1, acc[1][1]); }
    uint4 Xa0, Xa1, Xa2, Xa3, Xb0, Xb1, Xb2, Xb3, Ya0, Ya1, Ya2, Ya3, Yb0, Yb1, Yb2, Yb3;
    bf16_t* const sA0 = (bf16_t*)smem; bf16_t* const sB0 = sA0 + 128 * 72; bf16_t* const sA1 = sB0 + 128 * 72; bf16_t* const sB1 = sA1 + 128 * 72;
    GLOAD(X, 0)
    GLOAD(Y, 64)
    __syncthreads();
    GSTORE(X, sA0, sB0)
    __syncthreads();
#pragma unroll KU
    for (int k0 = 0; k0 < K; k0 += 128) {
        const bool more = (k0 + 128 < K);
        if (more) { GLOAD(X, k0 + 128) }
        GCOMPUTE(sA0, sB0)
        GSTORE(Y, sA1, sB1)
        __syncthreads();
        __builtin_amdgcn_sched_barrier(0);
        if (more) { GLOAD(Y, k0 + 192) }
        GCOMPUTE(sA1, sB1)
        if (more) { GSTORE(X, sA0, sB0) }
        __syncthreads();
        __builtin_amdgcn_sched_barrier(0);
    }
#undef GLOAD
#undef GSTORE
#undef GCOMPUTE
    epi(acc, m0 + wm * 64, n0 + wn * 64, lane);
}

struct EpiProj {
    bf16_t* C;
    DI void operator()(const f32x16 (&acc)[2][2], int rowbase, int colbase, int lane) const {
        const int rr = lane & 31, hh = lane >> 5;
#pragma unroll
        for (int w = 0; w < 2; ++w)
#pragma unroll
            for (int t = 0; t < 2; ++t)
#pragma unroll
                for (int j = 0; j < 4; ++j) {
                    uint2 o; o.x = pack2(acc[w][t][4 * j], acc[w][t][4 * j + 1]); o.y = pack2(acc[w][t][4 * j + 2], acc[w][t][4 * j + 3]);
                    *(uint2*)(C + (size_t)(rowbase + t * 32 + rr) * PLD + colbase + w * 32 + j * 8 + hh * 4) = o;
                }
    }
};
struct EpiHid {
    bf16_t* H; const float* bias;
    DI void operator()(const f32x16 (&acc)[2][2], int rowbase, int colbase, int lane) const {
        const int rr = lane & 31, hh = lane >> 5;
#pragma unroll
        for (int w = 0; w < 2; ++w)
#pragma unroll
            for (int t = 0; t < 2; ++t)
#pragma unroll
                for (int j = 0; j < 4; ++j) {
                    const int col = colbase + w * 32 + j * 8 + hh * 4;
                    const float4 bv = *(const float4*)(bias + col);
                    float v0 = acc[w][t][4 * j] + bv.x, v1 = acc[w][t][4 * j + 1] + bv.y, v2 = acc[w][t][4 * j + 2] + bv.z, v3 = acc[w][t][4 * j + 3] + bv.w;
                    v0 *= sigmoidf_(v0); v1 *= sigmoidf_(v1); v2 *= sigmoidf_(v2); v3 *= sigmoidf_(v3);
                    uint2 o; o.x = pack2(v0, v1); o.y = pack2(v2, v3);
                    *(uint2*)(H + (size_t)(rowbase + t * 32 + rr) * 256 + col) = o;
                }
    }
};
struct EpiKc {
    bf16_t* kc; const float *cosT, *sinT; int tokbase;
    DI void operator()(const f32x16 (&acc)[2][2], int rowbase, int colbase, int lane) const {
        if (colbase != 0) return;
        const int rr = lane & 31, hh = lane >> 5;
#pragma unroll
        for (int t = 0; t < 2; ++t) {
            const int r = rowbase + t * 32 + rr;
            int tk = 31 + 16 * r; tk = tk < S_ ? tk : S_ - 1;
            const float4 c = *(const float4*)(cosT + (size_t)(tokbase + tk) * 8 + hh * 4), s = *(const float4*)(sinT + (size_t)(tokbase + tk) * 8 + hh * 4);
            bf16_t* kp = kc + (size_t)r * 64 + hh * 4;
            const float a0 = acc[0][t][0], a1 = acc[0][t][1], a2 = acc[0][t][2], a3 = acc[0][t][3];
            const float b0 = acc[0][t][4], b1 = acc[0][t][5], b2 = acc[0][t][6], b3 = acc[0][t][7];
            uint2 o;
            o.x = pack2(a0 * c.x - b0 * s.x, a1 * c.y - b1 * s.y); o.y = pack2(a2 * c.z - b2 * s.z, a3 * c.w - b3 * s.w);
            *(uint2*)(kp) = o;
            o.x = pack2(b0 * c.x + a0 * s.x, b1 * c.y + a1 * s.y); o.y = pack2(b2 * c.z + a2 * s.z, b3 * c.w + a3 * s.w);
            *(uint2*)(kp + 8) = o;
#pragma unroll
            for (int j = 2; j < 4; ++j) {
                o.x = pack2(acc[0][t][4 * j], acc[0][t][4 * j + 1]); o.y = pack2(acc[0][t][4 * j + 2], acc[0][t][4 * j + 3]);
                *(uint2*)(kp + j * 8) = o;
            }
#pragma unroll
            for (int j = 0; j < 4; ++j) {
                o.x = pack2(acc[1][t][4 * j], acc[1][t][4 * j + 1]); o.y = pack2(acc[1][t][4 * j + 2], acc[1][t][4 * j + 3]);
                *(uint2*)(kp + 32 + j * 8) = o;
            }
        }
    }
};
struct EpiVc {
    bf16_t* vcT; char* smem;
    DI void operator()(const f32x16 (&acc)[2][2], int rowbase, int colbase, int lane) const {
        const int rr = lane & 31, hh = lane >> 5;
        bf16_t* tl = (bf16_t*)smem;
        __syncthreads();
        if (colbase == 0) {
            const int rl = rowbase & 127;
#pragma unroll
            for (int w = 0; w < 2; ++w)
#pragma unroll
                for (int t = 0; t < 2; ++t)
#pragma unroll
                    for (int i = 0; i < 16; ++i) tl[(w * 32 + crow(i, hh)) * 136 + rl + t * 32 + rr] = f2bf(acc[w][t][i]);
        }
        __syncthreads();
        const int m0 = rowbase & ~127;
#pragma unroll
        for (int i = 0; i < 4; ++i) {
            const int c = tidx() + i * 256, d = c >> 4, ch = c & 15;
            *(uint4*)(vcT + (size_t)d * 1024 + m0 + ch * 8) = *(const uint4*)&tl[d * 136 + ch * 8];
        }
    }
};
struct EpiOut {
    float* out; const float* x;
    DI void operator()(const f32x16 (&acc)[2][2], int rowbase, int colbase, int lane) const {
        const int rr = lane & 31, hh = lane >> 5;
#pragma unroll
        for (int w = 0; w < 2; ++w)
#pragma unroll
            for (int t = 0; t < 2; ++t)
#pragma unroll
                for (int j = 0; j < 4; ++j) {
                    const size_t o = (size_t)(rowbase + t * 32 + rr) * 1024 + colbase + w * 32 + j * 8 + hh * 4;
                    float4 xv = *(const float4*)(x + o);
                    xv.x += acc[w][t][4 * j]; xv.y += acc[w][t][4 * j + 1]; xv.z += acc[w][t][4 * j + 2]; xv.w += acc[w][t][4 * j + 3];
                    *(float4*)(out + o) = xv;
                }
    }
};
struct EpiFfn1 {
    bf16_t* act;
    DI void operator()(const f32x16 (&acc)[2][2], int rowbase, int colbase, int lane) const {
        const int rr = lane & 31, hh = lane >> 5;
        const int cb = (colbase >> 6) * 32;
#pragma unroll
        for (int t = 0; t < 2; ++t)
#pragma unroll
            for (int j = 0; j < 4; ++j) {
                float v[4];
#pragma unroll
                for (int i = 0; i < 4; ++i) { const float g = acc[0][t][4 * j + i], u = acc[1][t][4 * j + i]; v[i] = g * sigmoidf_(g) * u; }
                uint2 o; o.x = pack2(v[0], v[1]); o.y = pack2(v[2], v[3]);
                *(uint2*)(act + (size_t)(rowbase + t * 32 + rr) * DFF + cb + j * 8 + hh * 4) = o;
            }
    }
};

DI void rwkv_prep(const P& p, int idx, char* smem) {
    const int tile = idx, tt0 = tile * 32;
    const int tid = tidx(), wave = tid >> 6, lane = tid & 63, rr = lane & 31, hh = lane >> 5;
    bf16_t* lat = (bf16_t*)smem;
    float* res = (float*)(smem + 32 * 296 * 2);
    __syncthreads();
    for (int c = tid; c < 32 * 36; c += NTHR) {
        const int tok = c / 36, ch = c - tok * 36, gi = tt0 + tok, col = 1536 + ch * 8;
        const uint4 cu = *(const uint4*)(p.proj + (size_t)gi * PLD + col);
        uint4 pv = make_uint4(0, 0, 0, 0);
        if ((gi & (S_ - 1)) != 0) pv = *(const uint4*)(p.proj + (size_t)(gi - 1) * PLD + col);
        float a[8], b[8]; unpack8(cu, a); unpack8(pv, b);
        const float4 m0 = *(const float4*)(p.mu + col), m1 = *(const float4*)(p.mu + col + 4);
        const float mu[8] = {m0.x, m0.y, m0.z, m0.w, m1.x, m1.y, m1.z, m1.w};
#pragma unroll
        for (int e = 0; e < 8; ++e) {
            float x = a[e] + (b[e] - a[e]) * mu[e];
            if (ch < 8) x = 1.f - 2.f / (1.f + __expf(2.f * x)); else if (ch >= 16) x = sigmoidf_(x);
            a[e] = x;
        }
        *(uint4*)&lat[tok * 296 + ch * 8] = pack8(a);
    }
    __syncthreads();
#pragma unroll 1
    for (int h = 0; h < 8; ++h) {
    if (wave < 2) {
        const int mt = wave;
        f32x16 aw, aa;
#pragma unroll
        for (int i = 0; i < 16; ++i) { aw[i] = 0.f; aa[i] = 0.f; }
#pragma unroll
        for (int ks = 0; ks < 4; ++ks) {
            const bf16x8 wf = *(const bf16x8*)(p.w2T + (size_t)(h * 64 + mt * 32 + rr) * 64 + ks * 16 + hh * 8);
            const bf16x8 af = *(const bf16x8*)(p.a2T + (size_t)(h * 64 + mt * 32 + rr) * 64 + ks * 16 + hh * 8);
            const bf16x8 l0 = *(const bf16x8*)&lat[rr * 296 + ks * 16 + hh * 8];
            const bf16x8 l1 = *(const bf16x8*)&lat[rr * 296 + 64 + ks * 16 + hh * 8];
            aw = MFMA32(wf, l0, aw); aa = MFMA32(af, l1, aa);
        }
#pragma unroll
        for (int j = 0; j < 4; ++j) {
            *(float4*)&res[(0 * 32 + rr) * 64 + mt * 32 + j * 8 + hh * 4] = make_float4(aw[4 * j], aw[4 * j + 1], aw[4 * j + 2], aw[4 * j + 3]);
            *(float4*)&res[(1 * 32 + rr) * 64 + mt * 32 + j * 8 + hh * 4] = make_float4(aa[4 * j], aa[4 * j + 1], aa[4 * j + 2], aa[4 * j + 3]);
        }
    } else {
        const int mt = wave - 2;
        f32x16 ag;
#pragma unroll
        for (int i = 0; i < 16; ++i) ag[i] = 0.f;
#pragma unroll
        for (int ks = 0; ks < 10; ++ks) {
            const bf16x8 gf = *(const bf16x8*)(p.g2T + (size_t)(h * 64 + mt * 32 + rr) * 160 + ks * 16 + hh * 8);
            const bf16x8 l2 = *(const bf16x8*)&lat[rr * 296 + 128 + ks * 16 + hh * 8];
            ag = MFMA32(gf, l2, ag);
        }
#pragma unroll
        for (int j = 0; j < 4; ++j)
            *(float4*)&res[(2 * 32 + rr) * 64 + mt * 32 + j * 8 + hh * 4] = make_float4(ag[4 * j], ag[4 * j + 1], ag[4 * j + 2], ag[4 * j + 3]);
    }
    __syncthreads();
    {
        const int tok = tid >> 3, cgp = tid & 7, gi = tt0 + tok, b = gi >> 14, s = gi & (S_ - 1), cb = h * 64 + cgp * 8;
        const bool first = (s == 0);
        float r[8], k[8], v[8];
        {
            float a[8], pb[8];
            const bf16_t* pr = p.proj + (size_t)gi * PLD;
#pragma unroll
            for (int q = 0; q < 3; ++q) {
                const int col = q * 512 + cb;
                unpack8(*(const uint4*)(pr + col), a);
                if (first) {
#pragma unroll
                    for (int e = 0; e < 8; ++e) pb[e] = 0.f;
                } else unpack8(*(const uint4*)(pr - PLD + col), pb);
                const float4 m0 = *(const float4*)(p.mu + col), m1 = *(const float4*)(p.mu + col + 4);
                const float mu[8] = {m0.x, m0.y, m0.z, m0.w, m1.x, m1.y, m1.z, m1.w};
#pragma unroll
                for (int e = 0; e < 8; ++e) {
                    const float x = a[e] + (pb[e] - a[e]) * mu[e];
                    if (q == 0) r[e] = x; else if (q == 1) k[e] = x; else v[e] = x;
                }
            }
        }
        float om[8], av[8], gg[8], kk[8], km[8], bb[8];
        float ss = 0.f;
#pragma unroll
        for (int e = 0; e < 8; ++e) {
            const float wp = res[(0 * 32 + tok) * 64 + cgp * 8 + e] + p.w0[cb + e];
            const float z = -wp;
            const float sp = fmaxf(z, 0.f) + __logf(1.f + __expf(-fabsf(z)));
            const float w = -sp - 0.5f;
            om[e] = 1.f - __expf(-__expf(w));
            av[e] = sigmoidf_(res[(1 * 32 + tok) * 64 + cgp * 8 + e] + p.a0[cb + e]);
            gg[e] = res[(2 * 32 + tok) * 64 + cgp * 8 + e];
            kk[e] = k[e] * p.k_k[cb + e];
            ss += kk[e] * kk[e];
            km[e] = k[e] * (1.f + (av[e] - 1.f) * p.k_a[cb + e]);
        }
        ss += __shfl_xor(ss, 1); ss += __shfl_xor(ss, 2); ss += __shfl_xor(ss, 4);
        const float inv = 1.f / fmaxf(sqrtf(ss), 1e-12f);
#pragma unroll
        for (int e = 0; e < 8; ++e) { kk[e] *= inv; bb[e] = kk[e] * av[e]; }
        bf16_t* sp = p.stream + ((size_t)((b * 8 + h) * S_ + s) * 6) * 64 + cgp * 8;
        *(uint4*)(sp) = pack8(om); *(uint4*)(sp + 64) = pack8(km); *(uint4*)(sp + 128) = pack8(kk);
        *(uint4*)(sp + 192) = pack8(bb); *(uint4*)(sp + 256) = pack8(r); *(uint4*)(sp + 320) = pack8(v);
        *(uint4*)(p.gbuf + (size_t)gi * 512 + cb) = pack8(gg);
    }
    __syncthreads();
    }
}

DI void rope_item(const P& p, int idx, char* smem) {
    const int tt0 = idx * 64, tid = tidx();
    bf16_t* vtile = (bf16_t*)smem;
    bf16_t* ktile = vtile + 4 * 64 * 72;
    __syncthreads();
#pragma unroll 1
    for (int it = 0; it < 2; ++it) {
        const int item = tid + it * 256, tok = item >> 3, head = item & 7, gi = tt0 + tok;
        bf16_t* ptr = p.proj + (size_t)gi * PLD + QC + head * 64;
        const float4 c0 = *(const float4*)(p.cosT + (size_t)gi * 8), c1 = *(const float4*)(p.cosT + (size_t)gi * 8 + 4);
        const float4 s0 = *(const float4*)(p.sinT + (size_t)gi * 8), s1 = *(const float4*)(p.sinT + (size_t)gi * 8 + 4);
        const float cc[8] = {c0.x, c0.y, c0.z, c0.w, c1.x, c1.y, c1.z, c1.w}, sn[8] = {s0.x, s0.y, s0.z, s0.w, s1.x, s1.y, s1.z, s1.w};
        float a[8], b[8];
        unpack8(*(const uint4*)ptr, a); unpack8(*(const uint4*)(ptr + 8), b);
#pragma unroll
        for (int e = 0; e < 8; ++e) { const float x1 = a[e], x2 = b[e]; a[e] = (x1 * cc[e] - x2 * sn[e]) * QSC; b[e] = (x2 * cc[e] + x1 * sn[e]) * QSC; }
        *(uint4*)ptr = pack8(a); *(uint4*)(ptr + 8) = pack8(b);
#pragma unroll
        for (int q = 2; q < 8; ++q) {
            unpack8(*(const uint4*)(ptr + q * 8), a);
#pragma unroll
            for (int e = 0; e < 8; ++e) a[e] *= QSC;
            *(uint4*)(ptr + q * 8) = pack8(a);
        }
    }
    {
        const int tok = tid >> 2, sel = (tid >> 1) & 1, hk = tid & 1, gi = tt0 + tok;
        const float4 c0 = *(const float4*)(p.cosT + (size_t)gi * 8), c1 = *(const float4*)(p.cosT + (size_t)gi * 8 + 4);
        const float4 s0 = *(const float4*)(p.sinT + (size_t)gi * 8), s1 = *(const float4*)(p.sinT + (size_t)gi * 8 + 4);
        const float cc[8] = {c0.x, c0.y, c0.z, c0.w, c1.x, c1.y, c1.z, c1.w}, sn[8] = {s0.x, s0.y, s0.z, s0.w, s1.x, s1.y, s1.z, s1.w};
        float a[8], b[8];
        {
            bf16_t* ptr = p.proj + (size_t)gi * PLD + KVC + (sel ? 4 : 2) * 128 + hk * 64;
            unpack8(*(const uint4*)ptr, a); unpack8(*(const uint4*)(ptr + 8), b);
#pragma unroll
            for (int e = 0; e < 8; ++e) { const float x1 = a[e], x2 = b[e]; a[e] = x1 * cc[e] - x2 * sn[e]; b[e] = x2 * cc[e] + x1 * sn[e]; }
            const uint4 ra_ = pack8(a), rb_ = pack8(b);
            *(uint4*)ptr = ra_; *(uint4*)(ptr + 8) = rb_;
            if (sel == 0) {
                bf16_t* kt = ktile + (size_t)(hk * 64 + tok) * 72;
                *(uint4*)kt = ra_; *(uint4*)(kt + 8) = rb_;
#pragma unroll
                for (int q = 2; q < 8; ++q) *(uint4*)(kt + q * 8) = *(const uint4*)(ptr + q * 8);
            }
        }
        {
            const bf16_t* ptr = p.proj + (size_t)gi * PLD + KVC + (sel ? 5 : 3) * 128 + hk * 64;
            bf16_t* vt = vtile + (size_t)((sel * 2 + hk) * 64) * 72 + tok;
            unpack8(*(const uint4*)ptr, a); unpack8(*(const uint4*)(ptr + 8), b);
#pragma unroll
            for (int e = 0; e < 8; ++e) { const float x1 = a[e], x2 = b[e]; a[e] = x1 * cc[e] - x2 * sn[e]; b[e] = x2 * cc[e] + x1 * sn[e]; }
#pragma unroll
            for (int e = 0; e < 8; ++e) { vt[e * 72] = f2bf(a[e]); vt[(8 + e) * 72] = f2bf(b[e]); }
#pragma unroll
            for (int q = 2; q < 8; ++q) {
                const uint4 u = *(const uint4*)(ptr + q * 8);
                const unsigned w[4] = {u.x, u.y, u.z, u.w};
#pragma unroll
                for (int e = 0; e < 4; ++e) { vt[(q * 8 + 2 * e) * 72] = (bf16_t)(w[e] & 0xffffu); vt[(q * 8 + 2 * e + 1) * 72] = (bf16_t)(w[e] >> 16); }
            }
        }
    }
    __syncthreads();
    const int b = tt0 >> 14, s0 = tt0 & (S_ - 1);
#pragma unroll
    for (int i = 0; i < 8; ++i) {
        const int c = tid + i * 256, grp = c >> 9, d = (c >> 3) & 63, ch = c & 7, sel = grp >> 1, hk = grp & 1;
        const uint4 u = *(const uint4*)&vtile[(size_t)(grp * 64 + d) * 72 + ch * 8];
        *(uint4*)(p.vT + ((size_t)((sel * 4 + b * 2 + hk) * 64 + d)) * S_ + s0 + ch * 8) = u;
    }
    const int blk = s0 >> 6;
#pragma unroll
    for (int i = 0; i < 4; ++i) {
        const int c = tid + i * 256, hk = c >> 9, g8 = (c >> 6) & 7, ln = c & 63;
        const size_t dsto = ((size_t)(((b * 2 + hk) * 256 + blk) * 8 + g8) * 64 + ln) * 8;
        const int m16 = ln & 15, g4 = ln >> 4;
        {
            const int kg = g8 >> 1, ks = g8 & 1;
            *(uint4*)(p.ksw + dsto) = *(const uint4*)&ktile[(size_t)(hk * 64 + kg * 16 + m16) * 72 + ks * 32 + g4 * 8];
        }
        {
            const int kk = g8 >> 2, dt = g8 & 3;
            const bf16_t* row = &vtile[(size_t)((0 * 2 + hk) * 64 + dt * 16 + m16) * 72 + kk * 32 + 4 * g4];
            const uint2 lo = *(const uint2*)row, hi = *(const uint2*)(row + 16);
            *(uint4*)(p.vsw + dsto) = make_uint4(lo.x, lo.y, hi.x, hi.y);
        }
    }
}

DI void cmp1_item(const P& p, const int it, char* smem) {
    const int kv = it >> 6, bhk = (it >> 4) & 3, mt = (it >> 1) & 7, nt = it & 1, b = bhk >> 1, hk = bhk & 1;
    AFCmp af{p.proj + (size_t)(b * S_) * PLD + KVC + kv * 128 + hk * 64};
    EpiHid ep{p.hid + (size_t)((kv * 4 + bhk) * 1024) * 256, p.b1p + kv * 256};
    gemm_tile<1>(af, p.w1T + (size_t)(kv * 256 + nt * 128) * 2048, 2048, mt * 128, nt * 128, ep, smem);
}
DI void cmp2_item(const P& p, const int it, char* smem) {
    const int kv = it >> 5, bhk = (it >> 3) & 3, mt = it & 7, b = bhk >> 1;
    AFPlain af{p.hid + (size_t)((kv * 4 + bhk) * 1024) * 256, 256};
    if (kv == 0) { EpiKc ep{p.kc + (size_t)bhk * 1024 * 64, p.cosT, p.sinT, b * S_}; gemm_tile<1>(af, p.wc2T, 256, mt * 128, 0, ep, smem); }
    else { EpiVc ep{p.vcT + (size_t)bhk * 64 * 1024, smem}; gemm_tile<1>(af, p.wc2T + 128 * 256, 256, mt * 128, 0, ep, smem); }
}
DI void phase2(const P& p, char* smem) {
    for (int it = blockIdx.x; it < 128 + 512 + 1024; it += gridDim.x) {
        if (it < 128) cmp1_item(p, it, smem);
        else if (it < 640) rope_item(p, it - 128, smem);
        else rwkv_prep(p, it - 640, smem);
    }
}
DI void phase3(const P& p, char* smem) {
    for (int it = blockIdx.x; it < 64; it += gridDim.x) cmp2_item(p, it, smem);
}

template <int CTRL> DI float dpp_add(float x) { return x + __int_as_float(__builtin_amdgcn_mov_dpp(__float_as_int(x), CTRL, 0xF, 0xF, true)); }
DI float red16(float x) { x = dpp_add<0xB1>(x); x = dpp_add<0x4E>(x); x = dpp_add<0x141>(x); x = dpp_add<0x140>(x); return x; }

DI void cvt_store(const uint4 u, const bool isom, float* d) {
    float f0 = bflo(u.x), f1 = bfhi(u.x), f2 = bflo(u.y), f3 = bfhi(u.y), f4 = bflo(u.z), f5 = bfhi(u.z), f6 = bflo(u.w), f7 = bfhi(u.w);
    if (isom) { f0 = 1.f - f0; f1 = 1.f - f1; f2 = 1.f - f2; f3 = 1.f - f3; f4 = 1.f - f4; f5 = 1.f - f5; f6 = 1.f - f6; f7 = 1.f - f7; }
    *(float4*)d = make_float4(f0, f1, f2, f3); *(float4*)(d + 4) = make_float4(f4, f5, f6, f7);
}
DI void scan_unit(const P& p, int su, char* smem) {
    const int xcd = su & 7, kq = su >> 3, bh = xcd * 2 + (kq >> 3), oct = kq & 7, b = bh >> 3, h = bh & 7;
    const int tid = tidx(), wave = tid >> 6, lane = tid & 63;
    float* buf = (float*)smem;
    float* ypb = (float*)(smem + 49152);
    const bf16_t* sbase = p.stream + (size_t)bh * S_ * 384;
    __syncthreads();
#pragma unroll
    for (int i = 0; i < 3; ++i) { const int ci = tid + i * 256; cvt_store(*(const uint4*)(sbase + (size_t)ci * 8), (ci % 48) < 8, buf + ci * 8); }
    __syncthreads();
    if (wave < 2) {
        const int rl = lane >> 4, ks = lane & 15, row = oct * 8 + wave * 4 + rl;
        f2_t sA = {0.f, 0.f}, sB = {0.f, 0.f};
        __builtin_amdgcn_s_setprio(3);
        for (int c = 0; c < 1024; ++c) {
            const float* cb = buf + (c & 1) * 6144 + ks * 4;
            const float* vb = buf + (c & 1) * 6144 + 320 + row;
            float* yo = ypb + ((c & 1) * 2 + wave) * 1024 + lane;
            float4 dec = *(const float4*)(cb), km = *(const float4*)(cb + 64), kk = *(const float4*)(cb + 128), bb = *(const float4*)(cb + 192), rv = *(const float4*)(cb + 256);
            float v = vb[0];
            float4 dec1 = *(const float4*)(cb + 384), km1 = *(const float4*)(cb + 384 + 64), kk1 = *(const float4*)(cb + 384 + 128), bb1 = *(const float4*)(cb + 384 + 192), rv1 = *(const float4*)(cb + 384 + 256);
            float v1 = vb[384];
#pragma unroll
            for (int st = 0; st < 16; ++st) {
                float4 dec2 = dec1, km2 = km1, kk2 = kk1, bb2 = bb1, rv2 = rv1; float v2 = v1;
                if (st < 14) {
                    const float* rec = cb + (st + 2) * 384;
                    dec2 = *(const float4*)(rec); km2 = *(const float4*)(rec + 64); kk2 = *(const float4*)(rec + 128); bb2 = *(const float4*)(rec + 192); rv2 = *(const float4*)(rec + 256);
                    v2 = vb[(st + 2) * 384];
                }
                __builtin_amdgcn_sched_barrier(0x207);
                const f2_t vv = {v, v};
                const f2_t d01 = {dec.x, dec.y}, d23 = {dec.z, dec.w}, m01 = {km.x, km.y}, m23 = {km.z, km.w};
                const f2_t k01 = {kk.x, kk.y}, k23 = {kk.z, kk.w}, b01 = {bb.x, bb.y}, b23 = {bb.z, bb.w}, r01 = {rv.x, rv.y}, r23 = {rv.z, rv.w};
                const f2_t tA = sA * d01 + vv * m01, tB = sB * d23 + vv * m23;
                f2_t pa = sA * k01; pa = sB * k23 + pa;
                const float sa = red16(pa.x + pa.y);
                const f2_t sav = {sa, sa};
                sA = tA - sav * b01; sB = tB - sav * b23;
                f2_t ya = sA * r01; ya = sB * r23 + ya;
                yo[st * 64] = ya.x + ya.y;
                dec = dec1; km = km1; kk = kk1; bb = bb1; rv = rv1; v = v1;
                dec1 = dec2; km1 = km2; kk1 = kk2; bb1 = bb2; rv1 = rv2; v1 = v2;
            }
            __syncthreads();
        }
        __builtin_amdgcn_s_setprio(0);
    } else {
        const int ht = tid - 128;
        const int ystep = ht >> 3, r8 = ht & 7;
        float* yout = p.yraw + (size_t)(b * S_) * 512 + h * 64 + oct * 8 + r8;
        const float* ysrc = ypb + (r8 >> 2) * 1024 + ystep * 64 + (r8 & 3) * 16;
        uint4 ra0, ra1, ra2, ra3, ra4, ra5, rb0, rb1, rb2, rb3, rb4, rb5;
#define SLOAD(R, CH) { const bf16_t* sp_ = sbase + (size_t)(CH) * 6144 + (size_t)ht * 8; \
        R##0 = *(const uint4*)(sp_); R##1 = *(const uint4*)(sp_ + 1024); R##2 = *(const uint4*)(sp_ + 2048); R##3 = *(const uint4*)(sp_ + 3072); R##4 = *(const uint4*)(sp_ + 4096); R##5 = *(const uint4*)(sp_ + 5120); }
#define SSTORE(R, BI) { float* d_ = buf + (BI) * 6144 + ht * 8; const bool om_ = (ht % 48) < 8; \
        cvt_store(R##0, om_, d_); cvt_store(R##1, ((ht + 128) % 48) < 8, d_ + 1024); cvt_store(R##2, ((ht + 256) % 48) < 8, d_ + 2048); \
        cvt_store(R##3, ((ht + 384) % 48) < 8, d_ + 3072); cvt_store(R##4, ((ht + 512) % 48) < 8, d_ + 4096); cvt_store(R##5, ((ht + 640) % 48) < 8, d_ + 5120); }
#define YRED(C) { const float* ys_ = ysrc + ((C) & 1) * 2048; const float4 a_ = *(const float4*)ys_, b_ = *(const float4*)(ys_ + 4), c_ = *(const float4*)(ys_ + 8), d_ = *(const float4*)(ys_ + 12); \
        yout[(size_t)((C) * 16 + ystep) * 512] = ((a_.x + a_.y) + (a_.z + a_.w)) + ((b_.x + b_.y) + (b_.z + b_.w)) + ((c_.x + c_.y) + (c_.z + c_.w)) + ((d_.x + d_.y) + (d_.z + d_.w)); }
        SLOAD(ra, 1)
        for (int c = 0; c < 1024; c += 2) {
            if (c + 2 < 1024) SLOAD(rb, c + 2)
            SSTORE(ra, 1)
            if (c >= 1) YRED(c - 1)
            __syncthreads();
            if (c + 3 < 1024) SLOAD(ra, c + 3)
            if (c + 2 < 1024) SSTORE(rb, 0)
            YRED(c)
            __syncthreads();
        }
        YRED(1023)
#undef SLOAD
#undef SSTORE
#undef YRED
    }
}

struct AttnSmem {
    bf16_t k[64 * 72];
    bf16_t vt[64 * 68];
    float imp[32 * 256];
    unsigned selbits[32 * 8];
    unsigned wunion[4 * 8];
    unsigned bunion[8];
    unsigned gunion[8 * 8];
    int unit;
    int pad_[3];
    uint4 q[4 * 4 * 64];
};

#define ATTN_LOAD(KBASE, KSTRIDE, VTBASE, VTSTRIDE, NEEDV) { \
    rk0 = *(const uint4*)((KBASE) + (size_t)(tid >> 3) * (KSTRIDE) + (tid & 7) * 8); \
    rk1 = *(const uint4*)((KBASE) + (size_t)((tid >> 3) + 32) * (KSTRIDE) + (tid & 7) * 8); \
    if (NEEDV) { rv0 = *(const uint4*)((VTBASE) + (size_t)(tid >> 3) * (VTSTRIDE) + (tid & 7) * 8); \
                 rv1 = *(const uint4*)((VTBASE) + (size_t)((tid >> 3) + 32) * (VTSTRIDE) + (tid & 7) * 8); } }
#define ATTN_STORE(NEEDV) { \
    *(uint4*)&sm.k[(tid >> 3) * 72 + (tid & 7) * 8] = rk0; *(uint4*)&sm.k[((tid >> 3) + 32) * 72 + (tid & 7) * 8] = rk1; \
    if (NEEDV) { bf16_t* d0_ = &sm.vt[(tid >> 3) * 68 + (tid & 7) * 8]; bf16_t* d1_ = &sm.vt[((tid >> 3) + 32) * 68 + (tid & 7) * 8]; \
        *(uint2*)d0_ = make_uint2(rv0.x, rv0.y); *(uint2*)(d0_ + 4) = make_uint2(rv0.z, rv0.w); \
        *(uint2*)d1_ = make_uint2(rv1.x, rv1.y); *(uint2*)(d1_ + 4) = make_uint2(rv1.z, rv1.w); } }

template <int MODE, bool EM>
DI void attn_tile(AttnSmem& sm, const uint4* qs, f32x16 (&o)[2], float& m, float& l, const float inv_l, const int lo, const int hi, const bool lane_on,
                  const int lane, const int tokl, const int jbase) {
    const int rr = lane & 31, hh = lane >> 5;
    f32x16 s[2];
#pragma unroll
    for (int mt = 0; mt < 2; ++mt) {
#pragma unroll
        for (int i = 0; i < 16; ++i) s[mt][i] = 0.f;
#pragma unroll
        for (int ks = 0; ks < 4; ++ks) {
            const bf16x8 kf = *(const bf16x8*)&sm.k[(mt * 32 + rr) * 72 + ks * 16 + hh * 8];
            const bf16x8 qv = __builtin_bit_cast(bf16x8, qs[ks * 64]);
            s[mt] = MFMA32(kf, qv, s[mt]);
        }
        asm volatile("" ::: "memory");
    }
    (void)m;
    __builtin_amdgcn_sched_barrier(0);
    float psum = 0.f;
    if (EM) {
        const int lo2 = lo - 4 * hh, hi2 = hi - 4 * hh;
#pragma unroll
        for (int mt = 0; mt < 2; ++mt)
#pragma unroll
            for (int i = 0; i < 16; ++i) {
                const int kc_ = mt * 32 + (i & 3) + 8 * (i >> 2);
                float v = s[mt][i];
                v = (kc_ >= lo2 && kc_ <= hi2) ? v : -1e30f;
                float pv = __builtin_amdgcn_exp2f(v);
                if (MODE == 2) pv *= inv_l;
                s[mt][i] = pv; psum += pv;
            }
    } else {
        const float off = lane_on ? 0.f : -1e30f;
#pragma unroll
        for (int mt = 0; mt < 2; ++mt)
#pragma unroll
            for (int i = 0; i < 16; ++i) {
                float pv = __builtin_amdgcn_exp2f(s[mt][i] + off);
                if (MODE == 2) pv *= inv_l;
                s[mt][i] = pv; psum += pv;
            }
    }
    __builtin_amdgcn_sched_barrier(0);
    if (MODE != 2) l += psum;
    if (MODE == 0) return;
    if (MODE == 2) {
#pragma unroll
        for (int mt = 0; mt < 2; ++mt)
#pragma unroll
            for (int jj = 0; jj < 4; ++jj) {
                float q4 = (s[mt][4 * jj] + s[mt][4 * jj + 1]) + (s[mt][4 * jj + 2] + s[mt][4 * jj + 3]);
                float e3 = s[mt][4 * jj + 3];
                q4 += __shfl_xor(q4, 1); q4 += __shfl_xor(q4, 2);
                e3 += __shfl_xor(e3, 1); e3 += __shfl_xor(e3, 2);
                if ((rr & 3) == 0) {
                    const int j = jbase + mt * 8 + 2 * jj + hh;
                    atomicAdd(&sm.imp[tokl * 256 + j], q4);
                    if (j + 1 < 256) atomicAdd(&sm.imp[tokl * 256 + j + 1], e3);
                }
            }
    }
#pragma unroll
    for (int mt = 0; mt < 2; ++mt)
#pragma unroll
        for (int s2 = 0; s2 < 2; ++s2) {
            uint4 pu;
            pu.x = pack2(s[mt][8 * s2 + 0], s[mt][8 * s2 + 1]); pu.y = pack2(s[mt][8 * s2 + 2], s[mt][8 * s2 + 3]);
            pu.z = pack2(s[mt][8 * s2 + 4], s[mt][8 * s2 + 5]); pu.w = pack2(s[mt][8 * s2 + 6], s[mt][8 * s2 + 7]);
            const bf16x8 pf = __builtin_bit_cast(bf16x8, pu);
            asm volatile("" ::: "memory");
#pragma unroll
            for (int dt = 0; dt < 2; ++dt) {
                const bf16_t* vp = &sm.vt[(dt * 32 + rr) * 68 + mt * 32 + s2 * 16 + hh * 4];
                const uint2 v0 = *(const uint2*)vp, v1 = *(const uint2*)(vp + 8);
                const bf16x8 vf = __builtin_bit_cast(bf16x8, make_uint4(v0.x, v0.y, v1.x, v1.y));
                o[dt] = MFMA32(vf, pf, o[dt]);
            }
        }
}

template <int CTRL> DI unsigned dpp_umax(unsigned x) { const unsigned t = (unsigned)__builtin_amdgcn_mov_dpp((int)x, CTRL, 0xF, 0xF, true); return x > t ? x : t; }
DI unsigned wave_umax(unsigned v) {
    v = dpp_umax<0xB1>(v); v = dpp_umax<0x4E>(v); v = dpp_umax<0x141>(v); v = dpp_umax<0x140>(v);
    const unsigned a = (unsigned)__builtin_amdgcn_readlane((int)v, 0), b = (unsigned)__builtin_amdgcn_readlane((int)v, 16);
    const unsigned c = (unsigned)__builtin_amdgcn_readlane((int)v, 32), d = (unsigned)__builtin_amdgcn_readlane((int)v, 48);
    const unsigned ab = a > b ? a : b, cd = c > d ? c : d;
    return ab > cd ? ab : cd;
}


typedef unsigned u32x4 __attribute__((ext_vector_type(4)));
#define GLD16(R, PTR) asm volatile("global_load_dwordx4 %0, %1, off" : "=&v"(R) : "v"(PTR))
template <bool NEEDV, class NextF, class KPtrF, class VPtrF, class CompF>
DI void attn_pipe(AttnSmem& sm, const int tid, int j, const NextF next, const KPtrF kptr, const int kst, const VPtrF vptr, const int vst, const CompF comp) {
    if (j < 0) return;
    u32x4 Ak0, Ak1, Av0 = {0u, 0u, 0u, 0u}, Av1 = {0u, 0u, 0u, 0u}, Bk0, Bk1, Bv0 = {0u, 0u, 0u, 0u}, Bv1 = {0u, 0u, 0u, 0u};
    const int lr = tid >> 3, lc = (tid & 7) * 8;
#define PIPE_LOADS(S, JJ) { const bf16_t* kp_ = kptr(JJ) + (size_t)lr * kst + lc; GLD16(S##k0, kp_); GLD16(S##k1, kp_ + (size_t)32 * kst); \
        if (NEEDV) { const bf16_t* vp_ = vptr(JJ) + (size_t)lr * vst + lc; GLD16(S##v0, vp_); GLD16(S##v1, vp_ + (size_t)32 * vst); } }
#define PIPE_WAIT(S) { if (NEEDV) asm volatile("s_waitcnt vmcnt(4)" : "+v"(S##k0), "+v"(S##k1), "+v"(S##v0), "+v"(S##v1)); \
        else asm volatile("s_waitcnt vmcnt(2)" : "+v"(S##k0), "+v"(S##k1)); }
#define PIPE_STORES(S) { *(u32x4*)&sm.k[lr * 72 + lc] = S##k0; *(u32x4*)&sm.k[(lr + 32) * 72 + lc] = S##k1; \
        if (NEEDV) { bf16_t* d0_ = &sm.vt[lr * 68 + lc]; bf16_t* d1_ = &sm.vt[(lr + 32) * 68 + lc]; \
            *(uint2*)d0_ = make_uint2(S##v0.x, S##v0.y); *(uint2*)(d0_ + 4) = make_uint2(S##v0.z, S##v0.w); \
            *(uint2*)d1_ = make_uint2(S##v1.x, S##v1.y); *(uint2*)(d1_ + 4) = make_uint2(S##v1.z, S##v1.w); } }
    int jn = next(j);
    PIPE_LOADS(A, j)
    PIPE_LOADS(B, (jn >= 0 ? jn : j))
    while (true) {
        __syncthreads();
        PIPE_WAIT(A)
        PIPE_STORES(A)
        __syncthreads();
        const int jnn = jn >= 0 ? next(jn) : -1;
        PIPE_LOADS(A, (jnn >= 0 ? jnn : j))
        comp(j);
        if (jn < 0) break;
        __syncthreads();
        PIPE_WAIT(B)
        PIPE_STORES(B)
        __syncthreads();
        const int jnnn = jnn >= 0 ? next(jnn) : -1;
        PIPE_LOADS(B, (jnnn >= 0 ? jnnn : jn))
        comp(jn);
        if (jnn < 0) break;
        j = jnn; jn = jnnn;
    }
    asm volatile("s_waitcnt vmcnt(0)" : "+v"(Ak0), "+v"(Ak1), "+v"(Av0), "+v"(Av1), "+v"(Bk0), "+v"(Bk1), "+v"(Bv0), "+v"(Bv1));
#undef PIPE_LOADS
#undef PIPE_WAIT
#undef PIPE_STORES
}


typedef float f32x4v __attribute__((ext_vector_type(4)));
#define MFMA16(a, b, c) __builtin_amdgcn_mfma_f32_16x16x32_bf16((a), (b), (c), 0, 0, 0)
template <bool EM>
DI void sel16_scores(const u32x4 k0, const u32x4 k1, const u32x4 k2, const u32x4 k3, const u32x4 k4, const u32x4 k5, const u32x4 k6, const u32x4 k7,
                     const u32x4 q0, const u32x4 q1, float& l, const int hi, const bool lane_on, const int lane, u32x4& pf0, u32x4& pf1) {
    const int g4 = lane >> 4;
    const f32x4v z = {0.f, 0.f, 0.f, 0.f};
    const bf16x8 qa = __builtin_bit_cast(bf16x8, q0), qb = __builtin_bit_cast(bf16x8, q1);
    f32x4v a0 = MFMA16(__builtin_bit_cast(bf16x8, k0), qa, z); a0 = MFMA16(__builtin_bit_cast(bf16x8, k1), qb, a0);
    f32x4v a1 = MFMA16(__builtin_bit_cast(bf16x8, k2), qa, z); a1 = MFMA16(__builtin_bit_cast(bf16x8, k3), qb, a1);
    f32x4v a2 = MFMA16(__builtin_bit_cast(bf16x8, k4), qa, z); a2 = MFMA16(__builtin_bit_cast(bf16x8, k5), qb, a2);
    f32x4v a3 = MFMA16(__builtin_bit_cast(bf16x8, k6), qa, z); a3 = MFMA16(__builtin_bit_cast(bf16x8, k7), qb, a3);
    float psum = 0.f;
    if (EM) {
        const int hi2 = hi - 4 * g4;
#pragma unroll
        for (int r = 0; r < 4; ++r) {
            a0[r] = __builtin_amdgcn_exp2f((r <= hi2) ? a0[r] : -1e30f);
            a1[r] = __builtin_amdgcn_exp2f((16 + r <= hi2) ? a1[r] : -1e30f);
            a2[r] = __builtin_amdgcn_exp2f((32 + r <= hi2) ? a2[r] : -1e30f);
            a3[r] = __builtin_amdgcn_exp2f((48 + r <= hi2) ? a3[r] : -1e30f);
            psum += (a0[r] + a1[r]) + (a2[r] + a3[r]);
        }
    } else {
        const float off = lane_on ? 0.f : -1e30f;
#pragma unroll
        for (int r = 0; r < 4; ++r) {
            a0[r] = __builtin_amdgcn_exp2f(a0[r] + off); a1[r] = __builtin_amdgcn_exp2f(a1[r] + off);
            a2[r] = __builtin_amdgcn_exp2f(a2[r] + off); a3[r] = __builtin_amdgcn_exp2f(a3[r] + off);
            psum += (a0[r] + a1[r]) + (a2[r] + a3[r]);
        }
    }
    l += psum;
    pf0.x = pack2(a0[0], a0[1]); pf0.y = pack2(a0[2], a0[3]); pf0.z = pack2(a1[0], a1[1]); pf0.w = pack2(a1[2], a1[3]);
    pf1.x = pack2(a2[0], a2[1]); pf1.y = pack2(a2[2], a2[3]); pf1.z = pack2(a3[0], a3[1]); pf1.w = pack2(a3[2], a3[3]);
}
DI void sel16_pv(const u32x4 v0, const u32x4 v1, const u32x4 v2, const u32x4 v3, const u32x4 v4, const u32x4 v5, const u32x4 v6, const u32x4 v7,
                 const u32x4 pf0, const u32x4 pf1, f32x4v& o0, f32x4v& o1, f32x4v& o2, f32x4v& o3) {
    const bf16x8 pa = __builtin_bit_cast(bf16x8, pf0), pb = __builtin_bit_cast(bf16x8, pf1);
    o0 = MFMA16(__builtin_bit_cast(bf16x8, v0), pa, o0); o1 = MFMA16(__builtin_bit_cast(bf16x8, v1), pa, o1);
    o2 = MFMA16(__builtin_bit_cast(bf16x8, v2), pa, o2); o3 = MFMA16(__builtin_bit_cast(bf16x8, v3), pa, o3);
    o0 = MFMA16(__builtin_bit_cast(bf16x8, v4), pb, o0); o1 = MFMA16(__builtin_bit_cast(bf16x8, v5), pb, o1);
    o2 = MFMA16(__builtin_bit_cast(bf16x8, v6), pb, o2); o3 = MFMA16(__builtin_bit_cast(bf16x8, v7), pb, o3);
}

DI void attn_unit(const P& p, int u, char* smem) {
    AttnSmem& sm = *(AttnSmem*)smem;
    const int tid = tidx(), wave = tid >> 6, lane = tid & 63, rr = lane & 31, hh = lane >> 5;
    const int tile = 511 - (u >> 2), bhk = u & 3, b = bhk >> 1, hk = bhk & 1, t0 = tile * 32;
    const int tokl = wave * 8 + (rr >> 2), t = t0 + tokl, g = rr & 3, head = hk * 4 + g;
    const size_t tokg = (size_t)b * S_ + t;
    uint4* qs = &sm.q[wave * 256 + lane];
#pragma unroll
    for (int ks = 0; ks < 4; ++ks) qs[ks * 64] = *(const uint4*)(p.proj + tokg * PLD + QC + head * 64 + ks * 16 + hh * 8);
#define GATE(i) sigmoidf_(__uint_as_float((unsigned)p.proj[((size_t)b * S_ + t) * PLD + GC + head * 3 + (i)] << 16))
#pragma unroll
    for (int i = 0; i < 8; ++i) *(float4*)&sm.imp[(tid + i * 256) * 4] = make_float4(0.f, 0.f, 0.f, 0.f);
    sm.selbits[tid] = 0u;
    f32x16 o[2];
#pragma unroll
    for (int dt = 0; dt < 2; ++dt)
#pragma unroll
        for (int i = 0; i < 16; ++i) o[dt][i] = 0.f;
    float* park = &sm.imp[wave * 2048 + lane];
    const int ntc = (t0 >> 10) + 1;
    const int vmaxi = (t >= 31) ? ((t - 31) >> 4) : -1;
    const int twmin = t0 + wave * 8;
    const int wvmin = (twmin >= 31) ? ((twmin - 31) >> 4) : -1;
    const bf16_t* kcb = p.kc + (size_t)bhk * 1024 * 64;
    const bf16_t* vcb = p.vcT + (size_t)bhk * 64 * 1024;
    float m = -1e30f, l = 0.f;
    {
        auto nxt = [&](int j) -> int { return j + 1 < ntc ? j + 1 : -1; };
        auto kp = [&](int j) -> const bf16_t* { return kcb + (size_t)j * 64 * 64; };
        auto vp = [&](int j) -> const bf16_t* { return vcb + j * 64; };
        attn_pipe<false>(sm, tid, 0, nxt, kp, 64, vp, 1024, [&](int j) {
            if (j * 64 + 63 <= wvmin) attn_tile<0, false>(sm, qs, o, m, l, 0.f, 0, 0, true, lane, tokl, 0);
            else attn_tile<0, true>(sm, qs, o, m, l, 0.f, 0, vmaxi - j * 64, true, lane, tokl, 0);
        });
        const float lt = l + __shfl_xor(l, 32);
        const float inv_l = lt > 0.f ? 1.f / lt : 0.f;
        attn_pipe<true>(sm, tid, 0, nxt, kp, 64, vp, 1024, [&](int j) {
            if (j * 64 + 63 <= wvmin) attn_tile<2, false>(sm, qs, o, m, l, inv_l, 0, 0, true, lane, tokl, j * 16);
            else attn_tile<2, true>(sm, qs, o, m, l, inv_l, 0, vmaxi - j * 64, true, lane, tokl, j * 16);
        });
    }
    __syncthreads();
    const int cur = t0 >> 6;
    for (int tk = 0; tk < 8; ++tk) {
        const int tl = wave * 8 + tk;
        const float* ip = &sm.imp[tl * 256];
        unsigned nib = 0u;
        if (cur <= 15) {
#pragma unroll
            for (int e = 0; e < 4; ++e) if (lane * 4 + e <= cur) nib |= 1u << e;
        } else {
            unsigned k0, k1, k2, k3;
            {
                const float4 iv = *(const float4*)(ip + lane * 4);
                const int j0 = lane * 4;
                k0 = (j0 >= 1 && j0 <= cur - 2) ? ((__float_as_uint(iv.x) & 0xFFFFFF00u) | (unsigned)(255 - j0)) : 0u;
                k1 = (j0 + 1 <= cur - 2) ? ((__float_as_uint(iv.y) & 0xFFFFFF00u) | (unsigned)(254 - j0)) : 0u;
                k2 = (j0 + 2 <= cur - 2) ? ((__float_as_uint(iv.z) & 0xFFFFFF00u) | (unsigned)(253 - j0)) : 0u;
                k3 = (j0 + 3 <= cur - 2) ? ((__float_as_uint(iv.w) & 0xFFFFFF00u) | (unsigned)(252 - j0)) : 0u;
#pragma unroll
                for (int e = 0; e < 4; ++e) { const int j = j0 + e; if (j == 0 || j == cur || j == cur - 1) nib |= 1u << e; }
            }
            for (int r = 0; r < 13; ++r) {
                unsigned lm = k0 > k1 ? k0 : k1; const unsigned lm2 = k2 > k3 ? k2 : k3; lm = lm > lm2 ? lm : lm2;
                const unsigned wm = wave_umax(lm);
                if (k0 == wm) { k0 = 0u; nib |= 1u; }
                if (k1 == wm) { k1 = 0u; nib |= 2u; }
                if (k2 == wm) { k2 = 0u; nib |= 4u; }
                if (k3 == wm) { k3 = 0u; nib |= 8u; }
            }
        }
        atomicOr(&sm.selbits[tl * 8 + (lane >> 3)], nib << ((lane & 7) * 4));
    }
    __syncthreads();
    if (tid < 32) {
        const int w = tid >> 3, d = tid & 7; unsigned uu = 0u;
#pragma unroll
        for (int k = 0; k < 8; ++k) uu |= sm.selbits[(w * 8 + k) * 8 + d];
        sm.wunion[w * 8 + d] = uu;
    }
    if (tid < 64) {
        const int wg = tid >> 3, d = tid & 7; unsigned uu = 0u;
#pragma unroll
        for (int k = 0; k < 4; ++k) uu |= sm.selbits[(wg * 4 + k) * 8 + d];
        sm.gunion[wg * 8 + d] = uu;
    }
    __syncthreads();
    if (tid < 8) sm.bunion[tid] = sm.wunion[tid] | sm.wunion[8 + tid] | sm.wunion[16 + tid] | sm.wunion[24 + tid];
    __syncthreads();
    {
        const float g0 = GATE(0);
#pragma unroll
        for (int dt = 0; dt < 2; ++dt)
#pragma unroll
            for (int i = 0; i < 16; ++i) { park[(dt * 16 + i) * 64] = g0 * o[dt][i]; o[dt][i] = 0.f; }
    }
    {
        const bf16_t* kb = p.proj + (size_t)(b * S_) * PLD + KVC + 2 * 128 + hk * 64;
        const bf16_t* vb = p.vT + (size_t)((0 * 4 + bhk) * 64) * S_;
        m = -1e30f; l = 0.f;
        (void)kb; (void)vb; (void)m; (void)l;
        const bf16_t* kswb = p.ksw + ((size_t)bhk * 256 * 512 + lane) * 8;
        const bf16_t* vswb = p.vsw + ((size_t)bhk * 256 * 512 + lane) * 8;
        float* pbase = &sm.imp[wave * 2048];
        const int q16 = lane & 15, g4 = lane >> 4;
#pragma unroll 1
        for (int grp = 0; grp < 2; ++grp) {
            const int tokl16 = wave * 8 + grp * 4 + (q16 >> 2), t16 = t0 + tokl16, head16 = hk * 4 + (q16 & 3);
            const bf16_t* qrow = p.proj + ((size_t)b * S_ + t16) * PLD;
            const u32x4 qf0 = *(const u32x4*)(qrow + QC + head16 * 64 + g4 * 8), qf1 = *(const u32x4*)(qrow + QC + head16 * 64 + 32 + g4 * 8);
            const unsigned* gu = &sm.gunion[(wave * 2 + grp) * 8];
            auto nextg = [&](int j) -> int {
                ++j;
                while (j <= cur) {
                    const unsigned w = gu[j >> 5] >> (j & 31);
                    if (w) { j += __ffs((int)w) - 1; return j <= cur ? j : -1; }
                    j = (j | 31) + 1;
                }
                return -1;
            };
            f32x4v od0 = {0.f, 0.f, 0.f, 0.f}, od1 = od0, od2 = od0, od3 = od0;
            float lg = 0.f;
            u32x4 A0, A1, A2, A3, A4, A5, A6, A7, B0, B1, B2, B3, B4, B5, B6, B7, V0, V1, V2, V3, V4, V5, V6, V7, pf0, pf1;
#define SEL_LD8(R, BASE, JJ) { const bf16_t* b_ = (BASE) + (size_t)(JJ) * 4096; GLD16(R##0, b_); GLD16(R##1, b_ + 512); GLD16(R##2, b_ + 1024); GLD16(R##3, b_ + 1536); \
            GLD16(R##4, b_ + 2048); GLD16(R##5, b_ + 2560); GLD16(R##6, b_ + 3072); GLD16(R##7, b_ + 3584); }
#define SEL_WAIT8(R, N) asm volatile("s_waitcnt vmcnt(" #N ")" : "+v"(R##0), "+v"(R##1), "+v"(R##2), "+v"(R##3), "+v"(R##4), "+v"(R##5), "+v"(R##6), "+v"(R##7))
#define SEL_TILE(K, JJ) { \
            const int jj_ = (JJ); \
            const bool selme_ = (sm.selbits[tokl16 * 8 + (jj_ >> 5)] >> (jj_ & 31)) & 1u; \
            SEL_WAIT8(K, 16); \
            if (jj_ < cur) sel16_scores<false>(K##0, K##1, K##2, K##3, K##4, K##5, K##6, K##7, qf0, qf1, lg, 0, selme_, lane, pf0, pf1); \
            else sel16_scores<true>(K##0, K##1, K##2, K##3, K##4, K##5, K##6, K##7, qf0, qf1, lg, selme_ ? t16 - jj_ * 64 : -1, true, lane, pf0, pf1); \
            SEL_WAIT8(V, 8); \
            sel16_pv(V0, V1, V2, V3, V4, V5, V6, V7, pf0, pf1, od0, od1, od2, od3); }
            int j = nextg(-1);
            if (j >= 0) {
                SEL_LD8(A, kswb, j)
                while (true) {
                    const int jn = nextg(j);
                    SEL_LD8(V, vswb, j)
                    SEL_LD8(B, kswb, (jn >= 0 ? jn : j))
                    SEL_TILE(A, j)
                    if (jn < 0) break;
                    const int jnn = nextg(jn);
                    SEL_LD8(V, vswb, jn)
                    SEL_LD8(A, kswb, (jnn >= 0 ? jnn : jn))
                    SEL_TILE(B, jn)
                    if (jnn < 0) break;
                    j = jnn;
                }
                asm volatile("s_waitcnt vmcnt(0)" : "+v"(A0), "+v"(A1), "+v"(A2), "+v"(A3), "+v"(A4), "+v"(A5), "+v"(A6), "+v"(A7), "+v"(B0), "+v"(B1), "+v"(B2), "+v"(B3), "+v"(B4), "+v"(B5), "+v"(B6), "+v"(B7));
                asm volatile("s_waitcnt vmcnt(0)" : "+v"(V0), "+v"(V1), "+v"(V2), "+v"(V3), "+v"(V4), "+v"(V5), "+v"(V6), "+v"(V7));
            }
#undef SEL_LD8
#undef SEL_WAIT8
#undef SEL_TILE
            float lt = lg + __shfl_xor(lg, 16); lt += __shfl_xor(lt, 32);
            const float g1 = sigmoidf_(__uint_as_float((unsigned)qrow[GC + head16 * 3 + 1] << 16));
            const float sc = lt > 0.f ? g1 / lt : 0.f;
            const int r32 = grp * 16 + q16, hh32 = g4 & 1;
#pragma unroll
            for (int dt = 0; dt < 4; ++dt) {
                const f32x4v ov = dt == 0 ? od0 : (dt == 1 ? od1 : (dt == 2 ? od2 : od3));
#pragma unroll
                for (int r = 0; r < 4; ++r) {
                    const int i32 = r + 4 * ((dt & 1) * 2 + (g4 >> 1));
                    pbase[((dt >> 1) * 16 + i32) * 64 + r32 + 32 * hh32] += sc * ov[r];
                }
            }
        }
    }
    {
        const bf16_t* kb = p.proj + (size_t)(b * S_) * PLD + KVC + 4 * 128 + hk * 64;
        const bf16_t* vb = p.vT + (size_t)((1 * 4 + bhk) * 64) * S_;
        m = -1e30f; l = 0.f;
        const int jlo = (t0 >= 511) ? ((t0 - 511) >> 6) : 0, jhi = t0 >> 6;
        attn_pipe<true>(sm, tid, jlo, [&](int j) -> int { return j + 1 <= jhi ? j + 1 : -1; }, [&](int j) -> const bf16_t* { return kb + (size_t)j * 64 * PLD; }, PLD,
                        [&](int j) -> const bf16_t* { return vb + j * 64; }, S_, [&](int j) {
            if (j * 64 >= twmin + 7 - 511 && j * 64 + 63 <= twmin) attn_tile<1, false>(sm, qs, o, m, l, 0.f, 0, 0, true, lane, tokl, 0);
            else attn_tile<1, true>(sm, qs, o, m, l, 0.f, t - 511 - j * 64, t - j * 64, true, lane, tokl, 0);
        });
        const float lt = l + __shfl_xor(l, 32);
        const float sc = lt > 0.f ? GATE(2) / lt : 0.f;
#pragma unroll
        for (int dt = 0; dt < 2; ++dt)
#pragma unroll
            for (int i = 0; i < 16; ++i) o[dt][i] = park[(dt * 16 + i) * 64] + sc * o[dt][i];
    }
    bf16_t* mp = p.A + tokg * 1024 + 512 + head * 64;
#pragma unroll
    for (int dt = 0; dt < 2; ++dt)
#pragma unroll
        for (int jj = 0; jj < 4; ++jj) {
            uint2 ov; ov.x = pack2(o[dt][4 * jj], o[dt][4 * jj + 1]); ov.y = pack2(o[dt][4 * jj + 2], o[dt][4 * jj + 3]);
            *(uint2*)(mp + dt * 32 + jj * 8 + hh * 4) = ov;
        }
}

DI void phase4(const P& p, char* smem) {
    for (int su = blockIdx.x; su < 128; su += gridDim.x) scan_unit(p, su, smem);
    AttnSmem& sm = *(AttnSmem*)smem;
    while (true) {
        __syncthreads();
        if (tidx() == 0) sm.unit = (int)atomicAdd(p.counter, 1u);
        __syncthreads();
        const int u = sm.unit;
        if (u >= 2048) break;
        attn_unit(p, u, smem);
    }
}

DI void phase4b(const P& p) {
    const int tid = tidx();
    for (int it = blockIdx.x; it < T_ / 4; it += gridDim.x) {
        const int gi = it * 4 + (tid >> 6), cgp = tid & 63, h = cgp >> 3, c8 = (cgp & 7) * 8, col = cgp * 8, b = gi >> 14, s = gi & (S_ - 1);
        const float4 y0 = *(const float4*)(p.yraw + (size_t)gi * 512 + col), y1 = *(const float4*)(p.yraw + (size_t)gi * 512 + col + 4);
        float y[8] = {y0.x, y0.y, y0.z, y0.w, y1.x, y1.y, y1.z, y1.w};
        const bf16_t* sp = p.stream + ((size_t)((b * 8 + h) * S_ + s) * 6) * 64 + c8;
        float km[8], r[8], v[8], gg[8];
        unpack8(*(const uint4*)(sp + 64), km); unpack8(*(const uint4*)(sp + 256), r); unpack8(*(const uint4*)(sp + 320), v);
        unpack8(*(const uint4*)(p.gbuf + (size_t)gi * 512 + col), gg);
        float sum = 0.f, bon = 0.f;
#pragma unroll
        for (int e = 0; e < 8; ++e) { sum += y[e]; bon += r[e] * km[e] * p.r_k[col + e]; }
        sum += __shfl_xor(sum, 1); sum += __shfl_xor(sum, 2); sum += __shfl_xor(sum, 4);
        bon += __shfl_xor(bon, 1); bon += __shfl_xor(bon, 2); bon += __shfl_xor(bon, 4);
        const float mean = sum * (1.f / 64.f);
        float var = 0.f;
#pragma unroll
        for (int e = 0; e < 8; ++e) { y[e] -= mean; var += y[e] * y[e]; }
        var += __shfl_xor(var, 1); var += __shfl_xor(var, 2); var += __shfl_xor(var, 4);
        const float rs = rsqrtf(var * (1.f / 64.f) + 64e-5f);
        float o[8];
#pragma unroll
        for (int e = 0; e < 8; ++e) o[e] = (y[e] * rs * p.lnx_w[col + e] + p.lnx_b[col + e] + bon * v[e]) * gg[e];
        *(uint4*)(p.A + (size_t)gi * 1024 + col) = pack8(o);
    }
}

struct EpiFfn2 {
    float* out;
    DI void operator()(const f32x16 (&acc)[2][2], int rowbase, int colbase, int lane) const {
        const int rr = lane & 31, hh = lane >> 5;
#pragma unroll
        for (int w = 0; w < 2; ++w)
#pragma unroll
            for (int t = 0; t < 2; ++t)
#pragma unroll
                for (int j = 0; j < 4; ++j) {
                    float4* o = (float4*)(out + (size_t)(rowbase + t * 32 + rr) * 1024 + colbase + w * 32 + j * 8 + hh * 4);
                    float4 xv = *o;
                    xv.x += acc[w][t][4 * j]; xv.y += acc[w][t][4 * j + 1]; xv.z += acc[w][t][4 * j + 2]; xv.w += acc[w][t][4 * j + 3];
                    *o = xv;
                }
    }
};

DI void final_item(float* io, const float* g, int idx) {
    const int row = idx * 4 + (tidx() >> 6), lane = tidx() & 63;
    float4* sp = (float4*)(io + (size_t)row * 1024);
    float4 v[4]; float ss = 0.f;
#pragma unroll
    for (int i = 0; i < 4; ++i) { v[i] = sp[lane + 64 * i]; ss += v[i].x * v[i].x + v[i].y * v[i].y + v[i].z * v[i].z + v[i].w * v[i].w; }
    ss = wave_sum(ss);
    const float rs = rsqrtf(ss * (1.f / 1024.f) + 1e-6f);
#pragma unroll
    for (int i = 0; i < 4; ++i) {
        const float4 gv = ((const float4*)g)[lane + 64 * i];
        sp[lane + 64 * i] = make_float4(v[i].x * rs * gv.x, v[i].y * rs * gv.y, v[i].z * rs * gv.z, v[i].w * rs * gv.w);
    }
}

DI bool gemm_order(const int round, const int NT, int& mt, int& nt) {
    if (gridDim.x == 512) {
        const int xcd = blockIdx.x & 7, lb = blockIdx.x >> 3;
        const int q = round * 64 + lb;
        if (q >= 32 * NT) return false;
        mt = xcd * 32 + (q / (8 * NT)) * 8 + (q & 7);
        nt = (q >> 3) % NT;
        return true;
    }
    const int it = round * gridDim.x + blockIdx.x;
    if (it >= 256 * NT) return false;
    mt = it / NT; nt = it - mt * NT;
    return true;
}

DI void run_phase(const P& p, int ph, char* smem) {
    switch (ph) {
    case 0: phase0(p, smem); break;
    case 1:
        for (int rd = 0;; ++rd) {
            int mt, nt; if (!gemm_order(rd, 25, mt, nt)) break;
            gemm_tile<8>(AFPlain{p.A, 1024}, p.WinT + (size_t)nt * 128 * 1024, 1024, mt * 128, nt * 128, EpiProj{p.proj}, smem);
        }
        break;
    case 2: phase2(p, smem); break;
    case 3: phase3(p, smem); break;
    case 4: phase4(p, smem); break;
    case 5: phase4b(p); break;
    case 6:
        for (int rd = 0;; ++rd) {
            int mt, nt; if (!gemm_order(rd, 8, mt, nt)) break;
            gemm_tile<8>(AFPlain{p.A, 1024}, p.WoutT + (size_t)nt * 128 * 1024, 1024, mt * 128, nt * 128, EpiOut{p.out, p.x}, smem);
        }
        break;
    case 7:
        for (int it = blockIdx.x; it < T_ / 4; it += gridDim.x) rms_item(p.out, p.norm_ffn, p.A, it);
        break;
    case 8:
        for (int rd = 0;; ++rd) {
            int mt, nt; if (!gemm_order(rd, 44, mt, nt)) break;
            gemm_tile<8>(AFPlain{p.A, 1024}, p.WguT + (size_t)nt * 128 * 1024, 1024, mt * 128, nt * 128, EpiFfn1{p.stream}, smem);
        }
        break;
    case 9:
        for (int rd = 0;; ++rd) {
            int mt, nt; if (!gemm_order(rd, 8, mt, nt)) break;
            gemm_tile<1>(AFPlain{p.stream, DFF}, p.WdnT + (size_t)nt * 128 * DFF, DFF, mt * 128, nt * 128, EpiFfn2{p.out}, smem);
        }
        break;
    default:
        for (int it = blockIdx.x; it < T_ / 4; it += gridDim.x) final_item(p.out, p.norm_final, it);
        break;
    }
}
constexpr int NPHASE = 11;
constexpr int SMEM_BYTES = 73728;


#define XB_TMO      128
#define XB_XCNT(j)  (256  + 64 * (j))
#define XB_XSUB(j)  (1280 + 64 * (j))
#define XB_XGEN(j)  (2304 + 64 * (j))
#define XB_TOP      3328
#define XB_TOPGEN   3392
#define XCD_BAR_WORDS 3456
#define XB_SPIN_CAP (1u << 22)
#define LAS __attribute__((address_space(3)))
DI unsigned xb_ld(unsigned* p) { return __hip_atomic_load(p, __ATOMIC_RELAXED, __HIP_MEMORY_SCOPE_AGENT); }
DI unsigned xb_add(unsigned* p, unsigned v) { return __hip_atomic_fetch_add(p, v, __ATOMIC_RELAXED, __HIP_MEMORY_SCOPE_AGENT); }
DI unsigned xb_xcc_id() { return (unsigned)__builtin_amdgcn_s_getreg((3 << 11) | 20) & 0xFu; }
#define XB_SPIN(cond, bar) do { unsigned _sp = 0; while (cond) { __builtin_amdgcn_s_sleep(1); \
    if ((++_sp & 255u) == 0u) { if (xb_ld(&(bar)[XB_TMO])) break; if (_sp > XB_SPIN_CAP) { atomicAdd(&(bar)[XB_TMO], 1u); break; } } } } while (0)
struct XcdBarrier { unsigned* bar; unsigned x; volatile LAS unsigned* st; unsigned G; };
DI XcdBarrier xcd_barrier_post(unsigned* bar, volatile LAS unsigned* st, const unsigned G) {
    XcdBarrier b; b.bar = bar; b.x = xb_xcc_id(); b.st = st; b.G = G;
    if (tidx() == 0) (void)xb_add(&bar[XB_XCNT(b.x)], 1u);
    return b;
}
DI void xcd_barrier_complete(unsigned* bar, unsigned x, unsigned& nloc, unsigned& nx, const unsigned G) {
    unsigned sum, cnt, mine, sp = 0u;
    for (;;) {
        sum = 0u; cnt = 0u; mine = 0u;
#pragma unroll
        for (unsigned j = 0; j < 16; ++j) { const unsigned c = xb_ld(&bar[XB_XCNT(j)]); sum += c; cnt += (c > 0u) ? 1u : 0u; mine = (j == x) ? c : mine; }
        if (sum == G) break;
        __builtin_amdgcn_s_sleep(1);
        if ((++sp & 255u) == 0u) { if (xb_ld(&bar[XB_TMO])) break; if (sp > XB_SPIN_CAP) { atomicAdd(&bar[XB_TMO], 1u); break; } }
    }
    nloc = mine > 0u ? mine : 1u; nx = cnt > 0u ? cnt : 1u;
}
DI void xcd_barrier(const XcdBarrier& b) {
    asm volatile("s_waitcnt vmcnt(0)" ::: "memory");
    __syncthreads();
    if (tidx() == 0) {
        unsigned* bar = b.bar;
        __builtin_amdgcn_s_waitcnt(0);
        unsigned nloc = b.st[0], nx = b.st[1];
        if (nloc == 0u) { xcd_barrier_complete(bar, b.x, nloc, nx, b.G); b.st[0] = nloc; b.st[1] = nx; }
        const unsigned old = xb_add(&bar[XB_XSUB(b.x)], 1u);
        const unsigned gen = old / nloc;
        if (old + 1u == (gen + 1u) * nloc) {
            __builtin_amdgcn_fence(__ATOMIC_RELEASE, "agent");
            asm volatile("s_waitcnt vmcnt(0)" ::: "memory");
            const unsigned og = xb_add(&bar[XB_TOP], 1u);
            const unsigned tg = og / nx;
            if (og + 1u == (tg + 1u) * nx) xb_add(&bar[XB_TOPGEN], 1u);
            else XB_SPIN(xb_ld(&bar[XB_TOPGEN]) == tg, bar);
            __builtin_amdgcn_fence(__ATOMIC_ACQUIRE, "agent");
            xb_add(&bar[XB_XGEN(b.x)], 1u);
            asm volatile("s_waitcnt vmcnt(0)" ::: "memory");
        } else {
            XB_SPIN(xb_ld(&bar[XB_XGEN(b.x)]) == gen, bar);
            __builtin_amdgcn_fence(__ATOMIC_ACQUIRE, "agent");
            asm volatile("s_waitcnt vmcnt(0)" ::: "memory");
        }
    }
    __syncthreads();
}

DI void phase4_fused(const P& p, char* smem, const XcdBarrier& xb2) {
    const int tid = tidx();
    if (blockIdx.x < 128) {
        scan_unit(p, blockIdx.x, smem);
        if (tid == 0) {
            unsigned sp = 0u;
            while (xb_ld(p.counter + 4) == 0u) { __builtin_amdgcn_s_sleep(8); if (++sp > (1u << 22)) break; }
            __builtin_amdgcn_fence(__ATOMIC_ACQUIRE, "agent");
            asm volatile("s_waitcnt vmcnt(0)" ::: "memory");
        }
        __syncthreads();
    } else {
        const int lb = blockIdx.x - 128;
        for (int it = lb; it < 2560; it += 384) {
            const int mt = it / 10, nt = 15 + (it - mt * 10);
            gemm_tile<8>(AFPlain{p.A, 1024}, p.WinT + (size_t)nt * 128 * 1024, 1024, mt * 128, nt * 128, EpiProj{p.proj}, smem);
        }
        xcd_barrier(xb2);
        for (int it = lb; it < 640; it += 384) { if (it < 128) cmp1_item(p, it, smem); else rope_item(p, it - 128, smem); }
        xcd_barrier(xb2);
        for (int it = lb; it < 64; it += 384) cmp2_item(p, it, smem);
        xcd_barrier(xb2);
        if (lb == 0 && tid == 0) __hip_atomic_store(p.counter + 4, 1u, __ATOMIC_RELEASE, __HIP_MEMORY_SCOPE_AGENT);
    }
    AttnSmem& sm = *(AttnSmem*)smem;
    while (true) {
        __syncthreads();
        if (tidx() == 0) sm.unit = (int)atomicAdd(p.counter, 1u);
        __syncthreads();
        const int u = sm.unit;
        if (u >= 2048) break;
        attn_unit(p, u, smem);
    }
}

__global__ void __launch_bounds__(NTHR, 2) mega_kernel(P p) {
    __shared__ __attribute__((aligned(16))) char smem[SMEM_BYTES];
    __shared__ uint4 xb_words;
    __shared__ uint4 xb_words2;
    cg::grid_group grid = cg::this_grid();
    if (p.x == nullptr) grid.sync();
    if (tidx() == 0) { xb_words = make_uint4(0u, 0u, 0u, 0u); xb_words2 = make_uint4(0u, 0u, 0u, 0u); }
    __syncthreads();
    const XcdBarrier xb = xcd_barrier_post(p.bar, (volatile LAS unsigned*)&xb_words, gridDim.x);
    run_phase(p, 0, smem); xcd_barrier(xb);
    if (gridDim.x == 512) {
        XcdBarrier xb2; xb2.bar = p.bar + XCD_BAR_WORDS; xb2.x = xb.x; xb2.st = (volatile LAS unsigned*)&xb_words2; xb2.G = 384u;
        if (blockIdx.x >= 128 && tidx() == 0) (void)xb_add(&xb2.bar[XB_XCNT(xb2.x)], 1u);
        for (int rd = 0;; ++rd) {
            int mt, nt; if (!gemm_order(rd, 15, mt, nt)) break;
            gemm_tile<8>(AFPlain{p.A, 1024}, p.WinT + (size_t)nt * 128 * 1024, 1024, mt * 128, nt * 128, EpiProj{p.proj}, smem);
        }
        xcd_barrier(xb);
        for (int it = blockIdx.x; it < 1024; it += gridDim.x) rwkv_prep(p, it, smem);
        xcd_barrier(xb);
        phase4_fused(p, smem, xb2);
        xcd_barrier(xb);
    } else {
        run_phase(p, 1, smem); xcd_barrier(xb);
        run_phase(p, 2, smem); xcd_barrier(xb);
        run_phase(p, 3, smem); xcd_barrier(xb);
        run_phase(p, 4, smem); xcd_barrier(xb);
    }
    run_phase(p, 5, smem); xcd_barrier(xb);
    run_phase(p, 6, smem); xcd_barrier(xb);
    run_phase(p, 7, smem); xcd_barrier(xb);
    run_phase(p, 8, smem); xcd_barrier(xb);
    run_phase(p, 9, smem); xcd_barrier(xb);
    run_phase(p, 10, smem);
}
__global__ void __launch_bounds__(NTHR, 2) phase_kernel(P p, int ph) {
    __shared__ __attribute__((aligned(16))) char smem[SMEM_BYTES];
    run_phase(p, ph, smem);
}

extern "C" void kernel_launch(void* const* d_in, const int* in_sizes, int n_in, void* d_out, int out_size, void* d_ws, size_t ws_size,
                              hipStream_t stream) {
    P p{};
    p.x = (const float*)d_in[0]; p.pos = (const int*)d_in[1]; p.norm_mix = (const float*)d_in[2]; p.w_in = (const float*)d_in[3];
    p.mu = (const float*)d_in[4]; p.w0 = (const float*)d_in[5]; p.w2 = (const float*)d_in[6]; p.a0 = (const float*)d_in[7];
    p.a2 = (const float*)d_in[8]; p.g2 = (const float*)d_in[9]; p.k_k = (const float*)d_in[10]; p.k_a = (const float*)d_in[11];
    p.r_k = (const float*)d_in[12]; p.lnx_w = (const float*)d_in[13]; p.lnx_b = (const float*)d_in[14]; p.pe_k = (const float*)d_in[15];
    p.wk1 = (const float*)d_in[16]; p.bk1 = (const float*)d_in[17]; p.wk2 = (const float*)d_in[18]; p.pe_v = (const float*)d_in[19];
    p.wv1 = (const float*)d_in[20]; p.bv1 = (const float*)d_in[21]; p.wv2 = (const float*)d_in[22]; p.w_out = (const float*)d_in[23];
    p.norm_ffn = (const float*)d_in[24]; p.w_gate = (const float*)d_in[25]; p.w_up = (const float*)d_in[26]; p.w_down = (const float*)d_in[27];
    p.norm_final = (const float*)d_in[28];
    p.out = (float*)d_out;
    char* ws = (char*)d_ws;
    size_t off = 0;
    auto take = [&](size_t bytes) { char* r = ws + off; off += (bytes + 255) & ~(size_t)255; return r; };
    p.WinT = (bf16_t*)take((size_t)3200 * 1024 * 2);
    p.WoutT = (bf16_t*)take((size_t)1024 * 1024 * 2);
    p.WguT = (bf16_t*)take((size_t)5632 * 1024 * 2);
    p.WdnT = (bf16_t*)take((size_t)1024 * DFF * 2);
    p.w2T = (bf16_t*)take(512 * 64 * 2);
    p.a2T = (bf16_t*)take(512 * 64 * 2);
    p.g2T = (bf16_t*)take(512 * 160 * 2);
    p.w1T = (bf16_t*)take((size_t)2 * 256 * 2048 * 2);
    p.wc2T = (bf16_t*)take(2 * 128 * 256 * 2);
    p.b1p = (float*)take(512 * 4);
    p.cosT = (float*)take((size_t)T_ * 8 * 4);
    p.sinT = (float*)take((size_t)T_ * 8 * 4);
    p.counter = (unsigned*)take(256);
    p.bar = (unsigned*)take(2 * XCD_BAR_WORDS * 4);
    off = (size_t)32 << 20;
    p.A = (bf16_t*)take((size_t)T_ * 1024 * 2);
    p.proj = (bf16_t*)take((size_t)T_ * PLD * 2);
    p.stream = (bf16_t*)take((size_t)T_ * 8 * 384 * 2);
    p.ksw = (bf16_t*)take((size_t)4 * 256 * 4096 * 2);
    p.vsw = (bf16_t*)take((size_t)4 * 256 * 4096 * 2);
    if (off > ws_size) fprintf(stderr, "workspace too small: need %zu have %zu\n", off, ws_size);
    char* ob = (char*)d_out;
    p.gbuf = (bf16_t*)ob;
    p.yraw = (float*)(ob + ((size_t)32 << 20));
    p.vT = (bf16_t*)(ob + ((size_t)96 << 20));
    p.hid = (bf16_t*)(ob + ((size_t)112 << 20));
    p.kc = (bf16_t*)(ob + ((size_t)116 << 20));
    p.vcT = (bf16_t*)(ob + ((size_t)116 << 20) + (512 << 10));
#if MK_SINGLE
    static int grid_blocks = 0;
    if (!grid_blocks) {
        int dev = 0, cus = 0, per_cu = 0;
        hipGetDevice(&dev);
        hipDeviceGetAttribute(&cus, hipDeviceAttributeMultiprocessorCount, dev);
        hipOccupancyMaxActiveBlocksPerMultiprocessor(&per_cu, mega_kernel, NTHR, 0);
        if (per_cu > 2) per_cu = 2;
        if (per_cu < 1) per_cu = 1;
        grid_blocks = cus * per_cu;
    }
    (void)hipMemsetAsync(p.bar, 0, 2 * XCD_BAR_WORDS * 4, stream);
    void* args[] = {&p};
    hipError_t e = hipLaunchCooperativeKernel((void*)mega_kernel, dim3(grid_blocks), dim3(NTHR), args, 0, stream);
    if (e != hipSuccess) fprintf(stderr, "cooperative launch failed: %s (grid %d)\n", hipGetErrorString(e), grid_blocks);
#else
    for (int ph = 0; ph < NPHASE; ++ph) phase_kernel<<<512, NTHR, 0, stream>>>(p, ph);
#endif
}
```

```cpp
#include <hip/hip_runtime.h>
#include <hip/hip_cooperative_groups.h>
#include <cstdio>
namespace cg = cooperative_groups;

#ifndef MK_SINGLE
#define MK_SINGLE 1
#endif

#define DI __device__ __forceinline__
typedef unsigned short bf16_t;
typedef short bf16x8 __attribute__((ext_vector_type(8)));
typedef float f32x16 __attribute__((ext_vector_type(16)));
typedef __bf16 bf2_t __attribute__((ext_vector_type(2)));
typedef float f2_t __attribute__((ext_vector_type(2)));

constexpr int T_ = 32768, S_ = 16384;
constexpr int PLD = 3200;
constexpr int QC = 1856, KVC = 2368, GC = 3136;
constexpr int DFF = 2816;
constexpr int NTHR = 256;
constexpr float QSC = 0.125f * 1.4426950408889634f;

#define MFMA32(a, b, c) __builtin_amdgcn_mfma_f32_32x32x16_bf16((a), (b), (c), 0, 0, 0)

DI int tidx() { int r; asm volatile("v_mov_b32 %0, %1" : "=v"(r) : "v"(threadIdx.x)); return r; }
DI unsigned pack2(float a, float b) { f2_t v = {a, b}; return __builtin_bit_cast(unsigned, __builtin_convertvector(v, bf2_t)); }
DI float bflo(unsigned u) { return __uint_as_float(u << 16); }
DI float bfhi(unsigned u) { return __uint_as_float(u & 0xffff0000u); }
DI bf16_t f2bf(float a) { return (bf16_t)(pack2(a, 0.f) & 0xffffu); }
DI void unpack8(const uint4& u, float (&f)[8]) {
    f[0] = bflo(u.x); f[1] = bfhi(u.x); f[2] = bflo(u.y); f[3] = bfhi(u.y);
    f[4] = bflo(u.z); f[5] = bfhi(u.z); f[6] = bflo(u.w); f[7] = bfhi(u.w);
}
DI uint4 pack8(const float (&f)[8]) { uint4 u; u.x = pack2(f[0], f[1]); u.y = pack2(f[2], f[3]); u.z = pack2(f[4], f[5]); u.w = pack2(f[6], f[7]); return u; }
DI float wave_sum(float v) {
#pragma unroll
    for (int o = 32; o; o >>= 1) v += __shfl_xor(v, o);
    return v;
}
DI float sigmoidf_(float x) { return 1.f / (1.f + __expf(-x)); }
DI int crow(int reg, int h) { return (reg & 3) + 8 * (reg >> 2) + 4 * h; }

struct P {
    const float* x; const int* pos; const float *norm_mix, *w_in, *mu, *w0, *w2, *a0, *a2, *g2, *k_k, *k_a, *r_k, *lnx_w, *lnx_b,
        *pe_k, *wk1, *bk1, *wk2, *pe_v, *wv1, *bv1, *wv2, *w_out, *norm_ffn, *w_gate, *w_up, *w_down, *norm_final;
    float* out;
    bf16_t *WinT, *WoutT, *WguT, *WdnT, *w2T, *a2T, *g2T, *w1T, *wc2T;
    float *b1p, *cosT, *sinT;
    unsigned* counter; unsigned* bar;
    bf16_t *A, *proj, *stream;
    bf16_t* gbuf; float* yraw; bf16_t *vT, *hid, *kc, *vcT, *ksw, *vsw;
};

DI float tr_val(const P& p, int job, int k, int n) {
    switch (job) {
    case 0: { int c = n < 1824 ? n : ((n >= 1856 && n < 3160) ? n - 32 : -1); return c >= 0 ? p.w_in[(size_t)k * 3128 + c] : 0.f; }
    case 1: return p.w_out[k * 1024 + n];
    case 2: { int q = n >> 6, r = n & 63; return r < 32 ? p.w_gate[(size_t)k * DFF + q * 32 + r] : p.w_up[(size_t)k * DFF + q * 32 + r - 32]; }
    case 3: return p.w_down[(size_t)k * 1024 + n];
    case 4: return p.w2[k * 512 + n];
    case 5: return p.a2[k * 512 + n];
    case 6: return p.g2[k * 512 + n];
    case 7: return p.wk1[k * 256 + n];
    case 8: return p.wv1[k * 256 + n];
    case 9: return n < 64 ? p.wk2[k * 64 + n] : 0.f;
    default: return n < 64 ? p.wv2[k * 64 + n] : 0.f;
    }
}
DI void tr_item(const P& p, int it, float* tile) {
    int job, K, N; bf16_t* dst;
    if (it < 800) { job = 0; K = 1024; N = 3200; dst = p.WinT; }
    else if (it < 1056) { job = 1; it -= 800; K = 1024; N = 1024; dst = p.WoutT; }
    else if (it < 2464) { job = 2; it -= 1056; K = 1024; N = 5632; dst = p.WguT; }
    else if (it < 3168) { job = 3; it -= 2464; K = 2816; N = 1024; dst = p.WdnT; }
    else if (it < 3176) { job = 4; it -= 3168; K = 64; N = 512; dst = p.w2T; }
    else if (it < 3184) { job = 5; it -= 3176; K = 64; N = 512; dst = p.a2T; }
    else if (it < 3208) { job = 6; it -= 3184; K = 160; N = 512; dst = p.g2T; }
    else if (it < 3336) { job = 7; it -= 3208; K = 2048; N = 256; dst = p.w1T; }
    else if (it < 3464) { job = 8; it -= 3336; K = 2048; N = 256; dst = p.w1T + 256 * 2048; }
    else if (it < 3472) { job = 9; it -= 3464; K = 256; N = 128; dst = p.wc2T; }
    else { job = 10; it -= 3472; K = 256; N = 128; dst = p.wc2T + 128 * 256; }
    const int nt = N >> 6;
    const int k0 = (it / nt) * 64, n0 = (it % nt) * 64;
    const int tid = tidx();
    __syncthreads();
#pragma unroll 4
    for (int i = 0; i < 16; ++i) {
        const int kk = i * 4 + (tid >> 6), nn = tid & 63;
        tile[kk * 65 + nn] = (k0 + kk < K) ? tr_val(p, job, k0 + kk, n0 + nn) : 0.f;
    }
    __syncthreads();
#pragma unroll 4
    for (int i = 0; i < 16; ++i) {
        const int nn = i * 4 + (tid >> 6), kk = tid & 63;
        if (k0 + kk < K) dst[(size_t)(n0 + nn) * K + k0 + kk] = f2bf(tile[kk * 65 + nn]);
    }
}
DI void b1_item(const P& p, int idx) {
    const int kv = idx >> 4, jc = idx & 15, tid = tidx();
    const float* pe = kv ? p.pe_v : p.pe_k; const float* w1 = kv ? p.wv1 : p.wk1; const float* b1 = kv ? p.bv1 : p.bk1;
    const int j = jc * 16 + (tid >> 4), kl = tid & 15;
    float s = 0.f;
    for (int i = 0; i < 128; ++i) { const int k = kl + 16 * i; s += pe[k] * w1[k * 256 + j]; }
    s += __shfl_xor(s, 1); s += __shfl_xor(s, 2); s += __shfl_xor(s, 4); s += __shfl_xor(s, 8);
    if (kl == 0) p.b1p[kv * 256 + j] = b1[j] + s;
}
DI void sincos_d(float ang, float& c, float& s) {
    double x = (double)ang;
    const double TWO_PI = 6.283185307179586476925286766559;
    double n = __builtin_rint(x * (1.0 / TWO_PI));
    double r = x - n * TWO_PI;
    double q = r * 0.25;
    double q2 = q * q;
    double sn = q * (1.0 + q2 * (-1.0 / 6 + q2 * (1.0 / 120 + q2 * (-1.0 / 5040 + q2 * (1.0 / 362880 + q2 * (-1.0 / 39916800 + q2 * (1.0 / 6227020800.0)))))));
    double cs = 1.0 + q2 * (-0.5 + q2 * (1.0 / 24 + q2 * (-1.0 / 720 + q2 * (1.0 / 40320 + q2 * (-1.0 / 3628800 + q2 * (1.0 / 479001600.0))))));
    double s2 = 2 * sn * cs, c2 = 1 - 2 * sn * sn;
    double s4 = 2 * s2 * c2, c4 = 1 - 2 * s2 * s2;
    c = (float)c4; s = (float)s4;
}
DI void cs_item(const P& p, int idx) {
    const int e = idx * 256 + tidx(), tok = e >> 3, f = e & 7;
    const float invf[8] = {1.000000000e+00f, 1.939227432e-01f, 3.760603070e-02f, 7.292664610e-03f, 1.414213562e-03f, 2.742481884e-04f, 5.318295734e-05f, 1.031338525e-05f};
    float iv = invf[0];
#pragma unroll
    for (int i = 1; i < 8; ++i) iv = (f == i) ? invf[i] : iv;
    const float ang = (float)p.pos[tok] * iv;
    float c, s; sincos_d(ang, c, s);
    p.cosT[e] = c; p.sinT[e] = s;
}
DI void rms_item(const float* src, const float* g, bf16_t* dst, int idx) {
    const int row = idx * 4 + (tidx() >> 6), lane = tidx() & 63;
    const float4* sp = (const float4*)(src + (size_t)row * 1024);
    float4 v[4]; float ss = 0.f;
#pragma unroll
    for (int i = 0; i < 4; ++i) { v[i] = sp[lane + 64 * i]; ss += v[i].x * v[i].x + v[i].y * v[i].y + v[i].z * v[i].z + v[i].w * v[i].w; }
    ss = wave_sum(ss);
    const float rs = rsqrtf(ss * (1.f / 1024.f) + 1e-6f);
#pragma unroll
    for (int i = 0; i < 4; ++i) {
        const float4 gv = ((const float4*)g)[lane + 64 * i];
        uint2 o; o.x = pack2(v[i].x * rs * gv.x, v[i].y * rs * gv.y); o.y = pack2(v[i].z * rs * gv.z, v[i].w * rs * gv.w);
        *(uint2*)(dst + (size_t)row * 1024 + (lane + 64 * i) * 4) = o;
    }
}
DI void phase0(const P& p, char* smem) {
    if (blockIdx.x == 0 && tidx() < 8) p.counter[tidx()] = 0u;
    constexpr int NTR = 3480, NB1 = 32, NCS = 1024, NXN = 8192;
    for (int it = blockIdx.x; it < NTR + NB1 + NCS + NXN; it += gridDim.x) {
        if (it < NTR) { if (gridDim.x != 512 || it < 800 || it >= 3168) tr_item(p, it, (float*)smem); }
        else if (it < NTR + NB1) b1_item(p, it - NTR);
        else if (it < NTR + NB1 + NCS) cs_item(p, it - NTR - NB1);
        else rms_item(p.x, p.norm_mix, p.A, it - NTR - NB1 - NCS);
    }
}

struct AFPlain { const bf16_t* A; int lda; DI uint4 load(int row, int k) const { return *(const uint4*)(A + (size_t)row * lda + k); } };
struct AFCmp {
    const bf16_t* base;
    DI uint4 load(int r, int k) const { int tok = 16 * r + (k >> 6); tok = tok < S_ ? tok : S_ - 1; return *(const uint4*)(base + (size_t)tok * PLD + (k & 63)); }
};

template <int KU, class AF, class EPI>
DI void gemm_tile(const AF af, const bf16_t* __restrict__ Bt, const int K, const int m0, const int n0, const EPI epi, char* smem) {
    const int tid = tidx(), wave = tid >> 6, lane = tid & 63, wm = wave >> 1, wn = wave & 1, rr = lane & 31, hh = lane >> 5;
    f32x16 acc[2][2];
#pragma unroll
    for (int a = 0; a < 2; ++a)
#pragma unroll
        for (int b = 0; b < 2; ++b)
#pragma unroll
            for (int i = 0; i < 16; ++i) acc[a][b][i] = 0.f;
    const int lrow = tid >> 3, lk = (tid & 7) * 8;
#define GLOAD(R, KO) \
    R##a0 = af.load(m0 + lrow, (KO) + lk); R##a1 = af.load(m0 + lrow + 32, (KO) + lk); R##a2 = af.load(m0 + lrow + 64, (KO) + lk); R##a3 = af.load(m0 + lrow + 96, (KO) + lk); \
    R##b0 = *(const uint4*)(Bt + (size_t)(lrow) * K + (KO) + lk); R##b1 = *(const uint4*)(Bt + (size_t)(lrow + 32) * K + (KO) + lk); \
    R##b2 = *(const uint4*)(Bt + (size_t)(lrow + 64) * K + (KO) + lk); R##b3 = *(const uint4*)(Bt + (size_t)(lrow + 96) * K + (KO) + lk);
#define GSTORE(R, SA, SB) \
    *(uint4*)&(SA)[(lrow) * 72 + lk] = R##a0; *(uint4*)&(SA)[(lrow + 32) * 72 + lk] = R##a1; *(uint4*)&(SA)[(lrow + 64) * 72 + lk] = R##a2; *(uint4*)&(SA)[(lrow + 96) * 72 + lk] = R##a3; \
    *(uint4*)&(SB)[(lrow) * 72 + lk] = R##b0; *(uint4*)&(SB)[(lrow + 32) * 72 + lk] = R##b1; *(uint4*)&(SB)[(lrow + 64) * 72 + lk] = R##b2; *(uint4*)&(SB)[(lrow + 96) * 72 + lk] = R##b3;
#define GCOMPUTE(SA, SB) \
    _Pragma("unroll") for (int ks = 0; ks < 4; ++ks) { \
        bf16x8 tf0 = *(const bf16x8*)&(SA)[(wm * 64 + rr) * 72 + ks * 16 + hh * 8], tf1 = *(const bf16x8*)&(SA)[(wm * 64 + 32 + rr) * 72 + ks * 16 + hh * 8]; \
        bf16x8 wf0 = *(const bf16x8*)&(SB)[(wn * 64 + rr) * 72 + ks * 16 + hh * 8], wf1 = *(const bf16x8*)&(SB)[(wn * 64 + 32 + rr) * 72 + ks * 16 + hh * 8]; \
        acc[0][0] = MFMA32(wf0, tf0, acc[0][0]); acc[0][1] = MFMA32(wf0, tf1, acc[0][1]); acc[1][0] = MFMA32(wf1, tf0, acc[1][0]); acc[1][1] = MFMA32(wf1, tf1, acc[1][1]); }
    uint4 Xa0, Xa1, Xa2, Xa3, Xb0, Xb1, Xb2, Xb3, Ya0, Ya1, Ya2, Ya3, Yb0, Yb1, Yb2, Yb3;
    bf16_t* const sA0 = (bf16_t*)smem; bf16_t* const sB0 = sA0 + 128 * 72; bf16_t* const sA1 = sB0 + 128 * 72; bf16_t* const sB1 = sA1 + 128 * 72;
    GLOAD(X, 0)
    GLOAD(Y, 64)
    __syncthreads();
    GSTORE(X, sA0, sB0)
    __syncthreads();
#pragma unroll KU
    for (int k0 = 0; k0 < K; k0 += 128) {
        const bool more = (k0 + 128 < K);
        if (more) { GLOAD(X, k0 + 128) }
        GCOMPUTE(sA0, sB0)
        GSTORE(Y, sA1, sB1)
        __syncthreads();
        __builtin_amdgcn_sched_barrier(0);
        if (more) { GLOAD(Y, k0 + 192) }
        GCOMPUTE(sA1, sB1)
        if (more) { GSTORE(X, sA0, sB0) }
        __syncthreads();
        __builtin_amdgcn_sched_barrier(0);
    }
#undef GLOAD
#undef GSTORE
#undef GCOMPUTE
    epi(acc, m0 + wm * 64, n0 + wn * 64, lane);
}

struct EpiProj {
    bf16_t* C;
    DI void operator()(const f32x16 (&acc)[2][2], int rowbase, int colbase, int lane) const {
        const int rr = lane & 31, hh = lane >> 5;
#pragma unroll
        for (int w = 0; w < 2; ++w)
#pragma unroll
            for (int t = 0; t < 2; ++t)
#pragma unroll
                for (int j = 0; j < 4; ++j) {
                    uint2 o; o.x = pack2(acc[w][t][4 * j], acc[w][t][4 * j + 1]); o.y = pack2(acc[w][t][4 * j + 2], acc[w][t][4 * j + 3]);
                    *(uint2*)(C + (size_t)(rowbase + t * 32 + rr) * PLD + colbase + w * 32 + j * 8 + hh * 4) = o;
                }
    }
};
struct EpiHid {
    bf16_t* H; const float* bias;
    DI void operator()(const f32x16 (&acc)[2][2], int rowbase, int colbase, int lane) const {
        const int rr = lane & 31, hh = lane >> 5;
#pragma unroll
        for (int w = 0; w < 2; ++w)
#pragma unroll
            for (int t = 0; t < 2; ++t)
#pragma unroll
                for (int j = 0; j < 4; ++j) {
                    const int col = colbase + w * 32 + j * 8 + hh * 4;
                    const float4 bv = *(const float4*)(bias + col);
                    float v0 = acc[w][t][4 * j] + bv.x, v1 = acc[w][t][4 * j + 1] + bv.y, v2 = acc[w][t][4 * j + 2] + bv.z, v3 = acc[w][t][4 * j + 3] + bv.w;
                    v0 *= sigmoidf_(v0); v1 *= sigmoidf_(v1); v2 *= sigmoidf_(v2); v3 *= sigmoidf_(v3);
                    uint2 o; o.x = pack2(v0, v1); o.y = pack2(v2, v3);
                    *(uint2*)(H + (size_t)(rowbase + t * 32 + rr) * 256 + col) = o;
                }
    }
};
struct EpiKc {
    bf16_t* kc; const float *cosT, *sinT; int tokbase;
    DI void operator()(const f32x16 (&acc)[2][2], int rowbase, int colbase, int lane) const {
        if (colbase != 0) return;
        const int rr = lane & 31, hh = lane >> 5;
#pragma unroll
        for (int t = 0; t < 2; ++t) {
            const int r = rowbase + t * 32 + rr;
            int tk = 31 + 16 * r; tk = tk < S_ ? tk : S_ - 1;
            const float4 c = *(const float4*)(cosT + (size_t)(tokbase + tk) * 8 + hh * 4), s = *(const float4*)(sinT + (size_t)(tokbase + tk) * 8 + hh * 4);
            bf16_t* kp = kc + (size_t)r * 64 + hh * 4;
            const float a0 = acc[0][t][0], a1 = acc[0][t][1], a2 = acc[0][t][2], a3 = acc[0][t][3];
            const float b0 = acc[0][t][4], b1 = acc[0][t][5], b2 = acc[0][t][6], b3 = acc[0][t][7];
            uint2 o;
            o.x = pack2(a0 * c.x - b0 * s.x, a1 * c.y - b1 * s.y); o.y = pack2(a2 * c.z - b2 * s.z, a3 * c.w - b3 * s.w);
            *(uint2*)(kp) = o;
            o.x = pack2(b0 * c.x + a0 * s.x, b1 * c.y + a1 * s.y); o.y = pack2(b2 * c.z + a2 * s.z, b3 * c.w + a3 * s.w);
            *(uint2*)(kp + 8) = o;
#pragma unroll
            for (int j = 2; j < 4; ++j) {
                o.x = pack2(acc[0][t][4 * j], acc[0][t][4 * j + 1]); o.y = pack2(acc[0][t][4 * j + 2], acc[0][t][4 * j + 3]);
                *(uint2*)(kp + j * 8) = o;
            }
#pragma unroll
            for (int j = 0; j < 4; ++j) {
                o.x = pack2(acc[1][t][4 * j], acc[1][t][4 * j + 1]); o.y = pack2(acc[1][t][4 * j + 2], acc[1][t][4 * j + 3]);
                *(uint2*)(kp + 32 + j * 8) = o;
            }
        }
    }
};
struct EpiVc {
    bf16_t* vcT; char* smem;
    DI void operator()(const f32x16 (&acc)[2][2], int rowbase, int colbase, int lane) const {
        const int rr = lane & 31, hh = lane >> 5;
        bf16_t* tl = (bf16_t*)smem;
        __syncthreads();
        if (colbase == 0) {
            const int rl = rowbase & 127;
#pragma unroll
            for (int w = 0; w < 2; ++w)
#pragma unroll
                for (int t = 0; t < 2; ++t)
#pragma unroll
                    for (int i = 0; i < 16; ++i) tl[(w * 32 + crow(i, hh)) * 136 + rl + t * 32 + rr] = f2bf(acc[w][t][i]);
        }
        __syncthreads();
        const int m0 = rowbase & ~127;
#pragma unroll
        for (int i = 0; i < 4; ++i) {
            const int c = tidx() + i * 256, d = c >> 4, ch = c & 15;
            *(uint4*)(vcT + (size_t)d * 1024 + m0 + ch * 8) = *(const uint4*)&tl[d * 136 + ch * 8];
        }
    }
};
struct EpiOut {
    float* out; const float* x;
    DI void operator()(const f32x16 (&acc)[2][2], int rowbase, int colbase, int lane) const {
        const int rr = lane & 31, hh = lane >> 5;
#pragma unroll
        for (int w = 0; w < 2; ++w)
#pragma unroll
            for (int t = 0; t < 2; ++t)
#pragma unroll
                for (int j = 0; j < 4; ++j) {
                    const size_t o = (size_t)(rowbase + t * 32 + rr) * 1024 + colbase + w * 32 + j * 8 + hh * 4;
                    float4 xv = *(const float4*)(x + o);
                    xv.x += acc[w][t][4 * j]; xv.y += acc[w][t][4 * j + 1]; xv.z += acc[w][t][4 * j + 2]; xv.w += acc[w][t][4 * j + 3];
                    *(float4*)(out + o) = xv;
                }
    }
};
struct EpiFfn1 {
    bf16_t* act;
    DI void operator()(const f32x16 (&acc)[2][2], int rowbase, int colbase, int lane) const {
        const int rr = lane & 31, hh = lane >> 5;
        const int cb = (colbase >> 6) * 32;
#pragma unroll
        for (int t = 0; t < 2; ++t)
#pragma unroll
            for (int j = 0; j < 4; ++j) {
                float v[4];
#pragma unroll
                for (int i = 0; i < 4; ++i) { const float g = acc[0][t][4 * j + i], u = acc[1][t][4 * j + i]; v[i] = g * sigmoidf_(g) * u; }
                uint2 o; o.x = pack2(v[0], v[1]); o.y = pack2(v[2], v[3]);
                *(uint2*)(act + (size_t)(rowbase + t * 32 + rr) * DFF + cb + j * 8 + hh * 4) = o;
            }
    }
};

DI void rwkv_prep(const P& p, int idx, char* smem) {
    const int tile = idx, tt0 = tile * 32;
    const int tid = tidx(), wave = tid >> 6, lane = tid & 63, rr = lane & 31, hh = lane >> 5;
    bf16_t* lat = (bf16_t*)smem;
    float* res = (float*)(smem + 32 * 296 * 2);
    __syncthreads();
    for (int c = tid; c < 32 * 36; c += NTHR) {
        const int tok = c / 36, ch = c - tok * 36, gi = tt0 + tok, col = 1536 + ch * 8;
        const uint4 cu = *(const uint4*)(p.proj + (size_t)gi * PLD + col);
        uint4 pv = make_uint4(0, 0, 0, 0);
        if ((gi & (S_ - 1)) != 0) pv = *(const uint4*)(p.proj + (size_t)(gi - 1) * PLD + col);
        float a[8], b[8]; unpack8(cu, a); unpack8(pv, b);
        const float4 m0 = *(const float4*)(p.mu + col), m1 = *(const float4*)(p.mu + col + 4);
        const float mu[8] = {m0.x, m0.y, m0.z, m0.w, m1.x, m1.y, m1.z, m1.w};
#pragma unroll
        for (int e = 0; e < 8; ++e) {
            float x = a[e] + (b[e] - a[e]) * mu[e];
            if (ch < 8) x = 1.f - 2.f / (1.f + __expf(2.f * x)); else if (ch >= 16) x = sigmoidf_(x);
            a[e] = x;
        }
        *(uint4*)&lat[tok * 296 + ch * 8] = pack8(a);
    }
    __syncthreads();
#pragma unroll 1
    for (int h = 0; h < 8; ++h) {
    if (wave < 2) {
        const int mt = wave;
        f32x16 aw, aa;
#pragma unroll
        for (int i = 0; i < 16; ++i) { aw[i] = 0.f; aa[i] = 0.f; }
#pragma unroll
        for (int ks = 0; ks < 4; ++ks) {
            const bf16x8 wf = *(const bf16x8*)(p.w2T + (size_t)(h * 64 + mt * 32 + rr) * 64 + ks * 16 + hh * 8);
            const bf16x8 af = *(const bf16x8*)(p.a2T + (size_t)(h * 64 + mt * 32 + rr) * 64 + ks * 16 + hh * 8);
            const bf16x8 l0 = *(const bf16x8*)&lat[rr * 296 + ks * 16 + hh * 8];
            const bf16x8 l1 = *(const bf16x8*)&lat[rr * 296 + 64 + ks * 16 + hh * 8];
            aw = MFMA32(wf, l0, aw); aa = MFMA32(af, l1, aa);
        }
#pragma unroll
        for (int j = 0; j < 4; ++j) {
            *(float4*)&res[(0 * 32 + rr) * 64 + mt * 32 + j * 8 + hh * 4] = make_float4(aw[4 * j], aw[4 * j + 1], aw[4 * j + 2], aw[4 * j + 3]);
            *(float4*)&res[(1 * 32 + rr) * 64 + mt * 32 + j * 8 + hh * 4] = make_float4(aa[4 * j], aa[4 * j + 1], aa[4 * j + 2], aa[4 * j + 3]);
        }
    } else {
        const int mt = wave - 2;
        f32x16 ag;
#pragma unroll
        for (int i = 0; i < 16; ++i) ag[i] = 0.f;
#pragma unroll
        for (int ks = 0; ks < 10; ++ks) {
            const bf16x8 gf = *(const bf16x8*)(p.g2T + (size_t)(h * 64 + mt * 32 + rr) * 160 + ks * 16 + hh * 8);
            const bf16x8 l2 = *(const bf16x8*)&lat[rr * 296 + 128 + ks * 16 + hh * 8];
            ag = MFMA32(gf, l2, ag);
        }
#pragma unroll
        for (int j = 0; j < 4; ++j)
            *(float4*)&res[(2 * 32 + rr) * 64 + mt * 32 + j * 8 + hh * 4] = make_float4(ag[4 * j], ag[4 * j + 1], ag[4 * j + 2], ag[4 * j + 3]);
    }
    __syncthreads();
    {
        const int tok = tid >> 3, cgp = tid & 7, gi = tt0 + tok, b = gi >> 14, s = gi & (S_ - 1), cb = h * 64 + cgp * 8;
        const bool first = (s == 0);
        float r[8], k[8], v[8];
        {
            float a[8], pb[8];
            const bf16_t* pr = p.proj + (size_t)gi * PLD;
#pragma unroll
            for (int q = 0; q < 3; ++q) {
                const int col = q * 512 + cb;
                unpack8(*(const uint4*)(pr + col), a);
                if (first) {
#pragma unroll
                    for (int e = 0; e < 8; ++e) pb[e] = 0.f;
                } else unpack8(*(const uint4*)(pr - PLD + col), pb);
                const float4 m0 = *(const float4*)(p.mu + col), m1 = *(const float4*)(p.mu + col + 4);
                const float mu[8] = {m0.x, m0.y, m0.z, m0.w, m1.x, m1.y, m1.z, m1.w};
#pragma unroll
                for (int e = 0; e < 8; ++e) {
                    const float x = a[e] + (pb[e] - a[e]) * mu[e];
                    if (q == 0) r[e] = x; else if (q == 1) k[e] = x; else v[e] = x;
                }
            }
        }
        float om[8], av[8], gg[8], kk[8], km[8], bb[8];
        float ss = 0.f;
#pragma unroll
        for (int e = 0; e < 8; ++e) {
            const float wp = res[(0 * 32 + tok) * 64 + cgp * 8 + e] + p.w0[cb + e];
            const float z = -wp;
            const float sp = fmaxf(z, 0.f) + __logf(1.f + __expf(-fabsf(z)));
            const float w = -sp - 0.5f;
            om[e] = 1.f - __expf(-__expf(w));
            av[e] = sigmoidf_(res[(1 * 32 + tok) * 64 + cgp * 8 + e] + p.a0[cb + e]);
            gg[e] = res[(2 * 32 + tok) * 64 + cgp * 8 + e];
            kk[e] = k[e] * p.k_k[cb + e];
            ss += kk[e] * kk[e];
            km[e] = k[e] * (1.f + (av[e] - 1.f) * p.k_a[cb + e]);
        }
        ss += __shfl_xor(ss, 1); ss += __shfl_xor(ss, 2); ss += __shfl_xor(ss, 4);
        const float inv = 1.f / fmaxf(sqrtf(ss), 1e-12f);
#pragma unroll
        for (int e = 0; e < 8; ++e) { kk[e] *= inv; bb[e] = kk[e] * av[e]; }
        bf16_t* sp = p.stream + ((size_t)((b * 8 + h) * S_ + s) * 6) * 64 + cgp * 8;
        *(uint4*)(sp) = pack8(om); *(uint4*)(sp + 64) = pack8(km); *(uint4*)(sp + 128) = pack8(kk);
        *(uint4*)(sp + 192) = pack8(bb); *(uint4*)(sp + 256) = pack8(r); *(uint4*)(sp + 320) = pack8(v);
        *(uint4*)(p.gbuf + (size_t)gi * 512 + cb) = pack8(gg);
    }
    __syncthreads();
    }
}

DI void rope_item(const P& p, int idx, char* smem) {
    const int tt0 = idx * 64, tid = tidx();
    bf16_t* vtile = (bf16_t*)smem;
    bf16_t* ktile = vtile + 4 * 64 * 72;
    __syncthreads();
#pragma unroll 1
    for (int it = 0; it < 2; ++it) {
        const int item = tid + it * 256, tok = item >> 3, head = item & 7, gi = tt0 + tok;
        bf16_t* ptr = p.proj + (size_t)gi * PLD + QC + head * 64;
        const float4 c0 = *(const float4*)(p.cosT + (size_t)gi * 8), c1 = *(const float4*)(p.cosT + (size_t)gi * 8 + 4);
        const float4 s0 = *(const float4*)(p.sinT + (size_t)gi * 8), s1 = *(const float4*)(p.sinT + (size_t)gi * 8 + 4);
        const float cc[8] = {c0.x, c0.y, c0.z, c0.w, c1.x, c1.y, c1.z, c1.w}, sn[8] = {s0.x, s0.y, s0.z, s0.w, s1.x, s1.y, s1.z, s1.w};
        float a[8], b[8];
        unpack8(*(const uint4*)ptr, a); unpack8(*(const uint4*)(ptr + 8), b);
#pragma unroll
        for (int e = 0; e < 8; ++e) { const float x1 = a[e], x2 = b[e]; a[e] = (x1 * cc[e] - x2 * sn[e]) * QSC; b[e] = (x2 * cc[e] + x1 * sn[e]) * QSC; }
        *(uint4*)ptr = pack8(a); *(uint4*)(ptr + 8) = pack8(b);
#pragma unroll
        for (int q = 2; q < 8; ++q) {
            unpack8(*(const uint4*)(ptr + q * 8), a);
#pragma unroll
            for (int e = 0; e < 8; ++e) a[e] *= QSC;
            *(uint4*)(ptr + q * 8) = pack8(a);
        }
    }
    {
        const int tok = tid >> 2, sel = (tid >> 1) & 1, hk = tid & 1, gi = tt0 + tok;
        const float4 c0 = *(const float4*)(p.cosT + (size_t)gi * 8), c1 = *(const float4*)(p.cosT + (size_t)gi * 8 + 4);
        const float4 s0 = *(const float4*)(p.sinT + (size_t)gi * 8), s1 = *(const float4*)(p.sinT + (size_t)gi * 8 + 4);
        const float cc[8] = {c0.x, c0.y, c0.z, c0.w, c1.x, c1.y, c1.z, c1.w}, sn[8] = {s0.x, s0.y, s0.z, s0.w, s1.x, s1.y, s1.z, s1.w};
        float a[8], b[8];
        {
            bf16_t* ptr = p.proj + (size_t)gi * PLD + KVC + (sel ? 4 : 2) * 128 + hk * 64;
            unpack8(*(const uint4*)ptr, a); unpack8(*(const uint4*)(ptr + 8), b);
#pragma unroll
            for (int e = 0; e < 8; ++e) { const float x1 = a[e], x2 = b[e]; a[e] = x1 * cc[e] - x2 * sn[e]; b[e] = x2 * cc[e] + x1 * sn[e]; }
            const uint4 ra_ = pack8(a), rb_ = pack8(b);
            *(uint4*)ptr = ra_; *(uint4*)(ptr + 8) = rb_;
            if (sel == 0) {
                bf16_t* kt = ktile + (size_t)(hk * 64 + tok) * 72;
                *(uint4*)kt = ra_; *(uint4*)(kt + 8) = rb_;
#pragma unroll
                for (int q = 2; q < 8; ++q) *(uint4*)(kt + q * 8) = *(const uint4*)(ptr + q * 8);
            }
        }
        {
            const bf16_t* ptr = p.proj + (size_t)gi * PLD + KVC + (sel ? 5 : 3) * 128 + hk * 64;
            bf16_t* vt = vtile + (size_t)((sel * 2 + hk) * 64) * 72 + tok;
            unpack8(*(const uint4*)ptr, a); unpack8(*(const uint4*)(ptr + 8), b);
#pragma unroll
            for (int e = 0; e < 8; ++e) { const float x1 = a[e], x2 = b[e]; a[e] = x1 * cc[e] - x2 * sn[e]; b[e] = x2 * cc[e] + x1 * sn[e]; }
#pragma unroll
            for (int e = 0; e < 8; ++e) { vt[e * 72] = f2bf(a[e]); vt[(8 + e) * 72] = f2bf(b[e]); }
#pragma unroll
            for (int q = 2; q < 8; ++q) {
                const uint4 u = *(const uint4*)(ptr + q * 8);
                const unsigned w[4] = {u.x, u.y, u.z, u.w};
#pragma unroll
                for (int e = 0; e < 4; ++e) { vt[(q * 8 + 2 * e) * 72] = (bf16_t)(w[e] & 0xffffu); vt[(q * 8 + 2 * e + 1) * 72] = (bf16_t)(w[e] >> 16); }
            }
        }
    }
    __syncthreads();
    const int b = tt0 >> 14, s0 = tt0 & (S_ - 1);
#pragma unroll
    for (int i = 0; i < 8; ++i) {
        const int c = tid + i * 256, grp = c >> 9, d = (c >> 3) & 63, ch = c & 7, sel = grp >> 1, hk = grp & 1;
        const uint4 u = *(const uint4*)&vtile[(size_t)(grp * 64 + d) * 72 + ch * 8];
        *(uint4*)(p.vT + ((size_t)((sel * 4 + b * 2 + hk) * 64 + d)) * S_ + s0 + ch * 8) = u;
    }
    const int blk = s0 >> 6;
#pragma unroll
    for (int i = 0; i < 4; ++i) {
        const int c = tid + i * 256, hk = c >> 9, g8 = (c >> 6) & 7, ln = c & 63;
        const size_t dsto = ((size_t)(((b * 2 + hk) * 256 + blk) * 8 + g8) * 64 + ln) * 8;
        const int m16 = ln & 15, g4 = ln >> 4;
        {
            const int kg = g8 >> 1, ks = g8 & 1;
            *(uint4*)(p.ksw + dsto) = *(const uint4*)&ktile[(size_t)(hk * 64 + kg * 16 + m16) * 72 + ks * 32 + g4 * 8];
        }
        {
            const int kk = g8 >> 2, dt = g8 & 3;
            const bf16_t* row = &vtile[(size_t)((0 * 2 + hk) * 64 + dt * 16 + m16) * 72 + kk * 32 + 4 * g4];
            const uint2 lo = *(const uint2*)row, hi = *(const uint2*)(row + 16);
            *(uint4*)(p.vsw + dsto) = make_uint4(lo.x, lo.y, hi.x, hi.y);
        }
    }
}

DI void cmp1_item(const P& p, const int it, char* smem) {
    const int kv = it >> 6, bhk = (it >> 4) & 3, mt = (it >> 1) & 7, nt = it & 1, b = bhk >> 1, hk = bhk & 1;
    AFCmp af{p.proj + (size_t)(b * S_) * PLD + KVC + kv * 128 + hk * 64};
    EpiHid ep{p.hid + (size_t)((kv * 4 + bhk) * 1024) * 256, p.b1p + kv * 256};
    gemm_tile<1>(af, p.w1T + (size_t)(kv * 256 + nt * 128) * 2048, 2048, mt * 128, nt * 128, ep, smem);
}
DI void cmp2_item(const P& p, const int it, char* smem) {
    const int kv = it >> 5, bhk = (it >> 3) & 3, mt = it & 7, b = bhk >> 1;
    AFPlain af{p.hid + (size_t)((kv * 4 + bhk) * 1024) * 256, 256};
    if (kv == 0) { EpiKc ep{p.kc + (size_t)bhk * 1024 * 64, p.cosT, p.sinT, b * S_}; gemm_tile<1>(af, p.wc2T, 256, mt * 128, 0, ep, smem); }
    else { EpiVc ep{p.vcT + (size_t)bhk * 64 * 1024, smem}; gemm_tile<1>(af, p.wc2T + 128 * 256, 256, mt * 128, 0, ep, smem); }
}
DI void phase2(const P& p, char* smem) {
    for (int it = blockIdx.x; it < 128 + 512 + 1024; it += gridDim.x) {
        if (it < 128) cmp1_item(p, it, smem);
        else if (it < 640) rope_item(p, it - 128, smem);
        else rwkv_prep(p, it - 640, smem);
    }
}
DI void phase3(const P& p, char* smem) {
    for (int it = blockIdx.x; it < 64; it += gridDim.x) cmp2_item(p, it, smem);
}

template <int CTRL> DI float dpp_add(float x) { return x + __int_as_float(__builtin_amdgcn_mov_dpp(__float_as_int(x), CTRL, 0xF, 0xF, true)); }
DI float red16(float x) { x = dpp_add<0xB1>(x); x = dpp_add<0x4E>(x); x = dpp_add<0x141>(x); x = dpp_add<0x140>(x); return x; }

DI void cvt_store(const uint4 u, const bool isom, float* d) {
    float f0 = bflo(u.x), f1 = bfhi(u.x), f2 = bflo(u.y), f3 = bfhi(u.y), f4 = bflo(u.z), f5 = bfhi(u.z), f6 = bflo(u.w), f7 = bfhi(u.w);
    if (isom) { f0 = 1.f - f0; f1 = 1.f - f1; f2 = 1.f - f2; f3 = 1.f - f3; f4 = 1.f - f4; f5 = 1.f - f5; f6 = 1.f - f6; f7 = 1.f - f7; }
    *(float4*)d = make_float4(f0, f1, f2, f3); *(float4*)(d + 4) = make_float4(f4, f5, f6, f7);
}
DI void scan_unit(const P& p, int su, char* smem) {
    const int xcd = su & 7, kq = su >> 3, bh = xcd * 2 + (kq >> 3), oct = kq & 7, b = bh >> 3, h = bh & 7;
    const int tid = tidx(), wave = tid >> 6, lane = tid & 63;
    float* buf = (float*)smem;
    float* ypb = (float*)(smem + 49152);
    const bf16_t* sbase = p.stream + (size_t)bh * S_ * 384;
    __syncthreads();
#pragma unroll
    for (int i = 0; i < 3; ++i) { const int ci = tid + i * 256; cvt_store(*(const uint4*)(sbase + (size_t)ci * 8), (ci % 48) < 8, buf + ci * 8); }
    __syncthreads();
    if (wave < 2) {
        const int rl = lane >> 4, ks = lane & 15, row = oct * 8 + wave * 4 + rl;
        f2_t sA = {0.f, 0.f}, sB = {0.f, 0.f};
        __builtin_amdgcn_s_setprio(3);
        for (int c = 0; c < 1024; ++c) {
            const float* cb = buf + (c & 1) * 6144 + ks * 4;
            const float* vb = buf + (c & 1) * 6144 + 320 + row;
            float* yo = ypb + ((c & 1) * 2 + wave) * 1024 + lane;
            float4 dec = *(const float4*)(cb), km = *(const float4*)(cb + 64), kk = *(const float4*)(cb + 128), bb = *(const float4*)(cb + 192), rv = *(const float4*)(cb + 256);
            float v = vb[0];
            float4 dec1 = *(const float4*)(cb + 384), km1 = *(const float4*)(cb + 384 + 64), kk1 = *(const float4*)(cb + 384 + 128), bb1 = *(const float4*)(cb + 384 + 192), rv1 = *(const float4*)(cb + 384 + 256);
            float v1 = vb[384];
#pragma unroll
            for (int st = 0; st < 16; ++st) {
                float4 dec2 = dec1, km2 = km1, kk2 = kk1, bb2 = bb1, rv2 = rv1; float v2 = v1;
                if (st < 14) {
                    const float* rec = cb + (st + 2) * 384;
                    dec2 = *(const float4*)(rec); km2 = *(const float4*)(rec + 64); kk2 = *(const float4*)(rec + 128); bb2 = *(const float4*)(rec + 192); rv2 = *(const float4*)(rec + 256);
                    v2 = vb[(st + 2) * 384];
                }
                __builtin_amdgcn_sched_barrier(0x207);
                const f2_t vv = {v, v};
                const f2_t d01 = {dec.x, dec.y}, d23 = {dec.z, dec.w}, m01 = {km.x, km.y}, m23 = {km.z, km.w};
                const f2_t k01 = {kk.x, kk.y}, k23 = {kk.z, kk.w}, b01 = {bb.x, bb.y}, b23 = {bb.z, bb.w}, r01 = {rv.x, rv.y}, r23 = {rv.z, rv.w};
                const f2_t tA = sA * d01 + vv * m01, tB = sB * d23 + vv * m23;
                f2_t pa = sA * k01; pa = sB * k23 + pa;
                const float sa = red16(pa.x + pa.y);
                const f2_t sav = {sa, sa};
                sA = tA - sav * b01; sB = tB - sav * b23;
                f2_t ya = sA * r01; ya = sB * r23 + ya;
                yo[st * 64] = ya.x + ya.y;
                dec = dec1; km = km1; kk = kk1; bb = bb1; rv = rv1; v = v1;
                dec1 = dec2; km1 = km2; kk1 = kk2; bb1 = bb2; rv1 = rv2; v1 = v2;
            }
            __syncthreads();
        }
        __builtin_amdgcn_s_setprio(0);
    } else {
        const int ht = tid - 128;
        const int ystep = ht >> 3, r8 = ht & 7;
        float* yout = p.yraw + (size_t)(b * S_) * 512 + h * 64 + oct * 8 + r8;
        const float* ysrc = ypb + (r8 >> 2) * 1024 + ystep * 64 + (r8 & 3) * 16;
        uint4 ra0, ra1, ra2, ra3, ra4, ra5, rb0, rb1, rb2, rb3, rb4, rb5;
#define SLOAD(R, CH) { const bf16_t* sp_ = sbase + (size_t)(CH) * 6144 + (size_t)ht * 8; \
        R##0 = *(const uint4*)(sp_); R##1 = *(const uint4*)(sp_ + 1024); R##2 = *(const uint4*)(sp_ + 2048); R##3 = *(const uint4*)(sp_ + 3072); R##4 = *(const uint4*)(sp_ + 4096); R##5 = *(const uint4*)(sp_ + 5120); }
#define SSTORE(R, BI) { float* d_ = buf + (BI) * 6144 + ht * 8; const bool om_ = (ht % 48) < 8; \
        cvt_store(R##0, om_, d_); cvt_store(R##1, ((ht + 128) % 48) < 8, d_ + 1024); cvt_store(R##2, ((ht + 256) % 48) < 8, d_ + 2048); \
        cvt_store(R##3, ((ht + 384) % 48) < 8, d_ + 3072); cvt_store(R##4, ((ht + 512) % 48) < 8, d_ + 4096); cvt_store(R##5, ((ht + 640) % 48) < 8, d_ + 5120); }
#define YRED(C) { const float* ys_ = ysrc + ((C) & 1) * 2048; const float4 a_ = *(const float4*)ys_, b_ = *(const float4*)(ys_ + 4), c_ = *(const float4*)(ys_ + 8), d_ = *(const float4*)(ys_ + 12); \
        yout[(size_t)((C) * 16 + ystep) * 512] = ((a_.x + a_.y) + (a_.z + a_.w)) + ((b_.x + b_.y) + (b_.z + b_.w)) + ((c_.x + c_.y) + (c_.z + c_.w)) + ((d_.x + d_.y) + (d_.z + d_.w)); }
        SLOAD(ra, 1)
        for (int c = 0; c < 1024; c += 2) {
            if (c + 2 < 1024) SLOAD(rb, c + 2)
            SSTORE(ra, 1)
            if (c >= 1) YRED(c - 1)
            __syncthreads();
            if (c + 3 < 1024) SLOAD(ra, c + 3)
            if (c + 2 < 1024) SSTORE(rb, 0)
            YRED(c)
            __syncthreads();
        }
        YRED(1023)
#undef SLOAD
#undef SSTORE
#undef YRED
    }
}

struct AttnSmem {
    bf16_t k[64 * 72];
    bf16_t vt[64 * 68];
    float imp[32 * 256];
    unsigned selbits[32 * 8];
    unsigned wunion[4 * 8];
    unsigned bunion[8];
    unsigned gunion[8 * 8];
    int unit;
    int pad_[3];
    uint4 q[4 * 4 * 64];
};

#define ATTN_LOAD(KBASE, KSTRIDE, VTBASE, VTSTRIDE, NEEDV) { \
    rk0 = *(const uint4*)((KBASE) + (size_t)(tid >> 3) * (KSTRIDE) + (tid & 7) * 8); \
    rk1 = *(const uint4*)((KBASE) + (size_t)((tid >> 3) + 32) * (KSTRIDE) + (tid & 7) * 8); \
    if (NEEDV) { rv0 = *(const uint4*)((VTBASE) + (size_t)(tid >> 3) * (VTSTRIDE) + (tid & 7) * 8); \
                 rv1 = *(const uint4*)((VTBASE) + (size_t)((tid >> 3) + 32) * (VTSTRIDE) + (tid & 7) * 8); } }
#define ATTN_STORE(NEEDV) { \
    *(uint4*)&sm.k[(tid >> 3) * 72 + (tid & 7) * 8] = rk0; *(uint4*)&sm.k[((tid >> 3) + 32) * 72 + (tid & 7) * 8] = rk1; \
    if (NEEDV) { bf16_t* d0_ = &sm.vt[(tid >> 3) * 68 + (tid & 7) * 8]; bf16_t* d1_ = &sm.vt[((tid >> 3) + 32) * 68 + (tid & 7) * 8]; \
        *(uint2*)d0_ = make_uint2(rv0.x, rv0.y); *(uint2*)(d0_ + 4) = make_uint2(rv0.z, rv0.w); \
        *(uint2*)d1_ = make_uint2(rv1.x, rv1.y); *(uint2*)(d1_ + 4) = make_uint2(rv1.z, rv1.w); } }

template <int MODE, bool EM>
DI void attn_tile(AttnSmem& sm, const uint4* qs, f32x16 (&o)[2], float& m, float& l, const float inv_l, const int lo, const int hi, const bool lane_on,
                  const int lane, const int tokl, const int jbase) {
    const int rr = lane & 31, hh = lane >> 5;
    f32x16 s[2];
#pragma unroll
    for (int mt = 0; mt < 2; ++mt) {
#pragma unroll
        for (int i = 0; i < 16; ++i) s[mt][i] = 0.f;
#pragma unroll
        for (int ks = 0; ks < 4; ++ks) {
            const bf16x8 kf = *(const bf16x8*)&sm.k[(mt * 32 + rr) * 72 + ks * 16 + hh * 8];
            const bf16x8 qv = __builtin_bit_cast(bf16x8, qs[ks * 64]);
            s[mt] = MFMA32(kf, qv, s[mt]);
        }
        asm volatile("" ::: "memory");
    }
    (void)m;
    __builtin_amdgcn_sched_barrier(0);
    float psum = 0.f;
    if (EM) {
        const int lo2 = lo - 4 * hh, hi2 = hi - 4 * hh;
#pragma unroll
        for (int mt = 0; mt < 2; ++mt)
#pragma unroll
            for (int i = 0; i < 16; ++i) {
                const int kc_ = mt * 32 + (i & 3) + 8 * (i >> 2);
                float v = s[mt][i];
                v = (kc_ >= lo2 && kc_ <= hi2) ? v : -1e30f;
                float pv = __builtin_amdgcn_exp2f(v);
                if (MODE == 2) pv *= inv_l;
                s[mt][i] = pv; psum += pv;
            }
    } else {
        const float off = lane_on ? 0.f : -1e30f;
#pragma unroll
        for (int mt = 0; mt < 2; ++mt)
#pragma unroll
            for (int i = 0; i < 16; ++i) {
                float pv = __builtin_amdgcn_exp2f(s[mt][i] + off);
                if (MODE == 2) pv *= inv_l;
                s[mt][i] = pv; psum += pv;
            }
    }
    __builtin_amdgcn_sched_barrier(0);
    if (MODE != 2) l += psum;
    if (MODE == 0) return;
    if (MODE == 2) {
#pragma unroll
        for (int mt = 0; mt < 2; ++mt)
#pragma unroll
            for (int jj = 0; jj < 4; ++jj) {
                float q4 = (s[mt][4 * jj] + s[mt][4 * jj + 1]) + (s[mt][4 * jj + 2] + s[mt][4 * jj + 3]);
                float e3 = s[mt][4 * jj + 3];
                q4 += __shfl_xor(q4, 1); q4 += __shfl_xor(q4, 2);
                e3 += __shfl_xor(e3, 1); e3 += __shfl_xor(e3, 2);
                if ((rr & 3) == 0) {
                    const int j = jbase + mt * 8 + 2 * jj + hh;
                    atomicAdd(&sm.imp[tokl * 256 + j], q4);
                    if (j + 1 < 256) atomicAdd(&sm.imp[tokl * 256 + j + 1], e3);
                }
            }
    }
#pragma unroll
    for (int mt = 0; mt < 2; ++mt)
#pragma unroll
        for (int s2 = 0; s2 < 2; ++s2) {
            uint4 pu;
            pu.x = pack2(s[mt][8 * s2 + 0], s[mt][8 * s2 + 1]); pu.y = pack2(s[mt][8 * s2 + 2], s[mt][8 * s2 + 3]);
            pu.z = pack2(s[mt][8 * s2 + 4], s[mt][8 * s2 + 5]); pu.w = pack2(s[mt][8 * s2 + 6], s[mt][8 * s2 + 7]);
            const bf16x8 pf = __builtin_bit_cast(bf16x8, pu);
            asm volatile("" ::: "memory");
#pragma unroll
            for (int dt = 0; dt < 2; ++dt) {
                const bf16_t* vp = &sm.vt[(dt * 32 + rr) * 68 + mt * 32 + s2 * 16 + hh * 4];
                const uint2 v0 = *(const uint2*)vp, v1 = *(const uint2*)(vp + 8);
                const bf16x8 vf = __builtin_bit_cast(bf16x8, make_uint4(v0.x, v0.y, v1.x, v1.y));
                o[dt] = MFMA32(vf, pf, o[dt]);
            }
        }
}

template <int CTRL> DI unsigned dpp_umax(unsigned x) { const unsigned t = (unsigned)__builtin_amdgcn_mov_dpp((int)x, CTRL, 0xF, 0xF, true); return x > t ? x : t; }
DI unsigned wave_umax(unsigned v) {
    v = dpp_umax<0xB1>(v); v = dpp_umax<0x4E>(v); v = dpp_umax<0x141>(v); v = dpp_umax<0x140>(v);
    const unsigned a = (unsigned)__builtin_amdgcn_readlane((int)v, 0), b = (unsigned)__builtin_amdgcn_readlane((int)v, 16);
    const unsigned c = (unsigned)__builtin_amdgcn_readlane((int)v, 32), d = (unsigned)__builtin_amdgcn_readlane((int)v, 48);
    const unsigned ab = a > b ? a : b, cd = c > d ? c : d;
    return ab > cd ? ab : cd;
}


typedef unsigned u32x4 __attribute__((ext_vector_type(4)));
#define GLD16(R, PTR) asm volatile("global_load_dwordx4 %0, %1, off" : "=&v"(R) : "v"(PTR))
template <bool NEEDV, class NextF, class KPtrF, class VPtrF, class CompF>
DI void attn_pipe(AttnSmem& sm, const int tid, int j, const NextF next, const KPtrF kptr, const int kst, const VPtrF vptr, const int vst, const CompF comp) {
    if (j < 0) return;
    u32x4 Ak0, Ak1, Av0 = {0u, 0u, 0u, 0u}, Av1 = {0u, 0u, 0u, 0u}, Bk0, Bk1, Bv0 = {0u, 0u, 0u, 0u}, Bv1 = {0u, 0u, 0u, 0u};
    const int lr = tid >> 3, lc = (tid & 7) * 8;
#define PIPE_LOADS(S, JJ) { const bf16_t* kp_ = kptr(JJ) + (size_t)lr * kst + lc; GLD16(S##k0, kp_); GLD16(S##k1, kp_ + (size_t)32 * kst); \
        if (NEEDV) { const bf16_t* vp_ = vptr(JJ) + (size_t)lr * vst + lc; GLD16(S##v0, vp_); GLD16(S##v1, vp_ + (size_t)32 * vst); } }
#define PIPE_WAIT(S) { if (NEEDV) asm volatile("s_waitcnt vmcnt(4)" : "+v"(S##k0), "+v"(S##k1), "+v"(S##v0), "+v"(S##v1)); \
        else asm volatile("s_waitcnt vmcnt(2)" : "+v"(S##k0), "+v"(S##k1)); }
#define PIPE_STORES(S) { *(u32x4*)&sm.k[lr * 72 + lc] = S##k0; *(u32x4*)&sm.k[(lr + 32) * 72 + lc] = S##k1; \
        if (NEEDV) { bf16_t* d0_ = &sm.vt[lr * 68 + lc]; bf16_t* d1_ = &sm.vt[(lr + 32) * 68 + lc]; \
            *(uint2*)d0_ = make_uint2(S##v0.x, S##v0.y); *(uint2*)(d0_ + 4) = make_uint2(S##v0.z, S##v0.w); \
            *(uint2*)d1_ = make_uint2(S##v1.x, S##v1.y); *(uint2*)(d1_ + 4) = make_uint2(S##v1.z, S##v1.w); } }
    int jn = next(j);
    PIPE_LOADS(A, j)
    PIPE_LOADS(B, (jn >= 0 ? jn : j))
    while (true) {
        __syncthreads();
        PIPE_WAIT(A)
        PIPE_STORES(A)
        __syncthreads();
        const int jnn = jn >= 0 ? next(jn) : -1;
        PIPE_LOADS(A, (jnn >= 0 ? jnn : j))
        comp(j);
        if (jn < 0) break;
        __syncthreads();
        PIPE_WAIT(B)
        PIPE_STORES(B)
        __syncthreads();
        const int jnnn = jnn >= 0 ? next(jnn) : -1;
        PIPE_LOADS(B, (jnnn >= 0 ? jnnn : jn))
        comp(jn);
        if (jnn < 0) break;
        j = jnn; jn = jnnn;
    }
    asm volatile("s_waitcnt vmcnt(0)" : "+v"(Ak0), "+v"(Ak1), "+v"(Av0), "+v"(Av1), "+v"(Bk0), "+v"(Bk1), "+v"(Bv0), "+v"(Bv1));
#undef PIPE_LOADS
#undef PIPE_WAIT
#undef PIPE_STORES
}


typedef float f32x4v __attribute__((ext_vector_type(4)));
#define MFMA16(a, b, c) __builtin_amdgcn_mfma_f32_16x16x32_bf16((a), (b), (c), 0, 0, 0)
template <bool EM>
DI void sel16_scores(const u32x4 k0, const u32x4 k1, const u32x4 k2, const u32x4 k3, const u32x4 k4, const u32x4 k5, const u32x4 k6, const u32x4 k7,
                     const u32x4 q0, const u32x4 q1, float& l, const int hi, const bool lane_on, const int lane, u32x4& pf0, u32x4& pf1) {
    const int g4 = lane >> 4;
    const f32x4v z = {0.f, 0.f, 0.f, 0.f};
    const bf16x8 qa = __builtin_bit_cast(bf16x8, q0), qb = __builtin_bit_cast(bf16x8, q1);
    f32x4v a0 = MFMA16(__builtin_bit_cast(bf16x8, k0), qa, z); a0 = MFMA16(__builtin_bit_cast(bf16x8, k1), qb, a0);
    f32x4v a1 = MFMA16(__builtin_bit_cast(bf16x8, k2), qa, z); a1 = MFMA16(__builtin_bit_cast(bf16x8, k3), qb, a1);
    f32x4v a2 = MFMA16(__builtin_bit_cast(bf16x8, k4), qa, z); a2 = MFMA16(__builtin_bit_cast(bf16x8, k5), qb, a2);
    f32x4v a3 = MFMA16(__builtin_bit_cast(bf16x8, k6), qa, z); a3 = MFMA16(__builtin_bit_cast(bf16x8, k7), qb, a3);
    float psum = 0.f;
    if (EM) {
        const int hi2 = hi - 4 * g4;
#pragma unroll
        for (int r = 0; r < 4; ++r) {
            a0[r] = __builtin_amdgcn_exp2f((r <= hi2) ? a0[r] : -1e30f);
            a1[r] = __builtin_amdgcn_exp2f((16 + r <= hi2) ? a1[r] : -1e30f);
            a2[r] = __builtin_amdgcn_exp2f((32 + r <= hi2) ? a2[r] : -1e30f);
            a3[r] = __builtin_amdgcn_exp2f((48 + r <= hi2) ? a3[r] : -1e30f);
            psum += (a0[r] + a1[r]) + (a2[r] + a3[r]);
        }
    } else {
        const float off = lane_on ? 0.f : -1e30f;
#pragma unroll
        for (int r = 0; r < 4; ++r) {
            a0[r] = __builtin_amdgcn_exp2f(a0[r] + off); a1[r] = __builtin_amdgcn_exp2f(a1[r] + off);
            a2[r] = __builtin_amdgcn_exp2f(a2[r] + off); a3[r] = __builtin_amdgcn_exp2f(a3[r] + off);
            psum += (a0[r] + a1[r]) + (a2[r] + a3[r]);
        }
    }
    l += psum;
    pf0.x = pack2(a0[0], a0[1]); pf0.y = pack2(a0[2], a0[3]); pf0.z = pack2(a1[0], a1[1]); pf0.w = pack2(a1[2], a1[3]);
    pf1.x = pack2(a2[0], a2[1]); pf1.y = pack2(a2[2], a2[3]); pf1.z = pack2(a3[0], a3[1]); pf1.w = pack2(a3[2], a3[3]);
}
DI void sel16_pv(const u32x4 v0, const u32x4 v1, const u32x4 v2, const u32x4 v3, const u32x4 v4, const u32x4 v5, const u32x4 v6, const u32x4 v7,
                 const u32x4 pf0, const u32x4 pf1, f32x4v& o0, f32x4v& o1, f32x4v& o2, f32x4v& o3) {
    const bf16x8 pa = __builtin_bit_cast(bf16x8, pf0), pb = __builtin_bit_cast(bf16x8, pf1);
    o0 = MFMA16(__builtin_bit_cast(bf16x8, v0), pa, o0); o1 = MFMA16(__builtin_bit_cast(bf16x8, v1), pa, o1);
    o2 = MFMA16(__builtin_bit_cast(bf16x8, v2), pa, o2); o3 = MFMA16(__builtin_bit_cast(bf16x8, v3), pa, o3);
    o0 = MFMA16(__builtin_bit_cast(bf16x8, v4), pb, o0); o1 = MFMA16(__builtin_bit_cast(bf16x8, v5), pb, o1);
    o2 = MFMA16(__builtin_bit_cast(bf16x8, v6), pb, o2); o3 = MFMA16(__builtin_bit_cast(bf16x8, v7), pb, o3);
}

DI void attn_unit(const P& p, int u, char* smem) {
    AttnSmem& sm = *(AttnSmem*)smem;
    const int tid = tidx(), wave = tid >> 6, lane = tid & 63, rr = lane & 31, hh = lane >> 5;
    const int tile = 511 - (u >> 2), bhk = u & 3, b = bhk >> 1, hk = bhk & 1, t0 = tile * 32;
    const int tokl = wave * 8 + (rr >> 2), t = t0 + tokl, g = rr & 3, head = hk * 4 + g;
    const size_t tokg = (size_t)b * S_ + t;
    uint4* qs = &sm.q[wave * 256 + lane];
#pragma unroll
    for (int ks = 0; ks < 4; ++ks) qs[ks * 64] = *(const uint4*)(p.proj + tokg * PLD + QC + head * 64 + ks * 16 + hh * 8);
#define GATE(i) sigmoidf_(__uint_as_float((unsigned)p.proj[((size_t)b * S_ + t) * PLD + GC + head * 3 + (i)] << 16))
#pragma unroll
    for (int i = 0; i < 8; ++i) *(float4*)&sm.imp[(tid + i * 256) * 4] = make_float4(0.f, 0.f, 0.f, 0.f);
    sm.selbits[tid] = 0u;
    f32x16 o[2];
#pragma unroll
    for (int dt = 0; dt < 2; ++dt)
#pragma unroll
        for (int i = 0; i < 16; ++i) o[dt][i] = 0.f;
    float* park = &sm.imp[wave * 2048 + lane];
    const int ntc = (t0 >> 10) + 1;
    const int vmaxi = (t >= 31) ? ((t - 31) >> 4) : -1;
    const int twmin = t0 + wave * 8;
    const int wvmin = (twmin >= 31) ? ((twmin - 31) >> 4) : -1;
    const bf16_t* kcb = p.kc + (size_t)bhk * 1024 * 64;
    const bf16_t* vcb = p.vcT + (size_t)bhk * 64 * 1024;
    float m = -1e30f, l = 0.f;
    {
        auto nxt = [&](int j) -> int { return j + 1 < ntc ? j + 1 : -1; };
        auto kp = [&](int j) -> const bf16_t* { return kcb + (size_t)j * 64 * 64; };
        auto vp = [&](int j) -> const bf16_t* { return vcb + j * 64; };
        attn_pipe<false>(sm, tid, 0, nxt, kp, 64, vp, 1024, [&](int j) {
            if (j * 64 + 63 <= wvmin) attn_tile<0, false>(sm, qs, o, m, l, 0.f, 0, 0, true, lane, tokl, 0);
            else attn_tile<0, true>(sm, qs, o, m, l, 0.f, 0, vmaxi - j * 64, true, lane, tokl, 0);
        });
        const float lt = l + __shfl_xor(l, 32);
        const float inv_l = lt > 0.f ? 1.f / lt : 0.f;
        attn_pipe<true>(sm, tid, 0, nxt, kp, 64, vp, 1024, [&](int j) {
            if (j * 64 + 63 <= wvmin) attn_tile<2, false>(sm, qs, o, m, l, inv_l, 0, 0, true, lane, tokl, j * 16);
            else attn_tile<2, true>(sm, qs, o, m, l, inv_l, 0, vmaxi - j * 64, true, lane, tokl, j * 16);
        });
    }
    __syncthreads();
    const int cur = t0 >> 6;
    for (int tk = 0; tk < 8; ++tk) {
        const int tl = wave * 8 + tk;
        const float* ip = &sm.imp[tl * 256];
        unsigned nib = 0u;
        if (cur <= 15) {
#pragma unroll
            for (int e = 0; e < 4; ++e) if (lane * 4 + e <= cur) nib |= 1u << e;
        } else {
            unsigned k0, k1, k2, k3;
            {
                const float4 iv = *(const float4*)(ip + lane * 4);
                const int j0 = lane * 4;
                k0 = (j0 >= 1 && j0 <= cur - 2) ? ((__float_as_uint(iv.x) & 0xFFFFFF00u) | (unsigned)(255 - j0)) : 0u;
                k1 = (j0 + 1 <= cur - 2) ? ((__float_as_uint(iv.y) & 0xFFFFFF00u) | (unsigned)(254 - j0)) : 0u;
                k2 = (j0 + 2 <= cur - 2) ? ((__float_as_uint(iv.z) & 0xFFFFFF00u) | (unsigned)(253 - j0)) : 0u;
                k3 = (j0 + 3 <= cur - 2) ? ((__float_as_uint(iv.w) & 0xFFFFFF00u) | (unsigned)(252 - j0)) : 0u;
#pragma unroll
                for (int e = 0; e < 4; ++e) { const int j = j0 + e; if (j == 0 || j == cur || j == cur - 1) nib |= 1u << e; }
            }
            for (int r = 0; r < 13; ++r) {
                unsigned lm = k0 > k1 ? k0 : k1; const unsigned lm2 = k2 > k3 ? k2 : k3; lm = lm > lm2 ? lm : lm2;
                const unsigned wm = wave_umax(lm);
                if (k0 == wm) { k0 = 0u; nib |= 1u; }
                if (k1 == wm) { k1 = 0u; nib |= 2u; }
                if (k2 == wm) { k2 = 0u; nib |= 4u; }
                if (k3 == wm) { k3 = 0u; nib |= 8u; }
            }
        }
        atomicOr(&sm.selbits[tl * 8 + (lane >> 3)], nib << ((lane & 7) * 4));
    }
    __syncthreads();
    if (tid < 32) {
        const int w = tid >> 3, d = tid & 7; unsigned uu = 0u;
#pragma unroll
        for (int k = 0; k < 8; ++k) uu |= sm.selbits[(w * 8 + k) * 8 + d];
        sm.wunion[w * 8 + d] = uu;
    }
    if (tid < 64) {
        const int wg = tid >> 3, d = tid & 7; unsigned uu = 0u;
#pragma unroll
        for (int k = 0; k < 4; ++k) uu |= sm.selbits[(wg * 4 + k) * 8 + d];
        sm.gunion[wg * 8 + d] = uu;
    }
    __syncthreads();
    if (tid < 8) sm.bunion[tid] = sm.wunion[tid] | sm.wunion[8 + tid] | sm.wunion[16 + tid] | sm.wunion[24 + tid];
    __syncthreads();
    {
        const float g0 = GATE(0);
#pragma unroll
        for (int dt = 0; dt < 2; ++dt)
#pragma unroll
            for (int i = 0; i < 16; ++i) { park[(dt * 16 + i) * 64] = g0 * o[dt][i]; o[dt][i] = 0.f; }
    }
    {
        const bf16_t* kb = p.proj + (size_t)(b * S_) * PLD + KVC + 2 * 128 + hk * 64;
        const bf16_t* vb = p.vT + (size_t)((0 * 4 + bhk) * 64) * S_;
        m = -1e30f; l = 0.f;
        (void)kb; (void)vb; (void)m; (void)l;
        const bf16_t* kswb = p.ksw + ((size_t)bhk * 256 * 512 + lane) * 8;
        const bf16_t* vswb = p.vsw + ((size_t)bhk * 256 * 512 + lane) * 8;
        float* pbase = &sm.imp[wave * 2048];
        const int q16 = lane & 15, g4 = lane >> 4;
        const int tl0 = wave * 8 + (q16 >> 2), tl1 = tl0 + 4, tt0_ = t0 + tl0, tt1_ = t0 + tl1, head16 = hk * 4 + (q16 & 3);
        const bf16_t* qrow0 = p.proj + ((size_t)b * S_ + tt0_) * PLD;
        const bf16_t* qrow1 = p.proj + ((size_t)b * S_ + tt1_) * PLD;
        const u32x4 qa0 = *(const u32x4*)(qrow0 + QC + head16 * 64 + g4 * 8), qa1 = *(const u32x4*)(qrow0 + QC + head16 * 64 + 32 + g4 * 8);
        const u32x4 qb0 = *(const u32x4*)(qrow1 + QC + head16 * 64 + g4 * 8), qb1 = *(const u32x4*)(qrow1 + QC + head16 * 64 + 32 + g4 * 8);
        auto nextw = [&](int j) -> int {
            ++j;
            while (j <= cur) {
                const unsigned w = sm.wunion[wave * 8 + (j >> 5)] >> (j & 31);
                if (w) { j += __ffs((int)w) - 1; return j <= cur ? j : -1; }
                j = (j | 31) + 1;
            }
            return -1;
        };
        const f32x4v z4 = {0.f, 0.f, 0.f, 0.f};
        f32x4v oa0 = z4, oa1 = z4, oa2 = z4, oa3 = z4, ob0 = z4, ob1 = z4, ob2 = z4, ob3 = z4;
        float la = 0.f, lb = 0.f;
        u32x4 A0, A1, A2, A3, A4, A5, A6, A7, B0, B1, B2, B3, B4, B5, B6, B7, V0, V1, V2, V3, V4, V5, V6, V7;
        u32x4 pa0 = {0u, 0u, 0u, 0u}, pa1 = pa0, pb0 = pa0, pb1 = pa0;
#define SEL_LD8(R, BASE, JJ) { const bf16_t* b_ = (BASE) + (size_t)(JJ) * 4096; GLD16(R##0, b_); GLD16(R##1, b_ + 512); GLD16(R##2, b_ + 1024); GLD16(R##3, b_ + 1536); \
        GLD16(R##4, b_ + 2048); GLD16(R##5, b_ + 2560); GLD16(R##6, b_ + 3072); GLD16(R##7, b_ + 3584); }
#define SEL_WAIT8(R, N) asm volatile("s_waitcnt vmcnt(" #N ")" : "+v"(R##0), "+v"(R##1), "+v"(R##2), "+v"(R##3), "+v"(R##4), "+v"(R##5), "+v"(R##6), "+v"(R##7))
#define SEL_TILE(K, JJ) { \
        const int jj_ = (JJ); \
        const bool needa_ = (sm.gunion[(wave * 2 + 0) * 8 + (jj_ >> 5)] >> (jj_ & 31)) & 1u, needb_ = (sm.gunion[(wave * 2 + 1) * 8 + (jj_ >> 5)] >> (jj_ & 31)) & 1u; \
        const bool sela_ = (sm.selbits[tl0 * 8 + (jj_ >> 5)] >> (jj_ & 31)) & 1u, selb_ = (sm.selbits[tl1 * 8 + (jj_ >> 5)] >> (jj_ & 31)) & 1u; \
        SEL_WAIT8(K, 16); \
        if (needa_) { \
            if (jj_ < cur) sel16_scores<false>(K##0, K##1, K##2, K##3, K##4, K##5, K##6, K##7, qa0, qa1, la, 0, sela_, lane, pa0, pa1); \
            else sel16_scores<true>(K##0, K##1, K##2, K##3, K##4, K##5, K##6, K##7, qa0, qa1, la, sela_ ? tt0_ - jj_ * 64 : -1, true, lane, pa0, pa1); } \
        if (needb_) { \
            if (jj_ < cur) sel16_scores<false>(K##0, K##1, K##2, K##3, K##4, K##5, K##6, K##7, qb0, qb1, lb, 0, selb_, lane, pb0, pb1); \
            else sel16_scores<true>(K##0, K##1, K##2, K##3, K##4, K##5, K##6, K##7, qb0, qb1, lb, selb_ ? tt1_ - jj_ * 64 : -1, true, lane, pb0, pb1); } \
        SEL_WAIT8(V, 8); \
        if (needa_) sel16_pv(V0, V1, V2, V3, V4, V5, V6, V7, pa0, pa1, oa0, oa1, oa2, oa3); \
        if (needb_) sel16_pv(V0, V1, V2, V3, V4, V5, V6, V7, pb0, pb1, ob0, ob1, ob2, ob3); }
        {
            int j = nextw(-1);
            if (j >= 0) {
                SEL_LD8(A, kswb, j)
                while (true) {
                    const int jn = nextw(j);
                    SEL_LD8(V, vswb, j)
                    SEL_LD8(B, kswb, (jn >= 0 ? jn : j))
                    SEL_TILE(A, j)
                    if (jn < 0) break;
                    const int jnn = nextw(jn);
                    SEL_LD8(V, vswb, jn)
                    SEL_LD8(A, kswb, (jnn >= 0 ? jnn : jn))
                    SEL_TILE(B, jn)
                    if (jnn < 0) break;
                    j = jnn;
                }
                asm volatile("s_waitcnt vmcnt(0)" : "+v"(A0), "+v"(A1), "+v"(A2), "+v"(A3), "+v"(A4), "+v"(A5), "+v"(A6), "+v"(A7), "+v"(B0), "+v"(B1), "+v"(B2), "+v"(B3), "+v"(B4), "+v"(B5), "+v"(B6), "+v"(B7));
                asm volatile("s_waitcnt vmcnt(0)" : "+v"(V0), "+v"(V1), "+v"(V2), "+v"(V3), "+v"(V4), "+v"(V5), "+v"(V6), "+v"(V7));
            }
        }
#undef SEL_LD8
#undef SEL_WAIT8
#undef SEL_TILE
#define SEL_FIN(GRP, LG, QROW, O0, O1, O2, O3) { \
        float lt_ = (LG) + __shfl_xor((LG), 16); lt_ += __shfl_xor(lt_, 32); \
        const float g1_ = sigmoidf_(__uint_as_float((unsigned)(QROW)[GC + head16 * 3 + 1] << 16)); \
        const float sc_ = lt_ > 0.f ? g1_ / lt_ : 0.f; \
        const int r32_ = (GRP) * 16 + q16, hh32_ = g4 & 1; \
        _Pragma("unroll") for (int dt = 0; dt < 4; ++dt) { \
            const f32x4v ov_ = dt == 0 ? O0 : (dt == 1 ? O1 : (dt == 2 ? O2 : O3)); \
            _Pragma("unroll") for (int r = 0; r < 4; ++r) { \
                const int i32_ = r + 4 * ((dt & 1) * 2 + (g4 >> 1)); \
                pbase[((dt >> 1) * 16 + i32_) * 64 + r32_ + 32 * hh32_] += sc_ * ov_[r]; } } }
        SEL_FIN(0, la, qrow0, oa0, oa1, oa2, oa3)
        SEL_FIN(1, lb, qrow1, ob0, ob1, ob2, ob3)
#undef SEL_FIN
    }
    {
        const bf16_t* kb = p.proj + (size_t)(b * S_) * PLD + KVC + 4 * 128 + hk * 64;
        const bf16_t* vb = p.vT + (size_t)((1 * 4 + bhk) * 64) * S_;
        m = -1e30f; l = 0.f;
        const int jlo = (t0 >= 511) ? ((t0 - 511) >> 6) : 0, jhi = t0 >> 6;
        attn_pipe<true>(sm, tid, jlo, [&](int j) -> int { return j + 1 <= jhi ? j + 1 : -1; }, [&](int j) -> const bf16_t* { return kb + (size_t)j * 64 * PLD; }, PLD,
                        [&](int j) -> const bf16_t* { return vb + j * 64; }, S_, [&](int j) {
            if (j * 64 >= twmin + 7 - 511 && j * 64 + 63 <= twmin) attn_tile<1, false>(sm, qs, o, m, l, 0.f, 0, 0, true, lane, tokl, 0);
            else attn_tile<1, true>(sm, qs, o, m, l, 0.f, t - 511 - j * 64, t - j * 64, true, lane, tokl, 0);
        });
        const float lt = l + __shfl_xor(l, 32);
        const float sc = lt > 0.f ? GATE(2) / lt : 0.f;
#pragma unroll
        for (int dt = 0; dt < 2; ++dt)
#pragma unroll
            for (int i = 0; i < 16; ++i) o[dt][i] = park[(dt * 16 + i) * 64] + sc * o[dt][i];
    }
    bf16_t* mp = p.A + tokg * 1024 + 512 + head * 64;
#pragma unroll
    for (int dt = 0; dt < 2; ++dt)
#pragma unroll
        for (int jj = 0; jj < 4; ++jj) {
            uint2 ov; ov.x = pack2(o[dt][4 * jj], o[dt][4 * jj + 1]); ov.y = pack2(o[dt][4 * jj + 2], o[dt][4 * jj + 3]);
            *(uint2*)(mp + dt * 32 + jj * 8 + hh * 4) = ov;
        }
}

DI void phase4(const P& p, char* smem) {
    for (int su = blockIdx.x; su < 128; su += gridDim.x) scan_unit(p, su, smem);
    AttnSmem& sm = *(AttnSmem*)smem;
    while (true) {
        __syncthreads();
        if (tidx() == 0) sm.unit = (int)atomicAdd(p.counter, 1u);
        __syncthreads();
        const int u = sm.unit;
        if (u >= 2048) break;
        attn_unit(p, u, smem);
    }
}

DI void phase4b(const P& p) {
    const int tid = tidx();
    for (int it = blockIdx.x; it < T_ / 4; it += gridDim.x) {
        const int gi = it * 4 + (tid >> 6), cgp = tid & 63, h = cgp >> 3, c8 = (cgp & 7) * 8, col = cgp * 8, b = gi >> 14, s = gi & (S_ - 1);
        const float4 y0 = *(const float4*)(p.yraw + (size_t)gi * 512 + col), y1 = *(const float4*)(p.yraw + (size_t)gi * 512 + col + 4);
        float y[8] = {y0.x, y0.y, y0.z, y0.w, y1.x, y1.y, y1.z, y1.w};
        const bf16_t* sp = p.stream + ((size_t)((b * 8 + h) * S_ + s) * 6) * 64 + c8;
        float km[8], r[8], v[8], gg[8];
        unpack8(*(const uint4*)(sp + 64), km); unpack8(*(const uint4*)(sp + 256), r); unpack8(*(const uint4*)(sp + 320), v);
        unpack8(*(const uint4*)(p.gbuf + (size_t)gi * 512 + col), gg);
        float sum = 0.f, bon = 0.f;
#pragma unroll
        for (int e = 0; e < 8; ++e) { sum += y[e]; bon += r[e] * km[e] * p.r_k[col + e]; }
        sum += __shfl_xor(sum, 1); sum += __shfl_xor(sum, 2); sum += __shfl_xor(sum, 4);
        bon += __shfl_xor(bon, 1); bon += __shfl_xor(bon, 2); bon += __shfl_xor(bon, 4);
        const float mean = sum * (1.f / 64.f);
        float var = 0.f;
#pragma unroll
        for (int e = 0; e < 8; ++e) { y[e] -= mean; var += y[e] * y[e]; }
        var += __shfl_xor(var, 1); var += __shfl_xor(var, 2); var += __shfl_xor(var, 4);
        const float rs = rsqrtf(var * (1.f / 64.f) + 64e-5f);
        float o[8];
#pragma unroll
        for (int e = 0; e < 8; ++e) o[e] = (y[e] * rs * p.lnx_w[col + e] + p.lnx_b[col + e] + bon * v[e]) * gg[e];
        *(uint4*)(p.A + (size_t)gi * 1024 + col) = pack8(o);
    }
}

struct EpiFfn2 {
    float* out;
    DI void operator()(const f32x16 (&acc)[2][2], int rowbase, int colbase, int lane) const {
        const int rr = lane & 31, hh = lane >> 5;
#pragma unroll
        for (int w = 0; w < 2; ++w)
#pragma unroll
            for (int t = 0; t < 2; ++t)
#pragma unroll
                for (int j = 0; j < 4; ++j) {
                    float4* o = (float4*)(out + (size_t)(rowbase + t * 32 + rr) * 1024 + colbase + w * 32 + j * 8 + hh * 4);
                    float4 xv = *o;
                    xv.x += acc[w][t][4 * j]; xv.y += acc[w][t][4 * j + 1]; xv.z += acc[w][t][4 * j + 2]; xv.w += acc[w][t][4 * j + 3];
                    *o = xv;
                }
    }
};

DI void final_item(float* io, const float* g, int idx) {
    const int row = idx * 4 + (tidx() >> 6), lane = tidx() & 63;
    float4* sp = (float4*)(io + (size_t)row * 1024);
    float4 v[4]; float ss = 0.f;
#pragma unroll
    for (int i = 0; i < 4; ++i) { v[i] = sp[lane + 64 * i]; ss += v[i].x * v[i].x + v[i].y * v[i].y + v[i].z * v[i].z + v[i].w * v[i].w; }
    ss = wave_sum(ss);
    const float rs = rsqrtf(ss * (1.f / 1024.f) + 1e-6f);
#pragma unroll
    for (int i = 0; i < 4; ++i) {
        const float4 gv = ((const float4*)g)[lane + 64 * i];
        sp[lane + 64 * i] = make_float4(v[i].x * rs * gv.x, v[i].y * rs * gv.y, v[i].z * rs * gv.z, v[i].w * rs * gv.w);
    }
}

DI bool gemm_order(const int round, const int NT, int& mt, int& nt) {
    if (gridDim.x == 512) {
        const int xcd = blockIdx.x & 7, lb = blockIdx.x >> 3;
        const int q = round * 64 + lb;
        if (q >= 32 * NT) return false;
        mt = xcd * 32 + (q / (8 * NT)) * 8 + (q & 7);
        nt = (q >> 3) % NT;
        return true;
    }
    const int it = round * gridDim.x + blockIdx.x;
    if (it >= 256 * NT) return false;
    mt = it / NT; nt = it - mt * NT;
    return true;
}

DI void run_phase(const P& p, int ph, char* smem) {
    switch (ph) {
    case 0: phase0(p, smem); break;
    case 1:
        for (int rd = 0;; ++rd) {
            int mt, nt; if (!gemm_order(rd, 25, mt, nt)) break;
            gemm_tile<8>(AFPlain{p.A, 1024}, p.WinT + (size_t)nt * 128 * 1024, 1024, mt * 128, nt * 128, EpiProj{p.proj}, smem);
        }
        break;
    case 2: phase2(p, smem); break;
    case 3: phase3(p, smem); break;
    case 4: phase4(p, smem); break;
    case 5: phase4b(p); break;
    case 6:
        for (int rd = 0;; ++rd) {
            int mt, nt; if (!gemm_order(rd, 8, mt, nt)) break;
            gemm_tile<8>(AFPlain{p.A, 1024}, p.WoutT + (size_t)nt * 128 * 1024, 1024, mt * 128, nt * 128, EpiOut{p.out, p.x}, smem);
        }
        break;
    case 7:
        for (int it = blockIdx.x; it < T_ / 4; it += gridDim.x) rms_item(p.out, p.norm_ffn, p.A, it);
        break;
    case 8:
        for (int rd = 0;; ++rd) {
            int mt, nt; if (!gemm_order(rd, 44, mt, nt)) break;
            gemm_tile<8>(AFPlain{p.A, 1024}, p.WguT + (size_t)nt * 128 * 1024, 1024, mt * 128, nt * 128, EpiFfn1{p.stream}, smem);
        }
        break;
    case 9:
        for (int rd = 0;; ++rd) {
            int mt, nt; if (!gemm_order(rd, 8, mt, nt)) break;
            gemm_tile<1>(AFPlain{p.stream, DFF}, p.WdnT + (size_t)nt * 128 * DFF, DFF, mt * 128, nt * 128, EpiFfn2{p.out}, smem);
        }
        break;
    default:
        for (int it = blockIdx.x; it < T_ / 4; it += gridDim.x) final_item(p.out, p.norm_final, it);
        break;
    }
}
constexpr int NPHASE = 11;
constexpr int SMEM_BYTES = 73728;


#define XB_TMO      128
#define XB_XCNT(j)  (256  + 64 * (j))
#define XB_XSUB(j)  (1280 + 64 * (j))
#define XB_XGEN(j)  (2304 + 64 * (j))
#define XB_TOP      3328
#define XB_TOPGEN   3392
#define XCD_BAR_WORDS 3456
#define XB_SPIN_CAP (1u << 22)
#define LAS __attribute__((address_space(3)))
DI unsigned xb_ld(unsigned* p) { return __hip_atomic_load(p, __ATOMIC_RELAXED, __HIP_MEMORY_SCOPE_AGENT); }
DI unsigned xb_add(unsigned* p, unsigned v) { return __hip_atomic_fetch_add(p, v, __ATOMIC_RELAXED, __HIP_MEMORY_SCOPE_AGENT); }
DI unsigned xb_xcc_id() { return (unsigned)__builtin_amdgcn_s_getreg((3 << 11) | 20) & 0xFu; }
#define XB_SPIN(cond, bar) do { unsigned _sp = 0; while (cond) { __builtin_amdgcn_s_sleep(1); \
    if ((++_sp & 255u) == 0u) { if (xb_ld(&(bar)[XB_TMO])) break; if (_sp > XB_SPIN_CAP) { atomicAdd(&(bar)[XB_TMO], 1u); break; } } } } while (0)
struct XcdBarrier { unsigned* bar; unsigned x; volatile LAS unsigned* st; unsigned G; };
DI XcdBarrier xcd_barrier_post(unsigned* bar, volatile LAS unsigned* st, const unsigned G) {
    XcdBarrier b; b.bar = bar; b.x = xb_xcc_id(); b.st = st; b.G = G;
    if (tidx() == 0) (void)xb_add(&bar[XB_XCNT(b.x)], 1u);
    return b;
}
DI void xcd_barrier_complete(unsigned* bar, unsigned x, unsigned& nloc, unsigned& nx, const unsigned G) {
    unsigned sum, cnt, mine, sp = 0u;
    for (;;) {
        sum = 0u; cnt = 0u; mine = 0u;
#pragma unroll
        for (unsigned j = 0; j < 16; ++j) { const unsigned c = xb_ld(&bar[XB_XCNT(j)]); sum += c; cnt += (c > 0u) ? 1u : 0u; mine = (j == x) ? c : mine; }
        if (sum == G) break;
        __builtin_amdgcn_s_sleep(1);
        if ((++sp & 255u) == 0u) { if (xb_ld(&bar[XB_TMO])) break; if (sp > XB_SPIN_CAP) { atomicAdd(&bar[XB_TMO], 1u); break; } }
    }
    nloc = mine > 0u ? mine : 1u; nx = cnt > 0u ? cnt : 1u;
}
DI void xcd_barrier(const XcdBarrier& b) {
    asm volatile("s_waitcnt vmcnt(0)" ::: "memory");
    __syncthreads();
    if (tidx() == 0) {
        unsigned* bar = b.bar;
        __builtin_amdgcn_s_waitcnt(0);
        unsigned nloc = b.st[0], nx = b.st[1];
        if (nloc == 0u) { xcd_barrier_complete(bar, b.x, nloc, nx, b.G); b.st[0] = nloc; b.st[1] = nx; }
        const unsigned old = xb_add(&bar[XB_XSUB(b.x)], 1u);
        const unsigned gen = old / nloc;
        if (old + 1u == (gen + 1u) * nloc) {
            __builtin_amdgcn_fence(__ATOMIC_RELEASE, "agent");
            asm volatile("s_waitcnt vmcnt(0)" ::: "memory");
            const unsigned og = xb_add(&bar[XB_TOP], 1u);
            const unsigned tg = og / nx;
            if (og + 1u == (tg + 1u) * nx) xb_add(&bar[XB_TOPGEN], 1u);
            else XB_SPIN(xb_ld(&bar[XB_TOPGEN]) == tg, bar);
            __builtin_amdgcn_fence(__ATOMIC_ACQUIRE, "agent");
            xb_add(&bar[XB_XGEN(b.x)], 1u);
            asm volatile("s_waitcnt vmcnt(0)" ::: "memory");
        } else {
            XB_SPIN(xb_ld(&bar[XB_XGEN(b.x)]) == gen, bar);
            __builtin_amdgcn_fence(__ATOMIC_ACQUIRE, "agent");
            asm volatile("s_waitcnt vmcnt(0)" ::: "memory");
        }
    }
    __syncthreads();
}

DI void phase4_fused(const P& p, char* smem, const XcdBarrier& xb2) {
    const int tid = tidx();
    if (blockIdx.x < 128) {
        scan_unit(p, blockIdx.x, smem);
        if (tid == 0) {
            unsigned sp = 0u;
            while (xb_ld(p.counter + 4) == 0u) { __builtin_amdgcn_s_sleep(8); if (++sp > (1u << 22)) break; }
            __builtin_amdgcn_fence(__ATOMIC_ACQUIRE, "agent");
            asm volatile("s_waitcnt vmcnt(0)" ::: "memory");
        }
        __syncthreads();
    } else {
        const int lb = blockIdx.x - 128;
        for (int it = lb; it < 2560; it += 384) {
            const int mt = it / 10, nt = 15 + (it - mt * 10);
            gemm_tile<8>(AFPlain{p.A, 1024}, p.WinT + (size_t)nt * 128 * 1024, 1024, mt * 128, nt * 128, EpiProj{p.proj}, smem);
        }
        xcd_barrier(xb2);
        for (int it = lb; it < 640; it += 384) { if (it < 128) cmp1_item(p, it, smem); else rope_item(p, it - 128, smem); }
        xcd_barrier(xb2);
        for (int it = lb; it < 64; it += 384) cmp2_item(p, it, smem);
        xcd_barrier(xb2);
        if (lb == 0 && tid == 0) __hip_atomic_store(p.counter + 4, 1u, __ATOMIC_RELEASE, __HIP_MEMORY_SCOPE_AGENT);
    }
    AttnSmem& sm = *(AttnSmem*)smem;
    while (true) {
        __syncthreads();
        if (tidx() == 0) sm.unit = (int)atomicAdd(p.counter, 1u);
        __syncthreads();
        const int u = sm.unit;
        if (u >= 2048 + 2368) break;
        if (u < 2048) attn_unit(p, u, smem);
        else tr_item(p, 800 + (u - 2048), (float*)smem);
    }
}

__global__ void __launch_bounds__(NTHR, 2) mega_kernel(P p) {
    __shared__ __attribute__((aligned(16))) char smem[SMEM_BYTES];
    __shared__ uint4 xb_words;
    __shared__ uint4 xb_words2;
    cg::grid_group grid = cg::this_grid();
    if (p.x == nullptr) grid.sync();
    if (tidx() == 0) { xb_words = make_uint4(0u, 0u, 0u, 0u); xb_words2 = make_uint4(0u, 0u, 0u, 0u); }
    __syncthreads();
    const XcdBarrier xb = xcd_barrier_post(p.bar, (volatile LAS unsigned*)&xb_words, gridDim.x);
    run_phase(p, 0, smem); xcd_barrier(xb);
    if (gridDim.x == 512) {
        XcdBarrier xb2; xb2.bar = p.bar + XCD_BAR_WORDS; xb2.x = xb.x; xb2.st = (volatile LAS unsigned*)&xb_words2; xb2.G = 384u;
        if (blockIdx.x >= 128 && tidx() == 0) (void)xb_add(&xb2.bar[XB_XCNT(xb2.x)], 1u);
        for (int rd = 0;; ++rd) {
            int mt, nt; if (!gemm_order(rd, 15, mt, nt)) break;
            gemm_tile<8>(AFPlain{p.A, 1024}, p.WinT + (size_t)nt * 128 * 1024, 1024, mt * 128, nt * 128, EpiProj{p.proj}, smem);
        }
        xcd_barrier(xb);
        for (int it = blockIdx.x; it < 1024; it += gridDim.x) rwkv_prep(p, it, smem);
        xcd_barrier(xb);
        phase4_fused(p, smem, xb2);
        xcd_barrier(xb);
    } else {
        run_phase(p, 1, smem); xcd_barrier(xb);
        run_phase(p, 2, smem); xcd_barrier(xb);
        run_phase(p, 3, smem); xcd_barrier(xb);
        run_phase(p, 4, smem); xcd_barrier(xb);
    }
    run_phase(p, 5, smem); xcd_barrier(xb);
    run_phase(p, 6, smem); xcd_barrier(xb);
    run_phase(p, 7, smem); xcd_barrier(xb);
    run_phase(p, 8, smem); xcd_barrier(xb);
    run_phase(p, 9, smem); xcd_barrier(xb);
    run_phase(p, 10, smem);
}
__global__ void __launch_bounds__(NTHR, 2) phase_kernel(P p, int ph) {
    __shared__ __attribute__((aligned(16))) char smem[SMEM_BYTES];
    run_phase(p, ph, smem);
}

extern "C" void kernel_launch(void* const* d_in, const int* in_sizes, int n_in, void* d_out, int out_size, void* d_ws, size_t ws_size,
                              hipStream_t stream) {
    P p{};
    p.x = (const float*)d_in[0]; p.pos = (const int*)d_in[1]; p.norm_mix = (const float*)d_in[2]; p.w_in = (const float*)d_in[3];
    p.mu = (const float*)d_in[4]; p.w0 = (const float*)d_in[5]; p.w2 = (const float*)d_in[6]; p.a0 = (const float*)d_in[7];
    p.a2 = (const float*)d_in[8]; p.g2 = (const float*)d_in[9]; p.k_k = (const float*)d_in[10]; p.k_a = (const float*)d_in[11];
    p.r_k = (const float*)d_in[12]; p.lnx_w = (const float*)d_in[13]; p.lnx_b = (const float*)d_in[14]; p.pe_k = (const float*)d_in[15];
    p.wk1 = (const float*)d_in[16]; p.bk1 = (const float*)d_in[17]; p.wk2 = (const float*)d_in[18]; p.pe_v = (const float*)d_in[19];
    p.wv1 = (const float*)d_in[20]; p.bv1 = (const float*)d_in[21]; p.wv2 = (const float*)d_in[22]; p.w_out = (const float*)d_in[23];
    p.norm_ffn = (const float*)d_in[24]; p.w_gate = (const float*)d_in[25]; p.w_up = (const float*)d_in[26]; p.w_down = (const float*)d_in[27];
    p.norm_final = (const float*)d_in[28];
    p.out = (float*)d_out;
    char* ws = (char*)d_ws;
    size_t off = 0;
    auto take = [&](size_t bytes) { char* r = ws + off; off += (bytes + 255) & ~(size_t)255; return r; };
    p.WinT = (bf16_t*)take((size_t)3200 * 1024 * 2);
    p.WoutT = (bf16_t*)take((size_t)1024 * 1024 * 2);
    p.WguT = (bf16_t*)take((size_t)5632 * 1024 * 2);
    p.WdnT = (bf16_t*)take((size_t)1024 * DFF * 2);
    p.w2T = (bf16_t*)take(512 * 64 * 2);
    p.a2T = (bf16_t*)take(512 * 64 * 2);
    p.g2T = (bf16_t*)take(512 * 160 * 2);
    p.w1T = (bf16_t*)take((size_t)2 * 256 * 2048 * 2);
    p.wc2T = (bf16_t*)take(2 * 128 * 256 * 2);
    p.b1p = (float*)take(512 * 4);
    p.cosT = (float*)take((size_t)T_ * 8 * 4);
    p.sinT = (float*)take((size_t)T_ * 8 * 4);
    p.counter = (unsigned*)take(256);
    p.bar = (unsigned*)take(2 * XCD_BAR_WORDS * 4);
    off = (size_t)32 << 20;
    p.A = (bf16_t*)take((size_t)T_ * 1024 * 2);
    p.proj = (bf16_t*)take((size_t)T_ * PLD * 2);
    p.stream = (bf16_t*)take((size_t)T_ * 8 * 384 * 2);
    p.ksw = (bf16_t*)take((size_t)4 * 256 * 4096 * 2);
    p.vsw = (bf16_t*)take((size_t)4 * 256 * 4096 * 2);
    if (off > ws_size) fprintf(stderr, "workspace too small: need %zu have %zu\n", off, ws_size);
    char* ob = (char*)d_out;
    p.gbuf = (bf16_t*)ob;
    p.yraw = (float*)(ob + ((size_t)32 << 20));
    p.vT = (bf16_t*)(ob + ((size_t)96 << 20));
    p.hid = (bf16_t*)(ob + ((size_t)112 << 20));
    p.kc = (bf16_t*)(ob + ((size_t)116 << 20));
    p.vcT = (bf16_t*)(ob + ((size_t)116 << 20) + (512 << 10));
#if MK_SINGLE
    static int grid_blocks = 0;
    if (!grid_blocks) {
        int dev = 0, cus = 0, per_cu = 0;
        hipGetDevice(&dev);
        hipDeviceGetAttribute(&cus, hipDeviceAttributeMultiprocessorCount, dev);
        hipOccupancyMaxActiveBlocksPerMultiprocessor(&per_cu, mega_kernel, NTHR, 0);
        if (per_cu > 2) per_cu = 2;
        if (per_cu < 1) per_cu = 1;
        grid_blocks = cus * per_cu;
    }
    (void)hipMemsetAsync(p.bar, 0, 2 * XCD_BAR_WORDS * 4, stream);
    void* args[] = {&p};
    hipError_t e = hipLaunchCooperativeKernel((void*)mega_kernel, dim3(grid_blocks), dim3(NTHR), args, 0, stream);
    if (e != hipSuccess) fprintf(stderr, "cooperative launch failed: %s (grid %d)\n", hipGetErrorString(e), grid_blocks);
#else
    for (int ph = 0; ph < NPHASE; ++ph) phase_kernel<<<512, NTHR, 0, stream>>>(p, ph);
#endif
}
```

```cpp
#include <hip/hip_runtime.h>
#include <hip/hip_cooperative_groups.h>
#include <cstdio>
namespace cg = cooperative_groups;

#ifndef MK_SINGLE
#define MK_SINGLE 1
#endif

#define DI __device__ __forceinline__
typedef unsigned short bf16_t;
typedef short bf16x8 __attribute__((ext_vector_type(8)));
typedef float f32x16 __attribute__((ext_vector_type(16)));
typedef __bf16 bf2_t __attribute__((ext_vector_type(2)));
typedef float f2_t __attribute__((ext_vector_type(2)));

constexpr int T_ = 32768, S_ = 16384;
constexpr int PLD = 3200;
constexpr int QC = 1856, KVC = 2368, GC = 3136;
constexpr int DFF = 2816;
constexpr int NTHR = 256;
constexpr float QSC = 0.125f * 1.4426950408889634f;

#define MFMA32(a, b, c) __builtin_amdgcn_mfma_f32_32x32x16_bf16((a), (b), (c), 0, 0, 0)

DI int tidx() { int r; asm volatile("v_mov_b32 %0, %1" : "=v"(r) : "v"(threadIdx.x)); return r; }
DI unsigned pack2(float a, float b) { f2_t v = {a, b}; return __builtin_bit_cast(unsigned, __builtin_convertvector(v, bf2_t)); }
DI float bflo(unsigned u) { return __uint_as_float(u << 16); }
DI float bfhi(unsigned u) { return __uint_as_float(u & 0xffff0000u); }
DI bf16_t f2bf(float a) { return (bf16_t)(pack2(a, 0.f) & 0xffffu); }
DI void unpack8(const uint4& u, float (&f)[8]) {
    f[0] = bflo(u.x); f[1] = bfhi(u.x); f[2] = bflo(u.y); f[3] = bfhi(u.y);
    f[4] = bflo(u.z); f[5] = bfhi(u.z); f[6] = bflo(u.w); f[7] = bfhi(u.w);
}
DI uint4 pack8(const float (&f)[8]) { uint4 u; u.x = pack2(f[0], f[1]); u.y = pack2(f[2], f[3]); u.z = pack2(f[4], f[5]); u.w = pack2(f[6], f[7]); return u; }
DI float wave_sum(float v) {
#pragma unroll
    for (int o = 32; o; o >>= 1) v += __shfl_xor(v, o);
    return v;
}
DI float sigmoidf_(float x) { return 1.f / (1.f + __expf(-x)); }
DI int crow(int reg, int h) { return (reg & 3) + 8 * (reg >> 2) + 4 * h; }

struct P {
    const float* x; const int* pos; const float *norm_mix, *w_in, *mu, *w0, *w2, *a0, *a2, *g2, *k_k, *k_a, *r_k, *lnx_w, *lnx_b,
        *pe_k, *wk1, *bk1, *wk2, *pe_v, *wv1, *bv1, *wv2, *w_out, *norm_ffn, *w_gate, *w_up, *w_down, *norm_final;
    float* out;
    bf16_t *WinT, *WoutT, *WguT, *WdnT, *w2T, *a2T, *g2T, *w1T, *wc2T;
    float *b1p, *cosT, *sinT;
    unsigned* counter; unsigned* bar;
    bf16_t *A, *proj, *stream;
    bf16_t* gbuf; float* yraw; bf16_t *vT, *hid, *kc, *vcT, *ksw, *vsw;
};

DI float tr_val(const P& p, int job, int k, int n) {
    switch (job) {
    case 0: { int c = n < 1824 ? n : ((n >= 1856 && n < 3160) ? n - 32 : -1); return c >= 0 ? p.w_in[(size_t)k * 3128 + c] : 0.f; }
    case 1: return p.w_out[k * 1024 + n];
    case 2: { int q = n >> 6, r = n & 63; return r < 32 ? p.w_gate[(size_t)k * DFF + q * 32 + r] : p.w_up[(size_t)k * DFF + q * 32 + r - 32]; }
    case 3: return p.w_down[(size_t)k * 1024 + n];
    case 4: return p.w2[k * 512 + n];
    case 5: return p.a2[k * 512 + n];
    case 6: return p.g2[k * 512 + n];
    case 7: return p.wk1[k * 256 + n];
    case 8: return p.wv1[k * 256 + n];
    case 9: return n < 64 ? p.wk2[k * 64 + n] : 0.f;
    default: return n < 64 ? p.wv2[k * 64 + n] : 0.f;
    }
}
DI void tr_item(const P& p, int it, float* tile) {
    int job, K, N; bf16_t* dst;
    if (it < 800) { job = 0; K = 1024; N = 3200; dst = p.WinT; }
    else if (it < 1056) { job = 1; it -= 800; K = 1024; N = 1024; dst = p.WoutT; }
    else if (it < 2464) { job = 2; it -= 1056; K = 1024; N = 5632; dst = p.WguT; }
    else if (it < 3168) { job = 3; it -= 2464; K = 2816; N = 1024; dst = p.WdnT; }
    else if (it < 3176) { job = 4; it -= 3168; K = 64; N = 512; dst = p.w2T; }
    else if (it < 3184) { job = 5; it -= 3176; K = 64; N = 512; dst = p.a2T; }
    else if (it < 3208) { job = 6; it -= 3184; K = 160; N = 512; dst = p.g2T; }
    else if (it < 3336) { job = 7; it -= 3208; K = 2048; N = 256; dst = p.w1T; }
    else if (it < 3464) { job = 8; it -= 3336; K = 2048; N = 256; dst = p.w1T + 256 * 2048; }
    else if (it < 3472) { job = 9; it -= 3464; K = 256; N = 128; dst = p.wc2T; }
    else { job = 10; it -= 3472; K = 256; N = 128; dst = p.wc2T + 128 * 256; }
    const int nt = N >> 6;
    const int k0 = (it / nt) * 64, n0 = (it % nt) * 64;
    const int tid = tidx();
    __syncthreads();
#pragma unroll 4
    for (int i = 0; i < 16; ++i) {
        const int kk = i * 4 + (tid >> 6), nn = tid & 63;
        tile[kk * 65 + nn] = (k0 + kk < K) ? tr_val(p, job, k0 + kk, n0 + nn) : 0.f;
    }
    __syncthreads();
#pragma unroll 4
    for (int i = 0; i < 16; ++i) {
        const int nn = i * 4 + (tid >> 6), kk = tid & 63;
        if (k0 + kk < K) dst[(size_t)(n0 + nn) * K + k0 + kk] = f2bf(tile[kk * 65 + nn]);
    }
}
DI void b1_item(const P& p, int idx) {
    const int kv = idx >> 4, jc = idx & 15, tid = tidx();
    const float* pe = kv ? p.pe_v : p.pe_k; const float* w1 = kv ? p.wv1 : p.wk1; const float* b1 = kv ? p.bv1 : p.bk1;
    const int j = jc * 16 + (tid >> 4), kl = tid & 15;
    float s = 0.f;
    for (int i = 0; i < 128; ++i) { const int k = kl + 16 * i; s += pe[k] * w1[k * 256 + j]; }
    s += __shfl_xor(s, 1); s += __shfl_xor(s, 2); s += __shfl_xor(s, 4); s += __shfl_xor(s, 8);
    if (kl == 0) p.b1p[kv * 256 + j] = b1[j] + s;
}
DI void sincos_d(float ang, float& c, float& s) {
    double x = (double)ang;
    const double TWO_PI = 6.283185307179586476925286766559;
    double n = __builtin_rint(x * (1.0 / TWO_PI));
    double r = x - n * TWO_PI;
    double q = r * 0.25;
    double q2 = q * q;
    double sn = q * (1.0 + q2 * (-1.0 / 6 + q2 * (1.0 / 120 + q2 * (-1.0 / 5040 + q2 * (1.0 / 362880 + q2 * (-1.0 / 39916800 + q2 * (1.0 / 6227020800.0)))))));
    double cs = 1.0 + q2 * (-0.5 + q2 * (1.0 / 24 + q2 * (-1.0 / 720 + q2 * (1.0 / 40320 + q2 * (-1.0 / 3628800 + q2 * (1.0 / 479001600.0))))));
    double s2 = 2 * sn * cs, c2 = 1 - 2 * sn * sn;
    double s4 = 2 * s2 * c2, c4 = 1 - 2 * s2 * s2;
    c = (float)c4; s = (float)s4;
}
DI void cs_item(const P& p, int idx) {
    const int e = idx * 256 + tidx(), tok = e >> 3, f = e & 7;
    const float invf[8] = {1.000000000e+00f, 1.939227432e-01f, 3.760603070e-02f, 7.292664610e-03f, 1.414213562e-03f, 2.742481884e-04f, 5.318295734e-05f, 1.031338525e-05f};
    float iv = invf[0];
#pragma unroll
    for (int i = 1; i < 8; ++i) iv = (f == i) ? invf[i] : iv;
    const float ang = (float)p.pos[tok] * iv;
    float c, s; sincos_d(ang, c, s);
    p.cosT[e] = c; p.sinT[e] = s;
}
DI void rms_item(const float* src, const float* g, bf16_t* dst, int idx) {
    const int row = idx * 4 + (tidx() >> 6), lane = tidx() & 63;
    const float4* sp = (const float4*)(src + (size_t)row * 1024);
    float4 v[4]; float ss = 0.f;
#pragma unroll
    for (int i = 0; i < 4; ++i) { v[i] = sp[lane + 64 * i]; ss += v[i].x * v[i].x + v[i].y * v[i].y + v[i].z * v[i].z + v[i].w * v[i].w; }
    ss = wave_sum(ss);
    const float rs = rsqrtf(ss * (1.f / 1024.f) + 1e-6f);
#pragma unroll
    for (int i = 0; i < 4; ++i) {
        const float4 gv = ((const float4*)g)[lane + 64 * i];
        uint2 o; o.x = pack2(v[i].x * rs * gv.x, v[i].y * rs * gv.y); o.y = pack2(v[i].z * rs * gv.z, v[i].w * rs * gv.w);
        *(uint2*)(dst + (size_t)row * 1024 + (lane + 64 * i) * 4) = o;
    }
}
DI void phase0(const P& p, char* smem) {
    if (blockIdx.x == 0 && tidx() < 8) p.counter[tidx()] = 0u;
    constexpr int NTR = 3480, NB1 = 32, NCS = 1024, NXN = 8192;
    for (int it = blockIdx.x; it < NTR + NB1 + NCS + NXN; it += gridDim.x) {
        if (it < NTR) { if (gridDim.x != 512 || it < 800 || it >= 3168) tr_item(p, it, (float*)smem); }
        else if (it < NTR + NB1) b1_item(p, it - NTR);
        else if (it < NTR + NB1 + NCS) cs_item(p, it - NTR - NB1);
        else rms_item(p.x, p.norm_mix, p.A, it - NTR - NB1 - NCS);
    }
}

struct AFPlain { const bf16_t* A; int lda; DI uint4 load(int row, int k) const { return *(const uint4*)(A + (size_t)row * lda + k); } };
struct AFCmp {
    const bf16_t* base;
    DI uint4 load(int r, int k) const { int tok = 16 * r + (k >> 6); tok = tok < S_ ? tok : S_ - 1; return *(const uint4*)(base + (size_t)tok * PLD + (k & 63)); }
};

template <int KU, class AF, class EPI>
DI void gemm_tile(const AF af, const bf16_t* __restrict__ Bt, const int K, const int m0, const int n0, const EPI epi, char* smem) {
    const int tid = tidx(), wave = tid >> 6, lane = tid & 63, wm = wave >> 1, wn = wave & 1, rr = lane & 31, hh = lane >> 5;
    f32x16 acc[2][2];
#pragma unroll
    for (int a = 0; a < 2; ++a)
#pragma unroll
        for (int b = 0; b < 2; ++b)
#pragma unroll
            for (int i = 0; i < 16; ++i) acc[a][b][i] = 0.f;
    const int lrow = tid >> 3, lk = (tid & 7) * 8;
#define GLOAD(R, KO) \
    R##a0 = af.load(m0 + lrow, (KO) + lk); R##a1 = af.load(m0 + lrow + 32, (KO) + lk); R##a2 = af.load(m0 + lrow + 64, (KO) + lk); R##a3 = af.load(m0 + lrow + 96, (KO) + lk); \
    R##b0 = *(const uint4*)(Bt + (size_t)(lrow) * K + (KO) + lk); R##b1 = *(const uint4*)(Bt + (size_t)(lrow + 32) * K + (KO) + lk); \
    R##b2 = *(const uint4*)(Bt + (size_t)(lrow + 64) * K + (KO) + lk); R##b3 = *(const uint4*)(Bt + (size_t)(lrow + 96) * K + (KO) + lk);
#define GSTORE(R, SA, SB) \
    *(uint4*)&(SA)[(lrow) * 72 + lk] = R##a0; *(uint4*)&(SA)[(lrow + 32) * 72 + lk] = R##a1; *(uint4*)&(SA)[(lrow + 64) * 72 + lk] = R##a2; *(uint4*)&(SA)[(lrow + 96) * 72 + lk] = R##a3; \
    *(uint4*)&(SB)[(lrow) * 72 + lk] = R##b0; *(uint4*)&(SB)[(lrow + 32) * 72 + lk] = R##b1; *(uint4*)&(SB)[(lrow + 64) * 72 + lk] = R##b2; *(uint4*)&(SB)[(lrow + 96) * 72 + lk] = R##b3;
#define GCOMPUTE(SA, SB) \
    _Pragma("unroll") for (int ks = 0; ks < 4; ++ks) { \
        bf16x8 tf0 = *(const bf16x8*)&(SA)[(wm * 64 + rr) * 72 + ks * 16 + hh * 8], tf1 = *(const bf16x8*)&(SA)[(wm * 64 + 32 + rr) * 72 + ks * 16 + hh * 8]; \
        bf16x8 wf0 = *(const bf16x8*)&(SB)[(wn * 64 + rr) * 72 + ks * 16 + hh * 8], wf1 = *(const bf16x8*)&(SB)[(wn * 64 + 32 + rr) * 72 + ks * 16 + hh * 8]; \
        acc[0][0] = MFMA32(wf0, tf0, acc[0][0]); acc[0][1] = MFMA32(wf0, tf1, acc[0][1]); acc[1][0] = MFMA32(wf1, tf0, acc[1][0]); acc[1][1] = MFMA32(wf1, tf1, acc[1][1]); }
    uint4 Xa0, Xa1, Xa2, Xa3, Xb0, Xb1, Xb2, Xb3, Ya0, Ya1, Ya2, Ya3, Yb0, Yb1, Yb2, Yb3;
    bf16_t* const sA0 = (bf16_t*)smem; bf16_t* const sB0 = sA0 + 128 * 72; bf16_t* const sA1 = sB0 + 128 * 72; bf16_t* const sB1 = sA1 + 128 * 72;
    GLOAD(X, 0)
    GLOAD(Y, 64)
    __syncthreads();
    GSTORE(X, sA0, sB0)
    __syncthreads();
#pragma unroll KU
    for (int k0 = 0; k0 < K; k0 += 128) {
        const bool more = (k0 + 128 < K);
        if (more) { GLOAD(X, k0 + 128) }
        __builtin_amdgcn_s_setprio(1);
        GCOMPUTE(sA0, sB0)
        __builtin_amdgcn_s_setprio(0);
        GSTORE(Y, sA1, sB1)
        __syncthreads();
        __builtin_amdgcn_sched_barrier(0);
        if (more) { GLOAD(Y, k0 + 192) }
        __builtin_amdgcn_s_setprio(1);
        GCOMPUTE(sA1, sB1)
        __builtin_amdgcn_s_setprio(0);
        if (more) { GSTORE(X, sA0, sB0) }
        __syncthreads();
        __builtin_amdgcn_sched_barrier(0);
    }
#undef GLOAD
#undef GSTORE
#undef GCOMPUTE
    epi(acc, m0 + wm * 64, n0 + wn * 64, lane);
}

struct EpiProj {
    bf16_t* C;
    DI void operator()(const f32x16 (&acc)[2][2], int rowbase, int colbase, int lane) const {
        const int rr = lane & 31, hh = lane >> 5;
#pragma unroll
        for (int w = 0; w < 2; ++w)
#pragma unroll
            for (int t = 0; t < 2; ++t)
#pragma unroll
                for (int j = 0; j < 4; ++j) {
                    uint2 o; o.x = pack2(acc[w][t][4 * j], acc[w][t][4 * j + 1]); o.y = pack2(acc[w][t][4 * j + 2], acc[w][t][4 * j + 3]);
                    *(uint2*)(C + (size_t)(rowbase + t * 32 + rr) * PLD + colbase + w * 32 + j * 8 + hh * 4) = o;
                }
    }
};
struct EpiHid {
    bf16_t* H; const float* bias;
    DI void operator()(const f32x16 (&acc)[2][2], int rowbase, int colbase, int lane) const {
        const int rr = lane & 31, hh = lane >> 5;
#pragma unroll
        for (int w = 0; w < 2; ++w)
#pragma unroll
            for (int t = 0; t < 2; ++t)
#pragma unroll
                for (int j = 0; j < 4; ++j) {
                    const int col = colbase + w * 32 + j * 8 + hh * 4;
                    const float4 bv = *(const float4*)(bias + col);
                    float v0 = acc[w][t][4 * j] + bv.x, v1 = acc[w][t][4 * j + 1] + bv.y, v2 = acc[w][t][4 * j + 2] + bv.z, v3 = acc[w][t][4 * j + 3] + bv.w;
                    v0 *= sigmoidf_(v0); v1 *= sigmoidf_(v1); v2 *= sigmoidf_(v2); v3 *= sigmoidf_(v3);
                    uint2 o; o.x = pack2(v0, v1); o.y = pack2(v2, v3);
                    *(uint2*)(H + (size_t)(rowbase + t * 32 + rr) * 256 + col) = o;
                }
    }
};
struct EpiKc {
    bf16_t* kc; const float *cosT, *sinT; int tokbase;
    DI void operator()(const f32x16 (&acc)[2][2], int rowbase, int colbase, int lane) const {
        if (colbase != 0) return;
        const int rr = lane & 31, hh = lane >> 5;
#pragma unroll
        for (int t = 0; t < 2; ++t) {
            const int r = rowbase + t * 32 + rr;
            int tk = 31 + 16 * r; tk = tk < S_ ? tk : S_ - 1;
            const float4 c = *(const float4*)(cosT + (size_t)(tokbase + tk) * 8 + hh * 4), s = *(const float4*)(sinT + (size_t)(tokbase + tk) * 8 + hh * 4);
            bf16_t* kp = kc + (size_t)r * 64 + hh * 4;
            const float a0 = acc[0][t][0], a1 = acc[0][t][1], a2 = acc[0][t][2], a3 = acc[0][t][3];
            const float b0 = acc[0][t][4], b1 = acc[0][t][5], b2 = acc[0][t][6], b3 = acc[0][t][7];
            uint2 o;
            o.x = pack2(a0 * c.x - b0 * s.x, a1 * c.y - b1 * s.y); o.y = pack2(a2 * c.z - b2 * s.z, a3 * c.w - b3 * s.w);
            *(uint2*)(kp) = o;
            o.x = pack2(b0 * c.x + a0 * s.x, b1 * c.y + a1 * s.y); o.y = pack2(b2 * c.z + a2 * s.z, b3 * c.w + a3 * s.w);
            *(uint2*)(kp + 8) = o;
#pragma unroll
            for (int j = 2; j < 4; ++j) {
                o.x = pack2(acc[0][t][4 * j], acc[0][t][4 * j + 1]); o.y = pack2(acc[0][t][4 * j + 2], acc[0][t][4 * j + 3]);
                *(uint2*)(kp + j * 8) = o;
            }
#pragma unroll
            for (int j = 0; j < 4; ++j) {
                o.x = pack2(acc[1][t][4 * j], acc[1][t][4 * j + 1]); o.y = pack2(acc[1][t][4 * j + 2], acc[1][t][4 * j + 3]);
                *(uint2*)(kp + 32 + j * 8) = o;
            }
        }
    }
};
struct EpiVc {
    bf16_t* vcT; char* smem;
    DI void operator()(const f32x16 (&acc)[2][2], int rowbase, int colbase, int lane) const {
        const int rr = lane & 31, hh = lane >> 5;
        bf16_t* tl = (bf16_t*)smem;
        __syncthreads();
        if (colbase == 0) {
            const int rl = rowbase & 127;
#pragma unroll
            for (int w = 0; w < 2; ++w)
#pragma unroll
                for (int t = 0; t < 2; ++t)
#pragma unroll
                    for (int i = 0; i < 16; ++i) tl[(w * 32 + crow(i, hh)) * 136 + rl + t * 32 + rr] = f2bf(acc[w][t][i]);
        }
        __syncthreads();
        const int m0 = rowbase & ~127;
#pragma unroll
        for (int i = 0; i < 4; ++i) {
            const int c = tidx() + i * 256, d = c >> 4, ch = c & 15;
            *(uint4*)(vcT + (size_t)d * 1024 + m0 + ch * 8) = *(const uint4*)&tl[d * 136 + ch * 8];
        }
    }
};
struct EpiOut {
    float* out; const float* x;
    DI void operator()(const f32x16 (&acc)[2][2], int rowbase, int colbase, int lane) const {
        const int rr = lane & 31, hh = lane >> 5;
#pragma unroll
        for (int w = 0; w < 2; ++w)
#pragma unroll
            for (int t = 0; t < 2; ++t)
#pragma unroll
                for (int j = 0; j < 4; ++j) {
                    const size_t o = (size_t)(rowbase + t * 32 + rr) * 1024 + colbase + w * 32 + j * 8 + hh * 4;
                    float4 xv = *(const float4*)(x + o);
                    xv.x += acc[w][t][4 * j]; xv.y += acc[w][t][4 * j + 1]; xv.z += acc[w][t][4 * j + 2]; xv.w += acc[w][t][4 * j + 3];
                    *(float4*)(out + o) = xv;
                }
    }
};
struct EpiFfn1 {
    bf16_t* act;
    DI void operator()(const f32x16 (&acc)[2][2], int rowbase, int colbase, int lane) const {
        const int rr = lane & 31, hh = lane >> 5;
        const int cb = (colbase >> 6) * 32;
#pragma unroll
        for (int t = 0; t < 2; ++t)
#pragma unroll
            for (int j = 0; j < 4; ++j) {
                float v[4];
#pragma unroll
                for (int i = 0; i < 4; ++i) { const float g = acc[0][t][4 * j + i], u = acc[1][t][4 * j + i]; v[i] = g * sigmoidf_(g) * u; }
                uint2 o; o.x = pack2(v[0], v[1]); o.y = pack2(v[2], v[3]);
                *(uint2*)(act + (size_t)(rowbase + t * 32 + rr) * DFF + cb + j * 8 + hh * 4) = o;
            }
    }
};

DI void rwkv_prep(const P& p, int idx, char* smem) {
    const int tile = idx, tt0 = tile * 32;
    const int tid = tidx(), wave = tid >> 6, lane = tid & 63, rr = lane & 31, hh = lane >> 5;
    bf16_t* lat = (bf16_t*)smem;
    float* res = (float*)(smem + 32 * 296 * 2);
    __syncthreads();
    for (int c = tid; c < 32 * 36; c += NTHR) {
        const int tok = c / 36, ch = c - tok * 36, gi = tt0 + tok, col = 1536 + ch * 8;
        const uint4 cu = *(const uint4*)(p.proj + (size_t)gi * PLD + col);
        uint4 pv = make_uint4(0, 0, 0, 0);
        if ((gi & (S_ - 1)) != 0) pv = *(const uint4*)(p.proj + (size_t)(gi - 1) * PLD + col);
        float a[8], b[8]; unpack8(cu, a); unpack8(pv, b);
        const float4 m0 = *(const float4*)(p.mu + col), m1 = *(const float4*)(p.mu + col + 4);
        const float mu[8] = {m0.x, m0.y, m0.z, m0.w, m1.x, m1.y, m1.z, m1.w};
#pragma unroll
        for (int e = 0; e < 8; ++e) {
            float x = a[e] + (b[e] - a[e]) * mu[e];
            if (ch < 8) x = 1.f - 2.f / (1.f + __expf(2.f * x)); else if (ch >= 16) x = sigmoidf_(x);
            a[e] = x;
        }
        *(uint4*)&lat[tok * 296 + ch * 8] = pack8(a);
    }
    __syncthreads();
#pragma unroll 1
    for (int h = 0; h < 8; ++h) {
    if (wave < 2) {
        const int mt = wave;
        f32x16 aw, aa;
#pragma unroll
        for (int i = 0; i < 16; ++i) { aw[i] = 0.f; aa[i] = 0.f; }
#pragma unroll
        for (int ks = 0; ks < 4; ++ks) {
            const bf16x8 wf = *(const bf16x8*)(p.w2T + (size_t)(h * 64 + mt * 32 + rr) * 64 + ks * 16 + hh * 8);
            const bf16x8 af = *(const bf16x8*)(p.a2T + (size_t)(h * 64 + mt * 32 + rr) * 64 + ks * 16 + hh * 8);
            const bf16x8 l0 = *(const bf16x8*)&lat[rr * 296 + ks * 16 + hh * 8];
            const bf16x8 l1 = *(const bf16x8*)&lat[rr * 296 + 64 + ks * 16 + hh * 8];
            aw = MFMA32(wf, l0, aw); aa = MFMA32(af, l1, aa);
        }
#pragma unroll
        for (int j = 0; j < 4; ++j) {
            *(float4*)&res[(0 * 32 + rr) * 64 + mt * 32 + j * 8 + hh * 4] = make_float4(aw[4 * j], aw[4 * j + 1], aw[4 * j + 2], aw[4 * j + 3]);
            *(float4*)&res[(1 * 32 + rr) * 64 + mt * 32 + j * 8 + hh * 4] = make_float4(aa[4 * j], aa[4 * j + 1], aa[4 * j + 2], aa[4 * j + 3]);
        }
    } else {
        const int mt = wave - 2;
        f32x16 ag;
#pragma unroll
        for (int i = 0; i < 16; ++i) ag[i] = 0.f;
#pragma unroll
        for (int ks = 0; ks < 10; ++ks) {
            const bf16x8 gf = *(const bf16x8*)(p.g2T + (size_t)(h * 64 + mt * 32 + rr) * 160 + ks * 16 + hh * 8);
            const bf16x8 l2 = *(const bf16x8*)&lat[rr * 296 + 128 + ks * 16 + hh * 8];
            ag = MFMA32(gf, l2, ag);
        }
#pragma unroll
        for (int j = 0; j < 4; ++j)
            *(float4*)&res[(2 * 32 + rr) * 64 + mt * 32 + j * 8 + hh * 4] = make_float4(ag[4 * j], ag[4 * j + 1], ag[4 * j + 2], ag[4 * j + 3]);
    }
    __syncthreads();
    {
        const int tok = tid >> 3, cgp = tid & 7, gi = tt0 + tok, b = gi >> 14, s = gi & (S_ - 1), cb = h * 64 + cgp * 8;
        const bool first = (s == 0);
        float r[8], k[8], v[8];
        {
            float a[8], pb[8];
            const bf16_t* pr = p.proj + (size_t)gi * PLD;
#pragma unroll
            for (int q = 0; q < 3; ++q) {
                const int col = q * 512 + cb;
                unpack8(*(const uint4*)(pr + col), a);
                if (first) {
#pragma unroll
                    for (int e = 0; e < 8; ++e) pb[e] = 0.f;
                } else unpack8(*(const uint4*)(pr - PLD + col), pb);
                const float4 m0 = *(const float4*)(p.mu + col), m1 = *(const float4*)(p.mu + col + 4);
                const float mu[8] = {m0.x, m0.y, m0.z, m0.w, m1.x, m1.y, m1.z, m1.w};
#pragma unroll
                for (int e = 0; e < 8; ++e) {
                    const float x = a[e] + (pb[e] - a[e]) * mu[e];
                    if (q == 0) r[e] = x; else if (q == 1) k[e] = x; else v[e] = x;
                }
            }
        }
        float om[8], av[8], gg[8], kk[8], km[8], bb[8];
        float ss = 0.f;
#pragma unroll
        for (int e = 0; e < 8; ++e) {
            const float wp = res[(0 * 32 + tok) * 64 + cgp * 8 + e] + p.w0[cb + e];
            const float z = -wp;
            const float sp = fmaxf(z, 0.f) + __logf(1.f + __expf(-fabsf(z)));
            const float w = -sp - 0.5f;
            om[e] = 1.f - __expf(-__expf(w));
            av[e] = sigmoidf_(res[(1 * 32 + tok) * 64 + cgp * 8 + e] + p.a0[cb + e]);
            gg[e] = res[(2 * 32 + tok) * 64 + cgp * 8 + e];
            kk[e] = k[e] * p.k_k[cb + e];
            ss += kk[e] * kk[e];
            km[e] = k[e] * (1.f + (av[e] - 1.f) * p.k_a[cb + e]);
        }
        ss += __shfl_xor(ss, 1); ss += __shfl_xor(ss, 2); ss += __shfl_xor(ss, 4);
        const float inv = 1.f / fmaxf(sqrtf(ss), 1e-12f);
#pragma unroll
        for (int e = 0; e < 8; ++e) { kk[e] *= inv; bb[e] = kk[e] * av[e]; }
        bf16_t* sp = p.stream + ((size_t)((b * 8 + h) * S_ + s) * 6) * 64 + cgp * 8;
        *(uint4*)(sp) = pack8(om); *(uint4*)(sp + 64) = pack8(km); *(uint4*)(sp + 128) = pack8(kk);
        *(uint4*)(sp + 192) = pack8(bb); *(uint4*)(sp + 256) = pack8(r); *(uint4*)(sp + 320) = pack8(v);
        *(uint4*)(p.gbuf + (size_t)gi * 512 + cb) = pack8(gg);
    }
    __syncthreads();
    }
}

DI void rope_item(const P& p, int idx, char* smem) {
    const int tt0 = idx * 64, tid = tidx();
    bf16_t* vtile = (bf16_t*)smem;
    bf16_t* ktile = vtile + 4 * 64 * 72;
    __syncthreads();
#pragma unroll 1
    for (int it = 0; it < 2; ++it) {
        const int item = tid + it * 256, tok = item >> 3, head = item & 7, gi = tt0 + tok;
        bf16_t* ptr = p.proj + (size_t)gi * PLD + QC + head * 64;
        const float4 c0 = *(const float4*)(p.cosT + (size_t)gi * 8), c1 = *(const float4*)(p.cosT + (size_t)gi * 8 + 4);
        const float4 s0 = *(const float4*)(p.sinT + (size_t)gi * 8), s1 = *(const float4*)(p.sinT + (size_t)gi * 8 + 4);
        const float cc[8] = {c0.x, c0.y, c0.z, c0.w, c1.x, c1.y, c1.z, c1.w}, sn[8] = {s0.x, s0.y, s0.z, s0.w, s1.x, s1.y, s1.z, s1.w};
        float a[8], b[8];
        unpack8(*(const uint4*)ptr, a); unpack8(*(const uint4*)(ptr + 8), b);
#pragma unroll
        for (int e = 0; e < 8; ++e) { const float x1 = a[e], x2 = b[e]; a[e] = (x1 * cc[e] - x2 * sn[e]) * QSC; b[e] = (x2 * cc[e] + x1 * sn[e]) * QSC; }
        *(uint4*)ptr = pack8(a); *(uint4*)(ptr + 8) = pack8(b);
#pragma unroll
        for (int q = 2; q < 8; ++q) {
            unpack8(*(const uint4*)(ptr + q * 8), a);
#pragma unroll
            for (int e = 0; e < 8; ++e) a[e] *= QSC;
            *(uint4*)(ptr + q * 8) = pack8(a);
        }
    }
    {
        const int tok = tid >> 2, sel = (tid >> 1) & 1, hk = tid & 1, gi = tt0 + tok;
        const float4 c0 = *(const float4*)(p.cosT + (size_t)gi * 8), c1 = *(const float4*)(p.cosT + (size_t)gi * 8 + 4);
        const float4 s0 = *(const float4*)(p.sinT + (size_t)gi * 8), s1 = *(const float4*)(p.sinT + (size_t)gi * 8 + 4);
        const float cc[8] = {c0.x, c0.y, c0.z, c0.w, c1.x, c1.y, c1.z, c1.w}, sn[8] = {s0.x, s0.y, s0.z, s0.w, s1.x, s1.y, s1.z, s1.w};
        float a[8], b[8];
        {
            bf16_t* ptr = p.proj + (size_t)gi * PLD + KVC + (sel ? 4 : 2) * 128 + hk * 64;
            unpack8(*(const uint4*)ptr, a); unpack8(*(const uint4*)(ptr + 8), b);
#pragma unroll
            for (int e = 0; e < 8; ++e) { const float x1 = a[e], x2 = b[e]; a[e] = x1 * cc[e] - x2 * sn[e]; b[e] = x2 * cc[e] + x1 * sn[e]; }
            const uint4 ra_ = pack8(a), rb_ = pack8(b);
            *(uint4*)ptr = ra_; *(uint4*)(ptr + 8) = rb_;
            if (sel == 0) {
                bf16_t* kt = ktile + (size_t)(hk * 64 + tok) * 72;
                *(uint4*)kt = ra_; *(uint4*)(kt + 8) = rb_;
#pragma unroll
                for (int q = 2; q < 8; ++q) *(uint4*)(kt + q * 8) = *(const uint4*)(ptr + q * 8);
            }
        }
        {
            const bf16_t* ptr = p.proj + (size_t)gi * PLD + KVC + (sel ? 5 : 3) * 128 + hk * 64;
            bf16_t* vt = vtile + (size_t)((sel * 2 + hk) * 64) * 72 + tok;
            unpack8(*(const uint4*)ptr, a); unpack8(*(const uint4*)(ptr + 8), b);
#pragma unroll
            for (int e = 0; e < 8; ++e) { const float x1 = a[e], x2 = b[e]; a[e] = x1 * cc[e] - x2 * sn[e]; b[e] = x2 * cc[e] + x1 * sn[e]; }
#pragma unroll
            for (int e = 0; e < 8; ++e) { vt[e * 72] = f2bf(a[e]); vt[(8 + e) * 72] = f2bf(b[e]); }
#pragma unroll
            for (int q = 2; q < 8; ++q) {
                const uint4 u = *(const uint4*)(ptr + q * 8);
                const unsigned w[4] = {u.x, u.y, u.z, u.w};
#pragma unroll
                for (int e = 0; e < 4; ++e) { vt[(q * 8 + 2 * e) * 72] = (bf16_t)(w[e] & 0xffffu); vt[(q * 8 + 2 * e + 1) * 72] = (bf16_t)(w[e] >> 16); }
            }
        }
    }
    __syncthreads();
    const int b = tt0 >> 14, s0 = tt0 & (S_ - 1);
#pragma unroll
    for (int i = 0; i < 8; ++i) {
        const int c = tid + i * 256, grp = c >> 9, d = (c >> 3) & 63, ch = c & 7, sel = grp >> 1, hk = grp & 1;
        const uint4 u = *(const uint4*)&vtile[(size_t)(grp * 64 + d) * 72 + ch * 8];
        *(uint4*)(p.vT + ((size_t)((sel * 4 + b * 2 + hk) * 64 + d)) * S_ + s0 + ch * 8) = u;
    }
    const int blk = s0 >> 6;
#pragma unroll
    for (int i = 0; i < 4; ++i) {
        const int c = tid + i * 256, hk = c >> 9, g8 = (c >> 6) & 7, ln = c & 63;
        const size_t dsto = ((size_t)(((b * 2 + hk) * 256 + blk) * 8 + g8) * 64 + ln) * 8;
        const int m16 = ln & 15, g4 = ln >> 4;
        {
            const int kg = g8 >> 1, ks = g8 & 1;
            *(uint4*)(p.ksw + dsto) = *(const uint4*)&ktile[(size_t)(hk * 64 + kg * 16 + m16) * 72 + ks * 32 + g4 * 8];
        }
        {
            const int kk = g8 >> 2, dt = g8 & 3;
            const bf16_t* row = &vtile[(size_t)((0 * 2 + hk) * 64 + dt * 16 + m16) * 72 + kk * 32 + 4 * g4];
            const uint2 lo = *(const uint2*)row, hi = *(const uint2*)(row + 16);
            *(uint4*)(p.vsw + dsto) = make_uint4(lo.x, lo.y, hi.x, hi.y);
        }
    }
}

DI void cmp1_item(const P& p, const int it, char* smem) {
    const int kv = it >> 6, bhk = (it >> 4) & 3, mt = (it >> 1) & 7, nt = it & 1, b = bhk >> 1, hk = bhk & 1;
    AFCmp af{p.proj + (size_t)(b * S_) * PLD + KVC + kv * 128 + hk * 64};
    EpiHid ep{p.hid + (size_t)((kv * 4 + bhk) * 1024) * 256, p.b1p + kv * 256};
    gemm_tile<1>(af, p.w1T + (size_t)(kv * 256 + nt * 128) * 2048, 2048, mt * 128, nt * 128, ep, smem);
}
DI void cmp2_item(const P& p, const int it, char* smem) {
    const int kv = it >> 5, bhk = (it >> 3) & 3, mt = it & 7, b = bhk >> 1;
    AFPlain af{p.hid + (size_t)((kv * 4 + bhk) * 1024) * 256, 256};
    if (kv == 0) { EpiKc ep{p.kc + (size_t)bhk * 1024 * 64, p.cosT, p.sinT, b * S_}; gemm_tile<1>(af, p.wc2T, 256, mt * 128, 0, ep, smem); }
    else { EpiVc ep{p.vcT + (size_t)bhk * 64 * 1024, smem}; gemm_tile<1>(af, p.wc2T + 128 * 256, 256, mt * 128, 0, ep, smem); }
}
DI void phase2(const P& p, char* smem) {
    for (int it = blockIdx.x; it < 128 + 512 + 1024; it += gridDim.x) {
        if (it < 128) cmp1_item(p, it, smem);
        else if (it < 640) rope_item(p, it - 128, smem);
        else rwkv_prep(p, it - 640, smem);
    }
}
DI void phase3(const P& p, char* smem) {
    for (int it = blockIdx.x; it < 64; it += gridDim.x) cmp2_item(p, it, smem);
}

template <int CTRL> DI float dpp_add(float x) { return x + __int_as_float(__builtin_amdgcn_mov_dpp(__float_as_int(x), CTRL, 0xF, 0xF, true)); }
DI float red16(float x) { x = dpp_add<0xB1>(x); x = dpp_add<0x4E>(x); x = dpp_add<0x141>(x); x = dpp_add<0x140>(x); return x; }

DI void cvt_store(const uint4 u, const bool isom, float* d) {
    float f0 = bflo(u.x), f1 = bfhi(u.x), f2 = bflo(u.y), f3 = bfhi(u.y), f4 = bflo(u.z), f5 = bfhi(u.z), f6 = bflo(u.w), f7 = bfhi(u.w);
    if (isom) { f0 = 1.f - f0; f1 = 1.f - f1; f2 = 1.f - f2; f3 = 1.f - f3; f4 = 1.f - f4; f5 = 1.f - f5; f6 = 1.f - f6; f7 = 1.f - f7; }
    *(float4*)d = make_float4(f0, f1, f2, f3); *(float4*)(d + 4) = make_float4(f4, f5, f6, f7);
}
DI void scan_unit(const P& p, int su, char* smem) {
    const int xcd = su & 7, kq = su >> 3, bh = xcd * 2 + (kq >> 3), oct = kq & 7, b = bh >> 3, h = bh & 7;
    const int tid = tidx(), wave = tid >> 6, lane = tid & 63;
    float* buf = (float*)smem;
    float* ypb = (float*)(smem + 49152);
    const bf16_t* sbase = p.stream + (size_t)bh * S_ * 384;
    __syncthreads();
#pragma unroll
    for (int i = 0; i < 3; ++i) { const int ci = tid + i * 256; cvt_store(*(const uint4*)(sbase + (size_t)ci * 8), (ci % 48) < 8, buf + ci * 8); }
    __syncthreads();
    if (wave < 2) {
        const int rl = lane >> 4, ks = lane & 15, row = oct * 8 + wave * 4 + rl;
        f2_t sA = {0.f, 0.f}, sB = {0.f, 0.f};
        __builtin_amdgcn_s_setprio(3);
        for (int c = 0; c < 1024; ++c) {
            const float* cb = buf + (c & 1) * 6144 + ks * 4;
            const float* vb = buf + (c & 1) * 6144 + 320 + row;
            float* yo = ypb + ((c & 1) * 2 + wave) * 1024 + lane;
            float4 dec = *(const float4*)(cb), km = *(const float4*)(cb + 64), kk = *(const float4*)(cb + 128), bb = *(const float4*)(cb + 192), rv = *(const float4*)(cb + 256);
            float v = vb[0];
            float4 dec1 = *(const float4*)(cb + 384), km1 = *(const float4*)(cb + 384 + 64), kk1 = *(const float4*)(cb + 384 + 128), bb1 = *(const float4*)(cb + 384 + 192), rv1 = *(const float4*)(cb + 384 + 256);
            float v1 = vb[384];
#pragma unroll
            for (int st = 0; st < 16; ++st) {
                float4 dec2 = dec1, km2 = km1, kk2 = kk1, bb2 = bb1, rv2 = rv1; float v2 = v1;
                if (st < 14) {
                    const float* rec = cb + (st + 2) * 384;
                    dec2 = *(const float4*)(rec); km2 = *(const float4*)(rec + 64); kk2 = *(const float4*)(rec + 128); bb2 = *(const float4*)(rec + 192); rv2 = *(const float4*)(rec + 256);
                    v2 = vb[(st + 2) * 384];
                }
                __builtin_amdgcn_sched_barrier(0x207);
                const f2_t vv = {v, v};
                const f2_t d01 = {dec.x, dec.y}, d23 = {dec.z, dec.w}, m01 = {km.x, km.y}, m23 = {km.z, km.w};
                const f2_t k01 = {kk.x, kk.y}, k23 = {kk.z, kk.w}, b01 = {bb.x, bb.y}, b23 = {bb.z, bb.w}, r01 = {rv.x, rv.y}, r23 = {rv.z, rv.w};
                const f2_t tA = sA * d01 + vv * m01, tB = sB * d23 + vv * m23;
                f2_t pa = sA * k01; pa = sB * k23 + pa;
                const float sa = red16(pa.x + pa.y);
                const f2_t sav = {sa, sa};
                sA = tA - sav * b01; sB = tB - sav * b23;
                f2_t ya = sA * r01; ya = sB * r23 + ya;
                yo[st * 64] = ya.x + ya.y;
                dec = dec1; km = km1; kk = kk1; bb = bb1; rv = rv1; v = v1;
                dec1 = dec2; km1 = km2; kk1 = kk2; bb1 = bb2; rv1 = rv2; v1 = v2;
            }
            __syncthreads();
        }
        __builtin_amdgcn_s_setprio(0);
    } else {
        const int ht = tid - 128;
        const int ystep = ht >> 3, r8 = ht & 7;
        float* yout = p.yraw + (size_t)(b * S_) * 512 + h * 64 + oct * 8 + r8;
        const float* ysrc = ypb + (r8 >> 2) * 1024 + ystep * 64 + (r8 & 3) * 16;
        uint4 ra0, ra1, ra2, ra3, ra4, ra5, rb0, rb1, rb2, rb3, rb4, rb5;
#define SLOAD(R, CH) { const bf16_t* sp_ = sbase + (size_t)(CH) * 6144 + (size_t)ht * 8; \
        R##0 = *(const uint4*)(sp_); R##1 = *(const uint4*)(sp_ + 1024); R##2 = *(const uint4*)(sp_ + 2048); R##3 = *(const uint4*)(sp_ + 3072); R##4 = *(const uint4*)(sp_ + 4096); R##5 = *(const uint4*)(sp_ + 5120); }
#define SSTORE(R, BI) { float* d_ = buf + (BI) * 6144 + ht * 8; const bool om_ = (ht % 48) < 8; \
        cvt_store(R##0, om_, d_); cvt_store(R##1, ((ht + 128) % 48) < 8, d_ + 1024); cvt_store(R##2, ((ht + 256) % 48) < 8, d_ + 2048); \
        cvt_store(R##3, ((ht + 384) % 48) < 8, d_ + 3072); cvt_store(R##4, ((ht + 512) % 48) < 8, d_ + 4096); cvt_store(R##5, ((ht + 640) % 48) < 8, d_ + 5120); }
#define YRED(C) { const float* ys_ = ysrc + ((C) & 1) * 2048; const float4 a_ = *(const float4*)ys_, b_ = *(const float4*)(ys_ + 4), c_ = *(const float4*)(ys_ + 8), d_ = *(const float4*)(ys_ + 12); \
        yout[(size_t)((C) * 16 + ystep) * 512] = ((a_.x + a_.y) + (a_.z + a_.w)) + ((b_.x + b_.y) + (b_.z + b_.w)) + ((c_.x + c_.y) + (c_.z + c_.w)) + ((d_.x + d_.y) + (d_.z + d_.w)); }
        SLOAD(ra, 1)
        for (int c = 0; c < 1024; c += 2) {
            if (c + 2 < 1024) SLOAD(rb, c + 2)
            SSTORE(ra, 1)
            if (c >= 1) YRED(c - 1)
            __syncthreads();
            if (c + 3 < 1024) SLOAD(ra, c + 3)
            if (c + 2 < 1024) SSTORE(rb, 0)
            YRED(c)
            __syncthreads();
        }
        YRED(1023)
#undef SLOAD
#undef SSTORE
#undef YRED
    }
}

struct AttnSmem {
    bf16_t k[64 * 72];
    bf16_t vt[64 * 68];
    float imp[32 * 256];
    unsigned selbits[32 * 8];
    unsigned wunion[4 * 8];
    unsigned bunion[8];
    unsigned gunion[8 * 8];
    int unit;
    int pad_[3];
    uint4 q[4 * 4 * 64];
};

#define ATTN_LOAD(KBASE, KSTRIDE, VTBASE, VTSTRIDE, NEEDV) { \
    rk0 = *(const uint4*)((KBASE) + (size_t)(tid >> 3) * (KSTRIDE) + (tid & 7) * 8); \
    rk1 = *(const uint4*)((KBASE) + (size_t)((tid >> 3) + 32) * (KSTRIDE) + (tid & 7) * 8); \
    if (NEEDV) { rv0 = *(const uint4*)((VTBASE) + (size_t)(tid >> 3) * (VTSTRIDE) + (tid & 7) * 8); \
                 rv1 = *(const uint4*)((VTBASE) + (size_t)((tid >> 3) + 32) * (VTSTRIDE) + (tid & 7) * 8); } }
#define ATTN_STORE(NEEDV) { \
    *(uint4*)&sm.k[(tid >> 3) * 72 + (tid & 7) * 8] = rk0; *(uint4*)&sm.k[((tid >> 3) + 32) * 72 + (tid & 7) * 8] = rk1; \
    if (NEEDV) { bf16_t* d0_ = &sm.vt[(tid >> 3) * 68 + (tid & 7) * 8]; bf16_t* d1_ = &sm.vt[((tid >> 3) + 32) * 68 + (tid & 7) * 8]; \
        *(uint2*)d0_ = make_uint2(rv0.x, rv0.y); *(uint2*)(d0_ + 4) = make_uint2(rv0.z, rv0.w); \
        *(uint2*)d1_ = make_uint2(rv1.x, rv1.y); *(uint2*)(d1_ + 4) = make_uint2(rv1.z, rv1.w); } }

template <int MODE, bool EM>
DI void attn_tile(AttnSmem& sm, const uint4* qs, f32x16 (&o)[2], float& m, float& l, const float inv_l, const int lo, const int hi, const bool lane_on,
                  const int lane, const int tokl, const int jbase) {
    const int rr = lane & 31, hh = lane >> 5;
    f32x16 s[2];
#pragma unroll
    for (int mt = 0; mt < 2; ++mt) {
#pragma unroll
        for (int i = 0; i < 16; ++i) s[mt][i] = 0.f;
#pragma unroll
        for (int ks = 0; ks < 4; ++ks) {
            const bf16x8 kf = *(const bf16x8*)&sm.k[(mt * 32 + rr) * 72 + ks * 16 + hh * 8];
            const bf16x8 qv = __builtin_bit_cast(bf16x8, qs[ks * 64]);
            s[mt] = MFMA32(kf, qv, s[mt]);
        }
        asm volatile("" ::: "memory");
    }
    (void)m;
    __builtin_amdgcn_sched_barrier(0);
    float psum = 0.f;
    if (EM) {
        const int lo2 = lo - 4 * hh, hi2 = hi - 4 * hh;
#pragma unroll
        for (int mt = 0; mt < 2; ++mt)
#pragma unroll
            for (int i = 0; i < 16; ++i) {
                const int kc_ = mt * 32 + (i & 3) + 8 * (i >> 2);
                float v = s[mt][i];
                v = (kc_ >= lo2 && kc_ <= hi2) ? v : -1e30f;
                float pv = __builtin_amdgcn_exp2f(v);
                if (MODE == 2) pv *= inv_l;
                s[mt][i] = pv; psum += pv;
            }
    } else {
        const float off = lane_on ? 0.f : -1e30f;
#pragma unroll
        for (int mt = 0; mt < 2; ++mt)
#pragma unroll
            for (int i = 0; i < 16; ++i) {
                float pv = __builtin_amdgcn_exp2f(s[mt][i] + off);
                if (MODE == 2) pv *= inv_l;
                s[mt][i] = pv; psum += pv;
            }
    }
    __builtin_amdgcn_sched_barrier(0);
    if (MODE != 2) l += psum;
    if (MODE == 0) return;
    if (MODE == 2) {
#pragma unroll
        for (int mt = 0; mt < 2; ++mt)
#pragma unroll
            for (int jj = 0; jj < 4; ++jj) {
                float q4 = (s[mt][4 * jj] + s[mt][4 * jj + 1]) + (s[mt][4 * jj + 2] + s[mt][4 * jj + 3]);
                float e3 = s[mt][4 * jj + 3];
                q4 += __shfl_xor(q4, 1); q4 += __shfl_xor(q4, 2);
                e3 += __shfl_xor(e3, 1); e3 += __shfl_xor(e3, 2);
                if ((rr & 3) == 0) {
                    const int j = jbase + mt * 8 + 2 * jj + hh;
                    atomicAdd(&sm.imp[tokl * 256 + j], q4);
                    if (j + 1 < 256) atomicAdd(&sm.imp[tokl * 256 + j + 1], e3);
                }
            }
    }
#pragma unroll
    for (int mt = 0; mt < 2; ++mt)
#pragma unroll
        for (int s2 = 0; s2 < 2; ++s2) {
            uint4 pu;
            pu.x = pack2(s[mt][8 * s2 + 0], s[mt][8 * s2 + 1]); pu.y = pack2(s[mt][8 * s2 + 2], s[mt][8 * s2 + 3]);
            pu.z = pack2(s[mt][8 * s2 + 4], s[mt][8 * s2 + 5]); pu.w = pack2(s[mt][8 * s2 + 6], s[mt][8 * s2 + 7]);
            const bf16x8 pf = __builtin_bit_cast(bf16x8, pu);
            asm volatile("" ::: "memory");
#pragma unroll
            for (int dt = 0; dt < 2; ++dt) {
                const bf16_t* vp = &sm.vt[(dt * 32 + rr) * 68 + mt * 32 + s2 * 16 + hh * 4];
                const uint2 v0 = *(const uint2*)vp, v1 = *(const uint2*)(vp + 8);
                const bf16x8 vf = __builtin_bit_cast(bf16x8, make_uint4(v0.x, v0.y, v1.x, v1.y));
                o[dt] = MFMA32(vf, pf, o[dt]);
            }
        }
}

template <int CTRL> DI unsigned dpp_umax(unsigned x) { const unsigned t = (unsigned)__builtin_amdgcn_mov_dpp((int)x, CTRL, 0xF, 0xF, true); return x > t ? x : t; }
DI unsigned wave_umax(unsigned v) {
    v = dpp_umax<0xB1>(v); v = dpp_umax<0x4E>(v); v = dpp_umax<0x141>(v); v = dpp_umax<0x140>(v);
    const unsigned a = (unsigned)__builtin_amdgcn_readlane((int)v, 0), b = (unsigned)__builtin_amdgcn_readlane((int)v, 16);
    const unsigned c = (unsigned)__builtin_amdgcn_readlane((int)v, 32), d = (unsigned)__builtin_amdgcn_readlane((int)v, 48);
    const unsigned ab = a > b ? a : b, cd = c > d ? c : d;
    return ab > cd ? ab : cd;
}


typedef unsigned u32x4 __attribute__((ext_vector_type(4)));
#define GLD16(R, PTR) asm volatile("global_load_dwordx4 %0, %1, off" : "=&v"(R) : "v"(PTR))
template <bool NEEDV, class NextF, class KPtrF, class VPtrF, class CompF>
DI void attn_pipe(AttnSmem& sm, const int tid, int j, const NextF next, const KPtrF kptr, const int kst, const VPtrF vptr, const int vst, const CompF comp) {
    if (j < 0) return;
    u32x4 Ak0, Ak1, Av0 = {0u, 0u, 0u, 0u}, Av1 = {0u, 0u, 0u, 0u}, Bk0, Bk1, Bv0 = {0u, 0u, 0u, 0u}, Bv1 = {0u, 0u, 0u, 0u};
    const int lr = tid >> 3, lc = (tid & 7) * 8;
#define PIPE_LOADS(S, JJ) { const bf16_t* kp_ = kptr(JJ) + (size_t)lr * kst + lc; GLD16(S##k0, kp_); GLD16(S##k1, kp_ + (size_t)32 * kst); \
        if (NEEDV) { const bf16_t* vp_ = vptr(JJ) + (size_t)lr * vst + lc; GLD16(S##v0, vp_); GLD16(S##v1, vp_ + (size_t)32 * vst); } }
#define PIPE_WAIT(S) { if (NEEDV) asm volatile("s_waitcnt vmcnt(4)" : "+v"(S##k0), "+v"(S##k1), "+v"(S##v0), "+v"(S##v1)); \
        else asm volatile("s_waitcnt vmcnt(2)" : "+v"(S##k0), "+v"(S##k1)); }
#define PIPE_STORES(S) { *(u32x4*)&sm.k[lr * 72 + lc] = S##k0; *(u32x4*)&sm.k[(lr + 32) * 72 + lc] = S##k1; \
        if (NEEDV) { bf16_t* d0_ = &sm.vt[lr * 68 + lc]; bf16_t* d1_ = &sm.vt[(lr + 32) * 68 + lc]; \
            *(uint2*)d0_ = make_uint2(S##v0.x, S##v0.y); *(uint2*)(d0_ + 4) = make_uint2(S##v0.z, S##v0.w); \
            *(uint2*)d1_ = make_uint2(S##v1.x, S##v1.y); *(uint2*)(d1_ + 4) = make_uint2(S##v1.z, S##v1.w); } }
    int jn = next(j);
    PIPE_LOADS(A, j)
    PIPE_LOADS(B, (jn >= 0 ? jn : j))
    while (true) {
        __syncthreads();
        PIPE_WAIT(A)
        PIPE_STORES(A)
        __syncthreads();
        const int jnn = jn >= 0 ? next(jn) : -1;
        PIPE_LOADS(A, (jnn >= 0 ? jnn : j))
        comp(j);
        if (jn < 0) break;
        __syncthreads();
        PIPE_WAIT(B)
        PIPE_STORES(B)
        __syncthreads();
        const int jnnn = jnn >= 0 ? next(jnn) : -1;
        PIPE_LOADS(B, (jnnn >= 0 ? jnnn : jn))
        comp(jn);
        if (jnn < 0) break;
        j = jnn; jn = jnnn;
    }
    asm volatile("s_waitcnt vmcnt(0)" : "+v"(Ak0), "+v"(Ak1), "+v"(Av0), "+v"(Av1), "+v"(Bk0), "+v"(Bk1), "+v"(Bv0), "+v"(Bv1));
#undef PIPE_LOADS
#undef PIPE_WAIT
#undef PIPE_STORES
}


typedef float f32x4v __attribute__((ext_vector_type(4)));
#define MFMA16(a, b, c) __builtin_amdgcn_mfma_f32_16x16x32_bf16((a), (b), (c), 0, 0, 0)
template <bool EM>
DI void sel16_scores(const u32x4 k0, const u32x4 k1, const u32x4 k2, const u32x4 k3, const u32x4 k4, const u32x4 k5, const u32x4 k6, const u32x4 k7,
                     const u32x4 q0, const u32x4 q1, float& l, const int hi, const bool lane_on, const int lane, u32x4& pf0, u32x4& pf1) {
    const int g4 = lane >> 4;
    const f32x4v z = {0.f, 0.f, 0.f, 0.f};
    const bf16x8 qa = __builtin_bit_cast(bf16x8, q0), qb = __builtin_bit_cast(bf16x8, q1);
    f32x4v a0 = MFMA16(__builtin_bit_cast(bf16x8, k0), qa, z); a0 = MFMA16(__builtin_bit_cast(bf16x8, k1), qb, a0);
    f32x4v a1 = MFMA16(__builtin_bit_cast(bf16x8, k2), qa, z); a1 = MFMA16(__builtin_bit_cast(bf16x8, k3), qb, a1);
    f32x4v a2 = MFMA16(__builtin_bit_cast(bf16x8, k4), qa, z); a2 = MFMA16(__builtin_bit_cast(bf16x8, k5), qb, a2);
    f32x4v a3 = MFMA16(__builtin_bit_cast(bf16x8, k6), qa, z); a3 = MFMA16(__builtin_bit_cast(bf16x8, k7), qb, a3);
    float psum = 0.f;
    if (EM) {
        const int hi2 = hi - 4 * g4;
#pragma unroll
        for (int r = 0; r < 4; ++r) {
            a0[r] = __builtin_amdgcn_exp2f((r <= hi2) ? a0[r] : -1e30f);
            a1[r] = __builtin_amdgcn_exp2f((16 + r <= hi2) ? a1[r] : -1e30f);
            a2[r] = __builtin_amdgcn_exp2f((32 + r <= hi2) ? a2[r] : -1e30f);
            a3[r] = __builtin_amdgcn_exp2f((48 + r <= hi2) ? a3[r] : -1e30f);
            psum += (a0[r] + a1[r]) + (a2[r] + a3[r]);
        }
    } else {
        const float off = lane_on ? 0.f : -1e30f;
#pragma unroll
        for (int r = 0; r < 4; ++r) {
            a0[r] = __builtin_amdgcn_exp2f(a0[r] + off); a1[r] = __builtin_amdgcn_exp2f(a1[r] + off);
            a2[r] = __builtin_amdgcn_exp2f(a2[r] + off); a3[r] = __builtin_amdgcn_exp2f(a3[r] + off);
            psum += (a0[r] + a1[r]) + (a2[r] + a3[r]);
        }
    }
    l += psum;
    pf0.x = pack2(a0[0], a0[1]); pf0.y = pack2(a0[2], a0[3]); pf0.z = pack2(a1[0], a1[1]); pf0.w = pack2(a1[2], a1[3]);
    pf1.x = pack2(a2[0], a2[1]); pf1.y = pack2(a2[2], a2[3]); pf1.z = pack2(a3[0], a3[1]); pf1.w = pack2(a3[2], a3[3]);
}
DI void sel16_pv(const u32x4 v0, const u32x4 v1, const u32x4 v2, const u32x4 v3, const u32x4 v4, const u32x4 v5, const u32x4 v6, const u32x4 v7,
                 const u32x4 pf0, const u32x4 pf1, f32x4v& o0, f32x4v& o1, f32x4v& o2, f32x4v& o3) {
    const bf16x8 pa = __builtin_bit_cast(bf16x8, pf0), pb = __builtin_bit_cast(bf16x8, pf1);
    o0 = MFMA16(__builtin_bit_cast(bf16x8, v0), pa, o0); o1 = MFMA16(__builtin_bit_cast(bf16x8, v1), pa, o1);
    o2 = MFMA16(__builtin_bit_cast(bf16x8, v2), pa, o2); o3 = MFMA16(__builtin_bit_cast(bf16x8, v3), pa, o3);
    o0 = MFMA16(__builtin_bit_cast(bf16x8, v4), pb, o0); o1 = MFMA16(__builtin_bit_cast(bf16x8, v5), pb, o1);
    o2 = MFMA16(__builtin_bit_cast(bf16x8, v6), pb, o2); o3 = MFMA16(__builtin_bit_cast(bf16x8, v7), pb, o3);
}

DI void attn_unit(const P& p, int u, char* smem) {
    AttnSmem& sm = *(AttnSmem*)smem;
    const int tid = tidx(), wave = tid >> 6, lane = tid & 63, rr = lane & 31, hh = lane >> 5;
    const int tile = 511 - (u >> 2), bhk = u & 3, b = bhk >> 1, hk = bhk & 1, t0 = tile * 32;
    const int tokl = wave * 8 + (rr >> 2), t = t0 + tokl, g = rr & 3, head = hk * 4 + g;
    const size_t tokg = (size_t)b * S_ + t;
    uint4* qs = &sm.q[wave * 256 + lane];
#pragma unroll
    for (int ks = 0; ks < 4; ++ks) qs[ks * 64] = *(const uint4*)(p.proj + tokg * PLD + QC + head * 64 + ks * 16 + hh * 8);
#define GATE(i) sigmoidf_(__uint_as_float((unsigned)p.proj[((size_t)b * S_ + t) * PLD + GC + head * 3 + (i)] << 16))
#pragma unroll
    for (int i = 0; i < 8; ++i) *(float4*)&sm.imp[(tid + i * 256) * 4] = make_float4(0.f, 0.f, 0.f, 0.f);
    sm.selbits[tid] = 0u;
    f32x16 o[2];
#pragma unroll
    for (int dt = 0; dt < 2; ++dt)
#pragma unroll
        for (int i = 0; i < 16; ++i) o[dt][i] = 0.f;
    float* park = &sm.imp[wave * 2048 + lane];
    const int ntc = (t0 >> 10) + 1;
    const int vmaxi = (t >= 31) ? ((t - 31) >> 4) : -1;
    const int twmin = t0 + wave * 8;
    const int wvmin = (twmin >= 31) ? ((twmin - 31) >> 4) : -1;
    const bf16_t* kcb = p.kc + (size_t)bhk * 1024 * 64;
    const bf16_t* vcb = p.vcT + (size_t)bhk * 64 * 1024;
    float m = -1e30f, l = 0.f;
    {
        auto nxt = [&](int j) -> int { return j + 1 < ntc ? j + 1 : -1; };
        auto kp = [&](int j) -> const bf16_t* { return kcb + (size_t)j * 64 * 64; };
        auto vp = [&](int j) -> const bf16_t* { return vcb + j * 64; };
        attn_pipe<false>(sm, tid, 0, nxt, kp, 64, vp, 1024, [&](int j) {
            if (j * 64 + 63 <= wvmin) attn_tile<0, false>(sm, qs, o, m, l, 0.f, 0, 0, true, lane, tokl, 0);
            else attn_tile<0, true>(sm, qs, o, m, l, 0.f, 0, vmaxi - j * 64, true, lane, tokl, 0);
        });
        const float lt = l + __shfl_xor(l, 32);
        const float inv_l = lt > 0.f ? 1.f / lt : 0.f;
        attn_pipe<true>(sm, tid, 0, nxt, kp, 64, vp, 1024, [&](int j) {
            if (j * 64 + 63 <= wvmin) attn_tile<2, false>(sm, qs, o, m, l, inv_l, 0, 0, true, lane, tokl, j * 16);
            else attn_tile<2, true>(sm, qs, o, m, l, inv_l, 0, vmaxi - j * 64, true, lane, tokl, j * 16);
        });
    }
    __syncthreads();
    const int cur = t0 >> 6;
    for (int tk = 0; tk < 8; ++tk) {
        const int tl = wave * 8 + tk;
        const float* ip = &sm.imp[tl * 256];
        unsigned nib = 0u;
        if (cur <= 15) {
#pragma unroll
            for (int e = 0; e < 4; ++e) if (lane * 4 + e <= cur) nib |= 1u << e;
        } else {
            unsigned k0, k1, k2, k3;
            {
                const float4 iv = *(const float4*)(ip + lane * 4);
                const int j0 = lane * 4;
                k0 = (j0 >= 1 && j0 <= cur - 2) ? ((__float_as_uint(iv.x) & 0xFFFFFF00u) | (unsigned)(255 - j0)) : 0u;
                k1 = (j0 + 1 <= cur - 2) ? ((__float_as_uint(iv.y) & 0xFFFFFF00u) | (unsigned)(254 - j0)) : 0u;
                k2 = (j0 + 2 <= cur - 2) ? ((__float_as_uint(iv.z) & 0xFFFFFF00u) | (unsigned)(253 - j0)) : 0u;
                k3 = (j0 + 3 <= cur - 2) ? ((__float_as_uint(iv.w) & 0xFFFFFF00u) | (unsigned)(252 - j0)) : 0u;
#pragma unroll
                for (int e = 0; e < 4; ++e) { const int j = j0 + e; if (j == 0 || j == cur || j == cur - 1) nib |= 1u << e; }
            }
            for (int r = 0; r < 13; ++r) {
                unsigned lm = k0 > k1 ? k0 : k1; const unsigned lm2 = k2 > k3 ? k2 : k3; lm = lm > lm2 ? lm : lm2;
                const unsigned wm = wave_umax(lm);
                if (k0 == wm) { k0 = 0u; nib |= 1u; }
                if (k1 == wm) { k1 = 0u; nib |= 2u; }
                if (k2 == wm) { k2 = 0u; nib |= 4u; }
                if (k3 == wm) { k3 = 0u; nib |= 8u; }
            }
        }
        atomicOr(&sm.selbits[tl * 8 + (lane >> 3)], nib << ((lane & 7) * 4));
    }
    __syncthreads();
    if (tid < 32) {
        const int w = tid >> 3, d = tid & 7; unsigned uu = 0u;
#pragma unroll
        for (int k = 0; k < 8; ++k) uu |= sm.selbits[(w * 8 + k) * 8 + d];
        sm.wunion[w * 8 + d] = uu;
    }
    if (tid < 64) {
        const int wg = tid >> 3, d = tid & 7; unsigned uu = 0u;
#pragma unroll
        for (int k = 0; k < 4; ++k) uu |= sm.selbits[(wg * 4 + k) * 8 + d];
        sm.gunion[wg * 8 + d] = uu;
    }
    __syncthreads();
    if (tid < 8) sm.bunion[tid] = sm.wunion[tid] | sm.wunion[8 + tid] | sm.wunion[16 + tid] | sm.wunion[24 + tid];
    __syncthreads();
    {
        const float g0 = GATE(0);
#pragma unroll
        for (int dt = 0; dt < 2; ++dt)
#pragma unroll
            for (int i = 0; i < 16; ++i) { park[(dt * 16 + i) * 64] = g0 * o[dt][i]; o[dt][i] = 0.f; }
    }
    {
        const bf16_t* kb = p.proj + (size_t)(b * S_) * PLD + KVC + 2 * 128 + hk * 64;
        const bf16_t* vb = p.vT + (size_t)((0 * 4 + bhk) * 64) * S_;
        m = -1e30f; l = 0.f;
        (void)kb; (void)vb; (void)m; (void)l;
        const bf16_t* kswb = p.ksw + ((size_t)bhk * 256 * 512 + lane) * 8;
        const bf16_t* vswb = p.vsw + ((size_t)bhk * 256 * 512 + lane) * 8;
        float* pbase = &sm.imp[wave * 2048];
        const int q16 = lane & 15, g4 = lane >> 4;
        const int tl0 = wave * 8 + (q16 >> 2), tl1 = tl0 + 4, tt0_ = t0 + tl0, tt1_ = t0 + tl1, head16 = hk * 4 + (q16 & 3);
        const bf16_t* qrow0 = p.proj + ((size_t)b * S_ + tt0_) * PLD;
        const bf16_t* qrow1 = p.proj + ((size_t)b * S_ + tt1_) * PLD;
        const u32x4 qa0 = *(const u32x4*)(qrow0 + QC + head16 * 64 + g4 * 8), qa1 = *(const u32x4*)(qrow0 + QC + head16 * 64 + 32 + g4 * 8);
        const u32x4 qb0 = *(const u32x4*)(qrow1 + QC + head16 * 64 + g4 * 8), qb1 = *(const u32x4*)(qrow1 + QC + head16 * 64 + 32 + g4 * 8);
        auto nextw = [&](int j) -> int {
            ++j;
            while (j <= cur) {
                const unsigned w = sm.wunion[wave * 8 + (j >> 5)] >> (j & 31);
                if (w) { j += __ffs((int)w) - 1; return j <= cur ? j : -1; }
                j = (j | 31) + 1;
            }
            return -1;
        };
        const f32x4v z4 = {0.f, 0.f, 0.f, 0.f};
        f32x4v oa0 = z4, oa1 = z4, oa2 = z4, oa3 = z4, ob0 = z4, ob1 = z4, ob2 = z4, ob3 = z4;
        float la = 0.f, lb = 0.f;
        u32x4 A0, A1, A2, A3, A4, A5, A6, A7, B0, B1, B2, B3, B4, B5, B6, B7, V0, V1, V2, V3, V4, V5, V6, V7;
        u32x4 pa0 = {0u, 0u, 0u, 0u}, pa1 = pa0, pb0 = pa0, pb1 = pa0;
#define SEL_LD8(R, BASE, JJ) { const bf16_t* b_ = (BASE) + (size_t)(JJ) * 4096; GLD16(R##0, b_); GLD16(R##1, b_ + 512); GLD16(R##2, b_ + 1024); GLD16(R##3, b_ + 1536); \
        GLD16(R##4, b_ + 2048); GLD16(R##5, b_ + 2560); GLD16(R##6, b_ + 3072); GLD16(R##7, b_ + 3584); }
#define SEL_WAIT8(R, N) asm volatile("s_waitcnt vmcnt(" #N ")" : "+v"(R##0), "+v"(R##1), "+v"(R##2), "+v"(R##3), "+v"(R##4), "+v"(R##5), "+v"(R##6), "+v"(R##7))
#define SEL_TILE(K, JJ) { \
        const int jj_ = (JJ); \
        const bool needa_ = (sm.gunion[(wave * 2 + 0) * 8 + (jj_ >> 5)] >> (jj_ & 31)) & 1u, needb_ = (sm.gunion[(wave * 2 + 1) * 8 + (jj_ >> 5)] >> (jj_ & 31)) & 1u; \
        const bool sela_ = (sm.selbits[tl0 * 8 + (jj_ >> 5)] >> (jj_ & 31)) & 1u, selb_ = (sm.selbits[tl1 * 8 + (jj_ >> 5)] >> (jj_ & 31)) & 1u; \
        SEL_WAIT8(K, 16); \
        if (needa_) { \
            if (jj_ < cur) sel16_scores<false>(K##0, K##1, K##2, K##3, K##4, K##5, K##6, K##7, qa0, qa1, la, 0, sela_, lane, pa0, pa1); \
            else sel16_scores<true>(K##0, K##1, K##2, K##3, K##4, K##5, K##6, K##7, qa0, qa1, la, sela_ ? tt0_ - jj_ * 64 : -1, true, lane, pa0, pa1); } \
        if (needb_) { \
            if (jj_ < cur) sel16_scores<false>(K##0, K##1, K##2, K##3, K##4, K##5, K##6, K##7, qb0, qb1, lb, 0, selb_, lane, pb0, pb1); \
            else sel16_scores<true>(K##0, K##1, K##2, K##3, K##4, K##5, K##6, K##7, qb0, qb1, lb, selb_ ? tt1_ - jj_ * 64 : -1, true, lane, pb0, pb1); } \
        SEL_WAIT8(V, 8); \
        if (needa_) sel16_pv(V0, V1, V2, V3, V4, V5, V6, V7, pa0, pa1, oa0, oa1, oa2, oa3); \
        if (needb_) sel16_pv(V0, V1, V2, V3, V4, V5, V6, V7, pb0, pb1, ob0, ob1, ob2, ob3); }
        {
            int j = nextw(-1);
            if (j >= 0) {
                SEL_LD8(A, kswb, j)
                while (true) {
                    const int jn = nextw(j);
                    SEL_LD8(V, vswb, j)
                    SEL_LD8(B, kswb, (jn >= 0 ? jn : j))
                    SEL_TILE(A, j)
                    if (jn < 0) break;
                    const int jnn = nextw(jn);
                    SEL_LD8(V, vswb, jn)
                    SEL_LD8(A, kswb, (jnn >= 0 ? jnn : jn))
                    SEL_TILE(B, jn)
                    if (jnn < 0) break;
                    j = jnn;
                }
                asm volatile("s_waitcnt vmcnt(0)" : "+v"(A0), "+v"(A1), "+v"(A2), "+v"(A3), "+v"(A4), "+v"(A5), "+v"(A6), "+v"(A7), "+v"(B0), "+v"(B1), "+v"(B2), "+v"(B3), "+v"(B4), "+v"(B5), "+v"(B6), "+v"(B7));
                asm volatile("s_waitcnt vmcnt(0)" : "+v"(V0), "+v"(V1), "+v"(V2), "+v"(V3), "+v"(V4), "+v"(V5), "+v"(V6), "+v"(V7));
            }
        }
#undef SEL_LD8
#undef SEL_WAIT8
#undef SEL_TILE
#define SEL_FIN(GRP, LG, QROW, O0, O1, O2, O3) { \
        float lt_ = (LG) + __shfl_xor((LG), 16); lt_ += __shfl_xor(lt_, 32); \
        const float g1_ = sigmoidf_(__uint_as_float((unsigned)(QROW)[GC + head16 * 3 + 1] << 16)); \
        const float sc_ = lt_ > 0.f ? g1_ / lt_ : 0.f; \
        const int r32_ = (GRP) * 16 + q16, hh32_ = g4 & 1; \
        _Pragma("unroll") for (int dt = 0; dt < 4; ++dt) { \
            const f32x4v ov_ = dt == 0 ? O0 : (dt == 1 ? O1 : (dt == 2 ? O2 : O3)); \
            _Pragma("unroll") for (int r = 0; r < 4; ++r) { \
                const int i32_ = r + 4 * ((dt & 1) * 2 + (g4 >> 1)); \
                pbase[((dt >> 1) * 16 + i32_) * 64 + r32_ + 32 * hh32_] += sc_ * ov_[r]; } } }
        SEL_FIN(0, la, qrow0, oa0, oa1, oa2, oa3)
        SEL_FIN(1, lb, qrow1, ob0, ob1, ob2, ob3)
#undef SEL_FIN
    }
    {
        const bf16_t* kb = p.proj + (size_t)(b * S_) * PLD + KVC + 4 * 128 + hk * 64;
        const bf16_t* vb = p.vT + (size_t)((1 * 4 + bhk) * 64) * S_;
        m = -1e30f; l = 0.f;
        const int jlo = (t0 >= 511) ? ((t0 - 511) >> 6) : 0, jhi = t0 >> 6;
        attn_pipe<true>(sm, tid, jlo, [&](int j) -> int { return j + 1 <= jhi ? j + 1 : -1; }, [&](int j) -> const bf16_t* { return kb + (size_t)j * 64 * PLD; }, PLD,
                        [&](int j) -> const bf16_t* { return vb + j * 64; }, S_, [&](int j) {
            if (j * 64 >= twmin + 7 - 511 && j * 64 + 63 <= twmin) attn_tile<1, false>(sm, qs, o, m, l, 0.f, 0, 0, true, lane, tokl, 0);
            else attn_tile<1, true>(sm, qs, o, m, l, 0.f, t - 511 - j * 64, t - j * 64, true, lane, tokl, 0);
        });
        const float lt = l + __shfl_xor(l, 32);
        const float sc = lt > 0.f ? GATE(2) / lt : 0.f;
#pragma unroll
        for (int dt = 0; dt < 2; ++dt)
#pragma unroll
            for (int i = 0; i < 16; ++i) o[dt][i] = park[(dt * 16 + i) * 64] + sc * o[dt][i];
    }
    bf16_t* mp = p.A + tokg * 1024 + 512 + head * 64;
#pragma unroll
    for (int dt = 0; dt < 2; ++dt)
#pragma unroll
        for (int jj = 0; jj < 4; ++jj) {
            uint2 ov; ov.x = pack2(o[dt][4 * jj], o[dt][4 * jj + 1]); ov.y = pack2(o[dt][4 * jj + 2], o[dt][4 * jj + 3]);
            *(uint2*)(mp + dt * 32 + jj * 8 + hh * 4) = ov;
        }
}

DI void phase4(const P& p, char* smem) {
    for (int su = blockIdx.x; su < 128; su += gridDim.x) scan_unit(p, su, smem);
    AttnSmem& sm = *(AttnSmem*)smem;
    while (true) {
        __syncthreads();
        if (tidx() == 0) sm.unit = (int)atomicAdd(p.counter, 1u);
        __syncthreads();
        const int u = sm.unit;
        if (u >= 2048) break;
        attn_unit(p, u, smem);
    }
}

DI void phase4b(const P& p) {
    const int tid = tidx();
    for (int it = blockIdx.x; it < T_ / 4; it += gridDim.x) {
        const int gi = it * 4 + (tid >> 6), cgp = tid & 63, h = cgp >> 3, c8 = (cgp & 7) * 8, col = cgp * 8, b = gi >> 14, s = gi & (S_ - 1);
        const float4 y0 = *(const float4*)(p.yraw + (size_t)gi * 512 + col), y1 = *(const float4*)(p.yraw + (size_t)gi * 512 + col + 4);
        float y[8] = {y0.x, y0.y, y0.z, y0.w, y1.x, y1.y, y1.z, y1.w};
        const bf16_t* sp = p.stream + ((size_t)((b * 8 + h) * S_ + s) * 6) * 64 + c8;
        float km[8], r[8], v[8], gg[8];
        unpack8(*(const uint4*)(sp + 64), km); unpack8(*(const uint4*)(sp + 256), r); unpack8(*(const uint4*)(sp + 320), v);
        unpack8(*(const uint4*)(p.gbuf + (size_t)gi * 512 + col), gg);
        float sum = 0.f, bon = 0.f;
#pragma unroll
        for (int e = 0; e < 8; ++e) { sum += y[e]; bon += r[e] * km[e] * p.r_k[col + e]; }
        sum += __shfl_xor(sum, 1); sum += __shfl_xor(sum, 2); sum += __shfl_xor(sum, 4);
        bon += __shfl_xor(bon, 1); bon += __shfl_xor(bon, 2); bon += __shfl_xor(bon, 4);
        const float mean = sum * (1.f / 64.f);
        float var = 0.f;
#pragma unroll
        for (int e = 0; e < 8; ++e) { y[e] -= mean; var += y[e] * y[e]; }
        var += __shfl_xor(var, 1); var += __shfl_xor(var, 2); var += __shfl_xor(var, 4);
        const float rs = rsqrtf(var * (1.f / 64.f) + 64e-5f);
        float o[8];
#pragma unroll
        for (int e = 0; e < 8; ++e) o[e] = (y[e] * rs * p.lnx_w[col + e] + p.lnx_b[col + e] + bon * v[e]) * gg[e];
        *(uint4*)(p.A + (size_t)gi * 1024 + col) = pack8(o);
    }
}

struct EpiFfn2 {
    float* out;
    DI void operator()(const f32x16 (&acc)[2][2], int rowbase, int colbase, int lane) const {
        const int rr = lane & 31, hh = lane >> 5;
#pragma unroll
        for (int w = 0; w < 2; ++w)
#pragma unroll
            for (int t = 0; t < 2; ++t)
#pragma unroll
                for (int j = 0; j < 4; ++j) {
                    float4* o = (float4*)(out + (size_t)(rowbase + t * 32 + rr) * 1024 + colbase + w * 32 + j * 8 + hh * 4);
                    float4 xv = *o;
                    xv.x += acc[w][t][4 * j]; xv.y += acc[w][t][4 * j + 1]; xv.z += acc[w][t][4 * j + 2]; xv.w += acc[w][t][4 * j + 3];
                    *o = xv;
                }
    }
};

DI void final_item(float* io, const float* g, int idx) {
    const int row = idx * 4 + (tidx() >> 6), lane = tidx() & 63;
    float4* sp = (float4*)(io + (size_t)row * 1024);
    float4 v[4]; float ss = 0.f;
#pragma unroll
    for (int i = 0; i < 4; ++i) { v[i] = sp[lane + 64 * i]; ss += v[i].x * v[i].x + v[i].y * v[i].y + v[i].z * v[i].z + v[i].w * v[i].w; }
    ss = wave_sum(ss);
    const float rs = rsqrtf(ss * (1.f / 1024.f) + 1e-6f);
#pragma unroll
    for (int i = 0; i < 4; ++i) {
        const float4 gv = ((const float4*)g)[lane + 64 * i];
        sp[lane + 64 * i] = make_float4(v[i].x * rs * gv.x, v[i].y * rs * gv.y, v[i].z * rs * gv.z, v[i].w * rs * gv.w);
    }
}

DI bool gemm_order(const int round, const int NT, int& mt, int& nt) {
    if (gridDim.x == 512) {
        const int xcd = blockIdx.x & 7, lb = blockIdx.x >> 3;
        const int q = round * 64 + lb;
        if (q >= 32 * NT) return false;
        mt = xcd * 32 + (q / (8 * NT)) * 8 + (q & 7);
        nt = (q >> 3) % NT;
        return true;
    }
    const int it = round * gridDim.x + blockIdx.x;
    if (it >= 256 * NT) return false;
    mt = it / NT; nt = it - mt * NT;
    return true;
}

DI void run_phase(const P& p, int ph, char* smem) {
    switch (ph) {
    case 0: phase0(p, smem); break;
    case 1:
        for (int rd = 0;; ++rd) {
            int mt, nt; if (!gemm_order(rd, 25, mt, nt)) break;
            gemm_tile<8>(AFPlain{p.A, 1024}, p.WinT + (size_t)nt * 128 * 1024, 1024, mt * 128, nt * 128, EpiProj{p.proj}, smem);
        }
        break;
    case 2: phase2(p, smem); break;
    case 3: phase3(p, smem); break;
    case 4: phase4(p, smem); break;
    case 5: phase4b(p); break;
    case 6:
        for (int rd = 0;; ++rd) {
            int mt, nt; if (!gemm_order(rd, 8, mt, nt)) break;
            gemm_tile<8>(AFPlain{p.A, 1024}, p.WoutT + (size_t)nt * 128 * 1024, 1024, mt * 128, nt * 128, EpiOut{p.out, p.x}, smem);
        }
        break;
    case 7:
        for (int it = blockIdx.x; it < T_ / 4; it += gridDim.x) rms_item(p.out, p.norm_ffn, p.A, it);
        break;
    case 8:
        for (int rd = 0;; ++rd) {
            int mt, nt; if (!gemm_order(rd, 44, mt, nt)) break;
            gemm_tile<8>(AFPlain{p.A, 1024}, p.WguT + (size_t)nt * 128 * 1024, 1024, mt * 128, nt * 128, EpiFfn1{p.stream}, smem);
        }
        break;
    case 9:
        for (int rd = 0;; ++rd) {
            int mt, nt; if (!gemm_order(rd, 8, mt, nt)) break;
            gemm_tile<1>(AFPlain{p.stream, DFF}, p.WdnT + (size_t)nt * 128 * DFF, DFF, mt * 128, nt * 128, EpiFfn2{p.out}, smem);
        }
        break;
    default:
        for (int it = blockIdx.x; it < T_ / 4; it += gridDim.x) final_item(p.out, p.norm_final, it);
        break;
    }
}
constexpr int NPHASE = 11;
constexpr int SMEM_BYTES = 73728;


#define XB_TMO      128
#define XB_XCNT(j)  (256  + 64 * (j))
#define XB_XSUB(j)  (1280 + 64 * (j))
#define XB_XGEN(j)  (2304 + 64 * (j))
#define XB_TOP      3328
#define XB_TOPGEN   3392
#define XCD_BAR_WORDS 3456
#define XB_SPIN_CAP (1u << 22)
#define LAS __attribute__((address_space(3)))
DI unsigned xb_ld(unsigned* p) { return __hip_atomic_load(p, __ATOMIC_RELAXED, __HIP_MEMORY_SCOPE_AGENT); }
DI unsigned xb_add(unsigned* p, unsigned v) { return __hip_atomic_fetch_add(p, v, __ATOMIC_RELAXED, __HIP_MEMORY_SCOPE_AGENT); }
DI unsigned xb_xcc_id() { return (unsigned)__builtin_amdgcn_s_getreg((3 << 11) | 20) & 0xFu; }
#define XB_SPIN(cond, bar) do { unsigned _sp = 0; while (cond) { __builtin_amdgcn_s_sleep(1); \
    if ((++_sp & 255u) == 0u) { if (xb_ld(&(bar)[XB_TMO])) break; if (_sp > XB_SPIN_CAP) { atomicAdd(&(bar)[XB_TMO], 1u); break; } } } } while (0)
struct XcdBarrier { unsigned* bar; unsigned x; volatile LAS unsigned* st; unsigned G; };
DI XcdBarrier xcd_barrier_post(unsigned* bar, volatile LAS unsigned* st, const unsigned G) {
    XcdBarrier b; b.bar = bar; b.x = xb_xcc_id(); b.st = st; b.G = G;
    if (tidx() == 0) (void)xb_add(&bar[XB_XCNT(b.x)], 1u);
    return b;
}
DI void xcd_barrier_complete(unsigned* bar, unsigned x, unsigned& nloc, unsigned& nx, const unsigned G) {
    unsigned sum, cnt, mine, sp = 0u;
    for (;;) {
        sum = 0u; cnt = 0u; mine = 0u;
#pragma unroll
        for (unsigned j = 0; j < 16; ++j) { const unsigned c = xb_ld(&bar[XB_XCNT(j)]); sum += c; cnt += (c > 0u) ? 1u : 0u; mine = (j == x) ? c : mine; }
        if (sum == G) break;
        __builtin_amdgcn_s_sleep(1);
        if ((++sp & 255u) == 0u) { if (xb_ld(&bar[XB_TMO])) break; if (sp > XB_SPIN_CAP) { atomicAdd(&bar[XB_TMO], 1u); break; } }
    }
    nloc = mine > 0u ? mine : 1u; nx = cnt > 0u ? cnt : 1u;
}
DI void xcd_barrier(const XcdBarrier& b) {
    asm volatile("s_waitcnt vmcnt(0)" ::: "memory");
    __syncthreads();
    if (tidx() == 0) {
        unsigned* bar = b.bar;
        __builtin_amdgcn_s_waitcnt(0);
        unsigned nloc = b.st[0], nx = b.st[1];
        if (nloc == 0u) { xcd_barrier_complete(bar, b.x, nloc, nx, b.G); b.st[0] = nloc; b.st[1] = nx; }
        const unsigned old = xb_add(&bar[XB_XSUB(b.x)], 1u);
        const unsigned gen = old / nloc;
        if (old + 1u == (gen + 1u) * nloc) {
            __builtin_amdgcn_fence(__ATOMIC_RELEASE, "agent");
            asm volatile("s_waitcnt vmcnt(0)" ::: "memory");
            const unsigned og = xb_add(&bar[XB_TOP], 1u);
            const unsigned tg = og / nx;
            if (og + 1u == (tg + 1u) * nx) xb_add(&bar[XB_TOPGEN], 1u);
            else XB_SPIN(xb_ld(&bar[XB_TOPGEN]) == tg, bar);
            __builtin_amdgcn_fence(__ATOMIC_ACQUIRE, "agent");
            xb_add(&bar[XB_XGEN(b.x)], 1u);
            asm volatile("s_waitcnt vmcnt(0)" ::: "memory");
        } else {
            XB_SPIN(xb_ld(&bar[XB_XGEN(b.x)]) == gen, bar);
            __builtin_amdgcn_fence(__ATOMIC_ACQUIRE, "agent");
            asm volatile("s_waitcnt vmcnt(0)" ::: "memory");
        }
    }
    __syncthreads();
}

DI void phase4_fused(const P& p, char* smem, const XcdBarrier& xb2) {
    const int tid = tidx();
    if (blockIdx.x < 128) {
        scan_unit(p, blockIdx.x, smem);
        if (tid == 0) {
            unsigned sp = 0u;
            while (xb_ld(p.counter + 4) == 0u) { __builtin_amdgcn_s_sleep(8); if (++sp > (1u << 22)) break; }
            __builtin_amdgcn_fence(__ATOMIC_ACQUIRE, "agent");
            asm volatile("s_waitcnt vmcnt(0)" ::: "memory");
        }
        __syncthreads();
    } else {
        const int lb = blockIdx.x - 128;
        for (int it = lb; it < 2560; it += 384) {
            const int mt = it / 10, nt = 15 + (it - mt * 10);
            gemm_tile<8>(AFPlain{p.A, 1024}, p.WinT + (size_t)nt * 128 * 1024, 1024, mt * 128, nt * 128, EpiProj{p.proj}, smem);
        }
        xcd_barrier(xb2);
        for (int it = lb; it < 640; it += 384) { if (it < 128) cmp1_item(p, it, smem); else rope_item(p, it - 128, smem); }
        xcd_barrier(xb2);
        for (int it = lb; it < 64; it += 384) cmp2_item(p, it, smem);
        xcd_barrier(xb2);
        if (lb == 0 && tid == 0) __hip_atomic_store(p.counter + 4, 1u, __ATOMIC_RELEASE, __HIP_MEMORY_SCOPE_AGENT);
    }
    AttnSmem& sm = *(AttnSmem*)smem;
    while (true) {
        __syncthreads();
        if (tidx() == 0) sm.unit = (int)atomicAdd(p.counter, 1u);
        __syncthreads();
        const int u = sm.unit;
        if (u >= 2048 + 2368) break;
        if (u < 2048) attn_unit(p, u, smem);
        else tr_item(p, 800 + (u - 2048), (float*)smem);
    }
}

__global__ void __launch_bounds__(NTHR, 2) mega_kernel(P p) {
    __shared__ __attribute__((aligned(16))) char smem[SMEM_BYTES];
    __shared__ uint4 xb_words;
    __shared__ uint4 xb_words2;
    cg::grid_group grid = cg::this_grid();
    if (p.x == nullptr) grid.sync();
    if (tidx() == 0) { xb_words = make_uint4(0u, 0u, 0u, 0u); xb_words2 = make_uint4(0u, 0u, 0u, 0u); }
    __syncthreads();
    const XcdBarrier xb = xcd_barrier_post(p.bar, (volatile LAS unsigned*)&xb_words, gridDim.x);
    run_phase(p, 0, smem); xcd_barrier(xb);
    if (gridDim.x == 512) {
        XcdBarrier xb2; xb2.bar = p.bar + XCD_BAR_WORDS; xb2.x = xb.x; xb2.st = (volatile LAS unsigned*)&xb_words2; xb2.G = 384u;
        if (blockIdx.x >= 128 && tidx() == 0) (void)xb_add(&xb2.bar[XB_XCNT(xb2.x)], 1u);
        for (int rd = 0;; ++rd) {
            int mt, nt; if (!gemm_order(rd, 15, mt, nt)) break;
            gemm_tile<8>(AFPlain{p.A, 1024}, p.WinT + (size_t)nt * 128 * 1024, 1024, mt * 128, nt * 128, EpiProj{p.proj}, smem);
        }
        xcd_barrier(xb);
        for (int it = blockIdx.x; it < 1024; it += gridDim.x) rwkv_prep(p, it, smem);
        xcd_barrier(xb);
        phase4_fused(p, smem, xb2);
        xcd_barrier(xb);
    } else {
        run_phase(p, 1, smem); xcd_barrier(xb);
        run_phase(p, 2, smem); xcd_barrier(xb);
        run_phase(p, 3, smem); xcd_barrier(xb);
        run_phase(p, 4, smem); xcd_barrier(xb);
    }
    run_phase(p, 5, smem); xcd_barrier(xb);
    run_phase(p, 6, smem); xcd_barrier(xb);
    run_phase(p, 7, smem); xcd_barrier(xb);
    run_phase(p, 8, smem); xcd_barrier(xb);
    run_phase(p, 9, smem); xcd_barrier(xb);
    run_phase(p, 10, smem);
}
__global__ void __launch_bounds__(NTHR, 2) phase_kernel(P p, int ph) {
    __shared__ __attribute__((aligned(16))) char smem[SMEM_BYTES];
    run_phase(p, ph, smem);
}

extern "C" void kernel_launch(void* const* d_in, const int* in_sizes, int n_in, void* d_out, int out_size, void* d_ws, size_t ws_size,
                              hipStream_t stream) {
    P p{};
    p.x = (const float*)d_in[0]; p.pos = (const int*)d_in[1]; p.norm_mix = (const float*)d_in[2]; p.w_in = (const float*)d_in[3];
    p.mu = (const float*)d_in[4]; p.w0 = (const float*)d_in[5]; p.w2 = (const float*)d_in[6]; p.a0 = (const float*)d_in[7];
    p.a2 = (const float*)d_in[8]; p.g2 = (const float*)d_in[9]; p.k_k = (const float*)d_in[10]; p.k_a = (const float*)d_in[11];
    p.r_k = (const float*)d_in[12]; p.lnx_w = (const float*)d_in[13]; p.lnx_b = (const float*)d_in[14]; p.pe_k = (const float*)d_in[15];
    p.wk1 = (const float*)d_in[16]; p.bk1 = (const float*)d_in[17]; p.wk2 = (const float*)d_in[18]; p.pe_v = (const float*)d_in[19];
    p.wv1 = (const float*)d_in[20]; p.bv1 = (const float*)d_in[21]; p.wv2 = (const float*)d_in[22]; p.w_out = (const float*)d_in[23];
    p.norm_ffn = (const float*)d_in[24]; p.w_gate = (const float*)d_in[25]; p.w_up = (const float*)d_in[26]; p.w_down = (const float*)d_in[27];
    p.norm_final = (const float*)d_in[28];
    p.out = (float*)d_out;
    char* ws = (char*)d_ws;
    size_t off = 0;
    auto take = [&](size_t bytes) { char* r = ws + off; off += (bytes + 255) & ~(size_t)255; return r; };
    p.WinT = (bf16_t*)take((size_t)3200 * 1024 * 2);
    p.WoutT = (bf16_t*)take((size_t)1024 * 1024 * 2);
    p.WguT = (bf16_t*)take((size_t)5632 * 1024 * 2);
    p.WdnT = (bf16_t*)take((size_t)1024 * DFF * 2);
    p.w2T = (bf16_t*)take(512 * 64 * 2);
    p.a2T = (bf16_t*)take(512 * 64 * 2);
    p.g2T = (bf16_t*)take(512 * 160 * 2);
    p.w1T = (bf16_t*)take((size_t)2 * 256 * 2048 * 2);
    p.wc2T = (bf16_t*)take(2 * 128 * 256 * 2);
    p.b1p = (float*)take(512 * 4);
    p.cosT = (float*)take((size_t)T_ * 8 * 4);
    p.sinT = (float*)take((size_t)T_ * 8 * 4);
    p.counter = (unsigned*)take(256);
    p.bar = (unsigned*)take(2 * XCD_BAR_WORDS * 4);
    off = (size_t)32 << 20;
    p.A = (bf16_t*)take((size_t)T_ * 1024 * 2);
    p.proj = (bf16_t*)take((size_t)T_ * PLD * 2);
    p.stream = (bf16_t*)take((size_t)T_ * 8 * 384 * 2);
    p.ksw = (bf16_t*)take((size_t)4 * 256 * 4096 * 2);
    p.vsw = (bf16_t*)take((size_t)4 * 256 * 4096 * 2);
    if (off > ws_size) fprintf(stderr, "workspace too small: need %zu have %zu\n", off, ws_size);
    char* ob = (char*)d_out;
    p.gbuf = (bf16_t*)ob;
    p.yraw = (float*)(ob + ((size_t)32 << 20));
    p.vT = (bf16_t*)(ob + ((size_t)96 << 20));
    p.hid = (bf16_t*)(ob + ((size_t)112 << 20));
    p.kc = (bf16_t*)(ob + ((size_t)116 << 20));
    p.vcT = (bf16_t*)(ob + ((size_t)116 << 20) + (512 << 10));
#if MK_SINGLE
    static int grid_blocks = 0;
    if (!grid_blocks) {
        int dev = 0, cus = 0, per_cu = 0;
        hipGetDevice(&dev);
        hipDeviceGetAttribute(&cus, hipDeviceAttributeMultiprocessorCount, dev);
        hipOccupancyMaxActiveBlocksPerMultiprocessor(&per_cu, mega_kernel, NTHR, 0);
        if (per_cu > 2) per_cu = 2;
        if (per_cu < 1) per_cu = 1;
        grid_blocks = cus * per_cu;
    }
    (void)hipMemsetAsync(p.bar, 0, 2 * XCD_BAR_WORDS * 4, stream);
    void* args[] = {&p};
    hipError_t e = hipLaunchCooperativeKernel((void*)mega_kernel, dim3(grid_blocks), dim3(NTHR), args, 0, stream);
    if (e != hipSuccess) fprintf(stderr, "cooperative launch failed: %s (grid %d)\n", hipGetErrorString(e), grid_blocks);
#else
    for (int ph = 0; ph < NPHASE; ++ph) phase_kernel<<<512, NTHR, 0, stream>>>(p, ph);
#endif
}
```

```cpp
#include <hip/hip_runtime.h>
#include <hip/hip_cooperative_groups.h>
#include <cstdio>
namespace cg = cooperative_groups;

#ifndef MK_SINGLE
#define MK_SINGLE 1
#endif

#define DI __device__ __forceinline__
typedef unsigned short bf16_t;
typedef short bf16x8 __attribute__((ext_vector_type(8)));
typedef float f32x16 __attribute__((ext_vector_type(16)));
typedef __bf16 bf2_t __attribute__((ext_vector_type(2)));
typedef float f2_t __attribute__((ext_vector_type(2)));

constexpr int T_ = 32768, S_ = 16384;
constexpr int PLD = 3200;
constexpr int QC = 1856, KVC = 2368, GC = 3136;
constexpr int DFF = 2816;
constexpr int NTHR = 256;
constexpr float QSC = 0.125f * 1.4426950408889634f;

#define MFMA32(a, b, c) __builtin_amdgcn_mfma_f32_32x32x16_bf16((a), (b), (c), 0, 0, 0)

DI int tidx() { int r; asm volatile("v_mov_b32 %0, %1" : "=v"(r) : "v"(threadIdx.x)); return r; }
DI unsigned pack2(float a, float b) { f2_t v = {a, b}; return __builtin_bit_cast(unsigned, __builtin_convertvector(v, bf2_t)); }
DI float bflo(unsigned u) { return __uint_as_float(u << 16); }
DI float bfhi(unsigned u) { return __uint_as_float(u & 0xffff0000u); }
DI bf16_t f2bf(float a) { return (bf16_t)(pack2(a, 0.f) & 0xffffu); }
DI void unpack8(const uint4& u, float (&f)[8]) {
    f[0] = bflo(u.x); f[1] = bfhi(u.x); f[2] = bflo(u.y); f[3] = bfhi(u.y);
    f[4] = bflo(u.z); f[5] = bfhi(u.z); f[6] = bflo(u.w); f[7] = bfhi(u.w);
}
DI uint4 pack8(const float (&f)[8]) { uint4 u; u.x = pack2(f[0], f[1]); u.y = pack2(f[2], f[3]); u.z = pack2(f[4], f[5]); u.w = pack2(f[6], f[7]); return u; }
DI float wave_sum(float v) {
#pragma unroll
    for (int o = 32; o; o >>= 1) v += __shfl_xor(v, o);
    return v;
}
DI float sigmoidf_(float x) { return 1.f / (1.f + __expf(-x)); }
DI int crow(int reg, int h) { return (reg & 3) + 8 * (reg >> 2) + 4 * h; }

struct P {
    const float* x; const int* pos; const float *norm_mix, *w_in, *mu, *w0, *w2, *a0, *a2, *g2, *k_k, *k_a, *r_k, *lnx_w, *lnx_b,
        *pe_k, *wk1, *bk1, *wk2, *pe_v, *wv1, *bv1, *wv2, *w_out, *norm_ffn, *w_gate, *w_up, *w_down, *norm_final;
    float* out;
    bf16_t *WinT, *WoutT, *WguT, *WdnT, *w2T, *a2T, *g2T, *w1T, *wc2T;
    float *b1p, *cosT, *sinT;
    unsigned* counter; unsigned* bar;
    bf16_t *A, *proj, *stream;
    bf16_t* gbuf; float* yraw; bf16_t *vT, *hid, *kc, *vcT, *ksw, *vsw;
};

DI float tr_val(const P& p, int job, int k, int n) {
    switch (job) {
    case 0: { int c = n < 1824 ? n : ((n >= 1856 && n < 3160) ? n - 32 : -1); return c >= 0 ? p.w_in[(size_t)k * 3128 + c] : 0.f; }
    case 1: return p.w_out[k * 1024 + n];
    case 2: { int q = n >> 6, r = n & 63; return r < 32 ? p.w_gate[(size_t)k * DFF + q * 32 + r] : p.w_up[(size_t)k * DFF + q * 32 + r - 32]; }
    case 3: return p.w_down[(size_t)k * 1024 + n];
    case 4: return p.w2[k * 512 + n];
    case 5: return p.a2[k * 512 + n];
    case 6: return p.g2[k * 512 + n];
    case 7: return p.wk1[k * 256 + n];
    case 8: return p.wv1[k * 256 + n];
    case 9: return n < 64 ? p.wk2[k * 64 + n] : 0.f;
    default: return n < 64 ? p.wv2[k * 64 + n] : 0.f;
    }
}
DI void tr_item(const P& p, int it, float* tile) {
    int job, K, N; bf16_t* dst;
    if (it < 800) { job = 0; K = 1024; N = 3200; dst = p.WinT; }
    else if (it < 1056) { job = 1; it -= 800; K = 1024; N = 1024; dst = p.WoutT; }
    else if (it < 2464) { job = 2; it -= 1056; K = 1024; N = 5632; dst = p.WguT; }
    else if (it < 3168) { job = 3; it -= 2464; K = 2816; N = 1024; dst = p.WdnT; }
    else if (it < 3176) { job = 4; it -= 3168; K = 64; N = 512; dst = p.w2T; }
    else if (it < 3184) { job = 5; it -= 3176; K = 64; N = 512; dst = p.a2T; }
    else if (it < 3208) { job = 6; it -= 3184; K = 160; N = 512; dst = p.g2T; }
    else if (it < 3336) { job = 7; it -= 3208; K = 2048; N = 256; dst = p.w1T; }
    else if (it < 3464) { job = 8; it -= 3336; K = 2048; N = 256; dst = p.w1T + 256 * 2048; }
    else if (it < 3472) { job = 9; it -= 3464; K = 256; N = 128; dst = p.wc2T; }
    else { job = 10; it -= 3472; K = 256; N = 128; dst = p.wc2T + 128 * 256; }
    const int nt = N >> 6;
    const int k0 = (it / nt) * 64, n0 = (it % nt) * 64;
    const int tid = tidx();
    __syncthreads();
#pragma unroll 4
    for (int i = 0; i < 16; ++i) {
        const int kk = i * 4 + (tid >> 6), nn = tid & 63;
        tile[kk * 65 + nn] = (k0 + kk < K) ? tr_val(p, job, k0 + kk, n0 + nn) : 0.f;
    }
    __syncthreads();
#pragma unroll 4
    for (int i = 0; i < 16; ++i) {
        const int nn = i * 4 + (tid >> 6), kk = tid & 63;
        if (k0 + kk < K) dst[(size_t)(n0 + nn) * K + k0 + kk] = f2bf(tile[kk * 65 + nn]);
    }
}
DI void b1_item(const P& p, int idx) {
    const int kv = idx >> 4, jc = idx & 15, tid = tidx();
    const float* pe = kv ? p.pe_v : p.pe_k; const float* w1 = kv ? p.wv1 : p.wk1; const float* b1 = kv ? p.bv1 : p.bk1;
    const int j = jc * 16 + (tid >> 4), kl = tid & 15;
    float s = 0.f;
    for (int i = 0; i < 128; ++i) { const int k = kl + 16 * i; s += pe[k] * w1[k * 256 + j]; }
    s += __shfl_xor(s, 1); s += __shfl_xor(s, 2); s += __shfl_xor(s, 4); s += __shfl_xor(s, 8);
    if (kl == 0) p.b1p[kv * 256 + j] = b1[j] + s;
}
DI void sincos_d(float ang, float& c, float& s) {
    double x = (double)ang;
    const double TWO_PI = 6.283185307179586476925286766559;
    double n = __builtin_rint(x * (1.0 / TWO_PI));
    double r = x - n * TWO_PI;
    double q = r * 0.25;
    double q2 = q * q;
    double sn = q * (1.0 + q2 * (-1.0 / 6 + q2 * (1.0 / 120 + q2 * (-1.0 / 5040 + q2 * (1.0 / 362880 + q2 * (-1.0 / 39916800 + q2 * (1.0 / 6227020800.0)))))));
    double cs = 1.0 + q2 * (-0.5 + q2 * (1.0 / 24 + q2 * (-1.0 / 720 + q2 * (1.0 / 40320 + q2 * (-1.0 / 3628800 + q2 * (1.0 / 479001600.0))))));
    double s2 = 2 * sn * cs, c2 = 1 - 2 * sn * sn;
    double s4 = 2 * s2 * c2, c4 = 1 - 2 * s2 * s2;
    c = (float)c4; s = (float)s4;
}
DI void cs_item(const P& p, int idx) {
    const int e = idx * 256 + tidx(), tok = e >> 3, f = e & 7;
    const float invf[8] = {1.000000000e+00f, 1.939227432e-01f, 3.760603070e-02f, 7.292664610e-03f, 1.414213562e-03f, 2.742481884e-04f, 5.318295734e-05f, 1.031338525e-05f};
    float iv = invf[0];
#pragma unroll
    for (int i = 1; i < 8; ++i) iv = (f == i) ? invf[i] : iv;
    const float ang = (float)p.pos[tok] * iv;
    float c, s; sincos_d(ang, c, s);
    p.cosT[e] = c; p.sinT[e] = s;
}
DI void rms_item(const float* src, const float* g, bf16_t* dst, int idx) {
    const int row = idx * 4 + (tidx() >> 6), lane = tidx() & 63;
    const float4* sp = (const float4*)(src + (size_t)row * 1024);
    float4 v[4]; float ss = 0.f;
#pragma unroll
    for (int i = 0; i < 4; ++i) { v[i] = sp[lane + 64 * i]; ss += v[i].x * v[i].x + v[i].y * v[i].y + v[i].z * v[i].z + v[i].w * v[i].w; }
    ss = wave_sum(ss);
    const float rs = rsqrtf(ss * (1.f / 1024.f) + 1e-6f);
#pragma unroll
    for (int i = 0; i < 4; ++i) {
        const float4 gv = ((const float4*)g)[lane + 64 * i];
        uint2 o; o.x = pack2(v[i].x * rs * gv.x, v[i].y * rs * gv.y); o.y = pack2(v[i].z * rs * gv.z, v[i].w * rs * gv.w);
        *(uint2*)(dst + (size_t)row * 1024 + (lane + 64 * i) * 4) = o;
    }
}
DI void phase0(const P& p, char* smem) {
    if (blockIdx.x == 0 && tidx() < 8) p.counter[tidx()] = 0u;
    constexpr int NTR = 3480, NB1 = 32, NCS = 1024, NXN = 8192;
    for (int it = blockIdx.x; it < NTR + NB1 + NCS + NXN; it += gridDim.x) {
        if (it < NTR) { if (gridDim.x != 512 || it < 800 || it >= 3168) tr_item(p, it, (float*)smem); }
        else if (it < NTR + NB1) b1_item(p, it - NTR);
        else if (it < NTR + NB1 + NCS) cs_item(p, it - NTR - NB1);
        else rms_item(p.x, p.norm_mix, p.A, it - NTR - NB1 - NCS);
    }
}

struct AFPlain { const bf16_t* A; int lda; DI uint4 load(int row, int k) const { return *(const uint4*)(A + (size_t)row * lda + k); } };
struct AFCmp {
    const bf16_t* base;
    DI uint4 load(int r, int k) const { int tok = 16 * r + (k >> 6); tok = tok < S_ ? tok : S_ - 1; return *(const uint4*)(base + (size_t)tok * PLD + (k & 63)); }
};

template <int KU, class AF, class EPI>
DI void gemm_tile(const AF af, const bf16_t* __restrict__ Bt, const int K, const int m0, const int n0, const EPI epi, char* smem) {
    const int tid = tidx(), wave = tid >> 6, lane = tid & 63, wm = wave >> 1, wn = wave & 1, rr = lane & 31, hh = lane >> 5;
    f32x16 acc[2][2];
#pragma unroll
    for (int a = 0; a < 2; ++a)
#pragma unroll
        for (int b = 0; b < 2; ++b)
#pragma unroll
            for (int i = 0; i < 16; ++i) acc[a][b][i] = 0.f;
    const int lrow = tid >> 3, lk = (tid & 7) * 8;
#define GLOAD(R, KO) \
    R##a0 = af.load(m0 + lrow, (KO) + lk); R##a1 = af.load(m0 + lrow + 32, (KO) + lk); R##a2 = af.load(m0 + lrow + 64, (KO) + lk); R##a3 = af.load(m0 + lrow + 96, (KO) + lk); \
    R##b0 = *(const uint4*)(Bt + (size_t)(lrow) * K + (KO) + lk); R##b1 = *(const uint4*)(Bt + (size_t)(lrow + 32) * K + (KO) + lk); \
    R##b2 = *(const uint4*)(Bt + (size_t)(lrow + 64) * K + (KO) + lk); R##b3 = *(const uint4*)(Bt + (size_t)(lrow + 96) * K + (KO) + lk);
#define GSTORE(R, SA, SB) \
    *(uint4*)&(SA)[(lrow) * 72 + lk] = R##a0; *(uint4*)&(SA)[(lrow + 32) * 72 + lk] = R##a1; *(uint4*)&(SA)[(lrow + 64) * 72 + lk] = R##a2; *(uint4*)&(SA)[(lrow + 96) * 72 + lk] = R##a3; \
    *(uint4*)&(SB)[(lrow) * 72 + lk] = R##b0; *(uint4*)&(SB)[(lrow + 32) * 72 + lk] = R##b1; *(uint4*)&(SB)[(lrow + 64) * 72 + lk] = R##b2; *(uint4*)&(SB)[(lrow + 96) * 72 + lk] = R##b3;
#define GCOMPUTE(SA, SB) \
    _Pragma("unroll") for (int ks = 0; ks < 4; ++ks) { \
        bf16x8 tf0 = *(const bf16x8*)&(SA)[(wm * 64 + rr) * 72 + ks * 16 + hh * 8], tf1 = *(const bf16x8*)&(SA)[(wm * 64 + 32 + rr) * 72 + ks * 16 + hh * 8]; \
        bf16x8 wf0 = *(const bf16x8*)&(SB)[(wn * 64 + rr) * 72 + ks * 16 + hh * 8], wf1 = *(const bf16x8*)&(SB)[(wn * 64 + 32 + rr) * 72 + ks * 16 + hh * 8]; \
        acc[0][0] = MFMA32(wf0, tf0, acc[0][0]); acc[0][1] = MFMA32(wf0, tf1, acc[0][1]); acc[1][0] = MFMA32(wf1, tf0, acc[1][0]); acc[1][1] = MFMA32(wf1, tf1, acc[1][1]); }
    uint4 Xa0, Xa1, Xa2, Xa3, Xb0, Xb1, Xb2, Xb3, Ya0, Ya1, Ya2, Ya3, Yb0, Yb1, Yb2, Yb3;
    bf16_t* const sA0 = (bf16_t*)smem; bf16_t* const sB0 = sA0 + 128 * 72; bf16_t* const sA1 = sB0 + 128 * 72; bf16_t* const sB1 = sA1 + 128 * 72;
    GLOAD(X, 0)
    GLOAD(Y, 64)
    __syncthreads();
    GSTORE(X, sA0, sB0)
    __syncthreads();
#pragma unroll KU
    for (int k0 = 0; k0 < K; k0 += 128) {
        const bool more = (k0 + 128 < K);
        if (more) { GLOAD(X, k0 + 128) }
        __builtin_amdgcn_s_setprio(1);
        GCOMPUTE(sA0, sB0)
        __builtin_amdgcn_s_setprio(0);
        GSTORE(Y, sA1, sB1)
        __syncthreads();
        __builtin_amdgcn_sched_barrier(0);
        if (more) { GLOAD(Y, k0 + 192) }
        __builtin_amdgcn_s_setprio(1);
        GCOMPUTE(sA1, sB1)
        __builtin_amdgcn_s_setprio(0);
        if (more) { GSTORE(X, sA0, sB0) }
        __syncthreads();
        __builtin_amdgcn_sched_barrier(0);
    }
#undef GLOAD
#undef GSTORE
#undef GCOMPUTE
    epi(acc, m0 + wm * 64, n0 + wn * 64, lane);
}

struct EpiProj {
    bf16_t* C;
    DI void operator()(const f32x16 (&acc)[2][2], int rowbase, int colbase, int lane) const {
        const int rr = lane & 31, hh = lane >> 5;
#pragma unroll
        for (int w = 0; w < 2; ++w)
#pragma unroll
            for (int t = 0; t < 2; ++t)
#pragma unroll
                for (int j = 0; j < 4; ++j) {
                    uint2 o; o.x = pack2(acc[w][t][4 * j], acc[w][t][4 * j + 1]); o.y = pack2(acc[w][t][4 * j + 2], acc[w][t][4 * j + 3]);
                    *(uint2*)(C + (size_t)(rowbase + t * 32 + rr) * PLD + colbase + w * 32 + j * 8 + hh * 4) = o;
                }
    }
};
struct EpiHid {
    bf16_t* H; const float* bias;
    DI void operator()(const f32x16 (&acc)[2][2], int rowbase, int colbase, int lane) const {
        const int rr = lane & 31, hh = lane >> 5;
#pragma unroll
        for (int w = 0; w < 2; ++w)
#pragma unroll
            for (int t = 0; t < 2; ++t)
#pragma unroll
                for (int j = 0; j < 4; ++j) {
                    const int col = colbase + w * 32 + j * 8 + hh * 4;
                    const float4 bv = *(const float4*)(bias + col);
                    float v0 = acc[w][t][4 * j] + bv.x, v1 = acc[w][t][4 * j + 1] + bv.y, v2 = acc[w][t][4 * j + 2] + bv.z, v3 = acc[w][t][4 * j + 3] + bv.w;
                    v0 *= sigmoidf_(v0); v1 *= sigmoidf_(v1); v2 *= sigmoidf_(v2); v3 *= sigmoidf_(v3);
                    uint2 o; o.x = pack2(v0, v1); o.y = pack2(v2, v3);
                    *(uint2*)(H + (size_t)(rowbase + t * 32 + rr) * 256 + col) = o;
                }
    }
};
struct EpiKc {
    bf16_t* kc; const float *cosT, *sinT; int tokbase;
    DI void operator()(const f32x16 (&acc)[2][2], int rowbase, int colbase, int lane) const {
        if (colbase != 0) return;
        const int rr = lane & 31, hh = lane >> 5;
#pragma unroll
        for (int t = 0; t < 2; ++t) {
            const int r = rowbase + t * 32 + rr;
            int tk = 31 + 16 * r; tk = tk < S_ ? tk : S_ - 1;
            const float4 c = *(const float4*)(cosT + (size_t)(tokbase + tk) * 8 + hh * 4), s = *(const float4*)(sinT + (size_t)(tokbase + tk) * 8 + hh * 4);
            bf16_t* kp = kc + (size_t)r * 64 + hh * 4;
            const float a0 = acc[0][t][0], a1 = acc[0][t][1], a2 = acc[0][t][2], a3 = acc[0][t][3];
            const float b0 = acc[0][t][4], b1 = acc[0][t][5], b2 = acc[0][t][6], b3 = acc[0][t][7];
            uint2 o;
            o.x = pack2(a0 * c.x - b0 * s.x, a1 * c.y - b1 * s.y); o.y = pack2(a2 * c.z - b2 * s.z, a3 * c.w - b3 * s.w);
            *(uint2*)(kp) = o;
            o.x = pack2(b0 * c.x + a0 * s.x, b1 * c.y + a1 * s.y); o.y = pack2(b2 * c.z + a2 * s.z, b3 * c.w + a3 * s.w);
            *(uint2*)(kp + 8) = o;
#pragma unroll
            for (int j = 2; j < 4; ++j) {
                o.x = pack2(acc[0][t][4 * j], acc[0][t][4 * j + 1]); o.y = pack2(acc[0][t][4 * j + 2], acc[0][t][4 * j + 3]);
                *(uint2*)(kp + j * 8) = o;
            }
#pragma unroll
            for (int j = 0; j < 4; ++j) {
                o.x = pack2(acc[1][t][4 * j], acc[1][t][4 * j + 1]); o.y = pack2(acc[1][t][4 * j + 2], acc[1][t][4 * j + 3]);
                *(uint2*)(kp + 32 + j * 8) = o;
            }
        }
    }
};
struct EpiVc {
    bf16_t* vcT; char* smem;
    DI void operator()(const f32x16 (&acc)[2][2], int rowbase, int colbase, int lane) const {
        const int rr = lane & 31, hh = lane >> 5;
        bf16_t* tl = (bf16_t*)smem;
        __syncthreads();
        if (colbase == 0) {
            const int rl = rowbase & 127;
#pragma unroll
            for (int w = 0; w < 2; ++w)
#pragma unroll
                for (int t = 0; t < 2; ++t)
#pragma unroll
                    for (int i = 0; i < 16; ++i) tl[(w * 32 + crow(i, hh)) * 136 + rl + t * 32 + rr] = f2bf(acc[w][t][i]);
        }
        __syncthreads();
        const int m0 = rowbase & ~127;
#pragma unroll
        for (int i = 0; i < 4; ++i) {
            const int c = tidx() + i * 256, d = c >> 4, ch = c & 15;
            *(uint4*)(vcT + (size_t)d * 1024 + m0 + ch * 8) = *(const uint4*)&tl[d * 136 + ch * 8];
        }
    }
};
struct EpiOut {
    float* out; const float* x;
    DI void operator()(const f32x16 (&acc)[2][2], int rowbase, int colbase, int lane) const {
        const int rr = lane & 31, hh = lane >> 5;
#pragma unroll
        for (int w = 0; w < 2; ++w)
#pragma unroll
            for (int t = 0; t < 2; ++t)
#pragma unroll
                for (int j = 0; j < 4; ++j) {
                    const size_t o = (size_t)(rowbase + t * 32 + rr) * 1024 + colbase + w * 32 + j * 8 + hh * 4;
                    float4 xv = *(const float4*)(x + o);
                    xv.x += acc[w][t][4 * j]; xv.y += acc[w][t][4 * j + 1]; xv.z += acc[w][t][4 * j + 2]; xv.w += acc[w][t][4 * j + 3];
                    *(float4*)(out + o) = xv;
                }
    }
};
struct EpiFfn1 {
    bf16_t* act;
    DI void operator()(const f32x16 (&acc)[2][2], int rowbase, int colbase, int lane) const {
        const int rr = lane & 31, hh = lane >> 5;
        const int cb = (colbase >> 6) * 32;
#pragma unroll
        for (int t = 0; t < 2; ++t)
#pragma unroll
            for (int j = 0; j < 4; ++j) {
                float v[4];
#pragma unroll
                for (int i = 0; i < 4; ++i) { const float g = acc[0][t][4 * j + i], u = acc[1][t][4 * j + i]; v[i] = g * sigmoidf_(g) * u; }
                uint2 o; o.x = pack2(v[0], v[1]); o.y = pack2(v[2], v[3]);
                *(uint2*)(act + (size_t)(rowbase + t * 32 + rr) * DFF + cb + j * 8 + hh * 4) = o;
            }
    }
};

DI void rwkv_prep(const P& p, int idx, char* smem) {
    const int tile = idx, tt0 = tile * 32;
    const int tid = tidx(), wave = tid >> 6, lane = tid & 63, rr = lane & 31, hh = lane >> 5;
    bf16_t* lat = (bf16_t*)smem;
    float* res = (float*)(smem + 32 * 296 * 2);
    __syncthreads();
    for (int c = tid; c < 32 * 36; c += NTHR) {
        const int tok = c / 36, ch = c - tok * 36, gi = tt0 + tok, col = 1536 + ch * 8;
        const uint4 cu = *(const uint4*)(p.proj + (size_t)gi * PLD + col);
        uint4 pv = make_uint4(0, 0, 0, 0);
        if ((gi & (S_ - 1)) != 0) pv = *(const uint4*)(p.proj + (size_t)(gi - 1) * PLD + col);
        float a[8], b[8]; unpack8(cu, a); unpack8(pv, b);
        const float4 m0 = *(const float4*)(p.mu + col), m1 = *(const float4*)(p.mu + col + 4);
        const float mu[8] = {m0.x, m0.y, m0.z, m0.w, m1.x, m1.y, m1.z, m1.w};
#pragma unroll
        for (int e = 0; e < 8; ++e) {
            float x = a[e] + (b[e] - a[e]) * mu[e];
            if (ch < 8) x = 1.f - 2.f / (1.f + __expf(2.f * x)); else if (ch >= 16) x = sigmoidf_(x);
            a[e] = x;
        }
        *(uint4*)&lat[tok * 296 + ch * 8] = pack8(a);
    }
    __syncthreads();
#pragma unroll 1
    for (int h = 0; h < 8; ++h) {
    if (wave < 2) {
        const int mt = wave;
        f32x16 aw, aa;
#pragma unroll
        for (int i = 0; i < 16; ++i) { aw[i] = 0.f; aa[i] = 0.f; }
#pragma unroll
        for (int ks = 0; ks < 4; ++ks) {
            const bf16x8 wf = *(const bf16x8*)(p.w2T + (size_t)(h * 64 + mt * 32 + rr) * 64 + ks * 16 + hh * 8);
            const bf16x8 af = *(const bf16x8*)(p.a2T + (size_t)(h * 64 + mt * 32 + rr) * 64 + ks * 16 + hh * 8);
            const bf16x8 l0 = *(const bf16x8*)&lat[rr * 296 + ks * 16 + hh * 8];
            const bf16x8 l1 = *(const bf16x8*)&lat[rr * 296 + 64 + ks * 16 + hh * 8];
            aw = MFMA32(wf, l0, aw); aa = MFMA32(af, l1, aa);
        }
#pragma unroll
        for (int j = 0; j < 4; ++j) {
            *(float4*)&res[(0 * 32 + rr) * 64 + mt * 32 + j * 8 + hh * 4] = make_float4(aw[4 * j], aw[4 * j + 1], aw[4 * j + 2], aw[4 * j + 3]);
            *(float4*)&res[(1 * 32 + rr) * 64 + mt * 32 + j * 8 + hh * 4] = make_float4(aa[4 * j], aa[4 * j + 1], aa[4 * j + 2], aa[4 * j + 3]);
        }
    } else {
        const int mt = wave - 2;
        f32x16 ag;
#pragma unroll
        for (int i = 0; i < 16; ++i) ag[i] = 0.f;
#pragma unroll
        for (int ks = 0; ks < 10; ++ks) {
            const bf16x8 gf = *(const bf16x8*)(p.g2T + (size_t)(h * 64 + mt * 32 + rr) * 160 + ks * 16 + hh * 8);
            const bf16x8 l2 = *(const bf16x8*)&lat[rr * 296 + 128 + ks * 16 + hh * 8];
            ag = MFMA32(gf, l2, ag);
        }
#pragma unroll
        for (int j = 0; j < 4; ++j)
            *(float4*)&res[(2 * 32 + rr) * 64 + mt * 32 + j * 8 + hh * 4] = make_float4(ag[4 * j], ag[4 * j + 1], ag[4 * j + 2], ag[4 * j + 3]);
    }
    __syncthreads();
    {
        const int tok = tid >> 3, cgp = tid & 7, gi = tt0 + tok, b = gi >> 14, s = gi & (S_ - 1), cb = h * 64 + cgp * 8;
        const bool first = (s == 0);
        float r[8], k[8], v[8];
        {
            float a[8], pb[8];
            const bf16_t* pr = p.proj + (size_t)gi * PLD;
#pragma unroll
            for (int q = 0; q < 3; ++q) {
                const int col = q * 512 + cb;
                unpack8(*(const uint4*)(pr + col), a);
                if (first) {
#pragma unroll
                    for (int e = 0; e < 8; ++e) pb[e] = 0.f;
                } else unpack8(*(const uint4*)(pr - PLD + col), pb);
                const float4 m0 = *(const float4*)(p.mu + col), m1 = *(const float4*)(p.mu + col + 4);
                const float mu[8] = {m0.x, m0.y, m0.z, m0.w, m1.x, m1.y, m1.z, m1.w};
#pragma unroll
                for (int e = 0; e < 8; ++e) {
                    const float x = a[e] + (pb[e] - a[e]) * mu[e];
                    if (q == 0) r[e] = x; else if (q == 1) k[e] = x; else v[e] = x;
                }
            }
        }
        float om[8], av[8], gg[8], kk[8], km[8], bb[8];
        float ss = 0.f;
#pragma unroll
        for (int e = 0; e < 8; ++e) {
            const float wp = res[(0 * 32 + tok) * 64 + cgp * 8 + e] + p.w0[cb + e];
            const float z = -wp;
            const float sp = fmaxf(z, 0.f) + __logf(1.f + __expf(-fabsf(z)));
            const float w = -sp - 0.5f;
            om[e] = 1.f - __expf(-__expf(w));
            av[e] = sigmoidf_(res[(1 * 32 + tok) * 64 + cgp * 8 + e] + p.a0[cb + e]);
            gg[e] = res[(2 * 32 + tok) * 64 + cgp * 8 + e];
            kk[e] = k[e] * p.k_k[cb + e];
            ss += kk[e] * kk[e];
            km[e] = k[e] * (1.f + (av[e] - 1.f) * p.k_a[cb + e]);
        }
        ss += __shfl_xor(ss, 1); ss += __shfl_xor(ss, 2); ss += __shfl_xor(ss, 4);
        const float inv = 1.f / fmaxf(sqrtf(ss), 1e-12f);
#pragma unroll
        for (int e = 0; e < 8; ++e) { kk[e] *= inv; bb[e] = kk[e] * av[e]; }
        bf16_t* sp = p.stream + ((size_t)((b * 8 + h) * S_ + s) * 6) * 64 + cgp * 8;
        *(uint4*)(sp) = pack8(om); *(uint4*)(sp + 64) = pack8(km); *(uint4*)(sp + 128) = pack8(kk);
        *(uint4*)(sp + 192) = pack8(bb); *(uint4*)(sp + 256) = pack8(r); *(uint4*)(sp + 320) = pack8(v);
        *(uint4*)(p.gbuf + (size_t)gi * 512 + cb) = pack8(gg);
    }
    __syncthreads();
    }
}

DI void rope_item(const P& p, int idx, char* smem) {
    const int tt0 = idx * 64, tid = tidx();
    bf16_t* vtile = (bf16_t*)smem;
    bf16_t* ktile = vtile + 4 * 64 * 72;
    __syncthreads();
#pragma unroll 1
    for (int it = 0; it < 2; ++it) {
        const int item = tid + it * 256, tok = item >> 3, head = item & 7, gi = tt0 + tok;
        bf16_t* ptr = p.proj + (size_t)gi * PLD + QC + head * 64;
        const float4 c0 = *(const float4*)(p.cosT + (size_t)gi * 8), c1 = *(const float4*)(p.cosT + (size_t)gi * 8 + 4);
        const float4 s0 = *(const float4*)(p.sinT + (size_t)gi * 8), s1 = *(const float4*)(p.sinT + (size_t)gi * 8 + 4);
        const float cc[8] = {c0.x, c0.y, c0.z, c0.w, c1.x, c1.y, c1.z, c1.w}, sn[8] = {s0.x, s0.y, s0.z, s0.w, s1.x, s1.y, s1.z, s1.w};
        float a[8], b[8];
        unpack8(*(const uint4*)ptr, a); unpack8(*(const uint4*)(ptr + 8), b);
#pragma unroll
        for (int e = 0; e < 8; ++e) { const float x1 = a[e], x2 = b[e]; a[e] = (x1 * cc[e] - x2 * sn[e]) * QSC; b[e] = (x2 * cc[e] + x1 * sn[e]) * QSC; }
        *(uint4*)ptr = pack8(a); *(uint4*)(ptr + 8) = pack8(b);
#pragma unroll
        for (int q = 2; q < 8; ++q) {
            unpack8(*(const uint4*)(ptr + q * 8), a);
#pragma unroll
            for (int e = 0; e < 8; ++e) a[e] *= QSC;
            *(uint4*)(ptr + q * 8) = pack8(a);
        }
    }
    {
        const int tok = tid >> 2, sel = (tid >> 1) & 1, hk = tid & 1, gi = tt0 + tok;
        const float4 c0 = *(const float4*)(p.cosT + (size_t)gi * 8), c1 = *(const float4*)(p.cosT + (size_t)gi * 8 + 4);
        const float4 s0 = *(const float4*)(p.sinT + (size_t)gi * 8), s1 = *(const float4*)(p.sinT + (size_t)gi * 8 + 4);
        const float cc[8] = {c0.x, c0.y, c0.z, c0.w, c1.x, c1.y, c1.z, c1.w}, sn[8] = {s0.x, s0.y, s0.z, s0.w, s1.x, s1.y, s1.z, s1.w};
        float a[8], b[8];
        {
            bf16_t* ptr = p.proj + (size_t)gi * PLD + KVC + (sel ? 4 : 2) * 128 + hk * 64;
            unpack8(*(const uint4*)ptr, a); unpack8(*(const uint4*)(ptr + 8), b);
#pragma unroll
            for (int e = 0; e < 8; ++e) { const float x1 = a[e], x2 = b[e]; a[e] = x1 * cc[e] - x2 * sn[e]; b[e] = x2 * cc[e] + x1 * sn[e]; }
            const uint4 ra_ = pack8(a), rb_ = pack8(b);
            *(uint4*)ptr = ra_; *(uint4*)(ptr + 8) = rb_;
            if (sel == 0) {
                bf16_t* kt = ktile + (size_t)(hk * 64 + tok) * 72;
                *(uint4*)kt = ra_; *(uint4*)(kt + 8) = rb_;
#pragma unroll
                for (int q = 2; q < 8; ++q) *(uint4*)(kt + q * 8) = *(const uint4*)(ptr + q * 8);
            }
        }
        {
            const bf16_t* ptr = p.proj + (size_t)gi * PLD + KVC + (sel ? 5 : 3) * 128 + hk * 64;
            bf16_t* vt = vtile + (size_t)((sel * 2 + hk) * 64) * 72 + tok;
            unpack8(*(const uint4*)ptr, a); unpack8(*(const uint4*)(ptr + 8), b);
#pragma unroll
            for (int e = 0; e < 8; ++e) { const float x1 = a[e], x2 = b[e]; a[e] = x1 * cc[e] - x2 * sn[e]; b[e] = x2 * cc[e] + x1 * sn[e]; }
#pragma unroll
            for (int e = 0; e < 8; ++e) { vt[e * 72] = f2bf(a[e]); vt[(8 + e) * 72] = f2bf(b[e]); }
#pragma unroll
            for (int q = 2; q < 8; ++q) {
                const uint4 u = *(const uint4*)(ptr + q * 8);
                const unsigned w[4] = {u.x, u.y, u.z, u.w};
#pragma unroll
                for (int e = 0; e < 4; ++e) { vt[(q * 8 + 2 * e) * 72] = (bf16_t)(w[e] & 0xffffu); vt[(q * 8 + 2 * e + 1) * 72] = (bf16_t)(w[e] >> 16); }
            }
        }
    }
    __syncthreads();
    const int b = tt0 >> 14, s0 = tt0 & (S_ - 1);
#pragma unroll
    for (int i = 0; i < 8; ++i) {
        const int c = tid + i * 256, grp = c >> 9, d = (c >> 3) & 63, ch = c & 7, sel = grp >> 1, hk = grp & 1;
        const uint4 u = *(const uint4*)&vtile[(size_t)(grp * 64 + d) * 72 + ch * 8];
        *(uint4*)(p.vT + ((size_t)((sel * 4 + b * 2 + hk) * 64 + d)) * S_ + s0 + ch * 8) = u;
    }
    const int blk = s0 >> 6;
#pragma unroll
    for (int i = 0; i < 4; ++i) {
        const int c = tid + i * 256, hk = c >> 9, g8 = (c >> 6) & 7, ln = c & 63;
        const size_t dsto = ((size_t)(((b * 2 + hk) * 256 + blk) * 8 + g8) * 64 + ln) * 8;
        const int m16 = ln & 15, g4 = ln >> 4;
        {
            const int kg = g8 >> 1, ks = g8 & 1;
            *(uint4*)(p.ksw + dsto) = *(const uint4*)&ktile[(size_t)(hk * 64 + kg * 16 + m16) * 72 + ks * 32 + g4 * 8];
        }
        {
            const int kk = g8 >> 2, dt = g8 & 3;
            const bf16_t* row = &vtile[(size_t)((0 * 2 + hk) * 64 + dt * 16 + m16) * 72 + kk * 32 + 4 * g4];
            const uint2 lo = *(const uint2*)row, hi = *(const uint2*)(row + 16);
            *(uint4*)(p.vsw + dsto) = make_uint4(lo.x, lo.y, hi.x, hi.y);
        }
    }
}

DI void cmp1_item(const P& p, const int it, char* smem) {
    const int kv = it >> 6, bhk = (it >> 4) & 3, mt = (it >> 1) & 7, nt = it & 1, b = bhk >> 1, hk = bhk & 1;
    AFCmp af{p.proj + (size_t)(b * S_) * PLD + KVC + kv * 128 + hk * 64};
    EpiHid ep{p.hid + (size_t)((kv * 4 + bhk) * 1024) * 256, p.b1p + kv * 256};
    gemm_tile<1>(af, p.w1T + (size_t)(kv * 256 + nt * 128) * 2048, 2048, mt * 128, nt * 128, ep, smem);
}
DI void cmp2_item(const P& p, const int it, char* smem) {
    const int kv = it >> 5, bhk = (it >> 3) & 3, mt = it & 7, b = bhk >> 1;
    AFPlain af{p.hid + (size_t)((kv * 4 + bhk) * 1024) * 256, 256};
    if (kv == 0) { EpiKc ep{p.kc + (size_t)bhk * 1024 * 64, p.cosT, p.sinT, b * S_}; gemm_tile<1>(af, p.wc2T, 256, mt * 128, 0, ep, smem); }
    else { EpiVc ep{p.vcT + (size_t)bhk * 64 * 1024, smem}; gemm_tile<1>(af, p.wc2T + 128 * 256, 256, mt * 128, 0, ep, smem); }
}
DI void phase2(const P& p, char* smem) {
    for (int it = blockIdx.x; it < 128 + 512 + 1024; it += gridDim.x) {
        if (it < 128) cmp1_item(p, it, smem);
        else if (it < 640) rope_item(p, it - 128, smem);
        else rwkv_prep(p, it - 640, smem);
    }
}
DI void phase3(const P& p, char* smem) {
    for (int it = blockIdx.x; it < 64; it += gridDim.x) cmp2_item(p, it, smem);
}

template <int CTRL> DI float dpp_add(float x) { return x + __int_as_float(__builtin_amdgcn_mov_dpp(__float_as_int(x), CTRL, 0xF, 0xF, true)); }
DI float red16(float x) { x = dpp_add<0xB1>(x); x = dpp_add<0x4E>(x); x = dpp_add<0x141>(x); x = dpp_add<0x140>(x); return x; }

DI void cvt_store(const uint4 u, const bool isom, float* d) {
    float f0 = bflo(u.x), f1 = bfhi(u.x), f2 = bflo(u.y), f3 = bfhi(u.y), f4 = bflo(u.z), f5 = bfhi(u.z), f6 = bflo(u.w), f7 = bfhi(u.w);
    if (isom) { f0 = 1.f - f0; f1 = 1.f - f1; f2 = 1.f - f2; f3 = 1.f - f3; f4 = 1.f - f4; f5 = 1.f - f5; f6 = 1.f - f6; f7 = 1.f - f7; }
    *(float4*)d = make_float4(f0, f1, f2, f3); *(float4*)(d + 4) = make_float4(f4, f5, f6, f7);
}
DI void scan_unit(const P& p, int su, char* smem) {
    const int xcd = su & 7, kq = su >> 3, bh = xcd * 2 + (kq >> 3), oct = kq & 7, b = bh >> 3, h = bh & 7;
    const int tid = tidx(), wave = tid >> 6, lane = tid & 63;
    float* buf = (float*)smem;
    float* ypb = (float*)(smem + 49152);
    const bf16_t* sbase = p.stream + (size_t)bh * S_ * 384;
    __syncthreads();
#pragma unroll
    for (int i = 0; i < 3; ++i) { const int ci = tid + i * 256; cvt_store(*(const uint4*)(sbase + (size_t)ci * 8), (ci % 48) < 8, buf + ci * 8); }
    __syncthreads();
    if (wave < 2) {
        const int rl = lane >> 4, ks = lane & 15, row = oct * 8 + wave * 4 + rl;
        f2_t sA = {0.f, 0.f}, sB = {0.f, 0.f};
        __builtin_amdgcn_s_setprio(3);
        for (int c = 0; c < 1024; ++c) {
            const float* cb = buf + (c & 1) * 6144 + ks * 4;
            const float* vb = buf + (c & 1) * 6144 + 320 + row;
            float* yo = ypb + ((c & 1) * 2 + wave) * 1024 + lane;
            float4 dec = *(const float4*)(cb), km = *(const float4*)(cb + 64), kk = *(const float4*)(cb + 128), bb = *(const float4*)(cb + 192), rv = *(const float4*)(cb + 256);
            float v = vb[0];
            float4 dec1 = *(const float4*)(cb + 384), km1 = *(const float4*)(cb + 384 + 64), kk1 = *(const float4*)(cb + 384 + 128), bb1 = *(const float4*)(cb + 384 + 192), rv1 = *(const float4*)(cb + 384 + 256);
            float v1 = vb[384];
#pragma unroll
            for (int st = 0; st < 16; ++st) {
                float4 dec2 = dec1, km2 = km1, kk2 = kk1, bb2 = bb1, rv2 = rv1; float v2 = v1;
                if (st < 14) {
                    const float* rec = cb + (st + 2) * 384;
                    dec2 = *(const float4*)(rec); km2 = *(const float4*)(rec + 64); kk2 = *(const float4*)(rec + 128); bb2 = *(const float4*)(rec + 192); rv2 = *(const float4*)(rec + 256);
                    v2 = vb[(st + 2) * 384];
                }
                __builtin_amdgcn_sched_barrier(0x207);
                const f2_t vv = {v, v};
                const f2_t d01 = {dec.x, dec.y}, d23 = {dec.z, dec.w}, m01 = {km.x, km.y}, m23 = {km.z, km.w};
                const f2_t k01 = {kk.x, kk.y}, k23 = {kk.z, kk.w}, b01 = {bb.x, bb.y}, b23 = {bb.z, bb.w}, r01 = {rv.x, rv.y}, r23 = {rv.z, rv.w};
                const f2_t tA = sA * d01 + vv * m01, tB = sB * d23 + vv * m23;
                f2_t pa = sA * k01; pa = sB * k23 + pa;
                const float sa = red16(pa.x + pa.y);
                const f2_t sav = {sa, sa};
                sA = tA - sav * b01; sB = tB - sav * b23;
                f2_t ya = sA * r01; ya = sB * r23 + ya;
                yo[st * 64] = ya.x + ya.y;
                dec = dec1; km = km1; kk = kk1; bb = bb1; rv = rv1; v = v1;
                dec1 = dec2; km1 = km2; kk1 = kk2; bb1 = bb2; rv1 = rv2; v1 = v2;
            }
            __syncthreads();
        }
        __builtin_amdgcn_s_setprio(0);
    } else {
        const int ht = tid - 128;
        const int ystep = ht >> 3, r8 = ht & 7;
        float* yout = p.yraw + (size_t)(b * S_) * 512 + h * 64 + oct * 8 + r8;
        const float* ysrc = ypb + (r8 >> 2) * 1024 + ystep * 64 + (r8 & 3) * 16;
        uint4 ra0, ra1, ra2, ra3, ra4, ra5, rb0, rb1, rb2, rb3, rb4, rb5;
#define SLOAD(R, CH) { const bf16_t* sp_ = sbase + (size_t)(CH) * 6144 + (size_t)ht * 8; \
        R##0 = *(const uint4*)(sp_); R##1 = *(const uint4*)(sp_ + 1024); R##2 = *(const uint4*)(sp_ + 2048); R##3 = *(const uint4*)(sp_ + 3072); R##4 = *(const uint4*)(sp_ + 4096); R##5 = *(const uint4*)(sp_ + 5120); }
#define SSTORE(R, BI) { float* d_ = buf + (BI) * 6144 + ht * 8; const bool om_ = (ht % 48) < 8; \
        cvt_store(R##0, om_, d_); cvt_store(R##1, ((ht + 128) % 48) < 8, d_ + 1024); cvt_store(R##2, ((ht + 256) % 48) < 8, d_ + 2048); \
        cvt_store(R##3, ((ht + 384) % 48) < 8, d_ + 3072); cvt_store(R##4, ((ht + 512) % 48) < 8, d_ + 4096); cvt_store(R##5, ((ht + 640) % 48) < 8, d_ + 5120); }
#define YRED(C) { const float* ys_ = ysrc + ((C) & 1) * 2048; const float4 a_ = *(const float4*)ys_, b_ = *(const float4*)(ys_ + 4), c_ = *(const float4*)(ys_ + 8), d_ = *(const float4*)(ys_ + 12); \
        yout[(size_t)((C) * 16 + ystep) * 512] = ((a_.x + a_.y) + (a_.z + a_.w)) + ((b_.x + b_.y) + (b_.z + b_.w)) + ((c_.x + c_.y) + (c_.z + c_.w)) + ((d_.x + d_.y) + (d_.z + d_.w)); }
        SLOAD(ra, 1)
        for (int c = 0; c < 1024; c += 2) {
            if (c + 2 < 1024) SLOAD(rb, c + 2)
            SSTORE(ra, 1)
            if (c >= 1) YRED(c - 1)
            __syncthreads();
            if (c + 3 < 1024) SLOAD(ra, c + 3)
            if (c + 2 < 1024) SSTORE(rb, 0)
            YRED(c)
            __syncthreads();
        }
        YRED(1023)
#undef SLOAD
#undef SSTORE
#undef YRED
    }
}

struct AttnSmem {
    bf16_t k[64 * 72];
    bf16_t vt[64 * 68];
    float imp[32 * 256];
    unsigned selbits[32 * 8];
    unsigned wunion[4 * 8];
    unsigned bunion[8];
    unsigned gunion[8 * 8];
    int unit;
    int pad_[3];
    uint4 q[4 * 4 * 64];
};

#define ATTN_LOAD(KBASE, KSTRIDE, VTBASE, VTSTRIDE, NEEDV) { \
    rk0 = *(const uint4*)((KBASE) + (size_t)(tid >> 3) * (KSTRIDE) + (tid & 7) * 8); \
    rk1 = *(const uint4*)((KBASE) + (size_t)((tid >> 3) + 32) * (KSTRIDE) + (tid & 7) * 8); \
    if (NEEDV) { rv0 = *(const uint4*)((VTBASE) + (size_t)(tid >> 3) * (VTSTRIDE) + (tid & 7) * 8); \
                 rv1 = *(const uint4*)((VTBASE) + (size_t)((tid >> 3) + 32) * (VTSTRIDE) + (tid & 7) * 8); } }
#define ATTN_STORE(NEEDV) { \
    *(uint4*)&sm.k[(tid >> 3) * 72 + (tid & 7) * 8] = rk0; *(uint4*)&sm.k[((tid >> 3) + 32) * 72 + (tid & 7) * 8] = rk1; \
    if (NEEDV) { bf16_t* d0_ = &sm.vt[(tid >> 3) * 68 + (tid & 7) * 8]; bf16_t* d1_ = &sm.vt[((tid >> 3) + 32) * 68 + (tid & 7) * 8]; \
        *(uint2*)d0_ = make_uint2(rv0.x, rv0.y); *(uint2*)(d0_ + 4) = make_uint2(rv0.z, rv0.w); \
        *(uint2*)d1_ = make_uint2(rv1.x, rv1.y); *(uint2*)(d1_ + 4) = make_uint2(rv1.z, rv1.w); } }

template <int MODE, bool EM>
DI void attn_tile(AttnSmem& sm, const uint4* qs, f32x16 (&o)[2], float& m, float& l, const float inv_l, const int lo, const int hi, const bool lane_on,
                  const int lane, const int tokl, const int jbase) {
    const int rr = lane & 31, hh = lane >> 5;
    f32x16 s[2];
#pragma unroll
    for (int mt = 0; mt < 2; ++mt) {
#pragma unroll
        for (int i = 0; i < 16; ++i) s[mt][i] = 0.f;
#pragma unroll
        for (int ks = 0; ks < 4; ++ks) {
            const bf16x8 kf = *(const bf16x8*)&sm.k[(mt * 32 + rr) * 72 + ks * 16 + hh * 8];
            const bf16x8 qv = __builtin_bit_cast(bf16x8, qs[ks * 64]);
            s[mt] = MFMA32(kf, qv, s[mt]);
        }
        asm volatile("" ::: "memory");
    }
    (void)m;
    __builtin_amdgcn_sched_barrier(0);
    float psum = 0.f;
    if (EM) {
        const int lo2 = lo - 4 * hh, hi2 = hi - 4 * hh;
#pragma unroll
        for (int mt = 0; mt < 2; ++mt)
#pragma unroll
            for (int i = 0; i < 16; ++i) {
                const int kc_ = mt * 32 + (i & 3) + 8 * (i >> 2);
                float v = s[mt][i];
                v = (kc_ >= lo2 && kc_ <= hi2) ? v : -1e30f;
                float pv = __builtin_amdgcn_exp2f(v);
                if (MODE == 2) pv *= inv_l;
                s[mt][i] = pv; psum += pv;
            }
    } else {
        const float off = lane_on ? 0.f : -1e30f;
#pragma unroll
        for (int mt = 0; mt < 2; ++mt)
#pragma unroll
            for (int i = 0; i < 16; ++i) {
                float pv = __builtin_amdgcn_exp2f(s[mt][i] + off);
                if (MODE == 2) pv *= inv_l;
                s[mt][i] = pv; psum += pv;
            }
    }
    __builtin_amdgcn_sched_barrier(0);
    if (MODE != 2) l += psum;
    if (MODE == 0) return;
    if (MODE == 2) {
#pragma unroll
        for (int mt = 0; mt < 2; ++mt)
#pragma unroll
            for (int jj = 0; jj < 4; ++jj) {
                float q4 = (s[mt][4 * jj] + s[mt][4 * jj + 1]) + (s[mt][4 * jj + 2] + s[mt][4 * jj + 3]);
                float e3 = s[mt][4 * jj + 3];
                q4 += __shfl_xor(q4, 1); q4 += __shfl_xor(q4, 2);
                e3 += __shfl_xor(e3, 1); e3 += __shfl_xor(e3, 2);
                if ((rr & 3) == 0) {
                    const int j = jbase + mt * 8 + 2 * jj + hh;
                    atomicAdd(&sm.imp[tokl * 256 + j], q4);
                    if (j + 1 < 256) atomicAdd(&sm.imp[tokl * 256 + j + 1], e3);
                }
            }
    }
#pragma unroll
    for (int mt = 0; mt < 2; ++mt)
#pragma unroll
        for (int s2 = 0; s2 < 2; ++s2) {
            uint4 pu;
            pu.x = pack2(s[mt][8 * s2 + 0], s[mt][8 * s2 + 1]); pu.y = pack2(s[mt][8 * s2 + 2], s[mt][8 * s2 + 3]);
            pu.z = pack2(s[mt][8 * s2 + 4], s[mt][8 * s2 + 5]); pu.w = pack2(s[mt][8 * s2 + 6], s[mt][8 * s2 + 7]);
            const bf16x8 pf = __builtin_bit_cast(bf16x8, pu);
            asm volatile("" ::: "memory");
#pragma unroll
            for (int dt = 0; dt < 2; ++dt) {
                const bf16_t* vp = &sm.vt[(dt * 32 + rr) * 68 + mt * 32 + s2 * 16 + hh * 4];
                const uint2 v0 = *(const uint2*)vp, v1 = *(const uint2*)(vp + 8);
                const bf16x8 vf = __builtin_bit_cast(bf16x8, make_uint4(v0.x, v0.y, v1.x, v1.y));
                o[dt] = MFMA32(vf, pf, o[dt]);
            }
        }
}

template <int MODE, bool EM>
DI void attn_tile_g(AttnSmem& sm, const bf16_t* __restrict__ kg, const bf16_t* __restrict__ vg, const uint4* qs, f32x16 (&o)[2], float& m, float& l, const float inv_l, const int lo, const int hi, const bool lane_on,
                  const int lane, const int tokl, const int jbase) {
    const int rr = lane & 31, hh = lane >> 5;
    f32x16 s[2];
#pragma unroll
    for (int mt = 0; mt < 2; ++mt) {
#pragma unroll
        for (int i = 0; i < 16; ++i) s[mt][i] = 0.f;
#pragma unroll
        for (int ks = 0; ks < 4; ++ks) {
            const bf16x8 kf = *(const bf16x8*)(kg + (mt * 32 + rr) * 64 + ks * 16 + hh * 8);
            const bf16x8 qv = __builtin_bit_cast(bf16x8, qs[ks * 64]);
            s[mt] = MFMA32(kf, qv, s[mt]);
        }
        asm volatile("" ::: "memory");
    }
    (void)m;
    __builtin_amdgcn_sched_barrier(0);
    float psum = 0.f;
    if (EM) {
        const int lo2 = lo - 4 * hh, hi2 = hi - 4 * hh;
#pragma unroll
        for (int mt = 0; mt < 2; ++mt)
#pragma unroll
            for (int i = 0; i < 16; ++i) {
                const int kc_ = mt * 32 + (i & 3) + 8 * (i >> 2);
                float v = s[mt][i];
                v = (kc_ >= lo2 && kc_ <= hi2) ? v : -1e30f;
                float pv = __builtin_amdgcn_exp2f(v);
                if (MODE == 2) pv *= inv_l;
                s[mt][i] = pv; psum += pv;
            }
    } else {
        const float off = lane_on ? 0.f : -1e30f;
#pragma unroll
        for (int mt = 0; mt < 2; ++mt)
#pragma unroll
            for (int i = 0; i < 16; ++i) {
                float pv = __builtin_amdgcn_exp2f(s[mt][i] + off);
                if (MODE == 2) pv *= inv_l;
                s[mt][i] = pv; psum += pv;
            }
    }
    __builtin_amdgcn_sched_barrier(0);
    if (MODE != 2) l += psum;
    if (MODE == 0) return;
    if (MODE == 2) {
#pragma unroll
        for (int mt = 0; mt < 2; ++mt)
#pragma unroll
            for (int jj = 0; jj < 4; ++jj) {
                float q4 = (s[mt][4 * jj] + s[mt][4 * jj + 1]) + (s[mt][4 * jj + 2] + s[mt][4 * jj + 3]);
                float e3 = s[mt][4 * jj + 3];
                q4 += __shfl_xor(q4, 1); q4 += __shfl_xor(q4, 2);
                e3 += __shfl_xor(e3, 1); e3 += __shfl_xor(e3, 2);
                if ((rr & 3) == 0) {
                    const int j = jbase + mt * 8 + 2 * jj + hh;
                    atomicAdd(&sm.imp[tokl * 256 + j], q4);
                    if (j + 1 < 256) atomicAdd(&sm.imp[tokl * 256 + j + 1], e3);
                }
            }
    }
#pragma unroll
    for (int mt = 0; mt < 2; ++mt)
#pragma unroll
        for (int s2 = 0; s2 < 2; ++s2) {
            uint4 pu;
            pu.x = pack2(s[mt][8 * s2 + 0], s[mt][8 * s2 + 1]); pu.y = pack2(s[mt][8 * s2 + 2], s[mt][8 * s2 + 3]);
            pu.z = pack2(s[mt][8 * s2 + 4], s[mt][8 * s2 + 5]); pu.w = pack2(s[mt][8 * s2 + 6], s[mt][8 * s2 + 7]);
            const bf16x8 pf = __builtin_bit_cast(bf16x8, pu);
            asm volatile("" ::: "memory");
#pragma unroll
            for (int dt = 0; dt < 2; ++dt) {
                const bf16_t* vp = vg + (size_t)(dt * 32 + rr) * 1024 + mt * 32 + s2 * 16 + hh * 4;
                const uint2 v0 = *(const uint2*)vp, v1 = *(const uint2*)(vp + 8);
                const bf16x8 vf = __builtin_bit_cast(bf16x8, make_uint4(v0.x, v0.y, v1.x, v1.y));
                o[dt] = MFMA32(vf, pf, o[dt]);
            }
        }
}

template <int CTRL> DI unsigned dpp_umax(unsigned x) { const unsigned t = (unsigned)__builtin_amdgcn_mov_dpp((int)x, CTRL, 0xF, 0xF, true); return x > t ? x : t; }
DI unsigned wave_umax(unsigned v) {
    v = dpp_umax<0xB1>(v); v = dpp_umax<0x4E>(v); v = dpp_umax<0x141>(v); v = dpp_umax<0x140>(v);
    const unsigned a = (unsigned)__builtin_amdgcn_readlane((int)v, 0), b = (unsigned)__builtin_amdgcn_readlane((int)v, 16);
    const unsigned c = (unsigned)__builtin_amdgcn_readlane((int)v, 32), d = (unsigned)__builtin_amdgcn_readlane((int)v, 48);
    const unsigned ab = a > b ? a : b, cd = c > d ? c : d;
    return ab > cd ? ab : cd;
}


typedef unsigned u32x4 __attribute__((ext_vector_type(4)));
#define GLD16(R, PTR) asm volatile("global_load_dwordx4 %0, %1, off" : "=&v"(R) : "v"(PTR))
template <bool NEEDV, class NextF, class KPtrF, class VPtrF, class CompF>
DI void attn_pipe(AttnSmem& sm, const int tid, int j, const NextF next, const KPtrF kptr, const int kst, const VPtrF vptr, const int vst, const CompF comp) {
    if (j < 0) return;
    u32x4 Ak0, Ak1, Av0 = {0u, 0u, 0u, 0u}, Av1 = {0u, 0u, 0u, 0u}, Bk0, Bk1, Bv0 = {0u, 0u, 0u, 0u}, Bv1 = {0u, 0u, 0u, 0u};
    const int lr = tid >> 3, lc = (tid & 7) * 8;
#define PIPE_LOADS(S, JJ) { const bf16_t* kp_ = kptr(JJ) + (size_t)lr * kst + lc; GLD16(S##k0, kp_); GLD16(S##k1, kp_ + (size_t)32 * kst); \
        if (NEEDV) { const bf16_t* vp_ = vptr(JJ) + (size_t)lr * vst + lc; GLD16(S##v0, vp_); GLD16(S##v1, vp_ + (size_t)32 * vst); } }
#define PIPE_WAIT(S) { if (NEEDV) asm volatile("s_waitcnt vmcnt(4)" : "+v"(S##k0), "+v"(S##k1), "+v"(S##v0), "+v"(S##v1)); \
        else asm volatile("s_waitcnt vmcnt(2)" : "+v"(S##k0), "+v"(S##k1)); }
#define PIPE_STORES(S) { *(u32x4*)&sm.k[lr * 72 + lc] = S##k0; *(u32x4*)&sm.k[(lr + 32) * 72 + lc] = S##k1; \
        if (NEEDV) { bf16_t* d0_ = &sm.vt[lr * 68 + lc]; bf16_t* d1_ = &sm.vt[(lr + 32) * 68 + lc]; \
            *(uint2*)d0_ = make_uint2(S##v0.x, S##v0.y); *(uint2*)(d0_ + 4) = make_uint2(S##v0.z, S##v0.w); \
            *(uint2*)d1_ = make_uint2(S##v1.x, S##v1.y); *(uint2*)(d1_ + 4) = make_uint2(S##v1.z, S##v1.w); } }
    int jn = next(j);
    PIPE_LOADS(A, j)
    PIPE_LOADS(B, (jn >= 0 ? jn : j))
    while (true) {
        __syncthreads();
        PIPE_WAIT(A)
        PIPE_STORES(A)
        __syncthreads();
        const int jnn = jn >= 0 ? next(jn) : -1;
        PIPE_LOADS(A, (jnn >= 0 ? jnn : j))
        comp(j);
        if (jn < 0) break;
        __syncthreads();
        PIPE_WAIT(B)
        PIPE_STORES(B)
        __syncthreads();
        const int jnnn = jnn >= 0 ? next(jnn) : -1;
        PIPE_LOADS(B, (jnnn >= 0 ? jnnn : jn))
        comp(jn);
        if (jnn < 0) break;
        j = jnn; jn = jnnn;
    }
    asm volatile("s_waitcnt vmcnt(0)" : "+v"(Ak0), "+v"(Ak1), "+v"(Av0), "+v"(Av1), "+v"(Bk0), "+v"(Bk1), "+v"(Bv0), "+v"(Bv1));
#undef PIPE_LOADS
#undef PIPE_WAIT
#undef PIPE_STORES
}


typedef float f32x4v __attribute__((ext_vector_type(4)));
#define MFMA16(a, b, c) __builtin_amdgcn_mfma_f32_16x16x32_bf16((a), (b), (c), 0, 0, 0)
template <bool EM>
DI void sel16_scores(const u32x4 k0, const u32x4 k1, const u32x4 k2, const u32x4 k3, const u32x4 k4, const u32x4 k5, const u32x4 k6, const u32x4 k7,
                     const u32x4 q0, const u32x4 q1, float& l, const int hi, const bool lane_on, const int lane, u32x4& pf0, u32x4& pf1) {
    const int g4 = lane >> 4;
    const f32x4v z = {0.f, 0.f, 0.f, 0.f};
    const bf16x8 qa = __builtin_bit_cast(bf16x8, q0), qb = __builtin_bit_cast(bf16x8, q1);
    f32x4v a0 = MFMA16(__builtin_bit_cast(bf16x8, k0), qa, z); a0 = MFMA16(__builtin_bit_cast(bf16x8, k1), qb, a0);
    f32x4v a1 = MFMA16(__builtin_bit_cast(bf16x8, k2), qa, z); a1 = MFMA16(__builtin_bit_cast(bf16x8, k3), qb, a1);
    f32x4v a2 = MFMA16(__builtin_bit_cast(bf16x8, k4), qa, z); a2 = MFMA16(__builtin_bit_cast(bf16x8, k5), qb, a2);
    f32x4v a3 = MFMA16(__builtin_bit_cast(bf16x8, k6), qa, z); a3 = MFMA16(__builtin_bit_cast(bf16x8, k7), qb, a3);
    float psum = 0.f;
    if (EM) {
        const int hi2 = hi - 4 * g4;
#pragma unroll
        for (int r = 0; r < 4; ++r) {
            a0[r] = __builtin_amdgcn_exp2f((r <= hi2) ? a0[r] : -1e30f);
            a1[r] = __builtin_amdgcn_exp2f((16 + r <= hi2) ? a1[r] : -1e30f);
            a2[r] = __builtin_amdgcn_exp2f((32 + r <= hi2) ? a2[r] : -1e30f);
            a3[r] = __builtin_amdgcn_exp2f((48 + r <= hi2) ? a3[r] : -1e30f);
            psum += (a0[r] + a1[r]) + (a2[r] + a3[r]);
        }
    } else {
        const float off = lane_on ? 0.f : -1e30f;
#pragma unroll
        for (int r = 0; r < 4; ++r) {
            a0[r] = __builtin_amdgcn_exp2f(a0[r] + off); a1[r] = __builtin_amdgcn_exp2f(a1[r] + off);
            a2[r] = __builtin_amdgcn_exp2f(a2[r] + off); a3[r] = __builtin_amdgcn_exp2f(a3[r] + off);
            psum += (a0[r] + a1[r]) + (a2[r] + a3[r]);
        }
    }
    l += psum;
    pf0.x = pack2(a0[0], a0[1]); pf0.y = pack2(a0[2], a0[3]); pf0.z = pack2(a1[0], a1[1]); pf0.w = pack2(a1[2], a1[3]);
    pf1.x = pack2(a2[0], a2[1]); pf1.y = pack2(a2[2], a2[3]); pf1.z = pack2(a3[0], a3[1]); pf1.w = pack2(a3[2], a3[3]);
}
DI void sel16_pv(const u32x4 v0, const u32x4 v1, const u32x4 v2, const u32x4 v3, const u32x4 v4, const u32x4 v5, const u32x4 v6, const u32x4 v7,
                 const u32x4 pf0, const u32x4 pf1, f32x4v& o0, f32x4v& o1, f32x4v& o2, f32x4v& o3) {
    const bf16x8 pa = __builtin_bit_cast(bf16x8, pf0), pb = __builtin_bit_cast(bf16x8, pf1);
    o0 = MFMA16(__builtin_bit_cast(bf16x8, v0), pa, o0); o1 = MFMA16(__builtin_bit_cast(bf16x8, v1), pa, o1);
    o2 = MFMA16(__builtin_bit_cast(bf16x8, v2), pa, o2); o3 = MFMA16(__builtin_bit_cast(bf16x8, v3), pa, o3);
    o0 = MFMA16(__builtin_bit_cast(bf16x8, v4), pb, o0); o1 = MFMA16(__builtin_bit_cast(bf16x8, v5), pb, o1);
    o2 = MFMA16(__builtin_bit_cast(bf16x8, v6), pb, o2); o3 = MFMA16(__builtin_bit_cast(bf16x8, v7), pb, o3);
}

DI void attn_unit(const P& p, int u, char* smem) {
    AttnSmem& sm = *(AttnSmem*)smem;
    const int tid = tidx(), wave = tid >> 6, lane = tid & 63, rr = lane & 31, hh = lane >> 5;
    const int tile = 511 - (u >> 2), bhk = u & 3, b = bhk >> 1, hk = bhk & 1, t0 = tile * 32;
    const int tokl = wave * 8 + (rr >> 2), t = t0 + tokl, g = rr & 3, head = hk * 4 + g;
    const size_t tokg = (size_t)b * S_ + t;
    uint4* qs = &sm.q[wave * 256 + lane];
#pragma unroll
    for (int ks = 0; ks < 4; ++ks) qs[ks * 64] = *(const uint4*)(p.proj + tokg * PLD + QC + head * 64 + ks * 16 + hh * 8);
#define GATE(i) sigmoidf_(__uint_as_float((unsigned)p.proj[((size_t)b * S_ + t) * PLD + GC + head * 3 + (i)] << 16))
#pragma unroll
    for (int i = 0; i < 8; ++i) *(float4*)&sm.imp[(tid + i * 256) * 4] = make_float4(0.f, 0.f, 0.f, 0.f);
    sm.selbits[tid] = 0u;
    f32x16 o[2];
#pragma unroll
    for (int dt = 0; dt < 2; ++dt)
#pragma unroll
        for (int i = 0; i < 16; ++i) o[dt][i] = 0.f;
    float* park = &sm.imp[wave * 2048 + lane];
    const int ntc = (t0 >> 10) + 1;
    const int vmaxi = (t >= 31) ? ((t - 31) >> 4) : -1;
    const int twmin = t0 + wave * 8;
    const int wvmin = (twmin >= 31) ? ((twmin - 31) >> 4) : -1;
    const bf16_t* kcb = p.kc + (size_t)bhk * 1024 * 64;
    const bf16_t* vcb = p.vcT + (size_t)bhk * 64 * 1024;
    float m = -1e30f, l = 0.f;
    {
        __syncthreads();
        for (int j = 0; j < ntc; ++j) {
            const bf16_t* kg = kcb + (size_t)j * 64 * 64;
            if (j * 64 + 63 <= wvmin) attn_tile_g<0, false>(sm, kg, vcb, qs, o, m, l, 0.f, 0, 0, true, lane, tokl, 0);
            else attn_tile_g<0, true>(sm, kg, vcb, qs, o, m, l, 0.f, 0, vmaxi - j * 64, true, lane, tokl, 0);
        }
        const float lt = l + __shfl_xor(l, 32);
        const float inv_l = lt > 0.f ? 1.f / lt : 0.f;
        for (int j = 0; j < ntc; ++j) {
            const bf16_t* kg = kcb + (size_t)j * 64 * 64;
            const bf16_t* vg = vcb + j * 64;
            if (j * 64 + 63 <= wvmin) attn_tile_g<2, false>(sm, kg, vg, qs, o, m, l, inv_l, 0, 0, true, lane, tokl, j * 16);
            else attn_tile_g<2, true>(sm, kg, vg, qs, o, m, l, inv_l, 0, vmaxi - j * 64, true, lane, tokl, j * 16);
        }
    }
    __syncthreads();
    const int cur = t0 >> 6;
    for (int tk = 0; tk < 8; ++tk) {
        const int tl = wave * 8 + tk;
        const float* ip = &sm.imp[tl * 256];
        unsigned nib = 0u;
        if (cur <= 15) {
#pragma unroll
            for (int e = 0; e < 4; ++e) if (lane * 4 + e <= cur) nib |= 1u << e;
        } else {
            unsigned k0, k1, k2, k3;
            {
                const float4 iv = *(const float4*)(ip + lane * 4);
                const int j0 = lane * 4;
                k0 = (j0 >= 1 && j0 <= cur - 2) ? ((__float_as_uint(iv.x) & 0xFFFFFF00u) | (unsigned)(255 - j0)) : 0u;
                k1 = (j0 + 1 <= cur - 2) ? ((__float_as_uint(iv.y) & 0xFFFFFF00u) | (unsigned)(254 - j0)) : 0u;
                k2 = (j0 + 2 <= cur - 2) ? ((__float_as_uint(iv.z) & 0xFFFFFF00u) | (unsigned)(253 - j0)) : 0u;
                k3 = (j0 + 3 <= cur - 2) ? ((__float_as_uint(iv.w) & 0xFFFFFF00u) | (unsigned)(252 - j0)) : 0u;
#pragma unroll
                for (int e = 0; e < 4; ++e) { const int j = j0 + e; if (j == 0 || j == cur || j == cur - 1) nib |= 1u << e; }
            }
            for (int r = 0; r < 13; ++r) {
                unsigned lm = k0 > k1 ? k0 : k1; const unsigned lm2 = k2 > k3 ? k2 : k3; lm = lm > lm2 ? lm : lm2;
                const unsigned wm = wave_umax(lm);
                if (k0 == wm) { k0 = 0u; nib |= 1u; }
                if (k1 == wm) { k1 = 0u; nib |= 2u; }
                if (k2 == wm) { k2 = 0u; nib |= 4u; }
                if (k3 == wm) { k3 = 0u; nib |= 8u; }
            }
        }
        atomicOr(&sm.selbits[tl * 8 + (lane >> 3)], nib << ((lane & 7) * 4));
    }
    __syncthreads();
    if (tid < 32) {
        const int w = tid >> 3, d = tid & 7; unsigned uu = 0u;
#pragma unroll
        for (int k = 0; k < 8; ++k) uu |= sm.selbits[(w * 8 + k) * 8 + d];
        sm.wunion[w * 8 + d] = uu;
    }
    if (tid < 64) {
        const int wg = tid >> 3, d = tid & 7; unsigned uu = 0u;
#pragma unroll
        for (int k = 0; k < 4; ++k) uu |= sm.selbits[(wg * 4 + k) * 8 + d];
        sm.gunion[wg * 8 + d] = uu;
    }
    __syncthreads();
    if (tid < 8) sm.bunion[tid] = sm.wunion[tid] | sm.wunion[8 + tid] | sm.wunion[16 + tid] | sm.wunion[24 + tid];
    __syncthreads();
    {
        const float g0 = GATE(0);
#pragma unroll
        for (int dt = 0; dt < 2; ++dt)
#pragma unroll
            for (int i = 0; i < 16; ++i) { park[(dt * 16 + i) * 64] = g0 * o[dt][i]; o[dt][i] = 0.f; }
    }
    {
        const bf16_t* kb = p.proj + (size_t)(b * S_) * PLD + KVC + 2 * 128 + hk * 64;
        const bf16_t* vb = p.vT + (size_t)((0 * 4 + bhk) * 64) * S_;
        m = -1e30f; l = 0.f;
        (void)kb; (void)vb; (void)m; (void)l;
        const bf16_t* kswb = p.ksw + ((size_t)bhk * 256 * 512 + lane) * 8;
        const bf16_t* vswb = p.vsw + ((size_t)bhk * 256 * 512 + lane) * 8;
        float* pbase = &sm.imp[wave * 2048];
        const int q16 = lane & 15, g4 = lane >> 4;
        const int tl0 = wave * 8 + (q16 >> 2), tl1 = tl0 + 4, tt0_ = t0 + tl0, tt1_ = t0 + tl1, head16 = hk * 4 + (q16 & 3);
        const bf16_t* qrow0 = p.proj + ((size_t)b * S_ + tt0_) * PLD;
        const bf16_t* qrow1 = p.proj + ((size_t)b * S_ + tt1_) * PLD;
        const u32x4 qa0 = *(const u32x4*)(qrow0 + QC + head16 * 64 + g4 * 8), qa1 = *(const u32x4*)(qrow0 + QC + head16 * 64 + 32 + g4 * 8);
        const u32x4 qb0 = *(const u32x4*)(qrow1 + QC + head16 * 64 + g4 * 8), qb1 = *(const u32x4*)(qrow1 + QC + head16 * 64 + 32 + g4 * 8);
        auto nextw = [&](int j) -> int {
            ++j;
            while (j <= cur) {
                const unsigned w = sm.wunion[wave * 8 + (j >> 5)] >> (j & 31);
                if (w) { j += __ffs((int)w) - 1; return j <= cur ? j : -1; }
                j = (j | 31) + 1;
            }
            return -1;
        };
        const f32x4v z4 = {0.f, 0.f, 0.f, 0.f};
        f32x4v oa0 = z4, oa1 = z4, oa2 = z4, oa3 = z4, ob0 = z4, ob1 = z4, ob2 = z4, ob3 = z4;
        float la = 0.f, lb = 0.f;
        u32x4 A0, A1, A2, A3, A4, A5, A6, A7, B0, B1, B2, B3, B4, B5, B6, B7, V0, V1, V2, V3, V4, V5, V6, V7;
        u32x4 pa0 = {0u, 0u, 0u, 0u}, pa1 = pa0, pb0 = pa0, pb1 = pa0;
#define SEL_LD8(R, BASE, JJ) { const bf16_t* b_ = (BASE) + (size_t)(JJ) * 4096; GLD16(R##0, b_); GLD16(R##1, b_ + 512); GLD16(R##2, b_ + 1024); GLD16(R##3, b_ + 1536); \
        GLD16(R##4, b_ + 2048); GLD16(R##5, b_ + 2560); GLD16(R##6, b_ + 3072); GLD16(R##7, b_ + 3584); }
#define SEL_WAIT8(R, N) asm volatile("s_waitcnt vmcnt(" #N ")" : "+v"(R##0), "+v"(R##1), "+v"(R##2), "+v"(R##3), "+v"(R##4), "+v"(R##5), "+v"(R##6), "+v"(R##7))
#define SEL_TILE(K, JJ) { \
        const int jj_ = (JJ); \
        const bool needa_ = (sm.gunion[(wave * 2 + 0) * 8 + (jj_ >> 5)] >> (jj_ & 31)) & 1u, needb_ = (sm.gunion[(wave * 2 + 1) * 8 + (jj_ >> 5)] >> (jj_ & 31)) & 1u; \
        const bool sela_ = (sm.selbits[tl0 * 8 + (jj_ >> 5)] >> (jj_ & 31)) & 1u, selb_ = (sm.selbits[tl1 * 8 + (jj_ >> 5)] >> (jj_ & 31)) & 1u; \
        SEL_WAIT8(K, 16); \
        if (needa_) { \
            if (jj_ < cur) sel16_scores<false>(K##0, K##1, K##2, K##3, K##4, K##5, K##6, K##7, qa0, qa1, la, 0, sela_, lane, pa0, pa1); \
            else sel16_scores<true>(K##0, K##1, K##2, K##3, K##4, K##5, K##6, K##7, qa0, qa1, la, sela_ ? tt0_ - jj_ * 64 : -1, true, lane, pa0, pa1); } \
        if (needb_) { \
            if (jj_ < cur) sel16_scores<false>(K##0, K##1, K##2, K##3, K##4, K##5, K##6, K##7, qb0, qb1, lb, 0, selb_, lane, pb0, pb1); \
            else sel16_scores<true>(K##0, K##1, K##2, K##3, K##4, K##5, K##6, K##7, qb0, qb1, lb, selb_ ? tt1_ - jj_ * 64 : -1, true, lane, pb0, pb1); } \
        SEL_WAIT8(V, 8); \
        if (needa_) sel16_pv(V0, V1, V2, V3, V4, V5, V6, V7, pa0, pa1, oa0, oa1, oa2, oa3); \
        if (needb_) sel16_pv(V0, V1, V2, V3, V4, V5, V6, V7, pb0, pb1, ob0, ob1, ob2, ob3); }
        {
            int j = nextw(-1);
            if (j >= 0) {
                SEL_LD8(A, kswb, j)
                while (true) {
                    const int jn = nextw(j);
                    SEL_LD8(V, vswb, j)
                    SEL_LD8(B, kswb, (jn >= 0 ? jn : j))
                    SEL_TILE(A, j)
                    if (jn < 0) break;
                    const int jnn = nextw(jn);
                    SEL_LD8(V, vswb, jn)
                    SEL_LD8(A, kswb, (jnn >= 0 ? jnn : jn))
                    SEL_TILE(B, jn)
                    if (jnn < 0) break;
                    j = jnn;
                }
                asm volatile("s_waitcnt vmcnt(0)" : "+v"(A0), "+v"(A1), "+v"(A2), "+v"(A3), "+v"(A4), "+v"(A5), "+v"(A6), "+v"(A7), "+v"(B0), "+v"(B1), "+v"(B2), "+v"(B3), "+v"(B4), "+v"(B5), "+v"(B6), "+v"(B7));
                asm volatile("s_waitcnt vmcnt(0)" : "+v"(V0), "+v"(V1), "+v"(V2), "+v"(V3), "+v"(V4), "+v"(V5), "+v"(V6), "+v"(V7));
            }
        }
#undef SEL_LD8
#undef SEL_WAIT8
#undef SEL_TILE
#define SEL_FIN(GRP, LG, QROW, O0, O1, O2, O3) { \
        float lt_ = (LG) + __shfl_xor((LG), 16); lt_ += __shfl_xor(lt_, 32); \
        const float g1_ = sigmoidf_(__uint_as_float((unsigned)(QROW)[GC + head16 * 3 + 1] << 16)); \
        const float sc_ = lt_ > 0.f ? g1_ / lt_ : 0.f; \
        const int r32_ = (GRP) * 16 + q16, hh32_ = g4 & 1; \
        _Pragma("unroll") for (int dt = 0; dt < 4; ++dt) { \
            const f32x4v ov_ = dt == 0 ? O0 : (dt == 1 ? O1 : (dt == 2 ? O2 : O3)); \
            _Pragma("unroll") for (int r = 0; r < 4; ++r) { \
                const int i32_ = r + 4 * ((dt & 1) * 2 + (g4 >> 1)); \
                pbase[((dt >> 1) * 16 + i32_) * 64 + r32_ + 32 * hh32_] += sc_ * ov_[r]; } } }
        SEL_FIN(0, la, qrow0, oa0, oa1, oa2, oa3)
        SEL_FIN(1, lb, qrow1, ob0, ob1, ob2, ob3)
#undef SEL_FIN
    }
    {
        const bf16_t* kb = p.proj + (size_t)(b * S_) * PLD + KVC + 4 * 128 + hk * 64;
        const bf16_t* vb = p.vT + (size_t)((1 * 4 + bhk) * 64) * S_;
        m = -1e30f; l = 0.f;
        const int jlo = (t0 >= 511) ? ((t0 - 511) >> 6) : 0, jhi = t0 >> 6;
        attn_pipe<true>(sm, tid, jlo, [&](int j) -> int { return j + 1 <= jhi ? j + 1 : -1; }, [&](int j) -> const bf16_t* { return kb + (size_t)j * 64 * PLD; }, PLD,
                        [&](int j) -> const bf16_t* { return vb + j * 64; }, S_, [&](int j) {
            if (j * 64 >= twmin + 7 - 511 && j * 64 + 63 <= twmin) attn_tile<1, false>(sm, qs, o, m, l, 0.f, 0, 0, true, lane, tokl, 0);
            else attn_tile<1, true>(sm, qs, o, m, l, 0.f, t - 511 - j * 64, t - j * 64, true, lane, tokl, 0);
        });
        const float lt = l + __shfl_xor(l, 32);
        const float sc = lt > 0.f ? GATE(2) / lt : 0.f;
#pragma unroll
        for (int dt = 0; dt < 2; ++dt)
#pragma unroll
            for (int i = 0; i < 16; ++i) o[dt][i] = park[(dt * 16 + i) * 64] + sc * o[dt][i];
    }
    bf16_t* mp = p.A + tokg * 1024 + 512 + head * 64;
#pragma unroll
    for (int dt = 0; dt < 2; ++dt)
#pragma unroll
        for (int jj = 0; jj < 4; ++jj) {
            uint2 ov; ov.x = pack2(o[dt][4 * jj], o[dt][4 * jj + 1]); ov.y = pack2(o[dt][4 * jj + 2], o[dt][4 * jj + 3]);
            *(uint2*)(mp + dt * 32 + jj * 8 + hh * 4) = ov;
        }
}

DI void phase4(const P& p, char* smem) {
    for (int su = blockIdx.x; su < 128; su += gridDim.x) scan_unit(p, su, smem);
    AttnSmem& sm = *(AttnSmem*)smem;
    while (true) {
        __syncthreads();
        if (tidx() == 0) sm.unit = (int)atomicAdd(p.counter, 1u);
        __syncthreads();
        const int u = sm.unit;
        if (u >= 2048) break;
        attn_unit(p, u, smem);
    }
}

DI void phase4b(const P& p) {
    const int tid = tidx();
    for (int it = blockIdx.x; it < T_ / 4; it += gridDim.x) {
        const int gi = it * 4 + (tid >> 6), cgp = tid & 63, h = cgp >> 3, c8 = (cgp & 7) * 8, col = cgp * 8, b = gi >> 14, s = gi & (S_ - 1);
        const float4 y0 = *(const float4*)(p.yraw + (size_t)gi * 512 + col), y1 = *(const float4*)(p.yraw + (size_t)gi * 512 + col + 4);
        float y[8] = {y0.x, y0.y, y0.z, y0.w, y1.x, y1.y, y1.z, y1.w};
        const bf16_t* sp = p.stream + ((size_t)((b * 8 + h) * S_ + s) * 6) * 64 + c8;
        float km[8], r[8], v[8], gg[8];
        unpack8(*(const uint4*)(sp + 64), km); unpack8(*(const uint4*)(sp + 256), r); unpack8(*(const uint4*)(sp + 320), v);
        unpack8(*(const uint4*)(p.gbuf + (size_t)gi * 512 + col), gg);
        float sum = 0.f, bon = 0.f;
#pragma unroll
        for (int e = 0; e < 8; ++e) { sum += y[e]; bon += r[e] * km[e] * p.r_k[col + e]; }
        sum += __shfl_xor(sum, 1); sum += __shfl_xor(sum, 2); sum += __shfl_xor(sum, 4);
        bon += __shfl_xor(bon, 1); bon += __shfl_xor(bon, 2); bon += __shfl_xor(bon, 4);
        const float mean = sum * (1.f / 64.f);
        float var = 0.f;
#pragma unroll
        for (int e = 0; e < 8; ++e) { y[e] -= mean; var += y[e] * y[e]; }
        var += __shfl_xor(var, 1); var += __shfl_xor(var, 2); var += __shfl_xor(var, 4);
        const float rs = rsqrtf(var * (1.f / 64.f) + 64e-5f);
        float o[8];
#pragma unroll
        for (int e = 0; e < 8; ++e) o[e] = (y[e] * rs * p.lnx_w[col + e] + p.lnx_b[col + e] + bon * v[e]) * gg[e];
        *(uint4*)(p.A + (size_t)gi * 1024 + col) = pack8(o);
    }
}

struct EpiFfn2 {
    float* out;
    DI void operator()(const f32x16 (&acc)[2][2], int rowbase, int colbase, int lane) const {
        const int rr = lane & 31, hh = lane >> 5;
#pragma unroll
        for (int w = 0; w < 2; ++w)
#pragma unroll
            for (int t = 0; t < 2; ++t)
#pragma unroll
                for (int j = 0; j < 4; ++j) {
                    float4* o = (float4*)(out + (size_t)(rowbase + t * 32 + rr) * 1024 + colbase + w * 32 + j * 8 + hh * 4);
                    float4 xv = *o;
                    xv.x += acc[w][t][4 * j]; xv.y += acc[w][t][4 * j + 1]; xv.z += acc[w][t][4 * j + 2]; xv.w += acc[w][t][4 * j + 3];
                    *o = xv;
                }
    }
};

DI void final_item(float* io, const float* g, int idx) {
    const int row = idx * 4 + (tidx() >> 6), lane = tidx() & 63;
    float4* sp = (float4*)(io + (size_t)row * 1024);
    float4 v[4]; float ss = 0.f;
#pragma unroll
    for (int i = 0; i < 4; ++i) { v[i] = sp[lane + 64 * i]; ss += v[i].x * v[i].x + v[i].y * v[i].y + v[i].z * v[i].z + v[i].w * v[i].w; }
    ss = wave_sum(ss);
    const float rs = rsqrtf(ss * (1.f / 1024.f) + 1e-6f);
#pragma unroll
    for (int i = 0; i < 4; ++i) {
        const float4 gv = ((const float4*)g)[lane + 64 * i];
        sp[lane + 64 * i] = make_float4(v[i].x * rs * gv.x, v[i].y * rs * gv.y, v[i].z * rs * gv.z, v[i].w * rs * gv.w);
    }
}

DI bool gemm_order(const int round, const int NT, int& mt, int& nt) {
    if (gridDim.x == 512) {
        const int xcd = blockIdx.x & 7, lb = blockIdx.x >> 3;
        const int q = round * 64 + lb;
        if (q >= 32 * NT) return false;
        mt = xcd * 32 + (q / (8 * NT)) * 8 + (q & 7);
        nt = (q >> 3) % NT;
        return true;
    }
    const int it = round * gridDim.x + blockIdx.x;
    if (it >= 256 * NT) return false;
    mt = it / NT; nt = it - mt * NT;
    return true;
}

DI void run_phase(const P& p, int ph, char* smem) {
    switch (ph) {
    case 0: phase0(p, smem); break;
    case 1:
        for (int rd = 0;; ++rd) {
            int mt, nt; if (!gemm_order(rd, 25, mt, nt)) break;
            gemm_tile<8>(AFPlain{p.A, 1024}, p.WinT + (size_t)nt * 128 * 1024, 1024, mt * 128, nt * 128, EpiProj{p.proj}, smem);
        }
        break;
    case 2: phase2(p, smem); break;
    case 3: phase3(p, smem); break;
    case 4: phase4(p, smem); break;
    case 5: phase4b(p); break;
    case 6:
        for (int rd = 0;; ++rd) {
            int mt, nt; if (!gemm_order(rd, 8, mt, nt)) break;
            gemm_tile<8>(AFPlain{p.A, 1024}, p.WoutT + (size_t)nt * 128 * 1024, 1024, mt * 128, nt * 128, EpiOut{p.out, p.x}, smem);
        }
        break;
    case 7:
        for (int it = blockIdx.x; it < T_ / 4; it += gridDim.x) rms_item(p.out, p.norm_ffn, p.A, it);
        break;
    case 8:
        for (int rd = 0;; ++rd) {
            int mt, nt; if (!gemm_order(rd, 44, mt, nt)) break;
            gemm_tile<8>(AFPlain{p.A, 1024}, p.WguT + (size_t)nt * 128 * 1024, 1024, mt * 128, nt * 128, EpiFfn1{p.stream}, smem);
        }
        break;
    case 9:
        for (int rd = 0;; ++rd) {
            int mt, nt; if (!gemm_order(rd, 8, mt, nt)) break;
            gemm_tile<1>(AFPlain{p.stream, DFF}, p.WdnT + (size_t)nt * 128 * DFF, DFF, mt * 128, nt * 128, EpiFfn2{p.out}, smem);
        }
        break;
    default:
        for (int it = blockIdx.x; it < T_ / 4; it += gridDim.x) final_item(p.out, p.norm_final, it);
        break;
    }
}
constexpr int NPHASE = 11;
constexpr int SMEM_BYTES = 73728;


#define XB_TMO      128
#define XB_XCNT(j)  (256  + 64 * (j))
#define XB_XSUB(j)  (1280 + 64 * (j))
#define XB_XGEN(j)  (2304 + 64 * (j))
#define XB_TOP      3328
#define XB_TOPGEN   3392
#define XCD_BAR_WORDS 3456
#define XB_SPIN_CAP (1u << 22)
#define LAS __attribute__((address_space(3)))
DI unsigned xb_ld(unsigned* p) { return __hip_atomic_load(p, __ATOMIC_RELAXED, __HIP_MEMORY_SCOPE_AGENT); }
DI unsigned xb_add(unsigned* p, unsigned v) { return __hip_atomic_fetch_add(p, v, __ATOMIC_RELAXED, __HIP_MEMORY_SCOPE_AGENT); }
DI unsigned xb_xcc_id() { return (unsigned)__builtin_amdgcn_s_getreg((3 << 11) | 20) & 0xFu; }
#define XB_SPIN(cond, bar) do { unsigned _sp = 0; while (cond) { __builtin_amdgcn_s_sleep(1); \
    if ((++_sp & 255u) == 0u) { if (xb_ld(&(bar)[XB_TMO])) break; if (_sp > XB_SPIN_CAP) { atomicAdd(&(bar)[XB_TMO], 1u); break; } } } } while (0)
struct XcdBarrier { unsigned* bar; unsigned x; volatile LAS unsigned* st; unsigned G; };
DI XcdBarrier xcd_barrier_post(unsigned* bar, volatile LAS unsigned* st, const unsigned G) {
    XcdBarrier b; b.bar = bar; b.x = xb_xcc_id(); b.st = st; b.G = G;
    if (tidx() == 0) (void)xb_add(&bar[XB_XCNT(b.x)], 1u);
    return b;
}
DI void xcd_barrier_complete(unsigned* bar, unsigned x, unsigned& nloc, unsigned& nx, const unsigned G) {
    unsigned sum, cnt, mine, sp = 0u;
    for (;;) {
        sum = 0u; cnt = 0u; mine = 0u;
#pragma unroll
        for (unsigned j = 0; j < 16; ++j) { const unsigned c = xb_ld(&bar[XB_XCNT(j)]); sum += c; cnt += (c > 0u) ? 1u : 0u; mine = (j == x) ? c : mine; }
        if (sum == G) break;
        __builtin_amdgcn_s_sleep(1);
        if ((++sp & 255u) == 0u) { if (xb_ld(&bar[XB_TMO])) break; if (sp > XB_SPIN_CAP) { atomicAdd(&bar[XB_TMO], 1u); break; } }
    }
    nloc = mine > 0u ? mine : 1u; nx = cnt > 0u ? cnt : 1u;
}
DI void xcd_barrier(const XcdBarrier& b) {
    asm volatile("s_waitcnt vmcnt(0)" ::: "memory");
    __syncthreads();
    if (tidx() == 0) {
        unsigned* bar = b.bar;
        __builtin_amdgcn_s_waitcnt(0);
        unsigned nloc = b.st[0], nx = b.st[1];
        if (nloc == 0u) { xcd_barrier_complete(bar, b.x, nloc, nx, b.G); b.st[0] = nloc; b.st[1] = nx; }
        const unsigned old = xb_add(&bar[XB_XSUB(b.x)], 1u);
        const unsigned gen = old / nloc;
        if (old + 1u == (gen + 1u) * nloc) {
            __builtin_amdgcn_fence(__ATOMIC_RELEASE, "agent");
            asm volatile("s_waitcnt vmcnt(0)" ::: "memory");
            const unsigned og = xb_add(&bar[XB_TOP], 1u);
            const unsigned tg = og / nx;
            if (og + 1u == (tg + 1u) * nx) xb_add(&bar[XB_TOPGEN], 1u);
            else XB_SPIN(xb_ld(&bar[XB_TOPGEN]) == tg, bar);
            __builtin_amdgcn_fence(__ATOMIC_ACQUIRE, "agent");
            xb_add(&bar[XB_XGEN(b.x)], 1u);
            asm volatile("s_waitcnt vmcnt(0)" ::: "memory");
        } else {
            XB_SPIN(xb_ld(&bar[XB_XGEN(b.x)]) == gen, bar);
            __builtin_amdgcn_fence(__ATOMIC_ACQUIRE, "agent");
            asm volatile("s_waitcnt vmcnt(0)" ::: "memory");
        }
    }
    __syncthreads();
}

DI void phase4_fused(const P& p, char* smem, const XcdBarrier& xb2) {
    const int tid = tidx();
    if (blockIdx.x < 128) {
        scan_unit(p, blockIdx.x, smem);
        if (tid == 0) {
            unsigned sp = 0u;
            while (xb_ld(p.counter + 4) == 0u) { __builtin_amdgcn_s_sleep(8); if (++sp > (1u << 22)) break; }
            __builtin_amdgcn_fence(__ATOMIC_ACQUIRE, "agent");
            asm volatile("s_waitcnt vmcnt(0)" ::: "memory");
        }
        __syncthreads();
    } else {
        const int lb = blockIdx.x - 128;
        for (int it = lb; it < 2560; it += 384) {
            const int mt = it / 10, nt = 15 + (it - mt * 10);
            gemm_tile<8>(AFPlain{p.A, 1024}, p.WinT + (size_t)nt * 128 * 1024, 1024, mt * 128, nt * 128, EpiProj{p.proj}, smem);
        }
        xcd_barrier(xb2);
        for (int it = lb; it < 640; it += 384) { if (it < 128) cmp1_item(p, it, smem); else rope_item(p, it - 128, smem); }
        xcd_barrier(xb2);
        for (int it = lb; it < 64; it += 384) cmp2_item(p, it, smem);
        xcd_barrier(xb2);
        if (lb == 0 && tid == 0) __hip_atomic_store(p.counter + 4, 1u, __ATOMIC_RELEASE, __HIP_MEMORY_SCOPE_AGENT);
    }
    AttnSmem& sm = *(AttnSmem*)smem;
    while (true) {
        __syncthreads();
        if (tidx() == 0) sm.unit = (int)atomicAdd(p.counter, 1u);
        __syncthreads();
        const int u = sm.unit;
        if (u >= 2048 + 2368) break;
        if (u < 2048) attn_unit(p, u, smem);
        else tr_item(p, 800 + (u - 2048), (float*)smem);
    }
}

__global__ void __launch_bounds__(NTHR, 2) mega_kernel(P p) {
    __shared__ __attribute__((aligned(16))) char smem[SMEM_BYTES];
    __shared__ uint4 xb_words;
    __shared__ uint4 xb_words2;
    cg::grid_group grid = cg::this_grid();
    if (p.x == nullptr) grid.sync();
    if (tidx() == 0) { xb_words = make_uint4(0u, 0u, 0u, 0u); xb_words2 = make_uint4(0u, 0u, 0u, 0u); }
    __syncthreads();
    const XcdBarrier xb = xcd_barrier_post(p.bar, (volatile LAS unsigned*)&xb_words, gridDim.x);
    run_phase(p, 0, smem); xcd_barrier(xb);
    if (gridDim.x == 512) {
        XcdBarrier xb2; xb2.bar = p.bar + XCD_BAR_WORDS; xb2.x = xb.x; xb2.st = (volatile LAS unsigned*)&xb_words2; xb2.G = 384u;
        if (blockIdx.x >= 128 && tidx() == 0) (void)xb_add(&xb2.bar[XB_XCNT(xb2.x)], 1u);
        for (int rd = 0;; ++rd) {
            int mt, nt; if (!gemm_order(rd, 15, mt, nt)) break;
            gemm_tile<8>(AFPlain{p.A, 1024}, p.WinT + (size_t)nt * 128 * 1024, 1024, mt * 128, nt * 128, EpiProj{p.proj}, smem);
        }
        xcd_barrier(xb);
        for (int it = blockIdx.x; it < 1024; it += gridDim.x) rwkv_prep(p, it, smem);
        xcd_barrier(xb);
        phase4_fused(p, smem, xb2);
        xcd_barrier(xb);
    } else {
        run_phase(p, 1, smem); xcd_barrier(xb);
        run_phase(p, 2, smem); xcd_barrier(xb);
        run_phase(p, 3, smem); xcd_barrier(xb);
        run_phase(p, 4, smem); xcd_barrier(xb);
    }
    run_phase(p, 5, smem); xcd_barrier(xb);
    run_phase(p, 6, smem); xcd_barrier(xb);
    run_phase(p, 7, smem); xcd_barrier(xb);
    run_phase(p, 8, smem); xcd_barrier(xb);
    run_phase(p, 9, smem); xcd_barrier(xb);
    run_phase(p, 10, smem);
}
__global__ void __launch_bounds__(NTHR, 2) phase_kernel(P p, int ph) {
    __shared__ __attribute__((aligned(16))) char smem[SMEM_BYTES];
    run_phase(p, ph, smem);
}

extern "C" void kernel_launch(void* const* d_in, const int* in_sizes, int n_in, void* d_out, int out_size, void* d_ws, size_t ws_size,
                              hipStream_t stream) {
    P p{};
    p.x = (const float*)d_in[0]; p.pos = (const int*)d_in[1]; p.norm_mix = (const float*)d_in[2]; p.w_in = (const float*)d_in[3];
    p.mu = (const float*)d_in[4]; p.w0 = (const float*)d_in[5]; p.w2 = (const float*)d_in[6]; p.a0 = (const float*)d_in[7];
    p.a2 = (const float*)d_in[8]; p.g2 = (const float*)d_in[9]; p.k_k = (const float*)d_in[10]; p.k_a = (const float*)d_in[11];
    p.r_k = (const float*)d_in[12]; p.lnx_w = (const float*)d_in[13]; p.lnx_b = (const float*)d_in[14]; p.pe_k = (const float*)d_in[15];
    p.wk1 = (const float*)d_in[16]; p.bk1 = (const float*)d_in[17]; p.wk2 = (const float*)d_in[18]; p.pe_v = (const float*)d_in[19];
    p.wv1 = (const float*)d_in[20]; p.bv1 = (const float*)d_in[21]; p.wv2 = (const float*)d_in[22]; p.w_out = (const float*)d_in[23];
    p.norm_ffn = (const float*)d_in[24]; p.w_gate = (const float*)d_in[25]; p.w_up = (const float*)d_in[26]; p.w_down = (const float*)d_in[27];
    p.norm_final = (const float*)d_in[28];
    p.out = (float*)d_out;
    char* ws = (char*)d_ws;
    size_t off = 0;
    auto take = [&](size_t bytes) { char* r = ws + off; off += (bytes + 255) & ~(size_t)255; return r; };
    p.WinT = (bf16_t*)take((size_t)3200 * 1024 * 2);
    p.WoutT = (bf16_t*)take((size_t)1024 * 1024 * 2);
    p.WguT = (bf16_t*)take((size_t)5632 * 1024 * 2);
    p.WdnT = (bf16_t*)take((size_t)1024 * DFF * 2);
    p.w2T = (bf16_t*)take(512 * 64 * 2);
    p.a2T = (bf16_t*)take(512 * 64 * 2);
    p.g2T = (bf16_t*)take(512 * 160 * 2);
    p.w1T = (bf16_t*)take((size_t)2 * 256 * 2048 * 2);
    p.wc2T = (bf16_t*)take(2 * 128 * 256 * 2);
    p.b1p = (float*)take(512 * 4);
    p.cosT = (float*)take((size_t)T_ * 8 * 4);
    p.sinT = (float*)take((size_t)T_ * 8 * 4);
    p.counter = (unsigned*)take(256);
    p.bar = (unsigned*)take(2 * XCD_BAR_WORDS * 4);
    off = (size_t)32 << 20;
    p.A = (bf16_t*)take((size_t)T_ * 1024 * 2);
    p.proj = (bf16_t*)take((size_t)T_ * PLD * 2);
    p.stream = (bf16_t*)take((size_t)T_ * 8 * 384 * 2);
    p.ksw = (bf16_t*)take((size_t)4 * 256 * 4096 * 2);
    p.vsw = (bf16_t*)take((size_t)4 * 256 * 4096 * 2);
    if (off > ws_size) fprintf(stderr, "workspace too small: need %zu have %zu\n", off, ws_size);
    char* ob = (char*)d_out;
    p.gbuf = (bf16_t*)ob;
    p.yraw = (float*)(ob + ((size_t)32 << 20));
    p.vT = (bf16_t*)(ob + ((size_t)96 << 20));
    p.hid = (bf16_t*)(ob + ((size_t)112 << 20));
    p.kc = (bf16_t*)(ob + ((size_t)116 << 20));
    p.vcT = (bf16_t*)(ob + ((size_t)116 << 20) + (512 << 10));
#if MK_SINGLE
    static int grid_blocks = 0;
    if (!grid_blocks) {
        int dev = 0, cus = 0, per_cu = 0;
        hipGetDevice(&dev);
        hipDeviceGetAttribute(&cus, hipDeviceAttributeMultiprocessorCount, dev);
        hipOccupancyMaxActiveBlocksPerMultiprocessor(&per_cu, mega_kernel, NTHR, 0);
        if (per_cu > 2) per_cu = 2;
        if (per_cu < 1) per_cu = 1;
        grid_blocks = cus * per_cu;
    }
    (void)hipMemsetAsync(p.bar, 0, 2 * XCD_BAR_WORDS * 4, stream);
    void* args[] = {&p};
    hipError_t e = hipLaunchCooperativeKernel((void*)mega_kernel, dim3(grid_blocks), dim3(NTHR), args, 0, stream);
    if (e != hipSuccess) fprintf(stderr, "cooperative launch failed: %s (grid %d)\n", hipGetErrorString(e), grid_blocks);
#else
    for (int ph = 0; ph < NPHASE; ++ph) phase_kernel<<<512, NTHR, 0, stream>>>(p, ph);
#endif
}
```
